# Optimizing an MI355X kernel written in HIP

```python
import jax, jax.numpy as jnp
from jax import lax
import numpy as np

D_MODEL = 1024
BATCH = 8
SEQ = 4096
DEPTH = 4

GRID_W = 64
CTX_LEN = 256

NA_HEADS = 6
NA_DIM = 64
NA_WIN_ROWS = 8
NA_WIN_COLS = 16
MLA_HEADS = 4
MLA_Q_RANK = 256
MLA_KV_RANK = 128
MLA_NOPE = 128
MLA_ROPE = 64
MLA_V = 128
MLA_BLOCK = 128
SWA_HEADS = 6
SWA_KV_HEADS = 2
SWA_DIM = 64
SWA_WINDOW = 128
SWA_BLOCK = 128
N_EXPERTS = 16
EXPERT_FF = 1024
CAPACITY_FACTOR = 2

N_BRANCH = 3
ROPE_BASE = 10000.0
EPS = 1e-6

NA_W = NA_HEADS * NA_DIM
MLA_QK = MLA_NOPE + MLA_ROPE
MLA_W = MLA_HEADS * MLA_V
SWA_W = SWA_HEADS * SWA_DIM
SWA_KV_W = SWA_KV_HEADS * SWA_DIM
IN_SPLITS = (NA_W, NA_W, NA_W, MLA_Q_RANK, MLA_KV_RANK, MLA_ROPE, SWA_W, SWA_KV_W, SWA_KV_W, N_BRANCH * D_MODEL)
D_IN = sum(IN_SPLITS)

kernel_name = 'hybrid_na_mla_swa_ecmoe_dit'


def _rmsnorm(x, g):
    xf = x.astype(jnp.float32)
    y = xf * lax.rsqrt(jnp.mean(xf * xf, axis=-1, keepdims=True) + EPS)
    return (y * g.astype(jnp.float32)).astype(x.dtype)


def _heads(t, n):
    B, T, _ = t.shape
    return t.reshape(B, T, n, -1).transpose(0, 2, 1, 3)


def _merge_heads(t):
    B, n, T, d = t.shape
    return t.transpose(0, 2, 1, 3).reshape(B, T, n * d)


def _softmax32(s):
    return jax.nn.softmax(s.astype(jnp.float32), axis=-1)


def _rotate(x, ang):
    f = ang.shape[-1]
    x1, x2 = x[..., :f], x[..., f:]
    cos, sin = jnp.cos(ang), jnp.sin(ang)
    return jnp.concatenate([x1 * cos - x2 * sin, x2 * cos + x1 * sin], axis=-1)


def _axial_rope(x, row, col):
    half = x.shape[-1] // 2
    f = half // 2
    inv = ROPE_BASE ** (-jnp.arange(f, dtype=jnp.float32) / f)
    ar = row.astype(jnp.float32)[:, None] * inv
    ac = col.astype(jnp.float32)[:, None] * inv
    out = jnp.concatenate([_rotate(x[..., :half], ar), _rotate(x[..., half:], ac)], axis=-1)
    return out.astype(x.dtype)


def _rope_tail(t, n_rope, row, col):
    return jnp.concatenate([t[..., :-n_rope], _axial_rope(t[..., -n_rope:], row, col)], axis=-1)


def _ctx_attention(qc, kc, vc, scale, sink=None):
    B, Hq, L, _ = qc.shape
    Hk = kc.shape[1]
    G = Hq // Hk
    qg = qc.reshape(B, Hk, G, L, -1)
    s = jnp.einsum('bkgqd,bkcd->bkgqc', qg, kc).astype(jnp.float32) * scale
    if sink is not None:
        sk = jnp.broadcast_to(sink.reshape(1, Hk, G, 1, 1).astype(jnp.float32), s.shape[:-1] + (1,))
        p = _softmax32(jnp.concatenate([s, sk], axis=-1))[..., :L]
    else:
        p = _softmax32(s)
    o = jnp.einsum('bkgqc,bkcd->bkgqd', p.astype(vc.dtype), vc)
    return o.reshape(B, Hq, L, -1)


def _na_latent(q, k, v, kc, vc, rpb):
    B, H, S, d = q.shape
    rows = S // GRID_W
    wr = min(NA_WIN_ROWS, rows)
    scale = d ** -0.5
    r = jnp.arange(rows)
    ridx = jnp.clip(r - wr // 2, 0, rows - wr)[:, None] + jnp.arange(wr)[None, :]
    col = jnp.arange(GRID_W)
    c0 = jnp.clip(col - NA_WIN_COLS // 2, 0, GRID_W - NA_WIN_COLS)
    col_ok = (col[None, :] >= c0[:, None]) & (col[None, :] < c0[:, None] + NA_WIN_COLS)
    dr = ridx - r[:, None] + (NA_WIN_ROWS - 1)
    dc = jnp.clip(col[None, :] - col[:, None] + NA_WIN_COLS - 1, 0, 2 * NA_WIN_COLS - 2)
    bias = rpb[:, dr[:, None, :, None], dc[None, :, None, :]]
    qg = q.reshape(B, H, rows, GRID_W, d)
    kb = k.reshape(B, H, rows, GRID_W, d)[:, :, ridx]
    vb = v.reshape(B, H, rows, GRID_W, d)[:, :, ridx].reshape(B, H, rows, wr * GRID_W, d)
    s_loc = jnp.einsum('bhrqd,bhrwkd->bhrqwk', qg, kb).astype(jnp.float32) * scale + bias.astype(jnp.float32)
    s_loc = jnp.where(col_ok[:, None, :], s_loc, -jnp.inf).reshape(B, H, rows, GRID_W, wr * GRID_W)
    s_ctx = jnp.einsum('bhrqd,bhcd->bhrqc', qg, kc).astype(jnp.float32) * scale
    p = _softmax32(jnp.concatenate([s_loc, s_ctx], axis=-1)).astype(v.dtype)
    nl = wr * GRID_W
    o = jnp.einsum('bhrqj,bhrjd->bhrqd', p[..., :nl], vb) + jnp.einsum('bhrqc,bhcd->bhrqd', p[..., nl:], vc)
    return o.reshape(B, H, S, d)


def _mla_q(cq, q_norm, w_uq, q_g):
    B, T, _ = cq.shape
    q = (_rmsnorm(cq, q_norm) @ w_uq).reshape(B, T, MLA_HEADS, MLA_QK)
    return _rmsnorm(q, q_g).transpose(0, 2, 1, 3)


def _mla_kv(ckv, kr, kv_norm, w_ukv, k_g):
    B, T, _ = ckv.shape
    kv = (_rmsnorm(ckv, kv_norm) @ w_ukv).reshape(B, T, MLA_HEADS, MLA_NOPE + MLA_V)
    k_nope, v = kv[..., :MLA_NOPE], kv[..., MLA_NOPE:]
    k = jnp.concatenate([k_nope, jnp.broadcast_to(kr[:, :, None, :], (B, T, MLA_HEADS, MLA_ROPE))], axis=-1)
    return _rmsnorm(k, k_g).transpose(0, 2, 1, 3), v.transpose(0, 2, 1, 3)


def _mla_latent(q, k, v, kc, vc):
    B, H, S, dq = q.shape
    scale = dq ** -0.5
    k_all = jnp.concatenate([k, kc], axis=2)
    v_all = jnp.concatenate([v, vc], axis=2)
    nb = S // MLA_BLOCK
    qb = q.reshape(B, H, nb, MLA_BLOCK, dq).transpose(2, 0, 1, 3, 4)

    def block(qi):
        s = jnp.einsum('bhqd,bhkd->bhqk', qi, k_all).astype(jnp.float32) * scale
        return jnp.einsum('bhqk,bhkd->bhqd', _softmax32(s).astype(v_all.dtype), v_all)

    o = lax.map(block, qb)
    return o.transpose(1, 2, 0, 3, 4).reshape(B, H, S, -1)


def _swa_latent(q, k, v, kc, vc, sink):
    B, Hq, S, d = q.shape
    Hk = k.shape[1]
    G = Hq // Hk
    scale = d ** -0.5
    blk = SWA_BLOCK
    nb = S // blk
    qb = q.reshape(B, Hk, G, nb, blk, d)
    pad = jnp.zeros((B, Hk, blk, d), k.dtype)

    def band(t):
        tp = jnp.concatenate([pad, t, pad], axis=2).reshape(B, Hk, nb + 2, blk, d)
        return jnp.concatenate([tp[:, :, :-2], tp[:, :, 1:-1], tp[:, :, 2:]], axis=3)

    kb, vb = band(k), band(v)
    qpos = jnp.arange(nb)[:, None] * blk + jnp.arange(blk)[None, :]
    kpos = (jnp.arange(nb)[:, None] - 1) * blk + jnp.arange(3 * blk)[None, :]
    ok = (jnp.abs(qpos[:, :, None] - kpos[:, None, :]) <= SWA_WINDOW) & (kpos[:, None, :] >= 0) & (kpos[:, None, :] < S)
    s_loc = jnp.where(ok, jnp.einsum('bkgnqd,bknjd->bkgnqj', qb, kb).astype(jnp.float32) * scale, -jnp.inf)
    s_ctx = jnp.einsum('bkgnqd,bkcd->bkgnqc', qb, kc).astype(jnp.float32) * scale
    sk = jnp.broadcast_to(sink.reshape(1, Hk, G, 1, 1, 1).astype(jnp.float32), s_ctx.shape[:-1] + (1,))
    p = _softmax32(jnp.concatenate([s_loc, s_ctx, sk], axis=-1)).astype(v.dtype)
    nl = 3 * blk
    L = kc.shape[2]
    o = jnp.einsum('bkgnqj,bknjd->bkgnqd', p[..., :nl], vb) + jnp.einsum('bkgnqc,bkcd->bkgnqd', p[..., nl:nl + L], vc)
    return o.reshape(B, Hq, S, d)


def _ec_moe(h, router, w_gate, w_up, w_down):
    B, T, _ = h.shape
    cap = CAPACITY_FACTOR * T // N_EXPERTS
    aff = jax.nn.softmax((h @ router).astype(jnp.float32), axis=-1)
    gate, idx = lax.top_k(jnp.swapaxes(aff, 1, 2), cap)
    bidx = jnp.arange(B)[:, None, None]
    xg = h[bidx, idx]
    a = jnp.einsum('becd,edf->becf', xg, w_gate)
    u = jnp.einsum('becd,edf->becf', xg, w_up)
    y = jnp.einsum('becf,efd->becd', jax.nn.silu(a) * u, w_down) * gate[..., None].astype(h.dtype)
    return jnp.zeros_like(h).at[bidx, idx].add(y)


def _gated_merge(gl, y_na, y_mla, y_swa, w_o):
    g = jax.nn.sigmoid(gl.astype(jnp.float32)).astype(y_na.dtype)
    g = g.reshape(gl.shape[:-1] + (N_BRANCH, D_MODEL))
    return (g[..., 0, :] * y_na + g[..., 1, :] * y_mla + g[..., 2, :] * y_swa) @ w_o


def _layer(x, ctx, c_act, cctx_act, row, col, last,
           norm1_g, norm2_g, w_ada, b_ada, w_in,
           na_q_g, na_k_g, na_rpb,
           mla_q_norm, mla_w_uq, mla_kv_norm, mla_w_ukv, mla_q_g, mla_k_g,
           swa_q_g, swa_k_g, swa_sink,
           w_na_o, w_mla_o, w_swa_o, w_o,
           router, w_gate, w_up, w_down):
    mod = jnp.split((c_act @ w_ada + b_ada)[:, None, :], 6, axis=-1)
    mod_c = jnp.split(cctx_act @ w_ada + b_ada, 6, axis=-1)
    splits = [int(i) for i in np.cumsum(IN_SPLITS)[:-1]]

    h = _rmsnorm(x, norm1_g) * (1 + mod[1]) + mod[0]
    hc = _rmsnorm(ctx, norm1_g) * (1 + mod_c[1]) + mod_c[0]
    (na_q, na_k, na_v, mla_cq, mla_ckv, mla_kr, sw_q, sw_k, sw_v, gl) = jnp.split(h @ w_in, splits, axis=-1)
    (na_qc, na_kc, na_vc, mla_cqc, mla_ckvc, mla_krc, sw_qc, sw_kc, sw_vc, glc) = jnp.split(hc @ w_in, splits, axis=-1)

    na_kc_h = _rmsnorm(_heads(na_kc, NA_HEADS), na_k_g)
    na_vc_h = _heads(na_vc, NA_HEADS)
    o_na = _na_latent(_rmsnorm(_heads(na_q, NA_HEADS), na_q_g), _rmsnorm(_heads(na_k, NA_HEADS), na_k_g),
                      _heads(na_v, NA_HEADS), na_kc_h, na_vc_h, na_rpb)
    y_na = _merge_heads(o_na) @ w_na_o

    mla_kc_h, mla_vc_h = _mla_kv(mla_ckvc, mla_krc, mla_kv_norm, mla_w_ukv, mla_k_g)
    q_m = _rope_tail(_mla_q(mla_cq, mla_q_norm, mla_w_uq, mla_q_g), MLA_ROPE, row, col)
    k_m, v_m = _mla_kv(mla_ckv, mla_kr, mla_kv_norm, mla_w_ukv, mla_k_g)
    y_mla = _merge_heads(_mla_latent(q_m, _rope_tail(k_m, MLA_ROPE, row, col), v_m, mla_kc_h, mla_vc_h)) @ w_mla_o

    sw_kc_h = _rmsnorm(_heads(sw_kc, SWA_KV_HEADS), swa_k_g)
    sw_vc_h = _heads(sw_vc, SWA_KV_HEADS)
    q_s = _axial_rope(_rmsnorm(_heads(sw_q, SWA_HEADS), swa_q_g), row, col)
    k_s = _axial_rope(_rmsnorm(_heads(sw_k, SWA_KV_HEADS), swa_k_g), row, col)
    y_swa = _merge_heads(_swa_latent(q_s, k_s, _heads(sw_v, SWA_KV_HEADS), sw_kc_h, sw_vc_h, swa_sink)) @ w_swa_o

    x_new = x + mod[2] * _gated_merge(gl, y_na, y_mla, y_swa, w_o)
    h2 = _rmsnorm(x_new, norm2_g) * (1 + mod[4]) + mod[3]
    x_new = x_new + mod[5] * _ec_moe(h2, router, w_gate, w_up, w_down)
    if last:
        return x_new, ctx

    yc_na = _merge_heads(_ctx_attention(_rmsnorm(_heads(na_qc, NA_HEADS), na_q_g), na_kc_h, na_vc_h, NA_DIM ** -0.5)) @ w_na_o
    yc_mla = _merge_heads(_ctx_attention(_mla_q(mla_cqc, mla_q_norm, mla_w_uq, mla_q_g), mla_kc_h, mla_vc_h, MLA_QK ** -0.5)) @ w_mla_o
    yc_swa = _merge_heads(_ctx_attention(_rmsnorm(_heads(sw_qc, SWA_HEADS), swa_q_g), sw_kc_h, sw_vc_h, SWA_DIM ** -0.5, swa_sink)) @ w_swa_o
    ctx_new = ctx + mod_c[2] * _gated_merge(glc, yc_na, yc_mla, yc_swa, w_o)
    hc2 = _rmsnorm(ctx_new, norm2_g) * (1 + mod_c[4]) + mod_c[3]
    ctx_new = ctx_new + mod_c[5] * _ec_moe(hc2, router, w_gate, w_up, w_down)
    return x_new, ctx_new


def setup_inputs(seed: int = 0) -> dict:
    key = jax.random.key(seed)
    ks = jax.random.split(key, 32)
    L, D = DEPTH, D_MODEL

    def nrm(k, shape, scale):
        return jax.random.normal(k, shape, jnp.float32) * scale

    def gain(k, shape):
        return 1.0 + 0.1 * jax.random.normal(k, shape, jnp.float32)

    return {
        'x': nrm(ks[0], (BATCH, SEQ, D), 1.0),
        'c': nrm(ks[1], (BATCH, D), 1.0),
        'ctx': nrm(ks[2], (BATCH, CTX_LEN, D), 1.0),
        'c_ctx': nrm(ks[3], (D,), 1.0),
        'norm1_g': gain(ks[4], (L, D)),
        'norm2_g': gain(ks[5], (L, D)),
        'w_ada': nrm(ks[6], (L, D, 6 * D), 0.5 * D ** -0.5),
        'b_ada': nrm(ks[7], (L, 6 * D), 0.01),
        'w_in': nrm(ks[8], (L, D, D_IN), D ** -0.5),
        'na_q_g': gain(ks[9], (L, NA_DIM)),
        'na_k_g': gain(ks[10], (L, NA_DIM)),
        'na_rpb': nrm(ks[11], (L, NA_HEADS, 2 * NA_WIN_ROWS - 1, 2 * NA_WIN_COLS - 1), 0.5),
        'mla_q_norm': gain(ks[12], (L, MLA_Q_RANK)),
        'mla_w_uq': nrm(ks[13], (L, MLA_Q_RANK, MLA_HEADS * MLA_QK), MLA_Q_RANK ** -0.5),
        'mla_kv_norm': gain(ks[14], (L, MLA_KV_RANK)),
        'mla_w_ukv': nrm(ks[15], (L, MLA_KV_RANK, MLA_HEADS * (MLA_NOPE + MLA_V)), MLA_KV_RANK ** -0.5),
        'mla_q_g': gain(ks[16], (L, MLA_QK)),
        'mla_k_g': gain(ks[17], (L, MLA_QK)),
        'swa_q_g': gain(ks[18], (L, SWA_DIM)),
        'swa_k_g': gain(ks[19], (L, SWA_DIM)),
        'swa_sink': nrm(ks[20], (L, SWA_HEADS), 0.5),
        'w_na_o': nrm(ks[21], (L, NA_W, D), NA_W ** -0.5),
        'w_mla_o': nrm(ks[22], (L, MLA_W, D), MLA_W ** -0.5),
        'w_swa_o': nrm(ks[23], (L, SWA_W, D), SWA_W ** -0.5),
        'w_o': nrm(ks[24], (L, D, D), D ** -0.5),
        'router': nrm(ks[25], (L, D, N_EXPERTS), D ** -0.5),
        'w_gate': nrm(ks[26], (L, N_EXPERTS, D, EXPERT_FF), D ** -0.5),
        'w_up': nrm(ks[27], (L, N_EXPERTS, D, EXPERT_FF), D ** -0.5),
        'w_down': nrm(ks[28], (L, N_EXPERTS, EXPERT_FF, D), EXPERT_FF ** -0.5),
    }


def reference(x, c, ctx, c_ctx, norm1_g, norm2_g, w_ada, b_ada, w_in,
              na_q_g, na_k_g, na_rpb,
              mla_q_norm, mla_w_uq, mla_kv_norm, mla_w_ukv, mla_q_g, mla_k_g,
              swa_q_g, swa_k_g, swa_sink,
              w_na_o, w_mla_o, w_swa_o, w_o,
              router, w_gate, w_up, w_down):
    S = x.shape[1]
    t = jnp.arange(S)
    row = t // GRID_W
    col = t % GRID_W
    c_act = jax.nn.silu(c)
    cctx_act = jax.nn.silu(c_ctx)
    for l in range(DEPTH):
        x, ctx = _layer(x, ctx, c_act, cctx_act, row, col, l == DEPTH - 1,
                        norm1_g[l], norm2_g[l], w_ada[l], b_ada[l], w_in[l],
                        na_q_g[l], na_k_g[l], na_rpb[l],
                        mla_q_norm[l], mla_w_uq[l], mla_kv_norm[l], mla_w_ukv[l], mla_q_g[l], mla_k_g[l],
                        swa_q_g[l], swa_k_g[l], swa_sink[l],
                        w_na_o[l], w_mla_o[l], w_swa_o[l], w_o[l],
                        router[l], w_gate[l], w_up[l], w_down[l])
    return x
```

```cpp
#include <hip/hip_runtime.h>
#include <cstdio>
#include <cstdint>

#define DI __device__ __forceinline__
#ifndef PH_MASK
#define PH_MASK 0xFFFFF
#endif
#define PH(b) ((PH_MASK >> (b)) & 1)
#ifndef REP_MASK
#define REP_MASK 0
#endif
#define REPS(b) (1 + ((REP_MASK >> (b)) & 1))
#define LAS __attribute__((address_space(3)))
#define GAS __attribute__((address_space(1)))
typedef unsigned short bf16_t;
typedef short bf16x8 __attribute__((ext_vector_type(8)));
typedef short s16x4 __attribute__((ext_vector_type(4)));
typedef float f32x4 __attribute__((ext_vector_type(4)));
typedef float f32x2 __attribute__((ext_vector_type(2)));
typedef float f32x16 __attribute__((ext_vector_type(16)));
typedef unsigned u32x4 __attribute__((ext_vector_type(4)));
typedef unsigned u32x2 __attribute__((ext_vector_type(2)));
typedef int i32x8 __attribute__((ext_vector_type(8)));

constexpr int D = 1024, NB = 8, SEQ = 4096, NL = 4, CTX = 256;
constexpr int MLAT = NB * SEQ, MCTX = NB * CTX, MT = MLAT + MCTX;
constexpr int DIN = 5312, DINP = 2304, NGL = 3072;
constexpr int C_NAQ = 0, C_NAK = 384, C_NAV = 768, C_CQ = 1152, C_CKV = 1408, C_KR = 1536, C_SWQ = 1600, C_SWK = 1984, C_SWV = 2112, C_GL = 2240;
constexpr int UW = 1792;
constexpr int P1W = 1280;
constexpr int P2W = 1536;
constexpr int OCW = 1280;
constexpr int NE = 16, CAP_LAT = 512, CAP_CTX = 32;
constexpr int NSLOT_LAT = NB * NE * CAP_LAT, NSLOT = NSLOT_LAT + NB * NE * CAP_CTX;
constexpr float EPS = 1e-6f;
constexpr float LOG2E = 1.4426950408889634f;

constexpr size_t MiB = 1u << 20;
constexpr size_t WS_CTL = 0, CTL_BYTES = 1 * MiB;
constexpr size_t WS_MODV = 1 * MiB;
constexpr size_t WS_W = 2 * MiB;
constexpr size_t W_IN = 0, W_GL = 4718592  , W_UP = 11010048, W_NAO = 7864320  , W_MLAO = 13172736, W_SWAO = 8912896  , W_O = 15007744, W_GU = 17104896, W_DN = 84213760, W_END = 117768192;
constexpr size_t WS_XS = 115 * MiB;
constexpr size_t WS_HW = 251 * MiB;
constexpr size_t WS_G = WS_HW + 153 * MiB;
constexpr size_t WS_P1 = 608 * MiB;
constexpr size_t WS_P2 = 693 * MiB;
constexpr size_t WS_R4 = 795 * MiB;
constexpr size_t WS_AFL = 914 * MiB;
constexpr size_t WS_AFC = 916 * MiB;
constexpr size_t WS_SMAP = 917 * MiB;
constexpr size_t WS_GATE = 920 * MiB;
constexpr size_t WS_OCAT = 921 * MiB;
constexpr size_t WS_END = 1006 * MiB;
constexpr size_t WS_MERGED = WS_P1;
constexpr size_t WS_H2 = WS_HW;
constexpr size_t WS_XG = WS_HW + 68 * MiB;
constexpr size_t WS_ACT = WS_HW + 204 * MiB;
constexpr size_t WS_Y = WS_HW + 340 * MiB;
static_assert(W_END <= 113 * MiB && WS_W + 113 * MiB <= WS_XS, "weights");
static_assert(WS_XS + (size_t)MT * D * 4 <= WS_HW && WS_HW + (size_t)MT * DINP * 2 <= WS_G && WS_G + (size_t)MT * NGL * 2 <= WS_P1 && WS_P1 + (size_t)MT * P1W * 2 <= WS_P2 && WS_P2 + (size_t)MT * P2W * 2 <= WS_R4, "map");
static_assert(WS_R4 + (size_t)MT * UW * 2 <= WS_AFL && WS_Y + (size_t)NSLOT * D * 2 <= WS_R4 && WS_SMAP + (size_t)16 * MT * 4 <= WS_GATE && WS_GATE + (size_t)NSLOT * 4 <= WS_OCAT && WS_OCAT + (size_t)MT * OCW * 2 <= WS_END, "map2");
constexpr int CW_BAR = 4096;

constexpr int RING_BYTES = 131072, LDSCTL_OFF = RING_BYTES, LDS_BYTES = 147456;

DI unsigned pk2(float lo, float hi) { unsigned r; asm("v_cvt_pk_bf16_f32 %0, %1, %2" : "=v"(r) : "v"(lo), "v"(hi)); return r; }
DI unsigned pk4_fp8(float a, float b, float c, float d) { int w = 0; w = __builtin_amdgcn_cvt_pk_fp8_f32(a, b, w, false); w = __builtin_amdgcn_cvt_pk_fp8_f32(c, d, w, true); return (unsigned)w; }
DI float bflo(unsigned w) { return __uint_as_float(w << 16); }
DI float bfhi(unsigned w) { return __uint_as_float(w & 0xffff0000u); }
DI float bf2f(bf16_t b) { return __uint_as_float((unsigned)b << 16); }
DI float wave_sum(float v) {
#pragma unroll
    for (int o = 1; o < 64; o <<= 1) v += __shfl_xor(v, o);
    return v;
}
DI float sigmoidf_(float x) { return __builtin_amdgcn_rcpf(1.0f + __builtin_amdgcn_exp2f(-x * LOG2E)); }
DI int mod_index(int row) { return row < MLAT ? (row >> 12) : 8; }

#define XB_TMO      128
#define XB_XCNT(j)  (256  + 64 * (j))
#define XB_XSUB(j)  (1280 + 64 * (j))
#define XB_XGEN(j)  (2304 + 64 * (j))
#define XB_TOP      3328
#define XB_TOPGEN   3392
#define XCD_BAR_WORDS 3456
#define XB_SPIN_CAP (1u << 18)
DI unsigned xb_ld(unsigned* p)              { return __hip_atomic_load(p, __ATOMIC_RELAXED, __HIP_MEMORY_SCOPE_AGENT); }
DI unsigned xb_add(unsigned* p, unsigned v) { return __hip_atomic_fetch_add(p, v, __ATOMIC_RELAXED, __HIP_MEMORY_SCOPE_AGENT); }
DI unsigned xb_xcc_id() { return (unsigned)__builtin_amdgcn_s_getreg((3 << 11) | 20) & 0xFu; }
#define XB_SPIN(cond, bar) do { unsigned _sp = 0; while (cond) { __builtin_amdgcn_s_sleep(1); \
    if ((++_sp & 255u) == 0u) { if (xb_ld(&(bar)[XB_TMO])) break; if (_sp > XB_SPIN_CAP) { atomicAdd(&(bar)[XB_TMO], 1u); break; } } } } while (0)
struct XcdBarrier { unsigned* bar; unsigned x; volatile LAS unsigned* st; };
DI XcdBarrier xcd_barrier_post(unsigned* bar, volatile LAS unsigned* st) {
    XcdBarrier b; b.bar = bar; b.x = xb_xcc_id(); b.st = st;
    if (threadIdx.x == 0) (void)xb_add(&bar[XB_XCNT(b.x)], 1u);
    return b;
}
DI void xcd_barrier_complete(unsigned* bar, unsigned x, unsigned& nloc, unsigned& nx) {
    const unsigned G = gridDim.x * gridDim.y * gridDim.z;
    unsigned sum, cnt, mine, sp = 0u;
    for (;;) {
        sum = 0u; cnt = 0u; mine = 0u;
#pragma unroll
        for (unsigned j = 0; j < 16; ++j) { const unsigned c = xb_ld(&bar[XB_XCNT(j)]); sum += c; cnt += (c > 0u) ? 1u : 0u; mine = (j == x) ? c : mine; }
        if (sum == G) break;
        __builtin_amdgcn_s_sleep(1);
        if ((++sp & 255u) == 0u) { if (xb_ld(&bar[XB_TMO])) break; if (sp > XB_SPIN_CAP) { atomicAdd(&bar[XB_TMO], 1u); break; } }
    }
    nloc = mine > 0u ? mine : 1u; nx = cnt > 0u ? cnt : 1u;
}
DI void xcd_barrier(const XcdBarrier& b) {
    asm volatile("s_waitcnt vmcnt(0)" ::: "memory");
    __syncthreads();
    if (threadIdx.x == 0) {
        unsigned* bar = b.bar; asm volatile("" : "+s"(bar));
        __builtin_amdgcn_s_waitcnt(0);
        unsigned nloc = b.st[0], nx = b.st[1];
        if (nloc == 0u) { xcd_barrier_complete(bar, b.x, nloc, nx); b.st[0] = nloc; b.st[1] = nx; }
        const unsigned old = xb_add(&bar[XB_XSUB(b.x)], 1u);
        const unsigned gen = old / nloc;
        if (old + 1u == (gen + 1u) * nloc) {
            __builtin_amdgcn_fence(__ATOMIC_RELEASE, "agent");
            asm volatile("s_waitcnt vmcnt(0)" ::: "memory");
            const unsigned og = xb_add(&bar[XB_TOP], 1u);
            const unsigned tg = og / nx;
            if (og + 1u == (tg + 1u) * nx) xb_add(&bar[XB_TOPGEN], 1u);
            else XB_SPIN(xb_ld(&bar[XB_TOPGEN]) == tg, bar);
            __builtin_amdgcn_fence(__ATOMIC_ACQUIRE, "agent");
            xb_add(&bar[XB_XGEN(b.x)], 1u);
            asm volatile("s_waitcnt vmcnt(0)" ::: "memory");
        } else {
            XB_SPIN(xb_ld(&bar[XB_XGEN(b.x)]) == gen, bar);
            __builtin_amdgcn_fence(__ATOMIC_ACQUIRE, "agent");
            asm volatile("s_waitcnt vmcnt(0)" ::: "memory");
        }
    }
    __syncthreads();
}

namespace pg8 {
constexpr int BM = 256, BK = 64, HALF = 128, HTB = HALF * BK * 2, NXCD = 8, WGM = 8;
__host__ __device__ __forceinline__ int lds_byte(int r, int c) { const int st = (r >> 4) * 2 + (c >> 5), rr = r & 15, cc = c & 31, ob = rr * 64 + cc * 2; return st * 1024 + (ob ^ (((ob >> 9) & 1) << 5)); }
__host__ __device__ __forceinline__ void stage_rc(int b, int& R, int& C) { const int st = b / 1024, sb = b % 1024, swz = sb ^ (((sb >> 9) & 1) << 5); R = (st >> 1) * 16 + swz / 64; C = (st & 1) * 32 + (swz % 64) / 2; }
__host__ __device__ __forceinline__ int perm32(int rho) { const int n = rho >> 4, i = rho & 15; return 8 * (i >> 2) + 4 * n + (i & 3); }
struct Unit { int pm, pn; };
struct Gemm { const bf16_t* A; const bf16_t* Bt; int K, lda, ldb; size_t estride; };
struct Order {
    int nM, nN, nwg, G, c, moe;
    DI void init(int nM_, int nN_, int G_, int c_, int moe_ = 0) { nM = nM_; nN = nN_; nwg = nM * nN; G = G_; c = c_; moe = moe_; }
    DI bool next(int i, Unit& u) const {
        const long L = (long)i * G + c; if (L >= nwg) return false;
        int wgid = (int)L; { const int q = nwg / NXCD, r = nwg % NXCD, xcd = wgid % NXCD, off = wgid / NXCD; wgid = (xcd < r ? xcd * (q + 1) : r * (q + 1) + (xcd - r) * q) + off; }
        const int nig = WGM * nN, gid = wgid / nig, fm = gid * WGM, gsz = (nM - fm) < WGM ? (nM - fm) : WGM;
        u.pm = fm + ((wgid % nig) % gsz); u.pn = (wgid % nig) / gsz;
        if (moe && u.pm < 256) { const int e = u.pm >> 4, b = (u.pm >> 1) & 7, hf = u.pm & 1; u.pm = (((b << 4) | e) << 1) | hf; }
        return true;
    }
};
struct EpiStoreBf16 {
    static constexpr bool PERM = true;
    bf16_t* O; int ldc;
    DI void operator()(const f32x4 (&acc)[2][2][4][2], const Unit& u, int wr, int wc, int fr, int fq) const {
        const int row0 = u.pm * BM + wr * 64 + fr, col0 = u.pn * BM + wc * 32 + 8 * fq;
#pragma unroll
        for (int ai = 0; ai < 2; ++ai)
#pragma unroll
            for (int m = 0; m < 4; ++m) { bf16_t* rowp = O + (size_t)(row0 + ai * HALF + m * 16) * ldc + col0;
#pragma unroll
                for (int bj = 0; bj < 2; ++bj) { const f32x4 v0 = acc[ai][bj][m][0], v1 = acc[ai][bj][m][1];
                    u32x4 w; w.x = pk2(v0[0], v0[1]); w.y = pk2(v0[2], v0[3]); w.z = pk2(v1[0], v1[1]); w.w = pk2(v1[2], v1[3]);
                    *(u32x4*)(rowp + bj * HALF) = w; } }
    }
};
DI unsigned pk4_u8(float a, float b, float c, float d) {
    unsigned ua = (unsigned)(a * 255.0f + 0.5f), ub = (unsigned)(b * 255.0f + 0.5f), uc = (unsigned)(c * 255.0f + 0.5f), ud = (unsigned)(d * 255.0f + 0.5f);
    ua = ua < 1u ? 1u : ua; ub = ub < 1u ? 1u : ub; uc = uc < 1u ? 1u : uc; ud = ud < 1u ? 1u : ud;
    return ua | (ub << 8) | (uc << 16) | (ud << 24);
}
struct EpiGate {
    static constexpr bool PERM = true;
    unsigned char* O;
    DI void operator()(const f32x4 (&acc)[2][2][4][2], const Unit& u, int wr, int wc, int fr, int fq) const {
        const int row0 = u.pm * BM + wr * 64 + fr, col0 = u.pn * BM + wc * 32 + 8 * fq;
#pragma unroll
        for (int ai = 0; ai < 2; ++ai)
#pragma unroll
            for (int m = 0; m < 4; ++m) { unsigned char* rowp = O + (size_t)(row0 + ai * HALF + m * 16) * NGL + col0;
#pragma unroll
                for (int bj = 0; bj < 2; ++bj) { const f32x4 v0 = acc[ai][bj][m][0] * 0.03125f, v1 = acc[ai][bj][m][1] * 0.03125f;
                    u32x2 w; w.x = pk4_u8(sigmoidf_(v0[0]), sigmoidf_(v0[1]), sigmoidf_(v0[2]), sigmoidf_(v0[3])); w.y = pk4_u8(sigmoidf_(v1[0]), sigmoidf_(v1[1]), sigmoidf_(v1[2]), sigmoidf_(v1[3]));
                    *(u32x2*)(rowp + bj * HALF) = w; } }
    }
};
DI float u8f(unsigned w, int k) { return (float)((w >> (8 * k)) & 0xffu) * (1.0f / 255.0f); }
struct EpiMerge {
    static constexpr bool PERM = true;
    bf16_t* O; const unsigned char* gl; int first;
    DI void operator()(const f32x4 (&acc)[2][2][4][2], const Unit& u, int wr, int wc, int fr, int fq) const {
        const int row0 = u.pm * BM + wr * 64 + fr, col0 = u.pn * BM + wc * 32 + 8 * fq;
#pragma unroll
        for (int ai = 0; ai < 2; ++ai) {
            u32x2 g[4][2]; u32x4 p[4][2];
#pragma unroll
            for (int m = 0; m < 4; ++m)
#pragma unroll
                for (int bj = 0; bj < 2; ++bj) { const int row = row0 + ai * HALF + m * 16, col = col0 + bj * HALF;
                    g[m][bj] = *(const u32x2*)(gl + (size_t)row * NGL + col);
                    p[m][bj] = first ? (u32x4){0u, 0u, 0u, 0u} : *(const u32x4*)(O + (size_t)row * D + col); }
#pragma unroll
            for (int m = 0; m < 4; ++m)
#pragma unroll
                for (int bj = 0; bj < 2; ++bj) { const int row = row0 + ai * HALF + m * 16, col = col0 + bj * HALF;
                    const u32x2 gg = g[m][bj]; const u32x4 pp = p[m][bj]; const f32x4 v0 = acc[ai][bj][m][0], v1 = acc[ai][bj][m][1];
                    const float r0 = v0[0] * u8f(gg.x, 0) + bflo(pp.x), r1 = v0[1] * u8f(gg.x, 1) + bfhi(pp.x), r2 = v0[2] * u8f(gg.x, 2) + bflo(pp.y), r3 = v0[3] * u8f(gg.x, 3) + bfhi(pp.y);
                    const float r4 = v1[0] * u8f(gg.y, 0) + bflo(pp.z), r5 = v1[1] * u8f(gg.y, 1) + bfhi(pp.z), r6 = v1[2] * u8f(gg.y, 2) + bflo(pp.w), r7 = v1[3] * u8f(gg.y, 3) + bfhi(pp.w);
                    u32x4 w; w.x = pk2(r0, r1); w.y = pk2(r2, r3); w.z = pk2(r4, r5); w.w = pk2(r6, r7);
                    *(u32x4*)(O + (size_t)row * D + col) = w; }
        }
    }
};
struct EpiResid {
    static constexpr bool PERM = true;
    bf16_t* xs; const float* modg;
    DI void operator()(const f32x4 (&acc)[2][2][4][2], const Unit& u, int wr, int wc, int fr, int fq) const {
        const int row0 = u.pm * BM + wr * 64 + fr, col0 = u.pn * BM + wc * 32 + 8 * fq;
        const float* mp = modg + (size_t)mod_index(u.pm * BM) * 6144 + col0;
        f32x4 g0[2], g1[2];
#pragma unroll
        for (int bj = 0; bj < 2; ++bj) { g0[bj] = *(const f32x4*)(mp + bj * HALF); g1[bj] = *(const f32x4*)(mp + bj * HALF + 4); }
#pragma unroll
        for (int ai = 0; ai < 2; ++ai) {
            u32x4 xw[4][2];
#pragma unroll
            for (int m = 0; m < 4; ++m)
#pragma unroll
                for (int bj = 0; bj < 2; ++bj) xw[m][bj] = *(const u32x4*)(xs + (size_t)(row0 + ai * HALF + m * 16) * D + col0 + bj * HALF);
#pragma unroll
            for (int m = 0; m < 4; ++m)
#pragma unroll
                for (int bj = 0; bj < 2; ++bj) { const u32x4 x = xw[m][bj];
                    const f32x4 x0 = (f32x4){bflo(x.x), bfhi(x.x), bflo(x.y), bfhi(x.y)} + g0[bj] * acc[ai][bj][m][0];
                    const f32x4 x1 = (f32x4){bflo(x.z), bfhi(x.z), bflo(x.w), bfhi(x.w)} + g1[bj] * acc[ai][bj][m][1];
                    u32x4 w; w.x = pk2(x0[0], x0[1]); w.y = pk2(x0[2], x0[3]); w.z = pk2(x1[0], x1[1]); w.w = pk2(x1[2], x1[3]);
                    *(u32x4*)(xs + (size_t)(row0 + ai * HALF + m * 16) * D + col0 + bj * HALF) = w; }
        }
    }
};
struct EpiSwiglu {
    static constexpr bool PERM = true;
    unsigned char* O;
    DI void operator()(const f32x4 (&acc)[2][2][4][2], const Unit& u, int wr, int wc, int fr, int fq) const {
        const int row0 = u.pm * BM + wr * 64 + fr, col0 = u.pn * HALF + wc * 32 + 8 * fq;
#pragma unroll
        for (int ai = 0; ai < 2; ++ai)
#pragma unroll
            for (int m = 0; m < 4; ++m) { const int row = row0 + ai * HALF + m * 16;
                const f32x4 a0 = acc[ai][0][m][0] * 0.03125f, a1 = acc[ai][0][m][1] * 0.03125f, u0 = acc[ai][1][m][0] * 0.25f, u1 = acc[ai][1][m][1] * 0.25f;
                float r[8];
#pragma unroll
                for (int j = 0; j < 4; ++j) { r[j] = a0[j] * sigmoidf_(a0[j]) * u0[j]; r[4 + j] = a1[j] * sigmoidf_(a1[j]) * u1[j]; }
                u32x2 w; w.x = pk4_fp8(r[0], r[1], r[2], r[3]); w.y = pk4_fp8(r[4], r[5], r[6], r[7]);
                *(u32x2*)(O + (size_t)row * D + col0) = w; }
    }
};
struct EpiDown {
    static constexpr bool PERM = true;
    bf16_t* O; const float* gate;
    DI void operator()(const f32x4 (&acc)[2][2][4][2], const Unit& u, int wr, int wc, int fr, int fq) const {
        const int row0 = u.pm * BM + wr * 64 + fr, col0 = u.pn * BM + wc * 32 + 8 * fq;
        float gv[2][4];
#pragma unroll
        for (int ai = 0; ai < 2; ++ai)
#pragma unroll
            for (int m = 0; m < 4; ++m) gv[ai][m] = gate[row0 + ai * HALF + m * 16] * (1.0f / 256.0f);
#pragma unroll
        for (int ai = 0; ai < 2; ++ai)
#pragma unroll
            for (int m = 0; m < 4; ++m) { const int row = row0 + ai * HALF + m * 16; const float g = gv[ai][m]; bf16_t* rowp = O + (size_t)row * D + col0;
#pragma unroll
                for (int bj = 0; bj < 2; ++bj) { const f32x4 v0 = acc[ai][bj][m][0] * g, v1 = acc[ai][bj][m][1] * g;
                    u32x4 w; w.x = pk2(v0[0], v0[1]); w.y = pk2(v0[2], v0[3]); w.z = pk2(v1[0], v1[1]); w.w = pk2(v1[2], v1[3]);
                    *(u32x4*)(rowp + bj * HALF) = w; } }
    }
};

struct EpiMerge3 {
    static constexpr bool PERM = true;
    bf16_t* O; const unsigned char* gl;
    DI void operator()(f32x4 (&acc)[2][2][4][2], const Unit& u, int seg, int wr, int wc, int fr, int fq) const {
        const int row0 = u.pm * BM + wr * 64 + fr, col0 = u.pn * BM + wc * 32 + 8 * fq;
#pragma unroll
        for (int ai = 0; ai < 2; ++ai) {
            u32x2 ga[4][2], gb[4][2];
#pragma unroll
            for (int m = 0; m < 4; ++m)
#pragma unroll
                for (int bj = 0; bj < 2; ++bj) { const unsigned char* gp = gl + (size_t)(row0 + ai * HALF + m * 16) * NGL + 1024 * seg + col0 + bj * HALF;
                    ga[m][bj] = *(const u32x2*)gp; gb[m][bj] = seg < 2 ? *(const u32x2*)(gp + 1024) : (u32x2){0u, 0u}; }
#pragma unroll
            for (int m = 0; m < 4; ++m)
#pragma unroll
                for (int bj = 0; bj < 2; ++bj) {
                    f32x4 s0, s1;
#pragma unroll
                    for (int k = 0; k < 4; ++k) { const float a0 = (float)((ga[m][bj].x >> (8 * k)) & 0xffu), a1 = (float)((ga[m][bj].y >> (8 * k)) & 0xffu);
                        if (seg < 2) { const float b0 = (float)((gb[m][bj].x >> (8 * k)) & 0xffu), b1 = (float)((gb[m][bj].y >> (8 * k)) & 0xffu); s0[k] = a0 * __builtin_amdgcn_rcpf(b0); s1[k] = a1 * __builtin_amdgcn_rcpf(b1); }
                        else { s0[k] = a0 * (1.0f / 255.0f); s1[k] = a1 * (1.0f / 255.0f); } }
                    acc[ai][bj][m][0] *= s0; acc[ai][bj][m][1] *= s1;
                    if (seg == 2) { const f32x4 v0 = acc[ai][bj][m][0], v1 = acc[ai][bj][m][1];
                        u32x4 w; w.x = pk2(v0[0], v0[1]); w.y = pk2(v0[2], v0[3]); w.z = pk2(v1[0], v1[1]); w.w = pk2(v1[2], v1[3]);
                        *(u32x4*)(O + (size_t)(row0 + ai * HALF + m * 16) * D + col0 + bj * HALF) = w; }
                }
        }
    }
};
struct Gemm3 { const bf16_t* A0; const bf16_t* A1; const bf16_t* A2; const bf16_t* B0; const bf16_t* B1; const bf16_t* B2; int lda, ldb; };
template <class Epi>
DI void gemm_phase3(LAS unsigned char* lds, const Gemm3 g, const Order& S, const Epi& E) {
    int tid_ = threadIdx.x; asm volatile("" : "+v"(tid_));
    const int tid = tid_, wid = __builtin_amdgcn_readfirstlane(tid >> 6), lane = tid & 63, wr = wid >> 2, wc = wid & 3, fr = lane & 15, fq = lane >> 4;
    unsigned voffA[2], voffB[2];
#pragma unroll
    for (int i = 0; i < 2; ++i) { int R, C; stage_rc(tid * 16 + i * 8192, R, C); const int Rb = Epi::PERM ? ((R & ~31) + perm32(R & 31)) : R;
        voffA[i] = (unsigned)(R * g.lda * 2 + C * 2); voffB[i] = (unsigned)(Rb * g.ldb * 2 + C * 2); }
    const size_t kstep = (size_t)(BK * 2);
    const size_t hstepA = (size_t)HALF * g.lda * 2, hstepB = (size_t)HALF * g.ldb * 2;
    const size_t tstepA = 2 * hstepA, tstepB = 2 * hstepB;
    const unsigned ldsw = (unsigned)wid * 1024u;
    const int aoff = lds_byte(wr * 64 + fr, fq * 8), boff = lds_byte(wc * 32 + fr, fq * 8);
#define PG8_SA(b, h) (((b) * 2 + (h)) * HTB)
#define PG8_SB(b, h) ((4 + (b) * 2 + (h)) * HTB)
#define PG8_STAGE(bufoff, gbase, voff) do { _Pragma("unroll") for (int _i = 0; _i < 2; ++_i) \
        __builtin_amdgcn_global_load_lds((const unsigned*)((const char*)(gbase) + (voff)[_i]), (LAS unsigned*)(lds + (bufoff) + ldsw + _i * 8192), 16, 0, 0); } while (0)
#define PG8_LDA(dst, b, h) do { _Pragma("unroll") for (int m = 0; m < 4; ++m) _Pragma("unroll") for (int k = 0; k < 2; ++k) dst[m][k] = *(const LAS bf16x8*)(lds + PG8_SA(b, h) + aoff + m * 2048 + k * 1024); } while (0)
#define PG8_LDB(dst, b, h) do { _Pragma("unroll") for (int n = 0; n < 2; ++n) _Pragma("unroll") for (int k = 0; k < 2; ++k) dst[n][k] = *(const LAS bf16x8*)(lds + PG8_SB(b, h) + boff + n * 2048 + k * 1024); } while (0)
#define PG8_MMA(ai, bj, At, Bt) do { __builtin_amdgcn_s_setprio(1); _Pragma("unroll") for (int m = 0; m < 4; ++m) _Pragma("unroll") for (int n = 0; n < 2; ++n) _Pragma("unroll") for (int k = 0; k < 2; ++k) \
        acc[ai][bj][m][n] = __builtin_amdgcn_mfma_f32_16x16x32_bf16(Bt[n][k], At[m][k], acc[ai][bj][m][n], 0, 0, 0); __builtin_amdgcn_s_setprio(0); } while (0)
#define PG8_WAIT_V(n) asm volatile("s_waitcnt vmcnt(" #n ")" ::: "memory")
#define PG8_WAIT_L(n) asm volatile("s_waitcnt lgkmcnt(" #n ")" ::: "memory")
#define PG8_BAR __builtin_amdgcn_s_barrier()
#define PG8_SCHED __builtin_amdgcn_sched_barrier(0)
#define PG8_A3(sg, u) ((const char*)((sg) == 0 ? g.A0 : (sg) == 1 ? g.A1 : g.A2) + (size_t)(u).pm * tstepA)
#define PG8_B3(sg, u) ((const char*)((sg) == 0 ? g.B0 : (sg) == 1 ? g.B1 : g.B2) + (size_t)(u).pn * tstepB)
    Unit cur, nu; int ui = 0, seg = 0;
    if (!S.next(0, cur)) return;
    f32x4 acc[2][2][4][2];
#pragma unroll
    for (int a = 0; a < 2; ++a)
#pragma unroll
        for (int b = 0; b < 2; ++b)
#pragma unroll
            for (int m = 0; m < 4; ++m)
#pragma unroll
                for (int n = 0; n < 2; ++n) acc[a][b][m][n] = (f32x4){0.f, 0.f, 0.f, 0.f};
    bf16x8 At[4][2], B0[2][2], B1[2][2];
    const char* cA = PG8_A3(0, cur); const char* cB = PG8_B3(0, cur);
    PG8_STAGE(PG8_SB(0, 0), cB, voffB); PG8_STAGE(PG8_SB(0, 1), cB + hstepB, voffB); PG8_STAGE(PG8_SA(0, 0), cA, voffA); PG8_STAGE(PG8_SA(0, 1), cA + hstepA, voffA);
    if (wr == 1) PG8_BAR;
    PG8_WAIT_V(2); PG8_BAR;
    PG8_STAGE(PG8_SB(1, 0), cB + kstep, voffB); PG8_STAGE(PG8_SA(1, 0), cA + kstep, voffA); PG8_STAGE(PG8_SB(1, 1), cB + hstepB + kstep, voffB);
    PG8_WAIT_V(6); PG8_BAR;
    for (;;) {
        int nseg = seg + 1; bool has_next = true; nu = cur;
        if (nseg == 3) { nseg = 0; has_next = S.next(ui + 1, nu); }
        const char* nA = has_next ? PG8_A3(nseg, nu) : cA; const char* nB = has_next ? PG8_B3(nseg, nu) : cB;
        int nt_ = (seg == 1) ? 8 : 6; asm volatile("" : "+s"(nt_));
        const int nt = nt_;
#pragma nounroll
        for (int t = 0; t < nt; t += 2) {
            const bool last = (t == nt - 2);
            const char* a1 = cA + (size_t)(t + 1) * kstep;
            const char* a2 = last ? nA : cA + (size_t)(t + 2) * kstep; const char* b2 = last ? nB : cB + (size_t)(t + 2) * kstep;
            const char* a3 = a2 + kstep; const char* b3 = b2 + kstep;
            PG8_LDB(B0, 0, 0); PG8_LDB(B1, 0, 1); PG8_SCHED; PG8_LDA(At, 0, 0); PG8_STAGE(PG8_SA(1, 1), a1 + hstepA, voffA);
            PG8_WAIT_V(8); PG8_WAIT_L(0); PG8_BAR; PG8_MMA(0, 0, At, B0); PG8_MMA(0, 1, At, B1); PG8_BAR; PG8_SCHED;
            PG8_LDA(At, 0, 1); PG8_STAGE(PG8_SB(0, 0), b2, voffB); PG8_STAGE(PG8_SB(0, 1), b2 + hstepB, voffB); PG8_STAGE(PG8_SA(0, 0), a2, voffA);
            PG8_WAIT_V(8); PG8_WAIT_L(0); PG8_BAR; PG8_MMA(1, 0, At, B0); PG8_MMA(1, 1, At, B1); PG8_BAR; PG8_SCHED;
            PG8_LDB(B0, 1, 0); PG8_LDB(B1, 1, 1); PG8_SCHED; PG8_LDA(At, 1, 0); PG8_STAGE(PG8_SA(0, 1), a2 + hstepA, voffA);
            PG8_WAIT_V(8); PG8_WAIT_L(0); PG8_BAR; PG8_MMA(0, 0, At, B0); PG8_MMA(0, 1, At, B1); PG8_BAR; PG8_SCHED;
            PG8_LDA(At, 1, 1); PG8_STAGE(PG8_SB(1, 0), b3, voffB); PG8_STAGE(PG8_SB(1, 1), b3 + hstepB, voffB); PG8_STAGE(PG8_SA(1, 0), a3, voffA);
            PG8_WAIT_V(8); PG8_WAIT_L(0); PG8_BAR; PG8_MMA(1, 0, At, B0); PG8_MMA(1, 1, At, B1); PG8_BAR; PG8_SCHED;
        }
        if (wr == 0) PG8_BAR;
        E(acc, cur, seg, wr, wc, fr, fq);
        if (!has_next) break;
        if (seg == 2) {
#pragma unroll
            for (int a = 0; a < 2; ++a)
#pragma unroll
                for (int b = 0; b < 2; ++b)
#pragma unroll
                    for (int m = 0; m < 4; ++m)
#pragma unroll
                        for (int n = 0; n < 2; ++n) acc[a][b][m][n] = (f32x4){0.f, 0.f, 0.f, 0.f};
            cur = nu; ++ui;
        }
        seg = nseg; cA = nA; cB = nB;
        if (wr == 1) PG8_BAR;
    }
    PG8_WAIT_V(0);
    PG8_BAR;
#undef PG8_SA
#undef PG8_SB
#undef PG8_STAGE
#undef PG8_LDA
#undef PG8_LDB
#undef PG8_MMA
#undef PG8_WAIT_V
#undef PG8_WAIT_L
#undef PG8_BAR
#undef PG8_SCHED
#undef PG8_A3
#undef PG8_B3
}

template <class Epi, bool FP8 = false>
DI void gemm_phase(LAS unsigned char* lds, const Gemm g, const Order& S, const Epi& E) {
    constexpr int ESZ = FP8 ? 1 : 2;
    int tid_ = threadIdx.x; asm volatile("" : "+v"(tid_));
    const int tid = tid_, wid = __builtin_amdgcn_readfirstlane(tid >> 6), lane = tid & 63, wr = wid >> 2, wc = wid & 3, fr = lane & 15, fq = lane >> 4;
    const int K = g.K, nt = K * ESZ / (BK * 2);
    unsigned voffA[2], voffB[2];
#pragma unroll
    for (int i = 0; i < 2; ++i) { int R, C; stage_rc(tid * 16 + i * 8192, R, C); const int Rb = Epi::PERM ? ((R & ~31) + perm32(R & 31)) : R;
        voffA[i] = (unsigned)(R * g.lda * ESZ + C * 2); voffB[i] = (unsigned)(Rb * g.ldb * ESZ + C * 2); }
    const size_t kstep = (size_t)(BK * 2);
    const size_t hstepA = (size_t)HALF * g.lda * ESZ, hstepB = (size_t)HALF * g.ldb * ESZ;
    const size_t tstepA = 2 * hstepA, tstepB = 2 * hstepB;
    const unsigned ldsw = (unsigned)wid * 1024u;
    const int aoff = lds_byte(wr * 64 + fr, fq * 8), boff = lds_byte(wc * 32 + fr, fq * 8);
#define PG8_SA(b, h) (((b) * 2 + (h)) * HTB)
#define PG8_SB(b, h) ((4 + (b) * 2 + (h)) * HTB)
#define PG8_STAGE(bufoff, gbase, voff) do { _Pragma("unroll") for (int _i = 0; _i < 2; ++_i) \
        __builtin_amdgcn_global_load_lds((const unsigned*)((const char*)(gbase) + (voff)[_i]), (LAS unsigned*)(lds + (bufoff) + ldsw + _i * 8192), 16, 0, 0); } while (0)
#define PG8_LDA(dst, b, h) do { _Pragma("unroll") for (int m = 0; m < 4; ++m) _Pragma("unroll") for (int k = 0; k < 2; ++k) dst[m][k] = *(const LAS bf16x8*)(lds + PG8_SA(b, h) + aoff + m * 2048 + k * 1024); } while (0)
#define PG8_LDB(dst, b, h) do { _Pragma("unroll") for (int n = 0; n < 2; ++n) _Pragma("unroll") for (int k = 0; k < 2; ++k) dst[n][k] = *(const LAS bf16x8*)(lds + PG8_SB(b, h) + boff + n * 2048 + k * 1024); } while (0)
#define PG8_MMA(ai, bj, At, Bt) do { __builtin_amdgcn_s_setprio(1); _Pragma("unroll") for (int m = 0; m < 4; ++m) _Pragma("unroll") for (int n = 0; n < 2; ++n) { \
        if constexpr (FP8) { const i32x8 bb_ = __builtin_bit_cast(i32x8, __builtin_shufflevector(Bt[n][0], Bt[n][1], 0, 1, 2, 3, 4, 5, 6, 7, 8, 9, 10, 11, 12, 13, 14, 15)); \
            const i32x8 aa_ = __builtin_bit_cast(i32x8, __builtin_shufflevector(At[m][0], At[m][1], 0, 1, 2, 3, 4, 5, 6, 7, 8, 9, 10, 11, 12, 13, 14, 15)); \
            asm volatile("v_mfma_scale_f32_16x16x128_f8f6f4 %0, %1, %2, %0, %3, %3 op_sel_hi:[0,0,0]" : "+v"(acc[ai][bj][m][n]) : "v"(bb_), "v"(aa_), "v"(0x7F7F7F7F)); } \
        else { _Pragma("unroll") for (int k = 0; k < 2; ++k) acc[ai][bj][m][n] = __builtin_amdgcn_mfma_f32_16x16x32_bf16(Bt[n][k], At[m][k], acc[ai][bj][m][n], 0, 0, 0); } } \
        __builtin_amdgcn_s_setprio(0); } while (0)
#define PG8_WAIT_V(n) asm volatile("s_waitcnt vmcnt(" #n ")" ::: "memory")
#define PG8_WAIT_L(n) asm volatile("s_waitcnt lgkmcnt(" #n ")" ::: "memory")
#define PG8_BAR __builtin_amdgcn_s_barrier()
#define PG8_SCHED __builtin_amdgcn_sched_barrier(0)
#define PG8_EXPERT(pm) ((pm) < 256 ? (((pm) >> 1) & 15) : ((pm) - 256))
#define PG8_ABASE(u) ((const char*)g.A + (size_t)(u).pm * tstepA)
#define PG8_BBASE(u) ((const char*)g.Bt + (size_t)PG8_EXPERT((u).pm) * g.estride * ESZ + (size_t)(u).pn * tstepB)
    Unit cur, nxt; int ui = 0;
    if (!S.next(0, cur)) return;
    f32x4 acc[2][2][4][2];
#pragma unroll
    for (int a = 0; a < 2; ++a)
#pragma unroll
        for (int b = 0; b < 2; ++b)
#pragma unroll
            for (int m = 0; m < 4; ++m)
#pragma unroll
                for (int n = 0; n < 2; ++n) acc[a][b][m][n] = (f32x4){0.f, 0.f, 0.f, 0.f};
    bf16x8 At[4][2], B0[2][2], B1[2][2];
    const char* cA = PG8_ABASE(cur); const char* cB = PG8_BBASE(cur);
    PG8_STAGE(PG8_SB(0, 0), cB, voffB); PG8_STAGE(PG8_SB(0, 1), cB + hstepB, voffB); PG8_STAGE(PG8_SA(0, 0), cA, voffA); PG8_STAGE(PG8_SA(0, 1), cA + hstepA, voffA);
    if (wr == 1) PG8_BAR;
    PG8_WAIT_V(2); PG8_BAR;
    PG8_STAGE(PG8_SB(1, 0), cB + kstep, voffB); PG8_STAGE(PG8_SA(1, 0), cA + kstep, voffA); PG8_STAGE(PG8_SB(1, 1), cB + hstepB + kstep, voffB);
    PG8_WAIT_V(6); PG8_BAR;
    for (;;) {
        const bool has_next = S.next(ui + 1, nxt);
        const char* nA = has_next ? PG8_ABASE(nxt) : cA; const char* nB = has_next ? PG8_BBASE(nxt) : cB;
#pragma nounroll
        for (int t = 0; t < nt; t += 2) {
            const bool last = (t == nt - 2);
            const char* a1 = cA + (size_t)(t + 1) * kstep;
            const char* a2 = last ? nA : cA + (size_t)(t + 2) * kstep; const char* b2 = last ? nB : cB + (size_t)(t + 2) * kstep;
            const char* a3 = a2 + kstep; const char* b3 = b2 + kstep;
            PG8_LDB(B0, 0, 0); PG8_LDB(B1, 0, 1); PG8_SCHED; PG8_LDA(At, 0, 0); PG8_STAGE(PG8_SA(1, 1), a1 + hstepA, voffA);
            PG8_WAIT_V(8); PG8_WAIT_L(0); PG8_BAR; PG8_MMA(0, 0, At, B0); PG8_MMA(0, 1, At, B1); PG8_BAR; PG8_SCHED;
            PG8_LDA(At, 0, 1); PG8_STAGE(PG8_SB(0, 0), b2, voffB); PG8_STAGE(PG8_SB(0, 1), b2 + hstepB, voffB); PG8_STAGE(PG8_SA(0, 0), a2, voffA);
            PG8_WAIT_V(8); PG8_WAIT_L(0); PG8_BAR; PG8_MMA(1, 0, At, B0); PG8_MMA(1, 1, At, B1); PG8_BAR; PG8_SCHED;
            PG8_LDB(B0, 1, 0); PG8_LDB(B1, 1, 1); PG8_SCHED; PG8_LDA(At, 1, 0); PG8_STAGE(PG8_SA(0, 1), a2 + hstepA, voffA);
            PG8_WAIT_V(8); PG8_WAIT_L(0); PG8_BAR; PG8_MMA(0, 0, At, B0); PG8_MMA(0, 1, At, B1); PG8_BAR; PG8_SCHED;
            PG8_LDA(At, 1, 1); PG8_STAGE(PG8_SB(1, 0), b3, voffB); PG8_STAGE(PG8_SB(1, 1), b3 + hstepB, voffB); PG8_STAGE(PG8_SA(1, 0), a3, voffA);
            PG8_WAIT_V(8); PG8_WAIT_L(0); PG8_BAR; PG8_MMA(1, 0, At, B0); PG8_MMA(1, 1, At, B1); PG8_BAR; PG8_SCHED;
        }
        if (wr == 0) PG8_BAR;
        E(acc, cur, wr, wc, fr, fq);
        if (!has_next) break;
#pragma unroll
        for (int a = 0; a < 2; ++a)
#pragma unroll
            for (int b = 0; b < 2; ++b)
#pragma unroll
                for (int m = 0; m < 4; ++m)
#pragma unroll
                    for (int n = 0; n < 2; ++n) acc[a][b][m][n] = (f32x4){0.f, 0.f, 0.f, 0.f};
        cur = nxt; cA = nA; cB = nB; ++ui;
        if (wr == 1) PG8_BAR;
    }
    PG8_WAIT_V(0);
    PG8_BAR;
#undef PG8_SA
#undef PG8_SB
#undef PG8_STAGE
#undef PG8_LDA
#undef PG8_LDB
#undef PG8_MMA
#undef PG8_WAIT_V
#undef PG8_WAIT_L
#undef PG8_BAR
#undef PG8_SCHED
}
}

struct Args { const float* in[29]; float* out; unsigned char* ws; };
typedef const __attribute__((address_space(4))) Args* KArgs;
#define KA_FRESH(ka) asm volatile("" : "+s"(ka))
enum { I_X = 0, I_C, I_CTX, I_CCTX, I_N1G, I_N2G, I_WADA, I_BADA, I_WIN, I_NAQG, I_NAKG, I_RPB, I_MQN, I_WUQ, I_MKVN, I_WUKV, I_MQG, I_MKG, I_SWQG, I_SWKG, I_SINK,
       I_WNAO, I_WMLAO, I_WSWAO, I_WO, I_ROUTER, I_WGATE, I_WUP, I_WDOWN };
struct Frame {
    LAS unsigned char* lds;
    int tid, lane, wave, G, vcu, gw, ngw;
};

DI void frame_fresh(Frame& F) { int t = F.tid, w = F.wave, v = F.vcu; asm volatile("" : "+v"(t), "+s"(w), "+s"(v)); F.tid = t; F.lane = t & 63; F.wave = w; F.vcu = v; F.gw = v * 8 + w; }
DI void modv_phase(Frame& F, KArgs ka) {
    KA_FRESH(ka); const __attribute__((address_space(4))) Args& a = *ka; frame_fresh(F);
    LAS float* cact = (LAS float*)F.lds;
    LAS float* red = (LAS float*)(F.lds + 9 * 1024 * 4);
    const float* c = a.in[I_C]; const float* cc = a.in[I_CCTX];
    for (int i = F.tid; i < 9 * 1024; i += 512) { const float v = i < 8192 ? c[i] : cc[i - 8192]; cact[i] = v * sigmoidf_(v); }
    __syncthreads();
    float* modv = (float*)(a.ws + WS_MODV);
    const int cl = F.lane & 31, kp = F.lane >> 5;
    for (int unit = F.vcu; unit < NL * 192; unit += F.G) {
        const int l = unit / 192, n = (unit % 192) * 32 + cl;
        const float* w = a.in[I_WADA] + (size_t)l * 1024 * 6144 + n;
        float acc[9];
#pragma unroll
        for (int i = 0; i < 9; ++i) acc[i] = 0.f;
        const int k0 = F.wave * 128 + kp;
#pragma unroll 16
        for (int k = 0; k < 128; k += 2) { const float wv = w[(size_t)(k0 + k) * 6144];
#pragma unroll
            for (int i = 0; i < 9; ++i) acc[i] += cact[i * 1024 + k0 + k] * wv; }
#pragma unroll
        for (int i = 0; i < 9; ++i) red[((F.wave * 2 + kp) * 9 + i) * 32 + cl] = acc[i];
        __syncthreads();
        for (int t = F.tid; t < 9 * 32; t += 512) { const int i = t >> 5, nn = t & 31; float s = 0.f;
#pragma unroll
            for (int w16 = 0; w16 < 16; ++w16) s += red[(w16 * 9 + i) * 32 + nn];
            const int col = (unit % 192) * 32 + nn;
            modv[((size_t)l * 9 + i) * 6144 + col] = s + a.in[I_BADA][l * 6144 + col]; }
        __syncthreads();
    }
}
DI void copy_phase(Frame& F, KArgs ka) {
    KA_FRESH(ka); const __attribute__((address_space(4))) Args& a = *ka; frame_fresh(F);
    u32x2* xs = (u32x2*)(a.ws + WS_XS);
    const f32x4* x = (const f32x4*)a.in[I_X]; const f32x4* cx = (const f32x4*)a.in[I_CTX];
    const size_t nl = (size_t)MLAT * D / 4, nc = (size_t)MCTX * D / 4;
    for (size_t i = (size_t)blockIdx.x * 512 + F.tid; i < nl + nc; i += (size_t)F.G * 512) { const f32x4 v = i < nl ? x[i] : cx[i - nl]; u32x2 w; w.x = pk2(v.x, v.y); w.y = pk2(v.z, v.w); xs[i] = w; }
}

DI void cvt_tile(const float* W, int ldw, int k0, int n0, bf16_t* WT, int ldt, int drow0, int dcol0, const float* kscale, LAS float* scr, int lane) {
#pragma unroll 8
    for (int i = 0; i < 32; ++i) { const int kk = 2 * i + (lane >> 5); float v = W[(size_t)(k0 + kk) * ldw + n0 + (lane & 31)]; if (kscale) v *= kscale[k0 + kk]; scr[kk * 33 + (lane & 31)] = v; }
    asm volatile("s_waitcnt lgkmcnt(0)" ::: "memory");
    const int c = lane & 7;
#pragma unroll
    for (int j = 0; j < 4; ++j) { const int n = (lane >> 3) + 8 * j; const LAS float* s = scr + (8 * c) * 33 + n;
        u32x4 o; o.x = pk2(s[0 * 33], s[1 * 33]); o.y = pk2(s[2 * 33], s[3 * 33]); o.z = pk2(s[4 * 33], s[5 * 33]); o.w = pk2(s[6 * 33], s[7 * 33]);
        *(u32x4*)(WT + (size_t)(drow0 + n) * ldt + dcol0 + 8 * c) = o; }
    asm volatile("s_waitcnt lgkmcnt(0)" ::: "memory");
}
DI void cvt_tile_fp8(const float* W, int ldw, int k0, int n0, unsigned char* WT, int ldt, int drow0, int dcol0, float scale, LAS float* scr, int lane) {
#pragma unroll 8
    for (int i = 0; i < 32; ++i) { const int kk = 2 * i + (lane >> 5); scr[kk * 33 + (lane & 31)] = W[(size_t)(k0 + kk) * ldw + n0 + (lane & 31)] * scale; }
    asm volatile("s_waitcnt lgkmcnt(0)" ::: "memory");
    const int c = lane & 7;
#pragma unroll
    for (int j = 0; j < 4; ++j) { const int n = (lane >> 3) + 8 * j; const LAS float* s = scr + (8 * c) * 33 + n;
        u32x2 o; o.x = pk4_fp8(s[0 * 33], s[1 * 33], s[2 * 33], s[3 * 33]); o.y = pk4_fp8(s[4 * 33], s[5 * 33], s[6 * 33], s[7 * 33]);
        *(u32x2*)(WT + (size_t)(drow0 + n) * ldt + dcol0 + 8 * c) = o; }
    asm volatile("s_waitcnt lgkmcnt(0)" ::: "memory");
}
DI void convert_weights(Frame& F, KArgs ka, int l) {
    KA_FRESH(ka); const __attribute__((address_space(4))) Args& a = *ka; frame_fresh(F);
    LAS float* scr = (LAS float*)(F.lds + F.wave * 16384);
    unsigned char* wb = a.ws + WS_W;
    constexpr int T_IN = 16 * 166, T_UQ = 4 * 24, T_UKV = 2 * 32, T_NAO = 6 * 32, T_MLAO = 8 * 32, T_SWAO = 6 * 32, T_O = 16 * 32, T_E = 16 * 32 * 16;
    constexpr int NIT = T_IN + T_UQ + T_UKV + T_NAO + T_MLAO + T_SWAO + T_O + 3 * T_E;
    for (int it = F.gw; it < NIT; it += F.ngw) {
        int r = it;
        if (r < T_IN) { const int kb = r / 166, nb = r % 166;
            if (nb < 70) cvt_tile(a.in[I_WIN] + (size_t)l * 1024 * DIN, DIN, 64 * kb, 32 * nb, (bf16_t*)(wb + W_IN), 1024, 32 * nb, 64 * kb, nullptr, scr, F.lane);
            else cvt_tile_fp8(a.in[I_WIN] + (size_t)l * 1024 * DIN, DIN, 64 * kb, 32 * nb, wb + W_GL, 1024, 32 * nb - 2240, 64 * kb, 32.0f, scr, F.lane);
            continue; } r -= T_IN;
        if (r < T_UQ) { const int kb = r / 24, nb = r % 24; cvt_tile(a.in[I_WUQ] + (size_t)l * 256 * 768, 768, 64 * kb, 32 * nb, (bf16_t*)(wb + W_UP), 384, 32 * nb, 64 * kb, a.in[I_MQN] + l * 256, scr, F.lane); continue; } r -= T_UQ;
        if (r < T_UKV) { const int kb = r / 32, nb = r % 32; cvt_tile(a.in[I_WUKV] + (size_t)l * 128 * 1024, 1024, 64 * kb, 32 * nb, (bf16_t*)(wb + W_UP), 384, 768 + 32 * nb, 256 + 64 * kb, a.in[I_MKVN] + l * 128, scr, F.lane); continue; } r -= T_UKV;
        if (r < T_NAO) { const int kb = r / 32, nb = r % 32; cvt_tile(a.in[I_WNAO] + (size_t)l * 384 * 1024, 1024, 64 * kb, 32 * nb, (bf16_t*)(wb + W_NAO), 512, 32 * nb, 64 * kb, nullptr, scr, F.lane); continue; } r -= T_NAO;
        if (r < T_MLAO) { const int kb = r / 32, nb = r % 32; cvt_tile(a.in[I_WMLAO] + (size_t)l * 512 * 1024, 1024, 64 * kb, 32 * nb, (bf16_t*)(wb + W_MLAO), 512, 32 * nb, 64 * kb, nullptr, scr, F.lane); continue; } r -= T_MLAO;
        if (r < T_SWAO) { const int kb = r / 32, nb = r % 32; cvt_tile(a.in[I_WSWAO] + (size_t)l * 384 * 1024, 1024, 64 * kb, 32 * nb, (bf16_t*)(wb + W_SWAO), 512, 32 * nb, 64 * kb, nullptr, scr, F.lane); continue; } r -= T_SWAO;
        if (r < T_O) { const int kb = r / 32, nb = r % 32; cvt_tile(a.in[I_WO] + (size_t)l * 1024 * 1024, 1024, 64 * kb, 32 * nb, (bf16_t*)(wb + W_O), 1024, 32 * nb, 64 * kb, nullptr, scr, F.lane); continue; } r -= T_O;
        if (r < 2 * T_E) {
            const int which = r / T_E, rr = r % T_E, e = rr / 512, t = rr % 512, kb = t / 32, nb = t % 32, f0 = 32 * nb;
            const float* src = a.in[which ? I_WUP : I_WGATE] + ((size_t)l * 16 + e) * 1024 * 1024;
            cvt_tile_fp8(src, 1024, 64 * kb, f0, wb + W_GU + (size_t)e * 2048 * 1024, 1024, 256 * (f0 >> 7) + 128 * which + (f0 & 127), 64 * kb, 32.0f, scr, F.lane); continue; } r -= 2 * T_E;
        { const int e = r / 512, t = r % 512, kb = t / 32, nb = t % 32;
            cvt_tile_fp8(a.in[I_WDOWN] + ((size_t)l * 16 + e) * 1024 * 1024, 1024, 64 * kb, 32 * nb, wb + W_DN + (size_t)e * 1024 * 1024, 1024, 32 * nb, 64 * kb, 32.0f, scr, F.lane); }
    }
    constexpr int Z0 = 64 * 128, Z1 = 768 * 16, Z2 = 1024 * 32;
    unsigned zz = 0u; asm volatile("" : "+v"(zz));
    const u32x4 z = {zz, zz, zz, zz};
    for (int i = blockIdx.x * 512 + F.tid; i < Z0 + Z1 + Z2; i += F.G * 512) {
        if (i < Z0) *(u32x4*)((bf16_t*)(wb + W_IN) + (size_t)(2240 + i / 128) * 1024 + (i % 128) * 8) = z;
        else if (i < Z0 + Z1) { const int j = i - Z0; *(u32x4*)((bf16_t*)(wb + W_UP) + (size_t)(j / 16) * 384 + 256 + (j % 16) * 8) = z; }
        else { const int j = i - Z0 - Z1; *(u32x4*)((bf16_t*)(wb + W_UP) + (size_t)(768 + j / 32) * 384 + (j % 32) * 8) = z; }
    }
}

DI void row_phase(Frame& F, KArgs ka, int l, int dry = 0) {
    KA_FRESH(ka); const __attribute__((address_space(4))) Args& a = *ka; frame_fresh(F);
    bf16_t* xs = (bf16_t*)(a.ws + WS_XS);
    const float* modv = (const float*)(a.ws + WS_MODV);
    const int* smap = (const int*)(a.ws + WS_SMAP);
    const bf16_t* Y = (const bf16_t*)(a.ws + WS_Y);
    bf16_t* H = (bf16_t*)(a.ws + WS_R4);
    unsigned char* H8 = a.ws + WS_R4 + 68 * MiB;
    bf16_t* xso = xs; float* outo = a.out;
    if (dry) { unsigned char* tr = a.ws + WS_END + (size_t)F.gw * 16384; xso = (bf16_t*)tr; outo = (float*)tr; H = (bf16_t*)(tr + 8192); H8 = tr + 12288; }
    const int nrows = (l == NL) ? MLAT : MT;
    const bool comb = (l > 0);
    constexpr int RR = 4;
    for (int mb = RR * F.gw; mb < nrows; mb += RR * F.ngw) {
        f32x4 v[RR][4]; int myslot[RR];
#pragma unroll
        for (int rr = 0; rr < RR; ++rr) { const int m = mb + rr;
            if (l == 0) {
                const f32x4* xr = (const f32x4*)(m < MLAT ? a.in[I_X] + (size_t)m * D : a.in[I_CTX] + (size_t)(m - MLAT) * D) + F.lane;
                u32x2* xo = (u32x2*)(xs + (size_t)m * D) + F.lane;
#pragma unroll
                for (int j = 0; j < 4; ++j) { const f32x4 t = xr[64 * j]; u32x2 w; w.x = pk2(t.x, t.y); w.y = pk2(t.z, t.w); if (!dry) xo[64 * j] = w; v[rr][j] = (f32x4){bflo(w.x), bfhi(w.x), bflo(w.y), bfhi(w.y)}; }
            } else {
                const u32x2* xr = (const u32x2*)(xs + (size_t)m * D) + F.lane;
#pragma unroll
                for (int j = 0; j < 4; ++j) { const u32x2 w = xr[64 * j]; v[rr][j] = (f32x4){bflo(w.x), bfhi(w.x), bflo(w.y), bfhi(w.y)}; }
            }
            myslot[rr] = (comb && F.lane < 16) ? smap[(size_t)F.lane * MT + mb + rr] : -1; }
        const int mi = mod_index(mb);
        if (comb) {
            f32x4 acc[RR][4];
            unsigned long long mk[RR];
#pragma unroll
            for (int rr = 0; rr < RR; ++rr) { mk[rr] = __ballot(myslot[rr] >= 0);
#pragma unroll
                for (int j = 0; j < 4; ++j) acc[rr][j] = (f32x4){0.f, 0.f, 0.f, 0.f}; }
            while ((mk[0] | mk[1]) | (mk[2] | mk[3])) {
                u32x2 w[RR][4];
#pragma unroll
                for (int rr = 0; rr < RR; ++rr) {
                    int s = -1;
                    if (mk[rr]) { const int e0 = __builtin_ctzll(mk[rr]); s = __shfl(myslot[rr], e0); mk[rr] &= mk[rr] - 1; }
#pragma unroll
                    for (int j = 0; j < 4; ++j) w[rr][j] = (u32x2){0u, 0u};
                    if (s >= 0) { const u32x2* yr = (const u32x2*)(Y + (size_t)s * D) + F.lane;
#pragma unroll
                        for (int j = 0; j < 4; ++j) w[rr][j] = yr[64 * j]; }
                }
#pragma unroll
                for (int rr = 0; rr < RR; ++rr)
#pragma unroll
                    for (int j = 0; j < 4; ++j) acc[rr][j] += (f32x4){bflo(w[rr][j].x), bfhi(w[rr][j].x), bflo(w[rr][j].y), bfhi(w[rr][j].y)};
            }
            const f32x4* g5 = (const f32x4*)(modv + ((size_t)(l - 1) * 9 + mi) * 6144 + 5 * 1024) + F.lane;
            f32x4 g5v[4];
#pragma unroll
            for (int j = 0; j < 4; ++j) g5v[j] = g5[64 * j];
#pragma unroll
            for (int rr = 0; rr < RR; ++rr) { const int m = mb + rr;
                const size_t ro = dry ? (size_t)rr * 1024 : (size_t)m * D;
#pragma unroll
                for (int j = 0; j < 4; ++j) { v[rr][j] += g5v[j] * acc[rr][j];
                    if (l == NL) ((f32x4*)(outo + ro) + F.lane)[64 * j] = v[rr][j];
                    else { u32x2 w; w.x = pk2(v[rr][j].x, v[rr][j].y); w.y = pk2(v[rr][j].z, v[rr][j].w); ((u32x2*)(xso + ro) + F.lane)[64 * j] = w;
                           v[rr][j] = (f32x4){bflo(w.x), bfhi(w.x), bflo(w.y), bfhi(w.y)}; } } }
        }
        if (l < NL) {
            const f32x4* g = (const f32x4*)(a.in[I_N1G] + l * D) + F.lane;
            const f32x4* sh = (const f32x4*)(modv + ((size_t)l * 9 + mi) * 6144) + F.lane;
            const f32x4* sc = (const f32x4*)(modv + ((size_t)l * 9 + mi) * 6144 + 1024) + F.lane;
            f32x4 gg[4], shv[4];
#pragma unroll
            for (int j = 0; j < 4; ++j) { gg[j] = g[64 * j] * (sc[64 * j] + 1.0f); shv[j] = sh[64 * j]; }
#pragma unroll
            for (int rr = 0; rr < RR; ++rr) { const int m = mb + rr;
                float ss = 0.f;
#pragma unroll
                for (int j = 0; j < 4; ++j) ss += (v[rr][j].x * v[rr][j].x + v[rr][j].y * v[rr][j].y) + (v[rr][j].z * v[rr][j].z + v[rr][j].w * v[rr][j].w);
                const float rstd = __builtin_amdgcn_rsqf(wave_sum(ss) * (1.f / D) + EPS);
                u32x2* o = (u32x2*)(H + (dry ? (size_t)rr * 1024 : (size_t)m * D)) + F.lane;
                unsigned* o8 = (unsigned*)(H8 + (dry ? (size_t)rr * 1024 : (size_t)m * D)) + F.lane;
#pragma unroll
                for (int j = 0; j < 4; ++j) { const f32x4 hh = v[rr][j] * rstd * gg[j] + shv[j]; u32x2 w; w.x = pk2(hh.x, hh.y); w.y = pk2(hh.z, hh.w); o[64 * j] = w;
                    o8[64 * j] = pk4_fp8(hh.x, hh.y, hh.z, hh.w); } }
        }
    }
}

DI void rope_cs(int d, int prow, int pcol, float& cs, float& sn) {
    const int i = d & 15; const float pos = (float)((d & 32) ? pcol : prow);
    const float inv = __builtin_amdgcn_exp2f(-(float)i * (13.287712379549449f / 16.0f));
    const float rev = pos * inv * 0.15915494309189535f;
    const float fr = rev - floorf(rev);
    cs = __builtin_amdgcn_cosf(fr); sn = __builtin_amdgcn_sinf(fr);
}
DI void prep_phase(Frame& F, KArgs ka, int l) {
    KA_FRESH(ka); const __attribute__((address_space(4))) Args& a = *ka; frame_fresh(F);
    const bf16_t* HW = (const bf16_t*)(a.ws + WS_HW);
    bf16_t* P1 = (bf16_t*)(a.ws + WS_P1);
    const float sc64 = 0.125f * LOG2E;
    const int d0 = 8 * (F.lane & 7);
    float gn[3][8]; int srcc[3]; bool ropei[3], acti[3];
    const float* gp0 = a.in[I_NAQG]; const float* gp1 = a.in[I_NAKG]; const float* gp2 = a.in[I_SWQG]; const float* gp3 = a.in[I_SWKG];
#pragma unroll
    for (int i = 0; i < 3; ++i) { const int c = F.lane + 64 * i, col = 8 * c; acti[i] = c < 160;
        const int ty = col < 384 ? 0 : col < 768 ? 1 : col < 1152 ? 2 : 3;
        srcc[i] = col < 768 ? col : col + (C_SWQ - 768);
        ropei[i] = ty >= 2;
        const float sc = (ty == 0 || ty == 2) ? sc64 : 1.0f;
#pragma unroll
        for (int j = 0; j < 8; ++j) { const float g0 = gp0[l * 64 + d0 + j], g1 = gp1[l * 64 + d0 + j], g2 = gp2[l * 64 + d0 + j], g3 = gp3[l * 64 + d0 + j];
            gn[i][j] = acti[i] ? (ty == 0 ? g0 : ty == 1 ? g1 : ty == 2 ? g2 : g3) * sc : 0.f; } }
    float invf[8];
#pragma unroll
    for (int j = 0; j < 8; ++j) invf[j] = __builtin_amdgcn_exp2f(-(float)((d0 & 8) + j) * (13.287712379549449f / 16.0f)) * 0.15915494309189535f;
    const bool second = (d0 & 16) != 0, usecol = (d0 & 32) != 0;
    for (int mb = 2 * F.gw; mb < MT; mb += 2 * F.ngw) {
        u32x4 w[2][3];
#pragma unroll
        for (int rr = 0; rr < 2; ++rr)
#pragma unroll
            for (int i = 0; i < 3; ++i) if (acti[i]) w[rr][i] = *(const u32x4*)(HW + (size_t)(mb + rr) * DINP + srcc[i]); else w[rr][i] = (u32x4){0u, 0u, 0u, 0u};
#pragma unroll
        for (int rr = 0; rr < 2; ++rr) {
            const int m = mb + rr; const bool lat = m < MLAT; const int s = m & 4095; const float prw = (float)(s >> 6), pcl = (float)(s & 63); float pos = usecol ? pcl : prw; asm volatile("" : "+v"(pos));
            float cs[8], sn[8];
#pragma unroll
            for (int j = 0; j < 8; ++j) { cs[j] = 1.f; sn[j] = 0.f; }
            if (lat) {
#pragma unroll
                for (int j = 0; j < 8; ++j) { const float rev = pos * invf[j], fr = rev - floorf(rev); cs[j] = __builtin_amdgcn_cosf(fr); sn[j] = __builtin_amdgcn_sinf(fr); } }
#pragma unroll
            for (int i = 0; i < 3; ++i) {
                float x[8] = {bflo(w[rr][i].x), bfhi(w[rr][i].x), bflo(w[rr][i].y), bfhi(w[rr][i].y), bflo(w[rr][i].z), bfhi(w[rr][i].z), bflo(w[rr][i].w), bfhi(w[rr][i].w)};
                float ss = 0.f;
#pragma unroll
                for (int j = 0; j < 8; ++j) ss += x[j] * x[j];
                ss += __shfl_xor(ss, 1); ss += __shfl_xor(ss, 2); ss += __shfl_xor(ss, 4);
                const float rs = __builtin_amdgcn_rsqf(ss * (1.f / 64.f) + EPS);
#pragma unroll
                for (int j = 0; j < 8; ++j) x[j] *= rs * gn[i][j];
                const bool rp = ropei[i] && lat;
#pragma unroll
                for (int j = 0; j < 8; ++j) { const float y = __int_as_float(__builtin_amdgcn_ds_bpermute((F.lane ^ 2) << 2, __float_as_int(x[j]))); const float rot = second ? x[j] * cs[j] + y * sn[j] : x[j] * cs[j] - y * sn[j]; x[j] = rp ? rot : x[j]; }
                if (acti[i]) { u32x4 o; o.x = pk2(x[0], x[1]); o.y = pk2(x[2], x[3]); o.z = pk2(x[4], x[5]); o.w = pk2(x[6], x[7]);
                    *(u32x4*)(P1 + (size_t)m * P1W + 8 * (F.lane + 64 * i)) = o; }
            }
        }
    }
}
DI void prep2_phase(Frame& F, KArgs ka, int l, int dry = 0) {
    KA_FRESH(ka); const __attribute__((address_space(4))) Args& a = *ka; frame_fresh(F);
    const bf16_t* HW = (const bf16_t*)(a.ws + WS_HW);
    bf16_t* U = (bf16_t*)(a.ws + WS_R4);
    bf16_t* P2 = (bf16_t*)(a.ws + WS_P2);
    const float scq = 0.07216878364870322f * LOG2E;
    const int ln = F.lane, q = ln & 15, h = ln >> 4;
    float qgn[8], qgr[4], kgn[8], kgr[4], invf[4];
    { const float* qg = a.in[I_MQG] + l * 192; const float* kg = a.in[I_MKG] + l * 192;
#pragma unroll
      for (int j = 0; j < 8; ++j) { qgn[j] = qg[8 * q + j] * scq; kgn[j] = kg[8 * q + j]; }
#pragma unroll
      for (int j = 0; j < 4; ++j) { qgr[j] = qg[128 + 4 * q + j] * scq; kgr[j] = kg[128 + 4 * q + j];
          invf[j] = __builtin_amdgcn_exp2f(-(float)(4 * (q & 3) + j) * (13.287712379549449f / 16.0f)) * 0.15915494309189535f; } }
    const bool second = (q & 4) != 0, usecol = (q & 8) != 0;
    const int pl = (ln ^ 4) << 2;
    for (int mb = 2 * F.gw; mb < MT; mb += 2 * F.ngw) {
        u32x2 wcq[2], wqr[2], wkr[2]; unsigned wckv[2]; u32x4 wqn[2], wkn[2], wv[2];
#pragma unroll
        for (int rr = 0; rr < 2; ++rr) { const bf16_t* hr = HW + (size_t)(mb + rr) * DINP; const bf16_t* ur = U + (size_t)(mb + rr) * UW;
            wcq[rr] = *(const u32x2*)(hr + C_CQ + 4 * ln); wckv[rr] = *(const unsigned*)(hr + C_CKV + 2 * ln); wkr[rr] = *(const u32x2*)(hr + C_KR + 4 * q);
            wqn[rr] = *(const u32x4*)(ur + h * 192 + 8 * q); wqr[rr] = *(const u32x2*)(ur + h * 192 + 128 + 4 * q);
            wkn[rr] = *(const u32x4*)(ur + 768 + h * 256 + 8 * q); wv[rr] = *(const u32x4*)(ur + 768 + h * 256 + 128 + 8 * q); }
#pragma unroll
        for (int rr = 0; rr < 2; ++rr) {
            const int m = mb + rr; const bool lat = m < MLAT; const int s = m & 4095;
            bf16_t* ur = U + (size_t)m * UW; bf16_t* pr = P2 + (size_t)m * P2W;
            if (dry) { ur = (bf16_t*)(a.ws + WS_END + (size_t)F.gw * 8192); pr = ur + 2048; }
            float rq, rkv;
            { const float a0 = bflo(wcq[rr].x), a1 = bfhi(wcq[rr].x), a2 = bflo(wcq[rr].y), a3 = bfhi(wcq[rr].y);
              rq = __builtin_amdgcn_rsqf(wave_sum(a0 * a0 + a1 * a1 + a2 * a2 + a3 * a3) * (1.f / 256.f) + EPS); }
            { const float a0 = bflo(wckv[rr]), a1 = bfhi(wckv[rr]);
              rkv = __builtin_amdgcn_rsqf(wave_sum(a0 * a0 + a1 * a1) * (1.f / 128.f) + EPS); }
            float cs[4], sn[4];
            { const float prw = (float)(s >> 6), pcl = (float)(s & 63); float pos = usecol ? pcl : prw; asm volatile("" : "+v"(pos));
#pragma unroll
              for (int j = 0; j < 4; ++j) { const float rev = pos * invf[j], fr = rev - floorf(rev); cs[j] = lat ? __builtin_amdgcn_cosf(fr) : 1.f; sn[j] = lat ? __builtin_amdgcn_sinf(fr) : 0.f; } }
#pragma unroll
            for (int isk = 0; isk < 2; ++isk) {
                const u32x4 wn = isk ? wkn[rr] : wqn[rr]; const u32x2 wr2 = isk ? wkr[rr] : wqr[rr];
                const float sn_ = isk ? rkv : rq, sr_ = isk ? 1.0f : rq;
                float x[8] = {bflo(wn.x) * sn_, bfhi(wn.x) * sn_, bflo(wn.y) * sn_, bfhi(wn.y) * sn_, bflo(wn.z) * sn_, bfhi(wn.z) * sn_, bflo(wn.w) * sn_, bfhi(wn.w) * sn_};
                float y[4] = {bflo(wr2.x) * sr_, bfhi(wr2.x) * sr_, bflo(wr2.y) * sr_, bfhi(wr2.y) * sr_};
                float ss = 0.f;
#pragma unroll
                for (int j = 0; j < 8; ++j) ss += x[j] * x[j];
#pragma unroll
                for (int j = 0; j < 4; ++j) ss += y[j] * y[j];
                ss += __shfl_xor(ss, 1); ss += __shfl_xor(ss, 2); ss += __shfl_xor(ss, 4); ss += __shfl_xor(ss, 8);
                const float rs = __builtin_amdgcn_rsqf(ss * (1.f / 192.f) + EPS);
#pragma unroll
                for (int j = 0; j < 8; ++j) x[j] *= rs * (isk ? kgn[j] : qgn[j]);
#pragma unroll
                for (int j = 0; j < 4; ++j) { y[j] *= rs * (isk ? kgr[j] : qgr[j]);
                    const float p = __int_as_float(__builtin_amdgcn_ds_bpermute(pl, __float_as_int(y[j])));
                    y[j] = second ? y[j] * cs[j] + p * sn[j] : y[j] * cs[j] - p * sn[j]; }
                u32x4 o; o.x = pk2(x[0], x[1]); o.y = pk2(x[2], x[3]); o.z = pk2(x[4], x[5]); o.w = pk2(x[6], x[7]);
                u32x2 o2; o2.x = pk2(y[0], y[1]); o2.y = pk2(y[2], y[3]);
                *(u32x4*)(pr + 768 * isk + h * 192 + 8 * q) = o; *(u32x2*)(pr + 768 * isk + h * 192 + 128 + 4 * q) = o2;
            }
            { const u32x4 vw = wv[rr]; u32x4 o; o.x = pk2(bflo(vw.x) * rkv, bfhi(vw.x) * rkv); o.y = pk2(bflo(vw.y) * rkv, bfhi(vw.y) * rkv); o.z = pk2(bflo(vw.z) * rkv, bfhi(vw.z) * rkv); o.w = pk2(bflo(vw.w) * rkv, bfhi(vw.w) * rkv);
              *(u32x4*)(ur + 768 + h * 256 + 128 + 8 * q) = o; }
        }
    }
}

struct AU {
    const bf16_t *q, *k, *v; bf16_t* o;
    int ldq, ldk, ldv, ldo;
    int qrow0;
    int lat_row0, n_lat, ctx_row0, n_ctx;
    int mode;
    int qpos0, kpos0;
    float m0, l0;
    const float* rpb;
};
template <int DQ, int DV, int LDK, int LDV>
DI void attn_unit(LAS unsigned char* lds, const AU& u, int tid, int wave, int lane) {
    constexpr int KP = DQ * 2 + 16, VP = DV * 2 + 64, KBY = 64 * KP, VBY = 64 * VP, STG = KBY + VBY;
    constexpr int NKS = DQ / 16, NDT = DV / 32, KCH = DQ / 8, VCH = DV / 8;
    constexpr int KC = KP / 16, VC = VP / 16;
    constexpr int KI = (KC + 7) / 8, VI = (VC + 7) / 8;
    constexpr int BIAS_OFF = 98304;
    static_assert(2 * STG <= BIAS_OFF && KBY % 1024 == 0 && VBY % 1024 == 0, "attention LDS");
    const int r = lane & 31, h = lane >> 5;
    const int nt = u.n_lat + u.n_ctx;
    LAS float* btab = (LAS float*)(lds + BIAS_OFF);
    if (u.mode == 2) { for (int i = tid; i < 15 * 31; i += 512) btab[i] = u.rpb[i] * LOG2E; }
    bf16x8 qf[NKS];
    { const bf16_t* qp = u.q + (size_t)(u.qrow0 + wave * 32 + r) * u.ldq + 8 * h;
#pragma unroll
      for (int ks = 0; ks < NKS; ++ks) qf[ks] = *(const bf16x8*)(qp + 16 * ks); }
    f32x16 o[NDT];
#pragma unroll
    for (int dt = 0; dt < NDT; ++dt)
#pragma unroll
        for (int i = 0; i < 16; ++i) o[dt][i] = 0.f;
    float mrun = u.m0, lrun = (h == 0) ? u.l0 : 0.f;
    unsigned koff[KI], voff[VI];
#pragma unroll
    for (int i = 0; i < KI; ++i) { const int c = 64 * (wave + 8 * i) + lane, row = c / KC, cc = c % KC; koff[i] = (unsigned)(row * LDK * 2 + (cc < KCH ? cc : KCH - 1) * 16); }
#pragma unroll
    for (int i = 0; i < VI; ++i) { const int c = 64 * (wave + 8 * i) + lane, row = c / VC, cc = c % VC; voff[i] = (unsigned)(row * LDV * 2 + (cc < VCH ? cc : VCH - 1) * 16); }
#define AT_ROWBASE(t) ((t) < u.n_lat ? u.lat_row0 + 64 * (t) : u.ctx_row0 + 64 * ((t) - u.n_lat))
#define AT_ISSUE(t, buf) do { const int rb_ = AT_ROWBASE(t); const char* kb_ = (const char*)(u.k + (size_t)rb_ * LDK); const char* vb_ = (const char*)(u.v + (size_t)rb_ * LDV); \
        _Pragma("unroll") for (int i_ = 0; i_ < KI; ++i_) { const int j_ = wave + 8 * i_; if (j_ < KC) __builtin_amdgcn_global_load_lds((const unsigned*)(kb_ + koff[i_]), (LAS unsigned*)(lds + (buf) * STG + j_ * 1024), 16, 0, 0); } \
        _Pragma("unroll") for (int i_ = 0; i_ < VI; ++i_) { const int j_ = wave + 8 * i_; if (j_ < VC) __builtin_amdgcn_global_load_lds((const unsigned*)(vb_ + voff[i_]), (LAS unsigned*)(lds + (buf) * STG + KBY + j_ * 1024), 16, 0, 0); } } while (0)
    AT_ISSUE(0, 0);
    asm volatile("s_waitcnt vmcnt(0)" ::: "memory");
    __syncthreads();
    const int tq = (lane & 15) >> 2, tp = lane & 3, tblk = (lane >> 4) & 1;
    const int vlane_off = (4 * h + tq) * VP + 32 * tblk + 8 * tp;
    for (int t = 0; t < nt; ++t) {
        const int buf = t & 1;
        if (t + 1 < nt) AT_ISSUE(t + 1, buf ^ 1);
        bool skip = false; int a0 = 0, a1 = 0;
        if (u.mode == 1 && t < u.n_lat) { const int k0 = u.kpos0 + 64 * t, q0 = u.qpos0 + 32 * wave; skip = (k0 > q0 + 31 + 128) || (k0 + 63 < q0 - 128); a0 = k0; a1 = q0; }
        if (u.mode == 2 && t < u.n_lat) { const int kr = u.kpos0 + t, qr = u.qpos0 + (wave >> 1); int rs = qr - 4; rs = rs < 0 ? 0 : (rs > 56 ? 56 : rs); skip = (kr < rs) || (kr >= rs + 8); a0 = kr - qr + 7; }
        if (!skip) {
            const LAS unsigned char* Kt = lds + buf * STG; const LAS unsigned char* Vt = Kt + KBY;
            f32x16 s0, s1;
#pragma unroll
            for (int i = 0; i < 16; ++i) { s0[i] = 0.f; s1[i] = 0.f; }
#pragma unroll
            for (int ks = 0; ks < NKS; ++ks) {
                const bf16x8 k0 = *(const LAS bf16x8*)(Kt + r * KP + (16 * ks + 8 * h) * 2);
                const bf16x8 k1 = *(const LAS bf16x8*)(Kt + (32 + r) * KP + (16 * ks + 8 * h) * 2);
                s0 = __builtin_amdgcn_mfma_f32_32x32x16_bf16(k0, qf[ks], s0, 0, 0, 0);
                s1 = __builtin_amdgcn_mfma_f32_32x32x16_bf16(k1, qf[ks], s1, 0, 0, 0);
            }
            if (u.mode == 1 && t < u.n_lat) {
                const int qpos = a1 + r;
#pragma unroll
                for (int i = 0; i < 16; ++i) { const int kk = a0 + (i & 3) + 8 * (i >> 2) + 4 * h; int d0 = qpos - kk; d0 = d0 < 0 ? -d0 : d0; int d1 = qpos - (kk + 32); d1 = d1 < 0 ? -d1 : d1;
                    s0[i] = d0 <= 128 ? s0[i] : -INFINITY; s1[i] = d1 <= 128 ? s1[i] : -INFINITY; }
            }
            if (u.mode == 2 && t < u.n_lat) {
                const int qc = 32 * (wave & 1) + r; int cs = qc - 8; cs = cs < 0 ? 0 : (cs > 48 ? 48 : cs);
                const int bbase = a0 * 31 + 15 - qc;
                float bb[16];
#pragma unroll
                for (int half = 0; half < 2; ++half) {
#pragma unroll
                    for (int i = 0; i < 16; ++i) { int ix = bbase + 32 * half + (i & 3) + 8 * (i >> 2) + 4 * h; ix = ix < 0 ? 0 : (ix > 464 ? 464 : ix); bb[i] = btab[ix]; }
                    asm volatile("" : "+v"(bb[0]), "+v"(bb[1]), "+v"(bb[2]), "+v"(bb[3]), "+v"(bb[4]), "+v"(bb[5]), "+v"(bb[6]), "+v"(bb[7]), "+v"(bb[8]), "+v"(bb[9]), "+v"(bb[10]), "+v"(bb[11]), "+v"(bb[12]), "+v"(bb[13]), "+v"(bb[14]), "+v"(bb[15]));
#pragma unroll
                    for (int i = 0; i < 16; ++i) { const int kc = 32 * half + (i & 3) + 8 * (i >> 2) + 4 * h; const bool ok = (kc >= cs) && (kc < cs + 16);
                        if (half == 0) s0[i] = ok ? s0[i] + bb[i] : -INFINITY; else s1[i] = ok ? s1[i] + bb[i] : -INFINITY; }
                }
            }
            float mx = fmaxf(s0[0], s1[0]);
#pragma unroll
            for (int i = 1; i < 16; ++i) mx = fmaxf(mx, fmaxf(s0[i], s1[i]));
            mx = fmaxf(mx, __shfl_xor(mx, 32));
            const float mnew = fmaxf(mrun, mx), alpha = __builtin_amdgcn_exp2f(mrun - mnew);
            float ls = 0.f;
#pragma unroll
            for (int i = 0; i < 16; ++i) { s0[i] = __builtin_amdgcn_exp2f(s0[i] - mnew); s1[i] = __builtin_amdgcn_exp2f(s1[i] - mnew); ls += s0[i] + s1[i]; }
            lrun = lrun * alpha + ls; mrun = mnew;
#pragma unroll
            for (int dt = 0; dt < NDT; ++dt)
#pragma unroll
                for (int i = 0; i < 16; ++i) o[dt][i] *= alpha;
            bf16x8 pf[4];
            { u32x4 w;
              w.x = pk2(s0[0], s0[1]); w.y = pk2(s0[2], s0[3]); w.z = pk2(s0[4], s0[5]); w.w = pk2(s0[6], s0[7]); pf[0] = __builtin_bit_cast(bf16x8, w);
              w.x = pk2(s0[8], s0[9]); w.y = pk2(s0[10], s0[11]); w.z = pk2(s0[12], s0[13]); w.w = pk2(s0[14], s0[15]); pf[1] = __builtin_bit_cast(bf16x8, w);
              w.x = pk2(s1[0], s1[1]); w.y = pk2(s1[2], s1[3]); w.z = pk2(s1[4], s1[5]); w.w = pk2(s1[6], s1[7]); pf[2] = __builtin_bit_cast(bf16x8, w);
              w.x = pk2(s1[8], s1[9]); w.y = pk2(s1[10], s1[11]); w.z = pk2(s1[12], s1[13]); w.w = pk2(s1[14], s1[15]); pf[3] = __builtin_bit_cast(bf16x8, w); }
#pragma unroll
            for (int kk = 0; kk < 4; ++kk) {
#pragma unroll
                for (int dt = 0; dt < NDT; ++dt) {
                    const LAS unsigned char* vp = Vt + (16 * kk) * VP + vlane_off + 64 * dt;
                    const s16x4 lo = __builtin_amdgcn_ds_read_tr16_b64_v4i16((LAS s16x4*)vp);
                    const s16x4 hi = __builtin_amdgcn_ds_read_tr16_b64_v4i16((LAS s16x4*)(vp + 8 * VP));
                    const bf16x8 vf = __builtin_shufflevector(lo, hi, 0, 1, 2, 3, 4, 5, 6, 7);
                    o[dt] = __builtin_amdgcn_mfma_f32_32x32x16_bf16(vf, pf[kk], o[dt], 0, 0, 0);
                }
            }
        }
        asm volatile("s_waitcnt vmcnt(0)" ::: "memory");
        __syncthreads();
    }
    const float ltot = lrun + __shfl_xor(lrun, 32), inv = 1.0f / ltot;
    bf16_t* op = u.o + (size_t)(u.qrow0 + wave * 32 + r) * u.ldo + 4 * h;
#pragma unroll
    for (int dt = 0; dt < NDT; ++dt)
#pragma unroll
        for (int g = 0; g < 4; ++g) { u32x2 w; w.x = pk2(o[dt][4 * g] * inv, o[dt][4 * g + 1] * inv); w.y = pk2(o[dt][4 * g + 2] * inv, o[dt][4 * g + 3] * inv);
            *(u32x2*)(op + 32 * dt + 8 * g) = w; }
#undef AT_ROWBASE
#undef AT_ISSUE
}

DI void attn_phase(Frame& F, KArgs ka, int l) {
    KA_FRESH(ka); const __attribute__((address_space(4))) Args& a = *ka; frame_fresh(F);
    const bf16_t* HW = (const bf16_t*)(a.ws + WS_HW);
    const bf16_t* P1 = (const bf16_t*)(a.ws + WS_P1);
    const bf16_t* P2 = (const bf16_t*)(a.ws + WS_P2);
    const bf16_t* U = (const bf16_t*)(a.ws + WS_R4);
    bf16_t* OC = (bf16_t*)(a.ws + WS_OCAT);
    const bool last = (l == NL - 1);
    constexpr int nA = 512, nB = 768, nC = 768;
    const int ntot = nA + nB + nC + (last ? 0 : 128);
#ifndef ATT_PROBE
#define ATT_PROBE 0
#endif
    for (int rep2_ = 0; rep2_ < 1 + (ATT_PROBE != 0); ++rep2_)
    for (int id = F.vcu; id < ntot; id += F.G) {
        if (rep2_ == 1 && !((ATT_PROBE == 1) ? (id < nA) : (id >= nA && id < nA + nB))) continue;
        AU u; bool big = false;
        u.mode = 0; u.qpos0 = 0; u.kpos0 = 0; u.m0 = -1e30f; u.l0 = 0.f; u.rpb = nullptr; u.n_ctx = 4;
        if (id < nA) {
            const int b = id >> 6, h = (id >> 4) & 3, qb = id & 15; big = true;
            u.q = P2 + h * 192; u.ldq = P2W; u.k = P2 + 768 + h * 192; u.ldk = P2W; u.v = U + 768 + h * 256 + 128; u.ldv = UW; u.o = OC + 384 + h * 128; u.ldo = OCW;
            u.qrow0 = b * SEQ + qb * 256; u.lat_row0 = b * SEQ; u.n_lat = 64; u.ctx_row0 = MLAT + b * CTX;
        } else if (id < nA + nB) {
            const int j = id - nA, b = j / 96, h = (j >> 4) % 6, qb = j & 15;
            u.q = P1 + h * 64; u.ldq = P1W; u.k = P1 + 384 + h * 64; u.ldk = P1W; u.v = HW + C_NAV + h * 64; u.ldv = DINP; u.o = OC + h * 64; u.ldo = OCW;
            int rlo = 4 * qb - 4; rlo = rlo < 0 ? 0 : (rlo > 56 ? 56 : rlo); int rhi = 4 * qb + 3 - 4; rhi = (rhi < 0 ? 0 : (rhi > 56 ? 56 : rhi)) + 7;
            u.qrow0 = b * SEQ + qb * 256; u.lat_row0 = b * SEQ + rlo * 64; u.n_lat = rhi - rlo + 1; u.ctx_row0 = MLAT + b * CTX;
            u.mode = 2; u.qpos0 = 4 * qb; u.kpos0 = rlo; u.rpb = a.in[I_RPB] + (size_t)(l * 6 + h) * 465;
        } else if (id < nA + nB + nC) {
            const int j = id - nA - nB, b = j / 96, hq = (j >> 4) % 6, qb = j & 15, kvh = hq / 3;
            u.q = P1 + 768 + hq * 64; u.ldq = P1W; u.k = P1 + 1152 + kvh * 64; u.ldk = P1W; u.v = HW + C_SWV + kvh * 64; u.ldv = DINP; u.o = OC + 896 + hq * 64; u.ldo = OCW;
            int klo = qb * 256 - 128; klo = klo < 0 ? 0 : klo; int khi = qb * 256 + 384; khi = khi > SEQ ? SEQ : khi;
            u.qrow0 = b * SEQ + qb * 256; u.lat_row0 = b * SEQ + klo; u.n_lat = (khi - klo) >> 6; u.ctx_row0 = MLAT + b * CTX;
            u.mode = 1; u.qpos0 = qb * 256; u.kpos0 = klo; u.m0 = a.in[I_SINK][l * 6 + hq] * LOG2E; u.l0 = 1.f;
        } else {
            const int j = id - nA - nB - nC;
            u.n_lat = 0; u.lat_row0 = 0;
            if (j < 32) { const int b = j >> 2, h = j & 3; big = true;
                u.q = P2 + h * 192; u.ldq = P2W; u.k = P2 + 768 + h * 192; u.ldk = P2W; u.v = U + 768 + h * 256 + 128; u.ldv = UW; u.o = OC + 384 + h * 128; u.ldo = OCW;
                u.qrow0 = MLAT + b * CTX; u.ctx_row0 = MLAT + b * CTX;
            } else if (j < 80) { const int jj = j - 32, b = jj / 6, h = jj % 6;
                u.q = P1 + h * 64; u.ldq = P1W; u.k = P1 + 384 + h * 64; u.ldk = P1W; u.v = HW + C_NAV + h * 64; u.ldv = DINP; u.o = OC + h * 64; u.ldo = OCW;
                u.qrow0 = MLAT + b * CTX; u.ctx_row0 = MLAT + b * CTX;
            } else { const int jj = j - 80, b = jj / 6, hq = jj % 6, kvh = hq / 3;
                u.q = P1 + 768 + hq * 64; u.ldq = P1W; u.k = P1 + 1152 + kvh * 64; u.ldk = P1W; u.v = HW + C_SWV + kvh * 64; u.ldv = DINP; u.o = OC + 896 + hq * 64; u.ldo = OCW;
                u.qrow0 = MLAT + b * CTX; u.ctx_row0 = MLAT + b * CTX; u.m0 = a.in[I_SINK][l * 6 + hq] * LOG2E; u.l0 = 1.f;
            }
        }
        if (big) attn_unit<192, 128, P2W, UW>(F.lds, u, F.tid, F.wave, F.lane);
        else attn_unit<64, 64, P1W, DINP>(F.lds, u, F.tid, F.wave, F.lane);
    }
}

DI void norm2_phase(Frame& F, KArgs ka, int l, int nrows) {
    KA_FRESH(ka); const __attribute__((address_space(4))) Args& a = *ka; frame_fresh(F);
    LAS float* rt = (LAS float*)F.lds;
    const float* rg = a.in[I_ROUTER] + (size_t)l * 1024 * 16;
    for (int i = F.tid; i < 16384; i += 512) rt[i] = rg[i];
    __syncthreads();
    LAS float* xr = (LAS float*)(F.lds + 65536 + F.wave * 8192);
    const bf16_t* xs = (const bf16_t*)(a.ws + WS_XS);
    const float* modv = (const float*)(a.ws + WS_MODV);
    unsigned char* H2 = a.ws + WS_H2;
    float* AFL = (float*)(a.ws + WS_AFL); float* AFC = (float*)(a.ws + WS_AFC);
    const int eq = F.lane & 3, kq = F.lane >> 2;
    u32x2 xw[2][4];
#define N2_LOAD(mb_) do { _Pragma("unroll") for (int rr_ = 0; rr_ < 2; ++rr_) { const u32x2* xp_ = (const u32x2*)(xs + (size_t)((mb_) + rr_) * D) + F.lane; \
        _Pragma("unroll") for (int j_ = 0; j_ < 4; ++j_) xw[rr_][j_] = xp_[64 * j_]; } } while (0)
    if (2 * F.gw < nrows) N2_LOAD(2 * F.gw);
    for (int mb = 2 * F.gw; mb < nrows; mb += 2 * F.ngw) {
        const int mi = mod_index(mb);
        f32x4 v[2][4];
#pragma unroll
        for (int rr = 0; rr < 2; ++rr)
#pragma unroll
            for (int j = 0; j < 4; ++j) { const u32x2 w = xw[rr][j]; v[rr][j] = (f32x4){bflo(w.x), bfhi(w.x), bflo(w.y), bfhi(w.y)}; }
        if (mb + 2 * F.ngw < nrows) N2_LOAD(mb + 2 * F.ngw);
        const f32x4* g = (const f32x4*)(a.in[I_N2G] + l * D) + F.lane;
        const f32x4* sh = (const f32x4*)(modv + ((size_t)l * 9 + mi) * 6144 + 3 * 1024) + F.lane;
        const f32x4* sc = (const f32x4*)(modv + ((size_t)l * 9 + mi) * 6144 + 4 * 1024) + F.lane;
        f32x4 gg[4], shv[4];
#pragma unroll
        for (int j = 0; j < 4; ++j) { gg[j] = g[64 * j] * (sc[64 * j] + 1.0f); shv[j] = sh[64 * j]; }
#pragma unroll
        for (int rr = 0; rr < 2; ++rr) {
            float ss = 0.f;
#pragma unroll
            for (int j = 0; j < 4; ++j) ss += (v[rr][j].x * v[rr][j].x + v[rr][j].y * v[rr][j].y) + (v[rr][j].z * v[rr][j].z + v[rr][j].w * v[rr][j].w);
            const float rstd = __builtin_amdgcn_rsqf(wave_sum(ss) * (1.f / D) + EPS);
            unsigned* o = (unsigned*)(H2 + (size_t)(mb + rr) * D) + F.lane;
#pragma unroll
            for (int j = 0; j < 4; ++j) { const f32x4 hh = v[rr][j] * rstd * gg[j] + shv[j]; o[64 * j] = pk4_fp8(hh.x, hh.y, hh.z, hh.w);
                *(LAS f32x4*)(xr + rr * 1024 + 4 * F.lane + 256 * j) = hh; }
        }
        asm volatile("s_waitcnt lgkmcnt(0)" ::: "memory");
        f32x4 acc[2] = {{0.f, 0.f, 0.f, 0.f}, {0.f, 0.f, 0.f, 0.f}};
#pragma unroll 8
        for (int i = 0; i < 64; ++i) { const int k = kq + 16 * i; const float x0 = xr[k], x1 = xr[1024 + k]; const f32x4 w = *(const LAS f32x4*)(rt + k * 16 + 4 * eq); acc[0] += w * x0; acc[1] += w * x1; }
        asm volatile("s_waitcnt lgkmcnt(0)" ::: "memory");
#pragma unroll
        for (int rr = 0; rr < 2; ++rr) { const int m = mb + rr; f32x4 ac = acc[rr];
#pragma unroll
            for (int ofs = 4; ofs < 64; ofs <<= 1) { ac.x += __shfl_xor(ac.x, ofs); ac.y += __shfl_xor(ac.y, ofs); ac.z += __shfl_xor(ac.z, ofs); ac.w += __shfl_xor(ac.w, ofs); }
            float mx = fmaxf(fmaxf(ac.x, ac.y), fmaxf(ac.z, ac.w)); mx = fmaxf(mx, __shfl_xor(mx, 1)); mx = fmaxf(mx, __shfl_xor(mx, 2));
            f32x4 ex; ex.x = __expf(ac.x - mx); ex.y = __expf(ac.y - mx); ex.z = __expf(ac.z - mx); ex.w = __expf(ac.w - mx);
            float sum = (ex.x + ex.y) + (ex.z + ex.w); sum += __shfl_xor(sum, 1); sum += __shfl_xor(sum, 2);
            const float inv = 1.0f / sum;
            if (F.lane < 4) {
                if (m < MLAT) { const int b = m >> 12, s = m & 4095; float* p = AFL + ((size_t)(b * 16 + 4 * F.lane)) * 4096 + s; p[0] = ex.x * inv; p[4096] = ex.y * inv; p[2 * 4096] = ex.z * inv; p[3 * 4096] = ex.w * inv; }
                else { const int b = (m - MLAT) >> 8, s = (m - MLAT) & 255; float* p = AFC + ((size_t)(b * 16 + 4 * F.lane)) * 256 + s; p[0] = ex.x * inv; p[256] = ex.y * inv; p[512] = ex.z * inv; p[768] = ex.w * inv; }
            }
        }
    }
}

DI unsigned block_excl_scan(unsigned v, unsigned& total, LAS unsigned* wsum, int tid, int lane, int wave) {
    unsigned x = v;
#pragma unroll
    for (int o = 1; o < 64; o <<= 1) { const unsigned y = __shfl_up(x, o); if (lane >= o) x += y; }
    if (lane == 63) wsum[wave] = x;
    __syncthreads();
    unsigned base = 0, tot = 0;
#pragma unroll
    for (int w = 0; w < 8; ++w) { const unsigned s = wsum[w]; if (w < wave) base += s; tot += s; }
    __syncthreads();
    total = tot;
    return base + x - v;
}
DI void select_phase(Frame& F, KArgs ka, int l) {
    KA_FRESH(ka); const __attribute__((address_space(4))) Args& a = *ka; frame_fresh(F);
    const bool last = (l == NL - 1);
    const int nunits = last ? 128 : 256;
    LAS unsigned* hist = (LAS unsigned*)F.lds;
    LAS unsigned* wsum = (LAS unsigned*)(F.lds + 8192);
    LAS unsigned* bc = (LAS unsigned*)(F.lds + 8192 + 64);
    LAS int* sel = (LAS int*)(F.lds + 16384);
    const float* AFL = (const float*)(a.ws + WS_AFL); const float* AFC = (const float*)(a.ws + WS_AFC);
    int* smap = (int*)(a.ws + WS_SMAP); float* gate = (float*)(a.ws + WS_GATE);
    const unsigned char* H2 = a.ws + WS_H2; unsigned char* XG = a.ws + WS_XG;
    for (int unit = blockIdx.x; unit < nunits; unit += F.G) {
        const bool lat = unit < 128; const int be = unit & 127, b = be >> 4, e = be & 15;
        const int N = lat ? 4096 : 256, cap = lat ? CAP_LAT : CAP_CTX;
        const float* aff = lat ? AFL + (size_t)be * 4096 : AFC + (size_t)be * 256;
        unsigned key[8]; const int per = lat ? 8 : 1; const bool act = lat || F.tid < 256;
#pragma unroll
        for (int j = 0; j < 8; ++j) key[j] = (act && j < per) ? __float_as_uint(aff[F.tid * per + j]) : 0u;
        unsigned prefix = 0u, pmask = 0u, need = (unsigned)cap;
#pragma unroll
        for (int pass = 0; pass < 3; ++pass) {
            const int shift = pass == 0 ? 21 : (pass == 1 ? 10 : 0), nb = pass == 2 ? 1024 : 2048;
            for (int i = F.tid; i < 2048; i += 512) hist[i] = 0u;
            __syncthreads();
#pragma unroll
            for (int j = 0; j < 8; ++j) if (act && j < per && (key[j] & pmask) == prefix) (void)__hip_atomic_fetch_add(&hist[(key[j] >> shift) & (nb - 1)], 1u, __ATOMIC_RELAXED, __HIP_MEMORY_SCOPE_WORKGROUP);
            __syncthreads();
            unsigned c4[4], mine = 0;
#pragma unroll
            for (int j = 0; j < 4; ++j) { const int bin = 2047 - 4 * F.tid - j; c4[j] = bin < nb ? hist[bin] : 0u; mine += c4[j]; }
            unsigned tot; unsigned run = block_excl_scan(mine, tot, wsum, F.tid, F.lane, F.wave);
#pragma unroll
            for (int j = 0; j < 4; ++j) { const int bin = 2047 - 4 * F.tid - j;
                if (bin < nb && run < need && run + c4[j] >= need) { bc[0] = (unsigned)bin; bc[1] = run; }
                run += c4[j]; }
            __syncthreads();
            const unsigned cb = bc[0], above = bc[1];
            prefix |= cb << shift; pmask |= (unsigned)(nb - 1) << shift; need -= above;
            __syncthreads();
        }
        unsigned neq = 0, ngt = 0;
#pragma unroll
        for (int j = 0; j < 8; ++j) if (act && j < per) { neq += key[j] == prefix; ngt += key[j] > prefix; }
        unsigned teq; const unsigned eqbase = block_excl_scan(neq, teq, wsum, F.tid, F.lane, F.wave);
        unsigned nsel = 0, flags = 0, erun = eqbase;
#pragma unroll
        for (int j = 0; j < 8; ++j) if (act && j < per) { bool s = key[j] > prefix; if (key[j] == prefix) { s = erun < need; ++erun; } if (s) { flags |= 1u << j; ++nsel; } }
        unsigned tsel; unsigned sbase = block_excl_scan(nsel, tsel, wsum, F.tid, F.lane, F.wave);
        const int rowbase = lat ? b * SEQ : MLAT + b * CTX;
        const int slotbase = lat ? be * CAP_LAT : NSLOT_LAT + (e * 8 + b) * CAP_CTX;
#pragma unroll
        for (int j = 0; j < 8; ++j) if (act && j < per) { const int tok = F.tid * per + j; int slot = -1;
            if ((flags >> j) & 1u) { slot = slotbase + (int)sbase; sel[sbase] = tok; gate[slot] = __uint_as_float(key[j]); ++sbase; }
            smap[(size_t)e * MT + rowbase + tok] = slot; }
        __syncthreads();
        if (lat) {
            for (int t0 = F.wave * 16; t0 < cap; t0 += 128) {
                u32x4 rowv[16];
#pragma unroll
                for (int q = 0; q < 16; ++q) rowv[q] = ((const u32x4*)(H2 + (size_t)(rowbase + sel[t0 + q]) * D))[F.lane];
#pragma unroll
                for (int q = 0; q < 16; ++q) ((u32x4*)(XG + (size_t)(slotbase + t0 + q) * D))[F.lane] = rowv[q];
            }
        } else {
            const int t0 = F.wave * 4;
            u32x4 rowv[4];
#pragma unroll
            for (int q = 0; q < 4; ++q) rowv[q] = ((const u32x4*)(H2 + (size_t)(rowbase + sel[t0 + q]) * D))[F.lane];
#pragma unroll
            for (int q = 0; q < 4; ++q) ((u32x4*)(XG + (size_t)(slotbase + t0 + q) * D))[F.lane] = rowv[q];
        }
        __syncthreads();
    }
}

DI unsigned char* ws_fresh(KArgs ka) { KA_FRESH(ka); return ka->ws; }
__global__ void __launch_bounds__(512, 2) mega_fwd(Args a_unused) {
    extern __shared__ __attribute__((aligned(16))) unsigned char lds_raw[];
    KArgs ka = (KArgs)__builtin_amdgcn_kernarg_segment_ptr();
    Frame F;
    F.lds = (LAS unsigned char*)lds_raw;
    F.tid = threadIdx.x; F.lane = F.tid & 63; F.wave = __builtin_amdgcn_readfirstlane(F.tid >> 6);
    F.G = gridDim.x; { const int bx = blockIdx.x; F.vcu = (F.G % 8 == 0) ? (bx % 8) * (F.G / 8) + bx / 8 : bx; }
    F.gw = F.vcu * 8 + F.wave; F.ngw = F.G * 8;
    for (int u = F.tid; u < (LDS_BYTES - LDSCTL_OFF) / 4; u += 512) ((LAS unsigned*)(F.lds + LDSCTL_OFF))[u] = 0u;
    __syncthreads();
    XcdBarrier bar = xcd_barrier_post((unsigned*)(ws_fresh(ka) + WS_CTL) + CW_BAR, (volatile LAS unsigned*)(F.lds + LDSCTL_OFF + 32));
#define GRID_BAR() xcd_barrier(bar)
    const int bx = blockIdx.x;

    if (PH(0)) modv_phase(F, ka);
    for (int rep_ = 0; rep_ < REPS(2); ++rep_) if (PH(2)) convert_weights(F, ka, 0);
    GRID_BAR();
    if (PH(3)) row_phase(F, ka, 0);
    GRID_BAR();

    for (int l = 0; l < NL; ++l) {
        const bool last = (l == NL - 1);
        const int nMe = last ? MLAT / 256 : MT / 256;
        const int nMs = last ? NSLOT_LAT / 256 : NSLOT / 256;
        for (int rep_ = 0; rep_ < REPS(4); ++rep_) if (PH(4)) { unsigned char* ws = ws_fresh(ka);
            { pg8::Gemm g{(const bf16_t*)(ws + WS_R4), (const bf16_t*)(ws + WS_W + W_IN), 1024, 1024, 1024, 0}; pg8::Order S; S.init(MT / 256, DINP / 256, F.G, bx);
              pg8::EpiStoreBf16 E{(bf16_t*)(ws + WS_HW), DINP}; pg8::gemm_phase(F.lds, g, S, E); }
            { pg8::Gemm g{(const bf16_t*)(ws + WS_R4 + 68 * MiB), (const bf16_t*)(ws + WS_W + W_GL), 1024, 1024, 1024, 0}; pg8::Order S; S.init(MT / 256, NGL / 256, F.G, (bx + F.G / 2) % F.G);
              pg8::EpiGate E{ws + WS_G}; pg8::gemm_phase<pg8::EpiGate, true>(F.lds, g, S, E); } }
        GRID_BAR();
        for (int rep_ = 0; rep_ < REPS(5); ++rep_) if (PH(5)) { unsigned char* ws = ws_fresh(ka); pg8::Gemm g{(const bf16_t*)(ws + WS_HW) + C_CQ, (const bf16_t*)(ws + WS_W + W_UP), 384, DINP, 384, 0}; pg8::Order S; S.init(MT / 256, UW / 256, F.G, bx);
            pg8::EpiStoreBf16 E{(bf16_t*)(ws + WS_R4), UW}; pg8::gemm_phase(F.lds, g, S, E); }
        for (int rep_ = 0; rep_ < REPS(6); ++rep_) if (PH(6)) prep_phase(F, ka, l);
        GRID_BAR();
        for (int rep_ = 0; rep_ < REPS(7); ++rep_) if (PH(7)) prep2_phase(F, ka, l, rep_);
        GRID_BAR();
        for (int rep_ = 0; rep_ < REPS(8); ++rep_) if (PH(8)) attn_phase(F, ka, l);
        GRID_BAR();
        for (int rep_ = 0; rep_ < REPS(9); ++rep_) if (PH(9)) { unsigned char* ws = ws_fresh(ka); pg8::Order S; S.init(nMe, 4, F.G, bx);
          const bf16_t* OC = (const bf16_t*)(ws + WS_OCAT); bf16_t* MG = (bf16_t*)(ws + WS_MERGED); const unsigned char* GL = ws + WS_G;
          { pg8::Gemm3 g{OC, OC + 384, OC + 896, (const bf16_t*)(ws + WS_W + W_NAO), (const bf16_t*)(ws + WS_W + W_MLAO), (const bf16_t*)(ws + WS_W + W_SWAO), OCW, 512}; pg8::EpiMerge3 E{MG, GL}; pg8::gemm_phase3(F.lds, g, S, E); } }
        GRID_BAR();
        if (PH(10)) { unsigned char* ws = ws_fresh(ka); pg8::Gemm g{(const bf16_t*)(ws + WS_MERGED), (const bf16_t*)(ws + WS_W + W_O), 1024, 1024, 1024, 0}; pg8::Order S; S.init(nMe, 4, F.G, bx);
            pg8::EpiResid E{(bf16_t*)(ws + WS_XS), (const float*)(ws + WS_MODV) + (size_t)l * 9 * 6144 + 2 * 1024}; pg8::gemm_phase(F.lds, g, S, E); }
        GRID_BAR();
        for (int rep_ = 0; rep_ < REPS(11); ++rep_) if (PH(11)) norm2_phase(F, ka, l, last ? MLAT : MT);
        GRID_BAR();
        for (int rep_ = 0; rep_ < REPS(12); ++rep_) if (PH(12)) select_phase(F, ka, l);
        GRID_BAR();
        for (int rep_ = 0; rep_ < REPS(13); ++rep_) if (PH(13)) { unsigned char* ws = ws_fresh(ka); pg8::Gemm g{(const bf16_t*)(ws + WS_XG), (const bf16_t*)(ws + WS_W + W_GU), 1024, 1024, 1024, (size_t)2048 * 1024}; pg8::Order S; S.init(nMs, 8, F.G, bx, 1);
            pg8::EpiSwiglu E{ws + WS_ACT}; pg8::gemm_phase<pg8::EpiSwiglu, true>(F.lds, g, S, E); }
        GRID_BAR();
        for (int rep_ = 0; rep_ < REPS(14); ++rep_) if (PH(14)) { unsigned char* ws = ws_fresh(ka); pg8::Gemm g{(const bf16_t*)(ws + WS_ACT), (const bf16_t*)(ws + WS_W + W_DN), 1024, 1024, 1024, (size_t)1024 * 1024}; pg8::Order S; S.init(nMs, 4, F.G, bx, 1);
            pg8::EpiDown E{(bf16_t*)(ws + WS_Y), (const float*)(ws + WS_GATE)}; pg8::gemm_phase<pg8::EpiDown, true>(F.lds, g, S, E); }
        GRID_BAR();
        for (int rep_ = 0; rep_ < REPS(15); ++rep_) if (PH(15)) row_phase(F, ka, l + 1, rep_);
        if (!last) { for (int rep_ = 0; rep_ < REPS(16); ++rep_) if (PH(16)) convert_weights(F, ka, l + 1); GRID_BAR(); }
    }
}

extern "C" void kernel_launch(void* const* d_in, const int* in_sizes, int n_in, void* d_out, int out_size, void* d_ws, size_t ws_size, hipStream_t stream) {
    static int grid = 0;
    if (grid == 0) {
        if (n_in != 29 || in_sizes[0] != MLAT * D || out_size != MLAT * D || ws_size < WS_END) {
            fprintf(stderr, "kernel_launch: unexpected problem: n_in %d in0 %d out %d ws %zu (need %zu)\n", n_in, n_in > 0 ? in_sizes[0] : -1, out_size, ws_size, (size_t)WS_END); grid = -1; return; }
        int dev = 0, cus = 0, per_cu = 0;
        if (hipGetDevice(&dev) != hipSuccess || hipDeviceGetAttribute(&cus, hipDeviceAttributeMultiprocessorCount, dev) != hipSuccess) { fprintf(stderr, "kernel_launch: device query failed\n"); grid = -1; return; }
        if (hipFuncSetAttribute((const void*)mega_fwd, hipFuncAttributeMaxDynamicSharedMemorySize, LDS_BYTES) != hipSuccess) { fprintf(stderr, "kernel_launch: hipFuncSetAttribute failed\n"); grid = -1; return; }
        if (hipOccupancyMaxActiveBlocksPerMultiprocessor(&per_cu, (const void*)mega_fwd, 512, LDS_BYTES) != hipSuccess || per_cu < 1) {
            fprintf(stderr, "kernel_launch: occupancy query reports %d workgroups per CU\n", per_cu); }
        (void)hipGetLastError();
        grid = cus;
    }
    if (grid < 0) return;
    if (hipMemsetAsync((char*)d_ws + WS_CTL, 0, CTL_BYTES, stream) != hipSuccess) { fprintf(stderr, "kernel_launch: memset failed\n"); return; }
    Args a{};
    for (int i = 0; i < 29; ++i) a.in[i] = (const float*)d_in[i];
    a.out = (float*)d_out; a.ws = (unsigned char*)d_ws;
    hipLaunchKernelGGL(mega_fwd, dim3(grid), dim3(512), LDS_BYTES, stream, a);
    const hipError_t le = hipPeekAtLastError();
    if (le != hipSuccess) fprintf(stderr, "kernel_launch: launch failed: %s\n", hipGetErrorName(le));
}
```

```cpp
#include <hip/hip_runtime.h>
#include <cstdio>
#include <cstdint>

#define DI __device__ __forceinline__
#ifndef PH_MASK
#define PH_MASK 0xFFFFF
#endif
#define PH(b) ((PH_MASK >> (b)) & 1)
#ifndef REP_MASK
#define REP_MASK 0
#endif
#define REPS(b) (1 + ((REP_MASK >> (b)) & 1))
#define LAS __attribute__((address_space(3)))
#define GAS __attribute__((address_space(1)))
typedef unsigned short bf16_t;
typedef short bf16x8 __attribute__((ext_vector_type(8)));
typedef short s16x4 __attribute__((ext_vector_type(4)));
typedef float f32x4 __attribute__((ext_vector_type(4)));
typedef float f32x2 __attribute__((ext_vector_type(2)));
typedef float f32x16 __attribute__((ext_vector_type(16)));
typedef unsigned u32x4 __attribute__((ext_vector_type(4)));
typedef unsigned u32x2 __attribute__((ext_vector_type(2)));
typedef int i32x8 __attribute__((ext_vector_type(8)));

constexpr int D = 1024, NB = 8, SEQ = 4096, NL = 4, CTX = 256;
constexpr int MLAT = NB * SEQ, MCTX = NB * CTX, MT = MLAT + MCTX;
constexpr int DIN = 5312, DINP = 2304, NGL = 3072;
constexpr int C_NAQ = 0, C_NAK = 384, C_NAV = 768, C_CQ = 1152, C_CKV = 1408, C_KR = 1536, C_SWQ = 1600, C_SWK = 1984, C_SWV = 2112, C_GL = 2240;
constexpr int UW = 1792;
constexpr int P1W = 1280;
constexpr int P2W = 1536;
constexpr int OCW = 1280;
constexpr int NE = 16, CAP_LAT = 512, CAP_CTX = 32;
constexpr int NSLOT_LAT = NB * NE * CAP_LAT, NSLOT = NSLOT_LAT + NB * NE * CAP_CTX;
constexpr float EPS = 1e-6f;
constexpr float LOG2E = 1.4426950408889634f;

constexpr size_t MiB = 1u << 20;
constexpr size_t WS_CTL = 0, CTL_BYTES = 1 * MiB;
constexpr size_t WS_MODV = 1 * MiB;
constexpr size_t WS_W = 2 * MiB;
constexpr size_t W_IN = 0, W_GL = 4718592  , W_UP = 11010048, W_NAO = 7864320  , W_MLAO = 13172736, W_SWAO = 8912896  , W_O = 15007744, W_GU = 17104896, W_DN = 84213760, W_END = 117768192;
constexpr size_t WS_XS = 115 * MiB;
constexpr size_t WS_HW = 251 * MiB;
constexpr size_t WS_G = WS_HW + 153 * MiB;
constexpr size_t WS_P1 = 608 * MiB;
constexpr size_t WS_P2 = 693 * MiB;
constexpr size_t WS_R4 = 795 * MiB;
constexpr size_t WS_AFL = 914 * MiB;
constexpr size_t WS_AFC = 916 * MiB;
constexpr size_t WS_SMAP = 917 * MiB;
constexpr size_t WS_GATE = 920 * MiB;
constexpr size_t WS_OCAT = 921 * MiB;
constexpr size_t WS_END = 1006 * MiB;
constexpr size_t WS_MERGED = WS_P1;
constexpr size_t WS_H2 = WS_HW;
constexpr size_t WS_XG = WS_HW + 68 * MiB;
constexpr size_t WS_ACT = WS_HW + 204 * MiB;
constexpr size_t WS_Y = WS_HW + 340 * MiB;
static_assert(W_END <= 113 * MiB && WS_W + 113 * MiB <= WS_XS, "weights");
static_assert(WS_XS + (size_t)MT * D * 4 <= WS_HW && WS_HW + (size_t)MT * DINP * 2 <= WS_G && WS_G + (size_t)MT * NGL * 2 <= WS_P1 && WS_P1 + (size_t)MT * P1W * 2 <= WS_P2 && WS_P2 + (size_t)MT * P2W * 2 <= WS_R4, "map");
static_assert(WS_R4 + (size_t)MT * UW * 2 <= WS_AFL && WS_Y + (size_t)NSLOT * D * 2 <= WS_R4 && WS_SMAP + (size_t)16 * MT * 4 <= WS_GATE && WS_GATE + (size_t)NSLOT * 4 <= WS_OCAT && WS_OCAT + (size_t)MT * OCW * 2 <= WS_END, "map2");
constexpr int CW_BAR = 4096;

constexpr int RING_BYTES = 131072, LDSCTL_OFF = RING_BYTES, LDS_BYTES = 147456;

DI unsigned pk2(float lo, float hi) { unsigned r; asm("v_cvt_pk_bf16_f32 %0, %1, %2" : "=v"(r) : "v"(lo), "v"(hi)); return r; }
DI unsigned pk4_fp8(float a, float b, float c, float d) { int w = 0; w = __builtin_amdgcn_cvt_pk_fp8_f32(a, b, w, false); w = __builtin_amdgcn_cvt_pk_fp8_f32(c, d, w, true); return (unsigned)w; }
DI float bflo(unsigned w) { return __uint_as_float(w << 16); }
DI float bfhi(unsigned w) { return __uint_as_float(w & 0xffff0000u); }
DI float bf2f(bf16_t b) { return __uint_as_float((unsigned)b << 16); }
DI float wave_sum(float v) {
#pragma unroll
    for (int o = 1; o < 64; o <<= 1) v += __shfl_xor(v, o);
    return v;
}
DI float sigmoidf_(float x) { return __builtin_amdgcn_rcpf(1.0f + __builtin_amdgcn_exp2f(-x * LOG2E)); }
DI int mod_index(int row) { return row < MLAT ? (row >> 12) : 8; }

#define XB_TMO      128
#define XB_XCNT(j)  (256  + 64 * (j))
#define XB_XSUB(j)  (1280 + 64 * (j))
#define XB_XGEN(j)  (2304 + 64 * (j))
#define XB_TOP      3328
#define XB_TOPGEN   3392
#define XCD_BAR_WORDS 3456
#define XB_SPIN_CAP (1u << 18)
DI unsigned xb_ld(unsigned* p)              { return __hip_atomic_load(p, __ATOMIC_RELAXED, __HIP_MEMORY_SCOPE_AGENT); }
DI unsigned xb_add(unsigned* p, unsigned v) { return __hip_atomic_fetch_add(p, v, __ATOMIC_RELAXED, __HIP_MEMORY_SCOPE_AGENT); }
DI unsigned xb_xcc_id() { return (unsigned)__builtin_amdgcn_s_getreg((3 << 11) | 20) & 0xFu; }
#define XB_SPIN(cond, bar) do { unsigned _sp = 0; while (cond) { __builtin_amdgcn_s_sleep(1); \
    if ((++_sp & 255u) == 0u) { if (xb_ld(&(bar)[XB_TMO])) break; if (_sp > XB_SPIN_CAP) { atomicAdd(&(bar)[XB_TMO], 1u); break; } } } } while (0)
struct XcdBarrier { unsigned* bar; unsigned x; volatile LAS unsigned* st; };
DI XcdBarrier xcd_barrier_post(unsigned* bar, volatile LAS unsigned* st) {
    XcdBarrier b; b.bar = bar; b.x = xb_xcc_id(); b.st = st;
    if (threadIdx.x == 0) (void)xb_add(&bar[XB_XCNT(b.x)], 1u);
    return b;
}
DI void xcd_barrier_complete(unsigned* bar, unsigned x, unsigned& nloc, unsigned& nx) {
    const unsigned G = gridDim.x * gridDim.y * gridDim.z;
    unsigned sum, cnt, mine, sp = 0u;
    for (;;) {
        sum = 0u; cnt = 0u; mine = 0u;
#pragma unroll
        for (unsigned j = 0; j < 16; ++j) { const unsigned c = xb_ld(&bar[XB_XCNT(j)]); sum += c; cnt += (c > 0u) ? 1u : 0u; mine = (j == x) ? c : mine; }
        if (sum == G) break;
        __builtin_amdgcn_s_sleep(1);
        if ((++sp & 255u) == 0u) { if (xb_ld(&bar[XB_TMO])) break; if (sp > XB_SPIN_CAP) { atomicAdd(&bar[XB_TMO], 1u); break; } }
    }
    nloc = mine > 0u ? mine : 1u; nx = cnt > 0u ? cnt : 1u;
}
DI void xcd_barrier(const XcdBarrier& b) {
    asm volatile("s_waitcnt vmcnt(0)" ::: "memory");
    __syncthreads();
    if (threadIdx.x == 0) {
        unsigned* bar = b.bar; asm volatile("" : "+s"(bar));
        __builtin_amdgcn_s_waitcnt(0);
        unsigned nloc = b.st[0], nx = b.st[1];
        if (nloc == 0u) { xcd_barrier_complete(bar, b.x, nloc, nx); b.st[0] = nloc; b.st[1] = nx; }
        const unsigned old = xb_add(&bar[XB_XSUB(b.x)], 1u);
        const unsigned gen = old / nloc;
        if (old + 1u == (gen + 1u) * nloc) {
            __builtin_amdgcn_fence(__ATOMIC_RELEASE, "agent");
            asm volatile("s_waitcnt vmcnt(0)" ::: "memory");
            const unsigned og = xb_add(&bar[XB_TOP], 1u);
            const unsigned tg = og / nx;
            if (og + 1u == (tg + 1u) * nx) xb_add(&bar[XB_TOPGEN], 1u);
            else XB_SPIN(xb_ld(&bar[XB_TOPGEN]) == tg, bar);
            __builtin_amdgcn_fence(__ATOMIC_ACQUIRE, "agent");
            xb_add(&bar[XB_XGEN(b.x)], 1u);
            asm volatile("s_waitcnt vmcnt(0)" ::: "memory");
        } else {
            XB_SPIN(xb_ld(&bar[XB_XGEN(b.x)]) == gen, bar);
            __builtin_amdgcn_fence(__ATOMIC_ACQUIRE, "agent");
            asm volatile("s_waitcnt vmcnt(0)" ::: "memory");
        }
    }
    __syncthreads();
}

namespace pg8 {
constexpr int BM = 256, BK = 64, HALF = 128, HTB = HALF * BK * 2, NXCD = 8, WGM = 4;
__host__ __device__ __forceinline__ int lds_byte(int r, int c) { const int st = (r >> 4) * 2 + (c >> 5), rr = r & 15, cc = c & 31, ob = rr * 64 + cc * 2; return st * 1024 + (ob ^ (((ob >> 9) & 1) << 5)); }
__host__ __device__ __forceinline__ void stage_rc(int b, int& R, int& C) { const int st = b / 1024, sb = b % 1024, swz = sb ^ (((sb >> 9) & 1) << 5); R = (st >> 1) * 16 + swz / 64; C = (st & 1) * 32 + (swz % 64) / 2; }
__host__ __device__ __forceinline__ int perm32(int rho) { const int n = rho >> 4, i = rho & 15; return 8 * (i >> 2) + 4 * n + (i & 3); }
struct Unit { int pm, pn; };
struct Gemm { const bf16_t* A; const bf16_t* Bt; int K, lda, ldb; size_t estride; };
struct Order {
    int nM, nN, nwg, G, c, moe;
    DI void init(int nM_, int nN_, int G_, int c_, int moe_ = 0) { nM = nM_; nN = nN_; nwg = nM * nN; G = G_; c = c_; moe = moe_; }
    DI bool next(int i, Unit& u) const {
        const long L = (long)i * G + c; if (L >= nwg) return false;
        int wgid = (int)L; { const int q = nwg / NXCD, r = nwg % NXCD, xcd = wgid % NXCD, off = wgid / NXCD; wgid = (xcd < r ? xcd * (q + 1) : r * (q + 1) + (xcd - r) * q) + off; }
        const int nig = WGM * nN, gid = wgid / nig, fm = gid * WGM, gsz = (nM - fm) < WGM ? (nM - fm) : WGM;
        u.pm = fm + ((wgid % nig) % gsz); u.pn = (wgid % nig) / gsz;
        if (moe && u.pm < 256) { const int e = u.pm >> 4, b = (u.pm >> 1) & 7, hf = u.pm & 1; u.pm = (((b << 4) | e) << 1) | hf; }
        return true;
    }
};
struct EpiStoreBf16 {
    static constexpr bool PERM = true;
    bf16_t* O; int ldc;
    DI void operator()(const f32x4 (&acc)[2][2][4][2], const Unit& u, int wr, int wc, int fr, int fq) const {
        const int row0 = u.pm * BM + wr * 64 + fr, col0 = u.pn * BM + wc * 32 + 8 * fq;
#pragma unroll
        for (int ai = 0; ai < 2; ++ai)
#pragma unroll
            for (int m = 0; m < 4; ++m) { bf16_t* rowp = O + (size_t)(row0 + ai * HALF + m * 16) * ldc + col0;
#pragma unroll
                for (int bj = 0; bj < 2; ++bj) { const f32x4 v0 = acc[ai][bj][m][0], v1 = acc[ai][bj][m][1];
                    u32x4 w; w.x = pk2(v0[0], v0[1]); w.y = pk2(v0[2], v0[3]); w.z = pk2(v1[0], v1[1]); w.w = pk2(v1[2], v1[3]);
                    *(u32x4*)(rowp + bj * HALF) = w; } }
    }
};
DI unsigned pk4_u8(float a, float b, float c, float d) {
    unsigned ua = (unsigned)(a * 255.0f + 0.5f), ub = (unsigned)(b * 255.0f + 0.5f), uc = (unsigned)(c * 255.0f + 0.5f), ud = (unsigned)(d * 255.0f + 0.5f);
    ua = ua < 1u ? 1u : ua; ub = ub < 1u ? 1u : ub; uc = uc < 1u ? 1u : uc; ud = ud < 1u ? 1u : ud;
    return ua | (ub << 8) | (uc << 16) | (ud << 24);
}
struct EpiGate {
    static constexpr bool PERM = true;
    unsigned char* O;
    DI void operator()(const f32x4 (&acc)[2][2][4][2], const Unit& u, int wr, int wc, int fr, int fq) const {
        const int row0 = u.pm * BM + wr * 64 + fr, col0 = u.pn * BM + wc * 32 + 8 * fq;
#pragma unroll
        for (int ai = 0; ai < 2; ++ai)
#pragma unroll
            for (int m = 0; m < 4; ++m) { unsigned char* rowp = O + (size_t)(row0 + ai * HALF + m * 16) * NGL + col0;
#pragma unroll
                for (int bj = 0; bj < 2; ++bj) { const f32x4 v0 = acc[ai][bj][m][0] * 0.03125f, v1 = acc[ai][bj][m][1] * 0.03125f;
                    u32x2 w; w.x = pk4_u8(sigmoidf_(v0[0]), sigmoidf_(v0[1]), sigmoidf_(v0[2]), sigmoidf_(v0[3])); w.y = pk4_u8(sigmoidf_(v1[0]), sigmoidf_(v1[1]), sigmoidf_(v1[2]), sigmoidf_(v1[3]));
                    *(u32x2*)(rowp + bj * HALF) = w; } }
    }
};
DI float u8f(unsigned w, int k) { return (float)((w >> (8 * k)) & 0xffu) * (1.0f / 255.0f); }
struct EpiMerge {
    static constexpr bool PERM = true;
    bf16_t* O; const unsigned char* gl; int first;
    DI void operator()(const f32x4 (&acc)[2][2][4][2], const Unit& u, int wr, int wc, int fr, int fq) const {
        const int row0 = u.pm * BM + wr * 64 + fr, col0 = u.pn * BM + wc * 32 + 8 * fq;
#pragma unroll
        for (int ai = 0; ai < 2; ++ai) {
            u32x2 g[4][2]; u32x4 p[4][2];
#pragma unroll
            for (int m = 0; m < 4; ++m)
#pragma unroll
                for (int bj = 0; bj < 2; ++bj) { const int row = row0 + ai * HALF + m * 16, col = col0 + bj * HALF;
                    g[m][bj] = *(const u32x2*)(gl + (size_t)row * NGL + col);
                    p[m][bj] = first ? (u32x4){0u, 0u, 0u, 0u} : *(const u32x4*)(O + (size_t)row * D + col); }
#pragma unroll
            for (int m = 0; m < 4; ++m)
#pragma unroll
                for (int bj = 0; bj < 2; ++bj) { const int row = row0 + ai * HALF + m * 16, col = col0 + bj * HALF;
                    const u32x2 gg = g[m][bj]; const u32x4 pp = p[m][bj]; const f32x4 v0 = acc[ai][bj][m][0], v1 = acc[ai][bj][m][1];
                    const float r0 = v0[0] * u8f(gg.x, 0) + bflo(pp.x), r1 = v0[1] * u8f(gg.x, 1) + bfhi(pp.x), r2 = v0[2] * u8f(gg.x, 2) + bflo(pp.y), r3 = v0[3] * u8f(gg.x, 3) + bfhi(pp.y);
                    const float r4 = v1[0] * u8f(gg.y, 0) + bflo(pp.z), r5 = v1[1] * u8f(gg.y, 1) + bfhi(pp.z), r6 = v1[2] * u8f(gg.y, 2) + bflo(pp.w), r7 = v1[3] * u8f(gg.y, 3) + bfhi(pp.w);
                    u32x4 w; w.x = pk2(r0, r1); w.y = pk2(r2, r3); w.z = pk2(r4, r5); w.w = pk2(r6, r7);
                    *(u32x4*)(O + (size_t)row * D + col) = w; }
        }
    }
};
struct EpiResid {
    static constexpr bool PERM = true;
    bf16_t* xs; const float* modg;
    DI void operator()(const f32x4 (&acc)[2][2][4][2], const Unit& u, int wr, int wc, int fr, int fq) const {
        const int row0 = u.pm * BM + wr * 64 + fr, col0 = u.pn * BM + wc * 32 + 8 * fq;
        const float* mp = modg + (size_t)mod_index(u.pm * BM) * 6144 + col0;
        f32x4 g0[2], g1[2];
#pragma unroll
        for (int bj = 0; bj < 2; ++bj) { g0[bj] = *(const f32x4*)(mp + bj * HALF); g1[bj] = *(const f32x4*)(mp + bj * HALF + 4); }
#pragma unroll
        for (int ai = 0; ai < 2; ++ai) {
            u32x4 xw[4][2];
#pragma unroll
            for (int m = 0; m < 4; ++m)
#pragma unroll
                for (int bj = 0; bj < 2; ++bj) xw[m][bj] = *(const u32x4*)(xs + (size_t)(row0 + ai * HALF + m * 16) * D + col0 + bj * HALF);
#pragma unroll
            for (int m = 0; m < 4; ++m)
#pragma unroll
                for (int bj = 0; bj < 2; ++bj) { const u32x4 x = xw[m][bj];
                    const f32x4 x0 = (f32x4){bflo(x.x), bfhi(x.x), bflo(x.y), bfhi(x.y)} + g0[bj] * acc[ai][bj][m][0];
                    const f32x4 x1 = (f32x4){bflo(x.z), bfhi(x.z), bflo(x.w), bfhi(x.w)} + g1[bj] * acc[ai][bj][m][1];
                    u32x4 w; w.x = pk2(x0[0], x0[1]); w.y = pk2(x0[2], x0[3]); w.z = pk2(x1[0], x1[1]); w.w = pk2(x1[2], x1[3]);
                    *(u32x4*)(xs + (size_t)(row0 + ai * HALF + m * 16) * D + col0 + bj * HALF) = w; }
        }
    }
};
struct EpiSwiglu {
    static constexpr bool PERM = true;
    unsigned char* O;
    DI void operator()(const f32x4 (&acc)[2][2][4][2], const Unit& u, int wr, int wc, int fr, int fq) const {
        const int row0 = u.pm * BM + wr * 64 + fr, col0 = u.pn * HALF + wc * 32 + 8 * fq;
#pragma unroll
        for (int ai = 0; ai < 2; ++ai)
#pragma unroll
            for (int m = 0; m < 4; ++m) { const int row = row0 + ai * HALF + m * 16;
                const f32x4 a0 = acc[ai][0][m][0] * 0.03125f, a1 = acc[ai][0][m][1] * 0.03125f, u0 = acc[ai][1][m][0] * 0.25f, u1 = acc[ai][1][m][1] * 0.25f;
                float r[8];
#pragma unroll
                for (int j = 0; j < 4; ++j) { r[j] = a0[j] * sigmoidf_(a0[j]) * u0[j]; r[4 + j] = a1[j] * sigmoidf_(a1[j]) * u1[j]; }
                u32x2 w; w.x = pk4_fp8(r[0], r[1], r[2], r[3]); w.y = pk4_fp8(r[4], r[5], r[6], r[7]);
                *(u32x2*)(O + (size_t)row * D + col0) = w; }
    }
};
struct EpiDown {
    static constexpr bool PERM = true;
    bf16_t* O; const float* gate;
    DI void operator()(const f32x4 (&acc)[2][2][4][2], const Unit& u, int wr, int wc, int fr, int fq) const {
        const int row0 = u.pm * BM + wr * 64 + fr, col0 = u.pn * BM + wc * 32 + 8 * fq;
        float gv[2][4];
#pragma unroll
        for (int ai = 0; ai < 2; ++ai)
#pragma unroll
            for (int m = 0; m < 4; ++m) gv[ai][m] = gate[row0 + ai * HALF + m * 16] * (1.0f / 256.0f);
#pragma unroll
        for (int ai = 0; ai < 2; ++ai)
#pragma unroll
            for (int m = 0; m < 4; ++m) { const int row = row0 + ai * HALF + m * 16; const float g = gv[ai][m]; bf16_t* rowp = O + (size_t)row * D + col0;
#pragma unroll
                for (int bj = 0; bj < 2; ++bj) { const f32x4 v0 = acc[ai][bj][m][0] * g, v1 = acc[ai][bj][m][1] * g;
                    u32x4 w; w.x = pk2(v0[0], v0[1]); w.y = pk2(v0[2], v0[3]); w.z = pk2(v1[0], v1[1]); w.w = pk2(v1[2], v1[3]);
                    *(u32x4*)(rowp + bj * HALF) = w; } }
    }
};

struct EpiMerge3 {
    static constexpr bool PERM = true;
    bf16_t* O; const unsigned char* gl;
    DI void operator()(f32x4 (&acc)[2][2][4][2], const Unit& u, int seg, int wr, int wc, int fr, int fq) const {
        const int row0 = u.pm * BM + wr * 64 + fr, col0 = u.pn * BM + wc * 32 + 8 * fq;
#pragma unroll
        for (int ai = 0; ai < 2; ++ai) {
            u32x2 ga[4][2], gb[4][2];
#pragma unroll
            for (int m = 0; m < 4; ++m)
#pragma unroll
                for (int bj = 0; bj < 2; ++bj) { const unsigned char* gp = gl + (size_t)(row0 + ai * HALF + m * 16) * NGL + 1024 * seg + col0 + bj * HALF;
                    ga[m][bj] = *(const u32x2*)gp; gb[m][bj] = seg < 2 ? *(const u32x2*)(gp + 1024) : (u32x2){0u, 0u}; }
#pragma unroll
            for (int m = 0; m < 4; ++m)
#pragma unroll
                for (int bj = 0; bj < 2; ++bj) {
                    f32x4 s0, s1;
#pragma unroll
                    for (int k = 0; k < 4; ++k) { const float a0 = (float)((ga[m][bj].x >> (8 * k)) & 0xffu), a1 = (float)((ga[m][bj].y >> (8 * k)) & 0xffu);
                        if (seg < 2) { const float b0 = (float)((gb[m][bj].x >> (8 * k)) & 0xffu), b1 = (float)((gb[m][bj].y >> (8 * k)) & 0xffu); s0[k] = a0 * __builtin_amdgcn_rcpf(b0); s1[k] = a1 * __builtin_amdgcn_rcpf(b1); }
                        else { s0[k] = a0 * (1.0f / 255.0f); s1[k] = a1 * (1.0f / 255.0f); } }
                    acc[ai][bj][m][0] *= s0; acc[ai][bj][m][1] *= s1;
                    if (seg == 2) { const f32x4 v0 = acc[ai][bj][m][0], v1 = acc[ai][bj][m][1];
                        u32x4 w; w.x = pk2(v0[0], v0[1]); w.y = pk2(v0[2], v0[3]); w.z = pk2(v1[0], v1[1]); w.w = pk2(v1[2], v1[3]);
                        *(u32x4*)(O + (size_t)(row0 + ai * HALF + m * 16) * D + col0 + bj * HALF) = w; }
                }
        }
    }
};
struct Gemm3 { const bf16_t* A0; const bf16_t* A1; const bf16_t* A2; const bf16_t* B0; const bf16_t* B1; const bf16_t* B2; int lda, ldb; };
template <class Epi>
DI void gemm_phase3(LAS unsigned char* lds, const Gemm3 g, const Order& S, const Epi& E) {
    int tid_ = threadIdx.x; asm volatile("" : "+v"(tid_));
    const int tid = tid_, wid = __builtin_amdgcn_readfirstlane(tid >> 6), lane = tid & 63, wr = wid >> 2, wc = wid & 3, fr = lane & 15, fq = lane >> 4;
    unsigned voffA[2], voffB[2];
#pragma unroll
    for (int i = 0; i < 2; ++i) { int R, C; stage_rc(tid * 16 + i * 8192, R, C); const int Rb = Epi::PERM ? ((R & ~31) + perm32(R & 31)) : R;
        voffA[i] = (unsigned)(R * g.lda * 2 + C * 2); voffB[i] = (unsigned)(Rb * g.ldb * 2 + C * 2); }
    const size_t kstep = (size_t)(BK * 2);
    const size_t hstepA = (size_t)HALF * g.lda * 2, hstepB = (size_t)HALF * g.ldb * 2;
    const size_t tstepA = 2 * hstepA, tstepB = 2 * hstepB;
    const unsigned ldsw = (unsigned)wid * 1024u;
    const int aoff = lds_byte(wr * 64 + fr, fq * 8), boff = lds_byte(wc * 32 + fr, fq * 8);
#define PG8_SA(b, h) (((b) * 2 + (h)) * HTB)
#define PG8_SB(b, h) ((4 + (b) * 2 + (h)) * HTB)
#define PG8_STAGE(bufoff, gbase, voff) do { _Pragma("unroll") for (int _i = 0; _i < 2; ++_i) \
        __builtin_amdgcn_global_load_lds((const unsigned*)((const char*)(gbase) + (voff)[_i]), (LAS unsigned*)(lds + (bufoff) + ldsw + _i * 8192), 16, 0, 0); } while (0)
#define PG8_LDA(dst, b, h) do { _Pragma("unroll") for (int m = 0; m < 4; ++m) _Pragma("unroll") for (int k = 0; k < 2; ++k) dst[m][k] = *(const LAS bf16x8*)(lds + PG8_SA(b, h) + aoff + m * 2048 + k * 1024); } while (0)
#define PG8_LDB(dst, b, h) do { _Pragma("unroll") for (int n = 0; n < 2; ++n) _Pragma("unroll") for (int k = 0; k < 2; ++k) dst[n][k] = *(const LAS bf16x8*)(lds + PG8_SB(b, h) + boff + n * 2048 + k * 1024); } while (0)
#define PG8_MMA(ai, bj, At, Bt) do { __builtin_amdgcn_s_setprio(1); _Pragma("unroll") for (int m = 0; m < 4; ++m) _Pragma("unroll") for (int n = 0; n < 2; ++n) _Pragma("unroll") for (int k = 0; k < 2; ++k) \
        acc[ai][bj][m][n] = __builtin_amdgcn_mfma_f32_16x16x32_bf16(Bt[n][k], At[m][k], acc[ai][bj][m][n], 0, 0, 0); __builtin_amdgcn_s_setprio(0); } while (0)
#define PG8_WAIT_V(n) asm volatile("s_waitcnt vmcnt(" #n ")" ::: "memory")
#define PG8_WAIT_L(n) asm volatile("s_waitcnt lgkmcnt(" #n ")" ::: "memory")
#define PG8_BAR __builtin_amdgcn_s_barrier()
#define PG8_SCHED __builtin_amdgcn_sched_barrier(0)
#define PG8_A3(sg, u) ((const char*)((sg) == 0 ? g.A0 : (sg) == 1 ? g.A1 : g.A2) + (size_t)(u).pm * tstepA)
#define PG8_B3(sg, u) ((const char*)((sg) == 0 ? g.B0 : (sg) == 1 ? g.B1 : g.B2) + (size_t)(u).pn * tstepB)
    Unit cur, nu; int ui = 0, seg = 0;
    if (!S.next(0, cur)) return;
    f32x4 acc[2][2][4][2];
#pragma unroll
    for (int a = 0; a < 2; ++a)
#pragma unroll
        for (int b = 0; b < 2; ++b)
#pragma unroll
            for (int m = 0; m < 4; ++m)
#pragma unroll
                for (int n = 0; n < 2; ++n) acc[a][b][m][n] = (f32x4){0.f, 0.f, 0.f, 0.f};
    bf16x8 At[4][2], B0[2][2], B1[2][2];
    const char* cA = PG8_A3(0, cur); const char* cB = PG8_B3(0, cur);
    PG8_STAGE(PG8_SB(0, 0), cB, voffB); PG8_STAGE(PG8_SB(0, 1), cB + hstepB, voffB); PG8_STAGE(PG8_SA(0, 0), cA, voffA); PG8_STAGE(PG8_SA(0, 1), cA + hstepA, voffA);
    if (wr == 1) PG8_BAR;
    PG8_WAIT_V(2); PG8_BAR;
    PG8_STAGE(PG8_SB(1, 0), cB + kstep, voffB); PG8_STAGE(PG8_SA(1, 0), cA + kstep, voffA); PG8_STAGE(PG8_SB(1, 1), cB + hstepB + kstep, voffB);
    PG8_WAIT_V(6); PG8_BAR;
    for (;;) {
        int nseg = seg + 1; bool has_next = true; nu = cur;
        if (nseg == 3) { nseg = 0; has_next = S.next(ui + 1, nu); }
        const char* nA = has_next ? PG8_A3(nseg, nu) : cA; const char* nB = has_next ? PG8_B3(nseg, nu) : cB;
        int nt_ = (seg == 1) ? 8 : 6; asm volatile("" : "+s"(nt_));
        const int nt = nt_;
#pragma nounroll
        for (int t = 0; t < nt; t += 2) {
            const bool last = (t == nt - 2);
            const char* a1 = cA + (size_t)(t + 1) * kstep;
            const char* a2 = last ? nA : cA + (size_t)(t + 2) * kstep; const char* b2 = last ? nB : cB + (size_t)(t + 2) * kstep;
            const char* a3 = a2 + kstep; const char* b3 = b2 + kstep;
            PG8_LDB(B0, 0, 0); PG8_LDB(B1, 0, 1); PG8_SCHED; PG8_LDA(At, 0, 0); PG8_STAGE(PG8_SA(1, 1), a1 + hstepA, voffA);
            PG8_WAIT_V(8); PG8_WAIT_L(0); PG8_BAR; PG8_MMA(0, 0, At, B0); PG8_MMA(0, 1, At, B1); PG8_BAR; PG8_SCHED;
            PG8_LDA(At, 0, 1); PG8_STAGE(PG8_SB(0, 0), b2, voffB); PG8_STAGE(PG8_SB(0, 1), b2 + hstepB, voffB); PG8_STAGE(PG8_SA(0, 0), a2, voffA);
            PG8_WAIT_V(8); PG8_WAIT_L(0); PG8_BAR; PG8_MMA(1, 0, At, B0); PG8_MMA(1, 1, At, B1); PG8_BAR; PG8_SCHED;
            PG8_LDB(B0, 1, 0); PG8_LDB(B1, 1, 1); PG8_SCHED; PG8_LDA(At, 1, 0); PG8_STAGE(PG8_SA(0, 1), a2 + hstepA, voffA);
            PG8_WAIT_V(8); PG8_WAIT_L(0); PG8_BAR; PG8_MMA(0, 0, At, B0); PG8_MMA(0, 1, At, B1); PG8_BAR; PG8_SCHED;
            PG8_LDA(At, 1, 1); PG8_STAGE(PG8_SB(1, 0), b3, voffB); PG8_STAGE(PG8_SB(1, 1), b3 + hstepB, voffB); PG8_STAGE(PG8_SA(1, 0), a3, voffA);
            PG8_WAIT_V(8); PG8_WAIT_L(0); PG8_BAR; PG8_MMA(1, 0, At, B0); PG8_MMA(1, 1, At, B1); PG8_BAR; PG8_SCHED;
        }
        if (wr == 0) PG8_BAR;
        E(acc, cur, seg, wr, wc, fr, fq);
        if (!has_next) break;
        if (seg == 2) {
#pragma unroll
            for (int a = 0; a < 2; ++a)
#pragma unroll
                for (int b = 0; b < 2; ++b)
#pragma unroll
                    for (int m = 0; m < 4; ++m)
#pragma unroll
                        for (int n = 0; n < 2; ++n) acc[a][b][m][n] = (f32x4){0.f, 0.f, 0.f, 0.f};
            cur = nu; ++ui;
        }
        seg = nseg; cA = nA; cB = nB;
        if (wr == 1) PG8_BAR;
    }
    PG8_WAIT_V(0);
    PG8_BAR;
#undef PG8_SA
#undef PG8_SB
#undef PG8_STAGE
#undef PG8_LDA
#undef PG8_LDB
#undef PG8_MMA
#undef PG8_WAIT_V
#undef PG8_WAIT_L
#undef PG8_BAR
#undef PG8_SCHED
#undef PG8_A3
#undef PG8_B3
}

template <class Epi, bool FP8 = false>
DI void gemm_phase(LAS unsigned char* lds, const Gemm g, const Order& S, const Epi& E) {
    constexpr int ESZ = FP8 ? 1 : 2;
    int tid_ = threadIdx.x; asm volatile("" : "+v"(tid_));
    const int tid = tid_, wid = __builtin_amdgcn_readfirstlane(tid >> 6), lane = tid & 63, wr = wid >> 2, wc = wid & 3, fr = lane & 15, fq = lane >> 4;
    const int K = g.K, nt = K * ESZ / (BK * 2);
    unsigned voffA[2], voffB[2];
#pragma unroll
    for (int i = 0; i < 2; ++i) { int R, C; stage_rc(tid * 16 + i * 8192, R, C); const int Rb = Epi::PERM ? ((R & ~31) + perm32(R & 31)) : R;
        voffA[i] = (unsigned)(R * g.lda * ESZ + C * 2); voffB[i] = (unsigned)(Rb * g.ldb * ESZ + C * 2); }
    const size_t kstep = (size_t)(BK * 2);
    const size_t hstepA = (size_t)HALF * g.lda * ESZ, hstepB = (size_t)HALF * g.ldb * ESZ;
    const size_t tstepA = 2 * hstepA, tstepB = 2 * hstepB;
    const unsigned ldsw = (unsigned)wid * 1024u;
    const int aoff = lds_byte(wr * 64 + fr, fq * 8), boff = lds_byte(wc * 32 + fr, fq * 8);
#define PG8_SA(b, h) (((b) * 2 + (h)) * HTB)
#define PG8_SB(b, h) ((4 + (b) * 2 + (h)) * HTB)
#define PG8_STAGE(bufoff, gbase, voff) do { _Pragma("unroll") for (int _i = 0; _i < 2; ++_i) \
        __builtin_amdgcn_global_load_lds((const unsigned*)((const char*)(gbase) + (voff)[_i]), (LAS unsigned*)(lds + (bufoff) + ldsw + _i * 8192), 16, 0, 0); } while (0)
#define PG8_LDA(dst, b, h) do { _Pragma("unroll") for (int m = 0; m < 4; ++m) _Pragma("unroll") for (int k = 0; k < 2; ++k) dst[m][k] = *(const LAS bf16x8*)(lds + PG8_SA(b, h) + aoff + m * 2048 + k * 1024); } while (0)
#define PG8_LDB(dst, b, h) do { _Pragma("unroll") for (int n = 0; n < 2; ++n) _Pragma("unroll") for (int k = 0; k < 2; ++k) dst[n][k] = *(const LAS bf16x8*)(lds + PG8_SB(b, h) + boff + n * 2048 + k * 1024); } while (0)
#define PG8_MMA(ai, bj, At, Bt) do { __builtin_amdgcn_s_setprio(1); _Pragma("unroll") for (int m = 0; m < 4; ++m) _Pragma("unroll") for (int n = 0; n < 2; ++n) { \
        if constexpr (FP8) { const i32x8 bb_ = __builtin_bit_cast(i32x8, __builtin_shufflevector(Bt[n][0], Bt[n][1], 0, 1, 2, 3, 4, 5, 6, 7, 8, 9, 10, 11, 12, 13, 14, 15)); \
            const i32x8 aa_ = __builtin_bit_cast(i32x8, __builtin_shufflevector(At[m][0], At[m][1], 0, 1, 2, 3, 4, 5, 6, 7, 8, 9, 10, 11, 12, 13, 14, 15)); \
            asm volatile("v_mfma_scale_f32_16x16x128_f8f6f4 %0, %1, %2, %0, %3, %3 op_sel_hi:[0,0,0]" : "+v"(acc[ai][bj][m][n]) : "v"(bb_), "v"(aa_), "v"(0x7F7F7F7F)); } \
        else { _Pragma("unroll") for (int k = 0; k < 2; ++k) acc[ai][bj][m][n] = __builtin_amdgcn_mfma_f32_16x16x32_bf16(Bt[n][k], At[m][k], acc[ai][bj][m][n], 0, 0, 0); } } \
        __builtin_amdgcn_s_setprio(0); } while (0)
#define PG8_WAIT_V(n) asm volatile("s_waitcnt vmcnt(" #n ")" ::: "memory")
#define PG8_WAIT_L(n) asm volatile("s_waitcnt lgkmcnt(" #n ")" ::: "memory")
#define PG8_BAR __builtin_amdgcn_s_barrier()
#define PG8_SCHED __builtin_amdgcn_sched_barrier(0)
#define PG8_EXPERT(pm) ((pm) < 256 ? (((pm) >> 1) & 15) : ((pm) - 256))
#define PG8_ABASE(u) ((const char*)g.A + (size_t)(u).pm * tstepA)
#define PG8_BBASE(u) ((const char*)g.Bt + (size_t)PG8_EXPERT((u).pm) * g.estride * ESZ + (size_t)(u).pn * tstepB)
    Unit cur, nxt; int ui = 0;
    if (!S.next(0, cur)) return;
    f32x4 acc[2][2][4][2];
#pragma unroll
    for (int a = 0; a < 2; ++a)
#pragma unroll
        for (int b = 0; b < 2; ++b)
#pragma unroll
            for (int m = 0; m < 4; ++m)
#pragma unroll
                for (int n = 0; n < 2; ++n) acc[a][b][m][n] = (f32x4){0.f, 0.f, 0.f, 0.f};
    bf16x8 At[4][2], B0[2][2], B1[2][2];
    const char* cA = PG8_ABASE(cur); const char* cB = PG8_BBASE(cur);
    PG8_STAGE(PG8_SB(0, 0), cB, voffB); PG8_STAGE(PG8_SB(0, 1), cB + hstepB, voffB); PG8_STAGE(PG8_SA(0, 0), cA, voffA); PG8_STAGE(PG8_SA(0, 1), cA + hstepA, voffA);
    if (wr == 1) PG8_BAR;
    PG8_WAIT_V(2); PG8_BAR;
    PG8_STAGE(PG8_SB(1, 0), cB + kstep, voffB); PG8_STAGE(PG8_SA(1, 0), cA + kstep, voffA); PG8_STAGE(PG8_SB(1, 1), cB + hstepB + kstep, voffB);
    PG8_WAIT_V(6); PG8_BAR;
    for (;;) {
        const bool has_next = S.next(ui + 1, nxt);
        const char* nA = has_next ? PG8_ABASE(nxt) : cA; const char* nB = has_next ? PG8_BBASE(nxt) : cB;
#pragma nounroll
        for (int t = 0; t < nt; t += 2) {
            const bool last = (t == nt - 2);
            const char* a1 = cA + (size_t)(t + 1) * kstep;
            const char* a2 = last ? nA : cA + (size_t)(t + 2) * kstep; const char* b2 = last ? nB : cB + (size_t)(t + 2) * kstep;
            const char* a3 = a2 + kstep; const char* b3 = b2 + kstep;
            PG8_LDB(B0, 0, 0); PG8_LDB(B1, 0, 1); PG8_SCHED; PG8_LDA(At, 0, 0); PG8_STAGE(PG8_SA(1, 1), a1 + hstepA, voffA);
            PG8_WAIT_V(8); PG8_WAIT_L(0); PG8_BAR; PG8_MMA(0, 0, At, B0); PG8_MMA(0, 1, At, B1); PG8_BAR; PG8_SCHED;
            PG8_LDA(At, 0, 1); PG8_STAGE(PG8_SB(0, 0), b2, voffB); PG8_STAGE(PG8_SB(0, 1), b2 + hstepB, voffB); PG8_STAGE(PG8_SA(0, 0), a2, voffA);
            PG8_WAIT_V(8); PG8_WAIT_L(0); PG8_BAR; PG8_MMA(1, 0, At, B0); PG8_MMA(1, 1, At, B1); PG8_BAR; PG8_SCHED;
            PG8_LDB(B0, 1, 0); PG8_LDB(B1, 1, 1); PG8_SCHED; PG8_LDA(At, 1, 0); PG8_STAGE(PG8_SA(0, 1), a2 + hstepA, voffA);
            PG8_WAIT_V(8); PG8_WAIT_L(0); PG8_BAR; PG8_MMA(0, 0, At, B0); PG8_MMA(0, 1, At, B1); PG8_BAR; PG8_SCHED;
            PG8_LDA(At, 1, 1); PG8_STAGE(PG8_SB(1, 0), b3, voffB); PG8_STAGE(PG8_SB(1, 1), b3 + hstepB, voffB); PG8_STAGE(PG8_SA(1, 0), a3, voffA);
            PG8_WAIT_V(8); PG8_WAIT_L(0); PG8_BAR; PG8_MMA(1, 0, At, B0); PG8_MMA(1, 1, At, B1); PG8_BAR; PG8_SCHED;
        }
        if (wr == 0) PG8_BAR;
        E(acc, cur, wr, wc, fr, fq);
        if (!has_next) break;
#pragma unroll
        for (int a = 0; a < 2; ++a)
#pragma unroll
            for (int b = 0; b < 2; ++b)
#pragma unroll
                for (int m = 0; m < 4; ++m)
#pragma unroll
                    for (int n = 0; n < 2; ++n) acc[a][b][m][n] = (f32x4){0.f, 0.f, 0.f, 0.f};
        cur = nxt; cA = nA; cB = nB; ++ui;
        if (wr == 1) PG8_BAR;
    }
    PG8_WAIT_V(0);
    PG8_BAR;
#undef PG8_SA
#undef PG8_SB
#undef PG8_STAGE
#undef PG8_LDA
#undef PG8_LDB
#undef PG8_MMA
#undef PG8_WAIT_V
#undef PG8_WAIT_L
#undef PG8_BAR
#undef PG8_SCHED
}
}

struct Args { const float* in[29]; float* out; unsigned char* ws; };
typedef const __attribute__((address_space(4))) Args* KArgs;
#define KA_FRESH(ka) asm volatile("" : "+s"(ka))
enum { I_X = 0, I_C, I_CTX, I_CCTX, I_N1G, I_N2G, I_WADA, I_BADA, I_WIN, I_NAQG, I_NAKG, I_RPB, I_MQN, I_WUQ, I_MKVN, I_WUKV, I_MQG, I_MKG, I_SWQG, I_SWKG, I_SINK,
       I_WNAO, I_WMLAO, I_WSWAO, I_WO, I_ROUTER, I_WGATE, I_WUP, I_WDOWN };
struct Frame {
    LAS unsigned char* lds;
    int tid, lane, wave, G, vcu, gw, ngw;
};

DI void frame_fresh(Frame& F) { int t = F.tid, w = F.wave, v = F.vcu; asm volatile("" : "+v"(t), "+s"(w), "+s"(v)); F.tid = t; F.lane = t & 63; F.wave = w; F.vcu = v; F.gw = v * 8 + w; }
DI void modv_phase(Frame& F, KArgs ka) {
    KA_FRESH(ka); const __attribute__((address_space(4))) Args& a = *ka; frame_fresh(F);
    LAS float* cact = (LAS float*)F.lds;
    LAS float* red = (LAS float*)(F.lds + 9 * 1024 * 4);
    const float* c = a.in[I_C]; const float* cc = a.in[I_CCTX];
    for (int i = F.tid; i < 9 * 1024; i += 512) { const float v = i < 8192 ? c[i] : cc[i - 8192]; cact[i] = v * sigmoidf_(v); }
    __syncthreads();
    float* modv = (float*)(a.ws + WS_MODV);
    const int cl = F.lane & 31, kp = F.lane >> 5;
    for (int unit = F.vcu; unit < NL * 192; unit += F.G) {
        const int l = unit / 192, n = (unit % 192) * 32 + cl;
        const float* w = a.in[I_WADA] + (size_t)l * 1024 * 6144 + n;
        float acc[9];
#pragma unroll
        for (int i = 0; i < 9; ++i) acc[i] = 0.f;
        const int k0 = F.wave * 128 + kp;
#pragma unroll 16
        for (int k = 0; k < 128; k += 2) { const float wv = w[(size_t)(k0 + k) * 6144];
#pragma unroll
            for (int i = 0; i < 9; ++i) acc[i] += cact[i * 1024 + k0 + k] * wv; }
#pragma unroll
        for (int i = 0; i < 9; ++i) red[((F.wave * 2 + kp) * 9 + i) * 32 + cl] = acc[i];
        __syncthreads();
        for (int t = F.tid; t < 9 * 32; t += 512) { const int i = t >> 5, nn = t & 31; float s = 0.f;
#pragma unroll
            for (int w16 = 0; w16 < 16; ++w16) s += red[(w16 * 9 + i) * 32 + nn];
            const int col = (unit % 192) * 32 + nn;
            modv[((size_t)l * 9 + i) * 6144 + col] = s + a.in[I_BADA][l * 6144 + col]; }
        __syncthreads();
    }
}
DI void copy_phase(Frame& F, KArgs ka) {
    KA_FRESH(ka); const __attribute__((address_space(4))) Args& a = *ka; frame_fresh(F);
    u32x2* xs = (u32x2*)(a.ws + WS_XS);
    const f32x4* x = (const f32x4*)a.in[I_X]; const f32x4* cx = (const f32x4*)a.in[I_CTX];
    const size_t nl = (size_t)MLAT * D / 4, nc = (size_t)MCTX * D / 4;
    for (size_t i = (size_t)blockIdx.x * 512 + F.tid; i < nl + nc; i += (size_t)F.G * 512) { const f32x4 v = i < nl ? x[i] : cx[i - nl]; u32x2 w; w.x = pk2(v.x, v.y); w.y = pk2(v.z, v.w); xs[i] = w; }
}

DI void cvt_tile(const float* W, int ldw, int k0, int n0, bf16_t* WT, int ldt, int drow0, int dcol0, const float* kscale, LAS float* scr, int lane) {
#pragma unroll 8
    for (int i = 0; i < 32; ++i) { const int kk = 2 * i + (lane >> 5); float v = W[(size_t)(k0 + kk) * ldw + n0 + (lane & 31)]; if (kscale) v *= kscale[k0 + kk]; scr[kk * 33 + (lane & 31)] = v; }
    asm volatile("s_waitcnt lgkmcnt(0)" ::: "memory");
    const int c = lane & 7;
#pragma unroll
    for (int j = 0; j < 4; ++j) { const int n = (lane >> 3) + 8 * j; const LAS float* s = scr + (8 * c) * 33 + n;
        u32x4 o; o.x = pk2(s[0 * 33], s[1 * 33]); o.y = pk2(s[2 * 33], s[3 * 33]); o.z = pk2(s[4 * 33], s[5 * 33]); o.w = pk2(s[6 * 33], s[7 * 33]);
        *(u32x4*)(WT + (size_t)(drow0 + n) * ldt + dcol0 + 8 * c) = o; }
    asm volatile("s_waitcnt lgkmcnt(0)" ::: "memory");
}
DI void cvt_tile_fp8(const float* W, int ldw, int k0, int n0, unsigned char* WT, int ldt, int drow0, int dcol0, float scale, LAS float* scr, int lane) {
#pragma unroll 8
    for (int i = 0; i < 32; ++i) { const int kk = 2 * i + (lane >> 5); scr[kk * 33 + (lane & 31)] = W[(size_t)(k0 + kk) * ldw + n0 + (lane & 31)] * scale; }
    asm volatile("s_waitcnt lgkmcnt(0)" ::: "memory");
    const int c = lane & 7;
#pragma unroll
    for (int j = 0; j < 4; ++j) { const int n = (lane >> 3) + 8 * j; const LAS float* s = scr + (8 * c) * 33 + n;
        u32x2 o; o.x = pk4_fp8(s[0 * 33], s[1 * 33], s[2 * 33], s[3 * 33]); o.y = pk4_fp8(s[4 * 33], s[5 * 33], s[6 * 33], s[7 * 33]);
        *(u32x2*)(WT + (size_t)(drow0 + n) * ldt + dcol0 + 8 * c) = o; }
    asm volatile("s_waitcnt lgkmcnt(0)" ::: "memory");
}
DI void convert_weights(Frame& F, KArgs ka, int l) {
    KA_FRESH(ka); const __attribute__((address_space(4))) Args& a = *ka; frame_fresh(F);
    LAS float* scr = (LAS float*)(F.lds + F.wave * 16384);
    unsigned char* wb = a.ws + WS_W;
    constexpr int T_IN = 16 * 166, T_UQ = 4 * 24, T_UKV = 2 * 32, T_NAO = 6 * 32, T_MLAO = 8 * 32, T_SWAO = 6 * 32, T_O = 16 * 32, T_E = 16 * 32 * 16;
    constexpr int NIT = T_IN + T_UQ + T_UKV + T_NAO + T_MLAO + T_SWAO + T_O + 3 * T_E;
    for (int it = F.gw; it < NIT; it += F.ngw) {
        int r = it;
        if (r < T_IN) { const int kb = r / 166, nb = r % 166;
            if (nb < 70) cvt_tile(a.in[I_WIN] + (size_t)l * 1024 * DIN, DIN, 64 * kb, 32 * nb, (bf16_t*)(wb + W_IN), 1024, 32 * nb, 64 * kb, nullptr, scr, F.lane);
            else cvt_tile_fp8(a.in[I_WIN] + (size_t)l * 1024 * DIN, DIN, 64 * kb, 32 * nb, wb + W_GL, 1024, 32 * nb - 2240, 64 * kb, 32.0f, scr, F.lane);
            continue; } r -= T_IN;
        if (r < T_UQ) { const int kb = r / 24, nb = r % 24; cvt_tile(a.in[I_WUQ] + (size_t)l * 256 * 768, 768, 64 * kb, 32 * nb, (bf16_t*)(wb + W_UP), 384, 32 * nb, 64 * kb, a.in[I_MQN] + l * 256, scr, F.lane); continue; } r -= T_UQ;
        if (r < T_UKV) { const int kb = r / 32, nb = r % 32; cvt_tile(a.in[I_WUKV] + (size_t)l * 128 * 1024, 1024, 64 * kb, 32 * nb, (bf16_t*)(wb + W_UP), 384, 768 + 32 * nb, 256 + 64 * kb, a.in[I_MKVN] + l * 128, scr, F.lane); continue; } r -= T_UKV;
        if (r < T_NAO) { const int kb = r / 32, nb = r % 32; cvt_tile(a.in[I_WNAO] + (size_t)l * 384 * 1024, 1024, 64 * kb, 32 * nb, (bf16_t*)(wb + W_NAO), 512, 32 * nb, 64 * kb, nullptr, scr, F.lane); continue; } r -= T_NAO;
        if (r < T_MLAO) { const int kb = r / 32, nb = r % 32; cvt_tile(a.in[I_WMLAO] + (size_t)l * 512 * 1024, 1024, 64 * kb, 32 * nb, (bf16_t*)(wb + W_MLAO), 512, 32 * nb, 64 * kb, nullptr, scr, F.lane); continue; } r -= T_MLAO;
        if (r < T_SWAO) { const int kb = r / 32, nb = r % 32; cvt_tile(a.in[I_WSWAO] + (size_t)l * 384 * 1024, 1024, 64 * kb, 32 * nb, (bf16_t*)(wb + W_SWAO), 512, 32 * nb, 64 * kb, nullptr, scr, F.lane); continue; } r -= T_SWAO;
        if (r < T_O) { const int kb = r / 32, nb = r % 32; cvt_tile(a.in[I_WO] + (size_t)l * 1024 * 1024, 1024, 64 * kb, 32 * nb, (bf16_t*)(wb + W_O), 1024, 32 * nb, 64 * kb, nullptr, scr, F.lane); continue; } r -= T_O;
        if (r < 2 * T_E) {
            const int which = r / T_E, rr = r % T_E, e = rr / 512, t = rr % 512, kb = t / 32, nb = t % 32, f0 = 32 * nb;
            const float* src = a.in[which ? I_WUP : I_WGATE] + ((size_t)l * 16 + e) * 1024 * 1024;
            cvt_tile_fp8(src, 1024, 64 * kb, f0, wb + W_GU + (size_t)e * 2048 * 1024, 1024, 256 * (f0 >> 7) + 128 * which + (f0 & 127), 64 * kb, 32.0f, scr, F.lane); continue; } r -= 2 * T_E;
        { const int e = r / 512, t = r % 512, kb = t / 32, nb = t % 32;
            cvt_tile_fp8(a.in[I_WDOWN] + ((size_t)l * 16 + e) * 1024 * 1024, 1024, 64 * kb, 32 * nb, wb + W_DN + (size_t)e * 1024 * 1024, 1024, 32 * nb, 64 * kb, 32.0f, scr, F.lane); }
    }
    constexpr int Z0 = 64 * 128, Z1 = 768 * 16, Z2 = 1024 * 32;
    unsigned zz = 0u; asm volatile("" : "+v"(zz));
    const u32x4 z = {zz, zz, zz, zz};
    for (int i = blockIdx.x * 512 + F.tid; i < Z0 + Z1 + Z2; i += F.G * 512) {
        if (i < Z0) *(u32x4*)((bf16_t*)(wb + W_IN) + (size_t)(2240 + i / 128) * 1024 + (i % 128) * 8) = z;
        else if (i < Z0 + Z1) { const int j = i - Z0; *(u32x4*)((bf16_t*)(wb + W_UP) + (size_t)(j / 16) * 384 + 256 + (j % 16) * 8) = z; }
        else { const int j = i - Z0 - Z1; *(u32x4*)((bf16_t*)(wb + W_UP) + (size_t)(768 + j / 32) * 384 + (j % 32) * 8) = z; }
    }
}

DI void row_phase(Frame& F, KArgs ka, int l, int dry = 0) {
    KA_FRESH(ka); const __attribute__((address_space(4))) Args& a = *ka; frame_fresh(F);
    bf16_t* xs = (bf16_t*)(a.ws + WS_XS);
    const float* modv = (const float*)(a.ws + WS_MODV);
    const int* smap = (const int*)(a.ws + WS_SMAP);
    const bf16_t* Y = (const bf16_t*)(a.ws + WS_Y);
    bf16_t* H = (bf16_t*)(a.ws + WS_R4);
    unsigned char* H8 = a.ws + WS_R4 + 68 * MiB;
    bf16_t* xso = xs; float* outo = a.out;
    if (dry) { unsigned char* tr = a.ws + WS_END + (size_t)F.gw * 16384; xso = (bf16_t*)tr; outo = (float*)tr; H = (bf16_t*)(tr + 8192); H8 = tr + 12288; }
    const int nrows = (l == NL) ? MLAT : MT;
    const bool comb = (l > 0);
    constexpr int RR = 4;
    for (int mb = RR * F.gw; mb < nrows; mb += RR * F.ngw) {
        f32x4 v[RR][4]; int myslot[RR];
#pragma unroll
        for (int rr = 0; rr < RR; ++rr) { const int m = mb + rr;
            if (l == 0) {
                const f32x4* xr = (const f32x4*)(m < MLAT ? a.in[I_X] + (size_t)m * D : a.in[I_CTX] + (size_t)(m - MLAT) * D) + F.lane;
                u32x2* xo = (u32x2*)(xs + (size_t)m * D) + F.lane;
#pragma unroll
                for (int j = 0; j < 4; ++j) { const f32x4 t = xr[64 * j]; u32x2 w; w.x = pk2(t.x, t.y); w.y = pk2(t.z, t.w); if (!dry) xo[64 * j] = w; v[rr][j] = (f32x4){bflo(w.x), bfhi(w.x), bflo(w.y), bfhi(w.y)}; }
            } else {
                const u32x2* xr = (const u32x2*)(xs + (size_t)m * D) + F.lane;
#pragma unroll
                for (int j = 0; j < 4; ++j) { const u32x2 w = xr[64 * j]; v[rr][j] = (f32x4){bflo(w.x), bfhi(w.x), bflo(w.y), bfhi(w.y)}; }
            }
            myslot[rr] = (comb && F.lane < 16) ? smap[(size_t)F.lane * MT + mb + rr] : -1; }
        const int mi = mod_index(mb);
        if (comb) {
            f32x4 acc[RR][4];
            unsigned long long mk[RR];
#pragma unroll
            for (int rr = 0; rr < RR; ++rr) { mk[rr] = __ballot(myslot[rr] >= 0);
#pragma unroll
                for (int j = 0; j < 4; ++j) acc[rr][j] = (f32x4){0.f, 0.f, 0.f, 0.f}; }
            while ((mk[0] | mk[1]) | (mk[2] | mk[3])) {
                u32x2 w[RR][4];
#pragma unroll
                for (int rr = 0; rr < RR; ++rr) {
                    int s = -1;
                    if (mk[rr]) { const int e0 = __builtin_ctzll(mk[rr]); s = __shfl(myslot[rr], e0); mk[rr] &= mk[rr] - 1; }
#pragma unroll
                    for (int j = 0; j < 4; ++j) w[rr][j] = (u32x2){0u, 0u};
                    if (s >= 0) { const u32x2* yr = (const u32x2*)(Y + (size_t)s * D) + F.lane;
#pragma unroll
                        for (int j = 0; j < 4; ++j) w[rr][j] = yr[64 * j]; }
                }
#pragma unroll
                for (int rr = 0; rr < RR; ++rr)
#pragma unroll
                    for (int j = 0; j < 4; ++j) acc[rr][j] += (f32x4){bflo(w[rr][j].x), bfhi(w[rr][j].x), bflo(w[rr][j].y), bfhi(w[rr][j].y)};
            }
            const f32x4* g5 = (const f32x4*)(modv + ((size_t)(l - 1) * 9 + mi) * 6144 + 5 * 1024) + F.lane;
            f32x4 g5v[4];
#pragma unroll
            for (int j = 0; j < 4; ++j) g5v[j] = g5[64 * j];
#pragma unroll
            for (int rr = 0; rr < RR; ++rr) { const int m = mb + rr;
                const size_t ro = dry ? (size_t)rr * 1024 : (size_t)m * D;
#pragma unroll
                for (int j = 0; j < 4; ++j) { v[rr][j] += g5v[j] * acc[rr][j];
                    if (l == NL) ((f32x4*)(outo + ro) + F.lane)[64 * j] = v[rr][j];
                    else { u32x2 w; w.x = pk2(v[rr][j].x, v[rr][j].y); w.y = pk2(v[rr][j].z, v[rr][j].w); ((u32x2*)(xso + ro) + F.lane)[64 * j] = w;
                           v[rr][j] = (f32x4){bflo(w.x), bfhi(w.x), bflo(w.y), bfhi(w.y)}; } } }
        }
        if (l < NL) {
            const f32x4* g = (const f32x4*)(a.in[I_N1G] + l * D) + F.lane;
            const f32x4* sh = (const f32x4*)(modv + ((size_t)l * 9 + mi) * 6144) + F.lane;
            const f32x4* sc = (const f32x4*)(modv + ((size_t)l * 9 + mi) * 6144 + 1024) + F.lane;
            f32x4 gg[4], shv[4];
#pragma unroll
            for (int j = 0; j < 4; ++j) { gg[j] = g[64 * j] * (sc[64 * j] + 1.0f); shv[j] = sh[64 * j]; }
#pragma unroll
            for (int rr = 0; rr < RR; ++rr) { const int m = mb + rr;
                float ss = 0.f;
#pragma unroll
                for (int j = 0; j < 4; ++j) ss += (v[rr][j].x * v[rr][j].x + v[rr][j].y * v[rr][j].y) + (v[rr][j].z * v[rr][j].z + v[rr][j].w * v[rr][j].w);
                const float rstd = __builtin_amdgcn_rsqf(wave_sum(ss) * (1.f / D) + EPS);
                u32x2* o = (u32x2*)(H + (dry ? (size_t)rr * 1024 : (size_t)m * D)) + F.lane;
                unsigned* o8 = (unsigned*)(H8 + (dry ? (size_t)rr * 1024 : (size_t)m * D)) + F.lane;
#pragma unroll
                for (int j = 0; j < 4; ++j) { const f32x4 hh = v[rr][j] * rstd * gg[j] + shv[j]; u32x2 w; w.x = pk2(hh.x, hh.y); w.y = pk2(hh.z, hh.w); o[64 * j] = w;
                    o8[64 * j] = pk4_fp8(hh.x, hh.y, hh.z, hh.w); } }
        }
    }
}

DI void rope_cs(int d, int prow, int pcol, float& cs, float& sn) {
    const int i = d & 15; const float pos = (float)((d & 32) ? pcol : prow);
    const float inv = __builtin_amdgcn_exp2f(-(float)i * (13.287712379549449f / 16.0f));
    const float rev = pos * inv * 0.15915494309189535f;
    const float fr = rev - floorf(rev);
    cs = __builtin_amdgcn_cosf(fr); sn = __builtin_amdgcn_sinf(fr);
}
DI void prep_phase(Frame& F, KArgs ka, int l) {
    KA_FRESH(ka); const __attribute__((address_space(4))) Args& a = *ka; frame_fresh(F);
    const bf16_t* HW = (const bf16_t*)(a.ws + WS_HW);
    bf16_t* P1 = (bf16_t*)(a.ws + WS_P1);
    const float sc64 = 0.125f * LOG2E;
    const int d0 = 8 * (F.lane & 7);
    float gn[3][8]; int srcc[3]; bool ropei[3], acti[3];
    const float* gp0 = a.in[I_NAQG]; const float* gp1 = a.in[I_NAKG]; const float* gp2 = a.in[I_SWQG]; const float* gp3 = a.in[I_SWKG];
#pragma unroll
    for (int i = 0; i < 3; ++i) { const int c = F.lane + 64 * i, col = 8 * c; acti[i] = c < 160;
        const int ty = col < 384 ? 0 : col < 768 ? 1 : col < 1152 ? 2 : 3;
        srcc[i] = col < 768 ? col : col + (C_SWQ - 768);
        ropei[i] = ty >= 2;
        const float sc = (ty == 0 || ty == 2) ? sc64 : 1.0f;
#pragma unroll
        for (int j = 0; j < 8; ++j) { const float g0 = gp0[l * 64 + d0 + j], g1 = gp1[l * 64 + d0 + j], g2 = gp2[l * 64 + d0 + j], g3 = gp3[l * 64 + d0 + j];
            gn[i][j] = acti[i] ? (ty == 0 ? g0 : ty == 1 ? g1 : ty == 2 ? g2 : g3) * sc : 0.f; } }
    float invf[8];
#pragma unroll
    for (int j = 0; j < 8; ++j) invf[j] = __builtin_amdgcn_exp2f(-(float)((d0 & 8) + j) * (13.287712379549449f / 16.0f)) * 0.15915494309189535f;
    const bool second = (d0 & 16) != 0, usecol = (d0 & 32) != 0;
    for (int mb = 2 * F.gw; mb < MT; mb += 2 * F.ngw) {
        u32x4 w[2][3];
#pragma unroll
        for (int rr = 0; rr < 2; ++rr)
#pragma unroll
            for (int i = 0; i < 3; ++i) if (acti[i]) w[rr][i] = *(const u32x4*)(HW + (size_t)(mb + rr) * DINP + srcc[i]); else w[rr][i] = (u32x4){0u, 0u, 0u, 0u};
#pragma unroll
        for (int rr = 0; rr < 2; ++rr) {
            const int m = mb + rr; const bool lat = m < MLAT; const int s = m & 4095; const float prw = (float)(s >> 6), pcl = (float)(s & 63); float pos = usecol ? pcl : prw; asm volatile("" : "+v"(pos));
            float cs[8], sn[8];
#pragma unroll
            for (int j = 0; j < 8; ++j) { cs[j] = 1.f; sn[j] = 0.f; }
            if (lat) {
#pragma unroll
                for (int j = 0; j < 8; ++j) { const float rev = pos * invf[j], fr = rev - floorf(rev); cs[j] = __builtin_amdgcn_cosf(fr); sn[j] = __builtin_amdgcn_sinf(fr); } }
#pragma unroll
            for (int i = 0; i < 3; ++i) {
                float x[8] = {bflo(w[rr][i].x), bfhi(w[rr][i].x), bflo(w[rr][i].y), bfhi(w[rr][i].y), bflo(w[rr][i].z), bfhi(w[rr][i].z), bflo(w[rr][i].w), bfhi(w[rr][i].w)};
                float ss = 0.f;
#pragma unroll
                for (int j = 0; j < 8; ++j) ss += x[j] * x[j];
                ss += __shfl_xor(ss, 1); ss += __shfl_xor(ss, 2); ss += __shfl_xor(ss, 4);
                const float rs = __builtin_amdgcn_rsqf(ss * (1.f / 64.f) + EPS);
#pragma unroll
                for (int j = 0; j < 8; ++j) x[j] *= rs * gn[i][j];
                const bool rp = ropei[i] && lat;
#pragma unroll
                for (int j = 0; j < 8; ++j) { const float y = __int_as_float(__builtin_amdgcn_ds_bpermute((F.lane ^ 2) << 2, __float_as_int(x[j]))); const float rot = second ? x[j] * cs[j] + y * sn[j] : x[j] * cs[j] - y * sn[j]; x[j] = rp ? rot : x[j]; }
                if (acti[i]) { u32x4 o; o.x = pk2(x[0], x[1]); o.y = pk2(x[2], x[3]); o.z = pk2(x[4], x[5]); o.w = pk2(x[6], x[7]);
                    *(u32x4*)(P1 + (size_t)m * P1W + 8 * (F.lane + 64 * i)) = o; }
            }
        }
    }
}
DI void prep2_phase(Frame& F, KArgs ka, int l, int dry = 0) {
    KA_FRESH(ka); const __attribute__((address_space(4))) Args& a = *ka; frame_fresh(F);
    const bf16_t* HW = (const bf16_t*)(a.ws + WS_HW);
    bf16_t* U = (bf16_t*)(a.ws + WS_R4);
    bf16_t* P2 = (bf16_t*)(a.ws + WS_P2);
    const float scq = 0.07216878364870322f * LOG2E;
    const int ln = F.lane, q = ln & 15, h = ln >> 4;
    float qgn[8], qgr[4], kgn[8], kgr[4], invf[4];
    { const float* qg = a.in[I_MQG] + l * 192; const float* kg = a.in[I_MKG] + l * 192;
#pragma unroll
      for (int j = 0; j < 8; ++j) { qgn[j] = qg[8 * q + j] * scq; kgn[j] = kg[8 * q + j]; }
#pragma unroll
      for (int j = 0; j < 4; ++j) { qgr[j] = qg[128 + 4 * q + j] * scq; kgr[j] = kg[128 + 4 * q + j];
          invf[j] = __builtin_amdgcn_exp2f(-(float)(4 * (q & 3) + j) * (13.287712379549449f / 16.0f)) * 0.15915494309189535f; } }
    const bool second = (q & 4) != 0, usecol = (q & 8) != 0;
    const int pl = (ln ^ 4) << 2;
    for (int mb = 2 * F.gw; mb < MT; mb += 2 * F.ngw) {
        u32x2 wcq[2], wqr[2], wkr[2]; unsigned wckv[2]; u32x4 wqn[2], wkn[2], wv[2];
#pragma unroll
        for (int rr = 0; rr < 2; ++rr) { const bf16_t* hr = HW + (size_t)(mb + rr) * DINP; const bf16_t* ur = U + (size_t)(mb + rr) * UW;
            wcq[rr] = *(const u32x2*)(hr + C_CQ + 4 * ln); wckv[rr] = *(const unsigned*)(hr + C_CKV + 2 * ln); wkr[rr] = *(const u32x2*)(hr + C_KR + 4 * q);
            wqn[rr] = *(const u32x4*)(ur + h * 192 + 8 * q); wqr[rr] = *(const u32x2*)(ur + h * 192 + 128 + 4 * q);
            wkn[rr] = *(const u32x4*)(ur + 768 + h * 256 + 8 * q); wv[rr] = *(const u32x4*)(ur + 768 + h * 256 + 128 + 8 * q); }
#pragma unroll
        for (int rr = 0; rr < 2; ++rr) {
            const int m = mb + rr; const bool lat = m < MLAT; const int s = m & 4095;
            bf16_t* ur = U + (size_t)m * UW; bf16_t* pr = P2 + (size_t)m * P2W;
            if (dry) { ur = (bf16_t*)(a.ws + WS_END + (size_t)F.gw * 8192); pr = ur + 2048; }
            float rq, rkv;
            { const float a0 = bflo(wcq[rr].x), a1 = bfhi(wcq[rr].x), a2 = bflo(wcq[rr].y), a3 = bfhi(wcq[rr].y);
              rq = __builtin_amdgcn_rsqf(wave_sum(a0 * a0 + a1 * a1 + a2 * a2 + a3 * a3) * (1.f / 256.f) + EPS); }
            { const float a0 = bflo(wckv[rr]), a1 = bfhi(wckv[rr]);
              rkv = __builtin_amdgcn_rsqf(wave_sum(a0 * a0 + a1 * a1) * (1.f / 128.f) + EPS); }
            float cs[4], sn[4];
            { const float prw = (float)(s >> 6), pcl = (float)(s & 63); float pos = usecol ? pcl : prw; asm volatile("" : "+v"(pos));
#pragma unroll
              for (int j = 0; j < 4; ++j) { const float rev = pos * invf[j], fr = rev - floorf(rev); cs[j] = lat ? __builtin_amdgcn_cosf(fr) : 1.f; sn[j] = lat ? __builtin_amdgcn_sinf(fr) : 0.f; } }
#pragma unroll
            for (int isk = 0; isk < 2; ++isk) {
                const u32x4 wn = isk ? wkn[rr] : wqn[rr]; const u32x2 wr2 = isk ? wkr[rr] : wqr[rr];
                const float sn_ = isk ? rkv : rq, sr_ = isk ? 1.0f : rq;
                float x[8] = {bflo(wn.x) * sn_, bfhi(wn.x) * sn_, bflo(wn.y) * sn_, bfhi(wn.y) * sn_, bflo(wn.z) * sn_, bfhi(wn.z) * sn_, bflo(wn.w) * sn_, bfhi(wn.w) * sn_};
                float y[4] = {bflo(wr2.x) * sr_, bfhi(wr2.x) * sr_, bflo(wr2.y) * sr_, bfhi(wr2.y) * sr_};
                float ss = 0.f;
#pragma unroll
                for (int j = 0; j < 8; ++j) ss += x[j] * x[j];
#pragma unroll
                for (int j = 0; j < 4; ++j) ss += y[j] * y[j];
                ss += __shfl_xor(ss, 1); ss += __shfl_xor(ss, 2); ss += __shfl_xor(ss, 4); ss += __shfl_xor(ss, 8);
                const float rs = __builtin_amdgcn_rsqf(ss * (1.f / 192.f) + EPS);
#pragma unroll
                for (int j = 0; j < 8; ++j) x[j] *= rs * (isk ? kgn[j] : qgn[j]);
#pragma unroll
                for (int j = 0; j < 4; ++j) { y[j] *= rs * (isk ? kgr[j] : qgr[j]);
                    const float p = __int_as_float(__builtin_amdgcn_ds_bpermute(pl, __float_as_int(y[j])));
                    y[j] = second ? y[j] * cs[j] + p * sn[j] : y[j] * cs[j] - p * sn[j]; }
                u32x4 o; o.x = pk2(x[0], x[1]); o.y = pk2(x[2], x[3]); o.z = pk2(x[4], x[5]); o.w = pk2(x[6], x[7]);
                u32x2 o2; o2.x = pk2(y[0], y[1]); o2.y = pk2(y[2], y[3]);
                *(u32x4*)(pr + 768 * isk + h * 192 + 8 * q) = o; *(u32x2*)(pr + 768 * isk + h * 192 + 128 + 4 * q) = o2;
            }
            { const u32x4 vw = wv[rr]; u32x4 o; o.x = pk2(bflo(vw.x) * rkv, bfhi(vw.x) * rkv); o.y = pk2(bflo(vw.y) * rkv, bfhi(vw.y) * rkv); o.z = pk2(bflo(vw.z) * rkv, bfhi(vw.z) * rkv); o.w = pk2(bflo(vw.w) * rkv, bfhi(vw.w) * rkv);
              *(u32x4*)(ur + 768 + h * 256 + 128 + 8 * q) = o; }
        }
    }
}

struct AU {
    const bf16_t *q, *k, *v; bf16_t* o;
    int ldq, ldk, ldv, ldo;
    int qrow0;
    int lat_row0, n_lat, ctx_row0, n_ctx;
    int mode;
    int qpos0, kpos0;
    float m0, l0;
    const float* rpb;
};
template <int DQ, int DV, int LDK, int LDV>
DI void attn_unit(LAS unsigned char* lds, const AU& u, int tid, int wave, int lane) {
    constexpr int KP = DQ * 2 + 16, VP = DV * 2 + 64, KBY = 64 * KP, VBY = 64 * VP, STG = KBY + VBY;
    constexpr int NKS = DQ / 16, NDT = DV / 32, KCH = DQ / 8, VCH = DV / 8;
    constexpr int KC = KP / 16, VC = VP / 16;
    constexpr int KI = (KC + 7) / 8, VI = (VC + 7) / 8;
    constexpr int BIAS_OFF = 98304;
    static_assert(2 * STG <= BIAS_OFF && KBY % 1024 == 0 && VBY % 1024 == 0, "attention LDS");
    const int r = lane & 31, h = lane >> 5;
    const int nt = u.n_lat + u.n_ctx;
    LAS float* btab = (LAS float*)(lds + BIAS_OFF);
    if (u.mode == 2) { for (int i = tid; i < 15 * 31; i += 512) btab[i] = u.rpb[i] * LOG2E; }
    bf16x8 qf[NKS];
    { const bf16_t* qp = u.q + (size_t)(u.qrow0 + wave * 32 + r) * u.ldq + 8 * h;
#pragma unroll
      for (int ks = 0; ks < NKS; ++ks) qf[ks] = *(const bf16x8*)(qp + 16 * ks); }
    f32x16 o[NDT];
#pragma unroll
    for (int dt = 0; dt < NDT; ++dt)
#pragma unroll
        for (int i = 0; i < 16; ++i) o[dt][i] = 0.f;
    float mrun = u.m0, lrun = (h == 0) ? u.l0 : 0.f;
    unsigned koff[KI], voff[VI];
#pragma unroll
    for (int i = 0; i < KI; ++i) { const int c = 64 * (wave + 8 * i) + lane, row = c / KC, cc = c % KC; koff[i] = (unsigned)(row * LDK * 2 + (cc < KCH ? cc : KCH - 1) * 16); }
#pragma unroll
    for (int i = 0; i < VI; ++i) { const int c = 64 * (wave + 8 * i) + lane, row = c / VC, cc = c % VC; voff[i] = (unsigned)(row * LDV * 2 + (cc < VCH ? cc : VCH - 1) * 16); }
#define AT_ROWBASE(t) ((t) < u.n_lat ? u.lat_row0 + 64 * (t) : u.ctx_row0 + 64 * ((t) - u.n_lat))
#define AT_ISSUE(t, buf) do { const int rb_ = AT_ROWBASE(t); const char* kb_ = (const char*)(u.k + (size_t)rb_ * LDK); const char* vb_ = (const char*)(u.v + (size_t)rb_ * LDV); \
        _Pragma("unroll") for (int i_ = 0; i_ < KI; ++i_) { const int j_ = wave + 8 * i_; if (j_ < KC) __builtin_amdgcn_global_load_lds((const unsigned*)(kb_ + koff[i_]), (LAS unsigned*)(lds + (buf) * STG + j_ * 1024), 16, 0, 0); } \
        _Pragma("unroll") for (int i_ = 0; i_ < VI; ++i_) { const int j_ = wave + 8 * i_; if (j_ < VC) __builtin_amdgcn_global_load_lds((const unsigned*)(vb_ + voff[i_]), (LAS unsigned*)(lds + (buf) * STG + KBY + j_ * 1024), 16, 0, 0); } } while (0)
    AT_ISSUE(0, 0);
    asm volatile("s_waitcnt vmcnt(0)" ::: "memory");
    __syncthreads();
    const int tq = (lane & 15) >> 2, tp = lane & 3, tblk = (lane >> 4) & 1;
    const int vlane_off = (4 * h + tq) * VP + 32 * tblk + 8 * tp;
    for (int t = 0; t < nt; ++t) {
        const int buf = t & 1;
        if (t + 1 < nt) AT_ISSUE(t + 1, buf ^ 1);
        bool skip = false; int a0 = 0, a1 = 0;
        if (u.mode == 1 && t < u.n_lat) { const int k0 = u.kpos0 + 64 * t, q0 = u.qpos0 + 32 * wave; skip = (k0 > q0 + 31 + 128) || (k0 + 63 < q0 - 128); a0 = k0; a1 = q0; }
        if (u.mode == 2 && t < u.n_lat) { const int kr = u.kpos0 + t, qr = u.qpos0 + (wave >> 1); int rs = qr - 4; rs = rs < 0 ? 0 : (rs > 56 ? 56 : rs); skip = (kr < rs) || (kr >= rs + 8); a0 = kr - qr + 7; }
        if (!skip) {
            const LAS unsigned char* Kt = lds + buf * STG; const LAS unsigned char* Vt = Kt + KBY;
            f32x16 s0, s1;
#pragma unroll
            for (int i = 0; i < 16; ++i) { s0[i] = 0.f; s1[i] = 0.f; }
#pragma unroll
            for (int ks = 0; ks < NKS; ++ks) {
                const bf16x8 k0 = *(const LAS bf16x8*)(Kt + r * KP + (16 * ks + 8 * h) * 2);
                const bf16x8 k1 = *(const LAS bf16x8*)(Kt + (32 + r) * KP + (16 * ks + 8 * h) * 2);
                s0 = __builtin_amdgcn_mfma_f32_32x32x16_bf16(k0, qf[ks], s0, 0, 0, 0);
                s1 = __builtin_amdgcn_mfma_f32_32x32x16_bf16(k1, qf[ks], s1, 0, 0, 0);
            }
            if (u.mode == 1 && t < u.n_lat) {
                const int qpos = a1 + r;
#pragma unroll
                for (int i = 0; i < 16; ++i) { const int kk = a0 + (i & 3) + 8 * (i >> 2) + 4 * h; int d0 = qpos - kk; d0 = d0 < 0 ? -d0 : d0; int d1 = qpos - (kk + 32); d1 = d1 < 0 ? -d1 : d1;
                    s0[i] = d0 <= 128 ? s0[i] : -INFINITY; s1[i] = d1 <= 128 ? s1[i] : -INFINITY; }
            }
            if (u.mode == 2 && t < u.n_lat) {
                const int qc = 32 * (wave & 1) + r; int cs = qc - 8; cs = cs < 0 ? 0 : (cs > 48 ? 48 : cs);
                const int bbase = a0 * 31 + 15 - qc;
                float bb[16];
#pragma unroll
                for (int half = 0; half < 2; ++half) {
#pragma unroll
                    for (int i = 0; i < 16; ++i) { int ix = bbase + 32 * half + (i & 3) + 8 * (i >> 2) + 4 * h; ix = ix < 0 ? 0 : (ix > 464 ? 464 : ix); bb[i] = btab[ix]; }
                    asm volatile("" : "+v"(bb[0]), "+v"(bb[1]), "+v"(bb[2]), "+v"(bb[3]), "+v"(bb[4]), "+v"(bb[5]), "+v"(bb[6]), "+v"(bb[7]), "+v"(bb[8]), "+v"(bb[9]), "+v"(bb[10]), "+v"(bb[11]), "+v"(bb[12]), "+v"(bb[13]), "+v"(bb[14]), "+v"(bb[15]));
#pragma unroll
                    for (int i = 0; i < 16; ++i) { const int kc = 32 * half + (i & 3) + 8 * (i >> 2) + 4 * h; const bool ok = (kc >= cs) && (kc < cs + 16);
                        if (half == 0) s0[i] = ok ? s0[i] + bb[i] : -INFINITY; else s1[i] = ok ? s1[i] + bb[i] : -INFINITY; }
                }
            }
            float mx = fmaxf(s0[0], s1[0]);
#pragma unroll
            for (int i = 1; i < 16; ++i) mx = fmaxf(mx, fmaxf(s0[i], s1[i]));
            mx = fmaxf(mx, __shfl_xor(mx, 32));
            const float mnew = fmaxf(mrun, mx), alpha = __builtin_amdgcn_exp2f(mrun - mnew);
            float ls = 0.f;
#pragma unroll
            for (int i = 0; i < 16; ++i) { s0[i] = __builtin_amdgcn_exp2f(s0[i] - mnew); s1[i] = __builtin_amdgcn_exp2f(s1[i] - mnew); ls += s0[i] + s1[i]; }
            lrun = lrun * alpha + ls; mrun = mnew;
#pragma unroll
            for (int dt = 0; dt < NDT; ++dt)
#pragma unroll
                for (int i = 0; i < 16; ++i) o[dt][i] *= alpha;
            bf16x8 pf[4];
            { u32x4 w;
              w.x = pk2(s0[0], s0[1]); w.y = pk2(s0[2], s0[3]); w.z = pk2(s0[4], s0[5]); w.w = pk2(s0[6], s0[7]); pf[0] = __builtin_bit_cast(bf16x8, w);
              w.x = pk2(s0[8], s0[9]); w.y = pk2(s0[10], s0[11]); w.z = pk2(s0[12], s0[13]); w.w = pk2(s0[14], s0[15]); pf[1] = __builtin_bit_cast(bf16x8, w);
              w.x = pk2(s1[0], s1[1]); w.y = pk2(s1[2], s1[3]); w.z = pk2(s1[4], s1[5]); w.w = pk2(s1[6], s1[7]); pf[2] = __builtin_bit_cast(bf16x8, w);
              w.x = pk2(s1[8], s1[9]); w.y = pk2(s1[10], s1[11]); w.z = pk2(s1[12], s1[13]); w.w = pk2(s1[14], s1[15]); pf[3] = __builtin_bit_cast(bf16x8, w); }
#pragma unroll
            for (int kk = 0; kk < 4; ++kk) {
#pragma unroll
                for (int dt = 0; dt < NDT; ++dt) {
                    const LAS unsigned char* vp = Vt + (16 * kk) * VP + vlane_off + 64 * dt;
                    const s16x4 lo = __builtin_amdgcn_ds_read_tr16_b64_v4i16((LAS s16x4*)vp);
                    const s16x4 hi = __builtin_amdgcn_ds_read_tr16_b64_v4i16((LAS s16x4*)(vp + 8 * VP));
                    const bf16x8 vf = __builtin_shufflevector(lo, hi, 0, 1, 2, 3, 4, 5, 6, 7);
                    o[dt] = __builtin_amdgcn_mfma_f32_32x32x16_bf16(vf, pf[kk], o[dt], 0, 0, 0);
                }
            }
        }
        asm volatile("s_waitcnt vmcnt(0)" ::: "memory");
        __syncthreads();
    }
    const float ltot = lrun + __shfl_xor(lrun, 32), inv = 1.0f / ltot;
    bf16_t* op = u.o + (size_t)(u.qrow0 + wave * 32 + r) * u.ldo + 4 * h;
#pragma unroll
    for (int dt = 0; dt < NDT; ++dt)
#pragma unroll
        for (int g = 0; g < 4; ++g) { u32x2 w; w.x = pk2(o[dt][4 * g] * inv, o[dt][4 * g + 1] * inv); w.y = pk2(o[dt][4 * g + 2] * inv, o[dt][4 * g + 3] * inv);
            *(u32x2*)(op + 32 * dt + 8 * g) = w; }
#undef AT_ROWBASE
#undef AT_ISSUE
}

DI void attn_phase(Frame& F, KArgs ka, int l) {
    KA_FRESH(ka); const __attribute__((address_space(4))) Args& a = *ka; frame_fresh(F);
    const bf16_t* HW = (const bf16_t*)(a.ws + WS_HW);
    const bf16_t* P1 = (const bf16_t*)(a.ws + WS_P1);
    const bf16_t* P2 = (const bf16_t*)(a.ws + WS_P2);
    const bf16_t* U = (const bf16_t*)(a.ws + WS_R4);
    bf16_t* OC = (bf16_t*)(a.ws + WS_OCAT);
    const bool last = (l == NL - 1);
    constexpr int nA = 512, nB = 768, nC = 768;
    const int ntot = nA + nB + nC + (last ? 0 : 128);
#ifndef ATT_PROBE
#define ATT_PROBE 0
#endif
    for (int rep2_ = 0; rep2_ < 1 + (ATT_PROBE != 0); ++rep2_)
    for (int id = F.vcu; id < ntot; id += F.G) {
        if (rep2_ == 1 && !((ATT_PROBE == 1) ? (id < nA) : (id >= nA && id < nA + nB))) continue;
        AU u; bool big = false;
        u.mode = 0; u.qpos0 = 0; u.kpos0 = 0; u.m0 = -1e30f; u.l0 = 0.f; u.rpb = nullptr; u.n_ctx = 4;
        if (id < nA) {
            const int b = id >> 6, h = (id >> 4) & 3, qb = id & 15; big = true;
            u.q = P2 + h * 192; u.ldq = P2W; u.k = P2 + 768 + h * 192; u.ldk = P2W; u.v = U + 768 + h * 256 + 128; u.ldv = UW; u.o = OC + 384 + h * 128; u.ldo = OCW;
            u.qrow0 = b * SEQ + qb * 256; u.lat_row0 = b * SEQ; u.n_lat = 64; u.ctx_row0 = MLAT + b * CTX;
        } else if (id < nA + nB) {
            const int j = id - nA, b = j / 96, h = (j >> 4) % 6, qb = j & 15;
            u.q = P1 + h * 64; u.ldq = P1W; u.k = P1 + 384 + h * 64; u.ldk = P1W; u.v = HW + C_NAV + h * 64; u.ldv = DINP; u.o = OC + h * 64; u.ldo = OCW;
            int rlo = 4 * qb - 4; rlo = rlo < 0 ? 0 : (rlo > 56 ? 56 : rlo); int rhi = 4 * qb + 3 - 4; rhi = (rhi < 0 ? 0 : (rhi > 56 ? 56 : rhi)) + 7;
            u.qrow0 = b * SEQ + qb * 256; u.lat_row0 = b * SEQ + rlo * 64; u.n_lat = rhi - rlo + 1; u.ctx_row0 = MLAT + b * CTX;
            u.mode = 2; u.qpos0 = 4 * qb; u.kpos0 = rlo; u.rpb = a.in[I_RPB] + (size_t)(l * 6 + h) * 465;
        } else if (id < nA + nB + nC) {
            const int j = id - nA - nB, b = j / 96, hq = (j >> 4) % 6, qb = j & 15, kvh = hq / 3;
            u.q = P1 + 768 + hq * 64; u.ldq = P1W; u.k = P1 + 1152 + kvh * 64; u.ldk = P1W; u.v = HW + C_SWV + kvh * 64; u.ldv = DINP; u.o = OC + 896 + hq * 64; u.ldo = OCW;
            int klo = qb * 256 - 128; klo = klo < 0 ? 0 : klo; int khi = qb * 256 + 384; khi = khi > SEQ ? SEQ : khi;
            u.qrow0 = b * SEQ + qb * 256; u.lat_row0 = b * SEQ + klo; u.n_lat = (khi - klo) >> 6; u.ctx_row0 = MLAT + b * CTX;
            u.mode = 1; u.qpos0 = qb * 256; u.kpos0 = klo; u.m0 = a.in[I_SINK][l * 6 + hq] * LOG2E; u.l0 = 1.f;
        } else {
            const int j = id - nA - nB - nC;
            u.n_lat = 0; u.lat_row0 = 0;
            if (j < 32) { const int b = j >> 2, h = j & 3; big = true;
                u.q = P2 + h * 192; u.ldq = P2W; u.k = P2 + 768 + h * 192; u.ldk = P2W; u.v = U + 768 + h * 256 + 128; u.ldv = UW; u.o = OC + 384 + h * 128; u.ldo = OCW;
                u.qrow0 = MLAT + b * CTX; u.ctx_row0 = MLAT + b * CTX;
            } else if (j < 80) { const int jj = j - 32, b = jj / 6, h = jj % 6;
                u.q = P1 + h * 64; u.ldq = P1W; u.k = P1 + 384 + h * 64; u.ldk = P1W; u.v = HW + C_NAV + h * 64; u.ldv = DINP; u.o = OC + h * 64; u.ldo = OCW;
                u.qrow0 = MLAT + b * CTX; u.ctx_row0 = MLAT + b * CTX;
            } else { const int jj = j - 80, b = jj / 6, hq = jj % 6, kvh = hq / 3;
                u.q = P1 + 768 + hq * 64; u.ldq = P1W; u.k = P1 + 1152 + kvh * 64; u.ldk = P1W; u.v = HW + C_SWV + kvh * 64; u.ldv = DINP; u.o = OC + 896 + hq * 64; u.ldo = OCW;
                u.qrow0 = MLAT + b * CTX; u.ctx_row0 = MLAT + b * CTX; u.m0 = a.in[I_SINK][l * 6 + hq] * LOG2E; u.l0 = 1.f;
            }
        }
        if (big) attn_unit<192, 128, P2W, UW>(F.lds, u, F.tid, F.wave, F.lane);
        else attn_unit<64, 64, P1W, DINP>(F.lds, u, F.tid, F.wave, F.lane);
    }
}

DI void norm2_phase(Frame& F, KArgs ka, int l, int nrows) {
    KA_FRESH(ka); const __attribute__((address_space(4))) Args& a = *ka; frame_fresh(F);
    LAS float* rt = (LAS float*)F.lds;
    const float* rg = a.in[I_ROUTER] + (size_t)l * 1024 * 16;
    for (int i = F.tid; i < 16384; i += 512) rt[i] = rg[i];
    __syncthreads();
    LAS float* xr = (LAS float*)(F.lds + 65536 + F.wave * 8192);
    const bf16_t* xs = (const bf16_t*)(a.ws + WS_XS);
    const float* modv = (const float*)(a.ws + WS_MODV);
    unsigned char* H2 = a.ws + WS_H2;
    float* AFL = (float*)(a.ws + WS_AFL); float* AFC = (float*)(a.ws + WS_AFC);
    const int eq = F.lane & 3, kq = F.lane >> 2;
    u32x2 xw[2][4];
#define N2_LOAD(mb_) do { _Pragma("unroll") for (int rr_ = 0; rr_ < 2; ++rr_) { const u32x2* xp_ = (const u32x2*)(xs + (size_t)((mb_) + rr_) * D) + F.lane; \
        _Pragma("unroll") for (int j_ = 0; j_ < 4; ++j_) xw[rr_][j_] = xp_[64 * j_]; } } while (0)
    if (2 * F.gw < nrows) N2_LOAD(2 * F.gw);
    for (int mb = 2 * F.gw; mb < nrows; mb += 2 * F.ngw) {
        const int mi = mod_index(mb);
        f32x4 v[2][4];
#pragma unroll
        for (int rr = 0; rr < 2; ++rr)
#pragma unroll
            for (int j = 0; j < 4; ++j) { const u32x2 w = xw[rr][j]; v[rr][j] = (f32x4){bflo(w.x), bfhi(w.x), bflo(w.y), bfhi(w.y)}; }
        if (mb + 2 * F.ngw < nrows) N2_LOAD(mb + 2 * F.ngw);
        const f32x4* g = (const f32x4*)(a.in[I_N2G] + l * D) + F.lane;
        const f32x4* sh = (const f32x4*)(modv + ((size_t)l * 9 + mi) * 6144 + 3 * 1024) + F.lane;
        const f32x4* sc = (const f32x4*)(modv + ((size_t)l * 9 + mi) * 6144 + 4 * 1024) + F.lane;
        f32x4 gg[4], shv[4];
#pragma unroll
        for (int j = 0; j < 4; ++j) { gg[j] = g[64 * j] * (sc[64 * j] + 1.0f); shv[j] = sh[64 * j]; }
#pragma unroll
        for (int rr = 0; rr < 2; ++rr) {
            float ss = 0.f;
#pragma unroll
            for (int j = 0; j < 4; ++j) ss += (v[rr][j].x * v[rr][j].x + v[rr][j].y * v[rr][j].y) + (v[rr][j].z * v[rr][j].z + v[rr][j].w * v[rr][j].w);
            const float rstd = __builtin_amdgcn_rsqf(wave_sum(ss) * (1.f / D) + EPS);
            unsigned* o = (unsigned*)(H2 + (size_t)(mb + rr) * D) + F.lane;
#pragma unroll
            for (int j = 0; j < 4; ++j) { const f32x4 hh = v[rr][j] * rstd * gg[j] + shv[j]; o[64 * j] = pk4_fp8(hh.x, hh.y, hh.z, hh.w);
                *(LAS f32x4*)(xr + rr * 1024 + 4 * F.lane + 256 * j) = hh; }
        }
        asm volatile("s_waitcnt lgkmcnt(0)" ::: "memory");
        f32x4 acc[2] = {{0.f, 0.f, 0.f, 0.f}, {0.f, 0.f, 0.f, 0.f}};
#pragma unroll 8
        for (int i = 0; i < 64; ++i) { const int k = kq + 16 * i; const float x0 = xr[k], x1 = xr[1024 + k]; const f32x4 w = *(const LAS f32x4*)(rt + k * 16 + 4 * eq); acc[0] += w * x0; acc[1] += w * x1; }
        asm volatile("s_waitcnt lgkmcnt(0)" ::: "memory");
#pragma unroll
        for (int rr = 0; rr < 2; ++rr) { const int m = mb + rr; f32x4 ac = acc[rr];
#pragma unroll
            for (int ofs = 4; ofs < 64; ofs <<= 1) { ac.x += __shfl_xor(ac.x, ofs); ac.y += __shfl_xor(ac.y, ofs); ac.z += __shfl_xor(ac.z, ofs); ac.w += __shfl_xor(ac.w, ofs); }
            float mx = fmaxf(fmaxf(ac.x, ac.y), fmaxf(ac.z, ac.w)); mx = fmaxf(mx, __shfl_xor(mx, 1)); mx = fmaxf(mx, __shfl_xor(mx, 2));
            f32x4 ex; ex.x = __expf(ac.x - mx); ex.y = __expf(ac.y - mx); ex.z = __expf(ac.z - mx); ex.w = __expf(ac.w - mx);
            float sum = (ex.x + ex.y) + (ex.z + ex.w); sum += __shfl_xor(sum, 1); sum += __shfl_xor(sum, 2);
            const float inv = 1.0f / sum;
            if (F.lane < 4) {
                if (m < MLAT) { const int b = m >> 12, s = m & 4095; float* p = AFL + ((size_t)(b * 16 + 4 * F.lane)) * 4096 + s; p[0] = ex.x * inv; p[4096] = ex.y * inv; p[2 * 4096] = ex.z * inv; p[3 * 4096] = ex.w * inv; }
                else { const int b = (m - MLAT) >> 8, s = (m - MLAT) & 255; float* p = AFC + ((size_t)(b * 16 + 4 * F.lane)) * 256 + s; p[0] = ex.x * inv; p[256] = ex.y * inv; p[512] = ex.z * inv; p[768] = ex.w * inv; }
            }
        }
    }
}

DI unsigned block_excl_scan(unsigned v, unsigned& total, LAS unsigned* wsum, int tid, int lane, int wave) {
    unsigned x = v;
#pragma unroll
    for (int o = 1; o < 64; o <<= 1) { const unsigned y = __shfl_up(x, o); if (lane >= o) x += y; }
    if (lane == 63) wsum[wave] = x;
    __syncthreads();
    unsigned base = 0, tot = 0;
#pragma unroll
    for (int w = 0; w < 8; ++w) { const unsigned s = wsum[w]; if (w < wave) base += s; tot += s; }
    __syncthreads();
    total = tot;
    return base + x - v;
}
DI void select_phase(Frame& F, KArgs ka, int l) {
    KA_FRESH(ka); const __attribute__((address_space(4))) Args& a = *ka; frame_fresh(F);
    const bool last = (l == NL - 1);
    const int nunits = last ? 128 : 256;
    LAS unsigned* hist = (LAS unsigned*)F.lds;
    LAS unsigned* wsum = (LAS unsigned*)(F.lds + 8192);
    LAS unsigned* bc = (LAS unsigned*)(F.lds + 8192 + 64);
    LAS int* sel = (LAS int*)(F.lds + 16384);
    const float* AFL = (const float*)(a.ws + WS_AFL); const float* AFC = (const float*)(a.ws + WS_AFC);
    int* smap = (int*)(a.ws + WS_SMAP); float* gate = (float*)(a.ws + WS_GATE);
    const unsigned char* H2 = a.ws + WS_H2; unsigned char* XG = a.ws + WS_XG;
    for (int unit = blockIdx.x; unit < nunits; unit += F.G) {
        const bool lat = unit < 128; const int be = unit & 127, b = be >> 4, e = be & 15;
        const int N = lat ? 4096 : 256, cap = lat ? CAP_LAT : CAP_CTX;
        const float* aff = lat ? AFL + (size_t)be * 4096 : AFC + (size_t)be * 256;
        unsigned key[8]; const int per = lat ? 8 : 1; const bool act = lat || F.tid < 256;
#pragma unroll
        for (int j = 0; j < 8; ++j) key[j] = (act && j < per) ? __float_as_uint(aff[F.tid * per + j]) : 0u;
        unsigned prefix = 0u, pmask = 0u, need = (unsigned)cap;
#pragma unroll
        for (int pass = 0; pass < 3; ++pass) {
            const int shift = pass == 0 ? 21 : (pass == 1 ? 10 : 0), nb = pass == 2 ? 1024 : 2048;
            for (int i = F.tid; i < 2048; i += 512) hist[i] = 0u;
            __syncthreads();
#pragma unroll
            for (int j = 0; j < 8; ++j) if (act && j < per && (key[j] & pmask) == prefix) (void)__hip_atomic_fetch_add(&hist[(key[j] >> shift) & (nb - 1)], 1u, __ATOMIC_RELAXED, __HIP_MEMORY_SCOPE_WORKGROUP);
            __syncthreads();
            unsigned c4[4], mine = 0;
#pragma unroll
            for (int j = 0; j < 4; ++j) { const int bin = 2047 - 4 * F.tid - j; c4[j] = bin < nb ? hist[bin] : 0u; mine += c4[j]; }
            unsigned tot; unsigned run = block_excl_scan(mine, tot, wsum, F.tid, F.lane, F.wave);
#pragma unroll
            for (int j = 0; j < 4; ++j) { const int bin = 2047 - 4 * F.tid - j;
                if (bin < nb && run < need && run + c4[j] >= need) { bc[0] = (unsigned)bin; bc[1] = run; }
                run += c4[j]; }
            __syncthreads();
            const unsigned cb = bc[0], above = bc[1];
            prefix |= cb << shift; pmask |= (unsigned)(nb - 1) << shift; need -= above;
            __syncthreads();
        }
        unsigned neq = 0, ngt = 0;
#pragma unroll
        for (int j = 0; j < 8; ++j) if (act && j < per) { neq += key[j] == prefix; ngt += key[j] > prefix; }
        unsigned teq; const unsigned eqbase = block_excl_scan(neq, teq, wsum, F.tid, F.lane, F.wave);
        unsigned nsel = 0, flags = 0, erun = eqbase;
#pragma unroll
        for (int j = 0; j < 8; ++j) if (act && j < per) { bool s = key[j] > prefix; if (key[j] == prefix) { s = erun < need; ++erun; } if (s) { flags |= 1u << j; ++nsel; } }
        unsigned tsel; unsigned sbase = block_excl_scan(nsel, tsel, wsum, F.tid, F.lane, F.wave);
        const int rowbase = lat ? b * SEQ : MLAT + b * CTX;
        const int slotbase = lat ? be * CAP_LAT : NSLOT_LAT + (e * 8 + b) * CAP_CTX;
#pragma unroll
        for (int j = 0; j < 8; ++j) if (act && j < per) { const int tok = F.tid * per + j; int slot = -1;
            if ((flags >> j) & 1u) { slot = slotbase + (int)sbase; sel[sbase] = tok; gate[slot] = __uint_as_float(key[j]); ++sbase; }
            smap[(size_t)e * MT + rowbase + tok] = slot; }
        __syncthreads();
        if (lat) {
            for (int t0 = F.wave * 16; t0 < cap; t0 += 128) {
                u32x4 rowv[16];
#pragma unroll
                for (int q = 0; q < 16; ++q) rowv[q] = ((const u32x4*)(H2 + (size_t)(rowbase + sel[t0 + q]) * D))[F.lane];
#pragma unroll
                for (int q = 0; q < 16; ++q) ((u32x4*)(XG + (size_t)(slotbase + t0 + q) * D))[F.lane] = rowv[q];
            }
        } else {
            const int t0 = F.wave * 4;
            u32x4 rowv[4];
#pragma unroll
            for (int q = 0; q < 4; ++q) rowv[q] = ((const u32x4*)(H2 + (size_t)(rowbase + sel[t0 + q]) * D))[F.lane];
#pragma unroll
            for (int q = 0; q < 4; ++q) ((u32x4*)(XG + (size_t)(slotbase + t0 + q) * D))[F.lane] = rowv[q];
        }
        __syncthreads();
    }
}

DI unsigned char* ws_fresh(KArgs ka) { KA_FRESH(ka); return ka->ws; }
__global__ void __launch_bounds__(512, 2) mega_fwd(Args a_unused) {
    extern __shared__ __attribute__((aligned(16))) unsigned char lds_raw[];
    KArgs ka = (KArgs)__builtin_amdgcn_kernarg_segment_ptr();
    Frame F;
    F.lds = (LAS unsigned char*)lds_raw;
    F.tid = threadIdx.x; F.lane = F.tid & 63; F.wave = __builtin_amdgcn_readfirstlane(F.tid >> 6);
    F.G = gridDim.x; { const int bx = blockIdx.x; F.vcu = (F.G % 8 == 0) ? (bx % 8) * (F.G / 8) + bx / 8 : bx; }
    F.gw = F.vcu * 8 + F.wave; F.ngw = F.G * 8;
    for (int u = F.tid; u < (LDS_BYTES - LDSCTL_OFF) / 4; u += 512) ((LAS unsigned*)(F.lds + LDSCTL_OFF))[u] = 0u;
    __syncthreads();
    XcdBarrier bar = xcd_barrier_post((unsigned*)(ws_fresh(ka) + WS_CTL) + CW_BAR, (volatile LAS unsigned*)(F.lds + LDSCTL_OFF + 32));
#define GRID_BAR() xcd_barrier(bar)
    const int bx = blockIdx.x;

    if (PH(0)) modv_phase(F, ka);
    for (int rep_ = 0; rep_ < REPS(2); ++rep_) if (PH(2)) convert_weights(F, ka, 0);
    GRID_BAR();
    if (PH(3)) row_phase(F, ka, 0);
    GRID_BAR();

    for (int l = 0; l < NL; ++l) {
        const bool last = (l == NL - 1);
        const int nMe = last ? MLAT / 256 : MT / 256;
        const int nMs = last ? NSLOT_LAT / 256 : NSLOT / 256;
        for (int rep_ = 0; rep_ < REPS(4); ++rep_) if (PH(4)) { unsigned char* ws = ws_fresh(ka);
            { pg8::Gemm g{(const bf16_t*)(ws + WS_R4), (const bf16_t*)(ws + WS_W + W_IN), 1024, 1024, 1024, 0}; pg8::Order S; S.init(MT / 256, DINP / 256, F.G, bx);
              pg8::EpiStoreBf16 E{(bf16_t*)(ws + WS_HW), DINP}; pg8::gemm_phase(F.lds, g, S, E); }
            { pg8::Gemm g{(const bf16_t*)(ws + WS_R4 + 68 * MiB), (const bf16_t*)(ws + WS_W + W_GL), 1024, 1024, 1024, 0}; pg8::Order S; S.init(MT / 256, NGL / 256, F.G, (bx + F.G / 2) % F.G);
              pg8::EpiGate E{ws + WS_G}; pg8::gemm_phase<pg8::EpiGate, true>(F.lds, g, S, E); } }
        GRID_BAR();
        for (int rep_ = 0; rep_ < REPS(5); ++rep_) if (PH(5)) { unsigned char* ws = ws_fresh(ka); pg8::Gemm g{(const bf16_t*)(ws + WS_HW) + C_CQ, (const bf16_t*)(ws + WS_W + W_UP), 384, DINP, 384, 0}; pg8::Order S; S.init(MT / 256, UW / 256, F.G, bx);
            pg8::EpiStoreBf16 E{(bf16_t*)(ws + WS_R4), UW}; pg8::gemm_phase(F.lds, g, S, E); }
        for (int rep_ = 0; rep_ < REPS(6); ++rep_) if (PH(6)) prep_phase(F, ka, l);
        GRID_BAR();
        for (int rep_ = 0; rep_ < REPS(7); ++rep_) if (PH(7)) prep2_phase(F, ka, l, rep_);
        GRID_BAR();
        for (int rep_ = 0; rep_ < REPS(8); ++rep_) if (PH(8)) attn_phase(F, ka, l);
        GRID_BAR();
        for (int rep_ = 0; rep_ < REPS(9); ++rep_) if (PH(9)) { unsigned char* ws = ws_fresh(ka); pg8::Order S; S.init(nMe, 4, F.G, bx);
          const bf16_t* OC = (const bf16_t*)(ws + WS_OCAT); bf16_t* MG = (bf16_t*)(ws + WS_MERGED); const unsigned char* GL = ws + WS_G;
          { pg8::Gemm3 g{OC, OC + 384, OC + 896, (const bf16_t*)(ws + WS_W + W_NAO), (const bf16_t*)(ws + WS_W + W_MLAO), (const bf16_t*)(ws + WS_W + W_SWAO), OCW, 512}; pg8::EpiMerge3 E{MG, GL}; pg8::gemm_phase3(F.lds, g, S, E); } }
        GRID_BAR();
        if (PH(10)) { unsigned char* ws = ws_fresh(ka); pg8::Gemm g{(const bf16_t*)(ws + WS_MERGED), (const bf16_t*)(ws + WS_W + W_O), 1024, 1024, 1024, 0}; pg8::Order S; S.init(nMe, 4, F.G, bx);
            pg8::EpiResid E{(bf16_t*)(ws + WS_XS), (const float*)(ws + WS_MODV) + (size_t)l * 9 * 6144 + 2 * 1024}; pg8::gemm_phase(F.lds, g, S, E); }
        GRID_BAR();
        for (int rep_ = 0; rep_ < REPS(11); ++rep_) if (PH(11)) norm2_phase(F, ka, l, last ? MLAT : MT);
        GRID_BAR();
        for (int rep_ = 0; rep_ < REPS(12); ++rep_) if (PH(12)) select_phase(F, ka, l);
        GRID_BAR();
        for (int rep_ = 0; rep_ < REPS(13); ++rep_) if (PH(13)) { unsigned char* ws = ws_fresh(ka); pg8::Gemm g{(const bf16_t*)(ws + WS_XG), (const bf16_t*)(ws + WS_W + W_GU), 1024, 1024, 1024, (size_t)2048 * 1024}; pg8::Order S; S.init(nMs, 8, F.G, bx, 1);
            pg8::EpiSwiglu E{ws + WS_ACT}; pg8::gemm_phase<pg8::EpiSwiglu, true>(F.lds, g, S, E); }
        GRID_BAR();
        for (int rep_ = 0; rep_ < REPS(14); ++rep_) if (PH(14)) { unsigned char* ws = ws_fresh(ka); pg8::Gemm g{(const bf16_t*)(ws + WS_ACT), (const bf16_t*)(ws + WS_W + W_DN), 1024, 1024, 1024, (size_t)1024 * 1024}; pg8::Order S; S.init(nMs, 4, F.G, bx, 1);
            pg8::EpiDown E{(bf16_t*)(ws + WS_Y), (const float*)(ws + WS_GATE)}; pg8::gemm_phase<pg8::EpiDown, true>(F.lds, g, S, E); }
        GRID_BAR();
        for (int rep_ = 0; rep_ < REPS(15); ++rep_) if (PH(15)) row_phase(F, ka, l + 1, rep_);
        if (!last) { for (int rep_ = 0; rep_ < REPS(16); ++rep_) if (PH(16)) convert_weights(F, ka, l + 1); GRID_BAR(); }
    }
}

extern "C" void kernel_launch(void* const* d_in, const int* in_sizes, int n_in, void* d_out, int out_size, void* d_ws, size_t ws_size, hipStream_t stream) {
    static int grid = 0;
    if (grid == 0) {
        if (n_in != 29 || in_sizes[0] != MLAT * D || out_size != MLAT * D || ws_size < WS_END) {
            fprintf(stderr, "kernel_launch: unexpected problem: n_in %d in0 %d out %d ws %zu (need %zu)\n", n_in, n_in > 0 ? in_sizes[0] : -1, out_size, ws_size, (size_t)WS_END); grid = -1; return; }
        int dev = 0, cus = 0, per_cu = 0;
        if (hipGetDevice(&dev) != hipSuccess || hipDeviceGetAttribute(&cus, hipDeviceAttributeMultiprocessorCount, dev) != hipSuccess) { fprintf(stderr, "kernel_launch: device query failed\n"); grid = -1; return; }
        if (hipFuncSetAttribute((const void*)mega_fwd, hipFuncAttributeMaxDynamicSharedMemorySize, LDS_BYTES) != hipSuccess) { fprintf(stderr, "kernel_launch: hipFuncSetAttribute failed\n"); grid = -1; return; }
        if (hipOccupancyMaxActiveBlocksPerMultiprocessor(&per_cu, (const void*)mega_fwd, 512, LDS_BYTES) != hipSuccess || per_cu < 1) {
            fprintf(stderr, "kernel_launch: occupancy query reports %d workgroups per CU\n", per_cu); }
        (void)hipGetLastError();
        grid = cus;
    }
    if (grid < 0) return;
    if (hipMemsetAsync((char*)d_ws + WS_CTL, 0, CTL_BYTES, stream) != hipSuccess) { fprintf(stderr, "kernel_launch: memset failed\n"); return; }
    Args a{};
    for (int i = 0; i < 29; ++i) a.in[i] = (const float*)d_in[i];
    a.out = (float*)d_out; a.ws = (unsigned char*)d_ws;
    hipLaunchKernelGGL(mega_fwd, dim3(grid), dim3(512), LDS_BYTES, stream, a);
    const hipError_t le = hipPeekAtLastError();
    if (le != hipSuccess) fprintf(stderr, "kernel_launch: launch failed: %s\n", hipGetErrorName(le));
}
```

```cpp
#include <hip/hip_runtime.h>
#include <cstdio>
#include <cstdint>

#define DI __device__ __forceinline__
#ifndef PH_MASK
#define PH_MASK 0xFFFFF
#endif
#define PH(b) ((PH_MASK >> (b)) & 1)
#ifndef REP_MASK
#define REP_MASK 0
#endif
#define REPS(b) (1 + ((REP_MASK >> (b)) & 1))
#define LAS __attribute__((address_space(3)))
#define GAS __attribute__((address_space(1)))
typedef unsigned short bf16_t;
typedef short bf16x8 __attribute__((ext_vector_type(8)));
typedef short s16x4 __attribute__((ext_vector_type(4)));
typedef float f32x4 __attribute__((ext_vector_type(4)));
typedef float f32x2 __attribute__((ext_vector_type(2)));
typedef float f32x16 __attribute__((ext_vector_type(16)));
typedef unsigned u32x4 __attribute__((ext_vector_type(4)));
typedef unsigned u32x2 __attribute__((ext_vector_type(2)));
typedef int i32x8 __attribute__((ext_vector_type(8)));

constexpr int D = 1024, NB = 8, SEQ = 4096, NL = 4, CTX = 256;
constexpr int MLAT = NB * SEQ, MCTX = NB * CTX, MT = MLAT + MCTX;
constexpr int DIN = 5312, DINP = 2304, NGL = 3072;
constexpr int C_NAQ = 0, C_NAK = 384, C_NAV = 768, C_CQ = 1152, C_CKV = 1408, C_KR = 1536, C_SWQ = 1600, C_SWK = 1984, C_SWV = 2112, C_GL = 2240;
constexpr int UW = 1792;
constexpr int P1W = 1280;
constexpr int P2W = 1536;
constexpr int OCW = 1280;
constexpr int NE = 16, CAP_LAT = 512, CAP_CTX = 32;
constexpr int NSLOT_LAT = NB * NE * CAP_LAT, NSLOT = NSLOT_LAT + NB * NE * CAP_CTX;
constexpr float EPS = 1e-6f;
constexpr float LOG2E = 1.4426950408889634f;

constexpr size_t MiB = 1u << 20;
constexpr size_t WS_CTL = 0, CTL_BYTES = 1 * MiB;
constexpr size_t WS_MODV = 1 * MiB;
constexpr size_t WS_W = 2 * MiB;
constexpr size_t W_IN = 0, W_GL = 4718592  , W_UP = 11010048, W_NAO = 7864320  , W_MLAO = 13172736, W_SWAO = 8912896  , W_O = 15007744, W_GU = 17104896, W_DN = 84213760, W_END = 117768192;
constexpr size_t WS_XS = 115 * MiB;
constexpr size_t WS_HW = 251 * MiB;
constexpr size_t WS_G = WS_HW + 153 * MiB;
constexpr size_t WS_P1 = 608 * MiB;
constexpr size_t WS_P2 = 693 * MiB;
constexpr size_t WS_R4 = 795 * MiB;
constexpr size_t WS_AFL = 914 * MiB;
constexpr size_t WS_AFC = 916 * MiB;
constexpr size_t WS_SMAP = 917 * MiB;
constexpr size_t WS_GATE = 920 * MiB;
constexpr size_t WS_OCAT = 921 * MiB;
constexpr size_t WS_END = 1006 * MiB;
constexpr size_t WS_MERGED = WS_P1;
constexpr size_t WS_H2 = WS_HW;
constexpr size_t WS_XG = WS_HW + 68 * MiB;
constexpr size_t WS_ACT = WS_HW + 204 * MiB;
constexpr size_t WS_Y = WS_HW + 340 * MiB;
static_assert(W_END <= 113 * MiB && WS_W + 113 * MiB <= WS_XS, "weights");
static_assert(WS_XS + (size_t)MT * D * 4 <= WS_HW && WS_HW + (size_t)MT * DINP * 2 <= WS_G && WS_G + (size_t)MT * NGL * 2 <= WS_P1 && WS_P1 + (size_t)MT * P1W * 2 <= WS_P2 && WS_P2 + (size_t)MT * P2W * 2 <= WS_R4, "map");
static_assert(WS_R4 + (size_t)MT * UW * 2 <= WS_AFL && WS_Y + (size_t)NSLOT * D * 2 <= WS_R4 && WS_SMAP + (size_t)16 * MT * 4 <= WS_GATE && WS_GATE + (size_t)NSLOT * 4 <= WS_OCAT && WS_OCAT + (size_t)MT * OCW * 2 <= WS_END, "map2");
constexpr int CW_BAR = 4096;

constexpr int RING_BYTES = 131072, LDSCTL_OFF = RING_BYTES, LDS_BYTES = 147456;

DI unsigned pk2(float lo, float hi) { unsigned r; asm("v_cvt_pk_bf16_f32 %0, %1, %2" : "=v"(r) : "v"(lo), "v"(hi)); return r; }
DI unsigned pk4_fp8(float a, float b, float c, float d) { int w = 0; w = __builtin_amdgcn_cvt_pk_fp8_f32(a, b, w, false); w = __builtin_amdgcn_cvt_pk_fp8_f32(c, d, w, true); return (unsigned)w; }
DI float bflo(unsigned w) { return __uint_as_float(w << 16); }
DI float bfhi(unsigned w) { return __uint_as_float(w & 0xffff0000u); }
DI float bf2f(bf16_t b) { return __uint_as_float((unsigned)b << 16); }
DI float wave_sum(float v) {
#pragma unroll
    for (int o = 1; o < 64; o <<= 1) v += __shfl_xor(v, o);
    return v;
}
DI float sigmoidf_(float x) { return __builtin_amdgcn_rcpf(1.0f + __builtin_amdgcn_exp2f(-x * LOG2E)); }
DI int mod_index(int row) { return row < MLAT ? (row >> 12) : 8; }

#define XB_TMO      128
#define XB_XCNT(j)  (256  + 64 * (j))
#define XB_XSUB(j)  (1280 + 64 * (j))
#define XB_XGEN(j)  (2304 + 64 * (j))
#define XB_TOP      3328
#define XB_TOPGEN   3392
#define XCD_BAR_WORDS 3456
#define XB_SPIN_CAP (1u << 18)
DI unsigned xb_ld(unsigned* p)              { return __hip_atomic_load(p, __ATOMIC_RELAXED, __HIP_MEMORY_SCOPE_AGENT); }
DI unsigned xb_add(unsigned* p, unsigned v) { return __hip_atomic_fetch_add(p, v, __ATOMIC_RELAXED, __HIP_MEMORY_SCOPE_AGENT); }
DI unsigned xb_xcc_id() { return (unsigned)__builtin_amdgcn_s_getreg((3 << 11) | 20) & 0xFu; }
#define XB_SPIN(cond, bar) do { unsigned _sp = 0; while (cond) { __builtin_amdgcn_s_sleep(1); \
    if ((++_sp & 255u) == 0u) { if (xb_ld(&(bar)[XB_TMO])) break; if (_sp > XB_SPIN_CAP) { atomicAdd(&(bar)[XB_TMO], 1u); break; } } } } while (0)
struct XcdBarrier { unsigned* bar; unsigned x; volatile LAS unsigned* st; };
DI XcdBarrier xcd_barrier_post(unsigned* bar, volatile LAS unsigned* st) {
    XcdBarrier b; b.bar = bar; b.x = xb_xcc_id(); b.st = st;
    if (threadIdx.x == 0) (void)xb_add(&bar[XB_XCNT(b.x)], 1u);
    return b;
}
DI void xcd_barrier_complete(unsigned* bar, unsigned x, unsigned& nloc, unsigned& nx) {
    const unsigned G = gridDim.x * gridDim.y * gridDim.z;
    unsigned sum, cnt, mine, sp = 0u;
    for (;;) {
        sum = 0u; cnt = 0u; mine = 0u;
#pragma unroll
        for (unsigned j = 0; j < 16; ++j) { const unsigned c = xb_ld(&bar[XB_XCNT(j)]); sum += c; cnt += (c > 0u) ? 1u : 0u; mine = (j == x) ? c : mine; }
        if (sum == G) break;
        __builtin_amdgcn_s_sleep(1);
        if ((++sp & 255u) == 0u) { if (xb_ld(&bar[XB_TMO])) break; if (sp > XB_SPIN_CAP) { atomicAdd(&bar[XB_TMO], 1u); break; } }
    }
    nloc = mine > 0u ? mine : 1u; nx = cnt > 0u ? cnt : 1u;
}
DI void xcd_barrier(const XcdBarrier& b) {
    asm volatile("s_waitcnt vmcnt(0)" ::: "memory");
    __syncthreads();
    if (threadIdx.x == 0) {
        unsigned* bar = b.bar; unsigned bx_ = b.x; asm volatile("" : "+s"(bar), "+s"(bx_));
        __builtin_amdgcn_s_waitcnt(0);
        unsigned nloc = b.st[0], nx = b.st[1];
        if (nloc == 0u) { xcd_barrier_complete(bar, bx_, nloc, nx); b.st[0] = nloc; b.st[1] = nx; }
        const unsigned old = xb_add(&bar[XB_XSUB(bx_)], 1u);
        const unsigned gen = old / nloc;
        if (old + 1u == (gen + 1u) * nloc) {
            __builtin_amdgcn_fence(__ATOMIC_RELEASE, "agent");
            asm volatile("s_waitcnt vmcnt(0)" ::: "memory");
            const unsigned og = xb_add(&bar[XB_TOP], 1u);
            const unsigned tg = og / nx;
            if (og + 1u == (tg + 1u) * nx) xb_add(&bar[XB_TOPGEN], 1u);
            else XB_SPIN(xb_ld(&bar[XB_TOPGEN]) == tg, bar);
            __builtin_amdgcn_fence(__ATOMIC_ACQUIRE, "agent");
            xb_add(&bar[XB_XGEN(bx_)], 1u);
            asm volatile("s_waitcnt vmcnt(0)" ::: "memory");
        } else {
            XB_SPIN(xb_ld(&bar[XB_XGEN(bx_)]) == gen, bar);
            __builtin_amdgcn_fence(__ATOMIC_ACQUIRE, "agent");
            asm volatile("s_waitcnt vmcnt(0)" ::: "memory");
        }
    }
    __syncthreads();
}

namespace pg8 {
constexpr int BM = 256, BK = 64, HALF = 128, HTB = HALF * BK * 2, NXCD = 8, WGM = 8;
__host__ __device__ __forceinline__ int lds_byte(int r, int c) { const int st = (r >> 4) * 2 + (c >> 5), rr = r & 15, cc = c & 31, ob = rr * 64 + cc * 2; return st * 1024 + (ob ^ (((ob >> 9) & 1) << 5)); }
__host__ __device__ __forceinline__ void stage_rc(int b, int& R, int& C) { const int st = b / 1024, sb = b % 1024, swz = sb ^ (((sb >> 9) & 1) << 5); R = (st >> 1) * 16 + swz / 64; C = (st & 1) * 32 + (swz % 64) / 2; }
__host__ __device__ __forceinline__ int perm32(int rho) { const int n = rho >> 4, i = rho & 15; return 8 * (i >> 2) + 4 * n + (i & 3); }
struct Unit { int pm, pn; };
struct Gemm { const bf16_t* A; const bf16_t* Bt; int K, lda, ldb; size_t estride; };
struct Order {
    int nM, nN, nwg, G, c, moe;
    DI void init(int nM_, int nN_, int G_, int c_, int moe_ = 0) { nM = nM_; nN = nN_; nwg = nM * nN; G = G_; c = c_; moe = moe_; }
    DI bool next(int i, Unit& u) const {
        const long L = (long)i * G + c; if (L >= nwg) return false;
        int wgid = (int)L; { const int q = nwg / NXCD, r = nwg % NXCD, xcd = wgid % NXCD, off = wgid / NXCD; wgid = (xcd < r ? xcd * (q + 1) : r * (q + 1) + (xcd - r) * q) + off; }
        const int nig = WGM * nN, gid = wgid / nig, fm = gid * WGM, gsz = (nM - fm) < WGM ? (nM - fm) : WGM;
        u.pm = fm + ((wgid % nig) % gsz); u.pn = (wgid % nig) / gsz;
        if (moe && u.pm < 256) { const int e = u.pm >> 4, b = (u.pm >> 1) & 7, hf = u.pm & 1; u.pm = (((b << 4) | e) << 1) | hf; }
        return true;
    }
};
struct EpiStoreBf16 {
    static constexpr bool PERM = true;
    bf16_t* O; int ldc;
    DI void operator()(const f32x4 (&acc)[2][2][4][2], const Unit& u, int wr, int wc, int fr, int fq) const {
        const int row0 = u.pm * BM + wr * 64 + fr, col0 = u.pn * BM + wc * 32 + 8 * fq;
#pragma unroll
        for (int ai = 0; ai < 2; ++ai)
#pragma unroll
            for (int m = 0; m < 4; ++m) { bf16_t* rowp = O + (size_t)(row0 + ai * HALF + m * 16) * ldc + col0;
#pragma unroll
                for (int bj = 0; bj < 2; ++bj) { const f32x4 v0 = acc[ai][bj][m][0], v1 = acc[ai][bj][m][1];
                    u32x4 w; w.x = pk2(v0[0], v0[1]); w.y = pk2(v0[2], v0[3]); w.z = pk2(v1[0], v1[1]); w.w = pk2(v1[2], v1[3]);
                    *(u32x4*)(rowp + bj * HALF) = w; } }
    }
};
DI unsigned pk4_u8(float a, float b, float c, float d) {
    unsigned ua = (unsigned)(a * 255.0f + 0.5f), ub = (unsigned)(b * 255.0f + 0.5f), uc = (unsigned)(c * 255.0f + 0.5f), ud = (unsigned)(d * 255.0f + 0.5f);
    ua = ua < 1u ? 1u : ua; ub = ub < 1u ? 1u : ub; uc = uc < 1u ? 1u : uc; ud = ud < 1u ? 1u : ud;
    return ua | (ub << 8) | (uc << 16) | (ud << 24);
}
struct EpiGate {
    static constexpr bool PERM = true;
    unsigned char* O;
    DI void operator()(const f32x4 (&acc)[2][2][4][2], const Unit& u, int wr, int wc, int fr, int fq) const {
        const int row0 = u.pm * BM + wr * 64 + fr, col0 = u.pn * BM + wc * 32 + 8 * fq;
#pragma unroll
        for (int ai = 0; ai < 2; ++ai)
#pragma unroll
            for (int m = 0; m < 4; ++m) { unsigned char* rowp = O + (size_t)(row0 + ai * HALF + m * 16) * NGL + col0;
#pragma unroll
                for (int bj = 0; bj < 2; ++bj) { const f32x4 v0 = acc[ai][bj][m][0] * 0.03125f, v1 = acc[ai][bj][m][1] * 0.03125f;
                    u32x2 w; w.x = pk4_u8(sigmoidf_(v0[0]), sigmoidf_(v0[1]), sigmoidf_(v0[2]), sigmoidf_(v0[3])); w.y = pk4_u8(sigmoidf_(v1[0]), sigmoidf_(v1[1]), sigmoidf_(v1[2]), sigmoidf_(v1[3]));
                    *(u32x2*)(rowp + bj * HALF) = w; } }
    }
};
DI float u8f(unsigned w, int k) { return (float)((w >> (8 * k)) & 0xffu) * (1.0f / 255.0f); }
struct EpiMerge {
    static constexpr bool PERM = true;
    bf16_t* O; const unsigned char* gl; int first;
    DI void operator()(const f32x4 (&acc)[2][2][4][2], const Unit& u, int wr, int wc, int fr, int fq) const {
        const int row0 = u.pm * BM + wr * 64 + fr, col0 = u.pn * BM + wc * 32 + 8 * fq;
#pragma unroll
        for (int ai = 0; ai < 2; ++ai) {
            u32x2 g[4][2]; u32x4 p[4][2];
#pragma unroll
            for (int m = 0; m < 4; ++m)
#pragma unroll
                for (int bj = 0; bj < 2; ++bj) { const int row = row0 + ai * HALF + m * 16, col = col0 + bj * HALF;
                    g[m][bj] = *(const u32x2*)(gl + (size_t)row * NGL + col);
                    p[m][bj] = first ? (u32x4){0u, 0u, 0u, 0u} : *(const u32x4*)(O + (size_t)row * D + col); }
#pragma unroll
            for (int m = 0; m < 4; ++m)
#pragma unroll
                for (int bj = 0; bj < 2; ++bj) { const int row = row0 + ai * HALF + m * 16, col = col0 + bj * HALF;
                    const u32x2 gg = g[m][bj]; const u32x4 pp = p[m][bj]; const f32x4 v0 = acc[ai][bj][m][0], v1 = acc[ai][bj][m][1];
                    const float r0 = v0[0] * u8f(gg.x, 0) + bflo(pp.x), r1 = v0[1] * u8f(gg.x, 1) + bfhi(pp.x), r2 = v0[2] * u8f(gg.x, 2) + bflo(pp.y), r3 = v0[3] * u8f(gg.x, 3) + bfhi(pp.y);
                    const float r4 = v1[0] * u8f(gg.y, 0) + bflo(pp.z), r5 = v1[1] * u8f(gg.y, 1) + bfhi(pp.z), r6 = v1[2] * u8f(gg.y, 2) + bflo(pp.w), r7 = v1[3] * u8f(gg.y, 3) + bfhi(pp.w);
                    u32x4 w; w.x = pk2(r0, r1); w.y = pk2(r2, r3); w.z = pk2(r4, r5); w.w = pk2(r6, r7);
                    *(u32x4*)(O + (size_t)row * D + col) = w; }
        }
    }
};
struct EpiResid {
    static constexpr bool PERM = true;
    bf16_t* xs; const float* modg;
    DI void operator()(const f32x4 (&acc)[2][2][4][2], const Unit& u, int wr, int wc, int fr, int fq) const {
        const int row0 = u.pm * BM + wr * 64 + fr, col0 = u.pn * BM + wc * 32 + 8 * fq;
        const float* mp = modg + (size_t)mod_index(u.pm * BM) * 6144 + col0;
        f32x4 g0[2], g1[2];
#pragma unroll
        for (int bj = 0; bj < 2; ++bj) { g0[bj] = *(const f32x4*)(mp + bj * HALF) * (1.0f / 128.0f); g1[bj] = *(const f32x4*)(mp + bj * HALF + 4) * (1.0f / 128.0f); }
#pragma unroll
        for (int ai = 0; ai < 2; ++ai)
#pragma unroll
            for (int mh = 0; mh < 2; ++mh) {
                u32x4 xw[2][2];
#pragma unroll
                for (int m2 = 0; m2 < 2; ++m2)
#pragma unroll
                    for (int bj = 0; bj < 2; ++bj) xw[m2][bj] = *(const u32x4*)(xs + (size_t)(row0 + ai * HALF + (2 * mh + m2) * 16) * D + col0 + bj * HALF);
#pragma unroll
                for (int m2 = 0; m2 < 2; ++m2)
#pragma unroll
                    for (int bj = 0; bj < 2; ++bj) { const int m = 2 * mh + m2; const u32x4 x = xw[m2][bj];
                        const f32x4 x0 = (f32x4){bflo(x.x), bfhi(x.x), bflo(x.y), bfhi(x.y)} + g0[bj] * acc[ai][bj][m][0];
                        const f32x4 x1 = (f32x4){bflo(x.z), bfhi(x.z), bflo(x.w), bfhi(x.w)} + g1[bj] * acc[ai][bj][m][1];
                        u32x4 w; w.x = pk2(x0[0], x0[1]); w.y = pk2(x0[2], x0[3]); w.z = pk2(x1[0], x1[1]); w.w = pk2(x1[2], x1[3]);
                        *(u32x4*)(xs + (size_t)(row0 + ai * HALF + m * 16) * D + col0 + bj * HALF) = w; }
            }
    }
};
struct EpiSwiglu {
    static constexpr bool PERM = true;
    unsigned char* O;
    DI void operator()(const f32x4 (&acc)[2][2][4][2], const Unit& u, int wr, int wc, int fr, int fq) const {
        const int row0 = u.pm * BM + wr * 64 + fr, col0 = u.pn * HALF + wc * 32 + 8 * fq;
#pragma unroll
        for (int ai = 0; ai < 2; ++ai)
#pragma unroll
            for (int m = 0; m < 4; ++m) { const int row = row0 + ai * HALF + m * 16;
                const f32x4 a0 = acc[ai][0][m][0] * 0.03125f, a1 = acc[ai][0][m][1] * 0.03125f, u0 = acc[ai][1][m][0] * 0.25f, u1 = acc[ai][1][m][1] * 0.25f;
                float r[8];
#pragma unroll
                for (int j = 0; j < 4; ++j) { r[j] = a0[j] * sigmoidf_(a0[j]) * u0[j]; r[4 + j] = a1[j] * sigmoidf_(a1[j]) * u1[j]; }
                u32x2 w; w.x = pk4_fp8(r[0], r[1], r[2], r[3]); w.y = pk4_fp8(r[4], r[5], r[6], r[7]);
                *(u32x2*)(O + (size_t)row * D + col0) = w; }
    }
};
struct EpiDown {
    static constexpr bool PERM = true;
    bf16_t* O; const float* gate;
    DI void operator()(const f32x4 (&acc)[2][2][4][2], const Unit& u, int wr, int wc, int fr, int fq) const {
        const int row0 = u.pm * BM + wr * 64 + fr, col0 = u.pn * BM + wc * 32 + 8 * fq;
        float gv[2][4];
#pragma unroll
        for (int ai = 0; ai < 2; ++ai)
#pragma unroll
            for (int m = 0; m < 4; ++m) gv[ai][m] = gate[row0 + ai * HALF + m * 16] * (1.0f / 256.0f);
#pragma unroll
        for (int ai = 0; ai < 2; ++ai)
#pragma unroll
            for (int m = 0; m < 4; ++m) { const int row = row0 + ai * HALF + m * 16; const float g = gv[ai][m]; bf16_t* rowp = O + (size_t)row * D + col0;
#pragma unroll
                for (int bj = 0; bj < 2; ++bj) { const f32x4 v0 = acc[ai][bj][m][0] * g, v1 = acc[ai][bj][m][1] * g;
                    u32x4 w; w.x = pk2(v0[0], v0[1]); w.y = pk2(v0[2], v0[3]); w.z = pk2(v1[0], v1[1]); w.w = pk2(v1[2], v1[3]);
                    *(u32x4*)(rowp + bj * HALF) = w; } }
    }
};

struct EpiMerge3 {
    static constexpr bool PERM = true;
    bf16_t* O; const unsigned char* gl;
    DI void operator()(f32x4 (&acc)[2][2][4][2], const Unit& u, int seg, int wr, int wc, int fr, int fq) const {
        const int row0 = u.pm * BM + wr * 64 + fr, col0 = u.pn * BM + wc * 32 + 8 * fq;
#pragma unroll
        for (int ai = 0; ai < 2; ++ai) {
            u32x2 ga[4][2], gb[4][2];
#pragma unroll
            for (int m = 0; m < 4; ++m)
#pragma unroll
                for (int bj = 0; bj < 2; ++bj) { const unsigned char* gp = gl + (size_t)(row0 + ai * HALF + m * 16) * NGL + 1024 * seg + col0 + bj * HALF;
                    ga[m][bj] = *(const u32x2*)gp; gb[m][bj] = seg < 2 ? *(const u32x2*)(gp + 1024) : (u32x2){0u, 0u}; }
#pragma unroll
            for (int m = 0; m < 4; ++m)
#pragma unroll
                for (int bj = 0; bj < 2; ++bj) {
                    f32x4 s0, s1;
#pragma unroll
                    for (int k = 0; k < 4; ++k) { const float a0 = (float)((ga[m][bj].x >> (8 * k)) & 0xffu), a1 = (float)((ga[m][bj].y >> (8 * k)) & 0xffu);
                        if (seg < 2) { const float b0 = (float)((gb[m][bj].x >> (8 * k)) & 0xffu), b1 = (float)((gb[m][bj].y >> (8 * k)) & 0xffu); s0[k] = a0 * __builtin_amdgcn_rcpf(b0); s1[k] = a1 * __builtin_amdgcn_rcpf(b1); }
                        else { s0[k] = a0 * (1.0f / 255.0f); s1[k] = a1 * (1.0f / 255.0f); } }
                    acc[ai][bj][m][0] *= s0; acc[ai][bj][m][1] *= s1;
                    if (seg == 2) { const f32x4 v0 = acc[ai][bj][m][0] * 4.0f, v1 = acc[ai][bj][m][1] * 4.0f;
                        u32x2 w; w.x = pk4_fp8(v0[0], v0[1], v0[2], v0[3]); w.y = pk4_fp8(v1[0], v1[1], v1[2], v1[3]);
                        *(u32x2*)((unsigned char*)O + (size_t)(row0 + ai * HALF + m * 16) * D + col0 + bj * HALF) = w; }
                }
        }
    }
};
struct Gemm3 { const bf16_t* A0; const bf16_t* A1; const bf16_t* A2; const bf16_t* B0; const bf16_t* B1; const bf16_t* B2; int lda, ldb; };
template <class Epi>
DI void gemm_phase3(LAS unsigned char* lds, const Gemm3 g, const Order& S, const Epi& E) {
    int tid_ = threadIdx.x; asm volatile("" : "+v"(tid_));
    const int tid = tid_, wid = __builtin_amdgcn_readfirstlane(tid >> 6), lane = tid & 63, wr = wid >> 2, wc = wid & 3, fr = lane & 15, fq = lane >> 4;
    unsigned voffA[2], voffB[2];
#pragma unroll
    for (int i = 0; i < 2; ++i) { int R, C; stage_rc(tid * 16 + i * 8192, R, C); const int Rb = Epi::PERM ? ((R & ~31) + perm32(R & 31)) : R;
        voffA[i] = (unsigned)(R * g.lda * 2 + C * 2); voffB[i] = (unsigned)(Rb * g.ldb * 2 + C * 2); }
    const size_t kstep = (size_t)(BK * 2);
    const size_t hstepA = (size_t)HALF * g.lda * 2, hstepB = (size_t)HALF * g.ldb * 2;
    const size_t tstepA = 2 * hstepA, tstepB = 2 * hstepB;
    const unsigned ldsw = (unsigned)wid * 1024u;
    const int aoff = lds_byte(wr * 64 + fr, fq * 8), boff = lds_byte(wc * 32 + fr, fq * 8);
#define PG8_SA(b, h) (((b) * 2 + (h)) * HTB)
#define PG8_SB(b, h) ((4 + (b) * 2 + (h)) * HTB)
#define PG8_STAGE(bufoff, gbase, voff) do { _Pragma("unroll") for (int _i = 0; _i < 2; ++_i) \
        __builtin_amdgcn_global_load_lds((const unsigned*)((const char*)(gbase) + (voff)[_i]), (LAS unsigned*)(lds + (bufoff) + ldsw + _i * 8192), 16, 0, 0); } while (0)
#define PG8_LDA(dst, b, h) do { _Pragma("unroll") for (int m = 0; m < 4; ++m) _Pragma("unroll") for (int k = 0; k < 2; ++k) dst[m][k] = *(const LAS bf16x8*)(lds + PG8_SA(b, h) + aoff + m * 2048 + k * 1024); } while (0)
#define PG8_LDB(dst, b, h) do { _Pragma("unroll") for (int n = 0; n < 2; ++n) _Pragma("unroll") for (int k = 0; k < 2; ++k) dst[n][k] = *(const LAS bf16x8*)(lds + PG8_SB(b, h) + boff + n * 2048 + k * 1024); } while (0)
#define PG8_MMA(ai, bj, At, Bt) do { __builtin_amdgcn_s_setprio(1); _Pragma("unroll") for (int m = 0; m < 4; ++m) _Pragma("unroll") for (int n = 0; n < 2; ++n) _Pragma("unroll") for (int k = 0; k < 2; ++k) \
        acc[ai][bj][m][n] = __builtin_amdgcn_mfma_f32_16x16x32_bf16(Bt[n][k], At[m][k], acc[ai][bj][m][n], 0, 0, 0); __builtin_amdgcn_s_setprio(0); } while (0)
#define PG8_WAIT_V(n) asm volatile("s_waitcnt vmcnt(" #n ")" ::: "memory")
#define PG8_WAIT_L(n) asm volatile("s_waitcnt lgkmcnt(" #n ")" ::: "memory")
#define PG8_BAR __builtin_amdgcn_s_barrier()
#define PG8_SCHED __builtin_amdgcn_sched_barrier(0)
#define PG8_A3(sg, u) ((const char*)((sg) == 0 ? g.A0 : (sg) == 1 ? g.A1 : g.A2) + (size_t)(u).pm * tstepA)
#define PG8_B3(sg, u) ((const char*)((sg) == 0 ? g.B0 : (sg) == 1 ? g.B1 : g.B2) + (size_t)(u).pn * tstepB)
    Unit cur, nu; int ui = 0, seg = 0;
    if (!S.next(0, cur)) return;
    f32x4 acc[2][2][4][2];
#pragma unroll
    for (int a = 0; a < 2; ++a)
#pragma unroll
        for (int b = 0; b < 2; ++b)
#pragma unroll
            for (int m = 0; m < 4; ++m)
#pragma unroll
                for (int n = 0; n < 2; ++n) acc[a][b][m][n] = (f32x4){0.f, 0.f, 0.f, 0.f};
    bf16x8 At[4][2], B0[2][2], B1[2][2];
    const char* cA = PG8_A3(0, cur); const char* cB = PG8_B3(0, cur);
    PG8_STAGE(PG8_SB(0, 0), cB, voffB); PG8_STAGE(PG8_SB(0, 1), cB + hstepB, voffB); PG8_STAGE(PG8_SA(0, 0), cA, voffA); PG8_STAGE(PG8_SA(0, 1), cA + hstepA, voffA);
    if (wr == 1) PG8_BAR;
    PG8_WAIT_V(2); PG8_BAR;
    PG8_STAGE(PG8_SB(1, 0), cB + kstep, voffB); PG8_STAGE(PG8_SA(1, 0), cA + kstep, voffA); PG8_STAGE(PG8_SB(1, 1), cB + hstepB + kstep, voffB);
    PG8_WAIT_V(6); PG8_BAR;
    for (;;) {
        int nseg = seg + 1; bool has_next = true; nu = cur;
        if (nseg == 3) { nseg = 0; has_next = S.next(ui + 1, nu); }
        const char* nA = has_next ? PG8_A3(nseg, nu) : cA; const char* nB = has_next ? PG8_B3(nseg, nu) : cB;
        int nt_ = (seg == 1) ? 8 : 6; asm volatile("" : "+s"(nt_));
        const int nt = nt_;
#pragma nounroll
        for (int t = 0; t < nt; t += 2) {
            const bool last = (t == nt - 2);
            const char* a1 = cA + (size_t)(t + 1) * kstep;
            const char* a2 = last ? nA : cA + (size_t)(t + 2) * kstep; const char* b2 = last ? nB : cB + (size_t)(t + 2) * kstep;
            const char* a3 = a2 + kstep; const char* b3 = b2 + kstep;
            PG8_LDB(B0, 0, 0); PG8_LDB(B1, 0, 1); PG8_SCHED; PG8_LDA(At, 0, 0); PG8_STAGE(PG8_SA(1, 1), a1 + hstepA, voffA);
            PG8_WAIT_V(8); PG8_WAIT_L(0); PG8_BAR; PG8_MMA(0, 0, At, B0); PG8_MMA(0, 1, At, B1); PG8_BAR; PG8_SCHED;
            PG8_LDA(At, 0, 1); PG8_STAGE(PG8_SB(0, 0), b2, voffB); PG8_STAGE(PG8_SB(0, 1), b2 + hstepB, voffB); PG8_STAGE(PG8_SA(0, 0), a2, voffA);
            PG8_WAIT_V(8); PG8_WAIT_L(0); PG8_BAR; PG8_MMA(1, 0, At, B0); PG8_MMA(1, 1, At, B1); PG8_BAR; PG8_SCHED;
            PG8_LDB(B0, 1, 0); PG8_LDB(B1, 1, 1); PG8_SCHED; PG8_LDA(At, 1, 0); PG8_STAGE(PG8_SA(0, 1), a2 + hstepA, voffA);
            PG8_WAIT_V(8); PG8_WAIT_L(0); PG8_BAR; PG8_MMA(0, 0, At, B0); PG8_MMA(0, 1, At, B1); PG8_BAR; PG8_SCHED;
            PG8_LDA(At, 1, 1); PG8_STAGE(PG8_SB(1, 0), b3, voffB); PG8_STAGE(PG8_SB(1, 1), b3 + hstepB, voffB); PG8_STAGE(PG8_SA(1, 0), a3, voffA);
            PG8_WAIT_V(8); PG8_WAIT_L(0); PG8_BAR; PG8_MMA(1, 0, At, B0); PG8_MMA(1, 1, At, B1); PG8_BAR; PG8_SCHED;
        }
        if (wr == 0) PG8_BAR;
        E(acc, cur, seg, wr, wc, fr, fq);
        if (!has_next) break;
        if (seg == 2) {
#pragma unroll
            for (int a = 0; a < 2; ++a)
#pragma unroll
                for (int b = 0; b < 2; ++b)
#pragma unroll
                    for (int m = 0; m < 4; ++m)
#pragma unroll
                        for (int n = 0; n < 2; ++n) acc[a][b][m][n] = (f32x4){0.f, 0.f, 0.f, 0.f};
            cur = nu; ++ui;
        }
        seg = nseg; cA = nA; cB = nB;
        if (wr == 1) PG8_BAR;
    }
    PG8_WAIT_V(0);
    PG8_BAR;
#undef PG8_SA
#undef PG8_SB
#undef PG8_STAGE
#undef PG8_LDA
#undef PG8_LDB
#undef PG8_MMA
#undef PG8_WAIT_V
#undef PG8_WAIT_L
#undef PG8_BAR
#undef PG8_SCHED
#undef PG8_A3
#undef PG8_B3
}

template <class Epi, bool FP8 = false>
DI void gemm_phase(LAS unsigned char* lds, const Gemm g, const Order& S, const Epi& E) {
    constexpr int ESZ = FP8 ? 1 : 2;
    int tid_ = threadIdx.x; asm volatile("" : "+v"(tid_));
    const int tid = tid_, wid = __builtin_amdgcn_readfirstlane(tid >> 6), lane = tid & 63, wr = wid >> 2, wc = wid & 3, fr = lane & 15, fq = lane >> 4;
    const int K = g.K, nt = K * ESZ / (BK * 2);
    unsigned voffA[2], voffB[2];
#pragma unroll
    for (int i = 0; i < 2; ++i) { int R, C; stage_rc(tid * 16 + i * 8192, R, C); const int Rb = Epi::PERM ? ((R & ~31) + perm32(R & 31)) : R;
        voffA[i] = (unsigned)(R * g.lda * ESZ + C * 2); voffB[i] = (unsigned)(Rb * g.ldb * ESZ + C * 2); }
    const size_t kstep = (size_t)(BK * 2);
    const size_t hstepA = (size_t)HALF * g.lda * ESZ, hstepB = (size_t)HALF * g.ldb * ESZ;
    const size_t tstepA = 2 * hstepA, tstepB = 2 * hstepB;
    const unsigned ldsw = (unsigned)wid * 1024u;
    const int aoff = lds_byte(wr * 64 + fr, fq * 8), boff = lds_byte(wc * 32 + fr, fq * 8);
#define PG8_SA(b, h) (((b) * 2 + (h)) * HTB)
#define PG8_SB(b, h) ((4 + (b) * 2 + (h)) * HTB)
#define PG8_STAGE(bufoff, gbase, voff) do { _Pragma("unroll") for (int _i = 0; _i < 2; ++_i) \
        __builtin_amdgcn_global_load_lds((const unsigned*)((const char*)(gbase) + (voff)[_i]), (LAS unsigned*)(lds + (bufoff) + ldsw + _i * 8192), 16, 0, 0); } while (0)
#define PG8_LDA(dst, b, h) do { _Pragma("unroll") for (int m = 0; m < 4; ++m) _Pragma("unroll") for (int k = 0; k < 2; ++k) dst[m][k] = *(const LAS bf16x8*)(lds + PG8_SA(b, h) + aoff + m * 2048 + k * 1024); } while (0)
#define PG8_LDB(dst, b, h) do { _Pragma("unroll") for (int n = 0; n < 2; ++n) _Pragma("unroll") for (int k = 0; k < 2; ++k) dst[n][k] = *(const LAS bf16x8*)(lds + PG8_SB(b, h) + boff + n * 2048 + k * 1024); } while (0)
#define PG8_MMA(ai, bj, At, Bt) do { __builtin_amdgcn_s_setprio(1); _Pragma("unroll") for (int m = 0; m < 4; ++m) _Pragma("unroll") for (int n = 0; n < 2; ++n) { \
        if constexpr (FP8) { const i32x8 bb_ = __builtin_bit_cast(i32x8, __builtin_shufflevector(Bt[n][0], Bt[n][1], 0, 1, 2, 3, 4, 5, 6, 7, 8, 9, 10, 11, 12, 13, 14, 15)); \
            const i32x8 aa_ = __builtin_bit_cast(i32x8, __builtin_shufflevector(At[m][0], At[m][1], 0, 1, 2, 3, 4, 5, 6, 7, 8, 9, 10, 11, 12, 13, 14, 15)); \
            asm volatile("v_mfma_scale_f32_16x16x128_f8f6f4 %0, %1, %2, %0, %3, %3 op_sel_hi:[0,0,0]" : "+v"(acc[ai][bj][m][n]) : "v"(bb_), "v"(aa_), "v"(0x7F7F7F7F)); } \
        else { _Pragma("unroll") for (int k = 0; k < 2; ++k) acc[ai][bj][m][n] = __builtin_amdgcn_mfma_f32_16x16x32_bf16(Bt[n][k], At[m][k], acc[ai][bj][m][n], 0, 0, 0); } } \
        __builtin_amdgcn_s_setprio(0); } while (0)
#define PG8_WAIT_V(n) asm volatile("s_waitcnt vmcnt(" #n ")" ::: "memory")
#define PG8_WAIT_L(n) asm volatile("s_waitcnt lgkmcnt(" #n ")" ::: "memory")
#define PG8_BAR __builtin_amdgcn_s_barrier()
#define PG8_SCHED __builtin_amdgcn_sched_barrier(0)
#define PG8_EXPERT(pm) ((pm) < 256 ? (((pm) >> 1) & 15) : ((pm) - 256))
#define PG8_ABASE(u) ((const char*)g.A + (size_t)(u).pm * tstepA)
#define PG8_BBASE(u) ((const char*)g.Bt + (size_t)PG8_EXPERT((u).pm) * g.estride * ESZ + (size_t)(u).pn * tstepB)
    Unit cur, nxt; int ui = 0;
    if (!S.next(0, cur)) return;
    f32x4 acc[2][2][4][2];
#pragma unroll
    for (int a = 0; a < 2; ++a)
#pragma unroll
        for (int b = 0; b < 2; ++b)
#pragma unroll
            for (int m = 0; m < 4; ++m)
#pragma unroll
                for (int n = 0; n < 2; ++n) acc[a][b][m][n] = (f32x4){0.f, 0.f, 0.f, 0.f};
    bf16x8 At[4][2], B0[2][2], B1[2][2];
    const char* cA = PG8_ABASE(cur); const char* cB = PG8_BBASE(cur);
    PG8_STAGE(PG8_SB(0, 0), cB, voffB); PG8_STAGE(PG8_SB(0, 1), cB + hstepB, voffB); PG8_STAGE(PG8_SA(0, 0), cA, voffA); PG8_STAGE(PG8_SA(0, 1), cA + hstepA, voffA);
    if (wr == 1) PG8_BAR;
    PG8_WAIT_V(2); PG8_BAR;
    PG8_STAGE(PG8_SB(1, 0), cB + kstep, voffB); PG8_STAGE(PG8_SA(1, 0), cA + kstep, voffA); PG8_STAGE(PG8_SB(1, 1), cB + hstepB + kstep, voffB);
    PG8_WAIT_V(6); PG8_BAR;
    for (;;) {
        const bool has_next = S.next(ui + 1, nxt);
        const char* nA = has_next ? PG8_ABASE(nxt) : cA; const char* nB = has_next ? PG8_BBASE(nxt) : cB;
#pragma nounroll
        for (int t = 0; t < nt; t += 2) {
            const bool last = (t == nt - 2);
            const char* a1 = cA + (size_t)(t + 1) * kstep;
            const char* a2 = last ? nA : cA + (size_t)(t + 2) * kstep; const char* b2 = last ? nB : cB + (size_t)(t + 2) * kstep;
            const char* a3 = a2 + kstep; const char* b3 = b2 + kstep;
            PG8_LDB(B0, 0, 0); PG8_LDB(B1, 0, 1); PG8_SCHED; PG8_LDA(At, 0, 0); PG8_STAGE(PG8_SA(1, 1), a1 + hstepA, voffA);
            PG8_WAIT_V(8); PG8_WAIT_L(0); PG8_BAR; PG8_MMA(0, 0, At, B0); PG8_MMA(0, 1, At, B1); PG8_BAR; PG8_SCHED;
            PG8_LDA(At, 0, 1); PG8_STAGE(PG8_SB(0, 0), b2, voffB); PG8_STAGE(PG8_SB(0, 1), b2 + hstepB, voffB); PG8_STAGE(PG8_SA(0, 0), a2, voffA);
            PG8_WAIT_V(8); PG8_WAIT_L(0); PG8_BAR; PG8_MMA(1, 0, At, B0); PG8_MMA(1, 1, At, B1); PG8_BAR; PG8_SCHED;
            PG8_LDB(B0, 1, 0); PG8_LDB(B1, 1, 1); PG8_SCHED; PG8_LDA(At, 1, 0); PG8_STAGE(PG8_SA(0, 1), a2 + hstepA, voffA);
            PG8_WAIT_V(8); PG8_WAIT_L(0); PG8_BAR; PG8_MMA(0, 0, At, B0); PG8_MMA(0, 1, At, B1); PG8_BAR; PG8_SCHED;
            PG8_LDA(At, 1, 1); PG8_STAGE(PG8_SB(1, 0), b3, voffB); PG8_STAGE(PG8_SB(1, 1), b3 + hstepB, voffB); PG8_STAGE(PG8_SA(1, 0), a3, voffA);
            PG8_WAIT_V(8); PG8_WAIT_L(0); PG8_BAR; PG8_MMA(1, 0, At, B0); PG8_MMA(1, 1, At, B1); PG8_BAR; PG8_SCHED;
        }
        if (wr == 0) PG8_BAR;
        E(acc, cur, wr, wc, fr, fq);
        if (!has_next) break;
#pragma unroll
        for (int a = 0; a < 2; ++a)
#pragma unroll
            for (int b = 0; b < 2; ++b)
#pragma unroll
                for (int m = 0; m < 4; ++m)
#pragma unroll
                    for (int n = 0; n < 2; ++n) acc[a][b][m][n] = (f32x4){0.f, 0.f, 0.f, 0.f};
        cur = nxt; cA = nA; cB = nB; ++ui;
        if (wr == 1) PG8_BAR;
    }
    PG8_WAIT_V(0);
    PG8_BAR;
#undef PG8_SA
#undef PG8_SB
#undef PG8_STAGE
#undef PG8_LDA
#undef PG8_LDB
#undef PG8_MMA
#undef PG8_WAIT_V
#undef PG8_WAIT_L
#undef PG8_BAR
#undef PG8_SCHED
}
}

struct Args { const float* in[29]; float* out; unsigned char* ws; };
typedef const __attribute__((address_space(4))) Args* KArgs;
#define KA_FRESH(ka) asm volatile("" : "+s"(ka))
enum { I_X = 0, I_C, I_CTX, I_CCTX, I_N1G, I_N2G, I_WADA, I_BADA, I_WIN, I_NAQG, I_NAKG, I_RPB, I_MQN, I_WUQ, I_MKVN, I_WUKV, I_MQG, I_MKG, I_SWQG, I_SWKG, I_SINK,
       I_WNAO, I_WMLAO, I_WSWAO, I_WO, I_ROUTER, I_WGATE, I_WUP, I_WDOWN };
struct Frame {
    LAS unsigned char* lds;
    int tid, lane, wave, G, vcu, gw, ngw;
};

DI void frame_fresh(Frame& F) { int t = F.tid, w = F.wave, v = F.vcu; asm volatile("" : "+v"(t), "+s"(w), "+s"(v)); F.tid = t; F.lane = t & 63; F.wave = w; F.vcu = v; F.gw = v * 8 + w; }
DI void modv_phase(Frame& F, KArgs ka) {
    KA_FRESH(ka); const __attribute__((address_space(4))) Args& a = *ka; frame_fresh(F);
    LAS float* cact = (LAS float*)F.lds;
    LAS float* red = (LAS float*)(F.lds + 9 * 1024 * 4);
    const float* c = a.in[I_C]; const float* cc = a.in[I_CCTX];
    for (int i = F.tid; i < 9 * 1024; i += 512) { const float v = i < 8192 ? c[i] : cc[i - 8192]; cact[i] = v * sigmoidf_(v); }
    __syncthreads();
    float* modv = (float*)(a.ws + WS_MODV);
    const int cl = F.lane & 31, kp = F.lane >> 5;
    for (int unit = F.vcu; unit < NL * 192; unit += F.G) {
        const int l = unit / 192, n = (unit % 192) * 32 + cl;
        const float* w = a.in[I_WADA] + (size_t)l * 1024 * 6144 + n;
        float acc[9];
#pragma unroll
        for (int i = 0; i < 9; ++i) acc[i] = 0.f;
        const int k0 = F.wave * 128 + kp;
#pragma unroll 16
        for (int k = 0; k < 128; k += 2) { const float wv = w[(size_t)(k0 + k) * 6144];
#pragma unroll
            for (int i = 0; i < 9; ++i) acc[i] += cact[i * 1024 + k0 + k] * wv; }
#pragma unroll
        for (int i = 0; i < 9; ++i) red[((F.wave * 2 + kp) * 9 + i) * 32 + cl] = acc[i];
        __syncthreads();
        for (int t = F.tid; t < 9 * 32; t += 512) { const int i = t >> 5, nn = t & 31; float s = 0.f;
#pragma unroll
            for (int w16 = 0; w16 < 16; ++w16) s += red[(w16 * 9 + i) * 32 + nn];
            const int col = (unit % 192) * 32 + nn;
            modv[((size_t)l * 9 + i) * 6144 + col] = s + a.in[I_BADA][l * 6144 + col]; }
        __syncthreads();
    }
}
DI void copy_phase(Frame& F, KArgs ka) {
    KA_FRESH(ka); const __attribute__((address_space(4))) Args& a = *ka; frame_fresh(F);
    u32x2* xs = (u32x2*)(a.ws + WS_XS);
    const f32x4* x = (const f32x4*)a.in[I_X]; const f32x4* cx = (const f32x4*)a.in[I_CTX];
    const size_t nl = (size_t)MLAT * D / 4, nc = (size_t)MCTX * D / 4;
    for (size_t i = (size_t)blockIdx.x * 512 + F.tid; i < nl + nc; i += (size_t)F.G * 512) { const f32x4 v = i < nl ? x[i] : cx[i - nl]; u32x2 w; w.x = pk2(v.x, v.y); w.y = pk2(v.z, v.w); xs[i] = w; }
}

DI void cvt_tile(const float* W, int ldw, int k0, int n0, bf16_t* WT, int ldt, int drow0, int dcol0, const float* kscale, LAS float* scr, int lane) {
#pragma unroll 8
    for (int i = 0; i < 32; ++i) { const int kk = 2 * i + (lane >> 5); float v = W[(size_t)(k0 + kk) * ldw + n0 + (lane & 31)]; if (kscale) v *= kscale[k0 + kk]; scr[kk * 33 + (lane & 31)] = v; }
    asm volatile("s_waitcnt lgkmcnt(0)" ::: "memory");
    const int c = lane & 7;
#pragma unroll
    for (int j = 0; j < 4; ++j) { const int n = (lane >> 3) + 8 * j; const LAS float* s = scr + (8 * c) * 33 + n;
        u32x4 o; o.x = pk2(s[0 * 33], s[1 * 33]); o.y = pk2(s[2 * 33], s[3 * 33]); o.z = pk2(s[4 * 33], s[5 * 33]); o.w = pk2(s[6 * 33], s[7 * 33]);
        *(u32x4*)(WT + (size_t)(drow0 + n) * ldt + dcol0 + 8 * c) = o; }
    asm volatile("s_waitcnt lgkmcnt(0)" ::: "memory");
}
DI void cvt_tile_fp8(const float* W, int ldw, int k0, int n0, unsigned char* WT, int ldt, int drow0, int dcol0, float scale, LAS float* scr, int lane) {
#pragma unroll 8
    for (int i = 0; i < 32; ++i) { const int kk = 2 * i + (lane >> 5); scr[kk * 33 + (lane & 31)] = W[(size_t)(k0 + kk) * ldw + n0 + (lane & 31)] * scale; }
    asm volatile("s_waitcnt lgkmcnt(0)" ::: "memory");
    const int c = lane & 7;
#pragma unroll
    for (int j = 0; j < 4; ++j) { const int n = (lane >> 3) + 8 * j; const LAS float* s = scr + (8 * c) * 33 + n;
        u32x2 o; o.x = pk4_fp8(s[0 * 33], s[1 * 33], s[2 * 33], s[3 * 33]); o.y = pk4_fp8(s[4 * 33], s[5 * 33], s[6 * 33], s[7 * 33]);
        *(u32x2*)(WT + (size_t)(drow0 + n) * ldt + dcol0 + 8 * c) = o; }
    asm volatile("s_waitcnt lgkmcnt(0)" ::: "memory");
}
DI void convert_weights(Frame& F, KArgs ka, int l) {
    KA_FRESH(ka); const __attribute__((address_space(4))) Args& a = *ka; frame_fresh(F);
    LAS float* scr = (LAS float*)(F.lds + F.wave * 16384);
    unsigned char* wb = a.ws + WS_W;
    constexpr int T_IN = 16 * 166, T_UQ = 4 * 24, T_UKV = 2 * 32, T_NAO = 6 * 32, T_MLAO = 8 * 32, T_SWAO = 6 * 32, T_O = 16 * 32, T_E = 16 * 32 * 16;
    constexpr int NIT = T_IN + T_UQ + T_UKV + T_NAO + T_MLAO + T_SWAO + T_O + 3 * T_E;
    for (int it = F.gw; it < NIT; it += F.ngw) {
        int r = it;
        if (r < T_IN) { const int kb = r / 166, nb = r % 166;
            if (nb < 70) cvt_tile(a.in[I_WIN] + (size_t)l * 1024 * DIN, DIN, 64 * kb, 32 * nb, (bf16_t*)(wb + W_IN), 1024, 32 * nb, 64 * kb, nullptr, scr, F.lane);
            else cvt_tile_fp8(a.in[I_WIN] + (size_t)l * 1024 * DIN, DIN, 64 * kb, 32 * nb, wb + W_GL, 1024, 32 * nb - 2240, 64 * kb, 32.0f, scr, F.lane);
            continue; } r -= T_IN;
        if (r < T_UQ) { const int kb = r / 24, nb = r % 24; cvt_tile(a.in[I_WUQ] + (size_t)l * 256 * 768, 768, 64 * kb, 32 * nb, (bf16_t*)(wb + W_UP), 384, 32 * nb, 64 * kb, a.in[I_MQN] + l * 256, scr, F.lane); continue; } r -= T_UQ;
        if (r < T_UKV) { const int kb = r / 32, nb = r % 32; cvt_tile(a.in[I_WUKV] + (size_t)l * 128 * 1024, 1024, 64 * kb, 32 * nb, (bf16_t*)(wb + W_UP), 384, 768 + 32 * nb, 256 + 64 * kb, a.in[I_MKVN] + l * 128, scr, F.lane); continue; } r -= T_UKV;
        if (r < T_NAO) { const int kb = r / 32, nb = r % 32; cvt_tile(a.in[I_WNAO] + (size_t)l * 384 * 1024, 1024, 64 * kb, 32 * nb, (bf16_t*)(wb + W_NAO), 512, 32 * nb, 64 * kb, nullptr, scr, F.lane); continue; } r -= T_NAO;
        if (r < T_MLAO) { const int kb = r / 32, nb = r % 32; cvt_tile(a.in[I_WMLAO] + (size_t)l * 512 * 1024, 1024, 64 * kb, 32 * nb, (bf16_t*)(wb + W_MLAO), 512, 32 * nb, 64 * kb, nullptr, scr, F.lane); continue; } r -= T_MLAO;
        if (r < T_SWAO) { const int kb = r / 32, nb = r % 32; cvt_tile(a.in[I_WSWAO] + (size_t)l * 384 * 1024, 1024, 64 * kb, 32 * nb, (bf16_t*)(wb + W_SWAO), 512, 32 * nb, 64 * kb, nullptr, scr, F.lane); continue; } r -= T_SWAO;
        if (r < T_O) { const int kb = r / 32, nb = r % 32; cvt_tile_fp8(a.in[I_WO] + (size_t)l * 1024 * 1024, 1024, 64 * kb, 32 * nb, wb + W_O, 1024, 32 * nb, 64 * kb, 32.0f, scr, F.lane); continue; } r -= T_O;
        if (r < 2 * T_E) {
            const int which = r / T_E, rr = r % T_E, e = rr / 512, t = rr % 512, kb = t / 32, nb = t % 32, f0 = 32 * nb;
            const float* src = a.in[which ? I_WUP : I_WGATE] + ((size_t)l * 16 + e) * 1024 * 1024;
            cvt_tile_fp8(src, 1024, 64 * kb, f0, wb + W_GU + (size_t)e * 2048 * 1024, 1024, 256 * (f0 >> 7) + 128 * which + (f0 & 127), 64 * kb, 32.0f, scr, F.lane); continue; } r -= 2 * T_E;
        { const int e = r / 512, t = r % 512, kb = t / 32, nb = t % 32;
            cvt_tile_fp8(a.in[I_WDOWN] + ((size_t)l * 16 + e) * 1024 * 1024, 1024, 64 * kb, 32 * nb, wb + W_DN + (size_t)e * 1024 * 1024, 1024, 32 * nb, 64 * kb, 32.0f, scr, F.lane); }
    }
    constexpr int Z0 = 64 * 128, Z1 = 768 * 16, Z2 = 1024 * 32;
    unsigned zz = 0u; asm volatile("" : "+v"(zz));
    const u32x4 z = {zz, zz, zz, zz};
    for (int i = blockIdx.x * 512 + F.tid; i < Z0 + Z1 + Z2; i += F.G * 512) {
        if (i < Z0) *(u32x4*)((bf16_t*)(wb + W_IN) + (size_t)(2240 + i / 128) * 1024 + (i % 128) * 8) = z;
        else if (i < Z0 + Z1) { const int j = i - Z0; *(u32x4*)((bf16_t*)(wb + W_UP) + (size_t)(j / 16) * 384 + 256 + (j % 16) * 8) = z; }
        else { const int j = i - Z0 - Z1; *(u32x4*)((bf16_t*)(wb + W_UP) + (size_t)(768 + j / 32) * 384 + (j % 32) * 8) = z; }
    }
}

DI void row_phase(Frame& F, KArgs ka, int l, int dry = 0) {
    KA_FRESH(ka); const __attribute__((address_space(4))) Args& a = *ka; frame_fresh(F);
    bf16_t* xs = (bf16_t*)(a.ws + WS_XS);
    const float* modv = (const float*)(a.ws + WS_MODV);
    const int* smap = (const int*)(a.ws + WS_SMAP);
    const bf16_t* Y = (const bf16_t*)(a.ws + WS_Y);
    bf16_t* H = (bf16_t*)(a.ws + WS_R4);
    unsigned char* H8 = a.ws + WS_R4 + 68 * MiB;
    bf16_t* xso = xs; float* outo = a.out;
    if (dry) { unsigned char* tr = a.ws + WS_END + (size_t)F.gw * 16384; xso = (bf16_t*)tr; outo = (float*)tr; H = (bf16_t*)(tr + 8192); H8 = tr + 12288; }
    const int nrows = (l == NL) ? MLAT : MT;
    const bool comb = (l > 0);
    constexpr int RR = 4;
    for (int mb = RR * F.gw; mb < nrows; mb += RR * F.ngw) {
        f32x4 v[RR][4]; int myslot[RR];
#pragma unroll
        for (int rr = 0; rr < RR; ++rr) { const int m = mb + rr;
            if (l == 0) {
                const f32x4* xr = (const f32x4*)(m < MLAT ? a.in[I_X] + (size_t)m * D : a.in[I_CTX] + (size_t)(m - MLAT) * D) + F.lane;
                u32x2* xo = (u32x2*)(xs + (size_t)m * D) + F.lane;
#pragma unroll
                for (int j = 0; j < 4; ++j) { const f32x4 t = xr[64 * j]; u32x2 w; w.x = pk2(t.x, t.y); w.y = pk2(t.z, t.w); if (!dry) xo[64 * j] = w; v[rr][j] = (f32x4){bflo(w.x), bfhi(w.x), bflo(w.y), bfhi(w.y)}; }
            } else {
                const u32x2* xr = (const u32x2*)(xs + (size_t)m * D) + F.lane;
#pragma unroll
                for (int j = 0; j < 4; ++j) { const u32x2 w = xr[64 * j]; v[rr][j] = (f32x4){bflo(w.x), bfhi(w.x), bflo(w.y), bfhi(w.y)}; }
            }
            myslot[rr] = (comb && F.lane < 16) ? smap[(size_t)F.lane * MT + mb + rr] : -1; }
        const int mi = mod_index(mb);
        if (comb) {
            f32x4 acc[RR][4];
            unsigned long long mk[RR];
#pragma unroll
            for (int rr = 0; rr < RR; ++rr) { mk[rr] = __ballot(myslot[rr] >= 0);
#pragma unroll
                for (int j = 0; j < 4; ++j) acc[rr][j] = (f32x4){0.f, 0.f, 0.f, 0.f}; }
            while ((mk[0] | mk[1]) | (mk[2] | mk[3])) {
                u32x2 w[RR][4];
#pragma unroll
                for (int rr = 0; rr < RR; ++rr) {
                    int s = -1;
                    if (mk[rr]) { const int e0 = __builtin_ctzll(mk[rr]); s = __shfl(myslot[rr], e0); mk[rr] &= mk[rr] - 1; }
#pragma unroll
                    for (int j = 0; j < 4; ++j) w[rr][j] = (u32x2){0u, 0u};
                    if (s >= 0) { const u32x2* yr = (const u32x2*)(Y + (size_t)s * D) + F.lane;
#pragma unroll
                        for (int j = 0; j < 4; ++j) w[rr][j] = yr[64 * j]; }
                }
#pragma unroll
                for (int rr = 0; rr < RR; ++rr)
#pragma unroll
                    for (int j = 0; j < 4; ++j) acc[rr][j] += (f32x4){bflo(w[rr][j].x), bfhi(w[rr][j].x), bflo(w[rr][j].y), bfhi(w[rr][j].y)};
            }
            const f32x4* g5 = (const f32x4*)(modv + ((size_t)(l - 1) * 9 + mi) * 6144 + 5 * 1024) + F.lane;
            f32x4 g5v[4];
#pragma unroll
            for (int j = 0; j < 4; ++j) g5v[j] = g5[64 * j];
#pragma unroll
            for (int rr = 0; rr < RR; ++rr) { const int m = mb + rr;
                const size_t ro = dry ? (size_t)rr * 1024 : (size_t)m * D;
#pragma unroll
                for (int j = 0; j < 4; ++j) { v[rr][j] += g5v[j] * acc[rr][j];
                    if (l == NL) ((f32x4*)(outo + ro) + F.lane)[64 * j] = v[rr][j];
                    else { u32x2 w; w.x = pk2(v[rr][j].x, v[rr][j].y); w.y = pk2(v[rr][j].z, v[rr][j].w); ((u32x2*)(xso + ro) + F.lane)[64 * j] = w;
                           v[rr][j] = (f32x4){bflo(w.x), bfhi(w.x), bflo(w.y), bfhi(w.y)}; } } }
        }
        if (l < NL) {
            const f32x4* g = (const f32x4*)(a.in[I_N1G] + l * D) + F.lane;
            const f32x4* sh = (const f32x4*)(modv + ((size_t)l * 9 + mi) * 6144) + F.lane;
            const f32x4* sc = (const f32x4*)(modv + ((size_t)l * 9 + mi) * 6144 + 1024) + F.lane;
            f32x4 gg[4], shv[4];
#pragma unroll
            for (int j = 0; j < 4; ++j) { gg[j] = g[64 * j] * (sc[64 * j] + 1.0f); shv[j] = sh[64 * j]; }
#pragma unroll
            for (int rr = 0; rr < RR; ++rr) { const int m = mb + rr;
                float ss = 0.f;
#pragma unroll
                for (int j = 0; j < 4; ++j) ss += (v[rr][j].x * v[rr][j].x + v[rr][j].y * v[rr][j].y) + (v[rr][j].z * v[rr][j].z + v[rr][j].w * v[rr][j].w);
                const float rstd = __builtin_amdgcn_rsqf(wave_sum(ss) * (1.f / D) + EPS);
                u32x2* o = (u32x2*)(H + (dry ? (size_t)rr * 1024 : (size_t)m * D)) + F.lane;
                unsigned* o8 = (unsigned*)(H8 + (dry ? (size_t)rr * 1024 : (size_t)m * D)) + F.lane;
#pragma unroll
                for (int j = 0; j < 4; ++j) { const f32x4 hh = v[rr][j] * rstd * gg[j] + shv[j]; u32x2 w; w.x = pk2(hh.x, hh.y); w.y = pk2(hh.z, hh.w); o[64 * j] = w;
                    o8[64 * j] = pk4_fp8(hh.x, hh.y, hh.z, hh.w); } }
        }
    }
}

DI void rope_cs(int d, int prow, int pcol, float& cs, float& sn) {
    const int i = d & 15; const float pos = (float)((d & 32) ? pcol : prow);
    const float inv = __builtin_amdgcn_exp2f(-(float)i * (13.287712379549449f / 16.0f));
    const float rev = pos * inv * 0.15915494309189535f;
    const float fr = rev - floorf(rev);
    cs = __builtin_amdgcn_cosf(fr); sn = __builtin_amdgcn_sinf(fr);
}
DI void prep_phase(Frame& F, KArgs ka, int l) {
    KA_FRESH(ka); const __attribute__((address_space(4))) Args& a = *ka; frame_fresh(F);
    const bf16_t* HW = (const bf16_t*)(a.ws + WS_HW);
    bf16_t* P1 = (bf16_t*)(a.ws + WS_P1);
    const float sc64 = 0.125f * LOG2E;
    const int d0 = 8 * (F.lane & 7);
    float gn[3][8]; int srcc[3]; bool ropei[3], acti[3];
    const float* gp0 = a.in[I_NAQG]; const float* gp1 = a.in[I_NAKG]; const float* gp2 = a.in[I_SWQG]; const float* gp3 = a.in[I_SWKG];
#pragma unroll
    for (int i = 0; i < 3; ++i) { const int c = F.lane + 64 * i, col = 8 * c; acti[i] = c < 160;
        const int ty = col < 384 ? 0 : col < 768 ? 1 : col < 1152 ? 2 : 3;
        srcc[i] = col < 768 ? col : col + (C_SWQ - 768);
        ropei[i] = ty >= 2;
        const float sc = (ty == 0 || ty == 2) ? sc64 : 1.0f;
#pragma unroll
        for (int j = 0; j < 8; ++j) { const float g0 = gp0[l * 64 + d0 + j], g1 = gp1[l * 64 + d0 + j], g2 = gp2[l * 64 + d0 + j], g3 = gp3[l * 64 + d0 + j];
            gn[i][j] = acti[i] ? (ty == 0 ? g0 : ty == 1 ? g1 : ty == 2 ? g2 : g3) * sc : 0.f; } }
    float invf[8];
#pragma unroll
    for (int j = 0; j < 8; ++j) invf[j] = __builtin_amdgcn_exp2f(-(float)((d0 & 8) + j) * (13.287712379549449f / 16.0f)) * 0.15915494309189535f;
    const bool second = (d0 & 16) != 0, usecol = (d0 & 32) != 0;
    for (int mb = 2 * F.gw; mb < MT; mb += 2 * F.ngw) {
        u32x4 w[2][3];
#pragma unroll
        for (int rr = 0; rr < 2; ++rr)
#pragma unroll
            for (int i = 0; i < 3; ++i) if (acti[i]) w[rr][i] = *(const u32x4*)(HW + (size_t)(mb + rr) * DINP + srcc[i]); else w[rr][i] = (u32x4){0u, 0u, 0u, 0u};
#pragma unroll
        for (int rr = 0; rr < 2; ++rr) {
            const int m = mb + rr; const bool lat = m < MLAT; const int s = m & 4095; const float prw = (float)(s >> 6), pcl = (float)(s & 63); float pos = usecol ? pcl : prw; asm volatile("" : "+v"(pos));
            float cs[8], sn[8];
#pragma unroll
            for (int j = 0; j < 8; ++j) { cs[j] = 1.f; sn[j] = 0.f; }
            if (lat) {
#pragma unroll
                for (int j = 0; j < 8; ++j) { const float rev = pos * invf[j], fr = rev - floorf(rev); cs[j] = __builtin_amdgcn_cosf(fr); sn[j] = __builtin_amdgcn_sinf(fr); } }
#pragma unroll
            for (int i = 0; i < 3; ++i) {
                float x[8] = {bflo(w[rr][i].x), bfhi(w[rr][i].x), bflo(w[rr][i].y), bfhi(w[rr][i].y), bflo(w[rr][i].z), bfhi(w[rr][i].z), bflo(w[rr][i].w), bfhi(w[rr][i].w)};
                float ss = 0.f;
#pragma unroll
                for (int j = 0; j < 8; ++j) ss += x[j] * x[j];
                ss += __shfl_xor(ss, 1); ss += __shfl_xor(ss, 2); ss += __shfl_xor(ss, 4);
                const float rs = __builtin_amdgcn_rsqf(ss * (1.f / 64.f) + EPS);
#pragma unroll
                for (int j = 0; j < 8; ++j) x[j] *= rs * gn[i][j];
                const bool rp = ropei[i] && lat;
#pragma unroll
                for (int j = 0; j < 8; ++j) { const float y = __int_as_float(__builtin_amdgcn_ds_bpermute((F.lane ^ 2) << 2, __float_as_int(x[j]))); const float rot = second ? x[j] * cs[j] + y * sn[j] : x[j] * cs[j] - y * sn[j]; x[j] = rp ? rot : x[j]; }
                if (acti[i]) { u32x4 o; o.x = pk2(x[0], x[1]); o.y = pk2(x[2], x[3]); o.z = pk2(x[4], x[5]); o.w = pk2(x[6], x[7]);
                    *(u32x4*)(P1 + (size_t)m * P1W + 8 * (F.lane + 64 * i)) = o; }
            }
        }
    }
}
DI void prep2_phase(Frame& F, KArgs ka, int l, int dry = 0) {
    KA_FRESH(ka); const __attribute__((address_space(4))) Args& a = *ka; frame_fresh(F);
    const bf16_t* HW = (const bf16_t*)(a.ws + WS_HW);
    bf16_t* U = (bf16_t*)(a.ws + WS_R4);
    bf16_t* P2 = (bf16_t*)(a.ws + WS_P2);
    const float scq = 0.07216878364870322f * LOG2E;
    const int ln = F.lane, q = ln & 15, h = ln >> 4;
    float qgn[8], qgr[4], kgn[8], kgr[4], invf[4];
    { const float* qg = a.in[I_MQG] + l * 192; const float* kg = a.in[I_MKG] + l * 192;
#pragma unroll
      for (int j = 0; j < 8; ++j) { qgn[j] = qg[8 * q + j] * scq; kgn[j] = kg[8 * q + j]; }
#pragma unroll
      for (int j = 0; j < 4; ++j) { qgr[j] = qg[128 + 4 * q + j] * scq; kgr[j] = kg[128 + 4 * q + j];
          invf[j] = __builtin_amdgcn_exp2f(-(float)(4 * (q & 3) + j) * (13.287712379549449f / 16.0f)) * 0.15915494309189535f; } }
    const bool second = (q & 4) != 0, usecol = (q & 8) != 0;
    const int pl = (ln ^ 4) << 2;
    for (int mb = 2 * F.gw; mb < MT; mb += 2 * F.ngw) {
        u32x2 wcq[2], wqr[2], wkr[2]; unsigned wckv[2]; u32x4 wqn[2], wkn[2], wv[2];
#pragma unroll
        for (int rr = 0; rr < 2; ++rr) { const bf16_t* hr = HW + (size_t)(mb + rr) * DINP; const bf16_t* ur = U + (size_t)(mb + rr) * UW;
            wcq[rr] = *(const u32x2*)(hr + C_CQ + 4 * ln); wckv[rr] = *(const unsigned*)(hr + C_CKV + 2 * ln); wkr[rr] = *(const u32x2*)(hr + C_KR + 4 * q);
            wqn[rr] = *(const u32x4*)(ur + h * 192 + 8 * q); wqr[rr] = *(const u32x2*)(ur + h * 192 + 128 + 4 * q);
            wkn[rr] = *(const u32x4*)(ur + 768 + h * 256 + 8 * q); wv[rr] = *(const u32x4*)(ur + 768 + h * 256 + 128 + 8 * q); }
#pragma unroll
        for (int rr = 0; rr < 2; ++rr) {
            const int m = mb + rr; const bool lat = m < MLAT; const int s = m & 4095;
            bf16_t* ur = U + (size_t)m * UW; bf16_t* pr = P2 + (size_t)m * P2W;
            if (dry) { ur = (bf16_t*)(a.ws + WS_END + (size_t)F.gw * 8192); pr = ur + 2048; }
            float rq, rkv;
            { const float a0 = bflo(wcq[rr].x), a1 = bfhi(wcq[rr].x), a2 = bflo(wcq[rr].y), a3 = bfhi(wcq[rr].y);
              rq = __builtin_amdgcn_rsqf(wave_sum(a0 * a0 + a1 * a1 + a2 * a2 + a3 * a3) * (1.f / 256.f) + EPS); }
            { const float a0 = bflo(wckv[rr]), a1 = bfhi(wckv[rr]);
              rkv = __builtin_amdgcn_rsqf(wave_sum(a0 * a0 + a1 * a1) * (1.f / 128.f) + EPS); }
            float cs[4], sn[4];
            { const float prw = (float)(s >> 6), pcl = (float)(s & 63); float pos = usecol ? pcl : prw; asm volatile("" : "+v"(pos));
#pragma unroll
              for (int j = 0; j < 4; ++j) { const float rev = pos * invf[j], fr = rev - floorf(rev); cs[j] = lat ? __builtin_amdgcn_cosf(fr) : 1.f; sn[j] = lat ? __builtin_amdgcn_sinf(fr) : 0.f; } }
#pragma unroll
            for (int isk = 0; isk < 2; ++isk) {
                const u32x4 wn = isk ? wkn[rr] : wqn[rr]; const u32x2 wr2 = isk ? wkr[rr] : wqr[rr];
                const float sn_ = isk ? rkv : rq, sr_ = isk ? 1.0f : rq;
                float x[8] = {bflo(wn.x) * sn_, bfhi(wn.x) * sn_, bflo(wn.y) * sn_, bfhi(wn.y) * sn_, bflo(wn.z) * sn_, bfhi(wn.z) * sn_, bflo(wn.w) * sn_, bfhi(wn.w) * sn_};
                float y[4] = {bflo(wr2.x) * sr_, bfhi(wr2.x) * sr_, bflo(wr2.y) * sr_, bfhi(wr2.y) * sr_};
                float ss = 0.f;
#pragma unroll
                for (int j = 0; j < 8; ++j) ss += x[j] * x[j];
#pragma unroll
                for (int j = 0; j < 4; ++j) ss += y[j] * y[j];
                ss += __shfl_xor(ss, 1); ss += __shfl_xor(ss, 2); ss += __shfl_xor(ss, 4); ss += __shfl_xor(ss, 8);
                const float rs = __builtin_amdgcn_rsqf(ss * (1.f / 192.f) + EPS);
#pragma unroll
                for (int j = 0; j < 8; ++j) x[j] *= rs * (isk ? kgn[j] : qgn[j]);
#pragma unroll
                for (int j = 0; j < 4; ++j) { y[j] *= rs * (isk ? kgr[j] : qgr[j]);
                    const float p = __int_as_float(__builtin_amdgcn_ds_bpermute(pl, __float_as_int(y[j])));
                    y[j] = second ? y[j] * cs[j] + p * sn[j] : y[j] * cs[j] - p * sn[j]; }
                u32x4 o; o.x = pk2(x[0], x[1]); o.y = pk2(x[2], x[3]); o.z = pk2(x[4], x[5]); o.w = pk2(x[6], x[7]);
                u32x2 o2; o2.x = pk2(y[0], y[1]); o2.y = pk2(y[2], y[3]);
                *(u32x4*)(pr + 768 * isk + h * 192 + 8 * q) = o; *(u32x2*)(pr + 768 * isk + h * 192 + 128 + 4 * q) = o2;
            }
            { const u32x4 vw = wv[rr]; u32x4 o; o.x = pk2(bflo(vw.x) * rkv, bfhi(vw.x) * rkv); o.y = pk2(bflo(vw.y) * rkv, bfhi(vw.y) * rkv); o.z = pk2(bflo(vw.z) * rkv, bfhi(vw.z) * rkv); o.w = pk2(bflo(vw.w) * rkv, bfhi(vw.w) * rkv);
              *(u32x4*)(ur + 768 + h * 256 + 128 + 8 * q) = o; }
        }
    }
}

struct AU {
    const bf16_t *q, *k, *v; bf16_t* o;
    int ldq, ldk, ldv, ldo;
    int qrow0;
    int lat_row0, n_lat, ctx_row0, n_ctx;
    int mode;
    int qpos0, kpos0;
    float m0, l0;
    const float* rpb;
};
template <int DQ, int DV, int LDK, int LDV>
DI void attn_unit(LAS unsigned char* lds, const AU& u, int tid, int wave, int lane) {
    constexpr int KP = DQ * 2 + 16, VP = DV * 2 + 64, KBY = 64 * KP, VBY = 64 * VP, STG = KBY + VBY;
    constexpr int NKS = DQ / 16, NDT = DV / 32, KCH = DQ / 8, VCH = DV / 8;
    constexpr int KC = KP / 16, VC = VP / 16;
    constexpr int KI = (KC + 7) / 8, VI = (VC + 7) / 8;
    constexpr int BIAS_OFF = 98304;
    static_assert(2 * STG <= BIAS_OFF && KBY % 1024 == 0 && VBY % 1024 == 0, "attention LDS");
    const int r = lane & 31, h = lane >> 5;
    const int nt = u.n_lat + u.n_ctx;
    LAS float* btab = (LAS float*)(lds + BIAS_OFF);
    if (u.mode == 2) { for (int i = tid; i < 15 * 31; i += 512) btab[i] = u.rpb[i] * LOG2E; }
    bf16x8 qf[NKS];
    { const bf16_t* qp = u.q + (size_t)(u.qrow0 + wave * 32 + r) * u.ldq + 8 * h;
#pragma unroll
      for (int ks = 0; ks < NKS; ++ks) qf[ks] = *(const bf16x8*)(qp + 16 * ks); }
    f32x16 o[NDT];
#pragma unroll
    for (int dt = 0; dt < NDT; ++dt)
#pragma unroll
        for (int i = 0; i < 16; ++i) o[dt][i] = 0.f;
    float mrun = u.m0, lrun = (h == 0) ? u.l0 : 0.f;
    unsigned koff[KI], voff[VI];
#pragma unroll
    for (int i = 0; i < KI; ++i) { const int c = 64 * (wave + 8 * i) + lane, row = c / KC, cc = c % KC; koff[i] = (unsigned)(row * LDK * 2 + (cc < KCH ? cc : KCH - 1) * 16); }
#pragma unroll
    for (int i = 0; i < VI; ++i) { const int c = 64 * (wave + 8 * i) + lane, row = c / VC, cc = c % VC; voff[i] = (unsigned)(row * LDV * 2 + (cc < VCH ? cc : VCH - 1) * 16); }
#define AT_ROWBASE(t) ((t) < u.n_lat ? u.lat_row0 + 64 * (t) : u.ctx_row0 + 64 * ((t) - u.n_lat))
#define AT_ISSUE(t, buf) do { const int rb_ = AT_ROWBASE(t); const char* kb_ = (const char*)(u.k + (size_t)rb_ * LDK); const char* vb_ = (const char*)(u.v + (size_t)rb_ * LDV); \
        _Pragma("unroll") for (int i_ = 0; i_ < KI; ++i_) { const int j_ = wave + 8 * i_; if (j_ < KC) __builtin_amdgcn_global_load_lds((const unsigned*)(kb_ + koff[i_]), (LAS unsigned*)(lds + (buf) * STG + j_ * 1024), 16, 0, 0); } \
        _Pragma("unroll") for (int i_ = 0; i_ < VI; ++i_) { const int j_ = wave + 8 * i_; if (j_ < VC) __builtin_amdgcn_global_load_lds((const unsigned*)(vb_ + voff[i_]), (LAS unsigned*)(lds + (buf) * STG + KBY + j_ * 1024), 16, 0, 0); } } while (0)
    AT_ISSUE(0, 0);
    asm volatile("s_waitcnt vmcnt(0)" ::: "memory");
    __syncthreads();
    const int tq = (lane & 15) >> 2, tp = lane & 3, tblk = (lane >> 4) & 1;
    const int vlane_off = (4 * h + tq) * VP + 32 * tblk + 8 * tp;
    for (int t = 0; t < nt; ++t) {
        const int buf = t & 1;
        if (t + 1 < nt) AT_ISSUE(t + 1, buf ^ 1);
        bool skip = false; int a0 = 0, a1 = 0;
        if (u.mode == 1 && t < u.n_lat) { const int k0 = u.kpos0 + 64 * t, q0 = u.qpos0 + 32 * wave; skip = (k0 > q0 + 31 + 128) || (k0 + 63 < q0 - 128); a0 = k0; a1 = q0; }
        if (u.mode == 2 && t < u.n_lat) { const int kr = u.kpos0 + t, qr = u.qpos0 + (wave >> 1); int rs = qr - 4; rs = rs < 0 ? 0 : (rs > 56 ? 56 : rs); skip = (kr < rs) || (kr >= rs + 8); a0 = kr - qr + 7; }
        if (!skip) {
            const LAS unsigned char* Kt = lds + buf * STG; const LAS unsigned char* Vt = Kt + KBY;
            f32x16 s0, s1;
#pragma unroll
            for (int i = 0; i < 16; ++i) { s0[i] = 0.f; s1[i] = 0.f; }
#pragma unroll
            for (int ks = 0; ks < NKS; ++ks) {
                const bf16x8 k0 = *(const LAS bf16x8*)(Kt + r * KP + (16 * ks + 8 * h) * 2);
                const bf16x8 k1 = *(const LAS bf16x8*)(Kt + (32 + r) * KP + (16 * ks + 8 * h) * 2);
                s0 = __builtin_amdgcn_mfma_f32_32x32x16_bf16(k0, qf[ks], s0, 0, 0, 0);
                s1 = __builtin_amdgcn_mfma_f32_32x32x16_bf16(k1, qf[ks], s1, 0, 0, 0);
            }
            if (u.mode == 1 && t < u.n_lat) {
                const int qpos = a1 + r;
#pragma unroll
                for (int i = 0; i < 16; ++i) { const int kk = a0 + (i & 3) + 8 * (i >> 2) + 4 * h; int d0 = qpos - kk; d0 = d0 < 0 ? -d0 : d0; int d1 = qpos - (kk + 32); d1 = d1 < 0 ? -d1 : d1;
                    s0[i] = d0 <= 128 ? s0[i] : -INFINITY; s1[i] = d1 <= 128 ? s1[i] : -INFINITY; }
            }
            if (u.mode == 2 && t < u.n_lat) {
                const int qc = 32 * (wave & 1) + r; int cs = qc - 8; cs = cs < 0 ? 0 : (cs > 48 ? 48 : cs);
                const int bbase = a0 * 31 + 15 - qc;
                float bb[16];
#pragma unroll
                for (int half = 0; half < 2; ++half) {
#pragma unroll
                    for (int i = 0; i < 16; ++i) { int ix = bbase + 32 * half + (i & 3) + 8 * (i >> 2) + 4 * h; ix = ix < 0 ? 0 : (ix > 464 ? 464 : ix); bb[i] = btab[ix]; }
                    asm volatile("" : "+v"(bb[0]), "+v"(bb[1]), "+v"(bb[2]), "+v"(bb[3]), "+v"(bb[4]), "+v"(bb[5]), "+v"(bb[6]), "+v"(bb[7]), "+v"(bb[8]), "+v"(bb[9]), "+v"(bb[10]), "+v"(bb[11]), "+v"(bb[12]), "+v"(bb[13]), "+v"(bb[14]), "+v"(bb[15]));
#pragma unroll
                    for (int i = 0; i < 16; ++i) { const int kc = 32 * half + (i & 3) + 8 * (i >> 2) + 4 * h; const bool ok = (kc >= cs) && (kc < cs + 16);
                        if (half == 0) s0[i] = ok ? s0[i] + bb[i] : -INFINITY; else s1[i] = ok ? s1[i] + bb[i] : -INFINITY; }
                }
            }
            float mx = fmaxf(s0[0], s1[0]);
#pragma unroll
            for (int i = 1; i < 16; ++i) mx = fmaxf(mx, fmaxf(s0[i], s1[i]));
            mx = fmaxf(mx, __shfl_xor(mx, 32));
            const float mnew = fmaxf(mrun, mx), alpha = __builtin_amdgcn_exp2f(mrun - mnew);
            float ls = 0.f;
#pragma unroll
            for (int i = 0; i < 16; ++i) { s0[i] = __builtin_amdgcn_exp2f(s0[i] - mnew); s1[i] = __builtin_amdgcn_exp2f(s1[i] - mnew); ls += s0[i] + s1[i]; }
            lrun = lrun * alpha + ls; mrun = mnew;
#pragma unroll
            for (int dt = 0; dt < NDT; ++dt)
#pragma unroll
                for (int i = 0; i < 16; ++i) o[dt][i] *= alpha;
            bf16x8 pf[4];
            { u32x4 w;
              w.x = pk2(s0[0], s0[1]); w.y = pk2(s0[2], s0[3]); w.z = pk2(s0[4], s0[5]); w.w = pk2(s0[6], s0[7]); pf[0] = __builtin_bit_cast(bf16x8, w);
              w.x = pk2(s0[8], s0[9]); w.y = pk2(s0[10], s0[11]); w.z = pk2(s0[12], s0[13]); w.w = pk2(s0[14], s0[15]); pf[1] = __builtin_bit_cast(bf16x8, w);
              w.x = pk2(s1[0], s1[1]); w.y = pk2(s1[2], s1[3]); w.z = pk2(s1[4], s1[5]); w.w = pk2(s1[6], s1[7]); pf[2] = __builtin_bit_cast(bf16x8, w);
              w.x = pk2(s1[8], s1[9]); w.y = pk2(s1[10], s1[11]); w.z = pk2(s1[12], s1[13]); w.w = pk2(s1[14], s1[15]); pf[3] = __builtin_bit_cast(bf16x8, w); }
#pragma unroll
            for (int kk = 0; kk < 4; ++kk) {
#pragma unroll
                for (int dt = 0; dt < NDT; ++dt) {
                    const LAS unsigned char* vp = Vt + (16 * kk) * VP + vlane_off + 64 * dt;
                    const s16x4 lo = __builtin_amdgcn_ds_read_tr16_b64_v4i16((LAS s16x4*)vp);
                    const s16x4 hi = __builtin_amdgcn_ds_read_tr16_b64_v4i16((LAS s16x4*)(vp + 8 * VP));
                    const bf16x8 vf = __builtin_shufflevector(lo, hi, 0, 1, 2, 3, 4, 5, 6, 7);
                    o[dt] = __builtin_amdgcn_mfma_f32_32x32x16_bf16(vf, pf[kk], o[dt], 0, 0, 0);
                }
            }
        }
        asm volatile("s_waitcnt vmcnt(0)" ::: "memory");
        __syncthreads();
    }
    const float ltot = lrun + __shfl_xor(lrun, 32), inv = 1.0f / ltot;
    bf16_t* op = u.o + (size_t)(u.qrow0 + wave * 32 + r) * u.ldo + 4 * h;
#pragma unroll
    for (int dt = 0; dt < NDT; ++dt)
#pragma unroll
        for (int g = 0; g < 4; ++g) { u32x2 w; w.x = pk2(o[dt][4 * g] * inv, o[dt][4 * g + 1] * inv); w.y = pk2(o[dt][4 * g + 2] * inv, o[dt][4 * g + 3] * inv);
            *(u32x2*)(op + 32 * dt + 8 * g) = w; }
#undef AT_ROWBASE
#undef AT_ISSUE
}

DI void attn_phase(Frame& F, KArgs ka, int l) {
    KA_FRESH(ka); const __attribute__((address_space(4))) Args& a = *ka; frame_fresh(F);
    const bf16_t* HW = (const bf16_t*)(a.ws + WS_HW);
    const bf16_t* P1 = (const bf16_t*)(a.ws + WS_P1);
    const bf16_t* P2 = (const bf16_t*)(a.ws + WS_P2);
    const bf16_t* U = (const bf16_t*)(a.ws + WS_R4);
    bf16_t* OC = (bf16_t*)(a.ws + WS_OCAT);
    const bool last = (l == NL - 1);
    constexpr int nA = 512, nB = 768, nC = 768;
    const int ntot = nA + nB + nC + (last ? 0 : 128);
#ifndef ATT_PROBE
#define ATT_PROBE 0
#endif
    for (int rep2_ = 0; rep2_ < 1 + (ATT_PROBE != 0); ++rep2_)
    for (int id = F.vcu; id < ntot; id += F.G) {
        if (rep2_ == 1 && !((ATT_PROBE == 1) ? (id < nA) : (id >= nA && id < nA + nB))) continue;
        AU u; bool big = false;
        u.mode = 0; u.qpos0 = 0; u.kpos0 = 0; u.m0 = -1e30f; u.l0 = 0.f; u.rpb = nullptr; u.n_ctx = 4;
        if (id < nA) {
            const int b = id >> 6, h = (id >> 4) & 3, qb = id & 15; big = true;
            u.q = P2 + h * 192; u.ldq = P2W; u.k = P2 + 768 + h * 192; u.ldk = P2W; u.v = U + 768 + h * 256 + 128; u.ldv = UW; u.o = OC + 384 + h * 128; u.ldo = OCW;
            u.qrow0 = b * SEQ + qb * 256; u.lat_row0 = b * SEQ; u.n_lat = 64; u.ctx_row0 = MLAT + b * CTX;
        } else if (id < nA + nB) {
            const int j = id - nA, b = j / 96, h = (j >> 4) % 6, qb = j & 15;
            u.q = P1 + h * 64; u.ldq = P1W; u.k = P1 + 384 + h * 64; u.ldk = P1W; u.v = HW + C_NAV + h * 64; u.ldv = DINP; u.o = OC + h * 64; u.ldo = OCW;
            int rlo = 4 * qb - 4; rlo = rlo < 0 ? 0 : (rlo > 56 ? 56 : rlo); int rhi = 4 * qb + 3 - 4; rhi = (rhi < 0 ? 0 : (rhi > 56 ? 56 : rhi)) + 7;
            u.qrow0 = b * SEQ + qb * 256; u.lat_row0 = b * SEQ + rlo * 64; u.n_lat = rhi - rlo + 1; u.ctx_row0 = MLAT + b * CTX;
            u.mode = 2; u.qpos0 = 4 * qb; u.kpos0 = rlo; u.rpb = a.in[I_RPB] + (size_t)(l * 6 + h) * 465;
        } else if (id < nA + nB + nC) {
            const int j = id - nA - nB, b = j / 96, hq = (j >> 4) % 6, qb = j & 15, kvh = hq / 3;
            u.q = P1 + 768 + hq * 64; u.ldq = P1W; u.k = P1 + 1152 + kvh * 64; u.ldk = P1W; u.v = HW + C_SWV + kvh * 64; u.ldv = DINP; u.o = OC + 896 + hq * 64; u.ldo = OCW;
            int klo = qb * 256 - 128; klo = klo < 0 ? 0 : klo; int khi = qb * 256 + 384; khi = khi > SEQ ? SEQ : khi;
            u.qrow0 = b * SEQ + qb * 256; u.lat_row0 = b * SEQ + klo; u.n_lat = (khi - klo) >> 6; u.ctx_row0 = MLAT + b * CTX;
            u.mode = 1; u.qpos0 = qb * 256; u.kpos0 = klo; u.m0 = a.in[I_SINK][l * 6 + hq] * LOG2E; u.l0 = 1.f;
        } else {
            const int j = id - nA - nB - nC;
            u.n_lat = 0; u.lat_row0 = 0;
            if (j < 32) { const int b = j >> 2, h = j & 3; big = true;
                u.q = P2 + h * 192; u.ldq = P2W; u.k = P2 + 768 + h * 192; u.ldk = P2W; u.v = U + 768 + h * 256 + 128; u.ldv = UW; u.o = OC + 384 + h * 128; u.ldo = OCW;
                u.qrow0 = MLAT + b * CTX; u.ctx_row0 = MLAT + b * CTX;
            } else if (j < 80) { const int jj = j - 32, b = jj / 6, h = jj % 6;
                u.q = P1 + h * 64; u.ldq = P1W; u.k = P1 + 384 + h * 64; u.ldk = P1W; u.v = HW + C_NAV + h * 64; u.ldv = DINP; u.o = OC + h * 64; u.ldo = OCW;
                u.qrow0 = MLAT + b * CTX; u.ctx_row0 = MLAT + b * CTX;
            } else { const int jj = j - 80, b = jj / 6, hq = jj % 6, kvh = hq / 3;
                u.q = P1 + 768 + hq * 64; u.ldq = P1W; u.k = P1 + 1152 + kvh * 64; u.ldk = P1W; u.v = HW + C_SWV + kvh * 64; u.ldv = DINP; u.o = OC + 896 + hq * 64; u.ldo = OCW;
                u.qrow0 = MLAT + b * CTX; u.ctx_row0 = MLAT + b * CTX; u.m0 = a.in[I_SINK][l * 6 + hq] * LOG2E; u.l0 = 1.f;
            }
        }
        if (big) attn_unit<192, 128, P2W, UW>(F.lds, u, F.tid, F.wave, F.lane);
        else attn_unit<64, 64, P1W, DINP>(F.lds, u, F.tid, F.wave, F.lane);
    }
}

DI void norm2_phase(Frame& F, KArgs ka, int l, int nrows) {
    KA_FRESH(ka); const __attribute__((address_space(4))) Args& a = *ka; frame_fresh(F);
    LAS float* rt = (LAS float*)F.lds;
    const float* rg = a.in[I_ROUTER] + (size_t)l * 1024 * 16;
    for (int i = F.tid; i < 16384; i += 512) rt[i] = rg[i];
    __syncthreads();
    LAS float* xr = (LAS float*)(F.lds + 65536 + F.wave * 8192);
    const bf16_t* xs = (const bf16_t*)(a.ws + WS_XS);
    const float* modv = (const float*)(a.ws + WS_MODV);
    unsigned char* H2 = a.ws + WS_H2;
    float* AFL = (float*)(a.ws + WS_AFL); float* AFC = (float*)(a.ws + WS_AFC);
    const int eq = F.lane & 3, kq = F.lane >> 2;
    u32x2 xw[2][4];
#define N2_LOAD(mb_) do { _Pragma("unroll") for (int rr_ = 0; rr_ < 2; ++rr_) { const u32x2* xp_ = (const u32x2*)(xs + (size_t)((mb_) + rr_) * D) + F.lane; \
        _Pragma("unroll") for (int j_ = 0; j_ < 4; ++j_) xw[rr_][j_] = xp_[64 * j_]; } } while (0)
    if (2 * F.gw < nrows) N2_LOAD(2 * F.gw);
    for (int mb = 2 * F.gw; mb < nrows; mb += 2 * F.ngw) {
        const int mi = mod_index(mb);
        f32x4 v[2][4];
#pragma unroll
        for (int rr = 0; rr < 2; ++rr)
#pragma unroll
            for (int j = 0; j < 4; ++j) { const u32x2 w = xw[rr][j]; v[rr][j] = (f32x4){bflo(w.x), bfhi(w.x), bflo(w.y), bfhi(w.y)}; }
        if (mb + 2 * F.ngw < nrows) N2_LOAD(mb + 2 * F.ngw);
        const f32x4* g = (const f32x4*)(a.in[I_N2G] + l * D) + F.lane;
        const f32x4* sh = (const f32x4*)(modv + ((size_t)l * 9 + mi) * 6144 + 3 * 1024) + F.lane;
        const f32x4* sc = (const f32x4*)(modv + ((size_t)l * 9 + mi) * 6144 + 4 * 1024) + F.lane;
        f32x4 gg[4], shv[4];
#pragma unroll
        for (int j = 0; j < 4; ++j) { gg[j] = g[64 * j] * (sc[64 * j] + 1.0f); shv[j] = sh[64 * j]; }
#pragma unroll
        for (int rr = 0; rr < 2; ++rr) {
            float ss = 0.f;
#pragma unroll
            for (int j = 0; j < 4; ++j) ss += (v[rr][j].x * v[rr][j].x + v[rr][j].y * v[rr][j].y) + (v[rr][j].z * v[rr][j].z + v[rr][j].w * v[rr][j].w);
            const float rstd = __builtin_amdgcn_rsqf(wave_sum(ss) * (1.f / D) + EPS);
            unsigned* o = (unsigned*)(H2 + (size_t)(mb + rr) * D) + F.lane;
#pragma unroll
            for (int j = 0; j < 4; ++j) { const f32x4 hh = v[rr][j] * rstd * gg[j] + shv[j]; o[64 * j] = pk4_fp8(hh.x, hh.y, hh.z, hh.w);
                *(LAS f32x4*)(xr + rr * 1024 + 4 * F.lane + 256 * j) = hh; }
        }
        asm volatile("s_waitcnt lgkmcnt(0)" ::: "memory");
        f32x4 acc[2] = {{0.f, 0.f, 0.f, 0.f}, {0.f, 0.f, 0.f, 0.f}};
#pragma unroll 8
        for (int i = 0; i < 64; ++i) { const int k = kq + 16 * i; const float x0 = xr[k], x1 = xr[1024 + k]; const f32x4 w = *(const LAS f32x4*)(rt + k * 16 + 4 * eq); acc[0] += w * x0; acc[1] += w * x1; }
        asm volatile("s_waitcnt lgkmcnt(0)" ::: "memory");
#pragma unroll
        for (int rr = 0; rr < 2; ++rr) { const int m = mb + rr; f32x4 ac = acc[rr];
#pragma unroll
            for (int ofs = 4; ofs < 64; ofs <<= 1) { ac.x += __shfl_xor(ac.x, ofs); ac.y += __shfl_xor(ac.y, ofs); ac.z += __shfl_xor(ac.z, ofs); ac.w += __shfl_xor(ac.w, ofs); }
            float mx = fmaxf(fmaxf(ac.x, ac.y), fmaxf(ac.z, ac.w)); mx = fmaxf(mx, __shfl_xor(mx, 1)); mx = fmaxf(mx, __shfl_xor(mx, 2));
            f32x4 ex; ex.x = __expf(ac.x - mx); ex.y = __expf(ac.y - mx); ex.z = __expf(ac.z - mx); ex.w = __expf(ac.w - mx);
            float sum = (ex.x + ex.y) + (ex.z + ex.w); sum += __shfl_xor(sum, 1); sum += __shfl_xor(sum, 2);
            const float inv = 1.0f / sum;
            if (F.lane < 4) {
                if (m < MLAT) { const int b = m >> 12, s = m & 4095; float* p = AFL + ((size_t)(b * 16 + 4 * F.lane)) * 4096 + s; p[0] = ex.x * inv; p[4096] = ex.y * inv; p[2 * 4096] = ex.z * inv; p[3 * 4096] = ex.w * inv; }
                else { const int b = (m - MLAT) >> 8, s = (m - MLAT) & 255; float* p = AFC + ((size_t)(b * 16 + 4 * F.lane)) * 256 + s; p[0] = ex.x * inv; p[256] = ex.y * inv; p[512] = ex.z * inv; p[768] = ex.w * inv; }
            }
        }
    }
}

DI unsigned block_excl_scan(unsigned v, unsigned& total, LAS unsigned* wsum, int tid, int lane, int wave) {
    unsigned x = v;
#pragma unroll
    for (int o = 1; o < 64; o <<= 1) { const unsigned y = __shfl_up(x, o); if (lane >= o) x += y; }
    if (lane == 63) wsum[wave] = x;
    __syncthreads();
    unsigned base = 0, tot = 0;
#pragma unroll
    for (int w = 0; w < 8; ++w) { const unsigned s = wsum[w]; if (w < wave) base += s; tot += s; }
    __syncthreads();
    total = tot;
    return base + x - v;
}
DI void select_phase(Frame& F, KArgs ka, int l) {
    KA_FRESH(ka); const __attribute__((address_space(4))) Args& a = *ka; frame_fresh(F);
    const bool last = (l == NL - 1);
    const int nunits = last ? 128 : 256;
    LAS unsigned* hist = (LAS unsigned*)F.lds;
    LAS unsigned* wsum = (LAS unsigned*)(F.lds + 8192);
    LAS unsigned* bc = (LAS unsigned*)(F.lds + 8192 + 64);
    LAS int* sel = (LAS int*)(F.lds + 16384);
    const float* AFL = (const float*)(a.ws + WS_AFL); const float* AFC = (const float*)(a.ws + WS_AFC);
    int* smap = (int*)(a.ws + WS_SMAP); float* gate = (float*)(a.ws + WS_GATE);
    const unsigned char* H2 = a.ws + WS_H2; unsigned char* XG = a.ws + WS_XG;
    for (int unit = blockIdx.x; unit < nunits; unit += F.G) {
        const bool lat = unit < 128; const int be = unit & 127, b = be >> 4, e = be & 15;
        const int N = lat ? 4096 : 256, cap = lat ? CAP_LAT : CAP_CTX;
        const float* aff = lat ? AFL + (size_t)be * 4096 : AFC + (size_t)be * 256;
        unsigned key[8]; const int per = lat ? 8 : 1; const bool act = lat || F.tid < 256;
#pragma unroll
        for (int j = 0; j < 8; ++j) key[j] = (act && j < per) ? __float_as_uint(aff[F.tid * per + j]) : 0u;
        unsigned prefix = 0u, pmask = 0u, need = (unsigned)cap;
#pragma unroll
        for (int pass = 0; pass < 3; ++pass) {
            const int shift = pass == 0 ? 21 : (pass == 1 ? 10 : 0), nb = pass == 2 ? 1024 : 2048;
            for (int i = F.tid; i < 2048; i += 512) hist[i] = 0u;
            __syncthreads();
#pragma unroll
            for (int j = 0; j < 8; ++j) if (act && j < per && (key[j] & pmask) == prefix) (void)__hip_atomic_fetch_add(&hist[(key[j] >> shift) & (nb - 1)], 1u, __ATOMIC_RELAXED, __HIP_MEMORY_SCOPE_WORKGROUP);
            __syncthreads();
            unsigned c4[4], mine = 0;
#pragma unroll
            for (int j = 0; j < 4; ++j) { const int bin = 2047 - 4 * F.tid - j; c4[j] = bin < nb ? hist[bin] : 0u; mine += c4[j]; }
            unsigned tot; unsigned run = block_excl_scan(mine, tot, wsum, F.tid, F.lane, F.wave);
#pragma unroll
            for (int j = 0; j < 4; ++j) { const int bin = 2047 - 4 * F.tid - j;
                if (bin < nb && run < need && run + c4[j] >= need) { bc[0] = (unsigned)bin; bc[1] = run; }
                run += c4[j]; }
            __syncthreads();
            const unsigned cb = bc[0], above = bc[1];
            prefix |= cb << shift; pmask |= (unsigned)(nb - 1) << shift; need -= above;
            __syncthreads();
        }
        unsigned neq = 0, ngt = 0;
#pragma unroll
        for (int j = 0; j < 8; ++j) if (act && j < per) { neq += key[j] == prefix; ngt += key[j] > prefix; }
        unsigned teq; const unsigned eqbase = block_excl_scan(neq, teq, wsum, F.tid, F.lane, F.wave);
        unsigned nsel = 0, flags = 0, erun = eqbase;
#pragma unroll
        for (int j = 0; j < 8; ++j) if (act && j < per) { bool s = key[j] > prefix; if (key[j] == prefix) { s = erun < need; ++erun; } if (s) { flags |= 1u << j; ++nsel; } }
        unsigned tsel; unsigned sbase = block_excl_scan(nsel, tsel, wsum, F.tid, F.lane, F.wave);
        const int rowbase = lat ? b * SEQ : MLAT + b * CTX;
        const int slotbase = lat ? be * CAP_LAT : NSLOT_LAT + (e * 8 + b) * CAP_CTX;
#pragma unroll
        for (int j = 0; j < 8; ++j) if (act && j < per) { const int tok = F.tid * per + j; int slot = -1;
            if ((flags >> j) & 1u) { slot = slotbase + (int)sbase; sel[sbase] = tok; gate[slot] = __uint_as_float(key[j]); ++sbase; }
            smap[(size_t)e * MT + rowbase + tok] = slot; }
        __syncthreads();
        if (lat) {
            for (int t0 = F.wave * 16; t0 < cap; t0 += 128) {
                u32x4 rowv[16];
#pragma unroll
                for (int q = 0; q < 16; ++q) rowv[q] = ((const u32x4*)(H2 + (size_t)(rowbase + sel[t0 + q]) * D))[F.lane];
#pragma unroll
                for (int q = 0; q < 16; ++q) ((u32x4*)(XG + (size_t)(slotbase + t0 + q) * D))[F.lane] = rowv[q];
            }
        } else {
            const int t0 = F.wave * 4;
            u32x4 rowv[4];
#pragma unroll
            for (int q = 0; q < 4; ++q) rowv[q] = ((const u32x4*)(H2 + (size_t)(rowbase + sel[t0 + q]) * D))[F.lane];
#pragma unroll
            for (int q = 0; q < 4; ++q) ((u32x4*)(XG + (size_t)(slotbase + t0 + q) * D))[F.lane] = rowv[q];
        }
        __syncthreads();
    }
}

DI unsigned char* ws_fresh(KArgs ka) { KA_FRESH(ka); return ka->ws; }
__global__ void __launch_bounds__(512, 2) mega_fwd(Args a_unused) {
    extern __shared__ __attribute__((aligned(16))) unsigned char lds_raw[];
    KArgs ka = (KArgs)__builtin_amdgcn_kernarg_segment_ptr();
    Frame F;
    F.lds = (LAS unsigned char*)lds_raw;
    F.tid = threadIdx.x; F.lane = F.tid & 63; F.wave = __builtin_amdgcn_readfirstlane(F.tid >> 6);
    F.G = gridDim.x; { const int bx = blockIdx.x; F.vcu = (F.G % 8 == 0) ? (bx % 8) * (F.G / 8) + bx / 8 : bx; }
    F.gw = F.vcu * 8 + F.wave; F.ngw = F.G * 8;
    for (int u = F.tid; u < (LDS_BYTES - LDSCTL_OFF) / 4; u += 512) ((LAS unsigned*)(F.lds + LDSCTL_OFF))[u] = 0u;
    __syncthreads();
    XcdBarrier bar = xcd_barrier_post((unsigned*)(ws_fresh(ka) + WS_CTL) + CW_BAR, (volatile LAS unsigned*)(F.lds + LDSCTL_OFF + 32));
#define GRID_BAR() xcd_barrier(bar)
    const int bx = blockIdx.x;

    if (PH(0)) modv_phase(F, ka);
    for (int rep_ = 0; rep_ < REPS(2); ++rep_) if (PH(2)) convert_weights(F, ka, 0);
    GRID_BAR();
    if (PH(3)) row_phase(F, ka, 0);
    GRID_BAR();

    for (int l = 0; l < NL; ++l) {
        const bool last = (l == NL - 1);
        const int nMe = last ? MLAT / 256 : MT / 256;
        const int nMs = last ? NSLOT_LAT / 256 : NSLOT / 256;
        for (int rep_ = 0; rep_ < REPS(4); ++rep_) if (PH(4)) { unsigned char* ws = ws_fresh(ka);
            { pg8::Gemm g{(const bf16_t*)(ws + WS_R4), (const bf16_t*)(ws + WS_W + W_IN), 1024, 1024, 1024, 0}; pg8::Order S; S.init(MT / 256, DINP / 256, F.G, bx);
              pg8::EpiStoreBf16 E{(bf16_t*)(ws + WS_HW), DINP}; pg8::gemm_phase(F.lds, g, S, E); }
            { pg8::Gemm g{(const bf16_t*)(ws + WS_R4 + 68 * MiB), (const bf16_t*)(ws + WS_W + W_GL), 1024, 1024, 1024, 0}; pg8::Order S; S.init(MT / 256, NGL / 256, F.G, (bx + F.G / 2) % F.G);
              pg8::EpiGate E{ws + WS_G}; pg8::gemm_phase<pg8::EpiGate, true>(F.lds, g, S, E); } }
        GRID_BAR();
        for (int rep_ = 0; rep_ < REPS(5); ++rep_) if (PH(5)) { unsigned char* ws = ws_fresh(ka); pg8::Gemm g{(const bf16_t*)(ws + WS_HW) + C_CQ, (const bf16_t*)(ws + WS_W + W_UP), 384, DINP, 384, 0}; pg8::Order S; S.init(MT / 256, UW / 256, F.G, bx);
            pg8::EpiStoreBf16 E{(bf16_t*)(ws + WS_R4), UW}; pg8::gemm_phase(F.lds, g, S, E); }
        for (int rep_ = 0; rep_ < REPS(6); ++rep_) if (PH(6)) prep_phase(F, ka, l);
        GRID_BAR();
        for (int rep_ = 0; rep_ < REPS(7); ++rep_) if (PH(7)) prep2_phase(F, ka, l, rep_);
        GRID_BAR();
        for (int rep_ = 0; rep_ < REPS(8); ++rep_) if (PH(8)) attn_phase(F, ka, l);
        GRID_BAR();
        for (int rep_ = 0; rep_ < REPS(9); ++rep_) if (PH(9)) { unsigned char* ws = ws_fresh(ka); pg8::Order S; S.init(nMe, 4, F.G, bx);
          const bf16_t* OC = (const bf16_t*)(ws + WS_OCAT); bf16_t* MG = (bf16_t*)(ws + WS_MERGED); const unsigned char* GL = ws + WS_G;
          { pg8::Gemm3 g{OC, OC + 384, OC + 896, (const bf16_t*)(ws + WS_W + W_NAO), (const bf16_t*)(ws + WS_W + W_MLAO), (const bf16_t*)(ws + WS_W + W_SWAO), OCW, 512}; pg8::EpiMerge3 E{MG, GL}; pg8::gemm_phase3(F.lds, g, S, E); } }
        GRID_BAR();
        if (PH(10)) { unsigned char* ws = ws_fresh(ka); pg8::Gemm g{(const bf16_t*)(ws + WS_MERGED), (const bf16_t*)(ws + WS_W + W_O), 1024, 1024, 1024, 0}; pg8::Order S; S.init(nMe, 4, F.G, bx);
            pg8::EpiResid E{(bf16_t*)(ws + WS_XS), (const float*)(ws + WS_MODV) + (size_t)l * 9 * 6144 + 2 * 1024}; pg8::gemm_phase<pg8::EpiResid, true>(F.lds, g, S, E); }
        GRID_BAR();
        for (int rep_ = 0; rep_ < REPS(11); ++rep_) if (PH(11)) norm2_phase(F, ka, l, last ? MLAT : MT);
        GRID_BAR();
        for (int rep_ = 0; rep_ < REPS(12); ++rep_) if (PH(12)) select_phase(F, ka, l);
        GRID_BAR();
        for (int rep_ = 0; rep_ < REPS(13); ++rep_) if (PH(13)) { unsigned char* ws = ws_fresh(ka); pg8::Gemm g{(const bf16_t*)(ws + WS_XG), (const bf16_t*)(ws + WS_W + W_GU), 1024, 1024, 1024, (size_t)2048 * 1024}; pg8::Order S; S.init(nMs, 8, F.G, bx, 1);
            pg8::EpiSwiglu E{ws + WS_ACT}; pg8::gemm_phase<pg8::EpiSwiglu, true>(F.lds, g, S, E); }
        GRID_BAR();
        for (int rep_ = 0; rep_ < REPS(14); ++rep_) if (PH(14)) { unsigned char* ws = ws_fresh(ka); pg8::Gemm g{(const bf16_t*)(ws + WS_ACT), (const bf16_t*)(ws + WS_W + W_DN), 1024, 1024, 1024, (size_t)1024 * 1024}; pg8::Order S; S.init(nMs, 4, F.G, bx, 1);
            pg8::EpiDown E{(bf16_t*)(ws + WS_Y), (const float*)(ws + WS_GATE)}; pg8::gemm_phase<pg8::EpiDown, true>(F.lds, g, S, E); }
        GRID_BAR();
        for (int rep_ = 0; rep_ < REPS(15); ++rep_) if (PH(15)) row_phase(F, ka, l + 1, rep_);
        if (!last) { for (int rep_ = 0; rep_ < REPS(16); ++rep_) if (PH(16)) convert_weights(F, ka, l + 1); GRID_BAR(); }
    }
}

extern "C" void kernel_launch(void* const* d_in, const int* in_sizes, int n_in, void* d_out, int out_size, void* d_ws, size_t ws_size, hipStream_t stream) {
    static int grid = 0;
    if (grid == 0) {
        if (n_in != 29 || in_sizes[0] != MLAT * D || out_size != MLAT * D || ws_size < WS_END) {
            fprintf(stderr, "kernel_launch: unexpected problem: n_in %d in0 %d out %d ws %zu (need %zu)\n", n_in, n_in > 0 ? in_sizes[0] : -1, out_size, ws_size, (size_t)WS_END); grid = -1; return; }
        int dev = 0, cus = 0, per_cu = 0;
        if (hipGetDevice(&dev) != hipSuccess || hipDeviceGetAttribute(&cus, hipDeviceAttributeMultiprocessorCount, dev) != hipSuccess) { fprintf(stderr, "kernel_launch: device query failed\n"); grid = -1; return; }
        if (hipFuncSetAttribute((const void*)mega_fwd, hipFuncAttributeMaxDynamicSharedMemorySize, LDS_BYTES) != hipSuccess) { fprintf(stderr, "kernel_launch: hipFuncSetAttribute failed\n"); grid = -1; return; }
        if (hipOccupancyMaxActiveBlocksPerMultiprocessor(&per_cu, (const void*)mega_fwd, 512, LDS_BYTES) != hipSuccess || per_cu < 1) {
            fprintf(stderr, "kernel_launch: occupancy query reports %d workgroups per CU\n", per_cu); }
        (void)hipGetLastError();
        grid = cus;
    }
    if (grid < 0) return;
    if (hipMemsetAsync((char*)d_ws + WS_CTL, 0, CTL_BYTES, stream) != hipSuccess) { fprintf(stderr, "kernel_launch: memset failed\n"); return; }
    Args a{};
    for (int i = 0; i < 29; ++i) a.in[i] = (const float*)d_in[i];
    a.out = (float*)d_out; a.ws = (unsigned char*)d_ws;
    hipLaunchKernelGGL(mega_fwd, dim3(grid), dim3(512), LDS_BYTES, stream, a);
    const hipError_t le = hipPeekAtLastError();
    if (le != hipSuccess) fprintf(stderr, "kernel_launch: launch failed: %s\n", hipGetErrorName(le));
}
```

```cpp
#include <hip/hip_runtime.h>
#include <cstdio>
#include <cstdint>

#define DI __device__ __forceinline__
#ifndef PH_MASK
#define PH_MASK 0xFFFFF
#endif
#define PH(b) ((PH_MASK >> (b)) & 1)
#ifndef REP_MASK
#define REP_MASK 0
#endif
#define REPS(b) (1 + ((REP_MASK >> (b)) & 1))
#define LAS __attribute__((address_space(3)))
#define GAS __attribute__((address_space(1)))
typedef unsigned short bf16_t;
typedef short bf16x8 __attribute__((ext_vector_type(8)));
typedef short s16x4 __attribute__((ext_vector_type(4)));
typedef float f32x4 __attribute__((ext_vector_type(4)));
typedef float f32x2 __attribute__((ext_vector_type(2)));
typedef float f32x16 __attribute__((ext_vector_type(16)));
typedef unsigned u32x4 __attribute__((ext_vector_type(4)));
typedef unsigned u32x2 __attribute__((ext_vector_type(2)));
typedef int i32x8 __attribute__((ext_vector_type(8)));

constexpr int D = 1024, NB = 8, SEQ = 4096, NL = 4, CTX = 256;
constexpr int MLAT = NB * SEQ, MCTX = NB * CTX, MT = MLAT + MCTX;
constexpr int DIN = 5312, DINP = 2304, NGL = 3072;
constexpr int C_NAQ = 0, C_NAK = 384, C_NAV = 768, C_CQ = 1152, C_CKV = 1408, C_KR = 1536, C_SWQ = 1600, C_SWK = 1984, C_SWV = 2112, C_GL = 2240;
constexpr int UW = 1792;
constexpr int P1W = 1280;
constexpr int P2W = 1536;
constexpr int OCW = 1536;
constexpr int NE = 16, CAP_LAT = 512, CAP_CTX = 32;
constexpr int NSLOT_LAT = NB * NE * CAP_LAT, NSLOT = NSLOT_LAT + NB * NE * CAP_CTX;
constexpr float EPS = 1e-6f;
constexpr float LOG2E = 1.4426950408889634f;

constexpr size_t MiB = 1u << 20;
constexpr size_t WS_CTL = 0, CTL_BYTES = 1 * MiB;
constexpr size_t WS_MODV = 1 * MiB;
constexpr size_t WS_W = 2 * MiB;
constexpr size_t W_IN = 0, W_GL = 4718592  , W_UP = 11010048, W_NAO = 7864320  , W_MLAO = 13172736, W_SWAO = 8912896  , W_O = 15007744, W_GU = 17104896, W_DN = 84213760, W_END = 117768192;
constexpr size_t WS_XS = 115 * MiB;
constexpr size_t WS_HW = 251 * MiB;
constexpr size_t WS_G = WS_HW + 153 * MiB;
constexpr size_t WS_P1 = 608 * MiB;
constexpr size_t WS_P2 = 693 * MiB;
constexpr size_t WS_R4 = 795 * MiB;
constexpr size_t WS_AFL = 914 * MiB;
constexpr size_t WS_AFC = 916 * MiB;
constexpr size_t WS_SMAP = 917 * MiB;
constexpr size_t WS_GATE = 920 * MiB;
constexpr size_t WS_OCAT = 921 * MiB;
constexpr size_t WS_END = 1006 * MiB;
constexpr size_t WS_MERGED = WS_P1;
constexpr size_t WS_H2 = WS_HW;
constexpr size_t WS_XG = WS_HW + 68 * MiB;
constexpr size_t WS_ACT = WS_HW + 204 * MiB;
constexpr size_t WS_Y = WS_HW + 340 * MiB;
static_assert(W_END <= 113 * MiB && WS_W + 113 * MiB <= WS_XS, "weights");
static_assert(WS_XS + (size_t)MT * D * 4 <= WS_HW && WS_HW + (size_t)MT * DINP * 2 <= WS_G && WS_G + (size_t)MT * NGL * 2 <= WS_P1 && WS_P1 + (size_t)MT * P1W * 2 <= WS_P2 && WS_P2 + (size_t)MT * P2W * 2 <= WS_R4, "map");
static_assert(WS_R4 + (size_t)MT * UW * 2 <= WS_AFL && WS_Y + (size_t)NSLOT * D * 2 <= WS_R4 && WS_SMAP + (size_t)16 * MT * 4 <= WS_GATE && WS_GATE + (size_t)NSLOT * 4 <= WS_OCAT && WS_OCAT + (size_t)MT * OCW <= WS_END, "map2");
constexpr int CW_BAR = 4096;

constexpr int RING_BYTES = 131072, LDSCTL_OFF = RING_BYTES, LDS_BYTES = 147456;

DI unsigned pk2(float lo, float hi) { unsigned r; asm("v_cvt_pk_bf16_f32 %0, %1, %2" : "=v"(r) : "v"(lo), "v"(hi)); return r; }
DI unsigned pk4_fp8(float a, float b, float c, float d) { int w = 0; w = __builtin_amdgcn_cvt_pk_fp8_f32(a, b, w, false); w = __builtin_amdgcn_cvt_pk_fp8_f32(c, d, w, true); return (unsigned)w; }
DI float bflo(unsigned w) { return __uint_as_float(w << 16); }
DI float bfhi(unsigned w) { return __uint_as_float(w & 0xffff0000u); }
DI float bf2f(bf16_t b) { return __uint_as_float((unsigned)b << 16); }
DI float wave_sum(float v) {
#pragma unroll
    for (int o = 1; o < 64; o <<= 1) v += __shfl_xor(v, o);
    return v;
}
DI float sigmoidf_(float x) { return __builtin_amdgcn_rcpf(1.0f + __builtin_amdgcn_exp2f(-x * LOG2E)); }
DI int mod_index(int row) { return row < MLAT ? (row >> 12) : 8; }

#define XB_TMO      128
#define XB_XCNT(j)  (256  + 64 * (j))
#define XB_XSUB(j)  (1280 + 64 * (j))
#define XB_XGEN(j)  (2304 + 64 * (j))
#define XB_TOP      3328
#define XB_TOPGEN   3392
#define XCD_BAR_WORDS 3456
#define XB_SPIN_CAP (1u << 18)
DI unsigned xb_ld(unsigned* p)              { return __hip_atomic_load(p, __ATOMIC_RELAXED, __HIP_MEMORY_SCOPE_AGENT); }
DI unsigned xb_add(unsigned* p, unsigned v) { return __hip_atomic_fetch_add(p, v, __ATOMIC_RELAXED, __HIP_MEMORY_SCOPE_AGENT); }
DI unsigned xb_xcc_id() { return (unsigned)__builtin_amdgcn_s_getreg((3 << 11) | 20) & 0xFu; }
#define XB_SPIN(cond, bar) do { unsigned _sp = 0; while (cond) { __builtin_amdgcn_s_sleep(1); \
    if ((++_sp & 255u) == 0u) { if (xb_ld(&(bar)[XB_TMO])) break; if (_sp > XB_SPIN_CAP) { atomicAdd(&(bar)[XB_TMO], 1u); break; } } } } while (0)
struct XcdBarrier { unsigned* bar; unsigned x; volatile LAS unsigned* st; };
DI XcdBarrier xcd_barrier_post(unsigned* bar, volatile LAS unsigned* st) {
    XcdBarrier b; b.bar = bar; b.x = xb_xcc_id(); b.st = st;
    if (threadIdx.x == 0) (void)xb_add(&bar[XB_XCNT(b.x)], 1u);
    return b;
}
DI void xcd_barrier_complete(unsigned* bar, unsigned x, unsigned& nloc, unsigned& nx) {
    const unsigned G = gridDim.x * gridDim.y * gridDim.z;
    unsigned sum, cnt, mine, sp = 0u;
    for (;;) {
        sum = 0u; cnt = 0u; mine = 0u;
#pragma unroll
        for (unsigned j = 0; j < 16; ++j) { const unsigned c = xb_ld(&bar[XB_XCNT(j)]); sum += c; cnt += (c > 0u) ? 1u : 0u; mine = (j == x) ? c : mine; }
        if (sum == G) break;
        __builtin_amdgcn_s_sleep(1);
        if ((++sp & 255u) == 0u) { if (xb_ld(&bar[XB_TMO])) break; if (sp > XB_SPIN_CAP) { atomicAdd(&bar[XB_TMO], 1u); break; } }
    }
    nloc = mine > 0u ? mine : 1u; nx = cnt > 0u ? cnt : 1u;
}
DI void xcd_barrier(const XcdBarrier& b) {
    asm volatile("s_waitcnt vmcnt(0)" ::: "memory");
    __syncthreads();
    if (threadIdx.x == 0) {
        unsigned* bar = b.bar; unsigned bx_ = b.x; asm volatile("" : "+s"(bar), "+s"(bx_));
        __builtin_amdgcn_s_waitcnt(0);
        unsigned nloc = b.st[0], nx = b.st[1];
        if (nloc == 0u) { xcd_barrier_complete(bar, bx_, nloc, nx); b.st[0] = nloc; b.st[1] = nx; }
        const unsigned old = xb_add(&bar[XB_XSUB(bx_)], 1u);
        const unsigned gen = old / nloc;
        if (old + 1u == (gen + 1u) * nloc) {
            __builtin_amdgcn_fence(__ATOMIC_RELEASE, "agent");
            asm volatile("s_waitcnt vmcnt(0)" ::: "memory");
            const unsigned og = xb_add(&bar[XB_TOP], 1u);
            const unsigned tg = og / nx;
            if (og + 1u == (tg + 1u) * nx) xb_add(&bar[XB_TOPGEN], 1u);
            else XB_SPIN(xb_ld(&bar[XB_TOPGEN]) == tg, bar);
            __builtin_amdgcn_fence(__ATOMIC_ACQUIRE, "agent");
            xb_add(&bar[XB_XGEN(bx_)], 1u);
            asm volatile("s_waitcnt vmcnt(0)" ::: "memory");
        } else {
            XB_SPIN(xb_ld(&bar[XB_XGEN(bx_)]) == gen, bar);
            __builtin_amdgcn_fence(__ATOMIC_ACQUIRE, "agent");
            asm volatile("s_waitcnt vmcnt(0)" ::: "memory");
        }
    }
    __syncthreads();
}

namespace pg8 {
constexpr int BM = 256, BK = 64, HALF = 128, HTB = HALF * BK * 2, NXCD = 8, WGM = 8;
__host__ __device__ __forceinline__ int lds_byte(int r, int c) { const int st = (r >> 4) * 2 + (c >> 5), rr = r & 15, cc = c & 31, ob = rr * 64 + cc * 2; return st * 1024 + (ob ^ (((ob >> 9) & 1) << 5)); }
__host__ __device__ __forceinline__ void stage_rc(int b, int& R, int& C) { const int st = b / 1024, sb = b % 1024, swz = sb ^ (((sb >> 9) & 1) << 5); R = (st >> 1) * 16 + swz / 64; C = (st & 1) * 32 + (swz % 64) / 2; }
__host__ __device__ __forceinline__ int perm32(int rho) { const int n = rho >> 4, i = rho & 15; return 8 * (i >> 2) + 4 * n + (i & 3); }
struct Unit { int pm, pn; };
struct Gemm { const bf16_t* A; const bf16_t* Bt; int K, lda, ldb; size_t estride; };
struct Order {
    int nM, nN, nwg, G, c, moe;
    DI void init(int nM_, int nN_, int G_, int c_, int moe_ = 0) { nM = nM_; nN = nN_; nwg = nM * nN; G = G_; c = c_; moe = moe_; }
    DI bool next(int i, Unit& u) const {
        const long L = (long)i * G + c; if (L >= nwg) return false;
        int wgid = (int)L; { const int q = nwg / NXCD, r = nwg % NXCD, xcd = wgid % NXCD, off = wgid / NXCD; wgid = (xcd < r ? xcd * (q + 1) : r * (q + 1) + (xcd - r) * q) + off; }
        const int nig = WGM * nN, gid = wgid / nig, fm = gid * WGM, gsz = (nM - fm) < WGM ? (nM - fm) : WGM;
        u.pm = fm + ((wgid % nig) % gsz); u.pn = (wgid % nig) / gsz;
        if (moe && u.pm < 256) { const int e = u.pm >> 4, b = (u.pm >> 1) & 7, hf = u.pm & 1; u.pm = (((b << 4) | e) << 1) | hf; }
        return true;
    }
};
struct EpiStoreBf16 {
    static constexpr bool PERM = true;
    bf16_t* O; int ldc;
    DI void operator()(const f32x4 (&acc)[2][2][4][2], const Unit& u, int wr, int wc, int fr, int fq) const {
        const int row0 = u.pm * BM + wr * 64 + fr, col0 = u.pn * BM + wc * 32 + 8 * fq;
#pragma unroll
        for (int ai = 0; ai < 2; ++ai)
#pragma unroll
            for (int m = 0; m < 4; ++m) { bf16_t* rowp = O + (size_t)(row0 + ai * HALF + m * 16) * ldc + col0;
#pragma unroll
                for (int bj = 0; bj < 2; ++bj) { const f32x4 v0 = acc[ai][bj][m][0], v1 = acc[ai][bj][m][1];
                    u32x4 w; w.x = pk2(v0[0], v0[1]); w.y = pk2(v0[2], v0[3]); w.z = pk2(v1[0], v1[1]); w.w = pk2(v1[2], v1[3]);
                    *(u32x4*)(rowp + bj * HALF) = w; } }
    }
};
DI unsigned pk4_u8(float a, float b, float c, float d) {
    unsigned ua = (unsigned)(a * 255.0f + 0.5f), ub = (unsigned)(b * 255.0f + 0.5f), uc = (unsigned)(c * 255.0f + 0.5f), ud = (unsigned)(d * 255.0f + 0.5f);
    ua = ua < 1u ? 1u : ua; ub = ub < 1u ? 1u : ub; uc = uc < 1u ? 1u : uc; ud = ud < 1u ? 1u : ud;
    return ua | (ub << 8) | (uc << 16) | (ud << 24);
}
struct EpiGate {
    static constexpr bool PERM = true;
    unsigned char* O;
    DI void operator()(const f32x4 (&acc)[2][2][4][2], const Unit& u, int wr, int wc, int fr, int fq) const {
        const int row0 = u.pm * BM + wr * 64 + fr, col0 = u.pn * BM + wc * 32 + 8 * fq;
#pragma unroll
        for (int ai = 0; ai < 2; ++ai)
#pragma unroll
            for (int m = 0; m < 4; ++m) { unsigned char* rowp = O + (size_t)(row0 + ai * HALF + m * 16) * NGL + col0;
#pragma unroll
                for (int bj = 0; bj < 2; ++bj) { const f32x4 v0 = acc[ai][bj][m][0] * 0.03125f, v1 = acc[ai][bj][m][1] * 0.03125f;
                    u32x2 w; w.x = pk4_u8(sigmoidf_(v0[0]), sigmoidf_(v0[1]), sigmoidf_(v0[2]), sigmoidf_(v0[3])); w.y = pk4_u8(sigmoidf_(v1[0]), sigmoidf_(v1[1]), sigmoidf_(v1[2]), sigmoidf_(v1[3]));
                    *(u32x2*)(rowp + bj * HALF) = w; } }
    }
};
DI float u8f(unsigned w, int k) { return (float)((w >> (8 * k)) & 0xffu) * (1.0f / 255.0f); }
struct EpiMerge {
    static constexpr bool PERM = true;
    bf16_t* O; const unsigned char* gl; int first;
    DI void operator()(const f32x4 (&acc)[2][2][4][2], const Unit& u, int wr, int wc, int fr, int fq) const {
        const int row0 = u.pm * BM + wr * 64 + fr, col0 = u.pn * BM + wc * 32 + 8 * fq;
#pragma unroll
        for (int ai = 0; ai < 2; ++ai) {
            u32x2 g[4][2]; u32x4 p[4][2];
#pragma unroll
            for (int m = 0; m < 4; ++m)
#pragma unroll
                for (int bj = 0; bj < 2; ++bj) { const int row = row0 + ai * HALF + m * 16, col = col0 + bj * HALF;
                    g[m][bj] = *(const u32x2*)(gl + (size_t)row * NGL + col);
                    p[m][bj] = first ? (u32x4){0u, 0u, 0u, 0u} : *(const u32x4*)(O + (size_t)row * D + col); }
#pragma unroll
            for (int m = 0; m < 4; ++m)
#pragma unroll
                for (int bj = 0; bj < 2; ++bj) { const int row = row0 + ai * HALF + m * 16, col = col0 + bj * HALF;
                    const u32x2 gg = g[m][bj]; const u32x4 pp = p[m][bj]; const f32x4 v0 = acc[ai][bj][m][0], v1 = acc[ai][bj][m][1];
                    const float r0 = v0[0] * u8f(gg.x, 0) + bflo(pp.x), r1 = v0[1] * u8f(gg.x, 1) + bfhi(pp.x), r2 = v0[2] * u8f(gg.x, 2) + bflo(pp.y), r3 = v0[3] * u8f(gg.x, 3) + bfhi(pp.y);
                    const float r4 = v1[0] * u8f(gg.y, 0) + bflo(pp.z), r5 = v1[1] * u8f(gg.y, 1) + bfhi(pp.z), r6 = v1[2] * u8f(gg.y, 2) + bflo(pp.w), r7 = v1[3] * u8f(gg.y, 3) + bfhi(pp.w);
                    u32x4 w; w.x = pk2(r0, r1); w.y = pk2(r2, r3); w.z = pk2(r4, r5); w.w = pk2(r6, r7);
                    *(u32x4*)(O + (size_t)row * D + col) = w; }
        }
    }
};
struct EpiResid {
    static constexpr bool PERM = true;
    bf16_t* xs; const float* modg;
    DI void operator()(const f32x4 (&acc)[2][2][4][2], const Unit& u, int wr, int wc, int fr, int fq) const {
        const int row0 = u.pm * BM + wr * 64 + fr, col0 = u.pn * BM + wc * 32 + 8 * fq;
        const float* mp = modg + (size_t)mod_index(u.pm * BM) * 6144 + col0;
        f32x4 g0[2], g1[2];
#pragma unroll
        for (int bj = 0; bj < 2; ++bj) { g0[bj] = *(const f32x4*)(mp + bj * HALF) * (1.0f / 128.0f); g1[bj] = *(const f32x4*)(mp + bj * HALF + 4) * (1.0f / 128.0f); }
#pragma unroll
        for (int ai = 0; ai < 2; ++ai)
#pragma unroll
            for (int mh = 0; mh < 2; ++mh) {
                u32x4 xw[2][2];
#pragma unroll
                for (int m2 = 0; m2 < 2; ++m2)
#pragma unroll
                    for (int bj = 0; bj < 2; ++bj) xw[m2][bj] = *(const u32x4*)(xs + (size_t)(row0 + ai * HALF + (2 * mh + m2) * 16) * D + col0 + bj * HALF);
#pragma unroll
                for (int m2 = 0; m2 < 2; ++m2)
#pragma unroll
                    for (int bj = 0; bj < 2; ++bj) { const int m = 2 * mh + m2; const u32x4 x = xw[m2][bj];
                        const f32x4 x0 = (f32x4){bflo(x.x), bfhi(x.x), bflo(x.y), bfhi(x.y)} + g0[bj] * acc[ai][bj][m][0];
                        const f32x4 x1 = (f32x4){bflo(x.z), bfhi(x.z), bflo(x.w), bfhi(x.w)} + g1[bj] * acc[ai][bj][m][1];
                        u32x4 w; w.x = pk2(x0[0], x0[1]); w.y = pk2(x0[2], x0[3]); w.z = pk2(x1[0], x1[1]); w.w = pk2(x1[2], x1[3]);
                        *(u32x4*)(xs + (size_t)(row0 + ai * HALF + m * 16) * D + col0 + bj * HALF) = w; }
            }
    }
};
struct EpiSwiglu {
    static constexpr bool PERM = true;
    unsigned char* O;
    DI void operator()(const f32x4 (&acc)[2][2][4][2], const Unit& u, int wr, int wc, int fr, int fq) const {
        const int row0 = u.pm * BM + wr * 64 + fr, col0 = u.pn * HALF + wc * 32 + 8 * fq;
#pragma unroll
        for (int ai = 0; ai < 2; ++ai)
#pragma unroll
            for (int m = 0; m < 4; ++m) { const int row = row0 + ai * HALF + m * 16;
                const f32x4 a0 = acc[ai][0][m][0] * 0.03125f, a1 = acc[ai][0][m][1] * 0.03125f, u0 = acc[ai][1][m][0] * 0.25f, u1 = acc[ai][1][m][1] * 0.25f;
                float r[8];
#pragma unroll
                for (int j = 0; j < 4; ++j) { r[j] = a0[j] * sigmoidf_(a0[j]) * u0[j]; r[4 + j] = a1[j] * sigmoidf_(a1[j]) * u1[j]; }
                u32x2 w; w.x = pk4_fp8(r[0], r[1], r[2], r[3]); w.y = pk4_fp8(r[4], r[5], r[6], r[7]);
                *(u32x2*)(O + (size_t)row * D + col0) = w; }
    }
};
struct EpiDown {
    static constexpr bool PERM = true;
    bf16_t* O; const float* gate;
    DI void operator()(const f32x4 (&acc)[2][2][4][2], const Unit& u, int wr, int wc, int fr, int fq) const {
        const int row0 = u.pm * BM + wr * 64 + fr, col0 = u.pn * BM + wc * 32 + 8 * fq;
        float gv[2][4];
#pragma unroll
        for (int ai = 0; ai < 2; ++ai)
#pragma unroll
            for (int m = 0; m < 4; ++m) gv[ai][m] = gate[row0 + ai * HALF + m * 16] * (1.0f / 256.0f);
#pragma unroll
        for (int ai = 0; ai < 2; ++ai)
#pragma unroll
            for (int m = 0; m < 4; ++m) { const int row = row0 + ai * HALF + m * 16; const float g = gv[ai][m]; bf16_t* rowp = O + (size_t)row * D + col0;
#pragma unroll
                for (int bj = 0; bj < 2; ++bj) { const f32x4 v0 = acc[ai][bj][m][0] * g, v1 = acc[ai][bj][m][1] * g;
                    u32x4 w; w.x = pk2(v0[0], v0[1]); w.y = pk2(v0[2], v0[3]); w.z = pk2(v1[0], v1[1]); w.w = pk2(v1[2], v1[3]);
                    *(u32x4*)(rowp + bj * HALF) = w; } }
    }
};

struct EpiMerge3 {
    static constexpr bool PERM = true;
    bf16_t* O; const unsigned char* gl;
    DI void operator()(f32x4 (&acc)[2][2][4][2], const Unit& u, int seg, int wr, int wc, int fr, int fq) const {
        const int row0 = u.pm * BM + wr * 64 + fr, col0 = u.pn * BM + wc * 32 + 8 * fq;
#pragma unroll
        for (int ai = 0; ai < 2; ++ai) {
            u32x2 ga[4][2], gb[4][2];
#pragma unroll
            for (int m = 0; m < 4; ++m)
#pragma unroll
                for (int bj = 0; bj < 2; ++bj) { const unsigned char* gp = gl + (size_t)(row0 + ai * HALF + m * 16) * NGL + 1024 * seg + col0 + bj * HALF;
                    ga[m][bj] = *(const u32x2*)gp; gb[m][bj] = seg < 2 ? *(const u32x2*)(gp + 1024) : (u32x2){0u, 0u}; }
#pragma unroll
            for (int m = 0; m < 4; ++m)
#pragma unroll
                for (int bj = 0; bj < 2; ++bj) {
                    f32x4 s0, s1;
#pragma unroll
                    for (int k = 0; k < 4; ++k) { const float a0 = (float)((ga[m][bj].x >> (8 * k)) & 0xffu), a1 = (float)((ga[m][bj].y >> (8 * k)) & 0xffu);
                        if (seg < 2) { const float b0 = (float)((gb[m][bj].x >> (8 * k)) & 0xffu), b1 = (float)((gb[m][bj].y >> (8 * k)) & 0xffu); s0[k] = a0 * __builtin_amdgcn_rcpf(b0); s1[k] = a1 * __builtin_amdgcn_rcpf(b1); }
                        else { s0[k] = a0 * (1.0f / (255.0f * 128.0f)); s1[k] = a1 * (1.0f / (255.0f * 128.0f)); } }
                    acc[ai][bj][m][0] *= s0; acc[ai][bj][m][1] *= s1;
                    if (seg == 2) { const f32x4 v0 = acc[ai][bj][m][0] * 4.0f, v1 = acc[ai][bj][m][1] * 4.0f;
                        u32x2 w; w.x = pk4_fp8(v0[0], v0[1], v0[2], v0[3]); w.y = pk4_fp8(v1[0], v1[1], v1[2], v1[3]);
                        *(u32x2*)((unsigned char*)O + (size_t)(row0 + ai * HALF + m * 16) * D + col0 + bj * HALF) = w; }
                }
        }
    }
};
struct Gemm3 { const unsigned char* A0; const unsigned char* A1; const unsigned char* A2; const unsigned char* B0; const unsigned char* B1; const unsigned char* B2; int lda, ldb; };
template <class Epi>
DI void gemm_phase3(LAS unsigned char* lds, const Gemm3 g, const Order& S, const Epi& E) {
    int tid_ = threadIdx.x; asm volatile("" : "+v"(tid_));
    const int tid = tid_, wid = __builtin_amdgcn_readfirstlane(tid >> 6), lane = tid & 63, wr = wid >> 2, wc = wid & 3, fr = lane & 15, fq = lane >> 4;
    unsigned voffA[2], voffB[2];
#pragma unroll
    for (int i = 0; i < 2; ++i) { int R, C; stage_rc(tid * 16 + i * 8192, R, C); const int Rb = Epi::PERM ? ((R & ~31) + perm32(R & 31)) : R;
        voffA[i] = (unsigned)(R * g.lda + C * 2); voffB[i] = (unsigned)(Rb * g.ldb + C * 2); }
    const size_t kstep = (size_t)(BK * 2);
    const size_t hstepA = (size_t)HALF * g.lda, hstepB = (size_t)HALF * g.ldb;
    const size_t tstepA = 2 * hstepA, tstepB = 2 * hstepB;
    const unsigned ldsw = (unsigned)wid * 1024u;
    const int aoff = lds_byte(wr * 64 + fr, fq * 8), boff = lds_byte(wc * 32 + fr, fq * 8);
#define PG8_SA(b, h) (((b) * 2 + (h)) * HTB)
#define PG8_SB(b, h) ((4 + (b) * 2 + (h)) * HTB)
#define PG8_STAGE(bufoff, gbase, voff) do { _Pragma("unroll") for (int _i = 0; _i < 2; ++_i) \
        __builtin_amdgcn_global_load_lds((const unsigned*)((const char*)(gbase) + (voff)[_i]), (LAS unsigned*)(lds + (bufoff) + ldsw + _i * 8192), 16, 0, 0); } while (0)
#define PG8_LDA(dst, b, h) do { _Pragma("unroll") for (int m = 0; m < 4; ++m) _Pragma("unroll") for (int k = 0; k < 2; ++k) dst[m][k] = *(const LAS bf16x8*)(lds + PG8_SA(b, h) + aoff + m * 2048 + k * 1024); } while (0)
#define PG8_LDB(dst, b, h) do { _Pragma("unroll") for (int n = 0; n < 2; ++n) _Pragma("unroll") for (int k = 0; k < 2; ++k) dst[n][k] = *(const LAS bf16x8*)(lds + PG8_SB(b, h) + boff + n * 2048 + k * 1024); } while (0)
#define PG8_MMA(ai, bj, At, Bt) do { __builtin_amdgcn_s_setprio(1); _Pragma("unroll") for (int m = 0; m < 4; ++m) _Pragma("unroll") for (int n = 0; n < 2; ++n) { \
        const i32x8 bb_ = __builtin_bit_cast(i32x8, __builtin_shufflevector(Bt[n][0], Bt[n][1], 0, 1, 2, 3, 4, 5, 6, 7, 8, 9, 10, 11, 12, 13, 14, 15)); \
        const i32x8 aa_ = __builtin_bit_cast(i32x8, __builtin_shufflevector(At[m][0], At[m][1], 0, 1, 2, 3, 4, 5, 6, 7, 8, 9, 10, 11, 12, 13, 14, 15)); \
        asm volatile("v_mfma_scale_f32_16x16x128_f8f6f4 %0, %1, %2, %0, %3, %3 op_sel_hi:[0,0,0]" : "+v"(acc[ai][bj][m][n]) : "v"(bb_), "v"(aa_), "v"(0x7F7F7F7F)); } \
        __builtin_amdgcn_s_setprio(0); } while (0)
#define PG8_WAIT_V(n) asm volatile("s_waitcnt vmcnt(" #n ")" ::: "memory")
#define PG8_WAIT_L(n) asm volatile("s_waitcnt lgkmcnt(" #n ")" ::: "memory")
#define PG8_BAR __builtin_amdgcn_s_barrier()
#define PG8_SCHED __builtin_amdgcn_sched_barrier(0)
#define PG8_A3(sg, u) ((const char*)((sg) == 0 ? g.A0 : (sg) == 1 ? g.A1 : g.A2) + (size_t)(u).pm * tstepA)
#define PG8_B3(sg, u) ((const char*)((sg) == 0 ? g.B0 : (sg) == 1 ? g.B1 : g.B2) + (size_t)(u).pn * tstepB)
    Unit cur, nu; int ui = 0, seg = 0;
    if (!S.next(0, cur)) return;
    f32x4 acc[2][2][4][2];
#pragma unroll
    for (int a = 0; a < 2; ++a)
#pragma unroll
        for (int b = 0; b < 2; ++b)
#pragma unroll
            for (int m = 0; m < 4; ++m)
#pragma unroll
                for (int n = 0; n < 2; ++n) acc[a][b][m][n] = (f32x4){0.f, 0.f, 0.f, 0.f};
    bf16x8 At[4][2], B0[2][2], B1[2][2];
    const char* cA = PG8_A3(0, cur); const char* cB = PG8_B3(0, cur);
    PG8_STAGE(PG8_SB(0, 0), cB, voffB); PG8_STAGE(PG8_SB(0, 1), cB + hstepB, voffB); PG8_STAGE(PG8_SA(0, 0), cA, voffA); PG8_STAGE(PG8_SA(0, 1), cA + hstepA, voffA);
    if (wr == 1) PG8_BAR;
    PG8_WAIT_V(2); PG8_BAR;
    PG8_STAGE(PG8_SB(1, 0), cB + kstep, voffB); PG8_STAGE(PG8_SA(1, 0), cA + kstep, voffA); PG8_STAGE(PG8_SB(1, 1), cB + hstepB + kstep, voffB);
    PG8_WAIT_V(6); PG8_BAR;
    for (;;) {
        int nseg = seg + 1; bool has_next = true; nu = cur;
        if (nseg == 3) { nseg = 0; has_next = S.next(ui + 1, nu); }
        const char* nA = has_next ? PG8_A3(nseg, nu) : cA; const char* nB = has_next ? PG8_B3(nseg, nu) : cB;
        int nt_ = 4; asm volatile("" : "+s"(nt_));
        const int nt = nt_;
#pragma nounroll
        for (int t = 0; t < nt; t += 2) {
            const bool last = (t == nt - 2);
            const char* a1 = cA + (size_t)(t + 1) * kstep;
            const char* a2 = last ? nA : cA + (size_t)(t + 2) * kstep; const char* b2 = last ? nB : cB + (size_t)(t + 2) * kstep;
            const char* a3 = a2 + kstep; const char* b3 = b2 + kstep;
            PG8_LDB(B0, 0, 0); PG8_LDB(B1, 0, 1); PG8_SCHED; PG8_LDA(At, 0, 0); PG8_STAGE(PG8_SA(1, 1), a1 + hstepA, voffA);
            PG8_WAIT_V(8); PG8_WAIT_L(0); PG8_BAR; PG8_MMA(0, 0, At, B0); PG8_MMA(0, 1, At, B1); PG8_BAR; PG8_SCHED;
            PG8_LDA(At, 0, 1); PG8_STAGE(PG8_SB(0, 0), b2, voffB); PG8_STAGE(PG8_SB(0, 1), b2 + hstepB, voffB); PG8_STAGE(PG8_SA(0, 0), a2, voffA);
            PG8_WAIT_V(8); PG8_WAIT_L(0); PG8_BAR; PG8_MMA(1, 0, At, B0); PG8_MMA(1, 1, At, B1); PG8_BAR; PG8_SCHED;
            PG8_LDB(B0, 1, 0); PG8_LDB(B1, 1, 1); PG8_SCHED; PG8_LDA(At, 1, 0); PG8_STAGE(PG8_SA(0, 1), a2 + hstepA, voffA);
            PG8_WAIT_V(8); PG8_WAIT_L(0); PG8_BAR; PG8_MMA(0, 0, At, B0); PG8_MMA(0, 1, At, B1); PG8_BAR; PG8_SCHED;
            PG8_LDA(At, 1, 1); PG8_STAGE(PG8_SB(1, 0), b3, voffB); PG8_STAGE(PG8_SB(1, 1), b3 + hstepB, voffB); PG8_STAGE(PG8_SA(1, 0), a3, voffA);
            PG8_WAIT_V(8); PG8_WAIT_L(0); PG8_BAR; PG8_MMA(1, 0, At, B0); PG8_MMA(1, 1, At, B1); PG8_BAR; PG8_SCHED;
        }
        if (wr == 0) PG8_BAR;
        E(acc, cur, seg, wr, wc, fr, fq);
        if (!has_next) break;
        if (seg == 2) {
#pragma unroll
            for (int a = 0; a < 2; ++a)
#pragma unroll
                for (int b = 0; b < 2; ++b)
#pragma unroll
                    for (int m = 0; m < 4; ++m)
#pragma unroll
                        for (int n = 0; n < 2; ++n) acc[a][b][m][n] = (f32x4){0.f, 0.f, 0.f, 0.f};
            cur = nu; ++ui;
        }
        seg = nseg; cA = nA; cB = nB;
        if (wr == 1) PG8_BAR;
    }
    PG8_WAIT_V(0);
    PG8_BAR;
#undef PG8_SA
#undef PG8_SB
#undef PG8_STAGE
#undef PG8_LDA
#undef PG8_LDB
#undef PG8_MMA
#undef PG8_WAIT_V
#undef PG8_WAIT_L
#undef PG8_BAR
#undef PG8_SCHED
#undef PG8_A3
#undef PG8_B3
}

template <class Epi, bool FP8 = false>
DI void gemm_phase(LAS unsigned char* lds, const Gemm g, const Order& S, const Epi& E) {
    constexpr int ESZ = FP8 ? 1 : 2;
    int tid_ = threadIdx.x; asm volatile("" : "+v"(tid_));
    const int tid = tid_, wid = __builtin_amdgcn_readfirstlane(tid >> 6), lane = tid & 63, wr = wid >> 2, wc = wid & 3, fr = lane & 15, fq = lane >> 4;
    const int K = g.K, nt = K * ESZ / (BK * 2);
    unsigned voffA[2], voffB[2];
#pragma unroll
    for (int i = 0; i < 2; ++i) { int R, C; stage_rc(tid * 16 + i * 8192, R, C); const int Rb = Epi::PERM ? ((R & ~31) + perm32(R & 31)) : R;
        voffA[i] = (unsigned)(R * g.lda * ESZ + C * 2); voffB[i] = (unsigned)(Rb * g.ldb * ESZ + C * 2); }
    const size_t kstep = (size_t)(BK * 2);
    const size_t hstepA = (size_t)HALF * g.lda * ESZ, hstepB = (size_t)HALF * g.ldb * ESZ;
    const size_t tstepA = 2 * hstepA, tstepB = 2 * hstepB;
    const unsigned ldsw = (unsigned)wid * 1024u;
    const int aoff = lds_byte(wr * 64 + fr, fq * 8), boff = lds_byte(wc * 32 + fr, fq * 8);
#define PG8_SA(b, h) (((b) * 2 + (h)) * HTB)
#define PG8_SB(b, h) ((4 + (b) * 2 + (h)) * HTB)
#define PG8_STAGE(bufoff, gbase, voff) do { _Pragma("unroll") for (int _i = 0; _i < 2; ++_i) \
        __builtin_amdgcn_global_load_lds((const unsigned*)((const char*)(gbase) + (voff)[_i]), (LAS unsigned*)(lds + (bufoff) + ldsw + _i * 8192), 16, 0, 0); } while (0)
#define PG8_LDA(dst, b, h) do { _Pragma("unroll") for (int m = 0; m < 4; ++m) _Pragma("unroll") for (int k = 0; k < 2; ++k) dst[m][k] = *(const LAS bf16x8*)(lds + PG8_SA(b, h) + aoff + m * 2048 + k * 1024); } while (0)
#define PG8_LDB(dst, b, h) do { _Pragma("unroll") for (int n = 0; n < 2; ++n) _Pragma("unroll") for (int k = 0; k < 2; ++k) dst[n][k] = *(const LAS bf16x8*)(lds + PG8_SB(b, h) + boff + n * 2048 + k * 1024); } while (0)
#define PG8_MMA(ai, bj, At, Bt) do { __builtin_amdgcn_s_setprio(1); _Pragma("unroll") for (int m = 0; m < 4; ++m) _Pragma("unroll") for (int n = 0; n < 2; ++n) { \
        if constexpr (FP8) { const i32x8 bb_ = __builtin_bit_cast(i32x8, __builtin_shufflevector(Bt[n][0], Bt[n][1], 0, 1, 2, 3, 4, 5, 6, 7, 8, 9, 10, 11, 12, 13, 14, 15)); \
            const i32x8 aa_ = __builtin_bit_cast(i32x8, __builtin_shufflevector(At[m][0], At[m][1], 0, 1, 2, 3, 4, 5, 6, 7, 8, 9, 10, 11, 12, 13, 14, 15)); \
            asm volatile("v_mfma_scale_f32_16x16x128_f8f6f4 %0, %1, %2, %0, %3, %3 op_sel_hi:[0,0,0]" : "+v"(acc[ai][bj][m][n]) : "v"(bb_), "v"(aa_), "v"(0x7F7F7F7F)); } \
        else { _Pragma("unroll") for (int k = 0; k < 2; ++k) acc[ai][bj][m][n] = __builtin_amdgcn_mfma_f32_16x16x32_bf16(Bt[n][k], At[m][k], acc[ai][bj][m][n], 0, 0, 0); } } \
        __builtin_amdgcn_s_setprio(0); } while (0)
#define PG8_WAIT_V(n) asm volatile("s_waitcnt vmcnt(" #n ")" ::: "memory")
#define PG8_WAIT_L(n) asm volatile("s_waitcnt lgkmcnt(" #n ")" ::: "memory")
#define PG8_BAR __builtin_amdgcn_s_barrier()
#define PG8_SCHED __builtin_amdgcn_sched_barrier(0)
#define PG8_EXPERT(pm) ((pm) < 256 ? (((pm) >> 1) & 15) : ((pm) - 256))
#define PG8_ABASE(u) ((const char*)g.A + (size_t)(u).pm * tstepA)
#define PG8_BBASE(u) ((const char*)g.Bt + (size_t)PG8_EXPERT((u).pm) * g.estride * ESZ + (size_t)(u).pn * tstepB)
    Unit cur, nxt; int ui = 0;
    if (!S.next(0, cur)) return;
    f32x4 acc[2][2][4][2];
#pragma unroll
    for (int a = 0; a < 2; ++a)
#pragma unroll
        for (int b = 0; b < 2; ++b)
#pragma unroll
            for (int m = 0; m < 4; ++m)
#pragma unroll
                for (int n = 0; n < 2; ++n) acc[a][b][m][n] = (f32x4){0.f, 0.f, 0.f, 0.f};
    bf16x8 At[4][2], B0[2][2], B1[2][2];
    const char* cA = PG8_ABASE(cur); const char* cB = PG8_BBASE(cur);
    PG8_STAGE(PG8_SB(0, 0), cB, voffB); PG8_STAGE(PG8_SB(0, 1), cB + hstepB, voffB); PG8_STAGE(PG8_SA(0, 0), cA, voffA); PG8_STAGE(PG8_SA(0, 1), cA + hstepA, voffA);
    if (wr == 1) PG8_BAR;
    PG8_WAIT_V(2); PG8_BAR;
    PG8_STAGE(PG8_SB(1, 0), cB + kstep, voffB); PG8_STAGE(PG8_SA(1, 0), cA + kstep, voffA); PG8_STAGE(PG8_SB(1, 1), cB + hstepB + kstep, voffB);
    PG8_WAIT_V(6); PG8_BAR;
    for (;;) {
        const bool has_next = S.next(ui + 1, nxt);
        const char* nA = has_next ? PG8_ABASE(nxt) : cA; const char* nB = has_next ? PG8_BBASE(nxt) : cB;
#pragma nounroll
        for (int t = 0; t < nt; t += 2) {
            const bool last = (t == nt - 2);
            const char* a1 = cA + (size_t)(t + 1) * kstep;
            const char* a2 = last ? nA : cA + (size_t)(t + 2) * kstep; const char* b2 = last ? nB : cB + (size_t)(t + 2) * kstep;
            const char* a3 = a2 + kstep; const char* b3 = b2 + kstep;
            PG8_LDB(B0, 0, 0); PG8_LDB(B1, 0, 1); PG8_SCHED; PG8_LDA(At, 0, 0); PG8_STAGE(PG8_SA(1, 1), a1 + hstepA, voffA);
            PG8_WAIT_V(8); PG8_WAIT_L(0); PG8_BAR; PG8_MMA(0, 0, At, B0); PG8_MMA(0, 1, At, B1); PG8_BAR; PG8_SCHED;
            PG8_LDA(At, 0, 1); PG8_STAGE(PG8_SB(0, 0), b2, voffB); PG8_STAGE(PG8_SB(0, 1), b2 + hstepB, voffB); PG8_STAGE(PG8_SA(0, 0), a2, voffA);
            PG8_WAIT_V(8); PG8_WAIT_L(0); PG8_BAR; PG8_MMA(1, 0, At, B0); PG8_MMA(1, 1, At, B1); PG8_BAR; PG8_SCHED;
            PG8_LDB(B0, 1, 0); PG8_LDB(B1, 1, 1); PG8_SCHED; PG8_LDA(At, 1, 0); PG8_STAGE(PG8_SA(0, 1), a2 + hstepA, voffA);
            PG8_WAIT_V(8); PG8_WAIT_L(0); PG8_BAR; PG8_MMA(0, 0, At, B0); PG8_MMA(0, 1, At, B1); PG8_BAR; PG8_SCHED;
            PG8_LDA(At, 1, 1); PG8_STAGE(PG8_SB(1, 0), b3, voffB); PG8_STAGE(PG8_SB(1, 1), b3 + hstepB, voffB); PG8_STAGE(PG8_SA(1, 0), a3, voffA);
            PG8_WAIT_V(8); PG8_WAIT_L(0); PG8_BAR; PG8_MMA(1, 0, At, B0); PG8_MMA(1, 1, At, B1); PG8_BAR; PG8_SCHED;
        }
        if (wr == 0) PG8_BAR;
        E(acc, cur, wr, wc, fr, fq);
        if (!has_next) break;
#pragma unroll
        for (int a = 0; a < 2; ++a)
#pragma unroll
            for (int b = 0; b < 2; ++b)
#pragma unroll
                for (int m = 0; m < 4; ++m)
#pragma unroll
                    for (int n = 0; n < 2; ++n) acc[a][b][m][n] = (f32x4){0.f, 0.f, 0.f, 0.f};
        cur = nxt; cA = nA; cB = nB; ++ui;
        if (wr == 1) PG8_BAR;
    }
    PG8_WAIT_V(0);
    PG8_BAR;
#undef PG8_SA
#undef PG8_SB
#undef PG8_STAGE
#undef PG8_LDA
#undef PG8_LDB
#undef PG8_MMA
#undef PG8_WAIT_V
#undef PG8_WAIT_L
#undef PG8_BAR
#undef PG8_SCHED
}
}

struct Args { const float* in[29]; float* out; unsigned char* ws; };
typedef const __attribute__((address_space(4))) Args* KArgs;
#define KA_FRESH(ka) asm volatile("" : "+s"(ka))
enum { I_X = 0, I_C, I_CTX, I_CCTX, I_N1G, I_N2G, I_WADA, I_BADA, I_WIN, I_NAQG, I_NAKG, I_RPB, I_MQN, I_WUQ, I_MKVN, I_WUKV, I_MQG, I_MKG, I_SWQG, I_SWKG, I_SINK,
       I_WNAO, I_WMLAO, I_WSWAO, I_WO, I_ROUTER, I_WGATE, I_WUP, I_WDOWN };
struct Frame {
    LAS unsigned char* lds;
    int tid, lane, wave, G, vcu, gw, ngw;
};

DI void frame_fresh(Frame& F) { int t = F.tid, w = F.wave, v = F.vcu; asm volatile("" : "+v"(t), "+s"(w), "+s"(v)); F.tid = t; F.lane = t & 63; F.wave = w; F.vcu = v; F.gw = v * 8 + w; }
DI void modv_phase(Frame& F, KArgs ka) {
    KA_FRESH(ka); const __attribute__((address_space(4))) Args& a = *ka; frame_fresh(F);
    LAS float* cact = (LAS float*)F.lds;
    LAS float* red = (LAS float*)(F.lds + 9 * 1024 * 4);
    const float* c = a.in[I_C]; const float* cc = a.in[I_CCTX];
    for (int i = F.tid; i < 9 * 1024; i += 512) { const float v = i < 8192 ? c[i] : cc[i - 8192]; cact[i] = v * sigmoidf_(v); }
    __syncthreads();
    float* modv = (float*)(a.ws + WS_MODV);
    const int cl = F.lane & 31, kp = F.lane >> 5;
    for (int unit = F.vcu; unit < NL * 192; unit += F.G) {
        const int l = unit / 192, n = (unit % 192) * 32 + cl;
        const float* w = a.in[I_WADA] + (size_t)l * 1024 * 6144 + n;
        float acc[9];
#pragma unroll
        for (int i = 0; i < 9; ++i) acc[i] = 0.f;
        const int k0 = F.wave * 128 + kp;
#pragma unroll 16
        for (int k = 0; k < 128; k += 2) { const float wv = w[(size_t)(k0 + k) * 6144];
#pragma unroll
            for (int i = 0; i < 9; ++i) acc[i] += cact[i * 1024 + k0 + k] * wv; }
#pragma unroll
        for (int i = 0; i < 9; ++i) red[((F.wave * 2 + kp) * 9 + i) * 32 + cl] = acc[i];
        __syncthreads();
        for (int t = F.tid; t < 9 * 32; t += 512) { const int i = t >> 5, nn = t & 31; float s = 0.f;
#pragma unroll
            for (int w16 = 0; w16 < 16; ++w16) s += red[(w16 * 9 + i) * 32 + nn];
            const int col = (unit % 192) * 32 + nn;
            modv[((size_t)l * 9 + i) * 6144 + col] = s + a.in[I_BADA][l * 6144 + col]; }
        __syncthreads();
    }
}
DI void copy_phase(Frame& F, KArgs ka) {
    KA_FRESH(ka); const __attribute__((address_space(4))) Args& a = *ka; frame_fresh(F);
    u32x2* xs = (u32x2*)(a.ws + WS_XS);
    const f32x4* x = (const f32x4*)a.in[I_X]; const f32x4* cx = (const f32x4*)a.in[I_CTX];
    const size_t nl = (size_t)MLAT * D / 4, nc = (size_t)MCTX * D / 4;
    for (size_t i = (size_t)blockIdx.x * 512 + F.tid; i < nl + nc; i += (size_t)F.G * 512) { const f32x4 v = i < nl ? x[i] : cx[i - nl]; u32x2 w; w.x = pk2(v.x, v.y); w.y = pk2(v.z, v.w); xs[i] = w; }
}

DI void cvt_tile(const float* W, int ldw, int k0, int n0, bf16_t* WT, int ldt, int drow0, int dcol0, const float* kscale, LAS float* scr, int lane) {
#pragma unroll 8
    for (int i = 0; i < 32; ++i) { const int kk = 2 * i + (lane >> 5); float v = W[(size_t)(k0 + kk) * ldw + n0 + (lane & 31)]; if (kscale) v *= kscale[k0 + kk]; scr[kk * 33 + (lane & 31)] = v; }
    asm volatile("s_waitcnt lgkmcnt(0)" ::: "memory");
    const int c = lane & 7;
#pragma unroll
    for (int j = 0; j < 4; ++j) { const int n = (lane >> 3) + 8 * j; const LAS float* s = scr + (8 * c) * 33 + n;
        u32x4 o; o.x = pk2(s[0 * 33], s[1 * 33]); o.y = pk2(s[2 * 33], s[3 * 33]); o.z = pk2(s[4 * 33], s[5 * 33]); o.w = pk2(s[6 * 33], s[7 * 33]);
        *(u32x4*)(WT + (size_t)(drow0 + n) * ldt + dcol0 + 8 * c) = o; }
    asm volatile("s_waitcnt lgkmcnt(0)" ::: "memory");
}
DI void cvt_tile_fp8(const float* W, int ldw, int k0, int n0, unsigned char* WT, int ldt, int drow0, int dcol0, float scale, LAS float* scr, int lane) {
#pragma unroll 8
    for (int i = 0; i < 32; ++i) { const int kk = 2 * i + (lane >> 5); scr[kk * 33 + (lane & 31)] = W[(size_t)(k0 + kk) * ldw + n0 + (lane & 31)] * scale; }
    asm volatile("s_waitcnt lgkmcnt(0)" ::: "memory");
    const int c = lane & 7;
#pragma unroll
    for (int j = 0; j < 4; ++j) { const int n = (lane >> 3) + 8 * j; const LAS float* s = scr + (8 * c) * 33 + n;
        u32x2 o; o.x = pk4_fp8(s[0 * 33], s[1 * 33], s[2 * 33], s[3 * 33]); o.y = pk4_fp8(s[4 * 33], s[5 * 33], s[6 * 33], s[7 * 33]);
        *(u32x2*)(WT + (size_t)(drow0 + n) * ldt + dcol0 + 8 * c) = o; }
    asm volatile("s_waitcnt lgkmcnt(0)" ::: "memory");
}
DI void convert_weights(Frame& F, KArgs ka, int l) {
    KA_FRESH(ka); const __attribute__((address_space(4))) Args& a = *ka; frame_fresh(F);
    LAS float* scr = (LAS float*)(F.lds + F.wave * 16384);
    unsigned char* wb = a.ws + WS_W;
    constexpr int T_IN = 16 * 166, T_UQ = 4 * 24, T_UKV = 2 * 32, T_NAO = 6 * 32, T_MLAO = 8 * 32, T_SWAO = 6 * 32, T_O = 16 * 32, T_E = 16 * 32 * 16;
    constexpr int NIT = T_IN + T_UQ + T_UKV + T_NAO + T_MLAO + T_SWAO + T_O + 3 * T_E;
    for (int it = F.gw; it < NIT; it += F.ngw) {
        int r = it;
        if (r < T_IN) { const int kb = r / 166, nb = r % 166;
            if (nb < 70) cvt_tile(a.in[I_WIN] + (size_t)l * 1024 * DIN, DIN, 64 * kb, 32 * nb, (bf16_t*)(wb + W_IN), 1024, 32 * nb, 64 * kb, nullptr, scr, F.lane);
            else cvt_tile_fp8(a.in[I_WIN] + (size_t)l * 1024 * DIN, DIN, 64 * kb, 32 * nb, wb + W_GL, 1024, 32 * nb - 2240, 64 * kb, 32.0f, scr, F.lane);
            continue; } r -= T_IN;
        if (r < T_UQ) { const int kb = r / 24, nb = r % 24; cvt_tile(a.in[I_WUQ] + (size_t)l * 256 * 768, 768, 64 * kb, 32 * nb, (bf16_t*)(wb + W_UP), 384, 32 * nb, 64 * kb, a.in[I_MQN] + l * 256, scr, F.lane); continue; } r -= T_UQ;
        if (r < T_UKV) { const int kb = r / 32, nb = r % 32; cvt_tile(a.in[I_WUKV] + (size_t)l * 128 * 1024, 1024, 64 * kb, 32 * nb, (bf16_t*)(wb + W_UP), 384, 768 + 32 * nb, 256 + 64 * kb, a.in[I_MKVN] + l * 128, scr, F.lane); continue; } r -= T_UKV;
        if (r < T_NAO) { const int kb = r / 32, nb = r % 32; cvt_tile_fp8(a.in[I_WNAO] + (size_t)l * 384 * 1024, 1024, 64 * kb, 32 * nb, wb + W_NAO, 512, 32 * nb, 64 * kb, 32.0f, scr, F.lane); continue; } r -= T_NAO;
        if (r < T_MLAO) { const int kb = r / 32, nb = r % 32; cvt_tile_fp8(a.in[I_WMLAO] + (size_t)l * 512 * 1024, 1024, 64 * kb, 32 * nb, wb + W_MLAO, 512, 32 * nb, 64 * kb, 32.0f, scr, F.lane); continue; } r -= T_MLAO;
        if (r < T_SWAO) { const int kb = r / 32, nb = r % 32; cvt_tile_fp8(a.in[I_WSWAO] + (size_t)l * 384 * 1024, 1024, 64 * kb, 32 * nb, wb + W_SWAO, 512, 32 * nb, 64 * kb, 32.0f, scr, F.lane); continue; } r -= T_SWAO;
        if (r < T_O) { const int kb = r / 32, nb = r % 32; cvt_tile_fp8(a.in[I_WO] + (size_t)l * 1024 * 1024, 1024, 64 * kb, 32 * nb, wb + W_O, 1024, 32 * nb, 64 * kb, 32.0f, scr, F.lane); continue; } r -= T_O;
        if (r < 2 * T_E) {
            const int which = r / T_E, rr = r % T_E, e = rr / 512, t = rr % 512, kb = t / 32, nb = t % 32, f0 = 32 * nb;
            const float* src = a.in[which ? I_WUP : I_WGATE] + ((size_t)l * 16 + e) * 1024 * 1024;
            cvt_tile_fp8(src, 1024, 64 * kb, f0, wb + W_GU + (size_t)e * 2048 * 1024, 1024, 256 * (f0 >> 7) + 128 * which + (f0 & 127), 64 * kb, 32.0f, scr, F.lane); continue; } r -= 2 * T_E;
        { const int e = r / 512, t = r % 512, kb = t / 32, nb = t % 32;
            cvt_tile_fp8(a.in[I_WDOWN] + ((size_t)l * 16 + e) * 1024 * 1024, 1024, 64 * kb, 32 * nb, wb + W_DN + (size_t)e * 1024 * 1024, 1024, 32 * nb, 64 * kb, 32.0f, scr, F.lane); }
    }
    constexpr int Z0 = 64 * 128, Z1 = 768 * 16, Z2 = 1024 * 32, Z3 = 2 * 1024 * 8;
    unsigned zz = 0u; asm volatile("" : "+v"(zz));
    const u32x4 z = {zz, zz, zz, zz};
    for (int i = blockIdx.x * 512 + F.tid; i < Z0 + Z1 + Z2 + Z3; i += F.G * 512) {
        if (i >= Z0 + Z1 + Z2) { const int j = i - Z0 - Z1 - Z2, which = j >> 13, jj = j & 8191; *(u32x4*)(wb + (which ? W_SWAO : W_NAO) + (size_t)(jj >> 3) * 512 + 384 + (jj & 7) * 16) = z; continue; }
        if (i < Z0) *(u32x4*)((bf16_t*)(wb + W_IN) + (size_t)(2240 + i / 128) * 1024 + (i % 128) * 8) = z;
        else if (i < Z0 + Z1) { const int j = i - Z0; *(u32x4*)((bf16_t*)(wb + W_UP) + (size_t)(j / 16) * 384 + 256 + (j % 16) * 8) = z; }
        else { const int j = i - Z0 - Z1; *(u32x4*)((bf16_t*)(wb + W_UP) + (size_t)(768 + j / 32) * 384 + (j % 32) * 8) = z; }
    }
}

DI void row_phase(Frame& F, KArgs ka, int l, int dry = 0) {
    KA_FRESH(ka); const __attribute__((address_space(4))) Args& a = *ka; frame_fresh(F);
    bf16_t* xs = (bf16_t*)(a.ws + WS_XS);
    const float* modv = (const float*)(a.ws + WS_MODV);
    const int* smap = (const int*)(a.ws + WS_SMAP);
    const bf16_t* Y = (const bf16_t*)(a.ws + WS_Y);
    bf16_t* H = (bf16_t*)(a.ws + WS_R4);
    unsigned char* H8 = a.ws + WS_R4 + 68 * MiB;
    bf16_t* xso = xs; float* outo = a.out;
    if (dry) { unsigned char* tr = a.ws + WS_END + (size_t)F.gw * 16384; xso = (bf16_t*)tr; outo = (float*)tr; H = (bf16_t*)(tr + 8192); H8 = tr + 12288; }
    const int nrows = (l == NL) ? MLAT : MT;
    const bool comb = (l > 0);
    constexpr int RR = 4;
    for (int mb = RR * F.gw; mb < nrows; mb += RR * F.ngw) {
        f32x4 v[RR][4]; int myslot[RR];
#pragma unroll
        for (int rr = 0; rr < RR; ++rr) { const int m = mb + rr;
            if (l == 0) {
                if (F.lane < 16 && !dry) *(u32x4*)(a.ws + WS_OCAT + (size_t)m * OCW + ((F.lane >> 3) ? 1408 : 384) + 16 * (F.lane & 7)) = (u32x4){0u, 0u, 0u, 0u};
                const f32x4* xr = (const f32x4*)(m < MLAT ? a.in[I_X] + (size_t)m * D : a.in[I_CTX] + (size_t)(m - MLAT) * D) + F.lane;
                u32x2* xo = (u32x2*)(xs + (size_t)m * D) + F.lane;
#pragma unroll
                for (int j = 0; j < 4; ++j) { const f32x4 t = xr[64 * j]; u32x2 w; w.x = pk2(t.x, t.y); w.y = pk2(t.z, t.w); if (!dry) xo[64 * j] = w; v[rr][j] = (f32x4){bflo(w.x), bfhi(w.x), bflo(w.y), bfhi(w.y)}; }
            } else {
                const u32x2* xr = (const u32x2*)(xs + (size_t)m * D) + F.lane;
#pragma unroll
                for (int j = 0; j < 4; ++j) { const u32x2 w = xr[64 * j]; v[rr][j] = (f32x4){bflo(w.x), bfhi(w.x), bflo(w.y), bfhi(w.y)}; }
            }
            myslot[rr] = (comb && F.lane < 16) ? smap[(size_t)F.lane * MT + mb + rr] : -1; }
        const int mi = mod_index(mb);
        if (comb) {
            f32x4 acc[RR][4];
            unsigned long long mk[RR];
#pragma unroll
            for (int rr = 0; rr < RR; ++rr) { mk[rr] = __ballot(myslot[rr] >= 0);
#pragma unroll
                for (int j = 0; j < 4; ++j) acc[rr][j] = (f32x4){0.f, 0.f, 0.f, 0.f}; }
            while ((mk[0] | mk[1]) | (mk[2] | mk[3])) {
                u32x2 w[RR][4];
#pragma unroll
                for (int rr = 0; rr < RR; ++rr) {
                    int s = -1;
                    if (mk[rr]) { const int e0 = __builtin_ctzll(mk[rr]); s = __shfl(myslot[rr], e0); mk[rr] &= mk[rr] - 1; }
#pragma unroll
                    for (int j = 0; j < 4; ++j) w[rr][j] = (u32x2){0u, 0u};
                    if (s >= 0) { const u32x2* yr = (const u32x2*)(Y + (size_t)s * D) + F.lane;
#pragma unroll
                        for (int j = 0; j < 4; ++j) w[rr][j] = yr[64 * j]; }
                }
#pragma unroll
                for (int rr = 0; rr < RR; ++rr)
#pragma unroll
                    for (int j = 0; j < 4; ++j) acc[rr][j] += (f32x4){bflo(w[rr][j].x), bfhi(w[rr][j].x), bflo(w[rr][j].y), bfhi(w[rr][j].y)};
            }
            const f32x4* g5 = (const f32x4*)(modv + ((size_t)(l - 1) * 9 + mi) * 6144 + 5 * 1024) + F.lane;
            f32x4 g5v[4];
#pragma unroll
            for (int j = 0; j < 4; ++j) g5v[j] = g5[64 * j];
#pragma unroll
            for (int rr = 0; rr < RR; ++rr) { const int m = mb + rr;
                const size_t ro = dry ? (size_t)rr * 1024 : (size_t)m * D;
#pragma unroll
                for (int j = 0; j < 4; ++j) { v[rr][j] += g5v[j] * acc[rr][j];
                    if (l == NL) ((f32x4*)(outo + ro) + F.lane)[64 * j] = v[rr][j];
                    else { u32x2 w; w.x = pk2(v[rr][j].x, v[rr][j].y); w.y = pk2(v[rr][j].z, v[rr][j].w); ((u32x2*)(xso + ro) + F.lane)[64 * j] = w;
                           v[rr][j] = (f32x4){bflo(w.x), bfhi(w.x), bflo(w.y), bfhi(w.y)}; } } }
        }
        if (l < NL) {
            const f32x4* g = (const f32x4*)(a.in[I_N1G] + l * D) + F.lane;
            const f32x4* sh = (const f32x4*)(modv + ((size_t)l * 9 + mi) * 6144) + F.lane;
            const f32x4* sc = (const f32x4*)(modv + ((size_t)l * 9 + mi) * 6144 + 1024) + F.lane;
            f32x4 gg[4], shv[4];
#pragma unroll
            for (int j = 0; j < 4; ++j) { gg[j] = g[64 * j] * (sc[64 * j] + 1.0f); shv[j] = sh[64 * j]; }
#pragma unroll
            for (int rr = 0; rr < RR; ++rr) { const int m = mb + rr;
                float ss = 0.f;
#pragma unroll
                for (int j = 0; j < 4; ++j) ss += (v[rr][j].x * v[rr][j].x + v[rr][j].y * v[rr][j].y) + (v[rr][j].z * v[rr][j].z + v[rr][j].w * v[rr][j].w);
                const float rstd = __builtin_amdgcn_rsqf(wave_sum(ss) * (1.f / D) + EPS);
                u32x2* o = (u32x2*)(H + (dry ? (size_t)rr * 1024 : (size_t)m * D)) + F.lane;
                unsigned* o8 = (unsigned*)(H8 + (dry ? (size_t)rr * 1024 : (size_t)m * D)) + F.lane;
#pragma unroll
                for (int j = 0; j < 4; ++j) { const f32x4 hh = v[rr][j] * rstd * gg[j] + shv[j]; u32x2 w; w.x = pk2(hh.x, hh.y); w.y = pk2(hh.z, hh.w); o[64 * j] = w;
                    o8[64 * j] = pk4_fp8(hh.x, hh.y, hh.z, hh.w); } }
        }
    }
}

DI void rope_cs(int d, int prow, int pcol, float& cs, float& sn) {
    const int i = d & 15; const float pos = (float)((d & 32) ? pcol : prow);
    const float inv = __builtin_amdgcn_exp2f(-(float)i * (13.287712379549449f / 16.0f));
    const float rev = pos * inv * 0.15915494309189535f;
    const float fr = rev - floorf(rev);
    cs = __builtin_amdgcn_cosf(fr); sn = __builtin_amdgcn_sinf(fr);
}
DI void prep_phase(Frame& F, KArgs ka, int l) {
    KA_FRESH(ka); const __attribute__((address_space(4))) Args& a = *ka; frame_fresh(F);
    const bf16_t* HW = (const bf16_t*)(a.ws + WS_HW);
    bf16_t* P1 = (bf16_t*)(a.ws + WS_P1);
    const float sc64 = 0.125f * LOG2E;
    const int d0 = 8 * (F.lane & 7);
    float gn[3][8]; int srcc[3]; bool ropei[3], acti[3];
    const float* gp0 = a.in[I_NAQG]; const float* gp1 = a.in[I_NAKG]; const float* gp2 = a.in[I_SWQG]; const float* gp3 = a.in[I_SWKG];
#pragma unroll
    for (int i = 0; i < 3; ++i) { const int c = F.lane + 64 * i, col = 8 * c; acti[i] = c < 160;
        const int ty = col < 384 ? 0 : col < 768 ? 1 : col < 1152 ? 2 : 3;
        srcc[i] = col < 768 ? col : col + (C_SWQ - 768);
        ropei[i] = ty >= 2;
        const float sc = (ty == 0 || ty == 2) ? sc64 : 1.0f;
#pragma unroll
        for (int j = 0; j < 8; ++j) { const float g0 = gp0[l * 64 + d0 + j], g1 = gp1[l * 64 + d0 + j], g2 = gp2[l * 64 + d0 + j], g3 = gp3[l * 64 + d0 + j];
            gn[i][j] = acti[i] ? (ty == 0 ? g0 : ty == 1 ? g1 : ty == 2 ? g2 : g3) * sc : 0.f; } }
    float invf[8];
#pragma unroll
    for (int j = 0; j < 8; ++j) invf[j] = __builtin_amdgcn_exp2f(-(float)((d0 & 8) + j) * (13.287712379549449f / 16.0f)) * 0.15915494309189535f;
    const bool second = (d0 & 16) != 0, usecol = (d0 & 32) != 0;
    for (int mb = 2 * F.gw; mb < MT; mb += 2 * F.ngw) {
        u32x4 w[2][3];
#pragma unroll
        for (int rr = 0; rr < 2; ++rr)
#pragma unroll
            for (int i = 0; i < 3; ++i) if (acti[i]) w[rr][i] = *(const u32x4*)(HW + (size_t)(mb + rr) * DINP + srcc[i]); else w[rr][i] = (u32x4){0u, 0u, 0u, 0u};
#pragma unroll
        for (int rr = 0; rr < 2; ++rr) {
            const int m = mb + rr; const bool lat = m < MLAT; const int s = m & 4095; const float prw = (float)(s >> 6), pcl = (float)(s & 63); float pos = usecol ? pcl : prw; asm volatile("" : "+v"(pos));
            float cs[8], sn[8];
#pragma unroll
            for (int j = 0; j < 8; ++j) { cs[j] = 1.f; sn[j] = 0.f; }
            if (lat) {
#pragma unroll
                for (int j = 0; j < 8; ++j) { const float rev = pos * invf[j], fr = rev - floorf(rev); cs[j] = __builtin_amdgcn_cosf(fr); sn[j] = __builtin_amdgcn_sinf(fr); } }
#pragma unroll
            for (int i = 0; i < 3; ++i) {
                float x[8] = {bflo(w[rr][i].x), bfhi(w[rr][i].x), bflo(w[rr][i].y), bfhi(w[rr][i].y), bflo(w[rr][i].z), bfhi(w[rr][i].z), bflo(w[rr][i].w), bfhi(w[rr][i].w)};
                float ss = 0.f;
#pragma unroll
                for (int j = 0; j < 8; ++j) ss += x[j] * x[j];
                ss += __shfl_xor(ss, 1); ss += __shfl_xor(ss, 2); ss += __shfl_xor(ss, 4);
                const float rs = __builtin_amdgcn_rsqf(ss * (1.f / 64.f) + EPS);
#pragma unroll
                for (int j = 0; j < 8; ++j) x[j] *= rs * gn[i][j];
                const bool rp = ropei[i] && lat;
#pragma unroll
                for (int j = 0; j < 8; ++j) { const float y = __int_as_float(__builtin_amdgcn_ds_bpermute((F.lane ^ 2) << 2, __float_as_int(x[j]))); const float rot = second ? x[j] * cs[j] + y * sn[j] : x[j] * cs[j] - y * sn[j]; x[j] = rp ? rot : x[j]; }
                if (acti[i]) { u32x4 o; o.x = pk2(x[0], x[1]); o.y = pk2(x[2], x[3]); o.z = pk2(x[4], x[5]); o.w = pk2(x[6], x[7]);
                    *(u32x4*)(P1 + (size_t)m * P1W + 8 * (F.lane + 64 * i)) = o; }
            }
        }
    }
}
DI void prep2_phase(Frame& F, KArgs ka, int l, int dry = 0) {
    KA_FRESH(ka); const __attribute__((address_space(4))) Args& a = *ka; frame_fresh(F);
    const bf16_t* HW = (const bf16_t*)(a.ws + WS_HW);
    bf16_t* U = (bf16_t*)(a.ws + WS_R4);
    bf16_t* P2 = (bf16_t*)(a.ws + WS_P2);
    const float scq = 0.07216878364870322f * LOG2E;
    const int ln = F.lane, q = ln & 15, h = ln >> 4;
    float qgn[8], qgr[4], kgn[8], kgr[4], invf[4];
    { const float* qg = a.in[I_MQG] + l * 192; const float* kg = a.in[I_MKG] + l * 192;
#pragma unroll
      for (int j = 0; j < 8; ++j) { qgn[j] = qg[8 * q + j] * scq; kgn[j] = kg[8 * q + j]; }
#pragma unroll
      for (int j = 0; j < 4; ++j) { qgr[j] = qg[128 + 4 * q + j] * scq; kgr[j] = kg[128 + 4 * q + j];
          invf[j] = __builtin_amdgcn_exp2f(-(float)(4 * (q & 3) + j) * (13.287712379549449f / 16.0f)) * 0.15915494309189535f; } }
    const bool second = (q & 4) != 0, usecol = (q & 8) != 0;
    const int pl = (ln ^ 4) << 2;
    for (int mb = 2 * F.gw; mb < MT; mb += 2 * F.ngw) {
        u32x2 wcq[2], wqr[2], wkr[2]; unsigned wckv[2]; u32x4 wqn[2], wkn[2], wv[2];
#pragma unroll
        for (int rr = 0; rr < 2; ++rr) { const bf16_t* hr = HW + (size_t)(mb + rr) * DINP; const bf16_t* ur = U + (size_t)(mb + rr) * UW;
            wcq[rr] = *(const u32x2*)(hr + C_CQ + 4 * ln); wckv[rr] = *(const unsigned*)(hr + C_CKV + 2 * ln); wkr[rr] = *(const u32x2*)(hr + C_KR + 4 * q);
            wqn[rr] = *(const u32x4*)(ur + h * 192 + 8 * q); wqr[rr] = *(const u32x2*)(ur + h * 192 + 128 + 4 * q);
            wkn[rr] = *(const u32x4*)(ur + 768 + h * 256 + 8 * q); wv[rr] = *(const u32x4*)(ur + 768 + h * 256 + 128 + 8 * q); }
#pragma unroll
        for (int rr = 0; rr < 2; ++rr) {
            const int m = mb + rr; const bool lat = m < MLAT; const int s = m & 4095;
            bf16_t* ur = U + (size_t)m * UW; bf16_t* pr = P2 + (size_t)m * P2W;
            if (dry) { ur = (bf16_t*)(a.ws + WS_END + (size_t)F.gw * 8192); pr = ur + 2048; }
            float rq, rkv;
            { const float a0 = bflo(wcq[rr].x), a1 = bfhi(wcq[rr].x), a2 = bflo(wcq[rr].y), a3 = bfhi(wcq[rr].y);
              rq = __builtin_amdgcn_rsqf(wave_sum(a0 * a0 + a1 * a1 + a2 * a2 + a3 * a3) * (1.f / 256.f) + EPS); }
            { const float a0 = bflo(wckv[rr]), a1 = bfhi(wckv[rr]);
              rkv = __builtin_amdgcn_rsqf(wave_sum(a0 * a0 + a1 * a1) * (1.f / 128.f) + EPS); }
            float cs[4], sn[4];
            { const float prw = (float)(s >> 6), pcl = (float)(s & 63); float pos = usecol ? pcl : prw; asm volatile("" : "+v"(pos));
#pragma unroll
              for (int j = 0; j < 4; ++j) { const float rev = pos * invf[j], fr = rev - floorf(rev); cs[j] = lat ? __builtin_amdgcn_cosf(fr) : 1.f; sn[j] = lat ? __builtin_amdgcn_sinf(fr) : 0.f; } }
#pragma unroll
            for (int isk = 0; isk < 2; ++isk) {
                const u32x4 wn = isk ? wkn[rr] : wqn[rr]; const u32x2 wr2 = isk ? wkr[rr] : wqr[rr];
                const float sn_ = isk ? rkv : rq, sr_ = isk ? 1.0f : rq;
                float x[8] = {bflo(wn.x) * sn_, bfhi(wn.x) * sn_, bflo(wn.y) * sn_, bfhi(wn.y) * sn_, bflo(wn.z) * sn_, bfhi(wn.z) * sn_, bflo(wn.w) * sn_, bfhi(wn.w) * sn_};
                float y[4] = {bflo(wr2.x) * sr_, bfhi(wr2.x) * sr_, bflo(wr2.y) * sr_, bfhi(wr2.y) * sr_};
                float ss = 0.f;
#pragma unroll
                for (int j = 0; j < 8; ++j) ss += x[j] * x[j];
#pragma unroll
                for (int j = 0; j < 4; ++j) ss += y[j] * y[j];
                ss += __shfl_xor(ss, 1); ss += __shfl_xor(ss, 2); ss += __shfl_xor(ss, 4); ss += __shfl_xor(ss, 8);
                const float rs = __builtin_amdgcn_rsqf(ss * (1.f / 192.f) + EPS);
#pragma unroll
                for (int j = 0; j < 8; ++j) x[j] *= rs * (isk ? kgn[j] : qgn[j]);
#pragma unroll
                for (int j = 0; j < 4; ++j) { y[j] *= rs * (isk ? kgr[j] : qgr[j]);
                    const float p = __int_as_float(__builtin_amdgcn_ds_bpermute(pl, __float_as_int(y[j])));
                    y[j] = second ? y[j] * cs[j] + p * sn[j] : y[j] * cs[j] - p * sn[j]; }
                u32x4 o; o.x = pk2(x[0], x[1]); o.y = pk2(x[2], x[3]); o.z = pk2(x[4], x[5]); o.w = pk2(x[6], x[7]);
                u32x2 o2; o2.x = pk2(y[0], y[1]); o2.y = pk2(y[2], y[3]);
                *(u32x4*)(pr + 768 * isk + h * 192 + 8 * q) = o; *(u32x2*)(pr + 768 * isk + h * 192 + 128 + 4 * q) = o2;
            }
            { const u32x4 vw = wv[rr]; u32x4 o; o.x = pk2(bflo(vw.x) * rkv, bfhi(vw.x) * rkv); o.y = pk2(bflo(vw.y) * rkv, bfhi(vw.y) * rkv); o.z = pk2(bflo(vw.z) * rkv, bfhi(vw.z) * rkv); o.w = pk2(bflo(vw.w) * rkv, bfhi(vw.w) * rkv);
              *(u32x4*)(ur + 768 + h * 256 + 128 + 8 * q) = o; }
        }
    }
}

struct AU {
    const bf16_t *q, *k, *v; unsigned char* o;
    int ldq, ldk, ldv, ldo;
    int qrow0;
    int lat_row0, n_lat, ctx_row0, n_ctx;
    int mode;
    int qpos0, kpos0;
    float m0, l0;
    const float* rpb;
};
template <int DQ, int DV, int LDK, int LDV>
DI void attn_unit(LAS unsigned char* lds, const AU& u, int tid, int wave, int lane) {
    constexpr int KP = DQ * 2 + 16, VP = DV * 2 + 64, KBY = 64 * KP, VBY = 64 * VP, STG = KBY + VBY;
    constexpr int NKS = DQ / 16, NDT = DV / 32, KCH = DQ / 8, VCH = DV / 8;
    constexpr int KC = KP / 16, VC = VP / 16;
    constexpr int KI = (KC + 7) / 8, VI = (VC + 7) / 8;
    constexpr int BIAS_OFF = 98304;
    static_assert(2 * STG <= BIAS_OFF && KBY % 1024 == 0 && VBY % 1024 == 0, "attention LDS");
    const int r = lane & 31, h = lane >> 5;
    const int nt = u.n_lat + u.n_ctx;
    LAS float* btab = (LAS float*)(lds + BIAS_OFF);
    if (u.mode == 2) { for (int i = tid; i < 15 * 31; i += 512) btab[i] = u.rpb[i] * LOG2E; }
    bf16x8 qf[NKS];
    { const bf16_t* qp = u.q + (size_t)(u.qrow0 + wave * 32 + r) * u.ldq + 8 * h;
#pragma unroll
      for (int ks = 0; ks < NKS; ++ks) qf[ks] = *(const bf16x8*)(qp + 16 * ks); }
    f32x16 o[NDT];
#pragma unroll
    for (int dt = 0; dt < NDT; ++dt)
#pragma unroll
        for (int i = 0; i < 16; ++i) o[dt][i] = 0.f;
    float mrun = u.m0, lrun = (h == 0) ? u.l0 : 0.f;
    unsigned koff[KI], voff[VI];
#pragma unroll
    for (int i = 0; i < KI; ++i) { const int c = 64 * (wave + 8 * i) + lane, row = c / KC, cc = c % KC; koff[i] = (unsigned)(row * LDK * 2 + (cc < KCH ? cc : KCH - 1) * 16); }
#pragma unroll
    for (int i = 0; i < VI; ++i) { const int c = 64 * (wave + 8 * i) + lane, row = c / VC, cc = c % VC; voff[i] = (unsigned)(row * LDV * 2 + (cc < VCH ? cc : VCH - 1) * 16); }
#define AT_ROWBASE(t) ((t) < u.n_lat ? u.lat_row0 + 64 * (t) : u.ctx_row0 + 64 * ((t) - u.n_lat))
#define AT_ISSUE(t, buf) do { const int rb_ = AT_ROWBASE(t); const char* kb_ = (const char*)(u.k + (size_t)rb_ * LDK); const char* vb_ = (const char*)(u.v + (size_t)rb_ * LDV); \
        _Pragma("unroll") for (int i_ = 0; i_ < KI; ++i_) { const int j_ = wave + 8 * i_; if (j_ < KC) __builtin_amdgcn_global_load_lds((const unsigned*)(kb_ + koff[i_]), (LAS unsigned*)(lds + (buf) * STG + j_ * 1024), 16, 0, 0); } \
        _Pragma("unroll") for (int i_ = 0; i_ < VI; ++i_) { const int j_ = wave + 8 * i_; if (j_ < VC) __builtin_amdgcn_global_load_lds((const unsigned*)(vb_ + voff[i_]), (LAS unsigned*)(lds + (buf) * STG + KBY + j_ * 1024), 16, 0, 0); } } while (0)
    AT_ISSUE(0, 0);
    asm volatile("s_waitcnt vmcnt(0)" ::: "memory");
    __syncthreads();
    const int tq = (lane & 15) >> 2, tp = lane & 3, tblk = (lane >> 4) & 1;
    const int vlane_off = (4 * h + tq) * VP + 32 * tblk + 8 * tp;
    for (int t = 0; t < nt; ++t) {
        const int buf = t & 1;
        if (t + 1 < nt) AT_ISSUE(t + 1, buf ^ 1);
        bool skip = false; int a0 = 0, a1 = 0;
        if (u.mode == 1 && t < u.n_lat) { const int k0 = u.kpos0 + 64 * t, q0 = u.qpos0 + 32 * wave; skip = (k0 > q0 + 31 + 128) || (k0 + 63 < q0 - 128); a0 = k0; a1 = q0; }
        if (u.mode == 2 && t < u.n_lat) { const int kr = u.kpos0 + t, qr = u.qpos0 + (wave >> 1); int rs = qr - 4; rs = rs < 0 ? 0 : (rs > 56 ? 56 : rs); skip = (kr < rs) || (kr >= rs + 8); a0 = kr - qr + 7; }
        if (!skip) {
            const LAS unsigned char* Kt = lds + buf * STG; const LAS unsigned char* Vt = Kt + KBY;
            f32x16 s0, s1;
#pragma unroll
            for (int i = 0; i < 16; ++i) { s0[i] = 0.f; s1[i] = 0.f; }
#pragma unroll
            for (int ks = 0; ks < NKS; ++ks) {
                const bf16x8 k0 = *(const LAS bf16x8*)(Kt + r * KP + (16 * ks + 8 * h) * 2);
                const bf16x8 k1 = *(const LAS bf16x8*)(Kt + (32 + r) * KP + (16 * ks + 8 * h) * 2);
                s0 = __builtin_amdgcn_mfma_f32_32x32x16_bf16(k0, qf[ks], s0, 0, 0, 0);
                s1 = __builtin_amdgcn_mfma_f32_32x32x16_bf16(k1, qf[ks], s1, 0, 0, 0);
            }
            if (u.mode == 1 && t < u.n_lat) {
                const int qpos = a1 + r;
#pragma unroll
                for (int i = 0; i < 16; ++i) { const int kk = a0 + (i & 3) + 8 * (i >> 2) + 4 * h; int d0 = qpos - kk; d0 = d0 < 0 ? -d0 : d0; int d1 = qpos - (kk + 32); d1 = d1 < 0 ? -d1 : d1;
                    s0[i] = d0 <= 128 ? s0[i] : -INFINITY; s1[i] = d1 <= 128 ? s1[i] : -INFINITY; }
            }
            if (u.mode == 2 && t < u.n_lat) {
                const int qc = 32 * (wave & 1) + r; int cs = qc - 8; cs = cs < 0 ? 0 : (cs > 48 ? 48 : cs);
                const int bbase = a0 * 31 + 15 - qc;
                float bb[16];
#pragma unroll
                for (int half = 0; half < 2; ++half) {
#pragma unroll
                    for (int i = 0; i < 16; ++i) { int ix = bbase + 32 * half + (i & 3) + 8 * (i >> 2) + 4 * h; ix = ix < 0 ? 0 : (ix > 464 ? 464 : ix); bb[i] = btab[ix]; }
                    asm volatile("" : "+v"(bb[0]), "+v"(bb[1]), "+v"(bb[2]), "+v"(bb[3]), "+v"(bb[4]), "+v"(bb[5]), "+v"(bb[6]), "+v"(bb[7]), "+v"(bb[8]), "+v"(bb[9]), "+v"(bb[10]), "+v"(bb[11]), "+v"(bb[12]), "+v"(bb[13]), "+v"(bb[14]), "+v"(bb[15]));
#pragma unroll
                    for (int i = 0; i < 16; ++i) { const int kc = 32 * half + (i & 3) + 8 * (i >> 2) + 4 * h; const bool ok = (kc >= cs) && (kc < cs + 16);
                        if (half == 0) s0[i] = ok ? s0[i] + bb[i] : -INFINITY; else s1[i] = ok ? s1[i] + bb[i] : -INFINITY; }
                }
            }
            float mx = fmaxf(s0[0], s1[0]);
#pragma unroll
            for (int i = 1; i < 16; ++i) mx = fmaxf(mx, fmaxf(s0[i], s1[i]));
            mx = fmaxf(mx, __shfl_xor(mx, 32));
            const float mnew = fmaxf(mrun, mx), alpha = __builtin_amdgcn_exp2f(mrun - mnew);
            float ls = 0.f;
#pragma unroll
            for (int i = 0; i < 16; ++i) { s0[i] = __builtin_amdgcn_exp2f(s0[i] - mnew); s1[i] = __builtin_amdgcn_exp2f(s1[i] - mnew); ls += s0[i] + s1[i]; }
            lrun = lrun * alpha + ls; mrun = mnew;
#pragma unroll
            for (int dt = 0; dt < NDT; ++dt)
#pragma unroll
                for (int i = 0; i < 16; ++i) o[dt][i] *= alpha;
            bf16x8 pf[4];
            { u32x4 w;
              w.x = pk2(s0[0], s0[1]); w.y = pk2(s0[2], s0[3]); w.z = pk2(s0[4], s0[5]); w.w = pk2(s0[6], s0[7]); pf[0] = __builtin_bit_cast(bf16x8, w);
              w.x = pk2(s0[8], s0[9]); w.y = pk2(s0[10], s0[11]); w.z = pk2(s0[12], s0[13]); w.w = pk2(s0[14], s0[15]); pf[1] = __builtin_bit_cast(bf16x8, w);
              w.x = pk2(s1[0], s1[1]); w.y = pk2(s1[2], s1[3]); w.z = pk2(s1[4], s1[5]); w.w = pk2(s1[6], s1[7]); pf[2] = __builtin_bit_cast(bf16x8, w);
              w.x = pk2(s1[8], s1[9]); w.y = pk2(s1[10], s1[11]); w.z = pk2(s1[12], s1[13]); w.w = pk2(s1[14], s1[15]); pf[3] = __builtin_bit_cast(bf16x8, w); }
#pragma unroll
            for (int kk = 0; kk < 4; ++kk) {
#pragma unroll
                for (int dt = 0; dt < NDT; ++dt) {
                    const LAS unsigned char* vp = Vt + (16 * kk) * VP + vlane_off + 64 * dt;
                    const s16x4 lo = __builtin_amdgcn_ds_read_tr16_b64_v4i16((LAS s16x4*)vp);
                    const s16x4 hi = __builtin_amdgcn_ds_read_tr16_b64_v4i16((LAS s16x4*)(vp + 8 * VP));
                    const bf16x8 vf = __builtin_shufflevector(lo, hi, 0, 1, 2, 3, 4, 5, 6, 7);
                    o[dt] = __builtin_amdgcn_mfma_f32_32x32x16_bf16(vf, pf[kk], o[dt], 0, 0, 0);
                }
            }
        }
        asm volatile("s_waitcnt vmcnt(0)" ::: "memory");
        __syncthreads();
    }
    const float ltot = lrun + __shfl_xor(lrun, 32), inv = 1.0f / ltot;
    unsigned char* op = u.o + (size_t)(u.qrow0 + wave * 32 + r) * u.ldo + 4 * h;
    const float inv4 = inv * 4.0f;
#pragma unroll
    for (int dt = 0; dt < NDT; ++dt)
#pragma unroll
        for (int g = 0; g < 4; ++g) *(unsigned*)(op + 32 * dt + 8 * g) = pk4_fp8(o[dt][4 * g] * inv4, o[dt][4 * g + 1] * inv4, o[dt][4 * g + 2] * inv4, o[dt][4 * g + 3] * inv4);
#undef AT_ROWBASE
#undef AT_ISSUE
}

DI void attn_phase(Frame& F, KArgs ka, int l) {
    KA_FRESH(ka); const __attribute__((address_space(4))) Args& a = *ka; frame_fresh(F);
    const bf16_t* HW = (const bf16_t*)(a.ws + WS_HW);
    const bf16_t* P1 = (const bf16_t*)(a.ws + WS_P1);
    const bf16_t* P2 = (const bf16_t*)(a.ws + WS_P2);
    const bf16_t* U = (const bf16_t*)(a.ws + WS_R4);
    unsigned char* OC = a.ws + WS_OCAT;
    const bool last = (l == NL - 1);
    constexpr int nA = 512, nB = 768, nC = 768;
    const int ntot = nA + nB + nC + (last ? 0 : 128);
#ifndef ATT_PROBE
#define ATT_PROBE 0
#endif
    for (int rep2_ = 0; rep2_ < 1 + (ATT_PROBE != 0); ++rep2_)
    for (int id = F.vcu; id < ntot; id += F.G) {
        if (rep2_ == 1 && !((ATT_PROBE == 1) ? (id < nA) : (id >= nA && id < nA + nB))) continue;
        AU u; bool big = false;
        u.mode = 0; u.qpos0 = 0; u.kpos0 = 0; u.m0 = -1e30f; u.l0 = 0.f; u.rpb = nullptr; u.n_ctx = 4;
        if (id < nA) {
            const int b = id >> 6, h = (id >> 4) & 3, qb = id & 15; big = true;
            u.q = P2 + h * 192; u.ldq = P2W; u.k = P2 + 768 + h * 192; u.ldk = P2W; u.v = U + 768 + h * 256 + 128; u.ldv = UW; u.o = OC + 512 + h * 128; u.ldo = OCW;
            u.qrow0 = b * SEQ + qb * 256; u.lat_row0 = b * SEQ; u.n_lat = 64; u.ctx_row0 = MLAT + b * CTX;
        } else if (id < nA + nB) {
            const int j = id - nA, b = j / 96, h = (j >> 4) % 6, qb = j & 15;
            u.q = P1 + h * 64; u.ldq = P1W; u.k = P1 + 384 + h * 64; u.ldk = P1W; u.v = HW + C_NAV + h * 64; u.ldv = DINP; u.o = OC + h * 64; u.ldo = OCW;
            int rlo = 4 * qb - 4; rlo = rlo < 0 ? 0 : (rlo > 56 ? 56 : rlo); int rhi = 4 * qb + 3 - 4; rhi = (rhi < 0 ? 0 : (rhi > 56 ? 56 : rhi)) + 7;
            u.qrow0 = b * SEQ + qb * 256; u.lat_row0 = b * SEQ + rlo * 64; u.n_lat = rhi - rlo + 1; u.ctx_row0 = MLAT + b * CTX;
            u.mode = 2; u.qpos0 = 4 * qb; u.kpos0 = rlo; u.rpb = a.in[I_RPB] + (size_t)(l * 6 + h) * 465;
        } else if (id < nA + nB + nC) {
            const int j = id - nA - nB, b = j / 96, hq = (j >> 4) % 6, qb = j & 15, kvh = hq / 3;
            u.q = P1 + 768 + hq * 64; u.ldq = P1W; u.k = P1 + 1152 + kvh * 64; u.ldk = P1W; u.v = HW + C_SWV + kvh * 64; u.ldv = DINP; u.o = OC + 1024 + hq * 64; u.ldo = OCW;
            int klo = qb * 256 - 128; klo = klo < 0 ? 0 : klo; int khi = qb * 256 + 384; khi = khi > SEQ ? SEQ : khi;
            u.qrow0 = b * SEQ + qb * 256; u.lat_row0 = b * SEQ + klo; u.n_lat = (khi - klo) >> 6; u.ctx_row0 = MLAT + b * CTX;
            u.mode = 1; u.qpos0 = qb * 256; u.kpos0 = klo; u.m0 = a.in[I_SINK][l * 6 + hq] * LOG2E; u.l0 = 1.f;
        } else {
            const int j = id - nA - nB - nC;
            u.n_lat = 0; u.lat_row0 = 0;
            if (j < 32) { const int b = j >> 2, h = j & 3; big = true;
                u.q = P2 + h * 192; u.ldq = P2W; u.k = P2 + 768 + h * 192; u.ldk = P2W; u.v = U + 768 + h * 256 + 128; u.ldv = UW; u.o = OC + 512 + h * 128; u.ldo = OCW;
                u.qrow0 = MLAT + b * CTX; u.ctx_row0 = MLAT + b * CTX;
            } else if (j < 80) { const int jj = j - 32, b = jj / 6, h = jj % 6;
                u.q = P1 + h * 64; u.ldq = P1W; u.k = P1 + 384 + h * 64; u.ldk = P1W; u.v = HW + C_NAV + h * 64; u.ldv = DINP; u.o = OC + h * 64; u.ldo = OCW;
                u.qrow0 = MLAT + b * CTX; u.ctx_row0 = MLAT + b * CTX;
            } else { const int jj = j - 80, b = jj / 6, hq = jj % 6, kvh = hq / 3;
                u.q = P1 + 768 + hq * 64; u.ldq = P1W; u.k = P1 + 1152 + kvh * 64; u.ldk = P1W; u.v = HW + C_SWV + kvh * 64; u.ldv = DINP; u.o = OC + 1024 + hq * 64; u.ldo = OCW;
                u.qrow0 = MLAT + b * CTX; u.ctx_row0 = MLAT + b * CTX; u.m0 = a.in[I_SINK][l * 6 + hq] * LOG2E; u.l0 = 1.f;
            }
        }
        if (big) attn_unit<192, 128, P2W, UW>(F.lds, u, F.tid, F.wave, F.lane);
        else attn_unit<64, 64, P1W, DINP>(F.lds, u, F.tid, F.wave, F.lane);
    }
}

DI void norm2_phase(Frame& F, KArgs ka, int l, int nrows) {
    KA_FRESH(ka); const __attribute__((address_space(4))) Args& a = *ka; frame_fresh(F);
    LAS float* rt = (LAS float*)F.lds;
    const float* rg = a.in[I_ROUTER] + (size_t)l * 1024 * 16;
    for (int i = F.tid; i < 16384; i += 512) rt[i] = rg[i];
    __syncthreads();
    LAS float* xr = (LAS float*)(F.lds + 65536 + F.wave * 8192);
    const bf16_t* xs = (const bf16_t*)(a.ws + WS_XS);
    const float* modv = (const float*)(a.ws + WS_MODV);
    unsigned char* H2 = a.ws + WS_H2;
    float* AFL = (float*)(a.ws + WS_AFL); float* AFC = (float*)(a.ws + WS_AFC);
    const int eq = F.lane & 3, kq = F.lane >> 2;
    u32x2 xw[2][4];
#define N2_LOAD(mb_) do { _Pragma("unroll") for (int rr_ = 0; rr_ < 2; ++rr_) { const u32x2* xp_ = (const u32x2*)(xs + (size_t)((mb_) + rr_) * D) + F.lane; \
        _Pragma("unroll") for (int j_ = 0; j_ < 4; ++j_) xw[rr_][j_] = xp_[64 * j_]; } } while (0)
    if (2 * F.gw < nrows) N2_LOAD(2 * F.gw);
    for (int mb = 2 * F.gw; mb < nrows; mb += 2 * F.ngw) {
        const int mi = mod_index(mb);
        f32x4 v[2][4];
#pragma unroll
        for (int rr = 0; rr < 2; ++rr)
#pragma unroll
            for (int j = 0; j < 4; ++j) { const u32x2 w = xw[rr][j]; v[rr][j] = (f32x4){bflo(w.x), bfhi(w.x), bflo(w.y), bfhi(w.y)}; }
        if (mb + 2 * F.ngw < nrows) N2_LOAD(mb + 2 * F.ngw);
        const f32x4* g = (const f32x4*)(a.in[I_N2G] + l * D) + F.lane;
        const f32x4* sh = (const f32x4*)(modv + ((size_t)l * 9 + mi) * 6144 + 3 * 1024) + F.lane;
        const f32x4* sc = (const f32x4*)(modv + ((size_t)l * 9 + mi) * 6144 + 4 * 1024) + F.lane;
        f32x4 gg[4], shv[4];
#pragma unroll
        for (int j = 0; j < 4; ++j) { gg[j] = g[64 * j] * (sc[64 * j] + 1.0f); shv[j] = sh[64 * j]; }
#pragma unroll
        for (int rr = 0; rr < 2; ++rr) {
            float ss = 0.f;
#pragma unroll
            for (int j = 0; j < 4; ++j) ss += (v[rr][j].x * v[rr][j].x + v[rr][j].y * v[rr][j].y) + (v[rr][j].z * v[rr][j].z + v[rr][j].w * v[rr][j].w);
            const float rstd = __builtin_amdgcn_rsqf(wave_sum(ss) * (1.f / D) + EPS);
            unsigned* o = (unsigned*)(H2 + (size_t)(mb + rr) * D) + F.lane;
#pragma unroll
            for (int j = 0; j < 4; ++j) { const f32x4 hh = v[rr][j] * rstd * gg[j] + shv[j]; o[64 * j] = pk4_fp8(hh.x, hh.y, hh.z, hh.w);
                *(LAS f32x4*)(xr + rr * 1024 + 4 * F.lane + 256 * j) = hh; }
        }
        asm volatile("s_waitcnt lgkmcnt(0)" ::: "memory");
        f32x4 acc[2] = {{0.f, 0.f, 0.f, 0.f}, {0.f, 0.f, 0.f, 0.f}};
#pragma unroll 8
        for (int i = 0; i < 64; ++i) { const int k = kq + 16 * i; const float x0 = xr[k], x1 = xr[1024 + k]; const f32x4 w = *(const LAS f32x4*)(rt + k * 16 + 4 * eq); acc[0] += w * x0; acc[1] += w * x1; }
        asm volatile("s_waitcnt lgkmcnt(0)" ::: "memory");
#pragma unroll
        for (int rr = 0; rr < 2; ++rr) { const int m = mb + rr; f32x4 ac = acc[rr];
#pragma unroll
            for (int ofs = 4; ofs < 64; ofs <<= 1) { ac.x += __shfl_xor(ac.x, ofs); ac.y += __shfl_xor(ac.y, ofs); ac.z += __shfl_xor(ac.z, ofs); ac.w += __shfl_xor(ac.w, ofs); }
            float mx = fmaxf(fmaxf(ac.x, ac.y), fmaxf(ac.z, ac.w)); mx = fmaxf(mx, __shfl_xor(mx, 1)); mx = fmaxf(mx, __shfl_xor(mx, 2));
            f32x4 ex; ex.x = __expf(ac.x - mx); ex.y = __expf(ac.y - mx); ex.z = __expf(ac.z - mx); ex.w = __expf(ac.w - mx);
            float sum = (ex.x + ex.y) + (ex.z + ex.w); sum += __shfl_xor(sum, 1); sum += __shfl_xor(sum, 2);
            const float inv = 1.0f / sum;
            if (F.lane < 4) {
                if (m < MLAT) { const int b = m >> 12, s = m & 4095; float* p = AFL + ((size_t)(b * 16 + 4 * F.lane)) * 4096 + s; p[0] = ex.x * inv; p[4096] = ex.y * inv; p[2 * 4096] = ex.z * inv; p[3 * 4096] = ex.w * inv; }
                else { const int b = (m - MLAT) >> 8, s = (m - MLAT) & 255; float* p = AFC + ((size_t)(b * 16 + 4 * F.lane)) * 256 + s; p[0] = ex.x * inv; p[256] = ex.y * inv; p[512] = ex.z * inv; p[768] = ex.w * inv; }
            }
        }
    }
}

DI unsigned block_excl_scan(unsigned v, unsigned& total, LAS unsigned* wsum, int tid, int lane, int wave) {
    unsigned x = v;
#pragma unroll
    for (int o = 1; o < 64; o <<= 1) { const unsigned y = __shfl_up(x, o); if (lane >= o) x += y; }
    if (lane == 63) wsum[wave] = x;
    __syncthreads();
    unsigned base = 0, tot = 0;
#pragma unroll
    for (int w = 0; w < 8; ++w) { const unsigned s = wsum[w]; if (w < wave) base += s; tot += s; }
    __syncthreads();
    total = tot;
    return base + x - v;
}
DI void select_phase(Frame& F, KArgs ka, int l) {
    KA_FRESH(ka); const __attribute__((address_space(4))) Args& a = *ka; frame_fresh(F);
    const bool last = (l == NL - 1);
    const int nunits = last ? 128 : 256;
    LAS unsigned* hist = (LAS unsigned*)F.lds;
    LAS unsigned* wsum = (LAS unsigned*)(F.lds + 8192);
    LAS unsigned* bc = (LAS unsigned*)(F.lds + 8192 + 64);
    LAS int* sel = (LAS int*)(F.lds + 16384);
    const float* AFL = (const float*)(a.ws + WS_AFL); const float* AFC = (const float*)(a.ws + WS_AFC);
    int* smap = (int*)(a.ws + WS_SMAP); float* gate = (float*)(a.ws + WS_GATE);
    const unsigned char* H2 = a.ws + WS_H2; unsigned char* XG = a.ws + WS_XG;
    for (int unit = blockIdx.x; unit < nunits; unit += F.G) {
        const bool lat = unit < 128; const int be = unit & 127, b = be >> 4, e = be & 15;
        const int N = lat ? 4096 : 256, cap = lat ? CAP_LAT : CAP_CTX;
        const float* aff = lat ? AFL + (size_t)be * 4096 : AFC + (size_t)be * 256;
        unsigned key[8]; const int per = lat ? 8 : 1; const bool act = lat || F.tid < 256;
#pragma unroll
        for (int j = 0; j < 8; ++j) key[j] = (act && j < per) ? __float_as_uint(aff[F.tid * per + j]) : 0u;
        unsigned prefix = 0u, pmask = 0u, need = (unsigned)cap;
#pragma unroll
        for (int pass = 0; pass < 3; ++pass) {
            const int shift = pass == 0 ? 21 : (pass == 1 ? 10 : 0), nb = pass == 2 ? 1024 : 2048;
            for (int i = F.tid; i < 2048; i += 512) hist[i] = 0u;
            __syncthreads();
#pragma unroll
            for (int j = 0; j < 8; ++j) if (act && j < per && (key[j] & pmask) == prefix) (void)__hip_atomic_fetch_add(&hist[(key[j] >> shift) & (nb - 1)], 1u, __ATOMIC_RELAXED, __HIP_MEMORY_SCOPE_WORKGROUP);
            __syncthreads();
            unsigned c4[4], mine = 0;
#pragma unroll
            for (int j = 0; j < 4; ++j) { const int bin = 2047 - 4 * F.tid - j; c4[j] = bin < nb ? hist[bin] : 0u; mine += c4[j]; }
            unsigned tot; unsigned run = block_excl_scan(mine, tot, wsum, F.tid, F.lane, F.wave);
#pragma unroll
            for (int j = 0; j < 4; ++j) { const int bin = 2047 - 4 * F.tid - j;
                if (bin < nb && run < need && run + c4[j] >= need) { bc[0] = (unsigned)bin; bc[1] = run; }
                run += c4[j]; }
            __syncthreads();
            const unsigned cb = bc[0], above = bc[1];
            prefix |= cb << shift; pmask |= (unsigned)(nb - 1) << shift; need -= above;
            __syncthreads();
        }
        unsigned neq = 0, ngt = 0;
#pragma unroll
        for (int j = 0; j < 8; ++j) if (act && j < per) { neq += key[j] == prefix; ngt += key[j] > prefix; }
        unsigned teq; const unsigned eqbase = block_excl_scan(neq, teq, wsum, F.tid, F.lane, F.wave);
        unsigned nsel = 0, flags = 0, erun = eqbase;
#pragma unroll
        for (int j = 0; j < 8; ++j) if (act && j < per) { bool s = key[j] > prefix; if (key[j] == prefix) { s = erun < need; ++erun; } if (s) { flags |= 1u << j; ++nsel; } }
        unsigned tsel; unsigned sbase = block_excl_scan(nsel, tsel, wsum, F.tid, F.lane, F.wave);
        const int rowbase = lat ? b * SEQ : MLAT + b * CTX;
        const int slotbase = lat ? be * CAP_LAT : NSLOT_LAT + (e * 8 + b) * CAP_CTX;
#pragma unroll
        for (int j = 0; j < 8; ++j) if (act && j < per) { const int tok = F.tid * per + j; int slot = -1;
            if ((flags >> j) & 1u) { slot = slotbase + (int)sbase; sel[sbase] = tok; gate[slot] = __uint_as_float(key[j]); ++sbase; }
            smap[(size_t)e * MT + rowbase + tok] = slot; }
        __syncthreads();
        if (lat) {
            for (int t0 = F.wave * 16; t0 < cap; t0 += 128) {
                u32x4 rowv[16];
#pragma unroll
                for (int q = 0; q < 16; ++q) rowv[q] = ((const u32x4*)(H2 + (size_t)(rowbase + sel[t0 + q]) * D))[F.lane];
#pragma unroll
                for (int q = 0; q < 16; ++q) ((u32x4*)(XG + (size_t)(slotbase + t0 + q) * D))[F.lane] = rowv[q];
            }
        } else {
            const int t0 = F.wave * 4;
            u32x4 rowv[4];
#pragma unroll
            for (int q = 0; q < 4; ++q) rowv[q] = ((const u32x4*)(H2 + (size_t)(rowbase + sel[t0 + q]) * D))[F.lane];
#pragma unroll
            for (int q = 0; q < 4; ++q) ((u32x4*)(XG + (size_t)(slotbase + t0 + q) * D))[F.lane] = rowv[q];
        }
        __syncthreads();
    }
}

DI unsigned char* ws_fresh(KArgs ka) { KA_FRESH(ka); return ka->ws; }
__global__ void __launch_bounds__(512, 2) mega_fwd(Args a_unused) {
    extern __shared__ __attribute__((aligned(16))) unsigned char lds_raw[];
    KArgs ka = (KArgs)__builtin_amdgcn_kernarg_segment_ptr();
    Frame F;
    F.lds = (LAS unsigned char*)lds_raw;
    F.tid = threadIdx.x; F.lane = F.tid & 63; F.wave = __builtin_amdgcn_readfirstlane(F.tid >> 6);
    F.G = gridDim.x; { const int bx = blockIdx.x; F.vcu = (F.G % 8 == 0) ? (bx % 8) * (F.G / 8) + bx / 8 : bx; }
    F.gw = F.vcu * 8 + F.wave; F.ngw = F.G * 8;
    for (int u = F.tid; u < (LDS_BYTES - LDSCTL_OFF) / 4; u += 512) ((LAS unsigned*)(F.lds + LDSCTL_OFF))[u] = 0u;
    __syncthreads();
    XcdBarrier bar = xcd_barrier_post((unsigned*)(ws_fresh(ka) + WS_CTL) + CW_BAR, (volatile LAS unsigned*)(F.lds + LDSCTL_OFF + 32));
#define GRID_BAR() xcd_barrier(bar)
    const int bx = blockIdx.x;

    if (PH(0)) modv_phase(F, ka);
    for (int rep_ = 0; rep_ < REPS(2); ++rep_) if (PH(2)) convert_weights(F, ka, 0);
    GRID_BAR();
    if (PH(3)) row_phase(F, ka, 0);
    GRID_BAR();

    for (int l = 0; l < NL; ++l) {
        const bool last = (l == NL - 1);
        const int nMe = last ? MLAT / 256 : MT / 256;
        const int nMs = last ? NSLOT_LAT / 256 : NSLOT / 256;
        for (int rep_ = 0; rep_ < REPS(4); ++rep_) if (PH(4)) { unsigned char* ws = ws_fresh(ka);
            { pg8::Gemm g{(const bf16_t*)(ws + WS_R4), (const bf16_t*)(ws + WS_W + W_IN), 1024, 1024, 1024, 0}; pg8::Order S; S.init(MT / 256, DINP / 256, F.G, bx);
              pg8::EpiStoreBf16 E{(bf16_t*)(ws + WS_HW), DINP}; pg8::gemm_phase(F.lds, g, S, E); }
            { pg8::Gemm g{(const bf16_t*)(ws + WS_R4 + 68 * MiB), (const bf16_t*)(ws + WS_W + W_GL), 1024, 1024, 1024, 0}; pg8::Order S; S.init(MT / 256, NGL / 256, F.G, (bx + F.G / 2) % F.G);
              pg8::EpiGate E{ws + WS_G}; pg8::gemm_phase<pg8::EpiGate, true>(F.lds, g, S, E); } }
        GRID_BAR();
        for (int rep_ = 0; rep_ < REPS(5); ++rep_) if (PH(5)) { unsigned char* ws = ws_fresh(ka); pg8::Gemm g{(const bf16_t*)(ws + WS_HW) + C_CQ, (const bf16_t*)(ws + WS_W + W_UP), 384, DINP, 384, 0}; pg8::Order S; S.init(MT / 256, UW / 256, F.G, bx);
            pg8::EpiStoreBf16 E{(bf16_t*)(ws + WS_R4), UW}; pg8::gemm_phase(F.lds, g, S, E); }
        for (int rep_ = 0; rep_ < REPS(6); ++rep_) if (PH(6)) prep_phase(F, ka, l);
        GRID_BAR();
        for (int rep_ = 0; rep_ < REPS(7); ++rep_) if (PH(7)) prep2_phase(F, ka, l, rep_);
        GRID_BAR();
        for (int rep_ = 0; rep_ < REPS(8); ++rep_) if (PH(8)) attn_phase(F, ka, l);
        GRID_BAR();
        for (int rep_ = 0; rep_ < REPS(9); ++rep_) if (PH(9)) { unsigned char* ws = ws_fresh(ka); pg8::Order S; S.init(nMe, 4, F.G, bx);
          const unsigned char* OC = ws + WS_OCAT; bf16_t* MG = (bf16_t*)(ws + WS_MERGED); const unsigned char* GL = ws + WS_G;
          { pg8::Gemm3 g{OC, OC + 512, OC + 1024, ws + WS_W + W_NAO, ws + WS_W + W_MLAO, ws + WS_W + W_SWAO, OCW, 512}; pg8::EpiMerge3 E{MG, GL}; pg8::gemm_phase3(F.lds, g, S, E); } }
        GRID_BAR();
        if (PH(10)) { unsigned char* ws = ws_fresh(ka); pg8::Gemm g{(const bf16_t*)(ws + WS_MERGED), (const bf16_t*)(ws + WS_W + W_O), 1024, 1024, 1024, 0}; pg8::Order S; S.init(nMe, 4, F.G, bx);
            pg8::EpiResid E{(bf16_t*)(ws + WS_XS), (const float*)(ws + WS_MODV) + (size_t)l * 9 * 6144 + 2 * 1024}; pg8::gemm_phase<pg8::EpiResid, true>(F.lds, g, S, E); }
        GRID_BAR();
        for (int rep_ = 0; rep_ < REPS(11); ++rep_) if (PH(11)) norm2_phase(F, ka, l, last ? MLAT : MT);
        GRID_BAR();
        for (int rep_ = 0; rep_ < REPS(12); ++rep_) if (PH(12)) select_phase(F, ka, l);
        GRID_BAR();
        for (int rep_ = 0; rep_ < REPS(13); ++rep_) if (PH(13)) { unsigned char* ws = ws_fresh(ka); pg8::Gemm g{(const bf16_t*)(ws + WS_XG), (const bf16_t*)(ws + WS_W + W_GU), 1024, 1024, 1024, (size_t)2048 * 1024}; pg8::Order S; S.init(nMs, 8, F.G, bx, 1);
            pg8::EpiSwiglu E{ws + WS_ACT}; pg8::gemm_phase<pg8::EpiSwiglu, true>(F.lds, g, S, E); }
        GRID_BAR();
        for (int rep_ = 0; rep_ < REPS(14); ++rep_) if (PH(14)) { unsigned char* ws = ws_fresh(ka); pg8::Gemm g{(const bf16_t*)(ws + WS_ACT), (const bf16_t*)(ws + WS_W + W_DN), 1024, 1024, 1024, (size_t)1024 * 1024}; pg8::Order S; S.init(nMs, 4, F.G, bx, 1);
            pg8::EpiDown E{(bf16_t*)(ws + WS_Y), (const float*)(ws + WS_GATE)}; pg8::gemm_phase<pg8::EpiDown, true>(F.lds, g, S, E); }
        GRID_BAR();
        for (int rep_ = 0; rep_ < REPS(15); ++rep_) if (PH(15)) row_phase(F, ka, l + 1, rep_);
        if (!last) { for (int rep_ = 0; rep_ < REPS(16); ++rep_) if (PH(16)) convert_weights(F, ka, l + 1); GRID_BAR(); }
    }
}

extern "C" void kernel_launch(void* const* d_in, const int* in_sizes, int n_in, void* d_out, int out_size, void* d_ws, size_t ws_size, hipStream_t stream) {
    static int grid = 0;
    if (grid == 0) {
        if (n_in != 29 || in_sizes[0] != MLAT * D || out_size != MLAT * D || ws_size < WS_END) {
            fprintf(stderr, "kernel_launch: unexpected problem: n_in %d in0 %d out %d ws %zu (need %zu)\n", n_in, n_in > 0 ? in_sizes[0] : -1, out_size, ws_size, (size_t)WS_END); grid = -1; return; }
        int dev = 0, cus = 0, per_cu = 0;
        if (hipGetDevice(&dev) != hipSuccess || hipDeviceGetAttribute(&cus, hipDeviceAttributeMultiprocessorCount, dev) != hipSuccess) { fprintf(stderr, "kernel_launch: device query failed\n"); grid = -1; return; }
        if (hipFuncSetAttribute((const void*)mega_fwd, hipFuncAttributeMaxDynamicSharedMemorySize, LDS_BYTES) != hipSuccess) { fprintf(stderr, "kernel_launch: hipFuncSetAttribute failed\n"); grid = -1; return; }
        if (hipOccupancyMaxActiveBlocksPerMultiprocessor(&per_cu, (const void*)mega_fwd, 512, LDS_BYTES) != hipSuccess || per_cu < 1) {
            fprintf(stderr, "kernel_launch: occupancy query reports %d workgroups per CU\n", per_cu); }
        (void)hipGetLastError();
        grid = cus;
    }
    if (grid < 0) return;
    if (hipMemsetAsync((char*)d_ws + WS_CTL, 0, CTL_BYTES, stream) != hipSuccess) { fprintf(stderr, "kernel_launch: memset failed\n"); return; }
    Args a{};
    for (int i = 0; i < 29; ++i) a.in[i] = (const float*)d_in[i];
    a.out = (float*)d_out; a.ws = (unsigned char*)d_ws;
    hipLaunchKernelGGL(mega_fwd, dim3(grid), dim3(512), LDS_BYTES, stream, a);
    const hipError_t le = hipPeekAtLastError();
    if (le != hipSuccess) fprintf(stderr, "kernel_launch: launch failed: %s\n", hipGetErrorName(le));
}
```

```cpp
#include <hip/hip_runtime.h>
#include <cstdio>
#include <cstdint>

#define DI __device__ __forceinline__
#ifndef PH_MASK
#define PH_MASK 0xFFFFF
#endif
#define PH(b) ((PH_MASK >> (b)) & 1)
#ifndef REP_MASK
#define REP_MASK 0
#endif
#define REPS(b) (1 + ((REP_MASK >> (b)) & 1))
#define LAS __attribute__((address_space(3)))
#define GAS __attribute__((address_space(1)))
typedef unsigned short bf16_t;
typedef short bf16x8 __attribute__((ext_vector_type(8)));
typedef short s16x4 __attribute__((ext_vector_type(4)));
typedef float f32x4 __attribute__((ext_vector_type(4)));
typedef float f32x2 __attribute__((ext_vector_type(2)));
typedef float f32x16 __attribute__((ext_vector_type(16)));
typedef unsigned u32x4 __attribute__((ext_vector_type(4)));
typedef unsigned u32x2 __attribute__((ext_vector_type(2)));
typedef int i32x8 __attribute__((ext_vector_type(8)));

constexpr int D = 1024, NB = 8, SEQ = 4096, NL = 4, CTX = 256;
constexpr int MLAT = NB * SEQ, MCTX = NB * CTX, MT = MLAT + MCTX;
constexpr int DIN = 5312, DINP = 2304, NGL = 3072;
constexpr int C_NAQ = 0, C_NAK = 384, C_NAV = 768, C_CQ = 1152, C_CKV = 1408, C_KR = 1536, C_SWQ = 1600, C_SWK = 1984, C_SWV = 2112, C_GL = 2240;
constexpr int UW = 1792;
constexpr int P1W = 1280;
constexpr int P2W = 1536;
constexpr int OCW = 1536;
constexpr int NE = 16, CAP_LAT = 512, CAP_CTX = 32;
constexpr int NSLOT_LAT = NB * NE * CAP_LAT, NSLOT = NSLOT_LAT + NB * NE * CAP_CTX;
constexpr float EPS = 1e-6f;
constexpr float LOG2E = 1.4426950408889634f;

constexpr size_t MiB = 1u << 20;
constexpr size_t WS_CTL = 0, CTL_BYTES = 1 * MiB;
constexpr size_t WS_MODV = 1 * MiB;
constexpr size_t WS_W = 2 * MiB;
constexpr size_t W_IN = 0, W_GL = 4718592  , W_UP = 11010048, W_NAO = 7864320  , W_MLAO = 13172736, W_SWAO = 8912896  , W_O = 15007744, W_GU = 17104896, W_DN = 84213760, W_END = 117768192;
constexpr size_t WS_XS = 115 * MiB, WS_W2 = 183 * MiB  ;
constexpr size_t WS_HW = 251 * MiB;
constexpr size_t WS_G = WS_HW + 153 * MiB;
constexpr size_t WS_P1 = 608 * MiB;
constexpr size_t WS_P2 = 693 * MiB;
constexpr size_t WS_R4 = 795 * MiB;
constexpr size_t WS_AFL = 914 * MiB;
constexpr size_t WS_AFC = 916 * MiB;
constexpr size_t WS_SMAP = 917 * MiB;
constexpr size_t WS_GATE = 920 * MiB;
constexpr size_t WS_OCAT = 921 * MiB;
constexpr size_t WS_END = 1006 * MiB;
constexpr size_t WS_MERGED = WS_P1;
constexpr size_t WS_H2 = WS_HW;
constexpr size_t WS_XG = WS_HW + 68 * MiB;
constexpr size_t WS_ACT = WS_HW + 204 * MiB;
constexpr size_t WS_Y = WS_HW + 340 * MiB;
static_assert(W_END <= 113 * MiB && WS_W + 113 * MiB <= WS_XS, "weights");
static_assert(W_GU + 64 * MiB <= W_DN && W_DN + 32 * MiB <= 113 * MiB && WS_XS + (size_t)MT * D * 2 <= WS_W2 && WS_W2 + W_GU <= WS_HW, "second weight buffers");
static_assert(WS_XS + (size_t)MT * D * 4 <= WS_HW && WS_HW + (size_t)MT * DINP * 2 <= WS_G && WS_G + (size_t)MT * NGL * 2 <= WS_P1 && WS_P1 + (size_t)MT * P1W * 2 <= WS_P2 && WS_P2 + (size_t)MT * P2W * 2 <= WS_R4, "map");
static_assert(WS_R4 + (size_t)MT * UW * 2 <= WS_AFL && WS_Y + (size_t)NSLOT * D * 2 <= WS_R4 && WS_SMAP + (size_t)16 * MT * 4 <= WS_GATE && WS_GATE + (size_t)NSLOT * 4 <= WS_OCAT && WS_OCAT + (size_t)MT * OCW <= WS_END, "map2");
constexpr int CW_BAR = 4096;

constexpr int RING_BYTES = 131072, LDSCTL_OFF = RING_BYTES, LDS_BYTES = 147456;

DI unsigned pk2(float lo, float hi) { unsigned r; asm("v_cvt_pk_bf16_f32 %0, %1, %2" : "=v"(r) : "v"(lo), "v"(hi)); return r; }
DI unsigned pk4_fp8(float a, float b, float c, float d) { int w = 0; w = __builtin_amdgcn_cvt_pk_fp8_f32(a, b, w, false); w = __builtin_amdgcn_cvt_pk_fp8_f32(c, d, w, true); return (unsigned)w; }
DI float bflo(unsigned w) { return __uint_as_float(w << 16); }
DI float bfhi(unsigned w) { return __uint_as_float(w & 0xffff0000u); }
DI float bf2f(bf16_t b) { return __uint_as_float((unsigned)b << 16); }
DI float wave_sum(float v) {
#pragma unroll
    for (int o = 1; o < 64; o <<= 1) v += __shfl_xor(v, o);
    return v;
}
DI float sigmoidf_(float x) { return __builtin_amdgcn_rcpf(1.0f + __builtin_amdgcn_exp2f(-x * LOG2E)); }
DI int mod_index(int row) { return row < MLAT ? (row >> 12) : 8; }

#define XB_TMO      128
#define XB_XCNT(j)  (256  + 64 * (j))
#define XB_XSUB(j)  (1280 + 64 * (j))
#define XB_XGEN(j)  (2304 + 64 * (j))
#define XB_TOP      3328
#define XB_TOPGEN   3392
#define XCD_BAR_WORDS 3456
#define XB_SPIN_CAP (1u << 18)
DI unsigned xb_ld(unsigned* p)              { return __hip_atomic_load(p, __ATOMIC_RELAXED, __HIP_MEMORY_SCOPE_AGENT); }
DI unsigned xb_add(unsigned* p, unsigned v) { return __hip_atomic_fetch_add(p, v, __ATOMIC_RELAXED, __HIP_MEMORY_SCOPE_AGENT); }
DI unsigned xb_xcc_id() { return (unsigned)__builtin_amdgcn_s_getreg((3 << 11) | 20) & 0xFu; }
#define XB_SPIN(cond, bar) do { unsigned _sp = 0; while (cond) { __builtin_amdgcn_s_sleep(1); \
    if ((++_sp & 255u) == 0u) { if (xb_ld(&(bar)[XB_TMO])) break; if (_sp > XB_SPIN_CAP) { atomicAdd(&(bar)[XB_TMO], 1u); break; } } } } while (0)
struct XcdBarrier { unsigned* bar; unsigned x; volatile LAS unsigned* st; };
DI XcdBarrier xcd_barrier_post(unsigned* bar, volatile LAS unsigned* st) {
    XcdBarrier b; b.bar = bar; b.x = xb_xcc_id(); b.st = st;
    if (threadIdx.x == 0) (void)xb_add(&bar[XB_XCNT(b.x)], 1u);
    return b;
}
DI void xcd_barrier_complete(unsigned* bar, unsigned x, unsigned& nloc, unsigned& nx) {
    const unsigned G = gridDim.x * gridDim.y * gridDim.z;
    unsigned sum, cnt, mine, sp = 0u;
    for (;;) {
        sum = 0u; cnt = 0u; mine = 0u;
#pragma unroll
        for (unsigned j = 0; j < 16; ++j) { const unsigned c = xb_ld(&bar[XB_XCNT(j)]); sum += c; cnt += (c > 0u) ? 1u : 0u; mine = (j == x) ? c : mine; }
        if (sum == G) break;
        __builtin_amdgcn_s_sleep(1);
        if ((++sp & 255u) == 0u) { if (xb_ld(&bar[XB_TMO])) break; if (sp > XB_SPIN_CAP) { atomicAdd(&bar[XB_TMO], 1u); break; } }
    }
    nloc = mine > 0u ? mine : 1u; nx = cnt > 0u ? cnt : 1u;
}
DI void xcd_barrier(const XcdBarrier& b) {
    asm volatile("s_waitcnt vmcnt(0)" ::: "memory");
    __syncthreads();
    if (threadIdx.x == 0) {
        unsigned* bar = b.bar; unsigned bx_ = b.x; asm volatile("" : "+s"(bar), "+s"(bx_));
        __builtin_amdgcn_s_waitcnt(0);
        unsigned nloc = b.st[0], nx = b.st[1];
        if (nloc == 0u) { xcd_barrier_complete(bar, bx_, nloc, nx); b.st[0] = nloc; b.st[1] = nx; }
        const unsigned old = xb_add(&bar[XB_XSUB(bx_)], 1u);
        const unsigned gen = old / nloc;
        if (old + 1u == (gen + 1u) * nloc) {
            __builtin_amdgcn_fence(__ATOMIC_RELEASE, "agent");
            asm volatile("s_waitcnt vmcnt(0)" ::: "memory");
            const unsigned og = xb_add(&bar[XB_TOP], 1u);
            const unsigned tg = og / nx;
            if (og + 1u == (tg + 1u) * nx) xb_add(&bar[XB_TOPGEN], 1u);
            else XB_SPIN(xb_ld(&bar[XB_TOPGEN]) == tg, bar);
            __builtin_amdgcn_fence(__ATOMIC_ACQUIRE, "agent");
            xb_add(&bar[XB_XGEN(bx_)], 1u);
            asm volatile("s_waitcnt vmcnt(0)" ::: "memory");
        } else {
            XB_SPIN(xb_ld(&bar[XB_XGEN(bx_)]) == gen, bar);
            __builtin_amdgcn_fence(__ATOMIC_ACQUIRE, "agent");
            asm volatile("s_waitcnt vmcnt(0)" ::: "memory");
        }
    }
    __syncthreads();
}

namespace pg8 {
constexpr int BM = 256, BK = 64, HALF = 128, HTB = HALF * BK * 2, NXCD = 8, WGM = 8;
__host__ __device__ __forceinline__ int lds_byte(int r, int c) { const int st = (r >> 4) * 2 + (c >> 5), rr = r & 15, cc = c & 31, ob = rr * 64 + cc * 2; return st * 1024 + (ob ^ (((ob >> 9) & 1) << 5)); }
__host__ __device__ __forceinline__ void stage_rc(int b, int& R, int& C) { const int st = b / 1024, sb = b % 1024, swz = sb ^ (((sb >> 9) & 1) << 5); R = (st >> 1) * 16 + swz / 64; C = (st & 1) * 32 + (swz % 64) / 2; }
__host__ __device__ __forceinline__ int perm32(int rho) { const int n = rho >> 4, i = rho & 15; return 8 * (i >> 2) + 4 * n + (i & 3); }
struct Unit { int pm, pn; };
struct Gemm { const bf16_t* A; const bf16_t* Bt; int K, lda, ldb; size_t estride; };
struct Order {
    int nM, nN, nwg, G, c, moe;
    DI void init(int nM_, int nN_, int G_, int c_, int moe_ = 0) { nM = nM_; nN = nN_; nwg = nM * nN; G = G_; c = c_; moe = moe_; }
    DI bool next(int i, Unit& u) const {
        const long L = (long)i * G + c; if (L >= nwg) return false;
        int wgid = (int)L; { const int q = nwg / NXCD, r = nwg % NXCD, xcd = wgid % NXCD, off = wgid / NXCD; wgid = (xcd < r ? xcd * (q + 1) : r * (q + 1) + (xcd - r) * q) + off; }
        const int nig = WGM * nN, gid = wgid / nig, fm = gid * WGM, gsz = (nM - fm) < WGM ? (nM - fm) : WGM;
        u.pm = fm + ((wgid % nig) % gsz); u.pn = (wgid % nig) / gsz;
        if (moe && u.pm < 256) { const int e = u.pm >> 4, b = (u.pm >> 1) & 7, hf = u.pm & 1; u.pm = (((b << 4) | e) << 1) | hf; }
        return true;
    }
};
struct EpiStoreBf16 {
    static constexpr bool PERM = true;
    bf16_t* O; int ldc;
    DI void operator()(const f32x4 (&acc)[2][2][4][2], const Unit& u, int wr, int wc, int fr, int fq) const {
        const int row0 = u.pm * BM + wr * 64 + fr, col0 = u.pn * BM + wc * 32 + 8 * fq;
#pragma unroll
        for (int ai = 0; ai < 2; ++ai)
#pragma unroll
            for (int m = 0; m < 4; ++m) { bf16_t* rowp = O + (size_t)(row0 + ai * HALF + m * 16) * ldc + col0;
#pragma unroll
                for (int bj = 0; bj < 2; ++bj) { const f32x4 v0 = acc[ai][bj][m][0], v1 = acc[ai][bj][m][1];
                    u32x4 w; w.x = pk2(v0[0], v0[1]); w.y = pk2(v0[2], v0[3]); w.z = pk2(v1[0], v1[1]); w.w = pk2(v1[2], v1[3]);
                    *(u32x4*)(rowp + bj * HALF) = w; } }
    }
};
DI unsigned pk4_u8(float a, float b, float c, float d) {
    unsigned ua = (unsigned)(a * 255.0f + 0.5f), ub = (unsigned)(b * 255.0f + 0.5f), uc = (unsigned)(c * 255.0f + 0.5f), ud = (unsigned)(d * 255.0f + 0.5f);
    ua = ua < 1u ? 1u : ua; ub = ub < 1u ? 1u : ub; uc = uc < 1u ? 1u : uc; ud = ud < 1u ? 1u : ud;
    return ua | (ub << 8) | (uc << 16) | (ud << 24);
}
struct EpiGate {
    static constexpr bool PERM = true;
    unsigned char* O;
    DI void operator()(const f32x4 (&acc)[2][2][4][2], const Unit& u, int wr, int wc, int fr, int fq) const {
        const int row0 = u.pm * BM + wr * 64 + fr, col0 = u.pn * BM + wc * 32 + 8 * fq;
#pragma unroll
        for (int ai = 0; ai < 2; ++ai)
#pragma unroll
            for (int m = 0; m < 4; ++m) { unsigned char* rowp = O + (size_t)(row0 + ai * HALF + m * 16) * NGL + col0;
#pragma unroll
                for (int bj = 0; bj < 2; ++bj) { const f32x4 v0 = acc[ai][bj][m][0] * 0.03125f, v1 = acc[ai][bj][m][1] * 0.03125f;
                    u32x2 w; w.x = pk4_u8(sigmoidf_(v0[0]), sigmoidf_(v0[1]), sigmoidf_(v0[2]), sigmoidf_(v0[3])); w.y = pk4_u8(sigmoidf_(v1[0]), sigmoidf_(v1[1]), sigmoidf_(v1[2]), sigmoidf_(v1[3]));
                    *(u32x2*)(rowp + bj * HALF) = w; } }
    }
};
DI float u8f(unsigned w, int k) { return (float)((w >> (8 * k)) & 0xffu) * (1.0f / 255.0f); }
struct EpiMerge {
    static constexpr bool PERM = true;
    bf16_t* O; const unsigned char* gl; int first;
    DI void operator()(const f32x4 (&acc)[2][2][4][2], const Unit& u, int wr, int wc, int fr, int fq) const {
        const int row0 = u.pm * BM + wr * 64 + fr, col0 = u.pn * BM + wc * 32 + 8 * fq;
#pragma unroll
        for (int ai = 0; ai < 2; ++ai) {
            u32x2 g[4][2]; u32x4 p[4][2];
#pragma unroll
            for (int m = 0; m < 4; ++m)
#pragma unroll
                for (int bj = 0; bj < 2; ++bj) { const int row = row0 + ai * HALF + m * 16, col = col0 + bj * HALF;
                    g[m][bj] = *(const u32x2*)(gl + (size_t)row * NGL + col);
                    p[m][bj] = first ? (u32x4){0u, 0u, 0u, 0u} : *(const u32x4*)(O + (size_t)row * D + col); }
#pragma unroll
            for (int m = 0; m < 4; ++m)
#pragma unroll
                for (int bj = 0; bj < 2; ++bj) { const int row = row0 + ai * HALF + m * 16, col = col0 + bj * HALF;
                    const u32x2 gg = g[m][bj]; const u32x4 pp = p[m][bj]; const f32x4 v0 = acc[ai][bj][m][0], v1 = acc[ai][bj][m][1];
                    const float r0 = v0[0] * u8f(gg.x, 0) + bflo(pp.x), r1 = v0[1] * u8f(gg.x, 1) + bfhi(pp.x), r2 = v0[2] * u8f(gg.x, 2) + bflo(pp.y), r3 = v0[3] * u8f(gg.x, 3) + bfhi(pp.y);
                    const float r4 = v1[0] * u8f(gg.y, 0) + bflo(pp.z), r5 = v1[1] * u8f(gg.y, 1) + bfhi(pp.z), r6 = v1[2] * u8f(gg.y, 2) + bflo(pp.w), r7 = v1[3] * u8f(gg.y, 3) + bfhi(pp.w);
                    u32x4 w; w.x = pk2(r0, r1); w.y = pk2(r2, r3); w.z = pk2(r4, r5); w.w = pk2(r6, r7);
                    *(u32x4*)(O + (size_t)row * D + col) = w; }
        }
    }
};
struct EpiResid {
    static constexpr bool PERM = true;
    bf16_t* xs; const float* modg;
    DI void operator()(const f32x4 (&acc)[2][2][4][2], const Unit& u, int wr, int wc, int fr, int fq) const {
        const int row0 = u.pm * BM + wr * 64 + fr, col0 = u.pn * BM + wc * 32 + 8 * fq;
        const float* mp = modg + (size_t)mod_index(u.pm * BM) * 6144 + col0;
        f32x4 g0[2], g1[2];
#pragma unroll
        for (int bj = 0; bj < 2; ++bj) { g0[bj] = *(const f32x4*)(mp + bj * HALF) * (1.0f / 128.0f); g1[bj] = *(const f32x4*)(mp + bj * HALF + 4) * (1.0f / 128.0f); }
#pragma unroll
        for (int ai = 0; ai < 2; ++ai)
#pragma unroll
            for (int mh = 0; mh < 2; ++mh) {
                u32x4 xw[2][2];
#pragma unroll
                for (int m2 = 0; m2 < 2; ++m2)
#pragma unroll
                    for (int bj = 0; bj < 2; ++bj) xw[m2][bj] = *(const u32x4*)(xs + (size_t)(row0 + ai * HALF + (2 * mh + m2) * 16) * D + col0 + bj * HALF);
#pragma unroll
                for (int m2 = 0; m2 < 2; ++m2)
#pragma unroll
                    for (int bj = 0; bj < 2; ++bj) { const int m = 2 * mh + m2; const u32x4 x = xw[m2][bj];
                        const f32x4 x0 = (f32x4){bflo(x.x), bfhi(x.x), bflo(x.y), bfhi(x.y)} + g0[bj] * acc[ai][bj][m][0];
                        const f32x4 x1 = (f32x4){bflo(x.z), bfhi(x.z), bflo(x.w), bfhi(x.w)} + g1[bj] * acc[ai][bj][m][1];
                        u32x4 w; w.x = pk2(x0[0], x0[1]); w.y = pk2(x0[2], x0[3]); w.z = pk2(x1[0], x1[1]); w.w = pk2(x1[2], x1[3]);
                        *(u32x4*)(xs + (size_t)(row0 + ai * HALF + m * 16) * D + col0 + bj * HALF) = w; }
            }
    }
};
struct EpiSwiglu {
    static constexpr bool PERM = true;
    unsigned char* O;
    DI void operator()(const f32x4 (&acc)[2][2][4][2], const Unit& u, int wr, int wc, int fr, int fq) const {
        const int row0 = u.pm * BM + wr * 64 + fr, col0 = u.pn * HALF + wc * 32 + 8 * fq;
#pragma unroll
        for (int ai = 0; ai < 2; ++ai)
#pragma unroll
            for (int m = 0; m < 4; ++m) { const int row = row0 + ai * HALF + m * 16;
                const f32x4 a0 = acc[ai][0][m][0] * 0.03125f, a1 = acc[ai][0][m][1] * 0.03125f, u0 = acc[ai][1][m][0] * 0.25f, u1 = acc[ai][1][m][1] * 0.25f;
                float r[8];
#pragma unroll
                for (int j = 0; j < 4; ++j) { r[j] = a0[j] * sigmoidf_(a0[j]) * u0[j]; r[4 + j] = a1[j] * sigmoidf_(a1[j]) * u1[j]; }
                u32x2 w; w.x = pk4_fp8(r[0], r[1], r[2], r[3]); w.y = pk4_fp8(r[4], r[5], r[6], r[7]);
                *(u32x2*)(O + (size_t)row * D + col0) = w; }
    }
};
struct EpiDown {
    static constexpr bool PERM = true;
    bf16_t* O; const float* gate;
    DI void operator()(const f32x4 (&acc)[2][2][4][2], const Unit& u, int wr, int wc, int fr, int fq) const {
        const int row0 = u.pm * BM + wr * 64 + fr, col0 = u.pn * BM + wc * 32 + 8 * fq;
        float gv[2][4];
#pragma unroll
        for (int ai = 0; ai < 2; ++ai)
#pragma unroll
            for (int m = 0; m < 4; ++m) gv[ai][m] = gate[row0 + ai * HALF + m * 16] * (1.0f / 256.0f);
#pragma unroll
        for (int ai = 0; ai < 2; ++ai)
#pragma unroll
            for (int m = 0; m < 4; ++m) { const int row = row0 + ai * HALF + m * 16; const float g = gv[ai][m]; bf16_t* rowp = O + (size_t)row * D + col0;
#pragma unroll
                for (int bj = 0; bj < 2; ++bj) { const f32x4 v0 = acc[ai][bj][m][0] * g, v1 = acc[ai][bj][m][1] * g;
                    u32x4 w; w.x = pk2(v0[0], v0[1]); w.y = pk2(v0[2], v0[3]); w.z = pk2(v1[0], v1[1]); w.w = pk2(v1[2], v1[3]);
                    *(u32x4*)(rowp + bj * HALF) = w; } }
    }
};

struct EpiMerge3 {
    static constexpr bool PERM = true;
    bf16_t* O; const unsigned char* gl;
    DI void operator()(f32x4 (&acc)[2][2][4][2], const Unit& u, int seg, int wr, int wc, int fr, int fq) const {
        const int row0 = u.pm * BM + wr * 64 + fr, col0 = u.pn * BM + wc * 32 + 8 * fq;
#pragma unroll
        for (int ai = 0; ai < 2; ++ai) {
            u32x2 ga[4][2], gb[4][2];
#pragma unroll
            for (int m = 0; m < 4; ++m)
#pragma unroll
                for (int bj = 0; bj < 2; ++bj) { const unsigned char* gp = gl + (size_t)(row0 + ai * HALF + m * 16) * NGL + 1024 * seg + col0 + bj * HALF;
                    ga[m][bj] = *(const u32x2*)gp; gb[m][bj] = seg < 2 ? *(const u32x2*)(gp + 1024) : (u32x2){0u, 0u}; }
#pragma unroll
            for (int m = 0; m < 4; ++m)
#pragma unroll
                for (int bj = 0; bj < 2; ++bj) {
                    f32x4 s0, s1;
#pragma unroll
                    for (int k = 0; k < 4; ++k) { const float a0 = (float)((ga[m][bj].x >> (8 * k)) & 0xffu), a1 = (float)((ga[m][bj].y >> (8 * k)) & 0xffu);
                        if (seg < 2) { const float b0 = (float)((gb[m][bj].x >> (8 * k)) & 0xffu), b1 = (float)((gb[m][bj].y >> (8 * k)) & 0xffu); s0[k] = a0 * __builtin_amdgcn_rcpf(b0); s1[k] = a1 * __builtin_amdgcn_rcpf(b1); }
                        else { s0[k] = a0 * (1.0f / (255.0f * 128.0f)); s1[k] = a1 * (1.0f / (255.0f * 128.0f)); } }
                    acc[ai][bj][m][0] *= s0; acc[ai][bj][m][1] *= s1;
                    if (seg == 2) { const f32x4 v0 = acc[ai][bj][m][0] * 4.0f, v1 = acc[ai][bj][m][1] * 4.0f;
                        u32x2 w; w.x = pk4_fp8(v0[0], v0[1], v0[2], v0[3]); w.y = pk4_fp8(v1[0], v1[1], v1[2], v1[3]);
                        *(u32x2*)((unsigned char*)O + (size_t)(row0 + ai * HALF + m * 16) * D + col0 + bj * HALF) = w; }
                }
        }
    }
};
struct Gemm3 { const unsigned char* A0; const unsigned char* A1; const unsigned char* A2; const unsigned char* B0; const unsigned char* B1; const unsigned char* B2; int lda, ldb; };
template <class Epi>
DI void gemm_phase3(LAS unsigned char* lds, const Gemm3 g, const Order& S, const Epi& E) {
    int tid_ = threadIdx.x; asm volatile("" : "+v"(tid_));
    const int tid = tid_, wid = __builtin_amdgcn_readfirstlane(tid >> 6), lane = tid & 63, wr = wid >> 2, wc = wid & 3, fr = lane & 15, fq = lane >> 4;
    unsigned voffA[2], voffB[2];
#pragma unroll
    for (int i = 0; i < 2; ++i) { int R, C; stage_rc(tid * 16 + i * 8192, R, C); const int Rb = Epi::PERM ? ((R & ~31) + perm32(R & 31)) : R;
        voffA[i] = (unsigned)(R * g.lda + C * 2); voffB[i] = (unsigned)(Rb * g.ldb + C * 2); }
    const size_t kstep = (size_t)(BK * 2);
    const size_t hstepA = (size_t)HALF * g.lda, hstepB = (size_t)HALF * g.ldb;
    const size_t tstepA = 2 * hstepA, tstepB = 2 * hstepB;
    const unsigned ldsw = (unsigned)wid * 1024u;
    const int aoff = lds_byte(wr * 64 + fr, fq * 8), boff = lds_byte(wc * 32 + fr, fq * 8);
#define PG8_SA(b, h) (((b) * 2 + (h)) * HTB)
#define PG8_SB(b, h) ((4 + (b) * 2 + (h)) * HTB)
#define PG8_STAGE(bufoff, gbase, voff) do { _Pragma("unroll") for (int _i = 0; _i < 2; ++_i) \
        __builtin_amdgcn_global_load_lds((const unsigned*)((const char*)(gbase) + (voff)[_i]), (LAS unsigned*)(lds + (bufoff) + ldsw + _i * 8192), 16, 0, 0); } while (0)
#define PG8_LDA(dst, b, h) do { _Pragma("unroll") for (int m = 0; m < 4; ++m) _Pragma("unroll") for (int k = 0; k < 2; ++k) dst[m][k] = *(const LAS bf16x8*)(lds + PG8_SA(b, h) + aoff + m * 2048 + k * 1024); } while (0)
#define PG8_LDB(dst, b, h) do { _Pragma("unroll") for (int n = 0; n < 2; ++n) _Pragma("unroll") for (int k = 0; k < 2; ++k) dst[n][k] = *(const LAS bf16x8*)(lds + PG8_SB(b, h) + boff + n * 2048 + k * 1024); } while (0)
#define PG8_MMA(ai, bj, At, Bt) do { __builtin_amdgcn_s_setprio(1); _Pragma("unroll") for (int m = 0; m < 4; ++m) _Pragma("unroll") for (int n = 0; n < 2; ++n) { \
        const i32x8 bb_ = __builtin_bit_cast(i32x8, __builtin_shufflevector(Bt[n][0], Bt[n][1], 0, 1, 2, 3, 4, 5, 6, 7, 8, 9, 10, 11, 12, 13, 14, 15)); \
        const i32x8 aa_ = __builtin_bit_cast(i32x8, __builtin_shufflevector(At[m][0], At[m][1], 0, 1, 2, 3, 4, 5, 6, 7, 8, 9, 10, 11, 12, 13, 14, 15)); \
        asm volatile("v_mfma_scale_f32_16x16x128_f8f6f4 %0, %1, %2, %0, %3, %3 op_sel_hi:[0,0,0]" : "+v"(acc[ai][bj][m][n]) : "v"(bb_), "v"(aa_), "v"(0x7F7F7F7F)); } \
        __builtin_amdgcn_s_setprio(0); } while (0)
#define PG8_WAIT_V(n) asm volatile("s_waitcnt vmcnt(" #n ")" ::: "memory")
#define PG8_WAIT_L(n) asm volatile("s_waitcnt lgkmcnt(" #n ")" ::: "memory")
#define PG8_BAR __builtin_amdgcn_s_barrier()
#define PG8_SCHED __builtin_amdgcn_sched_barrier(0)
#define PG8_A3(sg, u) ((const char*)((sg) == 0 ? g.A0 : (sg) == 1 ? g.A1 : g.A2) + (size_t)(u).pm * tstepA)
#define PG8_B3(sg, u) ((const char*)((sg) == 0 ? g.B0 : (sg) == 1 ? g.B1 : g.B2) + (size_t)(u).pn * tstepB)
    Unit cur, nu; int ui = 0, seg = 0;
    if (!S.next(0, cur)) return;
    f32x4 acc[2][2][4][2];
#pragma unroll
    for (int a = 0; a < 2; ++a)
#pragma unroll
        for (int b = 0; b < 2; ++b)
#pragma unroll
            for (int m = 0; m < 4; ++m)
#pragma unroll
                for (int n = 0; n < 2; ++n) acc[a][b][m][n] = (f32x4){0.f, 0.f, 0.f, 0.f};
    bf16x8 At[4][2], B0[2][2], B1[2][2];
    const char* cA = PG8_A3(0, cur); const char* cB = PG8_B3(0, cur);
    PG8_STAGE(PG8_SB(0, 0), cB, voffB); PG8_STAGE(PG8_SB(0, 1), cB + hstepB, voffB); PG8_STAGE(PG8_SA(0, 0), cA, voffA); PG8_STAGE(PG8_SA(0, 1), cA + hstepA, voffA);
    if (wr == 1) PG8_BAR;
    PG8_WAIT_V(2); PG8_BAR;
    PG8_STAGE(PG8_SB(1, 0), cB + kstep, voffB); PG8_STAGE(PG8_SA(1, 0), cA + kstep, voffA); PG8_STAGE(PG8_SB(1, 1), cB + hstepB + kstep, voffB);
    PG8_WAIT_V(6); PG8_BAR;
    for (;;) {
        int nseg = seg + 1; bool has_next = true; nu = cur;
        if (nseg == 3) { nseg = 0; has_next = S.next(ui + 1, nu); }
        const char* nA = has_next ? PG8_A3(nseg, nu) : cA; const char* nB = has_next ? PG8_B3(nseg, nu) : cB;
        int nt_ = 4; asm volatile("" : "+s"(nt_));
        const int nt = nt_;
#pragma nounroll
        for (int t = 0; t < nt; t += 2) {
            const bool last = (t == nt - 2);
            const char* a1 = cA + (size_t)(t + 1) * kstep;
            const char* a2 = last ? nA : cA + (size_t)(t + 2) * kstep; const char* b2 = last ? nB : cB + (size_t)(t + 2) * kstep;
            const char* a3 = a2 + kstep; const char* b3 = b2 + kstep;
            PG8_LDB(B0, 0, 0); PG8_LDB(B1, 0, 1); PG8_SCHED; PG8_LDA(At, 0, 0); PG8_STAGE(PG8_SA(1, 1), a1 + hstepA, voffA);
            PG8_WAIT_V(8); PG8_WAIT_L(0); PG8_BAR; PG8_MMA(0, 0, At, B0); PG8_MMA(0, 1, At, B1); PG8_BAR; PG8_SCHED;
            PG8_LDA(At, 0, 1); PG8_STAGE(PG8_SB(0, 0), b2, voffB); PG8_STAGE(PG8_SB(0, 1), b2 + hstepB, voffB); PG8_STAGE(PG8_SA(0, 0), a2, voffA);
            PG8_WAIT_V(8); PG8_WAIT_L(0); PG8_BAR; PG8_MMA(1, 0, At, B0); PG8_MMA(1, 1, At, B1); PG8_BAR; PG8_SCHED;
            PG8_LDB(B0, 1, 0); PG8_LDB(B1, 1, 1); PG8_SCHED; PG8_LDA(At, 1, 0); PG8_STAGE(PG8_SA(0, 1), a2 + hstepA, voffA);
            PG8_WAIT_V(8); PG8_WAIT_L(0); PG8_BAR; PG8_MMA(0, 0, At, B0); PG8_MMA(0, 1, At, B1); PG8_BAR; PG8_SCHED;
            PG8_LDA(At, 1, 1); PG8_STAGE(PG8_SB(1, 0), b3, voffB); PG8_STAGE(PG8_SB(1, 1), b3 + hstepB, voffB); PG8_STAGE(PG8_SA(1, 0), a3, voffA);
            PG8_WAIT_V(8); PG8_WAIT_L(0); PG8_BAR; PG8_MMA(1, 0, At, B0); PG8_MMA(1, 1, At, B1); PG8_BAR; PG8_SCHED;
        }
        if (wr == 0) PG8_BAR;
        E(acc, cur, seg, wr, wc, fr, fq);
        if (!has_next) break;
        if (seg == 2) {
#pragma unroll
            for (int a = 0; a < 2; ++a)
#pragma unroll
                for (int b = 0; b < 2; ++b)
#pragma unroll
                    for (int m = 0; m < 4; ++m)
#pragma unroll
                        for (int n = 0; n < 2; ++n) acc[a][b][m][n] = (f32x4){0.f, 0.f, 0.f, 0.f};
            cur = nu; ++ui;
        }
        seg = nseg; cA = nA; cB = nB;
        if (wr == 1) PG8_BAR;
    }
    PG8_WAIT_V(0);
    PG8_BAR;
#undef PG8_SA
#undef PG8_SB
#undef PG8_STAGE
#undef PG8_LDA
#undef PG8_LDB
#undef PG8_MMA
#undef PG8_WAIT_V
#undef PG8_WAIT_L
#undef PG8_BAR
#undef PG8_SCHED
#undef PG8_A3
#undef PG8_B3
}

template <class Epi, bool FP8 = false>
DI void gemm_phase(LAS unsigned char* lds, const Gemm g, const Order& S, const Epi& E) {
    constexpr int ESZ = FP8 ? 1 : 2;
    int tid_ = threadIdx.x; asm volatile("" : "+v"(tid_));
    const int tid = tid_, wid = __builtin_amdgcn_readfirstlane(tid >> 6), lane = tid & 63, wr = wid >> 2, wc = wid & 3, fr = lane & 15, fq = lane >> 4;
    const int K = g.K, nt = K * ESZ / (BK * 2);
    unsigned voffA[2], voffB[2];
#pragma unroll
    for (int i = 0; i < 2; ++i) { int R, C; stage_rc(tid * 16 + i * 8192, R, C); const int Rb = Epi::PERM ? ((R & ~31) + perm32(R & 31)) : R;
        voffA[i] = (unsigned)(R * g.lda * ESZ + C * 2); voffB[i] = (unsigned)(Rb * g.ldb * ESZ + C * 2); }
    const size_t kstep = (size_t)(BK * 2);
    const size_t hstepA = (size_t)HALF * g.lda * ESZ, hstepB = (size_t)HALF * g.ldb * ESZ;
    const size_t tstepA = 2 * hstepA, tstepB = 2 * hstepB;
    const unsigned ldsw = (unsigned)wid * 1024u;
    const int aoff = lds_byte(wr * 64 + fr, fq * 8), boff = lds_byte(wc * 32 + fr, fq * 8);
#define PG8_SA(b, h) (((b) * 2 + (h)) * HTB)
#define PG8_SB(b, h) ((4 + (b) * 2 + (h)) * HTB)
#define PG8_STAGE(bufoff, gbase, voff) do { _Pragma("unroll") for (int _i = 0; _i < 2; ++_i) \
        __builtin_amdgcn_global_load_lds((const unsigned*)((const char*)(gbase) + (voff)[_i]), (LAS unsigned*)(lds + (bufoff) + ldsw + _i * 8192), 16, 0, 0); } while (0)
#define PG8_LDA(dst, b, h) do { _Pragma("unroll") for (int m = 0; m < 4; ++m) _Pragma("unroll") for (int k = 0; k < 2; ++k) dst[m][k] = *(const LAS bf16x8*)(lds + PG8_SA(b, h) + aoff + m * 2048 + k * 1024); } while (0)
#define PG8_LDB(dst, b, h) do { _Pragma("unroll") for (int n = 0; n < 2; ++n) _Pragma("unroll") for (int k = 0; k < 2; ++k) dst[n][k] = *(const LAS bf16x8*)(lds + PG8_SB(b, h) + boff + n * 2048 + k * 1024); } while (0)
#define PG8_MMA(ai, bj, At, Bt) do { __builtin_amdgcn_s_setprio(1); _Pragma("unroll") for (int m = 0; m < 4; ++m) _Pragma("unroll") for (int n = 0; n < 2; ++n) { \
        if constexpr (FP8) { const i32x8 bb_ = __builtin_bit_cast(i32x8, __builtin_shufflevector(Bt[n][0], Bt[n][1], 0, 1, 2, 3, 4, 5, 6, 7, 8, 9, 10, 11, 12, 13, 14, 15)); \
            const i32x8 aa_ = __builtin_bit_cast(i32x8, __builtin_shufflevector(At[m][0], At[m][1], 0, 1, 2, 3, 4, 5, 6, 7, 8, 9, 10, 11, 12, 13, 14, 15)); \
            asm volatile("v_mfma_scale_f32_16x16x128_f8f6f4 %0, %1, %2, %0, %3, %3 op_sel_hi:[0,0,0]" : "+v"(acc[ai][bj][m][n]) : "v"(bb_), "v"(aa_), "v"(0x7F7F7F7F)); } \
        else { _Pragma("unroll") for (int k = 0; k < 2; ++k) acc[ai][bj][m][n] = __builtin_amdgcn_mfma_f32_16x16x32_bf16(Bt[n][k], At[m][k], acc[ai][bj][m][n], 0, 0, 0); } } \
        __builtin_amdgcn_s_setprio(0); } while (0)
#define PG8_WAIT_V(n) asm volatile("s_waitcnt vmcnt(" #n ")" ::: "memory")
#define PG8_WAIT_L(n) asm volatile("s_waitcnt lgkmcnt(" #n ")" ::: "memory")
#define PG8_BAR __builtin_amdgcn_s_barrier()
#define PG8_SCHED __builtin_amdgcn_sched_barrier(0)
#define PG8_EXPERT(pm) ((pm) < 256 ? (((pm) >> 1) & 15) : ((pm) - 256))
#define PG8_ABASE(u) ((const char*)g.A + (size_t)(u).pm * tstepA)
#define PG8_BBASE(u) ((const char*)g.Bt + (size_t)PG8_EXPERT((u).pm) * g.estride * ESZ + (size_t)(u).pn * tstepB)
    Unit cur, nxt; int ui = 0;
    if (!S.next(0, cur)) return;
    f32x4 acc[2][2][4][2];
#pragma unroll
    for (int a = 0; a < 2; ++a)
#pragma unroll
        for (int b = 0; b < 2; ++b)
#pragma unroll
            for (int m = 0; m < 4; ++m)
#pragma unroll
                for (int n = 0; n < 2; ++n) acc[a][b][m][n] = (f32x4){0.f, 0.f, 0.f, 0.f};
    bf16x8 At[4][2], B0[2][2], B1[2][2];
    const char* cA = PG8_ABASE(cur); const char* cB = PG8_BBASE(cur);
    PG8_STAGE(PG8_SB(0, 0), cB, voffB); PG8_STAGE(PG8_SB(0, 1), cB + hstepB, voffB); PG8_STAGE(PG8_SA(0, 0), cA, voffA); PG8_STAGE(PG8_SA(0, 1), cA + hstepA, voffA);
    if (wr == 1) PG8_BAR;
    PG8_WAIT_V(2); PG8_BAR;
    PG8_STAGE(PG8_SB(1, 0), cB + kstep, voffB); PG8_STAGE(PG8_SA(1, 0), cA + kstep, voffA); PG8_STAGE(PG8_SB(1, 1), cB + hstepB + kstep, voffB);
    PG8_WAIT_V(6); PG8_BAR;
    for (;;) {
        const bool has_next = S.next(ui + 1, nxt);
        const char* nA = has_next ? PG8_ABASE(nxt) : cA; const char* nB = has_next ? PG8_BBASE(nxt) : cB;
#pragma nounroll
        for (int t = 0; t < nt; t += 2) {
            const bool last = (t == nt - 2);
            const char* a1 = cA + (size_t)(t + 1) * kstep;
            const char* a2 = last ? nA : cA + (size_t)(t + 2) * kstep; const char* b2 = last ? nB : cB + (size_t)(t + 2) * kstep;
            const char* a3 = a2 + kstep; const char* b3 = b2 + kstep;
            PG8_LDB(B0, 0, 0); PG8_LDB(B1, 0, 1); PG8_SCHED; PG8_LDA(At, 0, 0); PG8_STAGE(PG8_SA(1, 1), a1 + hstepA, voffA);
            PG8_WAIT_V(8); PG8_WAIT_L(0); PG8_BAR; PG8_MMA(0, 0, At, B0); PG8_MMA(0, 1, At, B1); PG8_BAR; PG8_SCHED;
            PG8_LDA(At, 0, 1); PG8_STAGE(PG8_SB(0, 0), b2, voffB); PG8_STAGE(PG8_SB(0, 1), b2 + hstepB, voffB); PG8_STAGE(PG8_SA(0, 0), a2, voffA);
            PG8_WAIT_V(8); PG8_WAIT_L(0); PG8_BAR; PG8_MMA(1, 0, At, B0); PG8_MMA(1, 1, At, B1); PG8_BAR; PG8_SCHED;
            PG8_LDB(B0, 1, 0); PG8_LDB(B1, 1, 1); PG8_SCHED; PG8_LDA(At, 1, 0); PG8_STAGE(PG8_SA(0, 1), a2 + hstepA, voffA);
            PG8_WAIT_V(8); PG8_WAIT_L(0); PG8_BAR; PG8_MMA(0, 0, At, B0); PG8_MMA(0, 1, At, B1); PG8_BAR; PG8_SCHED;
            PG8_LDA(At, 1, 1); PG8_STAGE(PG8_SB(1, 0), b3, voffB); PG8_STAGE(PG8_SB(1, 1), b3 + hstepB, voffB); PG8_STAGE(PG8_SA(1, 0), a3, voffA);
            PG8_WAIT_V(8); PG8_WAIT_L(0); PG8_BAR; PG8_MMA(1, 0, At, B0); PG8_MMA(1, 1, At, B1); PG8_BAR; PG8_SCHED;
        }
        if (wr == 0) PG8_BAR;
        E(acc, cur, wr, wc, fr, fq);
        if (!has_next) break;
#pragma unroll
        for (int a = 0; a < 2; ++a)
#pragma unroll
            for (int b = 0; b < 2; ++b)
#pragma unroll
                for (int m = 0; m < 4; ++m)
#pragma unroll
                    for (int n = 0; n < 2; ++n) acc[a][b][m][n] = (f32x4){0.f, 0.f, 0.f, 0.f};
        cur = nxt; cA = nA; cB = nB; ++ui;
        if (wr == 1) PG8_BAR;
    }
    PG8_WAIT_V(0);
    PG8_BAR;
#undef PG8_SA
#undef PG8_SB
#undef PG8_STAGE
#undef PG8_LDA
#undef PG8_LDB
#undef PG8_MMA
#undef PG8_WAIT_V
#undef PG8_WAIT_L
#undef PG8_BAR
#undef PG8_SCHED
}
}

struct Args { const float* in[29]; float* out; unsigned char* ws; };
typedef const __attribute__((address_space(4))) Args* KArgs;
#define KA_FRESH(ka) asm volatile("" : "+s"(ka))
enum { I_X = 0, I_C, I_CTX, I_CCTX, I_N1G, I_N2G, I_WADA, I_BADA, I_WIN, I_NAQG, I_NAKG, I_RPB, I_MQN, I_WUQ, I_MKVN, I_WUKV, I_MQG, I_MKG, I_SWQG, I_SWKG, I_SINK,
       I_WNAO, I_WMLAO, I_WSWAO, I_WO, I_ROUTER, I_WGATE, I_WUP, I_WDOWN };
struct Frame {
    LAS unsigned char* lds;
    int tid, lane, wave, G, vcu, gw, ngw;
};

DI void frame_fresh(Frame& F) { int t = F.tid, w = F.wave, v = F.vcu; asm volatile("" : "+v"(t), "+s"(w), "+s"(v)); F.tid = t; F.lane = t & 63; F.wave = w; F.vcu = v; F.gw = v * 8 + w; }
DI void modv_phase(Frame& F, KArgs ka) {
    KA_FRESH(ka); const __attribute__((address_space(4))) Args& a = *ka; frame_fresh(F);
    LAS float* cact = (LAS float*)F.lds;
    LAS float* red = (LAS float*)(F.lds + 9 * 1024 * 4);
    const float* c = a.in[I_C]; const float* cc = a.in[I_CCTX];
    for (int i = F.tid; i < 9 * 1024; i += 512) { const float v = i < 8192 ? c[i] : cc[i - 8192]; cact[i] = v * sigmoidf_(v); }
    __syncthreads();
    float* modv = (float*)(a.ws + WS_MODV);
    const int cl = F.lane & 31, kp = F.lane >> 5;
    for (int unit = F.vcu; unit < NL * 192; unit += F.G) {
        const int l = unit / 192, n = (unit % 192) * 32 + cl;
        const float* w = a.in[I_WADA] + (size_t)l * 1024 * 6144 + n;
        float acc[9];
#pragma unroll
        for (int i = 0; i < 9; ++i) acc[i] = 0.f;
        const int k0 = F.wave * 128 + kp;
#pragma unroll 16
        for (int k = 0; k < 128; k += 2) { const float wv = w[(size_t)(k0 + k) * 6144];
#pragma unroll
            for (int i = 0; i < 9; ++i) acc[i] += cact[i * 1024 + k0 + k] * wv; }
#pragma unroll
        for (int i = 0; i < 9; ++i) red[((F.wave * 2 + kp) * 9 + i) * 32 + cl] = acc[i];
        __syncthreads();
        for (int t = F.tid; t < 9 * 32; t += 512) { const int i = t >> 5, nn = t & 31; float s = 0.f;
#pragma unroll
            for (int w16 = 0; w16 < 16; ++w16) s += red[(w16 * 9 + i) * 32 + nn];
            const int col = (unit % 192) * 32 + nn;
            modv[((size_t)l * 9 + i) * 6144 + col] = s + a.in[I_BADA][l * 6144 + col]; }
        __syncthreads();
    }
}
DI void copy_phase(Frame& F, KArgs ka) {
    KA_FRESH(ka); const __attribute__((address_space(4))) Args& a = *ka; frame_fresh(F);
    u32x2* xs = (u32x2*)(a.ws + WS_XS);
    const f32x4* x = (const f32x4*)a.in[I_X]; const f32x4* cx = (const f32x4*)a.in[I_CTX];
    const size_t nl = (size_t)MLAT * D / 4, nc = (size_t)MCTX * D / 4;
    for (size_t i = (size_t)blockIdx.x * 512 + F.tid; i < nl + nc; i += (size_t)F.G * 512) { const f32x4 v = i < nl ? x[i] : cx[i - nl]; u32x2 w; w.x = pk2(v.x, v.y); w.y = pk2(v.z, v.w); xs[i] = w; }
}

DI unsigned char* wsel(unsigned char* ws, int l, size_t off) {
    const size_t p = (size_t)(l & 1);
    return ws + (off >= W_DN ? WS_W + off + p * (16 * MiB) : off >= W_GU ? WS_W + off + p * (32 * MiB) : (p ? WS_W2 : WS_W) + off);
}
constexpr int T_IN = 16 * 166, T_UQ = 4 * 24, T_UKV = 2 * 32, T_NAO = 6 * 32, T_MLAO = 8 * 32, T_SWAO = 6 * 32, T_O = 16 * 32, T_E = 16 * 32 * 16;
constexpr int NIT = T_IN + T_UQ + T_UKV + T_NAO + T_MLAO + T_SWAO + T_O + 3 * T_E;
DI void cvt_item(const __attribute__((address_space(4))) Args& a, int l, int r, LAS float* scr, int lane) {
    const float* W; const float* ks = nullptr; int ldw = 1024, kb, nb, ldt = 1024, drow0, dcol0 = 0, fp8 = 1; size_t woff;
    if (r < T_IN) { kb = r / 166; nb = r % 166; W = a.in[I_WIN] + (size_t)l * 1024 * DIN; ldw = DIN;
        if (nb < 70) { fp8 = 0; woff = W_IN; drow0 = 32 * nb; } else { woff = W_GL; drow0 = 32 * nb - 2240; } }
    else if ((r -= T_IN) < T_UQ) { kb = r / 24; nb = r % 24; W = a.in[I_WUQ] + (size_t)l * 256 * 768; ldw = 768; fp8 = 0; woff = W_UP; ldt = 384; drow0 = 32 * nb; ks = a.in[I_MQN] + l * 256; }
    else if ((r -= T_UQ) < T_UKV) { kb = r / 32; nb = r % 32; W = a.in[I_WUKV] + (size_t)l * 128 * 1024; fp8 = 0; woff = W_UP; ldt = 384; drow0 = 768 + 32 * nb; dcol0 = 256; ks = a.in[I_MKVN] + l * 128; }
    else if ((r -= T_UKV) < T_NAO) { kb = r / 32; nb = r % 32; W = a.in[I_WNAO] + (size_t)l * 384 * 1024; woff = W_NAO; ldt = 512; drow0 = 32 * nb; }
    else if ((r -= T_NAO) < T_MLAO) { kb = r / 32; nb = r % 32; W = a.in[I_WMLAO] + (size_t)l * 512 * 1024; woff = W_MLAO; ldt = 512; drow0 = 32 * nb; }
    else if ((r -= T_MLAO) < T_SWAO) { kb = r / 32; nb = r % 32; W = a.in[I_WSWAO] + (size_t)l * 384 * 1024; woff = W_SWAO; ldt = 512; drow0 = 32 * nb; }
    else if ((r -= T_SWAO) < T_O) { kb = r / 32; nb = r % 32; W = a.in[I_WO] + (size_t)l * 1024 * 1024; woff = W_O; drow0 = 32 * nb; }
    else if ((r -= T_O) < 2 * T_E) {
        const int which = r / T_E, rr = r % T_E, e = rr / 512, t = rr % 512; kb = t / 32; nb = t % 32; const int f0 = 32 * nb;
        W = a.in[which ? I_WUP : I_WGATE] + ((size_t)l * 16 + e) * 1024 * 1024; woff = W_GU + (size_t)e * 2048 * 1024; drow0 = 256 * (f0 >> 7) + 128 * which + (f0 & 127); }
    else { r -= 2 * T_E; const int e = r / 512, t = r % 512; kb = t / 32; nb = t % 32;
        W = a.in[I_WDOWN] + ((size_t)l * 16 + e) * 1024 * 1024; woff = W_DN + (size_t)e * 1024 * 1024; drow0 = 32 * nb; }
    const int k0 = 64 * kb, n0 = 32 * nb; dcol0 += k0;
    unsigned char* WT; { const size_t p = (size_t)(l & 1); WT = a.ws + (woff >= W_DN ? WS_W + woff + p * (16 * MiB) : woff >= W_GU ? WS_W + woff + p * (32 * MiB) : (p ? WS_W2 : WS_W) + woff); }
    const float sc = fp8 ? 32.0f : 1.0f;
    const float* Wl = W + (size_t)(k0 + (lane >> 5)) * ldw + n0 + (lane & 31); LAS float* sl = scr + (lane >> 5) * 33 + (lane & 31);
    if (ks) { ks += k0 + (lane >> 5);
#pragma unroll 8
        for (int i = 0; i < 32; ++i) sl[2 * i * 33] = Wl[(size_t)(2 * i) * ldw] * ks[2 * i]; }
    else {
#pragma unroll 8
        for (int i = 0; i < 32; ++i) sl[2 * i * 33] = Wl[(size_t)(2 * i) * ldw] * sc; }
    asm volatile("s_waitcnt lgkmcnt(0)" ::: "memory");
    const int c = lane & 7;
    if (fp8) {
#pragma unroll
        for (int j = 0; j < 4; ++j) { const int n = (lane >> 3) + 8 * j; const LAS float* s = scr + (8 * c) * 33 + n;
            u32x2 o; o.x = pk4_fp8(s[0 * 33], s[1 * 33], s[2 * 33], s[3 * 33]); o.y = pk4_fp8(s[4 * 33], s[5 * 33], s[6 * 33], s[7 * 33]);
            *(u32x2*)(WT + (size_t)(drow0 + n) * ldt + dcol0 + 8 * c) = o; }
    } else {
#pragma unroll
        for (int j = 0; j < 4; ++j) { const int n = (lane >> 3) + 8 * j; const LAS float* s = scr + (8 * c) * 33 + n;
            u32x4 o; o.x = pk2(s[0 * 33], s[1 * 33]); o.y = pk2(s[2 * 33], s[3 * 33]); o.z = pk2(s[4 * 33], s[5 * 33]); o.w = pk2(s[6 * 33], s[7 * 33]);
            *(u32x4*)((bf16_t*)WT + (size_t)(drow0 + n) * ldt + dcol0 + 8 * c) = o; }
    }
    asm volatile("s_waitcnt lgkmcnt(0)" ::: "memory");
}
DI void convert_weights(Frame& F, KArgs ka, int l, int begin) {
    KA_FRESH(ka); const __attribute__((address_space(4))) Args& a = *ka; frame_fresh(F);
    LAS float* scr = (LAS float*)(F.lds + F.wave * 16384);
#pragma nounroll
    for (int it = begin + F.gw; it < NIT; it += F.ngw) cvt_item(a, l, it, scr, F.lane);
    unsigned char* wb = a.ws + ((l & 1) ? WS_W2 : WS_W);
    constexpr int Z0 = 64 * 128, Z1 = 768 * 16, Z2 = 1024 * 32, Z3 = 2 * 1024 * 8;
    unsigned zz = 0u; asm volatile("" : "+v"(zz));
    const u32x4 z = {zz, zz, zz, zz};
    for (int i = blockIdx.x * 512 + F.tid; i < Z0 + Z1 + Z2 + Z3; i += F.G * 512) {
        if (i >= Z0 + Z1 + Z2) { const int j = i - Z0 - Z1 - Z2, which = j >> 13, jj = j & 8191; *(u32x4*)(wb + (which ? W_SWAO : W_NAO) + (size_t)(jj >> 3) * 512 + 384 + (jj & 7) * 16) = z; continue; }
        if (i < Z0) *(u32x4*)((bf16_t*)(wb + W_IN) + (size_t)(2240 + i / 128) * 1024 + (i % 128) * 8) = z;
        else if (i < Z0 + Z1) { const int j = i - Z0; *(u32x4*)((bf16_t*)(wb + W_UP) + (size_t)(j / 16) * 384 + 256 + (j % 16) * 8) = z; }
        else { const int j = i - Z0 - Z1; *(u32x4*)((bf16_t*)(wb + W_UP) + (size_t)(768 + j / 32) * 384 + (j % 32) * 8) = z; }
    }
}
DI void convert_tail(Frame& F, KArgs ka, int l, int first, int q) {
    KA_FRESH(ka); const __attribute__((address_space(4))) Args& a = *ka; frame_fresh(F);
    LAS float* scr = (LAS float*)(F.lds + F.wave * 16384);
#pragma nounroll
    for (int j = 0; j < q; ++j) { const int it = first + 8 * j + F.wave; if (it < NIT) cvt_item(a, l, it, scr, F.lane); }
}


DI void row_phase(Frame& F, KArgs ka, int l, int dry = 0) {
    KA_FRESH(ka); const __attribute__((address_space(4))) Args& a = *ka; frame_fresh(F);
    bf16_t* xs = (bf16_t*)(a.ws + WS_XS);
    const float* modv = (const float*)(a.ws + WS_MODV);
    const int* smap = (const int*)(a.ws + WS_SMAP);
    const bf16_t* Y = (const bf16_t*)(a.ws + WS_Y);
    bf16_t* H = (bf16_t*)(a.ws + WS_R4);
    unsigned char* H8 = a.ws + WS_R4 + 68 * MiB;
    bf16_t* xso = xs; float* outo = a.out;
    if (dry) { unsigned char* tr = a.ws + WS_END + (size_t)F.gw * 16384; xso = (bf16_t*)tr; outo = (float*)tr; H = (bf16_t*)(tr + 8192); H8 = tr + 12288; }
    const int nrows = (l == NL) ? MLAT : MT;
    const bool comb = (l > 0);
    constexpr int RR = 4;
    for (int mb = RR * F.gw; mb < nrows; mb += RR * F.ngw) {
        f32x4 v[RR][4]; int myslot[RR];
#pragma unroll
        for (int rr = 0; rr < RR; ++rr) { const int m = mb + rr;
            if (l == 0) {
                if (F.lane < 16 && !dry) *(u32x4*)(a.ws + WS_OCAT + (size_t)m * OCW + ((F.lane >> 3) ? 1408 : 384) + 16 * (F.lane & 7)) = (u32x4){0u, 0u, 0u, 0u};
                const f32x4* xr = (const f32x4*)(m < MLAT ? a.in[I_X] + (size_t)m * D : a.in[I_CTX] + (size_t)(m - MLAT) * D) + F.lane;
                u32x2* xo = (u32x2*)(xs + (size_t)m * D) + F.lane;
#pragma unroll
                for (int j = 0; j < 4; ++j) { const f32x4 t = xr[64 * j]; u32x2 w; w.x = pk2(t.x, t.y); w.y = pk2(t.z, t.w); if (!dry) xo[64 * j] = w; v[rr][j] = (f32x4){bflo(w.x), bfhi(w.x), bflo(w.y), bfhi(w.y)}; }
            } else {
                const u32x2* xr = (const u32x2*)(xs + (size_t)m * D) + F.lane;
#pragma unroll
                for (int j = 0; j < 4; ++j) { const u32x2 w = xr[64 * j]; v[rr][j] = (f32x4){bflo(w.x), bfhi(w.x), bflo(w.y), bfhi(w.y)}; }
            }
            myslot[rr] = (comb && F.lane < 16) ? smap[(size_t)F.lane * MT + mb + rr] : -1; }
        const int mi = mod_index(mb);
        if (comb) {
            f32x4 acc[RR][4];
            unsigned long long mk[RR];
#pragma unroll
            for (int rr = 0; rr < RR; ++rr) { mk[rr] = __ballot(myslot[rr] >= 0);
#pragma unroll
                for (int j = 0; j < 4; ++j) acc[rr][j] = (f32x4){0.f, 0.f, 0.f, 0.f}; }
            while ((mk[0] | mk[1]) | (mk[2] | mk[3])) {
                u32x2 w[RR][4];
#pragma unroll
                for (int rr = 0; rr < RR; ++rr) {
                    int s = -1;
                    if (mk[rr]) { const int e0 = __builtin_ctzll(mk[rr]); s = __shfl(myslot[rr], e0); mk[rr] &= mk[rr] - 1; }
#pragma unroll
                    for (int j = 0; j < 4; ++j) w[rr][j] = (u32x2){0u, 0u};
                    if (s >= 0) { const u32x2* yr = (const u32x2*)(Y + (size_t)s * D) + F.lane;
#pragma unroll
                        for (int j = 0; j < 4; ++j) w[rr][j] = yr[64 * j]; }
                }
#pragma unroll
                for (int rr = 0; rr < RR; ++rr)
#pragma unroll
                    for (int j = 0; j < 4; ++j) acc[rr][j] += (f32x4){bflo(w[rr][j].x), bfhi(w[rr][j].x), bflo(w[rr][j].y), bfhi(w[rr][j].y)};
            }
            const f32x4* g5 = (const f32x4*)(modv + ((size_t)(l - 1) * 9 + mi) * 6144 + 5 * 1024) + F.lane;
            f32x4 g5v[4];
#pragma unroll
            for (int j = 0; j < 4; ++j) g5v[j] = g5[64 * j];
#pragma unroll
            for (int rr = 0; rr < RR; ++rr) { const int m = mb + rr;
                const size_t ro = dry ? (size_t)rr * 1024 : (size_t)m * D;
#pragma unroll
                for (int j = 0; j < 4; ++j) { v[rr][j] += g5v[j] * acc[rr][j];
                    if (l == NL) ((f32x4*)(outo + ro) + F.lane)[64 * j] = v[rr][j];
                    else { u32x2 w; w.x = pk2(v[rr][j].x, v[rr][j].y); w.y = pk2(v[rr][j].z, v[rr][j].w); ((u32x2*)(xso + ro) + F.lane)[64 * j] = w;
                           v[rr][j] = (f32x4){bflo(w.x), bfhi(w.x), bflo(w.y), bfhi(w.y)}; } } }
        }
        if (l < NL) {
            const f32x4* g = (const f32x4*)(a.in[I_N1G] + l * D) + F.lane;
            const f32x4* sh = (const f32x4*)(modv + ((size_t)l * 9 + mi) * 6144) + F.lane;
            const f32x4* sc = (const f32x4*)(modv + ((size_t)l * 9 + mi) * 6144 + 1024) + F.lane;
            f32x4 gg[4], shv[4];
#pragma unroll
            for (int j = 0; j < 4; ++j) { gg[j] = g[64 * j] * (sc[64 * j] + 1.0f); shv[j] = sh[64 * j]; }
#pragma unroll
            for (int rr = 0; rr < RR; ++rr) { const int m = mb + rr;
                float ss = 0.f;
#pragma unroll
                for (int j = 0; j < 4; ++j) ss += (v[rr][j].x * v[rr][j].x + v[rr][j].y * v[rr][j].y) + (v[rr][j].z * v[rr][j].z + v[rr][j].w * v[rr][j].w);
                const float rstd = __builtin_amdgcn_rsqf(wave_sum(ss) * (1.f / D) + EPS);
                u32x2* o = (u32x2*)(H + (dry ? (size_t)rr * 1024 : (size_t)m * D)) + F.lane;
                unsigned* o8 = (unsigned*)(H8 + (dry ? (size_t)rr * 1024 : (size_t)m * D)) + F.lane;
#pragma unroll
                for (int j = 0; j < 4; ++j) { const f32x4 hh = v[rr][j] * rstd * gg[j] + shv[j]; u32x2 w; w.x = pk2(hh.x, hh.y); w.y = pk2(hh.z, hh.w); o[64 * j] = w;
                    o8[64 * j] = pk4_fp8(hh.x, hh.y, hh.z, hh.w); } }
        }
    }
}

DI void rope_cs(int d, int prow, int pcol, float& cs, float& sn) {
    const int i = d & 15; const float pos = (float)((d & 32) ? pcol : prow);
    const float inv = __builtin_amdgcn_exp2f(-(float)i * (13.287712379549449f / 16.0f));
    const float rev = pos * inv * 0.15915494309189535f;
    const float fr = rev - floorf(rev);
    cs = __builtin_amdgcn_cosf(fr); sn = __builtin_amdgcn_sinf(fr);
}
DI void prep_phase(Frame& F, KArgs ka, int l) {
    KA_FRESH(ka); const __attribute__((address_space(4))) Args& a = *ka; frame_fresh(F);
    const bf16_t* HW = (const bf16_t*)(a.ws + WS_HW);
    bf16_t* P1 = (bf16_t*)(a.ws + WS_P1);
    const float sc64 = 0.125f * LOG2E;
    const int d0 = 8 * (F.lane & 7);
    float gn[3][8]; int srcc[3]; bool ropei[3], acti[3];
    const float* gp0 = a.in[I_NAQG]; const float* gp1 = a.in[I_NAKG]; const float* gp2 = a.in[I_SWQG]; const float* gp3 = a.in[I_SWKG];
#pragma unroll
    for (int i = 0; i < 3; ++i) { const int c = F.lane + 64 * i, col = 8 * c; acti[i] = c < 160;
        const int ty = col < 384 ? 0 : col < 768 ? 1 : col < 1152 ? 2 : 3;
        srcc[i] = col < 768 ? col : col + (C_SWQ - 768);
        ropei[i] = ty >= 2;
        const float sc = (ty == 0 || ty == 2) ? sc64 : 1.0f;
#pragma unroll
        for (int j = 0; j < 8; ++j) { const float g0 = gp0[l * 64 + d0 + j], g1 = gp1[l * 64 + d0 + j], g2 = gp2[l * 64 + d0 + j], g3 = gp3[l * 64 + d0 + j];
            gn[i][j] = acti[i] ? (ty == 0 ? g0 : ty == 1 ? g1 : ty == 2 ? g2 : g3) * sc : 0.f; } }
    float invf[8];
#pragma unroll
    for (int j = 0; j < 8; ++j) invf[j] = __builtin_amdgcn_exp2f(-(float)((d0 & 8) + j) * (13.287712379549449f / 16.0f)) * 0.15915494309189535f;
    const bool second = (d0 & 16) != 0, usecol = (d0 & 32) != 0;
    for (int mb = 2 * F.gw; mb < MT; mb += 2 * F.ngw) {
        u32x4 w[2][3];
#pragma unroll
        for (int rr = 0; rr < 2; ++rr)
#pragma unroll
            for (int i = 0; i < 3; ++i) if (acti[i]) w[rr][i] = *(const u32x4*)(HW + (size_t)(mb + rr) * DINP + srcc[i]); else w[rr][i] = (u32x4){0u, 0u, 0u, 0u};
#pragma unroll
        for (int rr = 0; rr < 2; ++rr) {
            const int m = mb + rr; const bool lat = m < MLAT; const int s = m & 4095; const float prw = (float)(s >> 6), pcl = (float)(s & 63); float pos = usecol ? pcl : prw; asm volatile("" : "+v"(pos));
            float cs[8], sn[8];
#pragma unroll
            for (int j = 0; j < 8; ++j) { cs[j] = 1.f; sn[j] = 0.f; }
            if (lat) {
#pragma unroll
                for (int j = 0; j < 8; ++j) { const float rev = pos * invf[j], fr = rev - floorf(rev); cs[j] = __builtin_amdgcn_cosf(fr); sn[j] = __builtin_amdgcn_sinf(fr); } }
#pragma unroll
            for (int i = 0; i < 3; ++i) {
                float x[8] = {bflo(w[rr][i].x), bfhi(w[rr][i].x), bflo(w[rr][i].y), bfhi(w[rr][i].y), bflo(w[rr][i].z), bfhi(w[rr][i].z), bflo(w[rr][i].w), bfhi(w[rr][i].w)};
                float ss = 0.f;
#pragma unroll
                for (int j = 0; j < 8; ++j) ss += x[j] * x[j];
                ss += __shfl_xor(ss, 1); ss += __shfl_xor(ss, 2); ss += __shfl_xor(ss, 4);
                const float rs = __builtin_amdgcn_rsqf(ss * (1.f / 64.f) + EPS);
#pragma unroll
                for (int j = 0; j < 8; ++j) x[j] *= rs * gn[i][j];
                const bool rp = ropei[i] && lat;
#pragma unroll
                for (int j = 0; j < 8; ++j) { const float y = __int_as_float(__builtin_amdgcn_ds_bpermute((F.lane ^ 2) << 2, __float_as_int(x[j]))); const float rot = second ? x[j] * cs[j] + y * sn[j] : x[j] * cs[j] - y * sn[j]; x[j] = rp ? rot : x[j]; }
                if (acti[i]) { u32x4 o; o.x = pk2(x[0], x[1]); o.y = pk2(x[2], x[3]); o.z = pk2(x[4], x[5]); o.w = pk2(x[6], x[7]);
                    *(u32x4*)(P1 + (size_t)m * P1W + 8 * (F.lane + 64 * i)) = o; }
            }
        }
    }
}
DI void prep2_phase(Frame& F, KArgs ka, int l, int dry = 0) {
    KA_FRESH(ka); const __attribute__((address_space(4))) Args& a = *ka; frame_fresh(F);
    const bf16_t* HW = (const bf16_t*)(a.ws + WS_HW);
    bf16_t* U = (bf16_t*)(a.ws + WS_R4);
    bf16_t* P2 = (bf16_t*)(a.ws + WS_P2);
    const float scq = 0.07216878364870322f * LOG2E;
    const int ln = F.lane, q = ln & 15, h = ln >> 4;
    float qgn[8], qgr[4], kgn[8], kgr[4], invf[4];
    { const float* qg = a.in[I_MQG] + l * 192; const float* kg = a.in[I_MKG] + l * 192;
#pragma unroll
      for (int j = 0; j < 8; ++j) { qgn[j] = qg[8 * q + j] * scq; kgn[j] = kg[8 * q + j]; }
#pragma unroll
      for (int j = 0; j < 4; ++j) { qgr[j] = qg[128 + 4 * q + j] * scq; kgr[j] = kg[128 + 4 * q + j];
          invf[j] = __builtin_amdgcn_exp2f(-(float)(4 * (q & 3) + j) * (13.287712379549449f / 16.0f)) * 0.15915494309189535f; } }
    const bool second = (q & 4) != 0, usecol = (q & 8) != 0;
    const int pl = (ln ^ 4) << 2;
    for (int mb = 2 * F.gw; mb < MT; mb += 2 * F.ngw) {
        u32x2 wcq[2], wqr[2], wkr[2]; unsigned wckv[2]; u32x4 wqn[2], wkn[2], wv[2];
#pragma unroll
        for (int rr = 0; rr < 2; ++rr) { const bf16_t* hr = HW + (size_t)(mb + rr) * DINP; const bf16_t* ur = U + (size_t)(mb + rr) * UW;
            wcq[rr] = *(const u32x2*)(hr + C_CQ + 4 * ln); wckv[rr] = *(const unsigned*)(hr + C_CKV + 2 * ln); wkr[rr] = *(const u32x2*)(hr + C_KR + 4 * q);
            wqn[rr] = *(const u32x4*)(ur + h * 192 + 8 * q); wqr[rr] = *(const u32x2*)(ur + h * 192 + 128 + 4 * q);
            wkn[rr] = *(const u32x4*)(ur + 768 + h * 256 + 8 * q); wv[rr] = *(const u32x4*)(ur + 768 + h * 256 + 128 + 8 * q); }
#pragma unroll
        for (int rr = 0; rr < 2; ++rr) {
            const int m = mb + rr; const bool lat = m < MLAT; const int s = m & 4095;
            bf16_t* ur = U + (size_t)m * UW; bf16_t* pr = P2 + (size_t)m * P2W;
            if (dry) { ur = (bf16_t*)(a.ws + WS_END + (size_t)F.gw * 8192); pr = ur + 2048; }
            float rq, rkv;
            { const float a0 = bflo(wcq[rr].x), a1 = bfhi(wcq[rr].x), a2 = bflo(wcq[rr].y), a3 = bfhi(wcq[rr].y);
              rq = __builtin_amdgcn_rsqf(wave_sum(a0 * a0 + a1 * a1 + a2 * a2 + a3 * a3) * (1.f / 256.f) + EPS); }
            { const float a0 = bflo(wckv[rr]), a1 = bfhi(wckv[rr]);
              rkv = __builtin_amdgcn_rsqf(wave_sum(a0 * a0 + a1 * a1) * (1.f / 128.f) + EPS); }
            float cs[4], sn[4];
            { const float prw = (float)(s >> 6), pcl = (float)(s & 63); float pos = usecol ? pcl : prw; asm volatile("" : "+v"(pos));
#pragma unroll
              for (int j = 0; j < 4; ++j) { const float rev = pos * invf[j], fr = rev - floorf(rev); cs[j] = lat ? __builtin_amdgcn_cosf(fr) : 1.f; sn[j] = lat ? __builtin_amdgcn_sinf(fr) : 0.f; } }
#pragma unroll
            for (int isk = 0; isk < 2; ++isk) {
                const u32x4 wn = isk ? wkn[rr] : wqn[rr]; const u32x2 wr2 = isk ? wkr[rr] : wqr[rr];
                const float sn_ = isk ? rkv : rq, sr_ = isk ? 1.0f : rq;
                float x[8] = {bflo(wn.x) * sn_, bfhi(wn.x) * sn_, bflo(wn.y) * sn_, bfhi(wn.y) * sn_, bflo(wn.z) * sn_, bfhi(wn.z) * sn_, bflo(wn.w) * sn_, bfhi(wn.w) * sn_};
                float y[4] = {bflo(wr2.x) * sr_, bfhi(wr2.x) * sr_, bflo(wr2.y) * sr_, bfhi(wr2.y) * sr_};
                float ss = 0.f;
#pragma unroll
                for (int j = 0; j < 8; ++j) ss += x[j] * x[j];
#pragma unroll
                for (int j = 0; j < 4; ++j) ss += y[j] * y[j];
                ss += __shfl_xor(ss, 1); ss += __shfl_xor(ss, 2); ss += __shfl_xor(ss, 4); ss += __shfl_xor(ss, 8);
                const float rs = __builtin_amdgcn_rsqf(ss * (1.f / 192.f) + EPS);
#pragma unroll
                for (int j = 0; j < 8; ++j) x[j] *= rs * (isk ? kgn[j] : qgn[j]);
#pragma unroll
                for (int j = 0; j < 4; ++j) { y[j] *= rs * (isk ? kgr[j] : qgr[j]);
                    const float p = __int_as_float(__builtin_amdgcn_ds_bpermute(pl, __float_as_int(y[j])));
                    y[j] = second ? y[j] * cs[j] + p * sn[j] : y[j] * cs[j] - p * sn[j]; }
                u32x4 o; o.x = pk2(x[0], x[1]); o.y = pk2(x[2], x[3]); o.z = pk2(x[4], x[5]); o.w = pk2(x[6], x[7]);
                u32x2 o2; o2.x = pk2(y[0], y[1]); o2.y = pk2(y[2], y[3]);
                *(u32x4*)(pr + 768 * isk + h * 192 + 8 * q) = o; *(u32x2*)(pr + 768 * isk + h * 192 + 128 + 4 * q) = o2;
            }
            { const u32x4 vw = wv[rr]; u32x4 o; o.x = pk2(bflo(vw.x) * rkv, bfhi(vw.x) * rkv); o.y = pk2(bflo(vw.y) * rkv, bfhi(vw.y) * rkv); o.z = pk2(bflo(vw.z) * rkv, bfhi(vw.z) * rkv); o.w = pk2(bflo(vw.w) * rkv, bfhi(vw.w) * rkv);
              *(u32x4*)(ur + 768 + h * 256 + 128 + 8 * q) = o; }
        }
    }
}

struct AU {
    const bf16_t *q, *k, *v; unsigned char* o;
    int ldq, ldk, ldv, ldo;
    int qrow0;
    int lat_row0, n_lat, ctx_row0, n_ctx;
    int mode;
    int qpos0, kpos0;
    float m0, l0;
    const float* rpb;
};
template <int DQ, int DV, int LDK, int LDV>
DI void attn_unit(LAS unsigned char* lds, const AU& u, int tid, int wave, int lane) {
    constexpr int KP = DQ * 2 + 16, VP = DV * 2 + 64, KBY = 64 * KP, VBY = 64 * VP, STG = KBY + VBY;
    constexpr int NKS = DQ / 16, NDT = DV / 32, KCH = DQ / 8, VCH = DV / 8;
    constexpr int KC = KP / 16, VC = VP / 16;
    constexpr int KI = (KC + 7) / 8, VI = (VC + 7) / 8;
    constexpr int BIAS_OFF = 98304;
    static_assert(2 * STG <= BIAS_OFF && KBY % 1024 == 0 && VBY % 1024 == 0, "attention LDS");
    const int r = lane & 31, h = lane >> 5;
    const int nt = u.n_lat + u.n_ctx;
    LAS float* btab = (LAS float*)(lds + BIAS_OFF);
    if (u.mode == 2) { for (int i = tid; i < 15 * 31; i += 512) btab[i] = u.rpb[i] * LOG2E; }
    bf16x8 qf[NKS];
    { const bf16_t* qp = u.q + (size_t)(u.qrow0 + wave * 32 + r) * u.ldq + 8 * h;
#pragma unroll
      for (int ks = 0; ks < NKS; ++ks) qf[ks] = *(const bf16x8*)(qp + 16 * ks); }
    f32x16 o[NDT];
#pragma unroll
    for (int dt = 0; dt < NDT; ++dt)
#pragma unroll
        for (int i = 0; i < 16; ++i) o[dt][i] = 0.f;
    float mrun = u.m0, lrun = (h == 0) ? u.l0 : 0.f;
    unsigned koff[KI], voff[VI];
#pragma unroll
    for (int i = 0; i < KI; ++i) { const int c = 64 * (wave + 8 * i) + lane, row = c / KC, cc = c % KC; koff[i] = (unsigned)(row * LDK * 2 + (cc < KCH ? cc : KCH - 1) * 16); }
#pragma unroll
    for (int i = 0; i < VI; ++i) { const int c = 64 * (wave + 8 * i) + lane, row = c / VC, cc = c % VC; voff[i] = (unsigned)(row * LDV * 2 + (cc < VCH ? cc : VCH - 1) * 16); }
#define AT_ROWBASE(t) ((t) < u.n_lat ? u.lat_row0 + 64 * (t) : u.ctx_row0 + 64 * ((t) - u.n_lat))
#define AT_ISSUE(t, buf) do { const int rb_ = AT_ROWBASE(t); const char* kb_ = (const char*)(u.k + (size_t)rb_ * LDK); const char* vb_ = (const char*)(u.v + (size_t)rb_ * LDV); \
        _Pragma("unroll") for (int i_ = 0; i_ < KI; ++i_) { const int j_ = wave + 8 * i_; if (j_ < KC) __builtin_amdgcn_global_load_lds((const unsigned*)(kb_ + koff[i_]), (LAS unsigned*)(lds + (buf) * STG + j_ * 1024), 16, 0, 0); } \
        _Pragma("unroll") for (int i_ = 0; i_ < VI; ++i_) { const int j_ = wave + 8 * i_; if (j_ < VC) __builtin_amdgcn_global_load_lds((const unsigned*)(vb_ + voff[i_]), (LAS unsigned*)(lds + (buf) * STG + KBY + j_ * 1024), 16, 0, 0); } } while (0)
    AT_ISSUE(0, 0);
    asm volatile("s_waitcnt vmcnt(0)" ::: "memory");
    __syncthreads();
    const int tq = (lane & 15) >> 2, tp = lane & 3, tblk = (lane >> 4) & 1;
    const int vlane_off = (4 * h + tq) * VP + 32 * tblk + 8 * tp;
    for (int t = 0; t < nt; ++t) {
        const int buf = t & 1;
        if (t + 1 < nt) AT_ISSUE(t + 1, buf ^ 1);
        bool skip = false; int a0 = 0, a1 = 0;
        if (u.mode == 1 && t < u.n_lat) { const int k0 = u.kpos0 + 64 * t, q0 = u.qpos0 + 32 * wave; skip = (k0 > q0 + 31 + 128) || (k0 + 63 < q0 - 128); a0 = k0; a1 = q0; }
        if (u.mode == 2 && t < u.n_lat) { const int kr = u.kpos0 + t, qr = u.qpos0 + (wave >> 1); int rs = qr - 4; rs = rs < 0 ? 0 : (rs > 56 ? 56 : rs); skip = (kr < rs) || (kr >= rs + 8); a0 = kr - qr + 7; }
        if (!skip) {
            const LAS unsigned char* Kt = lds + buf * STG; const LAS unsigned char* Vt = Kt + KBY;
            f32x16 s0, s1;
#pragma unroll
            for (int i = 0; i < 16; ++i) { s0[i] = 0.f; s1[i] = 0.f; }
#pragma unroll
            for (int ks = 0; ks < NKS; ++ks) {
                const bf16x8 k0 = *(const LAS bf16x8*)(Kt + r * KP + (16 * ks + 8 * h) * 2);
                const bf16x8 k1 = *(const LAS bf16x8*)(Kt + (32 + r) * KP + (16 * ks + 8 * h) * 2);
                s0 = __builtin_amdgcn_mfma_f32_32x32x16_bf16(k0, qf[ks], s0, 0, 0, 0);
                s1 = __builtin_amdgcn_mfma_f32_32x32x16_bf16(k1, qf[ks], s1, 0, 0, 0);
            }
            if (u.mode == 1 && t < u.n_lat) {
                const int qpos = a1 + r;
#pragma unroll
                for (int i = 0; i < 16; ++i) { const int kk = a0 + (i & 3) + 8 * (i >> 2) + 4 * h; int d0 = qpos - kk; d0 = d0 < 0 ? -d0 : d0; int d1 = qpos - (kk + 32); d1 = d1 < 0 ? -d1 : d1;
                    s0[i] = d0 <= 128 ? s0[i] : -INFINITY; s1[i] = d1 <= 128 ? s1[i] : -INFINITY; }
            }
            if (u.mode == 2 && t < u.n_lat) {
                const int qc = 32 * (wave & 1) + r; int cs = qc - 8; cs = cs < 0 ? 0 : (cs > 48 ? 48 : cs);
                const int bbase = a0 * 31 + 15 - qc;
                float bb[16];
#pragma unroll
                for (int half = 0; half < 2; ++half) {
#pragma unroll
                    for (int i = 0; i < 16; ++i) { int ix = bbase + 32 * half + (i & 3) + 8 * (i >> 2) + 4 * h; ix = ix < 0 ? 0 : (ix > 464 ? 464 : ix); bb[i] = btab[ix]; }
                    asm volatile("" : "+v"(bb[0]), "+v"(bb[1]), "+v"(bb[2]), "+v"(bb[3]), "+v"(bb[4]), "+v"(bb[5]), "+v"(bb[6]), "+v"(bb[7]), "+v"(bb[8]), "+v"(bb[9]), "+v"(bb[10]), "+v"(bb[11]), "+v"(bb[12]), "+v"(bb[13]), "+v"(bb[14]), "+v"(bb[15]));
#pragma unroll
                    for (int i = 0; i < 16; ++i) { const int kc = 32 * half + (i & 3) + 8 * (i >> 2) + 4 * h; const bool ok = (kc >= cs) && (kc < cs + 16);
                        if (half == 0) s0[i] = ok ? s0[i] + bb[i] : -INFINITY; else s1[i] = ok ? s1[i] + bb[i] : -INFINITY; }
                }
            }
            float mx = fmaxf(s0[0], s1[0]);
#pragma unroll
            for (int i = 1; i < 16; ++i) mx = fmaxf(mx, fmaxf(s0[i], s1[i]));
            mx = fmaxf(mx, __shfl_xor(mx, 32));
            const float mnew = fmaxf(mrun, mx), alpha = __builtin_amdgcn_exp2f(mrun - mnew);
            float ls = 0.f;
#pragma unroll
            for (int i = 0; i < 16; ++i) { s0[i] = __builtin_amdgcn_exp2f(s0[i] - mnew); s1[i] = __builtin_amdgcn_exp2f(s1[i] - mnew); ls += s0[i] + s1[i]; }
            lrun = lrun * alpha + ls; mrun = mnew;
#pragma unroll
            for (int dt = 0; dt < NDT; ++dt)
#pragma unroll
                for (int i = 0; i < 16; ++i) o[dt][i] *= alpha;
            bf16x8 pf[4];
            { u32x4 w;
              w.x = pk2(s0[0], s0[1]); w.y = pk2(s0[2], s0[3]); w.z = pk2(s0[4], s0[5]); w.w = pk2(s0[6], s0[7]); pf[0] = __builtin_bit_cast(bf16x8, w);
              w.x = pk2(s0[8], s0[9]); w.y = pk2(s0[10], s0[11]); w.z = pk2(s0[12], s0[13]); w.w = pk2(s0[14], s0[15]); pf[1] = __builtin_bit_cast(bf16x8, w);
              w.x = pk2(s1[0], s1[1]); w.y = pk2(s1[2], s1[3]); w.z = pk2(s1[4], s1[5]); w.w = pk2(s1[6], s1[7]); pf[2] = __builtin_bit_cast(bf16x8, w);
              w.x = pk2(s1[8], s1[9]); w.y = pk2(s1[10], s1[11]); w.z = pk2(s1[12], s1[13]); w.w = pk2(s1[14], s1[15]); pf[3] = __builtin_bit_cast(bf16x8, w); }
#pragma unroll
            for (int kk = 0; kk < 4; ++kk) {
#pragma unroll
                for (int dt = 0; dt < NDT; ++dt) {
                    const LAS unsigned char* vp = Vt + (16 * kk) * VP + vlane_off + 64 * dt;
                    const s16x4 lo = __builtin_amdgcn_ds_read_tr16_b64_v4i16((LAS s16x4*)vp);
                    const s16x4 hi = __builtin_amdgcn_ds_read_tr16_b64_v4i16((LAS s16x4*)(vp + 8 * VP));
                    const bf16x8 vf = __builtin_shufflevector(lo, hi, 0, 1, 2, 3, 4, 5, 6, 7);
                    o[dt] = __builtin_amdgcn_mfma_f32_32x32x16_bf16(vf, pf[kk], o[dt], 0, 0, 0);
                }
            }
        }
        asm volatile("s_waitcnt vmcnt(0)" ::: "memory");
        __syncthreads();
    }
    const float ltot = lrun + __shfl_xor(lrun, 32), inv = 1.0f / ltot;
    unsigned char* op = u.o + (size_t)(u.qrow0 + wave * 32 + r) * u.ldo + 4 * h;
    const float inv4 = inv * 4.0f;
#pragma unroll
    for (int dt = 0; dt < NDT; ++dt)
#pragma unroll
        for (int g = 0; g < 4; ++g) *(unsigned*)(op + 32 * dt + 8 * g) = pk4_fp8(o[dt][4 * g] * inv4, o[dt][4 * g + 1] * inv4, o[dt][4 * g + 2] * inv4, o[dt][4 * g + 3] * inv4);
#undef AT_ROWBASE
#undef AT_ISSUE
}

DI void attn_phase(Frame& F, KArgs ka, int l) {
    KA_FRESH(ka); const __attribute__((address_space(4))) Args& a = *ka; frame_fresh(F);
    const bf16_t* HW = (const bf16_t*)(a.ws + WS_HW);
    const bf16_t* P1 = (const bf16_t*)(a.ws + WS_P1);
    const bf16_t* P2 = (const bf16_t*)(a.ws + WS_P2);
    const bf16_t* U = (const bf16_t*)(a.ws + WS_R4);
    unsigned char* OC = a.ws + WS_OCAT;
    const bool last = (l == NL - 1);
    constexpr int nA = 512, nB = 768, nC = 768;
    const int ntot = nA + nB + nC + (last ? 0 : 128);
#ifndef ATT_PROBE
#define ATT_PROBE 0
#endif
    for (int rep2_ = 0; rep2_ < 1 + (ATT_PROBE != 0); ++rep2_)
    for (int id = F.vcu; id < ntot; id += F.G) {
        if (rep2_ == 1 && !((ATT_PROBE == 1) ? (id < nA) : (id >= nA && id < nA + nB))) continue;
        AU u; bool big = false;
        u.mode = 0; u.qpos0 = 0; u.kpos0 = 0; u.m0 = -1e30f; u.l0 = 0.f; u.rpb = nullptr; u.n_ctx = 4;
        if (id < nA) {
            const int b = id >> 6, h = (id >> 4) & 3, qb = id & 15; big = true;
            u.q = P2 + h * 192; u.ldq = P2W; u.k = P2 + 768 + h * 192; u.ldk = P2W; u.v = U + 768 + h * 256 + 128; u.ldv = UW; u.o = OC + 512 + h * 128; u.ldo = OCW;
            u.qrow0 = b * SEQ + qb * 256; u.lat_row0 = b * SEQ; u.n_lat = 64; u.ctx_row0 = MLAT + b * CTX;
        } else if (id < nA + nB) {
            const int j = id - nA, b = j / 96, h = (j >> 4) % 6, qb = j & 15;
            u.q = P1 + h * 64; u.ldq = P1W; u.k = P1 + 384 + h * 64; u.ldk = P1W; u.v = HW + C_NAV + h * 64; u.ldv = DINP; u.o = OC + h * 64; u.ldo = OCW;
            int rlo = 4 * qb - 4; rlo = rlo < 0 ? 0 : (rlo > 56 ? 56 : rlo); int rhi = 4 * qb + 3 - 4; rhi = (rhi < 0 ? 0 : (rhi > 56 ? 56 : rhi)) + 7;
            u.qrow0 = b * SEQ + qb * 256; u.lat_row0 = b * SEQ + rlo * 64; u.n_lat = rhi - rlo + 1; u.ctx_row0 = MLAT + b * CTX;
            u.mode = 2; u.qpos0 = 4 * qb; u.kpos0 = rlo; u.rpb = a.in[I_RPB] + (size_t)(l * 6 + h) * 465;
        } else if (id < nA + nB + nC) {
            const int j = id - nA - nB, b = j / 96, hq = (j >> 4) % 6, qb = j & 15, kvh = hq / 3;
            u.q = P1 + 768 + hq * 64; u.ldq = P1W; u.k = P1 + 1152 + kvh * 64; u.ldk = P1W; u.v = HW + C_SWV + kvh * 64; u.ldv = DINP; u.o = OC + 1024 + hq * 64; u.ldo = OCW;
            int klo = qb * 256 - 128; klo = klo < 0 ? 0 : klo; int khi = qb * 256 + 384; khi = khi > SEQ ? SEQ : khi;
            u.qrow0 = b * SEQ + qb * 256; u.lat_row0 = b * SEQ + klo; u.n_lat = (khi - klo) >> 6; u.ctx_row0 = MLAT + b * CTX;
            u.mode = 1; u.qpos0 = qb * 256; u.kpos0 = klo; u.m0 = a.in[I_SINK][l * 6 + hq] * LOG2E; u.l0 = 1.f;
        } else {
            const int j = id - nA - nB - nC;
            u.n_lat = 0; u.lat_row0 = 0;
            if (j < 32) { const int b = j >> 2, h = j & 3; big = true;
                u.q = P2 + h * 192; u.ldq = P2W; u.k = P2 + 768 + h * 192; u.ldk = P2W; u.v = U + 768 + h * 256 + 128; u.ldv = UW; u.o = OC + 512 + h * 128; u.ldo = OCW;
                u.qrow0 = MLAT + b * CTX; u.ctx_row0 = MLAT + b * CTX;
            } else if (j < 80) { const int jj = j - 32, b = jj / 6, h = jj % 6;
                u.q = P1 + h * 64; u.ldq = P1W; u.k = P1 + 384 + h * 64; u.ldk = P1W; u.v = HW + C_NAV + h * 64; u.ldv = DINP; u.o = OC + h * 64; u.ldo = OCW;
                u.qrow0 = MLAT + b * CTX; u.ctx_row0 = MLAT + b * CTX;
            } else { const int jj = j - 80, b = jj / 6, hq = jj % 6, kvh = hq / 3;
                u.q = P1 + 768 + hq * 64; u.ldq = P1W; u.k = P1 + 1152 + kvh * 64; u.ldk = P1W; u.v = HW + C_SWV + kvh * 64; u.ldv = DINP; u.o = OC + 1024 + hq * 64; u.ldo = OCW;
                u.qrow0 = MLAT + b * CTX; u.ctx_row0 = MLAT + b * CTX; u.m0 = a.in[I_SINK][l * 6 + hq] * LOG2E; u.l0 = 1.f;
            }
        }
        if (big) attn_unit<192, 128, P2W, UW>(F.lds, u, F.tid, F.wave, F.lane);
        else attn_unit<64, 64, P1W, DINP>(F.lds, u, F.tid, F.wave, F.lane);
    }
}

DI void norm2_phase(Frame& F, KArgs ka, int l, int nrows) {
    KA_FRESH(ka); const __attribute__((address_space(4))) Args& a = *ka; frame_fresh(F);
    LAS float* rt = (LAS float*)F.lds;
    const float* rg = a.in[I_ROUTER] + (size_t)l * 1024 * 16;
    for (int i = F.tid; i < 16384; i += 512) rt[i] = rg[i];
    __syncthreads();
    LAS float* xr = (LAS float*)(F.lds + 65536 + F.wave * 8192);
    const bf16_t* xs = (const bf16_t*)(a.ws + WS_XS);
    const float* modv = (const float*)(a.ws + WS_MODV);
    unsigned char* H2 = a.ws + WS_H2;
    float* AFL = (float*)(a.ws + WS_AFL); float* AFC = (float*)(a.ws + WS_AFC);
    const int eq = F.lane & 3, kq = F.lane >> 2;
    u32x2 xw[2][4];
#define N2_LOAD(mb_) do { _Pragma("unroll") for (int rr_ = 0; rr_ < 2; ++rr_) { const u32x2* xp_ = (const u32x2*)(xs + (size_t)((mb_) + rr_) * D) + F.lane; \
        _Pragma("unroll") for (int j_ = 0; j_ < 4; ++j_) xw[rr_][j_] = xp_[64 * j_]; } } while (0)
    if (2 * F.gw < nrows) N2_LOAD(2 * F.gw);
    for (int mb = 2 * F.gw; mb < nrows; mb += 2 * F.ngw) {
        const int mi = mod_index(mb);
        f32x4 v[2][4];
#pragma unroll
        for (int rr = 0; rr < 2; ++rr)
#pragma unroll
            for (int j = 0; j < 4; ++j) { const u32x2 w = xw[rr][j]; v[rr][j] = (f32x4){bflo(w.x), bfhi(w.x), bflo(w.y), bfhi(w.y)}; }
        if (mb + 2 * F.ngw < nrows) N2_LOAD(mb + 2 * F.ngw);
        const f32x4* g = (const f32x4*)(a.in[I_N2G] + l * D) + F.lane;
        const f32x4* sh = (const f32x4*)(modv + ((size_t)l * 9 + mi) * 6144 + 3 * 1024) + F.lane;
        const f32x4* sc = (const f32x4*)(modv + ((size_t)l * 9 + mi) * 6144 + 4 * 1024) + F.lane;
        f32x4 gg[4], shv[4];
#pragma unroll
        for (int j = 0; j < 4; ++j) { gg[j] = g[64 * j] * (sc[64 * j] + 1.0f); shv[j] = sh[64 * j]; }
#pragma unroll
        for (int rr = 0; rr < 2; ++rr) {
            float ss = 0.f;
#pragma unroll
            for (int j = 0; j < 4; ++j) ss += (v[rr][j].x * v[rr][j].x + v[rr][j].y * v[rr][j].y) + (v[rr][j].z * v[rr][j].z + v[rr][j].w * v[rr][j].w);
            const float rstd = __builtin_amdgcn_rsqf(wave_sum(ss) * (1.f / D) + EPS);
            unsigned* o = (unsigned*)(H2 + (size_t)(mb + rr) * D) + F.lane;
#pragma unroll
            for (int j = 0; j < 4; ++j) { const f32x4 hh = v[rr][j] * rstd * gg[j] + shv[j]; o[64 * j] = pk4_fp8(hh.x, hh.y, hh.z, hh.w);
                *(LAS f32x4*)(xr + rr * 1024 + 4 * F.lane + 256 * j) = hh; }
        }
        asm volatile("s_waitcnt lgkmcnt(0)" ::: "memory");
        f32x4 acc[2] = {{0.f, 0.f, 0.f, 0.f}, {0.f, 0.f, 0.f, 0.f}};
#pragma unroll 8
        for (int i = 0; i < 64; ++i) { const int k = kq + 16 * i; const float x0 = xr[k], x1 = xr[1024 + k]; const f32x4 w = *(const LAS f32x4*)(rt + k * 16 + 4 * eq); acc[0] += w * x0; acc[1] += w * x1; }
        asm volatile("s_waitcnt lgkmcnt(0)" ::: "memory");
#pragma unroll
        for (int rr = 0; rr < 2; ++rr) { const int m = mb + rr; f32x4 ac = acc[rr];
#pragma unroll
            for (int ofs = 4; ofs < 64; ofs <<= 1) { ac.x += __shfl_xor(ac.x, ofs); ac.y += __shfl_xor(ac.y, ofs); ac.z += __shfl_xor(ac.z, ofs); ac.w += __shfl_xor(ac.w, ofs); }
            float mx = fmaxf(fmaxf(ac.x, ac.y), fmaxf(ac.z, ac.w)); mx = fmaxf(mx, __shfl_xor(mx, 1)); mx = fmaxf(mx, __shfl_xor(mx, 2));
            f32x4 ex; ex.x = __expf(ac.x - mx); ex.y = __expf(ac.y - mx); ex.z = __expf(ac.z - mx); ex.w = __expf(ac.w - mx);
            float sum = (ex.x + ex.y) + (ex.z + ex.w); sum += __shfl_xor(sum, 1); sum += __shfl_xor(sum, 2);
            const float inv = 1.0f / sum;
            if (F.lane < 4) {
                if (m < MLAT) { const int b = m >> 12, s = m & 4095; float* p = AFL + ((size_t)(b * 16 + 4 * F.lane)) * 4096 + s; p[0] = ex.x * inv; p[4096] = ex.y * inv; p[2 * 4096] = ex.z * inv; p[3 * 4096] = ex.w * inv; }
                else { const int b = (m - MLAT) >> 8, s = (m - MLAT) & 255; float* p = AFC + ((size_t)(b * 16 + 4 * F.lane)) * 256 + s; p[0] = ex.x * inv; p[256] = ex.y * inv; p[512] = ex.z * inv; p[768] = ex.w * inv; }
            }
        }
    }
}

DI unsigned block_excl_scan(unsigned v, unsigned& total, LAS unsigned* wsum, int tid, int lane, int wave) {
    unsigned x = v;
#pragma unroll
    for (int o = 1; o < 64; o <<= 1) { const unsigned y = __shfl_up(x, o); if (lane >= o) x += y; }
    if (lane == 63) wsum[wave] = x;
    __syncthreads();
    unsigned base = 0, tot = 0;
#pragma unroll
    for (int w = 0; w < 8; ++w) { const unsigned s = wsum[w]; if (w < wave) base += s; tot += s; }
    __syncthreads();
    total = tot;
    return base + x - v;
}
DI void select_phase(Frame& F, KArgs ka, int l) {
    KA_FRESH(ka); const __attribute__((address_space(4))) Args& a = *ka; frame_fresh(F);
    const bool last = (l == NL - 1);
    const int nunits = last ? 128 : 256;
    LAS unsigned* hist = (LAS unsigned*)F.lds;
    LAS unsigned* wsum = (LAS unsigned*)(F.lds + 8192);
    LAS unsigned* bc = (LAS unsigned*)(F.lds + 8192 + 64);
    LAS int* sel = (LAS int*)(F.lds + 16384);
    const float* AFL = (const float*)(a.ws + WS_AFL); const float* AFC = (const float*)(a.ws + WS_AFC);
    int* smap = (int*)(a.ws + WS_SMAP); float* gate = (float*)(a.ws + WS_GATE);
    const unsigned char* H2 = a.ws + WS_H2; unsigned char* XG = a.ws + WS_XG;
    for (int unit = blockIdx.x; unit < nunits; unit += F.G) {
        const bool lat = unit < 128; const int be = unit & 127, b = be >> 4, e = be & 15;
        const int N = lat ? 4096 : 256, cap = lat ? CAP_LAT : CAP_CTX;
        const float* aff = lat ? AFL + (size_t)be * 4096 : AFC + (size_t)be * 256;
        unsigned key[8]; const int per = lat ? 8 : 1; const bool act = lat || F.tid < 256;
#pragma unroll
        for (int j = 0; j < 8; ++j) key[j] = (act && j < per) ? __float_as_uint(aff[F.tid * per + j]) : 0u;
        unsigned prefix = 0u, pmask = 0u, need = (unsigned)cap;
#pragma unroll
        for (int pass = 0; pass < 3; ++pass) {
            const int shift = pass == 0 ? 21 : (pass == 1 ? 10 : 0), nb = pass == 2 ? 1024 : 2048;
            for (int i = F.tid; i < 2048; i += 512) hist[i] = 0u;
            __syncthreads();
#pragma unroll
            for (int j = 0; j < 8; ++j) if (act && j < per && (key[j] & pmask) == prefix) (void)__hip_atomic_fetch_add(&hist[(key[j] >> shift) & (nb - 1)], 1u, __ATOMIC_RELAXED, __HIP_MEMORY_SCOPE_WORKGROUP);
            __syncthreads();
            unsigned c4[4], mine = 0;
#pragma unroll
            for (int j = 0; j < 4; ++j) { const int bin = 2047 - 4 * F.tid - j; c4[j] = bin < nb ? hist[bin] : 0u; mine += c4[j]; }
            unsigned tot; unsigned run = block_excl_scan(mine, tot, wsum, F.tid, F.lane, F.wave);
#pragma unroll
            for (int j = 0; j < 4; ++j) { const int bin = 2047 - 4 * F.tid - j;
                if (bin < nb && run < need && run + c4[j] >= need) { bc[0] = (unsigned)bin; bc[1] = run; }
                run += c4[j]; }
            __syncthreads();
            const unsigned cb = bc[0], above = bc[1];
            prefix |= cb << shift; pmask |= (unsigned)(nb - 1) << shift; need -= above;
            __syncthreads();
        }
        unsigned neq = 0, ngt = 0;
#pragma unroll
        for (int j = 0; j < 8; ++j) if (act && j < per) { neq += key[j] == prefix; ngt += key[j] > prefix; }
        unsigned teq; const unsigned eqbase = block_excl_scan(neq, teq, wsum, F.tid, F.lane, F.wave);
        unsigned nsel = 0, flags = 0, erun = eqbase;
#pragma unroll
        for (int j = 0; j < 8; ++j) if (act && j < per) { bool s = key[j] > prefix; if (key[j] == prefix) { s = erun < need; ++erun; } if (s) { flags |= 1u << j; ++nsel; } }
        unsigned tsel; unsigned sbase = block_excl_scan(nsel, tsel, wsum, F.tid, F.lane, F.wave);
        const int rowbase = lat ? b * SEQ : MLAT + b * CTX;
        const int slotbase = lat ? be * CAP_LAT : NSLOT_LAT + (e * 8 + b) * CAP_CTX;
#pragma unroll
        for (int j = 0; j < 8; ++j) if (act && j < per) { const int tok = F.tid * per + j; int slot = -1;
            if ((flags >> j) & 1u) { slot = slotbase + (int)sbase; sel[sbase] = tok; gate[slot] = __uint_as_float(key[j]); ++sbase; }
            smap[(size_t)e * MT + rowbase + tok] = slot; }
        __syncthreads();
        if (lat) {
            for (int t0 = F.wave * 16; t0 < cap; t0 += 128) {
                u32x4 rowv[16];
#pragma unroll
                for (int q = 0; q < 16; ++q) rowv[q] = ((const u32x4*)(H2 + (size_t)(rowbase + sel[t0 + q]) * D))[F.lane];
#pragma unroll
                for (int q = 0; q < 16; ++q) ((u32x4*)(XG + (size_t)(slotbase + t0 + q) * D))[F.lane] = rowv[q];
            }
        } else {
            const int t0 = F.wave * 4;
            u32x4 rowv[4];
#pragma unroll
            for (int q = 0; q < 4; ++q) rowv[q] = ((const u32x4*)(H2 + (size_t)(rowbase + sel[t0 + q]) * D))[F.lane];
#pragma unroll
            for (int q = 0; q < 4; ++q) ((u32x4*)(XG + (size_t)(slotbase + t0 + q) * D))[F.lane] = rowv[q];
        }
        __syncthreads();
    }
}

#ifndef Q_INA
#define Q_INA 2
#endif
#ifndef Q_INB
#define Q_INB 4
#endif
#ifndef Q_INC
#define Q_INC 6
#endif
#ifndef Q_MRG
#define Q_MRG 4
#endif
#ifndef Q_WO
#define Q_WO 2
#endif
#ifndef Q_GU
#define Q_GU 3
#endif
#ifndef Q_DN
#define Q_DN 2
#endif
#define TAIL1(nwg_, Q_) do { const int r_ = (nwg_) % F.G; if (!last && r_ != 0) { if (bx >= r_) convert_tail(F, ka, l + 1, cur + 8 * (Q_) * (bx - r_), (Q_)); cur += 8 * (Q_) * (F.G - r_); } } while (0)
DI unsigned char* ws_fresh(KArgs ka) { KA_FRESH(ka); return ka->ws; }
__global__ void __launch_bounds__(512, 2) mega_fwd(Args a_unused) {
    extern __shared__ __attribute__((aligned(16))) unsigned char lds_raw[];
    KArgs ka = (KArgs)__builtin_amdgcn_kernarg_segment_ptr();
    Frame F;
    F.lds = (LAS unsigned char*)lds_raw;
    F.tid = threadIdx.x; F.lane = F.tid & 63; F.wave = __builtin_amdgcn_readfirstlane(F.tid >> 6);
    F.G = gridDim.x; { const int bx = blockIdx.x; F.vcu = (F.G % 8 == 0) ? (bx % 8) * (F.G / 8) + bx / 8 : bx; }
    F.gw = F.vcu * 8 + F.wave; F.ngw = F.G * 8;
    for (int u = F.tid; u < (LDS_BYTES - LDSCTL_OFF) / 4; u += 512) ((LAS unsigned*)(F.lds + LDSCTL_OFF))[u] = 0u;
    __syncthreads();
    XcdBarrier bar = xcd_barrier_post((unsigned*)(ws_fresh(ka) + WS_CTL) + CW_BAR, (volatile LAS unsigned*)(F.lds + LDSCTL_OFF + 32));
#define GRID_BAR() xcd_barrier(bar)
    const int bx = blockIdx.x;

    if (PH(0)) modv_phase(F, ka);
    for (int rep_ = 0; rep_ < REPS(2); ++rep_) if (PH(2)) convert_weights(F, ka, 0, 0);
    GRID_BAR();
    if (PH(3)) row_phase(F, ka, 0);
    GRID_BAR();

    for (int l = 0; l < NL; ++l) {
        const bool last = (l == NL - 1);
        const int nMe = last ? MLAT / 256 : MT / 256;
        const int nMs = last ? NSLOT_LAT / 256 : NSLOT / 256;
        int cur = 0;
        for (int rep_ = 0; rep_ < REPS(4); ++rep_) if (PH(4)) { unsigned char* ws = ws_fresh(ka);
            { pg8::Gemm g{(const bf16_t*)(ws + WS_R4), (const bf16_t*)wsel(ws, l, W_IN), 1024, 1024, 1024, 0}; pg8::Order S; S.init(MT / 256, DINP / 256, F.G, bx);
              pg8::EpiStoreBf16 E{(bf16_t*)(ws + WS_HW), DINP}; pg8::gemm_phase(F.lds, g, S, E); }
            { pg8::Gemm g{(const bf16_t*)(ws + WS_R4 + 68 * MiB), (const bf16_t*)wsel(ws, l, W_GL), 1024, 1024, 1024, 0}; pg8::Order S; S.init(MT / 256, NGL / 256, F.G, (bx + F.G / 2) % F.G);
              pg8::EpiGate E{ws + WS_G}; pg8::gemm_phase<pg8::EpiGate, true>(F.lds, g, S, E); } }
        if (!last && F.G == 256) {
            int q = 0, off = 0;
            if (bx < 128) { q = Q_INA; off = bx * Q_INA; } else if (bx >= 224) { q = Q_INC; off = 128 * Q_INA + 24 * Q_INB + (bx - 224) * Q_INC; } else if (bx >= 200) { q = Q_INB; off = 128 * Q_INA + (bx - 200) * Q_INB; }
            if (q) convert_tail(F, ka, l + 1, cur + 8 * off, q);
            cur += 8 * (128 * Q_INA + 24 * Q_INB + 32 * Q_INC); }
        GRID_BAR();
        for (int rep_ = 0; rep_ < REPS(5); ++rep_) if (PH(5)) { unsigned char* ws = ws_fresh(ka); pg8::Gemm g{(const bf16_t*)(ws + WS_HW) + C_CQ, (const bf16_t*)wsel(ws, l, W_UP), 384, DINP, 384, 0}; pg8::Order S; S.init(MT / 256, UW / 256, F.G, bx);
            pg8::EpiStoreBf16 E{(bf16_t*)(ws + WS_R4), UW}; pg8::gemm_phase(F.lds, g, S, E); }
        for (int rep_ = 0; rep_ < REPS(6); ++rep_) if (PH(6)) prep_phase(F, ka, l);
        GRID_BAR();
        for (int rep_ = 0; rep_ < REPS(7); ++rep_) if (PH(7)) prep2_phase(F, ka, l, rep_);
        GRID_BAR();
        for (int rep_ = 0; rep_ < REPS(8); ++rep_) if (PH(8)) attn_phase(F, ka, l);
        GRID_BAR();
        for (int rep_ = 0; rep_ < REPS(9); ++rep_) if (PH(9)) { unsigned char* ws = ws_fresh(ka); pg8::Order S; S.init(nMe, 4, F.G, bx);
          const unsigned char* OC = ws + WS_OCAT; bf16_t* MG = (bf16_t*)(ws + WS_MERGED); const unsigned char* GL = ws + WS_G;
          { pg8::Gemm3 g{OC, OC + 512, OC + 1024, wsel(ws, l, W_NAO), wsel(ws, l, W_MLAO), wsel(ws, l, W_SWAO), OCW, 512}; pg8::EpiMerge3 E{MG, GL}; pg8::gemm_phase3(F.lds, g, S, E); } }
        TAIL1(nMe * 4, Q_MRG);
        GRID_BAR();
        if (PH(10)) { unsigned char* ws = ws_fresh(ka); pg8::Gemm g{(const bf16_t*)(ws + WS_MERGED), (const bf16_t*)wsel(ws, l, W_O), 1024, 1024, 1024, 0}; pg8::Order S; S.init(nMe, 4, F.G, bx);
            pg8::EpiResid E{(bf16_t*)(ws + WS_XS), (const float*)(ws + WS_MODV) + (size_t)l * 9 * 6144 + 2 * 1024}; pg8::gemm_phase<pg8::EpiResid, true>(F.lds, g, S, E); }
        TAIL1(nMe * 4, Q_WO);
        GRID_BAR();
        for (int rep_ = 0; rep_ < REPS(11); ++rep_) if (PH(11)) norm2_phase(F, ka, l, last ? MLAT : MT);
        GRID_BAR();
        for (int rep_ = 0; rep_ < REPS(12); ++rep_) if (PH(12)) select_phase(F, ka, l);
        GRID_BAR();
        for (int rep_ = 0; rep_ < REPS(13); ++rep_) if (PH(13)) { unsigned char* ws = ws_fresh(ka); pg8::Gemm g{(const bf16_t*)(ws + WS_XG), (const bf16_t*)wsel(ws, l, W_GU), 1024, 1024, 1024, (size_t)2048 * 1024}; pg8::Order S; S.init(nMs, 8, F.G, bx, 1);
            pg8::EpiSwiglu E{ws + WS_ACT}; pg8::gemm_phase<pg8::EpiSwiglu, true>(F.lds, g, S, E); }
        TAIL1(nMs * 8, Q_GU);
        GRID_BAR();
        for (int rep_ = 0; rep_ < REPS(14); ++rep_) if (PH(14)) { unsigned char* ws = ws_fresh(ka); pg8::Gemm g{(const bf16_t*)(ws + WS_ACT), (const bf16_t*)wsel(ws, l, W_DN), 1024, 1024, 1024, (size_t)1024 * 1024}; pg8::Order S; S.init(nMs, 4, F.G, bx, 1);
            pg8::EpiDown E{(bf16_t*)(ws + WS_Y), (const float*)(ws + WS_GATE)}; pg8::gemm_phase<pg8::EpiDown, true>(F.lds, g, S, E); }
        TAIL1(nMs * 4, Q_DN);
        GRID_BAR();
        for (int rep_ = 0; rep_ < REPS(15); ++rep_) if (PH(15)) row_phase(F, ka, l + 1, rep_);
        if (!last) { for (int rep_ = 0; rep_ < REPS(16); ++rep_) if (PH(16)) convert_weights(F, ka, l + 1, cur); GRID_BAR(); }
    }
}

extern "C" void kernel_launch(void* const* d_in, const int* in_sizes, int n_in, void* d_out, int out_size, void* d_ws, size_t ws_size, hipStream_t stream) {
    static int grid = 0;
    if (grid == 0) {
        if (n_in != 29 || in_sizes[0] != MLAT * D || out_size != MLAT * D || ws_size < WS_END) {
            fprintf(stderr, "kernel_launch: unexpected problem: n_in %d in0 %d out %d ws %zu (need %zu)\n", n_in, n_in > 0 ? in_sizes[0] : -1, out_size, ws_size, (size_t)WS_END); grid = -1; return; }
        int dev = 0, cus = 0, per_cu = 0;
        if (hipGetDevice(&dev) != hipSuccess || hipDeviceGetAttribute(&cus, hipDeviceAttributeMultiprocessorCount, dev) != hipSuccess) { fprintf(stderr, "kernel_launch: device query failed\n"); grid = -1; return; }
        if (hipFuncSetAttribute((const void*)mega_fwd, hipFuncAttributeMaxDynamicSharedMemorySize, LDS_BYTES) != hipSuccess) { fprintf(stderr, "kernel_launch: hipFuncSetAttribute failed\n"); grid = -1; return; }
        if (hipOccupancyMaxActiveBlocksPerMultiprocessor(&per_cu, (const void*)mega_fwd, 512, LDS_BYTES) != hipSuccess || per_cu < 1) {
            fprintf(stderr, "kernel_launch: occupancy query reports %d workgroups per CU\n", per_cu); }
        (void)hipGetLastError();
        grid = cus;
    }
    if (grid < 0) return;
    if (hipMemsetAsync((char*)d_ws + WS_CTL, 0, CTL_BYTES, stream) != hipSuccess) { fprintf(stderr, "kernel_launch: memset failed\n"); return; }
    Args a{};
    for (int i = 0; i < 29; ++i) a.in[i] = (const float*)d_in[i];
    a.out = (float*)d_out; a.ws = (unsigned char*)d_ws;
    hipLaunchKernelGGL(mega_fwd, dim3(grid), dim3(512), LDS_BYTES, stream, a);
    const hipError_t le = hipPeekAtLastError();
    if (le != hipSuccess) fprintf(stderr, "kernel_launch: launch failed: %s\n", hipGetErrorName(le));
}
```

```cpp
#include <hip/hip_runtime.h>
#include <cstdio>
#include <cstdint>

#define DI __device__ __forceinline__
#ifndef PH_MASK
#define PH_MASK 0xFFFFF
#endif
#define PH(b) ((PH_MASK >> (b)) & 1)
#ifndef REP_MASK
#define REP_MASK 0
#endif
#define REPS(b) (1 + ((REP_MASK >> (b)) & 1))
#define LAS __attribute__((address_space(3)))
#define GAS __attribute__((address_space(1)))
typedef unsigned short bf16_t;
typedef short bf16x8 __attribute__((ext_vector_type(8)));
typedef short s16x4 __attribute__((ext_vector_type(4)));
typedef float f32x4 __attribute__((ext_vector_type(4)));
typedef float f32x2 __attribute__((ext_vector_type(2)));
typedef float f32x16 __attribute__((ext_vector_type(16)));
typedef unsigned u32x4 __attribute__((ext_vector_type(4)));
typedef unsigned u32x2 __attribute__((ext_vector_type(2)));
typedef int i32x8 __attribute__((ext_vector_type(8)));

constexpr int D = 1024, NB = 8, SEQ = 4096, NL = 4, CTX = 256;
constexpr int MLAT = NB * SEQ, MCTX = NB * CTX, MT = MLAT + MCTX;
constexpr int DIN = 5312, DINP = 2304, NGL = 3072;
constexpr int C_NAQ = 0, C_NAK = 384, C_NAV = 768, C_CQ = 1152, C_CKV = 1408, C_KR = 1536, C_SWQ = 1600, C_SWK = 1984, C_SWV = 2112, C_GL = 2240;
constexpr int UW = 1792;
constexpr int P1W = 1280;
constexpr int P2W = 1536;
constexpr int OCW = 1536;
constexpr int NE = 16, CAP_LAT = 512, CAP_CTX = 32;
constexpr int NSLOT_LAT = NB * NE * CAP_LAT, NSLOT = NSLOT_LAT + NB * NE * CAP_CTX;
constexpr float EPS = 1e-6f;
constexpr float LOG2E = 1.4426950408889634f;

constexpr size_t MiB = 1u << 20;
constexpr size_t WS_CTL = 0, CTL_BYTES = 1 * MiB;
constexpr size_t WS_MODV = 1 * MiB;
constexpr size_t WS_W = 2 * MiB;
constexpr size_t W_IN = 0, W_GL = 4718592  , W_UP = 11010048, W_NAO = 7864320  , W_MLAO = 13172736, W_SWAO = 8912896  , W_O = 15007744, W_GU = 17104896, W_DN = 84213760, W_END = 117768192;
constexpr size_t WS_XS = 115 * MiB, WS_W2 = 183 * MiB  ;
constexpr size_t WS_HW = 251 * MiB;
constexpr size_t WS_G = WS_HW + 153 * MiB;
constexpr size_t WS_P1 = 608 * MiB;
constexpr size_t WS_P2 = 693 * MiB;
constexpr size_t WS_R4 = 795 * MiB;
constexpr size_t WS_AFL = 914 * MiB;
constexpr size_t WS_AFC = 916 * MiB;
constexpr size_t WS_SMAP = 917 * MiB;
constexpr size_t WS_GATE = 920 * MiB;
constexpr size_t WS_OCAT = 921 * MiB;
constexpr size_t WS_END = 1006 * MiB;
constexpr size_t WS_MERGED = WS_P1;
constexpr size_t WS_H2 = WS_HW;
constexpr size_t WS_XG = WS_HW + 68 * MiB;
constexpr size_t WS_ACT = WS_HW + 204 * MiB;
constexpr size_t WS_Y = WS_HW + 340 * MiB;
static_assert(W_END <= 113 * MiB && WS_W + 113 * MiB <= WS_XS, "weights");
static_assert(W_GU + 64 * MiB <= W_DN && W_DN + 32 * MiB <= 113 * MiB && WS_XS + (size_t)MT * D * 2 <= WS_W2 && WS_W2 + W_GU <= WS_HW, "second weight buffers");
static_assert(WS_XS + (size_t)MT * D * 4 <= WS_HW && WS_HW + (size_t)MT * DINP * 2 <= WS_G && WS_G + (size_t)MT * NGL * 2 <= WS_P1 && WS_P1 + (size_t)MT * P1W * 2 <= WS_P2 && WS_P2 + (size_t)MT * P2W * 2 <= WS_R4, "map");
static_assert(WS_R4 + (size_t)MT * UW * 2 <= WS_AFL && WS_Y + (size_t)NSLOT * D * 2 <= WS_R4 && WS_SMAP + (size_t)16 * MT * 4 <= WS_GATE && WS_GATE + (size_t)NSLOT * 4 <= WS_OCAT && WS_OCAT + (size_t)MT * OCW <= WS_END, "map2");
constexpr int CW_BAR = 4096;

constexpr int RING_BYTES = 131072, LDSCTL_OFF = RING_BYTES, LDS_BYTES = 147456;

DI unsigned pk2(float lo, float hi) { unsigned r; asm("v_cvt_pk_bf16_f32 %0, %1, %2" : "=v"(r) : "v"(lo), "v"(hi)); return r; }
DI unsigned pk4_fp8(float a, float b, float c, float d) { int w = 0; w = __builtin_amdgcn_cvt_pk_fp8_f32(a, b, w, false); w = __builtin_amdgcn_cvt_pk_fp8_f32(c, d, w, true); return (unsigned)w; }
DI float bflo(unsigned w) { return __uint_as_float(w << 16); }
DI float bfhi(unsigned w) { return __uint_as_float(w & 0xffff0000u); }
DI float bf2f(bf16_t b) { return __uint_as_float((unsigned)b << 16); }
DI float wave_sum(float v) {
#pragma unroll
    for (int o = 1; o < 64; o <<= 1) v += __shfl_xor(v, o);
    return v;
}
DI float sigmoidf_(float x) { return __builtin_amdgcn_rcpf(1.0f + __builtin_amdgcn_exp2f(-x * LOG2E)); }
DI int mod_index(int row) { return row < MLAT ? (row >> 12) : 8; }

#define XB_TMO      128
#define XB_XCNT(j)  (256  + 64 * (j))
#define XB_XSUB(j)  (1280 + 64 * (j))
#define XB_XGEN(j)  (2304 + 64 * (j))
#define XB_TOP      3328
#define XB_TOPGEN   3392
#define XCD_BAR_WORDS 3456
#define XB_SPIN_CAP (1u << 18)
DI unsigned xb_ld(unsigned* p)              { return __hip_atomic_load(p, __ATOMIC_RELAXED, __HIP_MEMORY_SCOPE_AGENT); }
DI unsigned xb_add(unsigned* p, unsigned v) { return __hip_atomic_fetch_add(p, v, __ATOMIC_RELAXED, __HIP_MEMORY_SCOPE_AGENT); }
DI unsigned xb_xcc_id() { return (unsigned)__builtin_amdgcn_s_getreg((3 << 11) | 20) & 0xFu; }
#define XB_SPIN(cond, bar) do { unsigned _sp = 0; while (cond) { __builtin_amdgcn_s_sleep(1); \
    if ((++_sp & 255u) == 0u) { if (xb_ld(&(bar)[XB_TMO])) break; if (_sp > XB_SPIN_CAP) { atomicAdd(&(bar)[XB_TMO], 1u); break; } } } } while (0)
struct XcdBarrier { unsigned* bar; unsigned x; volatile LAS unsigned* st; };
DI XcdBarrier xcd_barrier_post(unsigned* bar, volatile LAS unsigned* st) {
    XcdBarrier b; b.bar = bar; b.x = xb_xcc_id(); b.st = st;
    if (threadIdx.x == 0) (void)xb_add(&bar[XB_XCNT(b.x)], 1u);
    return b;
}
DI void xcd_barrier_complete(unsigned* bar, unsigned x, unsigned& nloc, unsigned& nx) {
    const unsigned G = gridDim.x * gridDim.y * gridDim.z;
    unsigned sum, cnt, mine, sp = 0u;
    for (;;) {
        sum = 0u; cnt = 0u; mine = 0u;
#pragma unroll
        for (unsigned j = 0; j < 16; ++j) { const unsigned c = xb_ld(&bar[XB_XCNT(j)]); sum += c; cnt += (c > 0u) ? 1u : 0u; mine = (j == x) ? c : mine; }
        if (sum == G) break;
        __builtin_amdgcn_s_sleep(1);
        if ((++sp & 255u) == 0u) { if (xb_ld(&bar[XB_TMO])) break; if (sp > XB_SPIN_CAP) { atomicAdd(&bar[XB_TMO], 1u); break; } }
    }
    nloc = mine > 0u ? mine : 1u; nx = cnt > 0u ? cnt : 1u;
}
DI void xcd_barrier(const XcdBarrier& b) {
    asm volatile("s_waitcnt vmcnt(0)" ::: "memory");
    __syncthreads();
    if (threadIdx.x == 0) {
        unsigned* bar = b.bar; unsigned bx_ = b.x; asm volatile("" : "+s"(bar), "+s"(bx_));
        __builtin_amdgcn_s_waitcnt(0);
        unsigned nloc = b.st[0], nx = b.st[1];
        if (nloc == 0u) { xcd_barrier_complete(bar, bx_, nloc, nx); b.st[0] = nloc; b.st[1] = nx; }
        const unsigned old = xb_add(&bar[XB_XSUB(bx_)], 1u);
        const unsigned gen = old / nloc;
        if (old + 1u == (gen + 1u) * nloc) {
            __builtin_amdgcn_fence(__ATOMIC_RELEASE, "agent");
            asm volatile("s_waitcnt vmcnt(0)" ::: "memory");
            const unsigned og = xb_add(&bar[XB_TOP], 1u);
            const unsigned tg = og / nx;
            if (og + 1u == (tg + 1u) * nx) xb_add(&bar[XB_TOPGEN], 1u);
            else XB_SPIN(xb_ld(&bar[XB_TOPGEN]) == tg, bar);
            __builtin_amdgcn_fence(__ATOMIC_ACQUIRE, "agent");
            xb_add(&bar[XB_XGEN(bx_)], 1u);
            asm volatile("s_waitcnt vmcnt(0)" ::: "memory");
        } else {
            XB_SPIN(xb_ld(&bar[XB_XGEN(bx_)]) == gen, bar);
            __builtin_amdgcn_fence(__ATOMIC_ACQUIRE, "agent");
            asm volatile("s_waitcnt vmcnt(0)" ::: "memory");
        }
    }
    __syncthreads();
}

namespace pg8 {
constexpr int BM = 256, BK = 64, HALF = 128, HTB = HALF * BK * 2, NXCD = 8, WGM = 8;
__host__ __device__ __forceinline__ int lds_byte(int r, int c) { const int st = (r >> 4) * 2 + (c >> 5), rr = r & 15, cc = c & 31, ob = rr * 64 + cc * 2; return st * 1024 + (ob ^ (((ob >> 9) & 1) << 5)); }
__host__ __device__ __forceinline__ void stage_rc(int b, int& R, int& C) { const int st = b / 1024, sb = b % 1024, swz = sb ^ (((sb >> 9) & 1) << 5); R = (st >> 1) * 16 + swz / 64; C = (st & 1) * 32 + (swz % 64) / 2; }
__host__ __device__ __forceinline__ int perm32(int rho) { const int n = rho >> 4, i = rho & 15; return 8 * (i >> 2) + 4 * n + (i & 3); }
struct Unit { int pm, pn; };
struct Gemm { const bf16_t* A; const bf16_t* Bt; int K, lda, ldb; size_t estride; };
struct Order {
    int nM, nN, nwg, G, c, moe;
    DI void init(int nM_, int nN_, int G_, int c_, int moe_ = 0) { nM = nM_; nN = nN_; nwg = nM * nN; G = G_; c = c_; moe = moe_; }
    DI bool next(int i, Unit& u) const {
        const long L = (long)i * G + c; if (L >= nwg) return false;
        int wgid = (int)L; { const int q = nwg / NXCD, r = nwg % NXCD, xcd = wgid % NXCD, off = wgid / NXCD; wgid = (xcd < r ? xcd * (q + 1) : r * (q + 1) + (xcd - r) * q) + off; }
        const int nig = WGM * nN, gid = wgid / nig, fm = gid * WGM, gsz = (nM - fm) < WGM ? (nM - fm) : WGM;
        u.pm = fm + ((wgid % nig) % gsz); u.pn = (wgid % nig) / gsz;
        if (moe && u.pm < 256) { const int e = u.pm >> 4, b = (u.pm >> 1) & 7, hf = u.pm & 1; u.pm = (((b << 4) | e) << 1) | hf; }
        return true;
    }
};
struct EpiStoreBf16 {
    static constexpr bool PERM = true;
    bf16_t* O; int ldc;
    DI void operator()(const f32x4 (&acc)[2][2][4][2], const Unit& u, int wr, int wc, int fr, int fq) const {
        const int row0 = u.pm * BM + wr * 64 + fr, col0 = u.pn * BM + wc * 32 + 8 * fq;
#pragma unroll
        for (int ai = 0; ai < 2; ++ai)
#pragma unroll
            for (int m = 0; m < 4; ++m) { bf16_t* rowp = O + (size_t)(row0 + ai * HALF + m * 16) * ldc + col0;
#pragma unroll
                for (int bj = 0; bj < 2; ++bj) { const f32x4 v0 = acc[ai][bj][m][0], v1 = acc[ai][bj][m][1];
                    u32x4 w; w.x = pk2(v0[0], v0[1]); w.y = pk2(v0[2], v0[3]); w.z = pk2(v1[0], v1[1]); w.w = pk2(v1[2], v1[3]);
                    *(u32x4*)(rowp + bj * HALF) = w; } }
    }
};
DI unsigned pk4_u8(float a, float b, float c, float d) {
    unsigned ua = (unsigned)(a * 255.0f + 0.5f), ub = (unsigned)(b * 255.0f + 0.5f), uc = (unsigned)(c * 255.0f + 0.5f), ud = (unsigned)(d * 255.0f + 0.5f);
    ua = ua < 1u ? 1u : ua; ub = ub < 1u ? 1u : ub; uc = uc < 1u ? 1u : uc; ud = ud < 1u ? 1u : ud;
    return ua | (ub << 8) | (uc << 16) | (ud << 24);
}
struct EpiGate {
    static constexpr bool PERM = true;
    unsigned char* O;
    DI void operator()(const f32x4 (&acc)[2][2][4][2], const Unit& u, int wr, int wc, int fr, int fq) const {
        const int row0 = u.pm * BM + wr * 64 + fr, col0 = u.pn * BM + wc * 32 + 8 * fq;
#pragma unroll
        for (int ai = 0; ai < 2; ++ai)
#pragma unroll
            for (int m = 0; m < 4; ++m) { unsigned char* rowp = O + (size_t)(row0 + ai * HALF + m * 16) * NGL + col0;
#pragma unroll
                for (int bj = 0; bj < 2; ++bj) { const f32x4 v0 = acc[ai][bj][m][0] * 0.03125f, v1 = acc[ai][bj][m][1] * 0.03125f;
                    u32x2 w; w.x = pk4_u8(sigmoidf_(v0[0]), sigmoidf_(v0[1]), sigmoidf_(v0[2]), sigmoidf_(v0[3])); w.y = pk4_u8(sigmoidf_(v1[0]), sigmoidf_(v1[1]), sigmoidf_(v1[2]), sigmoidf_(v1[3]));
                    *(u32x2*)(rowp + bj * HALF) = w; } }
    }
};
DI float u8f(unsigned w, int k) { return (float)((w >> (8 * k)) & 0xffu) * (1.0f / 255.0f); }
struct EpiMerge {
    static constexpr bool PERM = true;
    bf16_t* O; const unsigned char* gl; int first;
    DI void operator()(const f32x4 (&acc)[2][2][4][2], const Unit& u, int wr, int wc, int fr, int fq) const {
        const int row0 = u.pm * BM + wr * 64 + fr, col0 = u.pn * BM + wc * 32 + 8 * fq;
#pragma unroll
        for (int ai = 0; ai < 2; ++ai) {
            u32x2 g[4][2]; u32x4 p[4][2];
#pragma unroll
            for (int m = 0; m < 4; ++m)
#pragma unroll
                for (int bj = 0; bj < 2; ++bj) { const int row = row0 + ai * HALF + m * 16, col = col0 + bj * HALF;
                    g[m][bj] = *(const u32x2*)(gl + (size_t)row * NGL + col);
                    p[m][bj] = first ? (u32x4){0u, 0u, 0u, 0u} : *(const u32x4*)(O + (size_t)row * D + col); }
#pragma unroll
            for (int m = 0; m < 4; ++m)
#pragma unroll
                for (int bj = 0; bj < 2; ++bj) { const int row = row0 + ai * HALF + m * 16, col = col0 + bj * HALF;
                    const u32x2 gg = g[m][bj]; const u32x4 pp = p[m][bj]; const f32x4 v0 = acc[ai][bj][m][0], v1 = acc[ai][bj][m][1];
                    const float r0 = v0[0] * u8f(gg.x, 0) + bflo(pp.x), r1 = v0[1] * u8f(gg.x, 1) + bfhi(pp.x), r2 = v0[2] * u8f(gg.x, 2) + bflo(pp.y), r3 = v0[3] * u8f(gg.x, 3) + bfhi(pp.y);
                    const float r4 = v1[0] * u8f(gg.y, 0) + bflo(pp.z), r5 = v1[1] * u8f(gg.y, 1) + bfhi(pp.z), r6 = v1[2] * u8f(gg.y, 2) + bflo(pp.w), r7 = v1[3] * u8f(gg.y, 3) + bfhi(pp.w);
                    u32x4 w; w.x = pk2(r0, r1); w.y = pk2(r2, r3); w.z = pk2(r4, r5); w.w = pk2(r6, r7);
                    *(u32x4*)(O + (size_t)row * D + col) = w; }
        }
    }
};
struct EpiResid {
    static constexpr bool PERM = true;
    bf16_t* xs; const float* modg;
    DI void operator()(const f32x4 (&acc)[2][2][4][2], const Unit& u, int wr, int wc, int fr, int fq) const {
        const int row0 = u.pm * BM + wr * 64 + fr, col0 = u.pn * BM + wc * 32 + 8 * fq;
        const float* mp = modg + (size_t)mod_index(u.pm * BM) * 6144 + col0;
        f32x4 g0[2], g1[2];
#pragma unroll
        for (int bj = 0; bj < 2; ++bj) { g0[bj] = *(const f32x4*)(mp + bj * HALF) * (1.0f / 128.0f); g1[bj] = *(const f32x4*)(mp + bj * HALF + 4) * (1.0f / 128.0f); }
#pragma unroll
        for (int ai = 0; ai < 2; ++ai)
#pragma unroll
            for (int mh = 0; mh < 2; ++mh) {
                u32x4 xw[2][2];
#pragma unroll
                for (int m2 = 0; m2 < 2; ++m2)
#pragma unroll
                    for (int bj = 0; bj < 2; ++bj) xw[m2][bj] = *(const u32x4*)(xs + (size_t)(row0 + ai * HALF + (2 * mh + m2) * 16) * D + col0 + bj * HALF);
#pragma unroll
                for (int m2 = 0; m2 < 2; ++m2)
#pragma unroll
                    for (int bj = 0; bj < 2; ++bj) { const int m = 2 * mh + m2; const u32x4 x = xw[m2][bj];
                        const f32x4 x0 = (f32x4){bflo(x.x), bfhi(x.x), bflo(x.y), bfhi(x.y)} + g0[bj] * acc[ai][bj][m][0];
                        const f32x4 x1 = (f32x4){bflo(x.z), bfhi(x.z), bflo(x.w), bfhi(x.w)} + g1[bj] * acc[ai][bj][m][1];
                        u32x4 w; w.x = pk2(x0[0], x0[1]); w.y = pk2(x0[2], x0[3]); w.z = pk2(x1[0], x1[1]); w.w = pk2(x1[2], x1[3]);
                        *(u32x4*)(xs + (size_t)(row0 + ai * HALF + m * 16) * D + col0 + bj * HALF) = w; }
            }
    }
};
struct EpiSwiglu {
    static constexpr bool PERM = true;
    unsigned char* O;
    DI void operator()(const f32x4 (&acc)[2][2][4][2], const Unit& u, int wr, int wc, int fr, int fq) const {
        const int row0 = u.pm * BM + wr * 64 + fr, col0 = u.pn * HALF + wc * 32 + 8 * fq;
#pragma unroll
        for (int ai = 0; ai < 2; ++ai)
#pragma unroll
            for (int m = 0; m < 4; ++m) { const int row = row0 + ai * HALF + m * 16;
                const f32x4 a0 = acc[ai][0][m][0] * 0.03125f, a1 = acc[ai][0][m][1] * 0.03125f, u0 = acc[ai][1][m][0] * 0.25f, u1 = acc[ai][1][m][1] * 0.25f;
                float r[8];
#pragma unroll
                for (int j = 0; j < 4; ++j) { r[j] = a0[j] * sigmoidf_(a0[j]) * u0[j]; r[4 + j] = a1[j] * sigmoidf_(a1[j]) * u1[j]; }
                u32x2 w; w.x = pk4_fp8(r[0], r[1], r[2], r[3]); w.y = pk4_fp8(r[4], r[5], r[6], r[7]);
                *(u32x2*)(O + (size_t)row * D + col0) = w; }
    }
};
struct EpiDown {
    static constexpr bool PERM = true;
    bf16_t* O; const float* gate;
    DI void operator()(const f32x4 (&acc)[2][2][4][2], const Unit& u, int wr, int wc, int fr, int fq) const {
        const int row0 = u.pm * BM + wr * 64 + fr, col0 = u.pn * BM + wc * 32 + 8 * fq;
        float gv[2][4];
#pragma unroll
        for (int ai = 0; ai < 2; ++ai)
#pragma unroll
            for (int m = 0; m < 4; ++m) gv[ai][m] = gate[row0 + ai * HALF + m * 16] * (1.0f / 256.0f);
#pragma unroll
        for (int ai = 0; ai < 2; ++ai)
#pragma unroll
            for (int m = 0; m < 4; ++m) { const int row = row0 + ai * HALF + m * 16; const float g = gv[ai][m]; bf16_t* rowp = O + (size_t)row * D + col0;
#pragma unroll
                for (int bj = 0; bj < 2; ++bj) { const f32x4 v0 = acc[ai][bj][m][0] * g, v1 = acc[ai][bj][m][1] * g;
                    u32x4 w; w.x = pk2(v0[0], v0[1]); w.y = pk2(v0[2], v0[3]); w.z = pk2(v1[0], v1[1]); w.w = pk2(v1[2], v1[3]);
                    *(u32x4*)(rowp + bj * HALF) = w; } }
    }
};

struct EpiMerge3 {
    static constexpr bool PERM = true;
    bf16_t* O; const unsigned char* gl;
    DI void operator()(f32x4 (&acc)[2][2][4][2], const Unit& u, int seg, int wr, int wc, int fr, int fq) const {
        const int row0 = u.pm * BM + wr * 64 + fr, col0 = u.pn * BM + wc * 32 + 8 * fq;
#pragma unroll
        for (int ai = 0; ai < 2; ++ai) {
            u32x2 ga[4][2], gb[4][2];
#pragma unroll
            for (int m = 0; m < 4; ++m)
#pragma unroll
                for (int bj = 0; bj < 2; ++bj) { const unsigned char* gp = gl + (size_t)(row0 + ai * HALF + m * 16) * NGL + 1024 * seg + col0 + bj * HALF;
                    ga[m][bj] = *(const u32x2*)gp; gb[m][bj] = seg < 2 ? *(const u32x2*)(gp + 1024) : (u32x2){0u, 0u}; }
#pragma unroll
            for (int m = 0; m < 4; ++m)
#pragma unroll
                for (int bj = 0; bj < 2; ++bj) {
                    f32x4 s0, s1;
#pragma unroll
                    for (int k = 0; k < 4; ++k) { const float a0 = (float)((ga[m][bj].x >> (8 * k)) & 0xffu), a1 = (float)((ga[m][bj].y >> (8 * k)) & 0xffu);
                        if (seg < 2) { const float b0 = (float)((gb[m][bj].x >> (8 * k)) & 0xffu), b1 = (float)((gb[m][bj].y >> (8 * k)) & 0xffu); s0[k] = a0 * __builtin_amdgcn_rcpf(b0); s1[k] = a1 * __builtin_amdgcn_rcpf(b1); }
                        else { s0[k] = a0 * (1.0f / (255.0f * 128.0f)); s1[k] = a1 * (1.0f / (255.0f * 128.0f)); } }
                    acc[ai][bj][m][0] *= s0; acc[ai][bj][m][1] *= s1;
                    if (seg == 2) { const f32x4 v0 = acc[ai][bj][m][0] * 4.0f, v1 = acc[ai][bj][m][1] * 4.0f;
                        u32x2 w; w.x = pk4_fp8(v0[0], v0[1], v0[2], v0[3]); w.y = pk4_fp8(v1[0], v1[1], v1[2], v1[3]);
                        *(u32x2*)((unsigned char*)O + (size_t)(row0 + ai * HALF + m * 16) * D + col0 + bj * HALF) = w; }
                }
        }
    }
};
struct Gemm3 { const unsigned char* A0; const unsigned char* A1; const unsigned char* A2; const unsigned char* B0; const unsigned char* B1; const unsigned char* B2; int lda, ldb; };
template <class Epi>
DI void gemm_phase3(LAS unsigned char* lds, const Gemm3 g, const Order& S, const Epi& E) {
    int tid_ = threadIdx.x; asm volatile("" : "+v"(tid_));
    const int tid = tid_, wid = __builtin_amdgcn_readfirstlane(tid >> 6), lane = tid & 63, wr = wid >> 2, wc = wid & 3, fr = lane & 15, fq = lane >> 4;
    unsigned voffA[2], voffB[2];
#pragma unroll
    for (int i = 0; i < 2; ++i) { int R, C; stage_rc(tid * 16 + i * 8192, R, C); const int Rb = Epi::PERM ? ((R & ~31) + perm32(R & 31)) : R;
        voffA[i] = (unsigned)(R * g.lda + C * 2); voffB[i] = (unsigned)(Rb * g.ldb + C * 2); }
    const size_t kstep = (size_t)(BK * 2);
    const size_t hstepA = (size_t)HALF * g.lda, hstepB = (size_t)HALF * g.ldb;
    const size_t tstepA = 2 * hstepA, tstepB = 2 * hstepB;
    const unsigned ldsw = (unsigned)wid * 1024u;
    const int aoff = lds_byte(wr * 64 + fr, fq * 8), boff = lds_byte(wc * 32 + fr, fq * 8);
#define PG8_SA(b, h) (((b) * 2 + (h)) * HTB)
#define PG8_SB(b, h) ((4 + (b) * 2 + (h)) * HTB)
#define PG8_STAGE(bufoff, gbase, voff) do { _Pragma("unroll") for (int _i = 0; _i < 2; ++_i) \
        __builtin_amdgcn_global_load_lds((const unsigned*)((const char*)(gbase) + (voff)[_i]), (LAS unsigned*)(lds + (bufoff) + ldsw + _i * 8192), 16, 0, 0); } while (0)
#define PG8_LDA(dst, b, h) do { _Pragma("unroll") for (int m = 0; m < 4; ++m) _Pragma("unroll") for (int k = 0; k < 2; ++k) dst[m][k] = *(const LAS bf16x8*)(lds + PG8_SA(b, h) + aoff + m * 2048 + k * 1024); } while (0)
#define PG8_LDB(dst, b, h) do { _Pragma("unroll") for (int n = 0; n < 2; ++n) _Pragma("unroll") for (int k = 0; k < 2; ++k) dst[n][k] = *(const LAS bf16x8*)(lds + PG8_SB(b, h) + boff + n * 2048 + k * 1024); } while (0)
#define PG8_MMA(ai, bj, At, Bt) do { __builtin_amdgcn_s_setprio(1); _Pragma("unroll") for (int m = 0; m < 4; ++m) _Pragma("unroll") for (int n = 0; n < 2; ++n) { \
        const i32x8 bb_ = __builtin_bit_cast(i32x8, __builtin_shufflevector(Bt[n][0], Bt[n][1], 0, 1, 2, 3, 4, 5, 6, 7, 8, 9, 10, 11, 12, 13, 14, 15)); \
        const i32x8 aa_ = __builtin_bit_cast(i32x8, __builtin_shufflevector(At[m][0], At[m][1], 0, 1, 2, 3, 4, 5, 6, 7, 8, 9, 10, 11, 12, 13, 14, 15)); \
        asm volatile("v_mfma_scale_f32_16x16x128_f8f6f4 %0, %1, %2, %0, %3, %3 op_sel_hi:[0,0,0]" : "+v"(acc[ai][bj][m][n]) : "v"(bb_), "v"(aa_), "v"(0x7F7F7F7F)); } \
        __builtin_amdgcn_s_setprio(0); } while (0)
#define PG8_WAIT_V(n) asm volatile("s_waitcnt vmcnt(" #n ")" ::: "memory")
#define PG8_WAIT_L(n) asm volatile("s_waitcnt lgkmcnt(" #n ")" ::: "memory")
#define PG8_BAR __builtin_amdgcn_s_barrier()
#define PG8_SCHED __builtin_amdgcn_sched_barrier(0)
#define PG8_A3(sg, u) ((const char*)((sg) == 0 ? g.A0 : (sg) == 1 ? g.A1 : g.A2) + (size_t)(u).pm * tstepA)
#define PG8_B3(sg, u) ((const char*)((sg) == 0 ? g.B0 : (sg) == 1 ? g.B1 : g.B2) + (size_t)(u).pn * tstepB)
    Unit cur, nu; int ui = 0, seg = 0;
    if (!S.next(0, cur)) return;
    f32x4 acc[2][2][4][2];
#pragma unroll
    for (int a = 0; a < 2; ++a)
#pragma unroll
        for (int b = 0; b < 2; ++b)
#pragma unroll
            for (int m = 0; m < 4; ++m)
#pragma unroll
                for (int n = 0; n < 2; ++n) acc[a][b][m][n] = (f32x4){0.f, 0.f, 0.f, 0.f};
    bf16x8 At[4][2], B0[2][2], B1[2][2];
    const char* cA = PG8_A3(0, cur); const char* cB = PG8_B3(0, cur);
    PG8_STAGE(PG8_SB(0, 0), cB, voffB); PG8_STAGE(PG8_SB(0, 1), cB + hstepB, voffB); PG8_STAGE(PG8_SA(0, 0), cA, voffA); PG8_STAGE(PG8_SA(0, 1), cA + hstepA, voffA);
    if (wr == 1) PG8_BAR;
    PG8_WAIT_V(2); PG8_BAR;
    PG8_STAGE(PG8_SB(1, 0), cB + kstep, voffB); PG8_STAGE(PG8_SA(1, 0), cA + kstep, voffA); PG8_STAGE(PG8_SB(1, 1), cB + hstepB + kstep, voffB);
    PG8_WAIT_V(6); PG8_BAR;
    for (;;) {
        int nseg = seg + 1; bool has_next = true; nu = cur;
        if (nseg == 3) { nseg = 0; has_next = S.next(ui + 1, nu); }
        const char* nA = has_next ? PG8_A3(nseg, nu) : cA; const char* nB = has_next ? PG8_B3(nseg, nu) : cB;
        int nt_ = 4; asm volatile("" : "+s"(nt_));
        const int nt = nt_;
#pragma nounroll
        for (int t = 0; t < nt; t += 2) {
            const bool last = (t == nt - 2);
            const char* a1 = cA + (size_t)(t + 1) * kstep;
            const char* a2 = last ? nA : cA + (size_t)(t + 2) * kstep; const char* b2 = last ? nB : cB + (size_t)(t + 2) * kstep;
            const char* a3 = a2 + kstep; const char* b3 = b2 + kstep;
            PG8_LDB(B0, 0, 0); PG8_LDB(B1, 0, 1); PG8_SCHED; PG8_LDA(At, 0, 0); PG8_STAGE(PG8_SA(1, 1), a1 + hstepA, voffA);
            PG8_WAIT_V(8); PG8_WAIT_L(0); PG8_BAR; PG8_MMA(0, 0, At, B0); PG8_MMA(0, 1, At, B1); PG8_BAR; PG8_SCHED;
            PG8_LDA(At, 0, 1); PG8_STAGE(PG8_SB(0, 0), b2, voffB); PG8_STAGE(PG8_SB(0, 1), b2 + hstepB, voffB); PG8_STAGE(PG8_SA(0, 0), a2, voffA);
            PG8_WAIT_V(8); PG8_WAIT_L(0); PG8_BAR; PG8_MMA(1, 0, At, B0); PG8_MMA(1, 1, At, B1); PG8_BAR; PG8_SCHED;
            PG8_LDB(B0, 1, 0); PG8_LDB(B1, 1, 1); PG8_SCHED; PG8_LDA(At, 1, 0); PG8_STAGE(PG8_SA(0, 1), a2 + hstepA, voffA);
            PG8_WAIT_V(8); PG8_WAIT_L(0); PG8_BAR; PG8_MMA(0, 0, At, B0); PG8_MMA(0, 1, At, B1); PG8_BAR; PG8_SCHED;
            PG8_LDA(At, 1, 1); PG8_STAGE(PG8_SB(1, 0), b3, voffB); PG8_STAGE(PG8_SB(1, 1), b3 + hstepB, voffB); PG8_STAGE(PG8_SA(1, 0), a3, voffA);
            PG8_WAIT_V(8); PG8_WAIT_L(0); PG8_BAR; PG8_MMA(1, 0, At, B0); PG8_MMA(1, 1, At, B1); PG8_BAR; PG8_SCHED;
        }
        if (wr == 0) PG8_BAR;
        E(acc, cur, seg, wr, wc, fr, fq);
        if (!has_next) break;
        if (seg == 2) {
#pragma unroll
            for (int a = 0; a < 2; ++a)
#pragma unroll
                for (int b = 0; b < 2; ++b)
#pragma unroll
                    for (int m = 0; m < 4; ++m)
#pragma unroll
                        for (int n = 0; n < 2; ++n) acc[a][b][m][n] = (f32x4){0.f, 0.f, 0.f, 0.f};
            cur = nu; ++ui;
        }
        seg = nseg; cA = nA; cB = nB;
        if (wr == 1) PG8_BAR;
    }
    PG8_WAIT_V(0);
    PG8_BAR;
#undef PG8_SA
#undef PG8_SB
#undef PG8_STAGE
#undef PG8_LDA
#undef PG8_LDB
#undef PG8_MMA
#undef PG8_WAIT_V
#undef PG8_WAIT_L
#undef PG8_BAR
#undef PG8_SCHED
#undef PG8_A3
#undef PG8_B3
}

template <class Epi, bool FP8 = false>
DI void gemm_phase(LAS unsigned char* lds, const Gemm g, const Order& S, const Epi& E) {
    constexpr int ESZ = FP8 ? 1 : 2;
    int tid_ = threadIdx.x; asm volatile("" : "+v"(tid_));
    const int tid = tid_, wid = __builtin_amdgcn_readfirstlane(tid >> 6), lane = tid & 63, wr = wid >> 2, wc = wid & 3, fr = lane & 15, fq = lane >> 4;
    const int K = g.K, nt = K * ESZ / (BK * 2);
    unsigned voffA[2], voffB[2];
#pragma unroll
    for (int i = 0; i < 2; ++i) { int R, C; stage_rc(tid * 16 + i * 8192, R, C); const int Rb = Epi::PERM ? ((R & ~31) + perm32(R & 31)) : R;
        voffA[i] = (unsigned)(R * g.lda * ESZ + C * 2); voffB[i] = (unsigned)(Rb * g.ldb * ESZ + C * 2); }
    const size_t kstep = (size_t)(BK * 2);
    const size_t hstepA = (size_t)HALF * g.lda * ESZ, hstepB = (size_t)HALF * g.ldb * ESZ;
    const size_t tstepA = 2 * hstepA, tstepB = 2 * hstepB;
    const unsigned ldsw = (unsigned)wid * 1024u;
    const int aoff = lds_byte(wr * 64 + fr, fq * 8), boff = lds_byte(wc * 32 + fr, fq * 8);
#define PG8_SA(b, h) (((b) * 2 + (h)) * HTB)
#define PG8_SB(b, h) ((4 + (b) * 2 + (h)) * HTB)
#define PG8_STAGE(bufoff, gbase, voff) do { _Pragma("unroll") for (int _i = 0; _i < 2; ++_i) \
        __builtin_amdgcn_global_load_lds((const unsigned*)((const char*)(gbase) + (voff)[_i]), (LAS unsigned*)(lds + (bufoff) + ldsw + _i * 8192), 16, 0, 0); } while (0)
#define PG8_LDA(dst, b, h) do { _Pragma("unroll") for (int m = 0; m < 4; ++m) _Pragma("unroll") for (int k = 0; k < 2; ++k) dst[m][k] = *(const LAS bf16x8*)(lds + PG8_SA(b, h) + aoff + m * 2048 + k * 1024); } while (0)
#define PG8_LDB(dst, b, h) do { _Pragma("unroll") for (int n = 0; n < 2; ++n) _Pragma("unroll") for (int k = 0; k < 2; ++k) dst[n][k] = *(const LAS bf16x8*)(lds + PG8_SB(b, h) + boff + n * 2048 + k * 1024); } while (0)
#define PG8_MMA(ai, bj, At, Bt) do { __builtin_amdgcn_s_setprio(1); _Pragma("unroll") for (int m = 0; m < 4; ++m) _Pragma("unroll") for (int n = 0; n < 2; ++n) { \
        if constexpr (FP8) { const i32x8 bb_ = __builtin_bit_cast(i32x8, __builtin_shufflevector(Bt[n][0], Bt[n][1], 0, 1, 2, 3, 4, 5, 6, 7, 8, 9, 10, 11, 12, 13, 14, 15)); \
            const i32x8 aa_ = __builtin_bit_cast(i32x8, __builtin_shufflevector(At[m][0], At[m][1], 0, 1, 2, 3, 4, 5, 6, 7, 8, 9, 10, 11, 12, 13, 14, 15)); \
            asm volatile("v_mfma_scale_f32_16x16x128_f8f6f4 %0, %1, %2, %0, %3, %3 op_sel_hi:[0,0,0]" : "+v"(acc[ai][bj][m][n]) : "v"(bb_), "v"(aa_), "v"(0x7F7F7F7F)); } \
        else { _Pragma("unroll") for (int k = 0; k < 2; ++k) acc[ai][bj][m][n] = __builtin_amdgcn_mfma_f32_16x16x32_bf16(Bt[n][k], At[m][k], acc[ai][bj][m][n], 0, 0, 0); } } \
        __builtin_amdgcn_s_setprio(0); } while (0)
#define PG8_WAIT_V(n) asm volatile("s_waitcnt vmcnt(" #n ")" ::: "memory")
#define PG8_WAIT_L(n) asm volatile("s_waitcnt lgkmcnt(" #n ")" ::: "memory")
#define PG8_BAR __builtin_amdgcn_s_barrier()
#define PG8_SCHED __builtin_amdgcn_sched_barrier(0)
#define PG8_EXPERT(pm) ((pm) < 256 ? (((pm) >> 1) & 15) : ((pm) - 256))
#define PG8_ABASE(u) ((const char*)g.A + (size_t)(u).pm * tstepA)
#define PG8_BBASE(u) ((const char*)g.Bt + (size_t)PG8_EXPERT((u).pm) * g.estride * ESZ + (size_t)(u).pn * tstepB)
    Unit cur, nxt; int ui = 0;
    if (!S.next(0, cur)) return;
    f32x4 acc[2][2][4][2];
#pragma unroll
    for (int a = 0; a < 2; ++a)
#pragma unroll
        for (int b = 0; b < 2; ++b)
#pragma unroll
            for (int m = 0; m < 4; ++m)
#pragma unroll
                for (int n = 0; n < 2; ++n) acc[a][b][m][n] = (f32x4){0.f, 0.f, 0.f, 0.f};
    bf16x8 At[4][2], B0[2][2], B1[2][2];
    const char* cA = PG8_ABASE(cur); const char* cB = PG8_BBASE(cur);
    PG8_STAGE(PG8_SB(0, 0), cB, voffB); PG8_STAGE(PG8_SB(0, 1), cB + hstepB, voffB); PG8_STAGE(PG8_SA(0, 0), cA, voffA); PG8_STAGE(PG8_SA(0, 1), cA + hstepA, voffA);
    if (wr == 1) PG8_BAR;
    PG8_WAIT_V(2); PG8_BAR;
    PG8_STAGE(PG8_SB(1, 0), cB + kstep, voffB); PG8_STAGE(PG8_SA(1, 0), cA + kstep, voffA); PG8_STAGE(PG8_SB(1, 1), cB + hstepB + kstep, voffB);
    PG8_WAIT_V(6); PG8_BAR;
    for (;;) {
        const bool has_next = S.next(ui + 1, nxt);
        const char* nA = has_next ? PG8_ABASE(nxt) : cA; const char* nB = has_next ? PG8_BBASE(nxt) : cB;
#pragma nounroll
        for (int t = 0; t < nt; t += 2) {
            const bool last = (t == nt - 2);
            const char* a1 = cA + (size_t)(t + 1) * kstep;
            const char* a2 = last ? nA : cA + (size_t)(t + 2) * kstep; const char* b2 = last ? nB : cB + (size_t)(t + 2) * kstep;
            const char* a3 = a2 + kstep; const char* b3 = b2 + kstep;
            PG8_LDB(B0, 0, 0); PG8_LDB(B1, 0, 1); PG8_SCHED; PG8_LDA(At, 0, 0); PG8_STAGE(PG8_SA(1, 1), a1 + hstepA, voffA);
            PG8_WAIT_V(8); PG8_WAIT_L(0); PG8_BAR; PG8_MMA(0, 0, At, B0); PG8_MMA(0, 1, At, B1); PG8_BAR; PG8_SCHED;
            PG8_LDA(At, 0, 1); PG8_STAGE(PG8_SB(0, 0), b2, voffB); PG8_STAGE(PG8_SB(0, 1), b2 + hstepB, voffB); PG8_STAGE(PG8_SA(0, 0), a2, voffA);
            PG8_WAIT_V(8); PG8_WAIT_L(0); PG8_BAR; PG8_MMA(1, 0, At, B0); PG8_MMA(1, 1, At, B1); PG8_BAR; PG8_SCHED;
            PG8_LDB(B0, 1, 0); PG8_LDB(B1, 1, 1); PG8_SCHED; PG8_LDA(At, 1, 0); PG8_STAGE(PG8_SA(0, 1), a2 + hstepA, voffA);
            PG8_WAIT_V(8); PG8_WAIT_L(0); PG8_BAR; PG8_MMA(0, 0, At, B0); PG8_MMA(0, 1, At, B1); PG8_BAR; PG8_SCHED;
            PG8_LDA(At, 1, 1); PG8_STAGE(PG8_SB(1, 0), b3, voffB); PG8_STAGE(PG8_SB(1, 1), b3 + hstepB, voffB); PG8_STAGE(PG8_SA(1, 0), a3, voffA);
            PG8_WAIT_V(8); PG8_WAIT_L(0); PG8_BAR; PG8_MMA(1, 0, At, B0); PG8_MMA(1, 1, At, B1); PG8_BAR; PG8_SCHED;
        }
        if (wr == 0) PG8_BAR;
        E(acc, cur, wr, wc, fr, fq);
        if (!has_next) break;
#pragma unroll
        for (int a = 0; a < 2; ++a)
#pragma unroll
            for (int b = 0; b < 2; ++b)
#pragma unroll
                for (int m = 0; m < 4; ++m)
#pragma unroll
                    for (int n = 0; n < 2; ++n) acc[a][b][m][n] = (f32x4){0.f, 0.f, 0.f, 0.f};
        cur = nxt; cA = nA; cB = nB; ++ui;
        if (wr == 1) PG8_BAR;
    }
    PG8_WAIT_V(0);
    PG8_BAR;
#undef PG8_SA
#undef PG8_SB
#undef PG8_STAGE
#undef PG8_LDA
#undef PG8_LDB
#undef PG8_MMA
#undef PG8_WAIT_V
#undef PG8_WAIT_L
#undef PG8_BAR
#undef PG8_SCHED
}
}

struct Args { const float* in[29]; float* out; unsigned char* ws; };
typedef const __attribute__((address_space(4))) Args* KArgs;
#define KA_FRESH(ka) asm volatile("" : "+s"(ka))
enum { I_X = 0, I_C, I_CTX, I_CCTX, I_N1G, I_N2G, I_WADA, I_BADA, I_WIN, I_NAQG, I_NAKG, I_RPB, I_MQN, I_WUQ, I_MKVN, I_WUKV, I_MQG, I_MKG, I_SWQG, I_SWKG, I_SINK,
       I_WNAO, I_WMLAO, I_WSWAO, I_WO, I_ROUTER, I_WGATE, I_WUP, I_WDOWN };
struct Frame {
    LAS unsigned char* lds;
    int tid, lane, wave, G, vcu, gw, ngw;
};

DI void frame_fresh(Frame& F) { int t = F.tid, w = F.wave, v = F.vcu; asm volatile("" : "+v"(t), "+s"(w), "+s"(v)); F.tid = t; F.lane = t & 63; F.wave = w; F.vcu = v; F.gw = v * 8 + w; }
DI void modv_phase(Frame& F, KArgs ka) {
    KA_FRESH(ka); const __attribute__((address_space(4))) Args& a = *ka; frame_fresh(F);
    LAS float* cact = (LAS float*)F.lds;
    LAS float* red = (LAS float*)(F.lds + 9 * 1024 * 4);
    const float* c = a.in[I_C]; const float* cc = a.in[I_CCTX];
    for (int i = F.tid; i < 9 * 1024; i += 512) { const float v = i < 8192 ? c[i] : cc[i - 8192]; cact[i] = v * sigmoidf_(v); }
    __syncthreads();
    float* modv = (float*)(a.ws + WS_MODV);
    const int cl = F.lane & 31, kp = F.lane >> 5;
    for (int unit = F.vcu; unit < NL * 192; unit += F.G) {
        const int l = unit / 192, n = (unit % 192) * 32 + cl;
        const float* w = a.in[I_WADA] + (size_t)l * 1024 * 6144 + n;
        float acc[9];
#pragma unroll
        for (int i = 0; i < 9; ++i) acc[i] = 0.f;
        const int k0 = F.wave * 128 + kp;
#pragma unroll 16
        for (int k = 0; k < 128; k += 2) { const float wv = w[(size_t)(k0 + k) * 6144];
#pragma unroll
            for (int i = 0; i < 9; ++i) acc[i] += cact[i * 1024 + k0 + k] * wv; }
#pragma unroll
        for (int i = 0; i < 9; ++i) red[((F.wave * 2 + kp) * 9 + i) * 32 + cl] = acc[i];
        __syncthreads();
        for (int t = F.tid; t < 9 * 32; t += 512) { const int i = t >> 5, nn = t & 31; float s = 0.f;
#pragma unroll
            for (int w16 = 0; w16 < 16; ++w16) s += red[(w16 * 9 + i) * 32 + nn];
            const int col = (unit % 192) * 32 + nn;
            modv[((size_t)l * 9 + i) * 6144 + col] = s + a.in[I_BADA][l * 6144 + col]; }
        __syncthreads();
    }
}
DI void copy_phase(Frame& F, KArgs ka) {
    KA_FRESH(ka); const __attribute__((address_space(4))) Args& a = *ka; frame_fresh(F);
    u32x2* xs = (u32x2*)(a.ws + WS_XS);
    const f32x4* x = (const f32x4*)a.in[I_X]; const f32x4* cx = (const f32x4*)a.in[I_CTX];
    const size_t nl = (size_t)MLAT * D / 4, nc = (size_t)MCTX * D / 4;
    for (size_t i = (size_t)blockIdx.x * 512 + F.tid; i < nl + nc; i += (size_t)F.G * 512) { const f32x4 v = i < nl ? x[i] : cx[i - nl]; u32x2 w; w.x = pk2(v.x, v.y); w.y = pk2(v.z, v.w); xs[i] = w; }
}

DI unsigned char* wsel(unsigned char* ws, int l, size_t off) {
    const size_t p = (size_t)(l & 1);
    return ws + (off >= W_DN ? WS_W + off + p * (16 * MiB) : off >= W_GU ? WS_W + off + p * (32 * MiB) : (p ? WS_W2 : WS_W) + off);
}
constexpr int T_IN = 16 * 166, T_UQ = 4 * 24, T_UKV = 2 * 32, T_NAO = 6 * 32, T_MLAO = 8 * 32, T_SWAO = 6 * 32, T_O = 16 * 32, T_E = 16 * 32 * 16;
constexpr int NIT = T_IN + T_UQ + T_UKV + T_NAO + T_MLAO + T_SWAO + T_O + 3 * T_E;
DI void cvt_item(const __attribute__((address_space(4))) Args& a, int l, int r, LAS float* scr, int lane) {
    const float* W; const float* ks = nullptr; int ldw = 1024, kb, nb, ldt = 1024, drow0, dcol0 = 0, fp8 = 1; size_t woff;
    if (r < T_IN) { kb = r / 166; nb = r % 166; W = a.in[I_WIN] + (size_t)l * 1024 * DIN; ldw = DIN;
        if (nb < 70) { fp8 = 0; woff = W_IN; drow0 = 32 * nb; } else { woff = W_GL; drow0 = 32 * nb - 2240; } }
    else if ((r -= T_IN) < T_UQ) { kb = r / 24; nb = r % 24; W = a.in[I_WUQ] + (size_t)l * 256 * 768; ldw = 768; fp8 = 0; woff = W_UP; ldt = 384; drow0 = 32 * nb; ks = a.in[I_MQN] + l * 256; }
    else if ((r -= T_UQ) < T_UKV) { kb = r / 32; nb = r % 32; W = a.in[I_WUKV] + (size_t)l * 128 * 1024; fp8 = 0; woff = W_UP; ldt = 384; drow0 = 768 + 32 * nb; dcol0 = 256; ks = a.in[I_MKVN] + l * 128; }
    else if ((r -= T_UKV) < T_NAO) { kb = r / 32; nb = r % 32; W = a.in[I_WNAO] + (size_t)l * 384 * 1024; woff = W_NAO; ldt = 512; drow0 = 32 * nb; }
    else if ((r -= T_NAO) < T_MLAO) { kb = r / 32; nb = r % 32; W = a.in[I_WMLAO] + (size_t)l * 512 * 1024; woff = W_MLAO; ldt = 512; drow0 = 32 * nb; }
    else if ((r -= T_MLAO) < T_SWAO) { kb = r / 32; nb = r % 32; W = a.in[I_WSWAO] + (size_t)l * 384 * 1024; woff = W_SWAO; ldt = 512; drow0 = 32 * nb; }
    else if ((r -= T_SWAO) < T_O) { kb = r / 32; nb = r % 32; W = a.in[I_WO] + (size_t)l * 1024 * 1024; woff = W_O; drow0 = 32 * nb; }
    else if ((r -= T_O) < 2 * T_E) {
        const int which = r / T_E, rr = r % T_E, e = rr / 512, t = rr % 512; kb = t / 32; nb = t % 32; const int f0 = 32 * nb;
        W = a.in[which ? I_WUP : I_WGATE] + ((size_t)l * 16 + e) * 1024 * 1024; woff = W_GU + (size_t)e * 2048 * 1024; drow0 = 256 * (f0 >> 7) + 128 * which + (f0 & 127); }
    else { r -= 2 * T_E; const int e = r / 512, t = r % 512; kb = t / 32; nb = t % 32;
        W = a.in[I_WDOWN] + ((size_t)l * 16 + e) * 1024 * 1024; woff = W_DN + (size_t)e * 1024 * 1024; drow0 = 32 * nb; }
    const int k0 = 64 * kb, n0 = 32 * nb; dcol0 += k0;
    unsigned char* WT; { const size_t p = (size_t)(l & 1); WT = a.ws + (woff >= W_DN ? WS_W + woff + p * (16 * MiB) : woff >= W_GU ? WS_W + woff + p * (32 * MiB) : (p ? WS_W2 : WS_W) + woff); }
    const float sc = fp8 ? 32.0f : 1.0f;
    const float* Wl = W + (size_t)(k0 + (lane >> 5)) * ldw + n0 + (lane & 31); LAS float* sl = scr + (lane >> 5) * 33 + (lane & 31);
    if (ks) { ks += k0 + (lane >> 5);
#pragma unroll 8
        for (int i = 0; i < 32; ++i) sl[2 * i * 33] = Wl[(size_t)(2 * i) * ldw] * ks[2 * i]; }
    else {
#pragma unroll 8
        for (int i = 0; i < 32; ++i) sl[2 * i * 33] = Wl[(size_t)(2 * i) * ldw] * sc; }
    asm volatile("s_waitcnt lgkmcnt(0)" ::: "memory");
    const int c = lane & 7;
    if (fp8) {
#pragma unroll
        for (int j = 0; j < 4; ++j) { const int n = (lane >> 3) + 8 * j; const LAS float* s = scr + (8 * c) * 33 + n;
            u32x2 o; o.x = pk4_fp8(s[0 * 33], s[1 * 33], s[2 * 33], s[3 * 33]); o.y = pk4_fp8(s[4 * 33], s[5 * 33], s[6 * 33], s[7 * 33]);
            *(u32x2*)(WT + (size_t)(drow0 + n) * ldt + dcol0 + 8 * c) = o; }
    } else {
#pragma unroll
        for (int j = 0; j < 4; ++j) { const int n = (lane >> 3) + 8 * j; const LAS float* s = scr + (8 * c) * 33 + n;
            u32x4 o; o.x = pk2(s[0 * 33], s[1 * 33]); o.y = pk2(s[2 * 33], s[3 * 33]); o.z = pk2(s[4 * 33], s[5 * 33]); o.w = pk2(s[6 * 33], s[7 * 33]);
            *(u32x4*)((bf16_t*)WT + (size_t)(drow0 + n) * ldt + dcol0 + 8 * c) = o; }
    }
    asm volatile("s_waitcnt lgkmcnt(0)" ::: "memory");
}
DI void convert_weights(Frame& F, KArgs ka, int l, int begin) {
    KA_FRESH(ka); const __attribute__((address_space(4))) Args& a = *ka; frame_fresh(F);
    LAS float* scr = (LAS float*)(F.lds + F.wave * 16384);
#pragma nounroll
    for (int it = begin + F.gw; it < NIT; it += F.ngw) cvt_item(a, l, it, scr, F.lane);
    unsigned char* wb = a.ws + ((l & 1) ? WS_W2 : WS_W);
    constexpr int Z0 = 64 * 128, Z1 = 768 * 16, Z2 = 1024 * 32, Z3 = 2 * 1024 * 8;
    unsigned zz = 0u; asm volatile("" : "+v"(zz));
    const u32x4 z = {zz, zz, zz, zz};
    for (int i = blockIdx.x * 512 + F.tid; i < Z0 + Z1 + Z2 + Z3; i += F.G * 512) {
        if (i >= Z0 + Z1 + Z2) { const int j = i - Z0 - Z1 - Z2, which = j >> 13, jj = j & 8191; *(u32x4*)(wb + (which ? W_SWAO : W_NAO) + (size_t)(jj >> 3) * 512 + 384 + (jj & 7) * 16) = z; continue; }
        if (i < Z0) *(u32x4*)((bf16_t*)(wb + W_IN) + (size_t)(2240 + i / 128) * 1024 + (i % 128) * 8) = z;
        else if (i < Z0 + Z1) { const int j = i - Z0; *(u32x4*)((bf16_t*)(wb + W_UP) + (size_t)(j / 16) * 384 + 256 + (j % 16) * 8) = z; }
        else { const int j = i - Z0 - Z1; *(u32x4*)((bf16_t*)(wb + W_UP) + (size_t)(768 + j / 32) * 384 + (j % 32) * 8) = z; }
    }
}
DI void convert_tail(Frame& F, KArgs ka, int l, int first, int q) {
    KA_FRESH(ka); const __attribute__((address_space(4))) Args& a = *ka; frame_fresh(F);
    LAS float* scr = (LAS float*)(F.lds + F.wave * 16384);
#pragma nounroll
    for (int j = 0; j < q; ++j) { const int it = first + 8 * j + F.wave; if (it < NIT) cvt_item(a, l, it, scr, F.lane); }
}


DI void row_phase(Frame& F, KArgs ka, int l, int dry = 0) {
    KA_FRESH(ka); const __attribute__((address_space(4))) Args& a = *ka; frame_fresh(F);
    bf16_t* xs = (bf16_t*)(a.ws + WS_XS);
    const float* modv = (const float*)(a.ws + WS_MODV);
    const int* smap = (const int*)(a.ws + WS_SMAP);
    const bf16_t* Y = (const bf16_t*)(a.ws + WS_Y);
    bf16_t* H = (bf16_t*)(a.ws + WS_R4);
    unsigned char* H8 = a.ws + WS_R4 + 68 * MiB;
    bf16_t* xso = xs; float* outo = a.out;
    if (dry) { unsigned char* tr = a.ws + WS_END + (size_t)F.gw * 16384; xso = (bf16_t*)tr; outo = (float*)tr; H = (bf16_t*)(tr + 8192); H8 = tr + 12288; }
    const int nrows = (l == NL) ? MLAT : MT;
    const bool comb = (l > 0);
    constexpr int RR = 4;
    for (int mb = RR * F.gw; mb < nrows; mb += RR * F.ngw) {
        f32x4 v[RR][4]; int myslot[RR];
#pragma unroll
        for (int rr = 0; rr < RR; ++rr) { const int m = mb + rr;
            if (l == 0) {
                if (F.lane < 16 && !dry) *(u32x4*)(a.ws + WS_OCAT + (size_t)m * OCW + ((F.lane >> 3) ? 1408 : 384) + 16 * (F.lane & 7)) = (u32x4){0u, 0u, 0u, 0u};
                const f32x4* xr = (const f32x4*)(m < MLAT ? a.in[I_X] + (size_t)m * D : a.in[I_CTX] + (size_t)(m - MLAT) * D) + F.lane;
                u32x2* xo = (u32x2*)(xs + (size_t)m * D) + F.lane;
#pragma unroll
                for (int j = 0; j < 4; ++j) { const f32x4 t = xr[64 * j]; u32x2 w; w.x = pk2(t.x, t.y); w.y = pk2(t.z, t.w); if (!dry) xo[64 * j] = w; v[rr][j] = (f32x4){bflo(w.x), bfhi(w.x), bflo(w.y), bfhi(w.y)}; }
            } else {
                const u32x2* xr = (const u32x2*)(xs + (size_t)m * D) + F.lane;
#pragma unroll
                for (int j = 0; j < 4; ++j) { const u32x2 w = xr[64 * j]; v[rr][j] = (f32x4){bflo(w.x), bfhi(w.x), bflo(w.y), bfhi(w.y)}; }
            }
            myslot[rr] = (comb && F.lane < 16) ? smap[(size_t)F.lane * MT + mb + rr] : -1; }
        const int mi = mod_index(mb);
        if (comb) {
            f32x4 acc[RR][4];
            unsigned long long mk[RR];
#pragma unroll
            for (int rr = 0; rr < RR; ++rr) { mk[rr] = __ballot(myslot[rr] >= 0);
#pragma unroll
                for (int j = 0; j < 4; ++j) acc[rr][j] = (f32x4){0.f, 0.f, 0.f, 0.f}; }
            while ((mk[0] | mk[1]) | (mk[2] | mk[3])) {
                u32x2 w[RR][4];
#pragma unroll
                for (int rr = 0; rr < RR; ++rr) {
                    int s = -1;
                    if (mk[rr]) { const int e0 = __builtin_ctzll(mk[rr]); s = __shfl(myslot[rr], e0); mk[rr] &= mk[rr] - 1; }
#pragma unroll
                    for (int j = 0; j < 4; ++j) w[rr][j] = (u32x2){0u, 0u};
                    if (s >= 0) { const u32x2* yr = (const u32x2*)(Y + (size_t)s * D) + F.lane;
#pragma unroll
                        for (int j = 0; j < 4; ++j) w[rr][j] = yr[64 * j]; }
                }
#pragma unroll
                for (int rr = 0; rr < RR; ++rr)
#pragma unroll
                    for (int j = 0; j < 4; ++j) acc[rr][j] += (f32x4){bflo(w[rr][j].x), bfhi(w[rr][j].x), bflo(w[rr][j].y), bfhi(w[rr][j].y)};
            }
            const f32x4* g5 = (const f32x4*)(modv + ((size_t)(l - 1) * 9 + mi) * 6144 + 5 * 1024) + F.lane;
            f32x4 g5v[4];
#pragma unroll
            for (int j = 0; j < 4; ++j) g5v[j] = g5[64 * j];
#pragma unroll
            for (int rr = 0; rr < RR; ++rr) { const int m = mb + rr;
                const size_t ro = dry ? (size_t)rr * 1024 : (size_t)m * D;
#pragma unroll
                for (int j = 0; j < 4; ++j) { v[rr][j] += g5v[j] * acc[rr][j];
                    if (l == NL) ((f32x4*)(outo + ro) + F.lane)[64 * j] = v[rr][j];
                    else { u32x2 w; w.x = pk2(v[rr][j].x, v[rr][j].y); w.y = pk2(v[rr][j].z, v[rr][j].w); ((u32x2*)(xso + ro) + F.lane)[64 * j] = w;
                           v[rr][j] = (f32x4){bflo(w.x), bfhi(w.x), bflo(w.y), bfhi(w.y)}; } } }
        }
        if (l < NL) {
            const f32x4* g = (const f32x4*)(a.in[I_N1G] + l * D) + F.lane;
            const f32x4* sh = (const f32x4*)(modv + ((size_t)l * 9 + mi) * 6144) + F.lane;
            const f32x4* sc = (const f32x4*)(modv + ((size_t)l * 9 + mi) * 6144 + 1024) + F.lane;
            f32x4 gg[4], shv[4];
#pragma unroll
            for (int j = 0; j < 4; ++j) { gg[j] = g[64 * j] * (sc[64 * j] + 1.0f); shv[j] = sh[64 * j]; }
#pragma unroll
            for (int rr = 0; rr < RR; ++rr) { const int m = mb + rr;
                float ss = 0.f;
#pragma unroll
                for (int j = 0; j < 4; ++j) ss += (v[rr][j].x * v[rr][j].x + v[rr][j].y * v[rr][j].y) + (v[rr][j].z * v[rr][j].z + v[rr][j].w * v[rr][j].w);
                const float rstd = __builtin_amdgcn_rsqf(wave_sum(ss) * (1.f / D) + EPS);
                u32x2* o = (u32x2*)(H + (dry ? (size_t)rr * 1024 : (size_t)m * D)) + F.lane;
                unsigned* o8 = (unsigned*)(H8 + (dry ? (size_t)rr * 1024 : (size_t)m * D)) + F.lane;
#pragma unroll
                for (int j = 0; j < 4; ++j) { const f32x4 hh = v[rr][j] * rstd * gg[j] + shv[j]; u32x2 w; w.x = pk2(hh.x, hh.y); w.y = pk2(hh.z, hh.w); o[64 * j] = w;
                    o8[64 * j] = pk4_fp8(hh.x, hh.y, hh.z, hh.w); } }
        }
    }
}

DI void rope_cs(int d, int prow, int pcol, float& cs, float& sn) {
    const int i = d & 15; const float pos = (float)((d & 32) ? pcol : prow);
    const float inv = __builtin_amdgcn_exp2f(-(float)i * (13.287712379549449f / 16.0f));
    const float rev = pos * inv * 0.15915494309189535f;
    const float fr = rev - floorf(rev);
    cs = __builtin_amdgcn_cosf(fr); sn = __builtin_amdgcn_sinf(fr);
}
DI void prep_phase(Frame& F, KArgs ka, int l) {
    KA_FRESH(ka); const __attribute__((address_space(4))) Args& a = *ka; frame_fresh(F);
    const bf16_t* HW = (const bf16_t*)(a.ws + WS_HW);
    bf16_t* P1 = (bf16_t*)(a.ws + WS_P1);
    const float sc64 = 0.125f * LOG2E;
    const int d0 = 8 * (F.lane & 7);
    float gn[3][8]; int srcc[3]; bool ropei[3], acti[3];
    const float* gp0 = a.in[I_NAQG]; const float* gp1 = a.in[I_NAKG]; const float* gp2 = a.in[I_SWQG]; const float* gp3 = a.in[I_SWKG];
#pragma unroll
    for (int i = 0; i < 3; ++i) { const int c = F.lane + 64 * i, col = 8 * c; acti[i] = c < 160;
        const int ty = col < 384 ? 0 : col < 768 ? 1 : col < 1152 ? 2 : 3;
        srcc[i] = col < 768 ? col : col + (C_SWQ - 768);
        ropei[i] = ty >= 2;
        const float sc = (ty == 0 || ty == 2) ? sc64 : 1.0f;
#pragma unroll
        for (int j = 0; j < 8; ++j) { const float g0 = gp0[l * 64 + d0 + j], g1 = gp1[l * 64 + d0 + j], g2 = gp2[l * 64 + d0 + j], g3 = gp3[l * 64 + d0 + j];
            gn[i][j] = acti[i] ? (ty == 0 ? g0 : ty == 1 ? g1 : ty == 2 ? g2 : g3) * sc : 0.f; } }
    float invf[8];
#pragma unroll
    for (int j = 0; j < 8; ++j) invf[j] = __builtin_amdgcn_exp2f(-(float)((d0 & 8) + j) * (13.287712379549449f / 16.0f)) * 0.15915494309189535f;
    const bool second = (d0 & 16) != 0, usecol = (d0 & 32) != 0;
    for (int mb = 2 * F.gw; mb < MT; mb += 2 * F.ngw) {
        u32x4 w[2][3];
#pragma unroll
        for (int rr = 0; rr < 2; ++rr)
#pragma unroll
            for (int i = 0; i < 3; ++i) if (acti[i]) w[rr][i] = *(const u32x4*)(HW + (size_t)(mb + rr) * DINP + srcc[i]); else w[rr][i] = (u32x4){0u, 0u, 0u, 0u};
#pragma unroll
        for (int rr = 0; rr < 2; ++rr) {
            const int m = mb + rr; const bool lat = m < MLAT; const int s = m & 4095; const float prw = (float)(s >> 6), pcl = (float)(s & 63); float pos = usecol ? pcl : prw; asm volatile("" : "+v"(pos));
            float cs[8], sn[8];
#pragma unroll
            for (int j = 0; j < 8; ++j) { cs[j] = 1.f; sn[j] = 0.f; }
            if (lat) {
#pragma unroll
                for (int j = 0; j < 8; ++j) { const float rev = pos * invf[j], fr = rev - floorf(rev); cs[j] = __builtin_amdgcn_cosf(fr); sn[j] = __builtin_amdgcn_sinf(fr); } }
#pragma unroll
            for (int i = 0; i < 3; ++i) {
                float x[8] = {bflo(w[rr][i].x), bfhi(w[rr][i].x), bflo(w[rr][i].y), bfhi(w[rr][i].y), bflo(w[rr][i].z), bfhi(w[rr][i].z), bflo(w[rr][i].w), bfhi(w[rr][i].w)};
                float ss = 0.f;
#pragma unroll
                for (int j = 0; j < 8; ++j) ss += x[j] * x[j];
                ss += __shfl_xor(ss, 1); ss += __shfl_xor(ss, 2); ss += __shfl_xor(ss, 4);
                const float rs = __builtin_amdgcn_rsqf(ss * (1.f / 64.f) + EPS);
#pragma unroll
                for (int j = 0; j < 8; ++j) x[j] *= rs * gn[i][j];
                const bool rp = ropei[i] && lat;
#pragma unroll
                for (int j = 0; j < 8; ++j) { const float y = __int_as_float(__builtin_amdgcn_ds_bpermute((F.lane ^ 2) << 2, __float_as_int(x[j]))); const float rot = second ? x[j] * cs[j] + y * sn[j] : x[j] * cs[j] - y * sn[j]; x[j] = rp ? rot : x[j]; }
                if (acti[i]) { u32x4 o; o.x = pk2(x[0], x[1]); o.y = pk2(x[2], x[3]); o.z = pk2(x[4], x[5]); o.w = pk2(x[6], x[7]);
                    *(u32x4*)(P1 + (size_t)m * P1W + 8 * (F.lane + 64 * i)) = o; }
            }
        }
    }
}
DI void prep2_phase(Frame& F, KArgs ka, int l, int dry = 0) {
    KA_FRESH(ka); const __attribute__((address_space(4))) Args& a = *ka; frame_fresh(F);
    const bf16_t* HW = (const bf16_t*)(a.ws + WS_HW);
    bf16_t* U = (bf16_t*)(a.ws + WS_R4);
    bf16_t* P2 = (bf16_t*)(a.ws + WS_P2);
    const float scq = 0.07216878364870322f * LOG2E;
    const int ln = F.lane, q = ln & 15, h = ln >> 4;
    float qgn[8], qgr[4], kgn[8], kgr[4], invf[4];
    { const float* qg = a.in[I_MQG] + l * 192; const float* kg = a.in[I_MKG] + l * 192;
#pragma unroll
      for (int j = 0; j < 8; ++j) { qgn[j] = qg[8 * q + j] * scq; kgn[j] = kg[8 * q + j]; }
#pragma unroll
      for (int j = 0; j < 4; ++j) { qgr[j] = qg[128 + 4 * q + j] * scq; kgr[j] = kg[128 + 4 * q + j];
          invf[j] = __builtin_amdgcn_exp2f(-(float)(4 * (q & 3) + j) * (13.287712379549449f / 16.0f)) * 0.15915494309189535f; } }
    const bool second = (q & 4) != 0, usecol = (q & 8) != 0;
    const int pl = (ln ^ 4) << 2;
    for (int mb = 2 * F.gw; mb < MT; mb += 2 * F.ngw) {
        u32x2 wcq[2], wqr[2], wkr[2]; unsigned wckv[2]; u32x4 wqn[2], wkn[2], wv[2];
#pragma unroll
        for (int rr = 0; rr < 2; ++rr) { const bf16_t* hr = HW + (size_t)(mb + rr) * DINP; const bf16_t* ur = U + (size_t)(mb + rr) * UW;
            wcq[rr] = *(const u32x2*)(hr + C_CQ + 4 * ln); wckv[rr] = *(const unsigned*)(hr + C_CKV + 2 * ln); wkr[rr] = *(const u32x2*)(hr + C_KR + 4 * q);
            wqn[rr] = *(const u32x4*)(ur + h * 192 + 8 * q); wqr[rr] = *(const u32x2*)(ur + h * 192 + 128 + 4 * q);
            wkn[rr] = *(const u32x4*)(ur + 768 + h * 256 + 8 * q); wv[rr] = *(const u32x4*)(ur + 768 + h * 256 + 128 + 8 * q); }
#pragma unroll
        for (int rr = 0; rr < 2; ++rr) {
            const int m = mb + rr; const bool lat = m < MLAT; const int s = m & 4095;
            bf16_t* ur = U + (size_t)m * UW; bf16_t* pr = P2 + (size_t)m * P2W;
            if (dry) { ur = (bf16_t*)(a.ws + WS_END + (size_t)F.gw * 8192); pr = ur + 2048; }
            float rq, rkv;
            { const float a0 = bflo(wcq[rr].x), a1 = bfhi(wcq[rr].x), a2 = bflo(wcq[rr].y), a3 = bfhi(wcq[rr].y);
              rq = __builtin_amdgcn_rsqf(wave_sum(a0 * a0 + a1 * a1 + a2 * a2 + a3 * a3) * (1.f / 256.f) + EPS); }
            { const float a0 = bflo(wckv[rr]), a1 = bfhi(wckv[rr]);
              rkv = __builtin_amdgcn_rsqf(wave_sum(a0 * a0 + a1 * a1) * (1.f / 128.f) + EPS); }
            float cs[4], sn[4];
            { const float prw = (float)(s >> 6), pcl = (float)(s & 63); float pos = usecol ? pcl : prw; asm volatile("" : "+v"(pos));
#pragma unroll
              for (int j = 0; j < 4; ++j) { const float rev = pos * invf[j], fr = rev - floorf(rev); cs[j] = lat ? __builtin_amdgcn_cosf(fr) : 1.f; sn[j] = lat ? __builtin_amdgcn_sinf(fr) : 0.f; } }
#pragma unroll
            for (int isk = 0; isk < 2; ++isk) {
                const u32x4 wn = isk ? wkn[rr] : wqn[rr]; const u32x2 wr2 = isk ? wkr[rr] : wqr[rr];
                const float sn_ = isk ? rkv : rq, sr_ = isk ? 1.0f : rq;
                float x[8] = {bflo(wn.x) * sn_, bfhi(wn.x) * sn_, bflo(wn.y) * sn_, bfhi(wn.y) * sn_, bflo(wn.z) * sn_, bfhi(wn.z) * sn_, bflo(wn.w) * sn_, bfhi(wn.w) * sn_};
                float y[4] = {bflo(wr2.x) * sr_, bfhi(wr2.x) * sr_, bflo(wr2.y) * sr_, bfhi(wr2.y) * sr_};
                float ss = 0.f;
#pragma unroll
                for (int j = 0; j < 8; ++j) ss += x[j] * x[j];
#pragma unroll
                for (int j = 0; j < 4; ++j) ss += y[j] * y[j];
                ss += __shfl_xor(ss, 1); ss += __shfl_xor(ss, 2); ss += __shfl_xor(ss, 4); ss += __shfl_xor(ss, 8);
                const float rs = __builtin_amdgcn_rsqf(ss * (1.f / 192.f) + EPS);
#pragma unroll
                for (int j = 0; j < 8; ++j) x[j] *= rs * (isk ? kgn[j] : qgn[j]);
#pragma unroll
                for (int j = 0; j < 4; ++j) { y[j] *= rs * (isk ? kgr[j] : qgr[j]);
                    const float p = __int_as_float(__builtin_amdgcn_ds_bpermute(pl, __float_as_int(y[j])));
                    y[j] = second ? y[j] * cs[j] + p * sn[j] : y[j] * cs[j] - p * sn[j]; }
                u32x4 o; o.x = pk2(x[0], x[1]); o.y = pk2(x[2], x[3]); o.z = pk2(x[4], x[5]); o.w = pk2(x[6], x[7]);
                u32x2 o2; o2.x = pk2(y[0], y[1]); o2.y = pk2(y[2], y[3]);
                *(u32x4*)(pr + 768 * isk + h * 192 + 8 * q) = o; *(u32x2*)(pr + 768 * isk + h * 192 + 128 + 4 * q) = o2;
            }
            { const u32x4 vw = wv[rr]; u32x4 o; o.x = pk2(bflo(vw.x) * rkv, bfhi(vw.x) * rkv); o.y = pk2(bflo(vw.y) * rkv, bfhi(vw.y) * rkv); o.z = pk2(bflo(vw.z) * rkv, bfhi(vw.z) * rkv); o.w = pk2(bflo(vw.w) * rkv, bfhi(vw.w) * rkv);
              *(u32x4*)(ur + 768 + h * 256 + 128 + 8 * q) = o; }
        }
    }
}

struct AU {
    const bf16_t *q, *k, *v; unsigned char* o;
    int ldq, ldk, ldv, ldo;
    int qrow0;
    int lat_row0, n_lat, ctx_row0, n_ctx;
    int mode;
    int qpos0, kpos0;
    float m0, l0;
    const float* rpb;
};
template <int DQ, int DV, int LDK, int LDV>
DI void attn_unit(LAS unsigned char* lds, const AU& u, int tid, int wave, int lane) {
    constexpr int KP = DQ * 2 + 16, VP = DV * 2 + 64, KBY = 64 * KP, VBY = 64 * VP, STG = KBY + VBY;
    constexpr int NKS = DQ / 16, NDT = DV / 32, KCH = DQ / 8, VCH = DV / 8;
    constexpr int KC = KP / 16, VC = VP / 16;
    constexpr int KI = (KC + 7) / 8, VI = (VC + 7) / 8;
    constexpr int BIAS_OFF = 98304;
    constexpr float MTHR = 11.5f;
    static_assert(2 * STG <= BIAS_OFF && KBY % 1024 == 0 && VBY % 1024 == 0, "attention LDS");
    const int r = lane & 31, h = lane >> 5;
    const int nt = u.n_lat + u.n_ctx;
    LAS float* btab = (LAS float*)(lds + BIAS_OFF);
    if (u.mode == 2) { for (int i = tid; i < 15 * 31; i += 512) btab[i] = u.rpb[i] * LOG2E; }
    bf16x8 qf[NKS];
    { const bf16_t* qp = u.q + (size_t)(u.qrow0 + wave * 32 + r) * u.ldq + 8 * h;
#pragma unroll
      for (int ks = 0; ks < NKS; ++ks) qf[ks] = *(const bf16x8*)(qp + 16 * ks); }
    f32x16 o[NDT];
#pragma unroll
    for (int dt = 0; dt < NDT; ++dt)
#pragma unroll
        for (int i = 0; i < 16; ++i) o[dt][i] = 0.f;
    float mrun = u.m0, lrun = (h == 0) ? u.l0 : 0.f;
    unsigned koff[KI], voff[VI];
#pragma unroll
    for (int i = 0; i < KI; ++i) { const int c = 64 * (wave + 8 * i) + lane, row = c / KC, cc = c % KC; koff[i] = (unsigned)(row * LDK * 2 + (cc < KCH ? cc : KCH - 1) * 16); }
#pragma unroll
    for (int i = 0; i < VI; ++i) { const int c = 64 * (wave + 8 * i) + lane, row = c / VC, cc = c % VC; voff[i] = (unsigned)(row * LDV * 2 + (cc < VCH ? cc : VCH - 1) * 16); }
#define AT_ROWBASE(t) ((t) < u.n_lat ? u.lat_row0 + 64 * (t) : u.ctx_row0 + 64 * ((t) - u.n_lat))
#define AT_ISSUE(t, buf) do { const int rb_ = AT_ROWBASE(t); const char* kb_ = (const char*)(u.k + (size_t)rb_ * LDK); const char* vb_ = (const char*)(u.v + (size_t)rb_ * LDV); \
        _Pragma("unroll") for (int i_ = 0; i_ < KI; ++i_) { const int j_ = wave + 8 * i_; if (j_ < KC) __builtin_amdgcn_global_load_lds((const unsigned*)(kb_ + koff[i_]), (LAS unsigned*)(lds + (buf) * STG + j_ * 1024), 16, 0, 0); } \
        _Pragma("unroll") for (int i_ = 0; i_ < VI; ++i_) { const int j_ = wave + 8 * i_; if (j_ < VC) __builtin_amdgcn_global_load_lds((const unsigned*)(vb_ + voff[i_]), (LAS unsigned*)(lds + (buf) * STG + KBY + j_ * 1024), 16, 0, 0); } } while (0)
    AT_ISSUE(0, 0);
    asm volatile("s_waitcnt vmcnt(0)" ::: "memory");
    __syncthreads();
    const int tq = (lane & 15) >> 2, tp = lane & 3, tblk = (lane >> 4) & 1;
    const int vlane_off = (4 * h + tq) * VP + 32 * tblk + 8 * tp;
    for (int t = 0; t < nt; ++t) {
        const int buf = t & 1;
        if (t + 1 < nt) AT_ISSUE(t + 1, buf ^ 1);
        bool skip = false; int a0 = 0, a1 = 0;
        if (u.mode == 1 && t < u.n_lat) { const int k0 = u.kpos0 + 64 * t, q0 = u.qpos0 + 32 * wave; skip = (k0 > q0 + 31 + 128) || (k0 + 63 < q0 - 128); a0 = k0; a1 = q0; }
        if (u.mode == 2 && t < u.n_lat) { const int kr = u.kpos0 + t, qr = u.qpos0 + (wave >> 1); int rs = qr - 4; rs = rs < 0 ? 0 : (rs > 56 ? 56 : rs); skip = (kr < rs) || (kr >= rs + 8); a0 = kr - qr + 7; }
        if (!skip) {
            const LAS unsigned char* Kt = lds + buf * STG; const LAS unsigned char* Vt = Kt + KBY;
            f32x16 s0, s1;
#pragma unroll
            for (int i = 0; i < 16; ++i) { s0[i] = 0.f; s1[i] = 0.f; }
#pragma unroll
            for (int ks = 0; ks < NKS; ++ks) {
                const bf16x8 k0 = *(const LAS bf16x8*)(Kt + r * KP + (16 * ks + 8 * h) * 2);
                const bf16x8 k1 = *(const LAS bf16x8*)(Kt + (32 + r) * KP + (16 * ks + 8 * h) * 2);
                s0 = __builtin_amdgcn_mfma_f32_32x32x16_bf16(k0, qf[ks], s0, 0, 0, 0);
                s1 = __builtin_amdgcn_mfma_f32_32x32x16_bf16(k1, qf[ks], s1, 0, 0, 0);
            }
            if (u.mode == 1 && t < u.n_lat) {
                const int qpos = a1 + r;
#pragma unroll
                for (int i = 0; i < 16; ++i) { const int kk = a0 + (i & 3) + 8 * (i >> 2) + 4 * h; int d0 = qpos - kk; d0 = d0 < 0 ? -d0 : d0; int d1 = qpos - (kk + 32); d1 = d1 < 0 ? -d1 : d1;
                    s0[i] = d0 <= 128 ? s0[i] : -INFINITY; s1[i] = d1 <= 128 ? s1[i] : -INFINITY; }
            }
            if (u.mode == 2 && t < u.n_lat) {
                const int qc = 32 * (wave & 1) + r; int cs = qc - 8; cs = cs < 0 ? 0 : (cs > 48 ? 48 : cs);
                const int bbase = a0 * 31 + 15 - qc;
                float bb[16];
#pragma unroll
                for (int half = 0; half < 2; ++half) {
#pragma unroll
                    for (int i = 0; i < 16; ++i) { int ix = bbase + 32 * half + (i & 3) + 8 * (i >> 2) + 4 * h; ix = ix < 0 ? 0 : (ix > 464 ? 464 : ix); bb[i] = btab[ix]; }
                    asm volatile("" : "+v"(bb[0]), "+v"(bb[1]), "+v"(bb[2]), "+v"(bb[3]), "+v"(bb[4]), "+v"(bb[5]), "+v"(bb[6]), "+v"(bb[7]), "+v"(bb[8]), "+v"(bb[9]), "+v"(bb[10]), "+v"(bb[11]), "+v"(bb[12]), "+v"(bb[13]), "+v"(bb[14]), "+v"(bb[15]));
#pragma unroll
                    for (int i = 0; i < 16; ++i) { const int kc = 32 * half + (i & 3) + 8 * (i >> 2) + 4 * h; const bool ok = (kc >= cs) && (kc < cs + 16);
                        if (half == 0) s0[i] = ok ? s0[i] + bb[i] : -INFINITY; else s1[i] = ok ? s1[i] + bb[i] : -INFINITY; }
                }
            }
            float mx = fmaxf(s0[0], s1[0]);
#pragma unroll
            for (int i = 1; i < 16; ++i) mx = fmaxf(mx, fmaxf(s0[i], s1[i]));
            mx = fmaxf(mx, __shfl_xor(mx, 32));
            if (__builtin_amdgcn_ballot_w64(mx > mrun + MTHR) != 0ull) {
                const float mnew = fmaxf(mrun, mx), alpha = __builtin_amdgcn_exp2f(mrun - mnew);
                lrun *= alpha; mrun = mnew;
#pragma unroll
                for (int dt = 0; dt < NDT; ++dt)
#pragma unroll
                    for (int i = 0; i < 16; ++i) o[dt][i] *= alpha;
            }
            float ls = 0.f;
#pragma unroll
            for (int i = 0; i < 16; ++i) { s0[i] = __builtin_amdgcn_exp2f(s0[i] - mrun); s1[i] = __builtin_amdgcn_exp2f(s1[i] - mrun); ls += s0[i] + s1[i]; }
            lrun += ls;
            bf16x8 pf[4];
            { u32x4 w;
              w.x = pk2(s0[0], s0[1]); w.y = pk2(s0[2], s0[3]); w.z = pk2(s0[4], s0[5]); w.w = pk2(s0[6], s0[7]); pf[0] = __builtin_bit_cast(bf16x8, w);
              w.x = pk2(s0[8], s0[9]); w.y = pk2(s0[10], s0[11]); w.z = pk2(s0[12], s0[13]); w.w = pk2(s0[14], s0[15]); pf[1] = __builtin_bit_cast(bf16x8, w);
              w.x = pk2(s1[0], s1[1]); w.y = pk2(s1[2], s1[3]); w.z = pk2(s1[4], s1[5]); w.w = pk2(s1[6], s1[7]); pf[2] = __builtin_bit_cast(bf16x8, w);
              w.x = pk2(s1[8], s1[9]); w.y = pk2(s1[10], s1[11]); w.z = pk2(s1[12], s1[13]); w.w = pk2(s1[14], s1[15]); pf[3] = __builtin_bit_cast(bf16x8, w); }
#pragma unroll
            for (int kk = 0; kk < 4; ++kk) {
#pragma unroll
                for (int dt = 0; dt < NDT; ++dt) {
                    const LAS unsigned char* vp = Vt + (16 * kk) * VP + vlane_off + 64 * dt;
                    const s16x4 lo = __builtin_amdgcn_ds_read_tr16_b64_v4i16((LAS s16x4*)vp);
                    const s16x4 hi = __builtin_amdgcn_ds_read_tr16_b64_v4i16((LAS s16x4*)(vp + 8 * VP));
                    const bf16x8 vf = __builtin_shufflevector(lo, hi, 0, 1, 2, 3, 4, 5, 6, 7);
                    o[dt] = __builtin_amdgcn_mfma_f32_32x32x16_bf16(vf, pf[kk], o[dt], 0, 0, 0);
                }
            }
        }
        asm volatile("s_waitcnt vmcnt(0)" ::: "memory");
        __syncthreads();
    }
    const float ltot = lrun + __shfl_xor(lrun, 32), inv = 1.0f / ltot;
    unsigned char* op = u.o + (size_t)(u.qrow0 + wave * 32 + r) * u.ldo + 4 * h;
    const float inv4 = inv * 4.0f;
#pragma unroll
    for (int dt = 0; dt < NDT; ++dt)
#pragma unroll
        for (int g = 0; g < 4; ++g) *(unsigned*)(op + 32 * dt + 8 * g) = pk4_fp8(o[dt][4 * g] * inv4, o[dt][4 * g + 1] * inv4, o[dt][4 * g + 2] * inv4, o[dt][4 * g + 3] * inv4);
#undef AT_ROWBASE
#undef AT_ISSUE
}

DI void attn_phase(Frame& F, KArgs ka, int l) {
    KA_FRESH(ka); const __attribute__((address_space(4))) Args& a = *ka; frame_fresh(F);
    const bf16_t* HW = (const bf16_t*)(a.ws + WS_HW);
    const bf16_t* P1 = (const bf16_t*)(a.ws + WS_P1);
    const bf16_t* P2 = (const bf16_t*)(a.ws + WS_P2);
    const bf16_t* U = (const bf16_t*)(a.ws + WS_R4);
    unsigned char* OC = a.ws + WS_OCAT;
    const bool last = (l == NL - 1);
    constexpr int nA = 512, nB = 768, nC = 768;
    const int ntot = nA + nB + nC + (last ? 0 : 128);
#ifndef ATT_PROBE
#define ATT_PROBE 0
#endif
    for (int rep2_ = 0; rep2_ < 1 + (ATT_PROBE != 0); ++rep2_)
    for (int id = F.vcu; id < ntot; id += F.G) {
        if (rep2_ == 1 && !((ATT_PROBE == 1) ? (id < nA) : (id >= nA && id < nA + nB))) continue;
        AU u; bool big = false;
        u.mode = 0; u.qpos0 = 0; u.kpos0 = 0; u.m0 = -1e30f; u.l0 = 0.f; u.rpb = nullptr; u.n_ctx = 4;
        if (id < nA) {
            const int b = id >> 6, h = (id >> 4) & 3, qb = id & 15; big = true;
            u.q = P2 + h * 192; u.ldq = P2W; u.k = P2 + 768 + h * 192; u.ldk = P2W; u.v = U + 768 + h * 256 + 128; u.ldv = UW; u.o = OC + 512 + h * 128; u.ldo = OCW;
            u.qrow0 = b * SEQ + qb * 256; u.lat_row0 = b * SEQ; u.n_lat = 64; u.ctx_row0 = MLAT + b * CTX;
        } else if (id < nA + nB) {
            const int j = id - nA, b = j / 96, h = (j >> 4) % 6, qb = j & 15;
            u.q = P1 + h * 64; u.ldq = P1W; u.k = P1 + 384 + h * 64; u.ldk = P1W; u.v = HW + C_NAV + h * 64; u.ldv = DINP; u.o = OC + h * 64; u.ldo = OCW;
            int rlo = 4 * qb - 4; rlo = rlo < 0 ? 0 : (rlo > 56 ? 56 : rlo); int rhi = 4 * qb + 3 - 4; rhi = (rhi < 0 ? 0 : (rhi > 56 ? 56 : rhi)) + 7;
            u.qrow0 = b * SEQ + qb * 256; u.lat_row0 = b * SEQ + rlo * 64; u.n_lat = rhi - rlo + 1; u.ctx_row0 = MLAT + b * CTX;
            u.mode = 2; u.qpos0 = 4 * qb; u.kpos0 = rlo; u.rpb = a.in[I_RPB] + (size_t)(l * 6 + h) * 465;
        } else if (id < nA + nB + nC) {
            const int j = id - nA - nB, b = j / 96, hq = (j >> 4) % 6, qb = j & 15, kvh = hq / 3;
            u.q = P1 + 768 + hq * 64; u.ldq = P1W; u.k = P1 + 1152 + kvh * 64; u.ldk = P1W; u.v = HW + C_SWV + kvh * 64; u.ldv = DINP; u.o = OC + 1024 + hq * 64; u.ldo = OCW;
            int klo = qb * 256 - 128; klo = klo < 0 ? 0 : klo; int khi = qb * 256 + 384; khi = khi > SEQ ? SEQ : khi;
            u.qrow0 = b * SEQ + qb * 256; u.lat_row0 = b * SEQ + klo; u.n_lat = (khi - klo) >> 6; u.ctx_row0 = MLAT + b * CTX;
            u.mode = 1; u.qpos0 = qb * 256; u.kpos0 = klo; u.m0 = a.in[I_SINK][l * 6 + hq] * LOG2E; u.l0 = 1.f;
        } else {
            const int j = id - nA - nB - nC;
            u.n_lat = 0; u.lat_row0 = 0;
            if (j < 32) { const int b = j >> 2, h = j & 3; big = true;
                u.q = P2 + h * 192; u.ldq = P2W; u.k = P2 + 768 + h * 192; u.ldk = P2W; u.v = U + 768 + h * 256 + 128; u.ldv = UW; u.o = OC + 512 + h * 128; u.ldo = OCW;
                u.qrow0 = MLAT + b * CTX; u.ctx_row0 = MLAT + b * CTX;
            } else if (j < 80) { const int jj = j - 32, b = jj / 6, h = jj % 6;
                u.q = P1 + h * 64; u.ldq = P1W; u.k = P1 + 384 + h * 64; u.ldk = P1W; u.v = HW + C_NAV + h * 64; u.ldv = DINP; u.o = OC + h * 64; u.ldo = OCW;
                u.qrow0 = MLAT + b * CTX; u.ctx_row0 = MLAT + b * CTX;
            } else { const int jj = j - 80, b = jj / 6, hq = jj % 6, kvh = hq / 3;
                u.q = P1 + 768 + hq * 64; u.ldq = P1W; u.k = P1 + 1152 + kvh * 64; u.ldk = P1W; u.v = HW + C_SWV + kvh * 64; u.ldv = DINP; u.o = OC + 1024 + hq * 64; u.ldo = OCW;
                u.qrow0 = MLAT + b * CTX; u.ctx_row0 = MLAT + b * CTX; u.m0 = a.in[I_SINK][l * 6 + hq] * LOG2E; u.l0 = 1.f;
            }
        }
        if (big) attn_unit<192, 128, P2W, UW>(F.lds, u, F.tid, F.wave, F.lane);
        else attn_unit<64, 64, P1W, DINP>(F.lds, u, F.tid, F.wave, F.lane);
    }
}

DI void norm2_phase(Frame& F, KArgs ka, int l, int nrows) {
    KA_FRESH(ka); const __attribute__((address_space(4))) Args& a = *ka; frame_fresh(F);
    LAS float* rt = (LAS float*)F.lds;
    const float* rg = a.in[I_ROUTER] + (size_t)l * 1024 * 16;
    for (int i = F.tid; i < 16384; i += 512) rt[i] = rg[i];
    __syncthreads();
    LAS float* xr = (LAS float*)(F.lds + 65536 + F.wave * 8192);
    const bf16_t* xs = (const bf16_t*)(a.ws + WS_XS);
    const float* modv = (const float*)(a.ws + WS_MODV);
    unsigned char* H2 = a.ws + WS_H2;
    float* AFL = (float*)(a.ws + WS_AFL); float* AFC = (float*)(a.ws + WS_AFC);
    const int eq = F.lane & 3, kq = F.lane >> 2;
    u32x2 xw[2][4];
#define N2_LOAD(mb_) do { _Pragma("unroll") for (int rr_ = 0; rr_ < 2; ++rr_) { const u32x2* xp_ = (const u32x2*)(xs + (size_t)((mb_) + rr_) * D) + F.lane; \
        _Pragma("unroll") for (int j_ = 0; j_ < 4; ++j_) xw[rr_][j_] = xp_[64 * j_]; } } while (0)
    if (2 * F.gw < nrows) N2_LOAD(2 * F.gw);
    for (int mb = 2 * F.gw; mb < nrows; mb += 2 * F.ngw) {
        const int mi = mod_index(mb);
        f32x4 v[2][4];
#pragma unroll
        for (int rr = 0; rr < 2; ++rr)
#pragma unroll
            for (int j = 0; j < 4; ++j) { const u32x2 w = xw[rr][j]; v[rr][j] = (f32x4){bflo(w.x), bfhi(w.x), bflo(w.y), bfhi(w.y)}; }
        if (mb + 2 * F.ngw < nrows) N2_LOAD(mb + 2 * F.ngw);
        const f32x4* g = (const f32x4*)(a.in[I_N2G] + l * D) + F.lane;
        const f32x4* sh = (const f32x4*)(modv + ((size_t)l * 9 + mi) * 6144 + 3 * 1024) + F.lane;
        const f32x4* sc = (const f32x4*)(modv + ((size_t)l * 9 + mi) * 6144 + 4 * 1024) + F.lane;
        f32x4 gg[4], shv[4];
#pragma unroll
        for (int j = 0; j < 4; ++j) { gg[j] = g[64 * j] * (sc[64 * j] + 1.0f); shv[j] = sh[64 * j]; }
#pragma unroll
        for (int rr = 0; rr < 2; ++rr) {
            float ss = 0.f;
#pragma unroll
            for (int j = 0; j < 4; ++j) ss += (v[rr][j].x * v[rr][j].x + v[rr][j].y * v[rr][j].y) + (v[rr][j].z * v[rr][j].z + v[rr][j].w * v[rr][j].w);
            const float rstd = __builtin_amdgcn_rsqf(wave_sum(ss) * (1.f / D) + EPS);
            unsigned* o = (unsigned*)(H2 + (size_t)(mb + rr) * D) + F.lane;
#pragma unroll
            for (int j = 0; j < 4; ++j) { const f32x4 hh = v[rr][j] * rstd * gg[j] + shv[j]; o[64 * j] = pk4_fp8(hh.x, hh.y, hh.z, hh.w);
                *(LAS f32x4*)(xr + rr * 1024 + 4 * F.lane + 256 * j) = hh; }
        }
        asm volatile("s_waitcnt lgkmcnt(0)" ::: "memory");
        f32x4 acc[2] = {{0.f, 0.f, 0.f, 0.f}, {0.f, 0.f, 0.f, 0.f}};
#pragma unroll 8
        for (int i = 0; i < 64; ++i) { const int k = kq + 16 * i; const float x0 = xr[k], x1 = xr[1024 + k]; const f32x4 w = *(const LAS f32x4*)(rt + k * 16 + 4 * eq); acc[0] += w * x0; acc[1] += w * x1; }
        asm volatile("s_waitcnt lgkmcnt(0)" ::: "memory");
#pragma unroll
        for (int rr = 0; rr < 2; ++rr) { const int m = mb + rr; f32x4 ac = acc[rr];
#pragma unroll
            for (int ofs = 4; ofs < 64; ofs <<= 1) { ac.x += __shfl_xor(ac.x, ofs); ac.y += __shfl_xor(ac.y, ofs); ac.z += __shfl_xor(ac.z, ofs); ac.w += __shfl_xor(ac.w, ofs); }
            float mx = fmaxf(fmaxf(ac.x, ac.y), fmaxf(ac.z, ac.w)); mx = fmaxf(mx, __shfl_xor(mx, 1)); mx = fmaxf(mx, __shfl_xor(mx, 2));
            f32x4 ex; ex.x = __expf(ac.x - mx); ex.y = __expf(ac.y - mx); ex.z = __expf(ac.z - mx); ex.w = __expf(ac.w - mx);
            float sum = (ex.x + ex.y) + (ex.z + ex.w); sum += __shfl_xor(sum, 1); sum += __shfl_xor(sum, 2);
            const float inv = 1.0f / sum;
            if (F.lane < 4) {
                if (m < MLAT) { const int b = m >> 12, s = m & 4095; float* p = AFL + ((size_t)(b * 16 + 4 * F.lane)) * 4096 + s; p[0] = ex.x * inv; p[4096] = ex.y * inv; p[2 * 4096] = ex.z * inv; p[3 * 4096] = ex.w * inv; }
                else { const int b = (m - MLAT) >> 8, s = (m - MLAT) & 255; float* p = AFC + ((size_t)(b * 16 + 4 * F.lane)) * 256 + s; p[0] = ex.x * inv; p[256] = ex.y * inv; p[512] = ex.z * inv; p[768] = ex.w * inv; }
            }
        }
    }
}

DI unsigned block_excl_scan(unsigned v, unsigned& total, LAS unsigned* wsum, int tid, int lane, int wave) {
    unsigned x = v;
#pragma unroll
    for (int o = 1; o < 64; o <<= 1) { const unsigned y = __shfl_up(x, o); if (lane >= o) x += y; }
    if (lane == 63) wsum[wave] = x;
    __syncthreads();
    unsigned base = 0, tot = 0;
#pragma unroll
    for (int w = 0; w < 8; ++w) { const unsigned s = wsum[w]; if (w < wave) base += s; tot += s; }
    __syncthreads();
    total = tot;
    return base + x - v;
}
DI void select_phase(Frame& F, KArgs ka, int l) {
    KA_FRESH(ka); const __attribute__((address_space(4))) Args& a = *ka; frame_fresh(F);
    const bool last = (l == NL - 1);
    const int nunits = last ? 128 : 256;
    LAS unsigned* hist = (LAS unsigned*)F.lds;
    LAS unsigned* wsum = (LAS unsigned*)(F.lds + 8192);
    LAS unsigned* bc = (LAS unsigned*)(F.lds + 8192 + 64);
    LAS int* sel = (LAS int*)(F.lds + 16384);
    const float* AFL = (const float*)(a.ws + WS_AFL); const float* AFC = (const float*)(a.ws + WS_AFC);
    int* smap = (int*)(a.ws + WS_SMAP); float* gate = (float*)(a.ws + WS_GATE);
    const unsigned char* H2 = a.ws + WS_H2; unsigned char* XG = a.ws + WS_XG;
    for (int unit = blockIdx.x; unit < nunits; unit += F.G) {
        const bool lat = unit < 128; const int be = unit & 127, b = be >> 4, e = be & 15;
        const int N = lat ? 4096 : 256, cap = lat ? CAP_LAT : CAP_CTX;
        const float* aff = lat ? AFL + (size_t)be * 4096 : AFC + (size_t)be * 256;
        unsigned key[8]; const int per = lat ? 8 : 1; const bool act = lat || F.tid < 256;
#pragma unroll
        for (int j = 0; j < 8; ++j) key[j] = (act && j < per) ? __float_as_uint(aff[F.tid * per + j]) : 0u;
        unsigned prefix = 0u, pmask = 0u, need = (unsigned)cap;
#pragma unroll
        for (int pass = 0; pass < 3; ++pass) {
            const int shift = pass == 0 ? 21 : (pass == 1 ? 10 : 0), nb = pass == 2 ? 1024 : 2048;
            for (int i = F.tid; i < 2048; i += 512) hist[i] = 0u;
            __syncthreads();
#pragma unroll
            for (int j = 0; j < 8; ++j) if (act && j < per && (key[j] & pmask) == prefix) (void)__hip_atomic_fetch_add(&hist[(key[j] >> shift) & (nb - 1)], 1u, __ATOMIC_RELAXED, __HIP_MEMORY_SCOPE_WORKGROUP);
            __syncthreads();
            unsigned c4[4], mine = 0;
#pragma unroll
            for (int j = 0; j < 4; ++j) { const int bin = 2047 - 4 * F.tid - j; c4[j] = bin < nb ? hist[bin] : 0u; mine += c4[j]; }
            unsigned tot; unsigned run = block_excl_scan(mine, tot, wsum, F.tid, F.lane, F.wave);
#pragma unroll
            for (int j = 0; j < 4; ++j) { const int bin = 2047 - 4 * F.tid - j;
                if (bin < nb && run < need && run + c4[j] >= need) { bc[0] = (unsigned)bin; bc[1] = run; }
                run += c4[j]; }
            __syncthreads();
            const unsigned cb = bc[0], above = bc[1];
            prefix |= cb << shift; pmask |= (unsigned)(nb - 1) << shift; need -= above;
            __syncthreads();
        }
        unsigned neq = 0, ngt = 0;
#pragma unroll
        for (int j = 0; j < 8; ++j) if (act && j < per) { neq += key[j] == prefix; ngt += key[j] > prefix; }
        unsigned teq; const unsigned eqbase = block_excl_scan(neq, teq, wsum, F.tid, F.lane, F.wave);
        unsigned nsel = 0, flags = 0, erun = eqbase;
#pragma unroll
        for (int j = 0; j < 8; ++j) if (act && j < per) { bool s = key[j] > prefix; if (key[j] == prefix) { s = erun < need; ++erun; } if (s) { flags |= 1u << j; ++nsel; } }
        unsigned tsel; unsigned sbase = block_excl_scan(nsel, tsel, wsum, F.tid, F.lane, F.wave);
        const int rowbase = lat ? b * SEQ : MLAT + b * CTX;
        const int slotbase = lat ? be * CAP_LAT : NSLOT_LAT + (e * 8 + b) * CAP_CTX;
#pragma unroll
        for (int j = 0; j < 8; ++j) if (act && j < per) { const int tok = F.tid * per + j; int slot = -1;
            if ((flags >> j) & 1u) { slot = slotbase + (int)sbase; sel[sbase] = tok; gate[slot] = __uint_as_float(key[j]); ++sbase; }
            smap[(size_t)e * MT + rowbase + tok] = slot; }
        __syncthreads();
        if (lat) {
            for (int t0 = F.wave * 16; t0 < cap; t0 += 128) {
                u32x4 rowv[16];
#pragma unroll
                for (int q = 0; q < 16; ++q) rowv[q] = ((const u32x4*)(H2 + (size_t)(rowbase + sel[t0 + q]) * D))[F.lane];
#pragma unroll
                for (int q = 0; q < 16; ++q) ((u32x4*)(XG + (size_t)(slotbase + t0 + q) * D))[F.lane] = rowv[q];
            }
        } else {
            const int t0 = F.wave * 4;
            u32x4 rowv[4];
#pragma unroll
            for (int q = 0; q < 4; ++q) rowv[q] = ((const u32x4*)(H2 + (size_t)(rowbase + sel[t0 + q]) * D))[F.lane];
#pragma unroll
            for (int q = 0; q < 4; ++q) ((u32x4*)(XG + (size_t)(slotbase + t0 + q) * D))[F.lane] = rowv[q];
        }
        __syncthreads();
    }
}

#ifndef Q_INA
#define Q_INA 2
#endif
#ifndef Q_INB
#define Q_INB 4
#endif
#ifndef Q_INC
#define Q_INC 6
#endif
#ifndef Q_MRG
#define Q_MRG 6
#endif
#ifndef Q_WO
#define Q_WO 1
#endif
#ifndef Q_GU
#define Q_GU 2
#endif
#ifndef Q_DN
#define Q_DN 2
#endif
#define TAIL1(nwg_, Q_) do { const int r_ = (nwg_) % F.G; if (!last && r_ != 0) { if (bx >= r_) convert_tail(F, ka, l + 1, cur + 8 * (Q_) * (bx - r_), (Q_)); cur += 8 * (Q_) * (F.G - r_); } } while (0)
DI unsigned char* ws_fresh(KArgs ka) { KA_FRESH(ka); return ka->ws; }
__global__ void __launch_bounds__(512, 2) mega_fwd(Args a_unused) {
    extern __shared__ __attribute__((aligned(16))) unsigned char lds_raw[];
    KArgs ka = (KArgs)__builtin_amdgcn_kernarg_segment_ptr();
    Frame F;
    F.lds = (LAS unsigned char*)lds_raw;
    F.tid = threadIdx.x; F.lane = F.tid & 63; F.wave = __builtin_amdgcn_readfirstlane(F.tid >> 6);
    F.G = gridDim.x; { const int bx = blockIdx.x; F.vcu = (F.G % 8 == 0) ? (bx % 8) * (F.G / 8) + bx / 8 : bx; }
    F.gw = F.vcu * 8 + F.wave; F.ngw = F.G * 8;
    for (int u = F.tid; u < (LDS_BYTES - LDSCTL_OFF) / 4; u += 512) ((LAS unsigned*)(F.lds + LDSCTL_OFF))[u] = 0u;
    __syncthreads();
    XcdBarrier bar = xcd_barrier_post((unsigned*)(ws_fresh(ka) + WS_CTL) + CW_BAR, (volatile LAS unsigned*)(F.lds + LDSCTL_OFF + 32));
#define GRID_BAR() xcd_barrier(bar)
    const int bx = blockIdx.x;

    if (PH(0)) modv_phase(F, ka);
    for (int rep_ = 0; rep_ < REPS(2); ++rep_) if (PH(2)) convert_weights(F, ka, 0, 0);
    GRID_BAR();
    if (PH(3)) row_phase(F, ka, 0);
    GRID_BAR();

    for (int l = 0; l < NL; ++l) {
        const bool last = (l == NL - 1);
        const int nMe = last ? MLAT / 256 : MT / 256;
        const int nMs = last ? NSLOT_LAT / 256 : NSLOT / 256;
        int cur = 0;
        for (int rep_ = 0; rep_ < REPS(4); ++rep_) if (PH(4)) { unsigned char* ws = ws_fresh(ka);
            { pg8::Gemm g{(const bf16_t*)(ws + WS_R4), (const bf16_t*)wsel(ws, l, W_IN), 1024, 1024, 1024, 0}; pg8::Order S; S.init(MT / 256, DINP / 256, F.G, bx);
              pg8::EpiStoreBf16 E{(bf16_t*)(ws + WS_HW), DINP}; pg8::gemm_phase(F.lds, g, S, E); }
            { pg8::Gemm g{(const bf16_t*)(ws + WS_R4 + 68 * MiB), (const bf16_t*)wsel(ws, l, W_GL), 1024, 1024, 1024, 0}; pg8::Order S; S.init(MT / 256, NGL / 256, F.G, (bx + F.G / 2) % F.G);
              pg8::EpiGate E{ws + WS_G}; pg8::gemm_phase<pg8::EpiGate, true>(F.lds, g, S, E); } }
        if (!last && F.G == 256) {
            int q = 0, off = 0;
            if (bx < 128) { q = Q_INA; off = bx * Q_INA; } else if (bx >= 224) { q = Q_INC; off = 128 * Q_INA + 24 * Q_INB + (bx - 224) * Q_INC; } else if (bx >= 200) { q = Q_INB; off = 128 * Q_INA + (bx - 200) * Q_INB; }
            if (q) convert_tail(F, ka, l + 1, cur + 8 * off, q);
            cur += 8 * (128 * Q_INA + 24 * Q_INB + 32 * Q_INC); }
        GRID_BAR();
        for (int rep_ = 0; rep_ < REPS(5); ++rep_) if (PH(5)) { unsigned char* ws = ws_fresh(ka); pg8::Gemm g{(const bf16_t*)(ws + WS_HW) + C_CQ, (const bf16_t*)wsel(ws, l, W_UP), 384, DINP, 384, 0}; pg8::Order S; S.init(MT / 256, UW / 256, F.G, bx);
            pg8::EpiStoreBf16 E{(bf16_t*)(ws + WS_R4), UW}; pg8::gemm_phase(F.lds, g, S, E); }
        for (int rep_ = 0; rep_ < REPS(6); ++rep_) if (PH(6)) prep_phase(F, ka, l);
        GRID_BAR();
        for (int rep_ = 0; rep_ < REPS(7); ++rep_) if (PH(7)) prep2_phase(F, ka, l, rep_);
        GRID_BAR();
        for (int rep_ = 0; rep_ < REPS(8); ++rep_) if (PH(8)) attn_phase(F, ka, l);
        GRID_BAR();
        for (int rep_ = 0; rep_ < REPS(9); ++rep_) if (PH(9)) { unsigned char* ws = ws_fresh(ka); pg8::Order S; S.init(nMe, 4, F.G, bx);
          const unsigned char* OC = ws + WS_OCAT; bf16_t* MG = (bf16_t*)(ws + WS_MERGED); const unsigned char* GL = ws + WS_G;
          { pg8::Gemm3 g{OC, OC + 512, OC + 1024, wsel(ws, l, W_NAO), wsel(ws, l, W_MLAO), wsel(ws, l, W_SWAO), OCW, 512}; pg8::EpiMerge3 E{MG, GL}; pg8::gemm_phase3(F.lds, g, S, E); } }
        TAIL1(nMe * 4, Q_MRG);
        GRID_BAR();
        if (PH(10)) { unsigned char* ws = ws_fresh(ka); pg8::Gemm g{(const bf16_t*)(ws + WS_MERGED), (const bf16_t*)wsel(ws, l, W_O), 1024, 1024, 1024, 0}; pg8::Order S; S.init(nMe, 4, F.G, bx);
            pg8::EpiResid E{(bf16_t*)(ws + WS_XS), (const float*)(ws + WS_MODV) + (size_t)l * 9 * 6144 + 2 * 1024}; pg8::gemm_phase<pg8::EpiResid, true>(F.lds, g, S, E); }
        TAIL1(nMe * 4, Q_WO);
        GRID_BAR();
        for (int rep_ = 0; rep_ < REPS(11); ++rep_) if (PH(11)) norm2_phase(F, ka, l, last ? MLAT : MT);
        GRID_BAR();
        for (int rep_ = 0; rep_ < REPS(12); ++rep_) if (PH(12)) select_phase(F, ka, l);
        GRID_BAR();
        for (int rep_ = 0; rep_ < REPS(13); ++rep_) if (PH(13)) { unsigned char* ws = ws_fresh(ka); pg8::Gemm g{(const bf16_t*)(ws + WS_XG), (const bf16_t*)wsel(ws, l, W_GU), 1024, 1024, 1024, (size_t)2048 * 1024}; pg8::Order S; S.init(nMs, 8, F.G, bx, 1);
            pg8::EpiSwiglu E{ws + WS_ACT}; pg8::gemm_phase<pg8::EpiSwiglu, true>(F.lds, g, S, E); }
        TAIL1(nMs * 8, Q_GU);
        GRID_BAR();
        for (int rep_ = 0; rep_ < REPS(14); ++rep_) if (PH(14)) { unsigned char* ws = ws_fresh(ka); pg8::Gemm g{(const bf16_t*)(ws + WS_ACT), (const bf16_t*)wsel(ws, l, W_DN), 1024, 1024, 1024, (size_t)1024 * 1024}; pg8::Order S; S.init(nMs, 4, F.G, bx, 1);
            pg8::EpiDown E{(bf16_t*)(ws + WS_Y), (const float*)(ws + WS_GATE)}; pg8::gemm_phase<pg8::EpiDown, true>(F.lds, g, S, E); }
        TAIL1(nMs * 4, Q_DN);
        GRID_BAR();
        for (int rep_ = 0; rep_ < REPS(15); ++rep_) if (PH(15)) row_phase(F, ka, l + 1, rep_);
        if (!last) { for (int rep_ = 0; rep_ < REPS(16); ++rep_) if (PH(16)) convert_weights(F, ka, l + 1, cur); GRID_BAR(); }
    }
}

extern "C" void kernel_launch(void* const* d_in, const int* in_sizes, int n_in, void* d_out, int out_size, void* d_ws, size_t ws_size, hipStream_t stream) {
    static int grid = 0;
    if (grid == 0) {
        if (n_in != 29 || in_sizes[0] != MLAT * D || out_size != MLAT * D || ws_size < WS_END) {
            fprintf(stderr, "kernel_launch: unexpected problem: n_in %d in0 %d out %d ws %zu (need %zu)\n", n_in, n_in > 0 ? in_sizes[0] : -1, out_size, ws_size, (size_t)WS_END); grid = -1; return; }
        int dev = 0, cus = 0, per_cu = 0;
        if (hipGetDevice(&dev) != hipSuccess || hipDeviceGetAttribute(&cus, hipDeviceAttributeMultiprocessorCount, dev) != hipSuccess) { fprintf(stderr, "kernel_launch: device query failed\n"); grid = -1; return; }
        if (hipFuncSetAttribute((const void*)mega_fwd, hipFuncAttributeMaxDynamicSharedMemorySize, LDS_BYTES) != hipSuccess) { fprintf(stderr, "kernel_launch: hipFuncSetAttribute failed\n"); grid = -1; return; }
        if (hipOccupancyMaxActiveBlocksPerMultiprocessor(&per_cu, (const void*)mega_fwd, 512, LDS_BYTES) != hipSuccess || per_cu < 1) {
            fprintf(stderr, "kernel_launch: occupancy query reports %d workgroups per CU\n", per_cu); }
        (void)hipGetLastError();
        grid = cus;
    }
    if (grid < 0) return;
    if (hipMemsetAsync((char*)d_ws + WS_CTL, 0, CTL_BYTES, stream) != hipSuccess) { fprintf(stderr, "kernel_launch: memset failed\n"); return; }
    Args a{};
    for (int i = 0; i < 29; ++i) a.in[i] = (const float*)d_in[i];
    a.out = (float*)d_out; a.ws = (unsigned char*)d_ws;
    hipLaunchKernelGGL(mega_fwd, dim3(grid), dim3(512), LDS_BYTES, stream, a);
    const hipError_t le = hipPeekAtLastError();
    if (le != hipSuccess) fprintf(stderr, "kernel_launch: launch failed: %s\n", hipGetErrorName(le));
}
```

```cpp
#include <hip/hip_runtime.h>
#include <cstdio>
#include <cstdint>

#define DI __device__ __forceinline__
#ifndef PH_MASK
#define PH_MASK 0xFFFFF
#endif
#define PH(b) ((PH_MASK >> (b)) & 1)
#ifndef REP_MASK
#define REP_MASK 0
#endif
#define REPS(b) (1 + ((REP_MASK >> (b)) & 1))
#define LAS __attribute__((address_space(3)))
#define GAS __attribute__((address_space(1)))
typedef unsigned short bf16_t;
typedef short bf16x8 __attribute__((ext_vector_type(8)));
typedef short s16x4 __attribute__((ext_vector_type(4)));
typedef float f32x4 __attribute__((ext_vector_type(4)));
typedef float f32x2 __attribute__((ext_vector_type(2)));
typedef float f32x16 __attribute__((ext_vector_type(16)));
typedef unsigned u32x4 __attribute__((ext_vector_type(4)));
typedef unsigned u32x2 __attribute__((ext_vector_type(2)));
typedef int i32x8 __attribute__((ext_vector_type(8)));

constexpr int D = 1024, NB = 8, SEQ = 4096, NL = 4, CTX = 256;
constexpr int MLAT = NB * SEQ, MCTX = NB * CTX, MT = MLAT + MCTX;
constexpr int DIN = 5312, DINP = 2304, NGL = 3072;
constexpr int C_NAQ = 0, C_NAK = 384, C_NAV = 768, C_CQ = 1152, C_CKV = 1408, C_KR = 1536, C_SWQ = 1600, C_SWK = 1984, C_SWV = 2112, C_GL = 2240;
constexpr int UW = 1792;
constexpr int P1W = 1280;
constexpr int P2W = 1536;
constexpr int OCW = 1536;
constexpr int NE = 16, CAP_LAT = 512, CAP_CTX = 32;
constexpr int NSLOT_LAT = NB * NE * CAP_LAT, NSLOT = NSLOT_LAT + NB * NE * CAP_CTX;
constexpr float EPS = 1e-6f;
constexpr float LOG2E = 1.4426950408889634f;

constexpr size_t MiB = 1u << 20;
constexpr size_t WS_CTL = 0, CTL_BYTES = 1 * MiB;
constexpr size_t WS_MODV = 1 * MiB;
constexpr size_t WS_W = 2 * MiB;
constexpr size_t W_IN = 0, W_GL = 4718592  , W_UP = 11010048, W_NAO = 7864320  , W_MLAO = 13172736, W_SWAO = 8912896  , W_O = 15007744, W_GU = 17104896, W_DN = 84213760, W_END = 117768192;
constexpr size_t WS_XS = 115 * MiB, WS_W2 = 183 * MiB  ;
constexpr size_t WS_HW = 251 * MiB;
constexpr size_t WS_G = WS_HW + 153 * MiB;
constexpr size_t WS_P1 = 608 * MiB;
constexpr size_t WS_P2 = 693 * MiB;
constexpr size_t WS_R4 = 795 * MiB;
constexpr size_t WS_AFL = 914 * MiB;
constexpr size_t WS_AFC = 916 * MiB;
constexpr size_t WS_SMAP = 917 * MiB;
constexpr size_t WS_GATE = 920 * MiB;
constexpr size_t WS_OCAT = 921 * MiB;
constexpr size_t WS_END = 1006 * MiB;
constexpr size_t WS_MERGED = WS_P1;
constexpr size_t WS_H2 = WS_HW;
constexpr size_t WS_XG = WS_HW + 68 * MiB;
constexpr size_t WS_ACT = WS_HW + 204 * MiB;
constexpr size_t WS_Y = WS_HW + 340 * MiB;
static_assert(W_END <= 113 * MiB && WS_W + 113 * MiB <= WS_XS, "weights");
static_assert(W_GU + 64 * MiB <= W_DN && W_DN + 32 * MiB <= 113 * MiB && WS_XS + (size_t)MT * D * 2 <= WS_W2 && WS_W2 + W_GU <= WS_HW, "second weight buffers");
static_assert(WS_XS + (size_t)MT * D * 4 <= WS_HW && WS_HW + (size_t)MT * DINP * 2 <= WS_G && WS_G + (size_t)MT * NGL * 2 <= WS_P1 && WS_P1 + (size_t)MT * P1W * 2 <= WS_P2 && WS_P2 + (size_t)MT * P2W * 2 <= WS_R4, "map");
static_assert(WS_R4 + (size_t)MT * UW * 2 <= WS_AFL && WS_Y + (size_t)NSLOT * D * 2 <= WS_R4 && WS_SMAP + (size_t)16 * MT * 4 <= WS_GATE && WS_GATE + (size_t)NSLOT * 4 <= WS_OCAT && WS_OCAT + (size_t)MT * OCW <= WS_END, "map2");
constexpr int CW_BAR = 4096;

constexpr int RING_BYTES = 131072, LDSCTL_OFF = RING_BYTES, LDS_BYTES = 147456;

DI unsigned pk2(float lo, float hi) { unsigned r; asm("v_cvt_pk_bf16_f32 %0, %1, %2" : "=v"(r) : "v"(lo), "v"(hi)); return r; }
DI unsigned pk4_fp8(float a, float b, float c, float d) { int w = 0; w = __builtin_amdgcn_cvt_pk_fp8_f32(a, b, w, false); w = __builtin_amdgcn_cvt_pk_fp8_f32(c, d, w, true); return (unsigned)w; }
DI float bflo(unsigned w) { return __uint_as_float(w << 16); }
DI float bfhi(unsigned w) { return __uint_as_float(w & 0xffff0000u); }
DI float bf2f(bf16_t b) { return __uint_as_float((unsigned)b << 16); }
DI float wave_sum(float v) {
#pragma unroll
    for (int o = 1; o < 64; o <<= 1) v += __shfl_xor(v, o);
    return v;
}
DI float sigmoidf_(float x) { return __builtin_amdgcn_rcpf(1.0f + __builtin_amdgcn_exp2f(-x * LOG2E)); }
DI int mod_index(int row) { return row < MLAT ? (row >> 12) : 8; }

#define XB_TMO      128
#define XB_XCNT(j)  (256  + 64 * (j))
#define XB_XSUB(j)  (1280 + 64 * (j))
#define XB_XGEN(j)  (2304 + 64 * (j))
#define XB_TOP      3328
#define XB_TOPGEN   3392
#define XCD_BAR_WORDS 3456
#define XB_SPIN_CAP (1u << 18)
DI unsigned xb_ld(unsigned* p)              { return __hip_atomic_load(p, __ATOMIC_RELAXED, __HIP_MEMORY_SCOPE_AGENT); }
DI unsigned xb_add(unsigned* p, unsigned v) { return __hip_atomic_fetch_add(p, v, __ATOMIC_RELAXED, __HIP_MEMORY_SCOPE_AGENT); }
DI unsigned xb_xcc_id() { return (unsigned)__builtin_amdgcn_s_getreg((3 << 11) | 20) & 0xFu; }
#define XB_SPIN(cond, bar) do { unsigned _sp = 0; while (cond) { __builtin_amdgcn_s_sleep(1); \
    if ((++_sp & 255u) == 0u) { if (xb_ld(&(bar)[XB_TMO])) break; if (_sp > XB_SPIN_CAP) { atomicAdd(&(bar)[XB_TMO], 1u); break; } } } } while (0)
struct XcdBarrier { unsigned* bar; unsigned x; volatile LAS unsigned* st; };
DI XcdBarrier xcd_barrier_post(unsigned* bar, volatile LAS unsigned* st) {
    XcdBarrier b; b.bar = bar; b.x = xb_xcc_id(); b.st = st;
    if (threadIdx.x == 0) (void)xb_add(&bar[XB_XCNT(b.x)], 1u);
    return b;
}
DI void xcd_barrier_complete(unsigned* bar, unsigned x, unsigned& nloc, unsigned& nx) {
    const unsigned G = gridDim.x * gridDim.y * gridDim.z;
    unsigned sum, cnt, mine, sp = 0u;
    for (;;) {
        sum = 0u; cnt = 0u; mine = 0u;
#pragma unroll
        for (unsigned j = 0; j < 16; ++j) { const unsigned c = xb_ld(&bar[XB_XCNT(j)]); sum += c; cnt += (c > 0u) ? 1u : 0u; mine = (j == x) ? c : mine; }
        if (sum == G) break;
        __builtin_amdgcn_s_sleep(1);
        if ((++sp & 255u) == 0u) { if (xb_ld(&bar[XB_TMO])) break; if (sp > XB_SPIN_CAP) { atomicAdd(&bar[XB_TMO], 1u); break; } }
    }
    nloc = mine > 0u ? mine : 1u; nx = cnt > 0u ? cnt : 1u;
}
DI void xcd_barrier(const XcdBarrier& b) {
    asm volatile("s_waitcnt vmcnt(0)" ::: "memory");
    __syncthreads();
    if (threadIdx.x == 0) {
        unsigned* bar = b.bar; unsigned bx_ = b.x; asm volatile("" : "+s"(bar), "+s"(bx_));
        __builtin_amdgcn_s_waitcnt(0);
        unsigned nloc = b.st[0], nx = b.st[1];
        if (nloc == 0u) { xcd_barrier_complete(bar, bx_, nloc, nx); b.st[0] = nloc; b.st[1] = nx; }
        const unsigned old = xb_add(&bar[XB_XSUB(bx_)], 1u);
        const unsigned gen = old / nloc;
        if (old + 1u == (gen + 1u) * nloc) {
            __builtin_amdgcn_fence(__ATOMIC_RELEASE, "agent");
            asm volatile("s_waitcnt vmcnt(0)" ::: "memory");
            const unsigned og = xb_add(&bar[XB_TOP], 1u);
            const unsigned tg = og / nx;
            if (og + 1u == (tg + 1u) * nx) xb_add(&bar[XB_TOPGEN], 1u);
            else XB_SPIN(xb_ld(&bar[XB_TOPGEN]) == tg, bar);
            __builtin_amdgcn_fence(__ATOMIC_ACQUIRE, "agent");
            xb_add(&bar[XB_XGEN(bx_)], 1u);
            asm volatile("s_waitcnt vmcnt(0)" ::: "memory");
        } else {
            XB_SPIN(xb_ld(&bar[XB_XGEN(bx_)]) == gen, bar);
            __builtin_amdgcn_fence(__ATOMIC_ACQUIRE, "agent");
            asm volatile("s_waitcnt vmcnt(0)" ::: "memory");
        }
    }
    __syncthreads();
}

namespace pg8 {
constexpr int BM = 256, BK = 64, HALF = 128, HTB = HALF * BK * 2, NXCD = 8, WGM = 8;
__host__ __device__ __forceinline__ int lds_byte(int r, int c) { const int st = (r >> 4) * 2 + (c >> 5), rr = r & 15, cc = c & 31, ob = rr * 64 + cc * 2; return st * 1024 + (ob ^ (((ob >> 9) & 1) << 5)); }
__host__ __device__ __forceinline__ void stage_rc(int b, int& R, int& C) { const int st = b / 1024, sb = b % 1024, swz = sb ^ (((sb >> 9) & 1) << 5); R = (st >> 1) * 16 + swz / 64; C = (st & 1) * 32 + (swz % 64) / 2; }
__host__ __device__ __forceinline__ int perm32(int rho) { const int n = rho >> 4, i = rho & 15; return 8 * (i >> 2) + 4 * n + (i & 3); }
struct Unit { int pm, pn; };
struct Gemm { const bf16_t* A; const bf16_t* Bt; int K, lda, ldb; size_t estride; };
struct Order {
    int nM, nN, nwg, G, c, moe;
    DI void init(int nM_, int nN_, int G_, int c_, int moe_ = 0) { nM = nM_; nN = nN_; nwg = nM * nN; G = G_; c = c_; moe = moe_; }
    DI bool next(int i, Unit& u) const {
        const long L = (long)i * G + c; if (L >= nwg) return false;
        int wgid = (int)L; { const int q = nwg / NXCD, r = nwg % NXCD, xcd = wgid % NXCD, off = wgid / NXCD; wgid = (xcd < r ? xcd * (q + 1) : r * (q + 1) + (xcd - r) * q) + off; }
        const int nig = WGM * nN, gid = wgid / nig, fm = gid * WGM, gsz = (nM - fm) < WGM ? (nM - fm) : WGM;
        u.pm = fm + ((wgid % nig) % gsz); u.pn = (wgid % nig) / gsz;
        if (moe && u.pm < 256) { const int e = u.pm >> 4, b = (u.pm >> 1) & 7, hf = u.pm & 1; u.pm = (((b << 4) | e) << 1) | hf; }
        return true;
    }
};
struct EpiStoreBf16 {
    static constexpr bool PERM = true;
    bf16_t* O; int ldc;
    DI void operator()(const f32x4 (&acc)[2][2][4][2], const Unit& u, int wr, int wc, int fr, int fq) const {
        const int row0 = u.pm * BM + wr * 64 + fr, col0 = u.pn * BM + wc * 32 + 8 * fq;
#pragma unroll
        for (int ai = 0; ai < 2; ++ai)
#pragma unroll
            for (int m = 0; m < 4; ++m) { bf16_t* rowp = O + (size_t)(row0 + ai * HALF + m * 16) * ldc + col0;
#pragma unroll
                for (int bj = 0; bj < 2; ++bj) { const f32x4 v0 = acc[ai][bj][m][0], v1 = acc[ai][bj][m][1];
                    u32x4 w; w.x = pk2(v0[0], v0[1]); w.y = pk2(v0[2], v0[3]); w.z = pk2(v1[0], v1[1]); w.w = pk2(v1[2], v1[3]);
                    *(u32x4*)(rowp + bj * HALF) = w; } }
    }
};
DI unsigned pk4_u8(float a, float b, float c, float d) {
    unsigned ua = (unsigned)(a * 255.0f + 0.5f), ub = (unsigned)(b * 255.0f + 0.5f), uc = (unsigned)(c * 255.0f + 0.5f), ud = (unsigned)(d * 255.0f + 0.5f);
    ua = ua < 1u ? 1u : ua; ub = ub < 1u ? 1u : ub; uc = uc < 1u ? 1u : uc; ud = ud < 1u ? 1u : ud;
    return ua | (ub << 8) | (uc << 16) | (ud << 24);
}
struct EpiGate {
    static constexpr bool PERM = true;
    unsigned char* O;
    DI void operator()(const f32x4 (&acc)[2][2][4][2], const Unit& u, int wr, int wc, int fr, int fq) const {
        const int row0 = u.pm * BM + wr * 64 + fr, col0 = u.pn * BM + wc * 32 + 8 * fq;
#pragma unroll
        for (int ai = 0; ai < 2; ++ai)
#pragma unroll
            for (int m = 0; m < 4; ++m) { unsigned char* rowp = O + (size_t)(row0 + ai * HALF + m * 16) * NGL + col0;
#pragma unroll
                for (int bj = 0; bj < 2; ++bj) { const f32x4 v0 = acc[ai][bj][m][0] * 0.03125f, v1 = acc[ai][bj][m][1] * 0.03125f;
                    u32x2 w; w.x = pk4_u8(sigmoidf_(v0[0]), sigmoidf_(v0[1]), sigmoidf_(v0[2]), sigmoidf_(v0[3])); w.y = pk4_u8(sigmoidf_(v1[0]), sigmoidf_(v1[1]), sigmoidf_(v1[2]), sigmoidf_(v1[3]));
                    *(u32x2*)(rowp + bj * HALF) = w; } }
    }
};
DI float u8f(unsigned w, int k) { return (float)((w >> (8 * k)) & 0xffu) * (1.0f / 255.0f); }
struct EpiMerge {
    static constexpr bool PERM = true;
    bf16_t* O; const unsigned char* gl; int first;
    DI void operator()(const f32x4 (&acc)[2][2][4][2], const Unit& u, int wr, int wc, int fr, int fq) const {
        const int row0 = u.pm * BM + wr * 64 + fr, col0 = u.pn * BM + wc * 32 + 8 * fq;
#pragma unroll
        for (int ai = 0; ai < 2; ++ai) {
            u32x2 g[4][2]; u32x4 p[4][2];
#pragma unroll
            for (int m = 0; m < 4; ++m)
#pragma unroll
                for (int bj = 0; bj < 2; ++bj) { const int row = row0 + ai * HALF + m * 16, col = col0 + bj * HALF;
                    g[m][bj] = *(const u32x2*)(gl + (size_t)row * NGL + col);
                    p[m][bj] = first ? (u32x4){0u, 0u, 0u, 0u} : *(const u32x4*)(O + (size_t)row * D + col); }
#pragma unroll
            for (int m = 0; m < 4; ++m)
#pragma unroll
                for (int bj = 0; bj < 2; ++bj) { const int row = row0 + ai * HALF + m * 16, col = col0 + bj * HALF;
                    const u32x2 gg = g[m][bj]; const u32x4 pp = p[m][bj]; const f32x4 v0 = acc[ai][bj][m][0], v1 = acc[ai][bj][m][1];
                    const float r0 = v0[0] * u8f(gg.x, 0) + bflo(pp.x), r1 = v0[1] * u8f(gg.x, 1) + bfhi(pp.x), r2 = v0[2] * u8f(gg.x, 2) + bflo(pp.y), r3 = v0[3] * u8f(gg.x, 3) + bfhi(pp.y);
                    const float r4 = v1[0] * u8f(gg.y, 0) + bflo(pp.z), r5 = v1[1] * u8f(gg.y, 1) + bfhi(pp.z), r6 = v1[2] * u8f(gg.y, 2) + bflo(pp.w), r7 = v1[3] * u8f(gg.y, 3) + bfhi(pp.w);
                    u32x4 w; w.x = pk2(r0, r1); w.y = pk2(r2, r3); w.z = pk2(r4, r5); w.w = pk2(r6, r7);
                    *(u32x4*)(O + (size_t)row * D + col) = w; }
        }
    }
};
struct EpiResid {
    static constexpr bool PERM = true;
    bf16_t* xs; const float* modg;
    DI void operator()(const f32x4 (&acc)[2][2][4][2], const Unit& u, int wr, int wc, int fr, int fq) const {
        const int row0 = u.pm * BM + wr * 64 + fr, col0 = u.pn * BM + wc * 32 + 8 * fq;
        const float* mp = modg + (size_t)mod_index(u.pm * BM) * 6144 + col0;
        f32x4 g0[2], g1[2];
#pragma unroll
        for (int bj = 0; bj < 2; ++bj) { g0[bj] = *(const f32x4*)(mp + bj * HALF) * (1.0f / 128.0f); g1[bj] = *(const f32x4*)(mp + bj * HALF + 4) * (1.0f / 128.0f); }
#pragma unroll
        for (int ai = 0; ai < 2; ++ai)
#pragma unroll
            for (int mh = 0; mh < 2; ++mh) {
                u32x4 xw[2][2];
#pragma unroll
                for (int m2 = 0; m2 < 2; ++m2)
#pragma unroll
                    for (int bj = 0; bj < 2; ++bj) xw[m2][bj] = *(const u32x4*)(xs + (size_t)(row0 + ai * HALF + (2 * mh + m2) * 16) * D + col0 + bj * HALF);
#pragma unroll
                for (int m2 = 0; m2 < 2; ++m2)
#pragma unroll
                    for (int bj = 0; bj < 2; ++bj) { const int m = 2 * mh + m2; const u32x4 x = xw[m2][bj];
                        const f32x4 x0 = (f32x4){bflo(x.x), bfhi(x.x), bflo(x.y), bfhi(x.y)} + g0[bj] * acc[ai][bj][m][0];
                        const f32x4 x1 = (f32x4){bflo(x.z), bfhi(x.z), bflo(x.w), bfhi(x.w)} + g1[bj] * acc[ai][bj][m][1];
                        u32x4 w; w.x = pk2(x0[0], x0[1]); w.y = pk2(x0[2], x0[3]); w.z = pk2(x1[0], x1[1]); w.w = pk2(x1[2], x1[3]);
                        *(u32x4*)(xs + (size_t)(row0 + ai * HALF + m * 16) * D + col0 + bj * HALF) = w; }
            }
    }
};
struct EpiSwiglu {
    static constexpr bool PERM = true;
    unsigned char* O;
    DI void operator()(const f32x4 (&acc)[2][2][4][2], const Unit& u, int wr, int wc, int fr, int fq) const {
        const int row0 = u.pm * BM + wr * 64 + fr, col0 = u.pn * HALF + wc * 32 + 8 * fq;
#pragma unroll
        for (int ai = 0; ai < 2; ++ai)
#pragma unroll
            for (int m = 0; m < 4; ++m) { const int row = row0 + ai * HALF + m * 16;
                const f32x4 a0 = acc[ai][0][m][0] * 0.03125f, a1 = acc[ai][0][m][1] * 0.03125f, u0 = acc[ai][1][m][0] * 0.25f, u1 = acc[ai][1][m][1] * 0.25f;
                float r[8];
#pragma unroll
                for (int j = 0; j < 4; ++j) { r[j] = a0[j] * sigmoidf_(a0[j]) * u0[j]; r[4 + j] = a1[j] * sigmoidf_(a1[j]) * u1[j]; }
                u32x2 w; w.x = pk4_fp8(r[0], r[1], r[2], r[3]); w.y = pk4_fp8(r[4], r[5], r[6], r[7]);
                *(u32x2*)(O + (size_t)row * D + col0) = w; }
    }
};
struct EpiDown {
    static constexpr bool PERM = true;
    bf16_t* O; const float* gate;
    DI void operator()(const f32x4 (&acc)[2][2][4][2], const Unit& u, int wr, int wc, int fr, int fq) const {
        const int row0 = u.pm * BM + wr * 64 + fr, col0 = u.pn * BM + wc * 32 + 8 * fq;
        float gv[2][4];
#pragma unroll
        for (int ai = 0; ai < 2; ++ai)
#pragma unroll
            for (int m = 0; m < 4; ++m) gv[ai][m] = gate[row0 + ai * HALF + m * 16] * (1.0f / 256.0f);
#pragma unroll
        for (int ai = 0; ai < 2; ++ai)
#pragma unroll
            for (int m = 0; m < 4; ++m) { const int row = row0 + ai * HALF + m * 16; const float g = gv[ai][m]; bf16_t* rowp = O + (size_t)row * D + col0;
#pragma unroll
                for (int bj = 0; bj < 2; ++bj) { const f32x4 v0 = acc[ai][bj][m][0] * g, v1 = acc[ai][bj][m][1] * g;
                    u32x4 w; w.x = pk2(v0[0], v0[1]); w.y = pk2(v0[2], v0[3]); w.z = pk2(v1[0], v1[1]); w.w = pk2(v1[2], v1[3]);
                    *(u32x4*)(rowp + bj * HALF) = w; } }
    }
};

struct EpiMerge3 {
    static constexpr bool PERM = true;
    bf16_t* O; const unsigned char* gl;
    DI void operator()(f32x4 (&acc)[2][2][4][2], const Unit& u, int seg, int wr, int wc, int fr, int fq) const {
        const int row0 = u.pm * BM + wr * 64 + fr, col0 = u.pn * BM + wc * 32 + 8 * fq;
#pragma unroll
        for (int ai = 0; ai < 2; ++ai) {
            u32x2 ga[4][2], gb[4][2];
#pragma unroll
            for (int m = 0; m < 4; ++m)
#pragma unroll
                for (int bj = 0; bj < 2; ++bj) { const unsigned char* gp = gl + (size_t)(row0 + ai * HALF + m * 16) * NGL + 1024 * seg + col0 + bj * HALF;
                    ga[m][bj] = *(const u32x2*)gp; gb[m][bj] = seg < 2 ? *(const u32x2*)(gp + 1024) : (u32x2){0u, 0u}; }
#pragma unroll
            for (int m = 0; m < 4; ++m)
#pragma unroll
                for (int bj = 0; bj < 2; ++bj) {
                    f32x4 s0, s1;
#pragma unroll
                    for (int k = 0; k < 4; ++k) { const float a0 = (float)((ga[m][bj].x >> (8 * k)) & 0xffu), a1 = (float)((ga[m][bj].y >> (8 * k)) & 0xffu);
                        if (seg < 2) { const float b0 = (float)((gb[m][bj].x >> (8 * k)) & 0xffu), b1 = (float)((gb[m][bj].y >> (8 * k)) & 0xffu); s0[k] = a0 * __builtin_amdgcn_rcpf(b0); s1[k] = a1 * __builtin_amdgcn_rcpf(b1); }
                        else { s0[k] = a0 * (1.0f / (255.0f * 128.0f)); s1[k] = a1 * (1.0f / (255.0f * 128.0f)); } }
                    acc[ai][bj][m][0] *= s0; acc[ai][bj][m][1] *= s1;
                    if (seg == 2) { const f32x4 v0 = acc[ai][bj][m][0] * 4.0f, v1 = acc[ai][bj][m][1] * 4.0f;
                        u32x2 w; w.x = pk4_fp8(v0[0], v0[1], v0[2], v0[3]); w.y = pk4_fp8(v1[0], v1[1], v1[2], v1[3]);
                        *(u32x2*)((unsigned char*)O + (size_t)(row0 + ai * HALF + m * 16) * D + col0 + bj * HALF) = w; }
                }
        }
    }
};
struct Gemm3 { const unsigned char* A0; const unsigned char* A1; const unsigned char* A2; const unsigned char* B0; const unsigned char* B1; const unsigned char* B2; int lda, ldb; };
template <class Epi>
DI void gemm_phase3(LAS unsigned char* lds, const Gemm3 g, const Order& S, const Epi& E) {
    int tid_ = threadIdx.x; asm volatile("" : "+v"(tid_));
    const int tid = tid_, wid = __builtin_amdgcn_readfirstlane(tid >> 6), lane = tid & 63, wr = wid >> 2, wc = wid & 3, fr = lane & 15, fq = lane >> 4;
    unsigned voffA[2], voffB[2];
#pragma unroll
    for (int i = 0; i < 2; ++i) { int R, C; stage_rc(tid * 16 + i * 8192, R, C); const int Rb = Epi::PERM ? ((R & ~31) + perm32(R & 31)) : R;
        voffA[i] = (unsigned)(R * g.lda + C * 2); voffB[i] = (unsigned)(Rb * g.ldb + C * 2); }
    const size_t kstep = (size_t)(BK * 2);
    const size_t hstepA = (size_t)HALF * g.lda, hstepB = (size_t)HALF * g.ldb;
    const size_t tstepA = 2 * hstepA, tstepB = 2 * hstepB;
    const unsigned ldsw = (unsigned)wid * 1024u;
    const int aoff = lds_byte(wr * 64 + fr, fq * 8), boff = lds_byte(wc * 32 + fr, fq * 8);
#define PG8_SA(b, h) (((b) * 2 + (h)) * HTB)
#define PG8_SB(b, h) ((4 + (b) * 2 + (h)) * HTB)
#define PG8_STAGE(bufoff, gbase, voff) do { _Pragma("unroll") for (int _i = 0; _i < 2; ++_i) \
        __builtin_amdgcn_global_load_lds((const unsigned*)((const char*)(gbase) + (voff)[_i]), (LAS unsigned*)(lds + (bufoff) + ldsw + _i * 8192), 16, 0, 0); } while (0)
#define PG8_LDA(dst, b, h) do { _Pragma("unroll") for (int m = 0; m < 4; ++m) _Pragma("unroll") for (int k = 0; k < 2; ++k) dst[m][k] = *(const LAS bf16x8*)(lds + PG8_SA(b, h) + aoff + m * 2048 + k * 1024); } while (0)
#define PG8_LDB(dst, b, h) do { _Pragma("unroll") for (int n = 0; n < 2; ++n) _Pragma("unroll") for (int k = 0; k < 2; ++k) dst[n][k] = *(const LAS bf16x8*)(lds + PG8_SB(b, h) + boff + n * 2048 + k * 1024); } while (0)
#define PG8_MMA(ai, bj, At, Bt) do { __builtin_amdgcn_s_setprio(1); _Pragma("unroll") for (int m = 0; m < 4; ++m) _Pragma("unroll") for (int n = 0; n < 2; ++n) { \
        const i32x8 bb_ = __builtin_bit_cast(i32x8, __builtin_shufflevector(Bt[n][0], Bt[n][1], 0, 1, 2, 3, 4, 5, 6, 7, 8, 9, 10, 11, 12, 13, 14, 15)); \
        const i32x8 aa_ = __builtin_bit_cast(i32x8, __builtin_shufflevector(At[m][0], At[m][1], 0, 1, 2, 3, 4, 5, 6, 7, 8, 9, 10, 11, 12, 13, 14, 15)); \
        asm volatile("v_mfma_scale_f32_16x16x128_f8f6f4 %0, %1, %2, %0, %3, %3 op_sel_hi:[0,0,0]" : "+v"(acc[ai][bj][m][n]) : "v"(bb_), "v"(aa_), "v"(0x7F7F7F7F)); } \
        __builtin_amdgcn_s_setprio(0); } while (0)
#define PG8_WAIT_V(n) asm volatile("s_waitcnt vmcnt(" #n ")" ::: "memory")
#define PG8_WAIT_L(n) asm volatile("s_waitcnt lgkmcnt(" #n ")" ::: "memory")
#define PG8_BAR __builtin_amdgcn_s_barrier()
#define PG8_SCHED __builtin_amdgcn_sched_barrier(0)
#define PG8_A3(sg, u) ((const char*)((sg) == 0 ? g.A0 : (sg) == 1 ? g.A1 : g.A2) + (size_t)(u).pm * tstepA)
#define PG8_B3(sg, u) ((const char*)((sg) == 0 ? g.B0 : (sg) == 1 ? g.B1 : g.B2) + (size_t)(u).pn * tstepB)
    Unit cur, nu; int ui = 0, seg = 0;
    if (!S.next(0, cur)) return;
    f32x4 acc[2][2][4][2];
#pragma unroll
    for (int a = 0; a < 2; ++a)
#pragma unroll
        for (int b = 0; b < 2; ++b)
#pragma unroll
            for (int m = 0; m < 4; ++m)
#pragma unroll
                for (int n = 0; n < 2; ++n) acc[a][b][m][n] = (f32x4){0.f, 0.f, 0.f, 0.f};
    bf16x8 At[4][2], B0[2][2], B1[2][2];
    const char* cA = PG8_A3(0, cur); const char* cB = PG8_B3(0, cur);
    PG8_STAGE(PG8_SB(0, 0), cB, voffB); PG8_STAGE(PG8_SB(0, 1), cB + hstepB, voffB); PG8_STAGE(PG8_SA(0, 0), cA, voffA); PG8_STAGE(PG8_SA(0, 1), cA + hstepA, voffA);
    if (wr == 1) PG8_BAR;
    PG8_WAIT_V(2); PG8_BAR;
    PG8_STAGE(PG8_SB(1, 0), cB + kstep, voffB); PG8_STAGE(PG8_SA(1, 0), cA + kstep, voffA); PG8_STAGE(PG8_SB(1, 1), cB + hstepB + kstep, voffB);
    PG8_WAIT_V(6); PG8_BAR;
    for (;;) {
        int nseg = seg + 1; bool has_next = true; nu = cur;
        if (nseg == 3) { nseg = 0; has_next = S.next(ui + 1, nu); }
        const char* nA = has_next ? PG8_A3(nseg, nu) : cA; const char* nB = has_next ? PG8_B3(nseg, nu) : cB;
        int nt_ = 4; asm volatile("" : "+s"(nt_));
        const int nt = nt_;
#pragma nounroll
        for (int t = 0; t < nt; t += 2) {
            const bool last = (t == nt - 2);
            const char* a1 = cA + (size_t)(t + 1) * kstep;
            const char* a2 = last ? nA : cA + (size_t)(t + 2) * kstep; const char* b2 = last ? nB : cB + (size_t)(t + 2) * kstep;
            const char* a3 = a2 + kstep; const char* b3 = b2 + kstep;
            PG8_LDB(B0, 0, 0); PG8_LDB(B1, 0, 1); PG8_SCHED; PG8_LDA(At, 0, 0); PG8_STAGE(PG8_SA(1, 1), a1 + hstepA, voffA);
            PG8_WAIT_V(8); PG8_WAIT_L(0); PG8_BAR; PG8_MMA(0, 0, At, B0); PG8_MMA(0, 1, At, B1); PG8_BAR; PG8_SCHED;
            PG8_LDA(At, 0, 1); PG8_STAGE(PG8_SB(0, 0), b2, voffB); PG8_STAGE(PG8_SB(0, 1), b2 + hstepB, voffB); PG8_STAGE(PG8_SA(0, 0), a2, voffA);
            PG8_WAIT_V(8); PG8_WAIT_L(0); PG8_BAR; PG8_MMA(1, 0, At, B0); PG8_MMA(1, 1, At, B1); PG8_BAR; PG8_SCHED;
            PG8_LDB(B0, 1, 0); PG8_LDB(B1, 1, 1); PG8_SCHED; PG8_LDA(At, 1, 0); PG8_STAGE(PG8_SA(0, 1), a2 + hstepA, voffA);
            PG8_WAIT_V(8); PG8_WAIT_L(0); PG8_BAR; PG8_MMA(0, 0, At, B0); PG8_MMA(0, 1, At, B1); PG8_BAR; PG8_SCHED;
            PG8_LDA(At, 1, 1); PG8_STAGE(PG8_SB(1, 0), b3, voffB); PG8_STAGE(PG8_SB(1, 1), b3 + hstepB, voffB); PG8_STAGE(PG8_SA(1, 0), a3, voffA);
            PG8_WAIT_V(8); PG8_WAIT_L(0); PG8_BAR; PG8_MMA(1, 0, At, B0); PG8_MMA(1, 1, At, B1); PG8_BAR; PG8_SCHED;
        }
        if (wr == 0) PG8_BAR;
        E(acc, cur, seg, wr, wc, fr, fq);
        if (!has_next) break;
        if (seg == 2) {
#pragma unroll
            for (int a = 0; a < 2; ++a)
#pragma unroll
                for (int b = 0; b < 2; ++b)
#pragma unroll
                    for (int m = 0; m < 4; ++m)
#pragma unroll
                        for (int n = 0; n < 2; ++n) acc[a][b][m][n] = (f32x4){0.f, 0.f, 0.f, 0.f};
            cur = nu; ++ui;
        }
        seg = nseg; cA = nA; cB = nB;
        if (wr == 1) PG8_BAR;
    }
    PG8_WAIT_V(0);
    PG8_BAR;
#undef PG8_SA
#undef PG8_SB
#undef PG8_STAGE
#undef PG8_LDA
#undef PG8_LDB
#undef PG8_MMA
#undef PG8_WAIT_V
#undef PG8_WAIT_L
#undef PG8_BAR
#undef PG8_SCHED
#undef PG8_A3
#undef PG8_B3
}

template <class Epi, bool FP8 = false>
DI void gemm_phase(LAS unsigned char* lds, const Gemm g, const Order& S, const Epi& E) {
    constexpr int ESZ = FP8 ? 1 : 2;
    int tid_ = threadIdx.x; asm volatile("" : "+v"(tid_));
    const int tid = tid_, wid = __builtin_amdgcn_readfirstlane(tid >> 6), lane = tid & 63, wr = wid >> 2, wc = wid & 3, fr = lane & 15, fq = lane >> 4;
    const int K = g.K, nt = K * ESZ / (BK * 2);
    unsigned voffA[2], voffB[2];
#pragma unroll
    for (int i = 0; i < 2; ++i) { int R, C; stage_rc(tid * 16 + i * 8192, R, C); const int Rb = Epi::PERM ? ((R & ~31) + perm32(R & 31)) : R;
        voffA[i] = (unsigned)(R * g.lda * ESZ + C * 2); voffB[i] = (unsigned)(Rb * g.ldb * ESZ + C * 2); }
    const size_t kstep = (size_t)(BK * 2);
    const size_t hstepA = (size_t)HALF * g.lda * ESZ, hstepB = (size_t)HALF * g.ldb * ESZ;
    const size_t tstepA = 2 * hstepA, tstepB = 2 * hstepB;
    const unsigned ldsw = (unsigned)wid * 1024u;
    const int aoff = lds_byte(wr * 64 + fr, fq * 8), boff = lds_byte(wc * 32 + fr, fq * 8);
#define PG8_SA(b, h) (((b) * 2 + (h)) * HTB)
#define PG8_SB(b, h) ((4 + (b) * 2 + (h)) * HTB)
#define PG8_STAGE(bufoff, gbase, voff) do { _Pragma("unroll") for (int _i = 0; _i < 2; ++_i) \
        __builtin_amdgcn_global_load_lds((const unsigned*)((const char*)(gbase) + (voff)[_i]), (LAS unsigned*)(lds + (bufoff) + ldsw + _i * 8192), 16, 0, 0); } while (0)
#define PG8_LDA(dst, b, h) do { _Pragma("unroll") for (int m = 0; m < 4; ++m) _Pragma("unroll") for (int k = 0; k < 2; ++k) dst[m][k] = *(const LAS bf16x8*)(lds + PG8_SA(b, h) + aoff + m * 2048 + k * 1024); } while (0)
#define PG8_LDB(dst, b, h) do { _Pragma("unroll") for (int n = 0; n < 2; ++n) _Pragma("unroll") for (int k = 0; k < 2; ++k) dst[n][k] = *(const LAS bf16x8*)(lds + PG8_SB(b, h) + boff + n * 2048 + k * 1024); } while (0)
#define PG8_MMA(ai, bj, At, Bt) do { __builtin_amdgcn_s_setprio(1); _Pragma("unroll") for (int m = 0; m < 4; ++m) _Pragma("unroll") for (int n = 0; n < 2; ++n) { \
        if constexpr (FP8) { const i32x8 bb_ = __builtin_bit_cast(i32x8, __builtin_shufflevector(Bt[n][0], Bt[n][1], 0, 1, 2, 3, 4, 5, 6, 7, 8, 9, 10, 11, 12, 13, 14, 15)); \
            const i32x8 aa_ = __builtin_bit_cast(i32x8, __builtin_shufflevector(At[m][0], At[m][1], 0, 1, 2, 3, 4, 5, 6, 7, 8, 9, 10, 11, 12, 13, 14, 15)); \
            asm volatile("v_mfma_scale_f32_16x16x128_f8f6f4 %0, %1, %2, %0, %3, %3 op_sel_hi:[0,0,0]" : "+v"(acc[ai][bj][m][n]) : "v"(bb_), "v"(aa_), "v"(0x7F7F7F7F)); } \
        else { _Pragma("unroll") for (int k = 0; k < 2; ++k) acc[ai][bj][m][n] = __builtin_amdgcn_mfma_f32_16x16x32_bf16(Bt[n][k], At[m][k], acc[ai][bj][m][n], 0, 0, 0); } } \
        __builtin_amdgcn_s_setprio(0); } while (0)
#define PG8_WAIT_V(n) asm volatile("s_waitcnt vmcnt(" #n ")" ::: "memory")
#define PG8_WAIT_L(n) asm volatile("s_waitcnt lgkmcnt(" #n ")" ::: "memory")
#define PG8_BAR __builtin_amdgcn_s_barrier()
#define PG8_SCHED __builtin_amdgcn_sched_barrier(0)
#define PG8_EXPERT(pm) ((pm) < 256 ? (((pm) >> 1) & 15) : ((pm) - 256))
#define PG8_ABASE(u) ((const char*)g.A + (size_t)(u).pm * tstepA)
#define PG8_BBASE(u) ((const char*)g.Bt + (size_t)PG8_EXPERT((u).pm) * g.estride * ESZ + (size_t)(u).pn * tstepB)
    Unit cur, nxt; int ui = 0;
    if (!S.next(0, cur)) return;
    f32x4 acc[2][2][4][2];
#pragma unroll
    for (int a = 0; a < 2; ++a)
#pragma unroll
        for (int b = 0; b < 2; ++b)
#pragma unroll
            for (int m = 0; m < 4; ++m)
#pragma unroll
                for (int n = 0; n < 2; ++n) acc[a][b][m][n] = (f32x4){0.f, 0.f, 0.f, 0.f};
    bf16x8 At[4][2], B0[2][2], B1[2][2];
    const char* cA = PG8_ABASE(cur); const char* cB = PG8_BBASE(cur);
    PG8_STAGE(PG8_SB(0, 0), cB, voffB); PG8_STAGE(PG8_SB(0, 1), cB + hstepB, voffB); PG8_STAGE(PG8_SA(0, 0), cA, voffA); PG8_STAGE(PG8_SA(0, 1), cA + hstepA, voffA);
    if (wr == 1) PG8_BAR;
    PG8_WAIT_V(2); PG8_BAR;
    PG8_STAGE(PG8_SB(1, 0), cB + kstep, voffB); PG8_STAGE(PG8_SA(1, 0), cA + kstep, voffA); PG8_STAGE(PG8_SB(1, 1), cB + hstepB + kstep, voffB);
    PG8_WAIT_V(6); PG8_BAR;
    for (;;) {
        const bool has_next = S.next(ui + 1, nxt);
        const char* nA = has_next ? PG8_ABASE(nxt) : cA; const char* nB = has_next ? PG8_BBASE(nxt) : cB;
#pragma nounroll
        for (int t = 0; t < nt; t += 2) {
            const bool last = (t == nt - 2);
            const char* a1 = cA + (size_t)(t + 1) * kstep;
            const char* a2 = last ? nA : cA + (size_t)(t + 2) * kstep; const char* b2 = last ? nB : cB + (size_t)(t + 2) * kstep;
            const char* a3 = a2 + kstep; const char* b3 = b2 + kstep;
            PG8_LDB(B0, 0, 0); PG8_LDB(B1, 0, 1); PG8_SCHED; PG8_LDA(At, 0, 0); PG8_STAGE(PG8_SA(1, 1), a1 + hstepA, voffA);
            PG8_WAIT_V(8); PG8_WAIT_L(0); PG8_BAR; PG8_MMA(0, 0, At, B0); PG8_MMA(0, 1, At, B1); PG8_BAR; PG8_SCHED;
            PG8_LDA(At, 0, 1); PG8_STAGE(PG8_SB(0, 0), b2, voffB); PG8_STAGE(PG8_SB(0, 1), b2 + hstepB, voffB); PG8_STAGE(PG8_SA(0, 0), a2, voffA);
            PG8_WAIT_V(8); PG8_WAIT_L(0); PG8_BAR; PG8_MMA(1, 0, At, B0); PG8_MMA(1, 1, At, B1); PG8_BAR; PG8_SCHED;
            PG8_LDB(B0, 1, 0); PG8_LDB(B1, 1, 1); PG8_SCHED; PG8_LDA(At, 1, 0); PG8_STAGE(PG8_SA(0, 1), a2 + hstepA, voffA);
            PG8_WAIT_V(8); PG8_WAIT_L(0); PG8_BAR; PG8_MMA(0, 0, At, B0); PG8_MMA(0, 1, At, B1); PG8_BAR; PG8_SCHED;
            PG8_LDA(At, 1, 1); PG8_STAGE(PG8_SB(1, 0), b3, voffB); PG8_STAGE(PG8_SB(1, 1), b3 + hstepB, voffB); PG8_STAGE(PG8_SA(1, 0), a3, voffA);
            PG8_WAIT_V(8); PG8_WAIT_L(0); PG8_BAR; PG8_MMA(1, 0, At, B0); PG8_MMA(1, 1, At, B1); PG8_BAR; PG8_SCHED;
        }
        if (wr == 0) PG8_BAR;
        E(acc, cur, wr, wc, fr, fq);
        if (!has_next) break;
#pragma unroll
        for (int a = 0; a < 2; ++a)
#pragma unroll
            for (int b = 0; b < 2; ++b)
#pragma unroll
                for (int m = 0; m < 4; ++m)
#pragma unroll
                    for (int n = 0; n < 2; ++n) acc[a][b][m][n] = (f32x4){0.f, 0.f, 0.f, 0.f};
        cur = nxt; cA = nA; cB = nB; ++ui;
        if (wr == 1) PG8_BAR;
    }
    PG8_WAIT_V(0);
    PG8_BAR;
#undef PG8_SA
#undef PG8_SB
#undef PG8_STAGE
#undef PG8_LDA
#undef PG8_LDB
#undef PG8_MMA
#undef PG8_WAIT_V
#undef PG8_WAIT_L
#undef PG8_BAR
#undef PG8_SCHED
}
}

struct Args { const float* in[29]; float* out; unsigned char* ws; };
typedef const __attribute__((address_space(4))) Args* KArgs;
#define KA_FRESH(ka) asm volatile("" : "+s"(ka))
enum { I_X = 0, I_C, I_CTX, I_CCTX, I_N1G, I_N2G, I_WADA, I_BADA, I_WIN, I_NAQG, I_NAKG, I_RPB, I_MQN, I_WUQ, I_MKVN, I_WUKV, I_MQG, I_MKG, I_SWQG, I_SWKG, I_SINK,
       I_WNAO, I_WMLAO, I_WSWAO, I_WO, I_ROUTER, I_WGATE, I_WUP, I_WDOWN };
struct Frame {
    LAS unsigned char* lds;
    int tid, lane, wave, G, vcu, gw, ngw;
};

DI void frame_fresh(Frame& F) { int t = F.tid, w = F.wave, v = F.vcu; asm volatile("" : "+v"(t), "+s"(w), "+s"(v)); F.tid = t; F.lane = t & 63; F.wave = w; F.vcu = v; F.gw = v * 8 + w; }
DI void modv_phase(Frame& F, KArgs ka) {
    KA_FRESH(ka); const __attribute__((address_space(4))) Args& a = *ka; frame_fresh(F);
    LAS float* cact = (LAS float*)F.lds;
    LAS float* red = (LAS float*)(F.lds + 9 * 1024 * 4);
    const float* c = a.in[I_C]; const float* cc = a.in[I_CCTX];
    for (int i = F.tid; i < 9 * 1024; i += 512) { const float v = i < 8192 ? c[i] : cc[i - 8192]; cact[i] = v * sigmoidf_(v); }
    __syncthreads();
    float* modv = (float*)(a.ws + WS_MODV);
    const int cl = F.lane & 31, kp = F.lane >> 5;
    for (int unit = F.vcu; unit < NL * 192; unit += F.G) {
        const int l = unit / 192, n = (unit % 192) * 32 + cl;
        const float* w = a.in[I_WADA] + (size_t)l * 1024 * 6144 + n;
        float acc[9];
#pragma unroll
        for (int i = 0; i < 9; ++i) acc[i] = 0.f;
        const int k0 = F.wave * 128 + kp;
#pragma unroll 16
        for (int k = 0; k < 128; k += 2) { const float wv = w[(size_t)(k0 + k) * 6144];
#pragma unroll
            for (int i = 0; i < 9; ++i) acc[i] += cact[i * 1024 + k0 + k] * wv; }
#pragma unroll
        for (int i = 0; i < 9; ++i) red[((F.wave * 2 + kp) * 9 + i) * 32 + cl] = acc[i];
        __syncthreads();
        for (int t = F.tid; t < 9 * 32; t += 512) { const int i = t >> 5, nn = t & 31; float s = 0.f;
#pragma unroll
            for (int w16 = 0; w16 < 16; ++w16) s += red[(w16 * 9 + i) * 32 + nn];
            const int col = (unit % 192) * 32 + nn;
            modv[((size_t)l * 9 + i) * 6144 + col] = s + a.in[I_BADA][l * 6144 + col]; }
        __syncthreads();
    }
}
DI void copy_phase(Frame& F, KArgs ka) {
    KA_FRESH(ka); const __attribute__((address_space(4))) Args& a = *ka; frame_fresh(F);
    u32x2* xs = (u32x2*)(a.ws + WS_XS);
    const f32x4* x = (const f32x4*)a.in[I_X]; const f32x4* cx = (const f32x4*)a.in[I_CTX];
    const size_t nl = (size_t)MLAT * D / 4, nc = (size_t)MCTX * D / 4;
    for (size_t i = (size_t)blockIdx.x * 512 + F.tid; i < nl + nc; i += (size_t)F.G * 512) { const f32x4 v = i < nl ? x[i] : cx[i - nl]; u32x2 w; w.x = pk2(v.x, v.y); w.y = pk2(v.z, v.w); xs[i] = w; }
}

DI unsigned char* wsel(unsigned char* ws, int l, size_t off) {
    const size_t p = (size_t)(l & 1);
    return ws + (off >= W_DN ? WS_W + off + p * (16 * MiB) : off >= W_GU ? WS_W + off + p * (32 * MiB) : (p ? WS_W2 : WS_W) + off);
}
constexpr int T_IN = 16 * 166, T_UQ = 4 * 24, T_UKV = 2 * 32, T_NAO = 6 * 32, T_MLAO = 8 * 32, T_SWAO = 6 * 32, T_O = 16 * 32, T_E = 16 * 32 * 16;
constexpr int NIT = T_IN + T_UQ + T_UKV + T_NAO + T_MLAO + T_SWAO + T_O + 3 * T_E;
DI void cvt_item(const __attribute__((address_space(4))) Args& a, int l, int r, LAS float* scr, int lane) {
    const float* W; const float* ks = nullptr; int ldw = 1024, kb, nb, ldt = 1024, drow0, dcol0 = 0, fp8 = 1; size_t woff;
    if (r < T_IN) { kb = r / 166; nb = r % 166; W = a.in[I_WIN] + (size_t)l * 1024 * DIN; ldw = DIN;
        if (nb < 70) { fp8 = 0; woff = W_IN; drow0 = 32 * nb; } else { woff = W_GL; drow0 = 32 * nb - 2240; } }
    else if ((r -= T_IN) < T_UQ) { kb = r / 24; nb = r % 24; W = a.in[I_WUQ] + (size_t)l * 256 * 768; ldw = 768; fp8 = 0; woff = W_UP; ldt = 384; drow0 = 32 * nb; ks = a.in[I_MQN] + l * 256; }
    else if ((r -= T_UQ) < T_UKV) { kb = r / 32; nb = r % 32; W = a.in[I_WUKV] + (size_t)l * 128 * 1024; fp8 = 0; woff = W_UP; ldt = 384; drow0 = 768 + 32 * nb; dcol0 = 256; ks = a.in[I_MKVN] + l * 128; }
    else if ((r -= T_UKV) < T_NAO) { kb = r / 32; nb = r % 32; W = a.in[I_WNAO] + (size_t)l * 384 * 1024; woff = W_NAO; ldt = 512; drow0 = 32 * nb; }
    else if ((r -= T_NAO) < T_MLAO) { kb = r / 32; nb = r % 32; W = a.in[I_WMLAO] + (size_t)l * 512 * 1024; woff = W_MLAO; ldt = 512; drow0 = 32 * nb; }
    else if ((r -= T_MLAO) < T_SWAO) { kb = r / 32; nb = r % 32; W = a.in[I_WSWAO] + (size_t)l * 384 * 1024; woff = W_SWAO; ldt = 512; drow0 = 32 * nb; }
    else if ((r -= T_SWAO) < T_O) { kb = r / 32; nb = r % 32; W = a.in[I_WO] + (size_t)l * 1024 * 1024; woff = W_O; drow0 = 32 * nb; }
    else if ((r -= T_O) < 2 * T_E) {
        const int which = r / T_E, rr = r % T_E, e = rr / 512, t = rr % 512; kb = t / 32; nb = t % 32; const int f0 = 32 * nb;
        W = a.in[which ? I_WUP : I_WGATE] + ((size_t)l * 16 + e) * 1024 * 1024; woff = W_GU + (size_t)e * 2048 * 1024; drow0 = 256 * (f0 >> 7) + 128 * which + (f0 & 127); }
    else { r -= 2 * T_E; const int e = r / 512, t = r % 512; kb = t / 32; nb = t % 32;
        W = a.in[I_WDOWN] + ((size_t)l * 16 + e) * 1024 * 1024; woff = W_DN + (size_t)e * 1024 * 1024; drow0 = 32 * nb; }
    const int k0 = 64 * kb, n0 = 32 * nb; dcol0 += k0;
    unsigned char* WT; { const size_t p = (size_t)(l & 1); WT = a.ws + (woff >= W_DN ? WS_W + woff + p * (16 * MiB) : woff >= W_GU ? WS_W + woff + p * (32 * MiB) : (p ? WS_W2 : WS_W) + woff); }
    const float sc = fp8 ? 32.0f : 1.0f;
    const float* Wl = W + (size_t)(k0 + (lane >> 5)) * ldw + n0 + (lane & 31); LAS float* sl = scr + (lane >> 5) * 33 + (lane & 31);
    if (ks) { ks += k0 + (lane >> 5);
#pragma unroll 8
        for (int i = 0; i < 32; ++i) sl[2 * i * 33] = Wl[(size_t)(2 * i) * ldw] * ks[2 * i]; }
    else {
        float wv[32];
#pragma unroll
        for (int i = 0; i < 32; ++i) wv[i] = Wl[(size_t)(2 * i) * ldw];
#pragma unroll
        for (int i = 0; i < 32; ++i) sl[2 * i * 33] = wv[i] * sc; }
    asm volatile("s_waitcnt lgkmcnt(0)" ::: "memory");
    const int c = lane & 7;
    if (fp8) {
#pragma unroll
        for (int j = 0; j < 4; ++j) { const int n = (lane >> 3) + 8 * j; const LAS float* s = scr + (8 * c) * 33 + n;
            u32x2 o; o.x = pk4_fp8(s[0 * 33], s[1 * 33], s[2 * 33], s[3 * 33]); o.y = pk4_fp8(s[4 * 33], s[5 * 33], s[6 * 33], s[7 * 33]);
            *(u32x2*)(WT + (size_t)(drow0 + n) * ldt + dcol0 + 8 * c) = o; }
    } else {
#pragma unroll
        for (int j = 0; j < 4; ++j) { const int n = (lane >> 3) + 8 * j; const LAS float* s = scr + (8 * c) * 33 + n;
            u32x4 o; o.x = pk2(s[0 * 33], s[1 * 33]); o.y = pk2(s[2 * 33], s[3 * 33]); o.z = pk2(s[4 * 33], s[5 * 33]); o.w = pk2(s[6 * 33], s[7 * 33]);
            *(u32x4*)((bf16_t*)WT + (size_t)(drow0 + n) * ldt + dcol0 + 8 * c) = o; }
    }
    asm volatile("s_waitcnt lgkmcnt(0)" ::: "memory");
}
DI void convert_weights(Frame& F, KArgs ka, int l, int begin) {
    KA_FRESH(ka); const __attribute__((address_space(4))) Args& a = *ka; frame_fresh(F);
    LAS float* scr = (LAS float*)(F.lds + F.wave * 16384);
#pragma nounroll
    for (int it = begin + F.gw; it < NIT; it += F.ngw) cvt_item(a, l, it, scr, F.lane);
    unsigned char* wb = a.ws + ((l & 1) ? WS_W2 : WS_W);
    constexpr int Z0 = 64 * 128, Z1 = 768 * 16, Z2 = 1024 * 32, Z3 = 2 * 1024 * 8;
    unsigned zz = 0u; asm volatile("" : "+v"(zz));
    const u32x4 z = {zz, zz, zz, zz};
    for (int i = blockIdx.x * 512 + F.tid; i < Z0 + Z1 + Z2 + Z3; i += F.G * 512) {
        if (i >= Z0 + Z1 + Z2) { const int j = i - Z0 - Z1 - Z2, which = j >> 13, jj = j & 8191; *(u32x4*)(wb + (which ? W_SWAO : W_NAO) + (size_t)(jj >> 3) * 512 + 384 + (jj & 7) * 16) = z; continue; }
        if (i < Z0) *(u32x4*)((bf16_t*)(wb + W_IN) + (size_t)(2240 + i / 128) * 1024 + (i % 128) * 8) = z;
        else if (i < Z0 + Z1) { const int j = i - Z0; *(u32x4*)((bf16_t*)(wb + W_UP) + (size_t)(j / 16) * 384 + 256 + (j % 16) * 8) = z; }
        else { const int j = i - Z0 - Z1; *(u32x4*)((bf16_t*)(wb + W_UP) + (size_t)(768 + j / 32) * 384 + (j % 32) * 8) = z; }
    }
}
DI void convert_tail(Frame& F, KArgs ka, int l, int first, int q) {
    KA_FRESH(ka); const __attribute__((address_space(4))) Args& a = *ka; frame_fresh(F);
    LAS float* scr = (LAS float*)(F.lds + F.wave * 16384);
#pragma nounroll
    for (int j = 0; j < q; ++j) { const int it = first + 8 * j + F.wave; if (it < NIT) cvt_item(a, l, it, scr, F.lane); }
}


DI void row_phase(Frame& F, KArgs ka, int l, int dry = 0) {
    KA_FRESH(ka); const __attribute__((address_space(4))) Args& a = *ka; frame_fresh(F);
    bf16_t* xs = (bf16_t*)(a.ws + WS_XS);
    const float* modv = (const float*)(a.ws + WS_MODV);
    const int* smap = (const int*)(a.ws + WS_SMAP);
    const bf16_t* Y = (const bf16_t*)(a.ws + WS_Y);
    bf16_t* H = (bf16_t*)(a.ws + WS_R4);
    unsigned char* H8 = a.ws + WS_R4 + 68 * MiB;
    bf16_t* xso = xs; float* outo = a.out;
    if (dry) { unsigned char* tr = a.ws + WS_END + (size_t)F.gw * 16384; xso = (bf16_t*)tr; outo = (float*)tr; H = (bf16_t*)(tr + 8192); H8 = tr + 12288; }
    const int nrows = (l == NL) ? MLAT : MT;
    const bool comb = (l > 0);
    constexpr int RR = 4;
    for (int mb = RR * F.gw; mb < nrows; mb += RR * F.ngw) {
        f32x4 v[RR][4]; int myslot[RR];
#pragma unroll
        for (int rr = 0; rr < RR; ++rr) { const int m = mb + rr;
            if (l == 0) {
                if (F.lane < 16 && !dry) *(u32x4*)(a.ws + WS_OCAT + (size_t)m * OCW + ((F.lane >> 3) ? 1408 : 384) + 16 * (F.lane & 7)) = (u32x4){0u, 0u, 0u, 0u};
                const f32x4* xr = (const f32x4*)(m < MLAT ? a.in[I_X] + (size_t)m * D : a.in[I_CTX] + (size_t)(m - MLAT) * D) + F.lane;
                u32x2* xo = (u32x2*)(xs + (size_t)m * D) + F.lane;
#pragma unroll
                for (int j = 0; j < 4; ++j) { const f32x4 t = xr[64 * j]; u32x2 w; w.x = pk2(t.x, t.y); w.y = pk2(t.z, t.w); if (!dry) xo[64 * j] = w; v[rr][j] = (f32x4){bflo(w.x), bfhi(w.x), bflo(w.y), bfhi(w.y)}; }
            } else {
                const u32x2* xr = (const u32x2*)(xs + (size_t)m * D) + F.lane;
#pragma unroll
                for (int j = 0; j < 4; ++j) { const u32x2 w = xr[64 * j]; v[rr][j] = (f32x4){bflo(w.x), bfhi(w.x), bflo(w.y), bfhi(w.y)}; }
            }
            myslot[rr] = (comb && F.lane < 16) ? smap[(size_t)F.lane * MT + mb + rr] : -1; }
        const int mi = mod_index(mb);
        if (comb) {
            f32x4 acc[RR][4];
            unsigned long long mk[RR];
#pragma unroll
            for (int rr = 0; rr < RR; ++rr) { mk[rr] = __ballot(myslot[rr] >= 0);
#pragma unroll
                for (int j = 0; j < 4; ++j) acc[rr][j] = (f32x4){0.f, 0.f, 0.f, 0.f}; }
            while ((mk[0] | mk[1]) | (mk[2] | mk[3])) {
                u32x2 w[RR][4];
#pragma unroll
                for (int rr = 0; rr < RR; ++rr) {
                    int s = -1;
                    if (mk[rr]) { const int e0 = __builtin_ctzll(mk[rr]); s = __shfl(myslot[rr], e0); mk[rr] &= mk[rr] - 1; }
#pragma unroll
                    for (int j = 0; j < 4; ++j) w[rr][j] = (u32x2){0u, 0u};
                    if (s >= 0) { const u32x2* yr = (const u32x2*)(Y + (size_t)s * D) + F.lane;
#pragma unroll
                        for (int j = 0; j < 4; ++j) w[rr][j] = yr[64 * j]; }
                }
#pragma unroll
                for (int rr = 0; rr < RR; ++rr)
#pragma unroll
                    for (int j = 0; j < 4; ++j) acc[rr][j] += (f32x4){bflo(w[rr][j].x), bfhi(w[rr][j].x), bflo(w[rr][j].y), bfhi(w[rr][j].y)};
            }
            const f32x4* g5 = (const f32x4*)(modv + ((size_t)(l - 1) * 9 + mi) * 6144 + 5 * 1024) + F.lane;
            f32x4 g5v[4];
#pragma unroll
            for (int j = 0; j < 4; ++j) g5v[j] = g5[64 * j];
#pragma unroll
            for (int rr = 0; rr < RR; ++rr) { const int m = mb + rr;
                const size_t ro = dry ? (size_t)rr * 1024 : (size_t)m * D;
#pragma unroll
                for (int j = 0; j < 4; ++j) { v[rr][j] += g5v[j] * acc[rr][j];
                    if (l == NL) ((f32x4*)(outo + ro) + F.lane)[64 * j] = v[rr][j];
                    else { u32x2 w; w.x = pk2(v[rr][j].x, v[rr][j].y); w.y = pk2(v[rr][j].z, v[rr][j].w); ((u32x2*)(xso + ro) + F.lane)[64 * j] = w;
                           v[rr][j] = (f32x4){bflo(w.x), bfhi(w.x), bflo(w.y), bfhi(w.y)}; } } }
        }
        if (l < NL) {
            const f32x4* g = (const f32x4*)(a.in[I_N1G] + l * D) + F.lane;
            const f32x4* sh = (const f32x4*)(modv + ((size_t)l * 9 + mi) * 6144) + F.lane;
            const f32x4* sc = (const f32x4*)(modv + ((size_t)l * 9 + mi) * 6144 + 1024) + F.lane;
            f32x4 gg[4], shv[4];
#pragma unroll
            for (int j = 0; j < 4; ++j) { gg[j] = g[64 * j] * (sc[64 * j] + 1.0f); shv[j] = sh[64 * j]; }
#pragma unroll
            for (int rr = 0; rr < RR; ++rr) { const int m = mb + rr;
                float ss = 0.f;
#pragma unroll
                for (int j = 0; j < 4; ++j) ss += (v[rr][j].x * v[rr][j].x + v[rr][j].y * v[rr][j].y) + (v[rr][j].z * v[rr][j].z + v[rr][j].w * v[rr][j].w);
                const float rstd = __builtin_amdgcn_rsqf(wave_sum(ss) * (1.f / D) + EPS);
                u32x2* o = (u32x2*)(H + (dry ? (size_t)rr * 1024 : (size_t)m * D)) + F.lane;
                unsigned* o8 = (unsigned*)(H8 + (dry ? (size_t)rr * 1024 : (size_t)m * D)) + F.lane;
#pragma unroll
                for (int j = 0; j < 4; ++j) { const f32x4 hh = v[rr][j] * rstd * gg[j] + shv[j]; u32x2 w; w.x = pk2(hh.x, hh.y); w.y = pk2(hh.z, hh.w); o[64 * j] = w;
                    o8[64 * j] = pk4_fp8(hh.x, hh.y, hh.z, hh.w); } }
        }
    }
}

DI void rope_cs(int d, int prow, int pcol, float& cs, float& sn) {
    const int i = d & 15; const float pos = (float)((d & 32) ? pcol : prow);
    const float inv = __builtin_amdgcn_exp2f(-(float)i * (13.287712379549449f / 16.0f));
    const float rev = pos * inv * 0.15915494309189535f;
    const float fr = rev - floorf(rev);
    cs = __builtin_amdgcn_cosf(fr); sn = __builtin_amdgcn_sinf(fr);
}
DI void prep_phase(Frame& F, KArgs ka, int l) {
    KA_FRESH(ka); const __attribute__((address_space(4))) Args& a = *ka; frame_fresh(F);
    const bf16_t* HW = (const bf16_t*)(a.ws + WS_HW);
    bf16_t* P1 = (bf16_t*)(a.ws + WS_P1);
    const float sc64 = 0.125f * LOG2E;
    const int d0 = 8 * (F.lane & 7);
    float gn[3][8]; int srcc[3]; bool ropei[3], acti[3];
    const float* gp0 = a.in[I_NAQG]; const float* gp1 = a.in[I_NAKG]; const float* gp2 = a.in[I_SWQG]; const float* gp3 = a.in[I_SWKG];
#pragma unroll
    for (int i = 0; i < 3; ++i) { const int c = F.lane + 64 * i, col = 8 * c; acti[i] = c < 160;
        const int ty = col < 384 ? 0 : col < 768 ? 1 : col < 1152 ? 2 : 3;
        srcc[i] = col < 768 ? col : col + (C_SWQ - 768);
        ropei[i] = ty >= 2;
        const float sc = (ty == 0 || ty == 2) ? sc64 : 1.0f;
#pragma unroll
        for (int j = 0; j < 8; ++j) { const float g0 = gp0[l * 64 + d0 + j], g1 = gp1[l * 64 + d0 + j], g2 = gp2[l * 64 + d0 + j], g3 = gp3[l * 64 + d0 + j];
            gn[i][j] = acti[i] ? (ty == 0 ? g0 : ty == 1 ? g1 : ty == 2 ? g2 : g3) * sc : 0.f; } }
    float invf[8];
#pragma unroll
    for (int j = 0; j < 8; ++j) invf[j] = __builtin_amdgcn_exp2f(-(float)((d0 & 8) + j) * (13.287712379549449f / 16.0f)) * 0.15915494309189535f;
    const bool second = (d0 & 16) != 0, usecol = (d0 & 32) != 0;
    for (int mb = 2 * F.gw; mb < MT; mb += 2 * F.ngw) {
        u32x4 w[2][3];
#pragma unroll
        for (int rr = 0; rr < 2; ++rr)
#pragma unroll
            for (int i = 0; i < 3; ++i) if (acti[i]) w[rr][i] = *(const u32x4*)(HW + (size_t)(mb + rr) * DINP + srcc[i]); else w[rr][i] = (u32x4){0u, 0u, 0u, 0u};
#pragma unroll
        for (int rr = 0; rr < 2; ++rr) {
            const int m = mb + rr; const bool lat = m < MLAT; const int s = m & 4095; const float prw = (float)(s >> 6), pcl = (float)(s & 63); float pos = usecol ? pcl : prw; asm volatile("" : "+v"(pos));
            float cs[8], sn[8];
#pragma unroll
            for (int j = 0; j < 8; ++j) { cs[j] = 1.f; sn[j] = 0.f; }
            if (lat) {
#pragma unroll
                for (int j = 0; j < 8; ++j) { const float rev = pos * invf[j], fr = rev - floorf(rev); cs[j] = __builtin_amdgcn_cosf(fr); sn[j] = __builtin_amdgcn_sinf(fr); } }
#pragma unroll
            for (int i = 0; i < 3; ++i) {
                float x[8] = {bflo(w[rr][i].x), bfhi(w[rr][i].x), bflo(w[rr][i].y), bfhi(w[rr][i].y), bflo(w[rr][i].z), bfhi(w[rr][i].z), bflo(w[rr][i].w), bfhi(w[rr][i].w)};
                float ss = 0.f;
#pragma unroll
                for (int j = 0; j < 8; ++j) ss += x[j] * x[j];
                ss += __shfl_xor(ss, 1); ss += __shfl_xor(ss, 2); ss += __shfl_xor(ss, 4);
                const float rs = __builtin_amdgcn_rsqf(ss * (1.f / 64.f) + EPS);
#pragma unroll
                for (int j = 0; j < 8; ++j) x[j] *= rs * gn[i][j];
                const bool rp = ropei[i] && lat;
#pragma unroll
                for (int j = 0; j < 8; ++j) { const float y = __int_as_float(__builtin_amdgcn_ds_bpermute((F.lane ^ 2) << 2, __float_as_int(x[j]))); const float rot = second ? x[j] * cs[j] + y * sn[j] : x[j] * cs[j] - y * sn[j]; x[j] = rp ? rot : x[j]; }
                if (acti[i]) { u32x4 o; o.x = pk2(x[0], x[1]); o.y = pk2(x[2], x[3]); o.z = pk2(x[4], x[5]); o.w = pk2(x[6], x[7]);
                    *(u32x4*)(P1 + (size_t)m * P1W + 8 * (F.lane + 64 * i)) = o; }
            }
        }
    }
}
DI void prep2_phase(Frame& F, KArgs ka, int l, int dry = 0) {
    KA_FRESH(ka); const __attribute__((address_space(4))) Args& a = *ka; frame_fresh(F);
    const bf16_t* HW = (const bf16_t*)(a.ws + WS_HW);
    bf16_t* U = (bf16_t*)(a.ws + WS_R4);
    bf16_t* P2 = (bf16_t*)(a.ws + WS_P2);
    const float scq = 0.07216878364870322f * LOG2E;
    const int ln = F.lane, q = ln & 15, h = ln >> 4;
    float qgn[8], qgr[4], kgn[8], kgr[4], invf[4];
    { const float* qg = a.in[I_MQG] + l * 192; const float* kg = a.in[I_MKG] + l * 192;
#pragma unroll
      for (int j = 0; j < 8; ++j) { qgn[j] = qg[8 * q + j] * scq; kgn[j] = kg[8 * q + j]; }
#pragma unroll
      for (int j = 0; j < 4; ++j) { qgr[j] = qg[128 + 4 * q + j] * scq; kgr[j] = kg[128 + 4 * q + j];
          invf[j] = __builtin_amdgcn_exp2f(-(float)(4 * (q & 3) + j) * (13.287712379549449f / 16.0f)) * 0.15915494309189535f; } }
    const bool second = (q & 4) != 0, usecol = (q & 8) != 0;
    const int pl = (ln ^ 4) << 2;
    for (int mb = 2 * F.gw; mb < MT; mb += 2 * F.ngw) {
        u32x2 wcq[2], wqr[2], wkr[2]; unsigned wckv[2]; u32x4 wqn[2], wkn[2], wv[2];
#pragma unroll
        for (int rr = 0; rr < 2; ++rr) { const bf16_t* hr = HW + (size_t)(mb + rr) * DINP; const bf16_t* ur = U + (size_t)(mb + rr) * UW;
            wcq[rr] = *(const u32x2*)(hr + C_CQ + 4 * ln); wckv[rr] = *(const unsigned*)(hr + C_CKV + 2 * ln); wkr[rr] = *(const u32x2*)(hr + C_KR + 4 * q);
            wqn[rr] = *(const u32x4*)(ur + h * 192 + 8 * q); wqr[rr] = *(const u32x2*)(ur + h * 192 + 128 + 4 * q);
            wkn[rr] = *(const u32x4*)(ur + 768 + h * 256 + 8 * q); wv[rr] = *(const u32x4*)(ur + 768 + h * 256 + 128 + 8 * q); }
#pragma unroll
        for (int rr = 0; rr < 2; ++rr) {
            const int m = mb + rr; const bool lat = m < MLAT; const int s = m & 4095;
            bf16_t* ur = U + (size_t)m * UW; bf16_t* pr = P2 + (size_t)m * P2W;
            if (dry) { ur = (bf16_t*)(a.ws + WS_END + (size_t)F.gw * 8192); pr = ur + 2048; }
            float rq, rkv;
            { const float a0 = bflo(wcq[rr].x), a1 = bfhi(wcq[rr].x), a2 = bflo(wcq[rr].y), a3 = bfhi(wcq[rr].y);
              rq = __builtin_amdgcn_rsqf(wave_sum(a0 * a0 + a1 * a1 + a2 * a2 + a3 * a3) * (1.f / 256.f) + EPS); }
            { const float a0 = bflo(wckv[rr]), a1 = bfhi(wckv[rr]);
              rkv = __builtin_amdgcn_rsqf(wave_sum(a0 * a0 + a1 * a1) * (1.f / 128.f) + EPS); }
            float cs[4], sn[4];
            { const float prw = (float)(s >> 6), pcl = (float)(s & 63); float pos = usecol ? pcl : prw; asm volatile("" : "+v"(pos));
#pragma unroll
              for (int j = 0; j < 4; ++j) { const float rev = pos * invf[j], fr = rev - floorf(rev); cs[j] = lat ? __builtin_amdgcn_cosf(fr) : 1.f; sn[j] = lat ? __builtin_amdgcn_sinf(fr) : 0.f; } }
#pragma unroll
            for (int isk = 0; isk < 2; ++isk) {
                const u32x4 wn = isk ? wkn[rr] : wqn[rr]; const u32x2 wr2 = isk ? wkr[rr] : wqr[rr];
                const float sn_ = isk ? rkv : rq, sr_ = isk ? 1.0f : rq;
                float x[8] = {bflo(wn.x) * sn_, bfhi(wn.x) * sn_, bflo(wn.y) * sn_, bfhi(wn.y) * sn_, bflo(wn.z) * sn_, bfhi(wn.z) * sn_, bflo(wn.w) * sn_, bfhi(wn.w) * sn_};
                float y[4] = {bflo(wr2.x) * sr_, bfhi(wr2.x) * sr_, bflo(wr2.y) * sr_, bfhi(wr2.y) * sr_};
                float ss = 0.f;
#pragma unroll
                for (int j = 0; j < 8; ++j) ss += x[j] * x[j];
#pragma unroll
                for (int j = 0; j < 4; ++j) ss += y[j] * y[j];
                ss += __shfl_xor(ss, 1); ss += __shfl_xor(ss, 2); ss += __shfl_xor(ss, 4); ss += __shfl_xor(ss, 8);
                const float rs = __builtin_amdgcn_rsqf(ss * (1.f / 192.f) + EPS);
#pragma unroll
                for (int j = 0; j < 8; ++j) x[j] *= rs * (isk ? kgn[j] : qgn[j]);
#pragma unroll
                for (int j = 0; j < 4; ++j) { y[j] *= rs * (isk ? kgr[j] : qgr[j]);
                    const float p = __int_as_float(__builtin_amdgcn_ds_bpermute(pl, __float_as_int(y[j])));
                    y[j] = second ? y[j] * cs[j] + p * sn[j] : y[j] * cs[j] - p * sn[j]; }
                u32x4 o; o.x = pk2(x[0], x[1]); o.y = pk2(x[2], x[3]); o.z = pk2(x[4], x[5]); o.w = pk2(x[6], x[7]);
                u32x2 o2; o2.x = pk2(y[0], y[1]); o2.y = pk2(y[2], y[3]);
                *(u32x4*)(pr + 768 * isk + h * 192 + 8 * q) = o; *(u32x2*)(pr + 768 * isk + h * 192 + 128 + 4 * q) = o2;
            }
            { const u32x4 vw = wv[rr]; u32x4 o; o.x = pk2(bflo(vw.x) * rkv, bfhi(vw.x) * rkv); o.y = pk2(bflo(vw.y) * rkv, bfhi(vw.y) * rkv); o.z = pk2(bflo(vw.z) * rkv, bfhi(vw.z) * rkv); o.w = pk2(bflo(vw.w) * rkv, bfhi(vw.w) * rkv);
              *(u32x4*)(ur + 768 + h * 256 + 128 + 8 * q) = o; }
        }
    }
}

struct AU {
    const bf16_t *q, *k, *v; unsigned char* o;
    int ldq, ldk, ldv, ldo;
    int qrow0;
    int lat_row0, n_lat, ctx_row0, n_ctx;
    int mode;
    int qpos0, kpos0;
    float m0, l0;
    const float* rpb;
};
template <int DQ, int DV, int LDK, int LDV>
DI void attn_unit(LAS unsigned char* lds, const AU& u, int tid, int wave, int lane) {
    constexpr int KP = DQ * 2 + 16, VP = DV * 2 + 64, KBY = 64 * KP, VBY = 64 * VP, STG = KBY + VBY;
    constexpr int NKS = DQ / 16, NDT = DV / 32, KCH = DQ / 8, VCH = DV / 8;
    constexpr int KC = KP / 16, VC = VP / 16;
    constexpr int KI = (KC + 7) / 8, VI = (VC + 7) / 8;
    constexpr int BIAS_OFF = 98304;
    constexpr float MTHR = 11.5f;
    static_assert(2 * STG <= BIAS_OFF && KBY % 1024 == 0 && VBY % 1024 == 0, "attention LDS");
    const int r = lane & 31, h = lane >> 5;
    const int nt = u.n_lat + u.n_ctx;
    LAS float* btab = (LAS float*)(lds + BIAS_OFF);
    if (u.mode == 2) { for (int i = tid; i < 15 * 31; i += 512) btab[i] = u.rpb[i] * LOG2E; }
    bf16x8 qf[NKS];
    { const bf16_t* qp = u.q + (size_t)(u.qrow0 + wave * 32 + r) * u.ldq + 8 * h;
#pragma unroll
      for (int ks = 0; ks < NKS; ++ks) qf[ks] = *(const bf16x8*)(qp + 16 * ks); }
    f32x16 o[NDT];
#pragma unroll
    for (int dt = 0; dt < NDT; ++dt)
#pragma unroll
        for (int i = 0; i < 16; ++i) o[dt][i] = 0.f;
    float mrun = u.m0, lrun = (h == 0) ? u.l0 : 0.f;
    unsigned koff[KI], voff[VI];
#pragma unroll
    for (int i = 0; i < KI; ++i) { const int c = 64 * (wave + 8 * i) + lane, row = c / KC, cc = c % KC; koff[i] = (unsigned)(row * LDK * 2 + (cc < KCH ? cc : KCH - 1) * 16); }
#pragma unroll
    for (int i = 0; i < VI; ++i) { const int c = 64 * (wave + 8 * i) + lane, row = c / VC, cc = c % VC; voff[i] = (unsigned)(row * LDV * 2 + (cc < VCH ? cc : VCH - 1) * 16); }
#define AT_ROWBASE(t) ((t) < u.n_lat ? u.lat_row0 + 64 * (t) : u.ctx_row0 + 64 * ((t) - u.n_lat))
#define AT_ISSUE(t, buf) do { const int rb_ = AT_ROWBASE(t); const char* kb_ = (const char*)(u.k + (size_t)rb_ * LDK); const char* vb_ = (const char*)(u.v + (size_t)rb_ * LDV); \
        _Pragma("unroll") for (int i_ = 0; i_ < KI; ++i_) { const int j_ = wave + 8 * i_; if (j_ < KC) __builtin_amdgcn_global_load_lds((const unsigned*)(kb_ + koff[i_]), (LAS unsigned*)(lds + (buf) * STG + j_ * 1024), 16, 0, 0); } \
        _Pragma("unroll") for (int i_ = 0; i_ < VI; ++i_) { const int j_ = wave + 8 * i_; if (j_ < VC) __builtin_amdgcn_global_load_lds((const unsigned*)(vb_ + voff[i_]), (LAS unsigned*)(lds + (buf) * STG + KBY + j_ * 1024), 16, 0, 0); } } while (0)
    AT_ISSUE(0, 0);
    asm volatile("s_waitcnt vmcnt(0)" ::: "memory");
    __syncthreads();
    const int tq = (lane & 15) >> 2, tp = lane & 3, tblk = (lane >> 4) & 1;
    const int vlane_off = (4 * h + tq) * VP + 32 * tblk + 8 * tp;
    for (int t = 0; t < nt; ++t) {
        const int buf = t & 1;
        if (t + 1 < nt) AT_ISSUE(t + 1, buf ^ 1);
        bool skip = false; int a0 = 0, a1 = 0;
        if (u.mode == 1 && t < u.n_lat) { const int k0 = u.kpos0 + 64 * t, q0 = u.qpos0 + 32 * wave; skip = (k0 > q0 + 31 + 128) || (k0 + 63 < q0 - 128); a0 = k0; a1 = q0; }
        if (u.mode == 2 && t < u.n_lat) { const int kr = u.kpos0 + t, qr = u.qpos0 + (wave >> 1); int rs = qr - 4; rs = rs < 0 ? 0 : (rs > 56 ? 56 : rs); skip = (kr < rs) || (kr >= rs + 8); a0 = kr - qr + 7; }
        if (!skip) {
            const LAS unsigned char* Kt = lds + buf * STG; const LAS unsigned char* Vt = Kt + KBY;
            f32x16 s0, s1;
#pragma unroll
            for (int i = 0; i < 16; ++i) { s0[i] = 0.f; s1[i] = 0.f; }
#pragma unroll
            for (int ks = 0; ks < NKS; ++ks) {
                const bf16x8 k0 = *(const LAS bf16x8*)(Kt + r * KP + (16 * ks + 8 * h) * 2);
                const bf16x8 k1 = *(const LAS bf16x8*)(Kt + (32 + r) * KP + (16 * ks + 8 * h) * 2);
                s0 = __builtin_amdgcn_mfma_f32_32x32x16_bf16(k0, qf[ks], s0, 0, 0, 0);
                s1 = __builtin_amdgcn_mfma_f32_32x32x16_bf16(k1, qf[ks], s1, 0, 0, 0);
            }
            if (u.mode == 1 && t < u.n_lat) {
                const int qpos = a1 + r;
#pragma unroll
                for (int i = 0; i < 16; ++i) { const int kk = a0 + (i & 3) + 8 * (i >> 2) + 4 * h; int d0 = qpos - kk; d0 = d0 < 0 ? -d0 : d0; int d1 = qpos - (kk + 32); d1 = d1 < 0 ? -d1 : d1;
                    s0[i] = d0 <= 128 ? s0[i] : -INFINITY; s1[i] = d1 <= 128 ? s1[i] : -INFINITY; }
            }
            if (u.mode == 2 && t < u.n_lat) {
                const int qc = 32 * (wave & 1) + r; int cs = qc - 8; cs = cs < 0 ? 0 : (cs > 48 ? 48 : cs);
                const int bbase = a0 * 31 + 15 - qc;
                float bb[16];
#pragma unroll
                for (int half = 0; half < 2; ++half) {
#pragma unroll
                    for (int i = 0; i < 16; ++i) { int ix = bbase + 32 * half + (i & 3) + 8 * (i >> 2) + 4 * h; ix = ix < 0 ? 0 : (ix > 464 ? 464 : ix); bb[i] = btab[ix]; }
                    asm volatile("" : "+v"(bb[0]), "+v"(bb[1]), "+v"(bb[2]), "+v"(bb[3]), "+v"(bb[4]), "+v"(bb[5]), "+v"(bb[6]), "+v"(bb[7]), "+v"(bb[8]), "+v"(bb[9]), "+v"(bb[10]), "+v"(bb[11]), "+v"(bb[12]), "+v"(bb[13]), "+v"(bb[14]), "+v"(bb[15]));
#pragma unroll
                    for (int i = 0; i < 16; ++i) { const int kc = 32 * half + (i & 3) + 8 * (i >> 2) + 4 * h; const bool ok = (kc >= cs) && (kc < cs + 16);
                        if (half == 0) s0[i] = ok ? s0[i] + bb[i] : -INFINITY; else s1[i] = ok ? s1[i] + bb[i] : -INFINITY; }
                }
            }
            float mx = fmaxf(s0[0], s1[0]);
#pragma unroll
            for (int i = 1; i < 16; ++i) mx = fmaxf(mx, fmaxf(s0[i], s1[i]));
            mx = fmaxf(mx, __shfl_xor(mx, 32));
            if (__builtin_amdgcn_ballot_w64(mx > mrun + MTHR) != 0ull) {
                const float mnew = fmaxf(mrun, mx), alpha = __builtin_amdgcn_exp2f(mrun - mnew);
                lrun *= alpha; mrun = mnew;
#pragma unroll
                for (int dt = 0; dt < NDT; ++dt)
#pragma unroll
                    for (int i = 0; i < 16; ++i) o[dt][i] *= alpha;
            }
            float ls = 0.f;
#pragma unroll
            for (int i = 0; i < 16; ++i) { s0[i] = __builtin_amdgcn_exp2f(s0[i] - mrun); s1[i] = __builtin_amdgcn_exp2f(s1[i] - mrun); ls += s0[i] + s1[i]; }
            lrun += ls;
            bf16x8 pf[4];
            { u32x4 w;
              w.x = pk2(s0[0], s0[1]); w.y = pk2(s0[2], s0[3]); w.z = pk2(s0[4], s0[5]); w.w = pk2(s0[6], s0[7]); pf[0] = __builtin_bit_cast(bf16x8, w);
              w.x = pk2(s0[8], s0[9]); w.y = pk2(s0[10], s0[11]); w.z = pk2(s0[12], s0[13]); w.w = pk2(s0[14], s0[15]); pf[1] = __builtin_bit_cast(bf16x8, w);
              w.x = pk2(s1[0], s1[1]); w.y = pk2(s1[2], s1[3]); w.z = pk2(s1[4], s1[5]); w.w = pk2(s1[6], s1[7]); pf[2] = __builtin_bit_cast(bf16x8, w);
              w.x = pk2(s1[8], s1[9]); w.y = pk2(s1[10], s1[11]); w.z = pk2(s1[12], s1[13]); w.w = pk2(s1[14], s1[15]); pf[3] = __builtin_bit_cast(bf16x8, w); }
#pragma unroll
            for (int kk = 0; kk < 4; ++kk) {
#pragma unroll
                for (int dt = 0; dt < NDT; ++dt) {
                    const LAS unsigned char* vp = Vt + (16 * kk) * VP + vlane_off + 64 * dt;
                    const s16x4 lo = __builtin_amdgcn_ds_read_tr16_b64_v4i16((LAS s16x4*)vp);
                    const s16x4 hi = __builtin_amdgcn_ds_read_tr16_b64_v4i16((LAS s16x4*)(vp + 8 * VP));
                    const bf16x8 vf = __builtin_shufflevector(lo, hi, 0, 1, 2, 3, 4, 5, 6, 7);
                    o[dt] = __builtin_amdgcn_mfma_f32_32x32x16_bf16(vf, pf[kk], o[dt], 0, 0, 0);
                }
            }
        }
        asm volatile("s_waitcnt vmcnt(0)" ::: "memory");
        __syncthreads();
    }
    const float ltot = lrun + __shfl_xor(lrun, 32), inv = 1.0f / ltot;
    unsigned char* op = u.o + (size_t)(u.qrow0 + wave * 32 + r) * u.ldo + 4 * h;
    const float inv4 = inv * 4.0f;
#pragma unroll
    for (int dt = 0; dt < NDT; ++dt)
#pragma unroll
        for (int g = 0; g < 4; ++g) *(unsigned*)(op + 32 * dt + 8 * g) = pk4_fp8(o[dt][4 * g] * inv4, o[dt][4 * g + 1] * inv4, o[dt][4 * g + 2] * inv4, o[dt][4 * g + 3] * inv4);
#undef AT_ROWBASE
#undef AT_ISSUE
}

DI void attn_phase(Frame& F, KArgs ka, int l) {
    KA_FRESH(ka); const __attribute__((address_space(4))) Args& a = *ka; frame_fresh(F);
    const bf16_t* HW = (const bf16_t*)(a.ws + WS_HW);
    const bf16_t* P1 = (const bf16_t*)(a.ws + WS_P1);
    const bf16_t* P2 = (const bf16_t*)(a.ws + WS_P2);
    const bf16_t* U = (const bf16_t*)(a.ws + WS_R4);
    unsigned char* OC = a.ws + WS_OCAT;
    const bool last = (l == NL - 1);
    constexpr int nA = 512, nB = 768, nC = 768;
    const int ntot = nA + nB + nC + (last ? 0 : 128);
#ifndef ATT_PROBE
#define ATT_PROBE 0
#endif
    for (int rep2_ = 0; rep2_ < 1 + (ATT_PROBE != 0); ++rep2_)
    for (int id = F.vcu; id < ntot; id += F.G) {
        if (rep2_ == 1 && !((ATT_PROBE == 1) ? (id < nA) : (id >= nA && id < nA + nB))) continue;
        AU u; bool big = false;
        u.mode = 0; u.qpos0 = 0; u.kpos0 = 0; u.m0 = -1e30f; u.l0 = 0.f; u.rpb = nullptr; u.n_ctx = 4;
        if (id < nA) {
            const int b = id >> 6, h = (id >> 4) & 3, qb = id & 15; big = true;
            u.q = P2 + h * 192; u.ldq = P2W; u.k = P2 + 768 + h * 192; u.ldk = P2W; u.v = U + 768 + h * 256 + 128; u.ldv = UW; u.o = OC + 512 + h * 128; u.ldo = OCW;
            u.qrow0 = b * SEQ + qb * 256; u.lat_row0 = b * SEQ; u.n_lat = 64; u.ctx_row0 = MLAT + b * CTX;
        } else if (id < nA + nB) {
            const int j = id - nA, b = j / 96, h = (j >> 4) % 6, qb = j & 15;
            u.q = P1 + h * 64; u.ldq = P1W; u.k = P1 + 384 + h * 64; u.ldk = P1W; u.v = HW + C_NAV + h * 64; u.ldv = DINP; u.o = OC + h * 64; u.ldo = OCW;
            int rlo = 4 * qb - 4; rlo = rlo < 0 ? 0 : (rlo > 56 ? 56 : rlo); int rhi = 4 * qb + 3 - 4; rhi = (rhi < 0 ? 0 : (rhi > 56 ? 56 : rhi)) + 7;
            u.qrow0 = b * SEQ + qb * 256; u.lat_row0 = b * SEQ + rlo * 64; u.n_lat = rhi - rlo + 1; u.ctx_row0 = MLAT + b * CTX;
            u.mode = 2; u.qpos0 = 4 * qb; u.kpos0 = rlo; u.rpb = a.in[I_RPB] + (size_t)(l * 6 + h) * 465;
        } else if (id < nA + nB + nC) {
            const int j = id - nA - nB, b = j / 96, hq = (j >> 4) % 6, qb = j & 15, kvh = hq / 3;
            u.q = P1 + 768 + hq * 64; u.ldq = P1W; u.k = P1 + 1152 + kvh * 64; u.ldk = P1W; u.v = HW + C_SWV + kvh * 64; u.ldv = DINP; u.o = OC + 1024 + hq * 64; u.ldo = OCW;
            int klo = qb * 256 - 128; klo = klo < 0 ? 0 : klo; int khi = qb * 256 + 384; khi = khi > SEQ ? SEQ : khi;
            u.qrow0 = b * SEQ + qb * 256; u.lat_row0 = b * SEQ + klo; u.n_lat = (khi - klo) >> 6; u.ctx_row0 = MLAT + b * CTX;
            u.mode = 1; u.qpos0 = qb * 256; u.kpos0 = klo; u.m0 = a.in[I_SINK][l * 6 + hq] * LOG2E; u.l0 = 1.f;
        } else {
            const int j = id - nA - nB - nC;
            u.n_lat = 0; u.lat_row0 = 0;
            if (j < 32) { const int b = j >> 2, h = j & 3; big = true;
                u.q = P2 + h * 192; u.ldq = P2W; u.k = P2 + 768 + h * 192; u.ldk = P2W; u.v = U + 768 + h * 256 + 128; u.ldv = UW; u.o = OC + 512 + h * 128; u.ldo = OCW;
                u.qrow0 = MLAT + b * CTX; u.ctx_row0 = MLAT + b * CTX;
            } else if (j < 80) { const int jj = j - 32, b = jj / 6, h = jj % 6;
                u.q = P1 + h * 64; u.ldq = P1W; u.k = P1 + 384 + h * 64; u.ldk = P1W; u.v = HW + C_NAV + h * 64; u.ldv = DINP; u.o = OC + h * 64; u.ldo = OCW;
                u.qrow0 = MLAT + b * CTX; u.ctx_row0 = MLAT + b * CTX;
            } else { const int jj = j - 80, b = jj / 6, hq = jj % 6, kvh = hq / 3;
                u.q = P1 + 768 + hq * 64; u.ldq = P1W; u.k = P1 + 1152 + kvh * 64; u.ldk = P1W; u.v = HW + C_SWV + kvh * 64; u.ldv = DINP; u.o = OC + 1024 + hq * 64; u.ldo = OCW;
                u.qrow0 = MLAT + b * CTX; u.ctx_row0 = MLAT + b * CTX; u.m0 = a.in[I_SINK][l * 6 + hq] * LOG2E; u.l0 = 1.f;
            }
        }
        if (big) attn_unit<192, 128, P2W, UW>(F.lds, u, F.tid, F.wave, F.lane);
        else attn_unit<64, 64, P1W, DINP>(F.lds, u, F.tid, F.wave, F.lane);
    }
}

DI void norm2_phase(Frame& F, KArgs ka, int l, int nrows) {
    KA_FRESH(ka); const __attribute__((address_space(4))) Args& a = *ka; frame_fresh(F);
    LAS float* rt = (LAS float*)F.lds;
    const float* rg = a.in[I_ROUTER] + (size_t)l * 1024 * 16;
    for (int i = F.tid; i < 16384; i += 512) rt[i] = rg[i];
    __syncthreads();
    LAS float* xr = (LAS float*)(F.lds + 65536 + F.wave * 8192);
    const bf16_t* xs = (const bf16_t*)(a.ws + WS_XS);
    const float* modv = (const float*)(a.ws + WS_MODV);
    unsigned char* H2 = a.ws + WS_H2;
    float* AFL = (float*)(a.ws + WS_AFL); float* AFC = (float*)(a.ws + WS_AFC);
    const int eq = F.lane & 3, kq = F.lane >> 2;
    u32x2 xw[2][4];
#define N2_LOAD(mb_) do { _Pragma("unroll") for (int rr_ = 0; rr_ < 2; ++rr_) { const u32x2* xp_ = (const u32x2*)(xs + (size_t)((mb_) + rr_) * D) + F.lane; \
        _Pragma("unroll") for (int j_ = 0; j_ < 4; ++j_) xw[rr_][j_] = xp_[64 * j_]; } } while (0)
    if (2 * F.gw < nrows) N2_LOAD(2 * F.gw);
    for (int mb = 2 * F.gw; mb < nrows; mb += 2 * F.ngw) {
        const int mi = mod_index(mb);
        f32x4 v[2][4];
#pragma unroll
        for (int rr = 0; rr < 2; ++rr)
#pragma unroll
            for (int j = 0; j < 4; ++j) { const u32x2 w = xw[rr][j]; v[rr][j] = (f32x4){bflo(w.x), bfhi(w.x), bflo(w.y), bfhi(w.y)}; }
        if (mb + 2 * F.ngw < nrows) N2_LOAD(mb + 2 * F.ngw);
        const f32x4* g = (const f32x4*)(a.in[I_N2G] + l * D) + F.lane;
        const f32x4* sh = (const f32x4*)(modv + ((size_t)l * 9 + mi) * 6144 + 3 * 1024) + F.lane;
        const f32x4* sc = (const f32x4*)(modv + ((size_t)l * 9 + mi) * 6144 + 4 * 1024) + F.lane;
        f32x4 gg[4], shv[4];
#pragma unroll
        for (int j = 0; j < 4; ++j) { gg[j] = g[64 * j] * (sc[64 * j] + 1.0f); shv[j] = sh[64 * j]; }
#pragma unroll
        for (int rr = 0; rr < 2; ++rr) {
            float ss = 0.f;
#pragma unroll
            for (int j = 0; j < 4; ++j) ss += (v[rr][j].x * v[rr][j].x + v[rr][j].y * v[rr][j].y) + (v[rr][j].z * v[rr][j].z + v[rr][j].w * v[rr][j].w);
            const float rstd = __builtin_amdgcn_rsqf(wave_sum(ss) * (1.f / D) + EPS);
            unsigned* o = (unsigned*)(H2 + (size_t)(mb + rr) * D) + F.lane;
#pragma unroll
            for (int j = 0; j < 4; ++j) { const f32x4 hh = v[rr][j] * rstd * gg[j] + shv[j]; o[64 * j] = pk4_fp8(hh.x, hh.y, hh.z, hh.w);
                *(LAS f32x4*)(xr + rr * 1024 + 4 * F.lane + 256 * j) = hh; }
        }
        asm volatile("s_waitcnt lgkmcnt(0)" ::: "memory");
        f32x4 acc[2] = {{0.f, 0.f, 0.f, 0.f}, {0.f, 0.f, 0.f, 0.f}};
#pragma unroll 8
        for (int i = 0; i < 64; ++i) { const int k = kq + 16 * i; const float x0 = xr[k], x1 = xr[1024 + k]; const f32x4 w = *(const LAS f32x4*)(rt + k * 16 + 4 * eq); acc[0] += w * x0; acc[1] += w * x1; }
        asm volatile("s_waitcnt lgkmcnt(0)" ::: "memory");
#pragma unroll
        for (int rr = 0; rr < 2; ++rr) { const int m = mb + rr; f32x4 ac = acc[rr];
#pragma unroll
            for (int ofs = 4; ofs < 64; ofs <<= 1) { ac.x += __shfl_xor(ac.x, ofs); ac.y += __shfl_xor(ac.y, ofs); ac.z += __shfl_xor(ac.z, ofs); ac.w += __shfl_xor(ac.w, ofs); }
            float mx = fmaxf(fmaxf(ac.x, ac.y), fmaxf(ac.z, ac.w)); mx = fmaxf(mx, __shfl_xor(mx, 1)); mx = fmaxf(mx, __shfl_xor(mx, 2));
            f32x4 ex; ex.x = __expf(ac.x - mx); ex.y = __expf(ac.y - mx); ex.z = __expf(ac.z - mx); ex.w = __expf(ac.w - mx);
            float sum = (ex.x + ex.y) + (ex.z + ex.w); sum += __shfl_xor(sum, 1); sum += __shfl_xor(sum, 2);
            const float inv = 1.0f / sum;
            if (F.lane < 4) {
                if (m < MLAT) { const int b = m >> 12, s = m & 4095; float* p = AFL + ((size_t)(b * 16 + 4 * F.lane)) * 4096 + s; p[0] = ex.x * inv; p[4096] = ex.y * inv; p[2 * 4096] = ex.z * inv; p[3 * 4096] = ex.w * inv; }
                else { const int b = (m - MLAT) >> 8, s = (m - MLAT) & 255; float* p = AFC + ((size_t)(b * 16 + 4 * F.lane)) * 256 + s; p[0] = ex.x * inv; p[256] = ex.y * inv; p[512] = ex.z * inv; p[768] = ex.w * inv; }
            }
        }
    }
}

DI unsigned block_excl_scan(unsigned v, unsigned& total, LAS unsigned* wsum, int tid, int lane, int wave) {
    unsigned x = v;
#pragma unroll
    for (int o = 1; o < 64; o <<= 1) { const unsigned y = __shfl_up(x, o); if (lane >= o) x += y; }
    if (lane == 63) wsum[wave] = x;
    __syncthreads();
    unsigned base = 0, tot = 0;
#pragma unroll
    for (int w = 0; w < 8; ++w) { const unsigned s = wsum[w]; if (w < wave) base += s; tot += s; }
    __syncthreads();
    total = tot;
    return base + x - v;
}
DI void select_phase(Frame& F, KArgs ka, int l) {
    KA_FRESH(ka); const __attribute__((address_space(4))) Args& a = *ka; frame_fresh(F);
    const bool last = (l == NL - 1);
    const int nunits = last ? 128 : 256;
    LAS unsigned* hist = (LAS unsigned*)F.lds;
    LAS unsigned* wsum = (LAS unsigned*)(F.lds + 8192);
    LAS unsigned* bc = (LAS unsigned*)(F.lds + 8192 + 64);
    LAS int* sel = (LAS int*)(F.lds + 16384);
    const float* AFL = (const float*)(a.ws + WS_AFL); const float* AFC = (const float*)(a.ws + WS_AFC);
    int* smap = (int*)(a.ws + WS_SMAP); float* gate = (float*)(a.ws + WS_GATE);
    const unsigned char* H2 = a.ws + WS_H2; unsigned char* XG = a.ws + WS_XG;
    for (int unit = blockIdx.x; unit < nunits; unit += F.G) {
        const bool lat = unit < 128; const int be = unit & 127, b = be >> 4, e = be & 15;
        const int N = lat ? 4096 : 256, cap = lat ? CAP_LAT : CAP_CTX;
        const float* aff = lat ? AFL + (size_t)be * 4096 : AFC + (size_t)be * 256;
        unsigned key[8]; const int per = lat ? 8 : 1; const bool act = lat || F.tid < 256;
#pragma unroll
        for (int j = 0; j < 8; ++j) key[j] = (act && j < per) ? __float_as_uint(aff[F.tid * per + j]) : 0u;
        unsigned prefix = 0u, pmask = 0u, need = (unsigned)cap;
#pragma unroll
        for (int pass = 0; pass < 3; ++pass) {
            const int shift = pass == 0 ? 21 : (pass == 1 ? 10 : 0), nb = pass == 2 ? 1024 : 2048;
            for (int i = F.tid; i < 2048; i += 512) hist[i] = 0u;
            __syncthreads();
#pragma unroll
            for (int j = 0; j < 8; ++j) if (act && j < per && (key[j] & pmask) == prefix) (void)__hip_atomic_fetch_add(&hist[(key[j] >> shift) & (nb - 1)], 1u, __ATOMIC_RELAXED, __HIP_MEMORY_SCOPE_WORKGROUP);
            __syncthreads();
            unsigned c4[4], mine = 0;
#pragma unroll
            for (int j = 0; j < 4; ++j) { const int bin = 2047 - 4 * F.tid - j; c4[j] = bin < nb ? hist[bin] : 0u; mine += c4[j]; }
            unsigned tot; unsigned run = block_excl_scan(mine, tot, wsum, F.tid, F.lane, F.wave);
#pragma unroll
            for (int j = 0; j < 4; ++j) { const int bin = 2047 - 4 * F.tid - j;
                if (bin < nb && run < need && run + c4[j] >= need) { bc[0] = (unsigned)bin; bc[1] = run; }
                run += c4[j]; }
            __syncthreads();
            const unsigned cb = bc[0], above = bc[1];
            prefix |= cb << shift; pmask |= (unsigned)(nb - 1) << shift; need -= above;
            __syncthreads();
        }
        unsigned neq = 0, ngt = 0;
#pragma unroll
        for (int j = 0; j < 8; ++j) if (act && j < per) { neq += key[j] == prefix; ngt += key[j] > prefix; }
        unsigned teq; const unsigned eqbase = block_excl_scan(neq, teq, wsum, F.tid, F.lane, F.wave);
        unsigned nsel = 0, flags = 0, erun = eqbase;
#pragma unroll
        for (int j = 0; j < 8; ++j) if (act && j < per) { bool s = key[j] > prefix; if (key[j] == prefix) { s = erun < need; ++erun; } if (s) { flags |= 1u << j; ++nsel; } }
        unsigned tsel; unsigned sbase = block_excl_scan(nsel, tsel, wsum, F.tid, F.lane, F.wave);
        const int rowbase = lat ? b * SEQ : MLAT + b * CTX;
        const int slotbase = lat ? be * CAP_LAT : NSLOT_LAT + (e * 8 + b) * CAP_CTX;
#pragma unroll
        for (int j = 0; j < 8; ++j) if (act && j < per) { const int tok = F.tid * per + j; int slot = -1;
            if ((flags >> j) & 1u) { slot = slotbase + (int)sbase; sel[sbase] = tok; gate[slot] = __uint_as_float(key[j]); ++sbase; }
            smap[(size_t)e * MT + rowbase + tok] = slot; }
        __syncthreads();
        if (lat) {
            for (int t0 = F.wave * 16; t0 < cap; t0 += 128) {
                u32x4 rowv[16];
#pragma unroll
                for (int q = 0; q < 16; ++q) rowv[q] = ((const u32x4*)(H2 + (size_t)(rowbase + sel[t0 + q]) * D))[F.lane];
#pragma unroll
                for (int q = 0; q < 16; ++q) ((u32x4*)(XG + (size_t)(slotbase + t0 + q) * D))[F.lane] = rowv[q];
            }
        } else {
            const int t0 = F.wave * 4;
            u32x4 rowv[4];
#pragma unroll
            for (int q = 0; q < 4; ++q) rowv[q] = ((const u32x4*)(H2 + (size_t)(rowbase + sel[t0 + q]) * D))[F.lane];
#pragma unroll
            for (int q = 0; q < 4; ++q) ((u32x4*)(XG + (size_t)(slotbase + t0 + q) * D))[F.lane] = rowv[q];
        }
        __syncthreads();
    }
}

#ifndef Q_INA
#define Q_INA 2
#endif
#ifndef Q_INB
#define Q_INB 4
#endif
#ifndef Q_INC
#define Q_INC 6
#endif
#ifndef Q_MRG
#define Q_MRG 6
#endif
#ifndef Q_WO
#define Q_WO 1
#endif
#ifndef Q_GU
#define Q_GU 2
#endif
#ifndef Q_DN
#define Q_DN 2
#endif
#define TAIL1(nwg_, Q_) do { const int r_ = (nwg_) % F.G; if (!last && r_ != 0) { if (bx >= r_) convert_tail(F, ka, l + 1, cur + 8 * (Q_) * (bx - r_), (Q_)); cur += 8 * (Q_) * (F.G - r_); } } while (0)
DI unsigned char* ws_fresh(KArgs ka) { KA_FRESH(ka); return ka->ws; }
__global__ void __launch_bounds__(512, 2) mega_fwd(Args a_unused) {
    extern __shared__ __attribute__((aligned(16))) unsigned char lds_raw[];
    KArgs ka = (KArgs)__builtin_amdgcn_kernarg_segment_ptr();
    Frame F;
    F.lds = (LAS unsigned char*)lds_raw;
    F.tid = threadIdx.x; F.lane = F.tid & 63; F.wave = __builtin_amdgcn_readfirstlane(F.tid >> 6);
    F.G = gridDim.x; { const int bx = blockIdx.x; F.vcu = (F.G % 8 == 0) ? (bx % 8) * (F.G / 8) + bx / 8 : bx; }
    F.gw = F.vcu * 8 + F.wave; F.ngw = F.G * 8;
    for (int u = F.tid; u < (LDS_BYTES - LDSCTL_OFF) / 4; u += 512) ((LAS unsigned*)(F.lds + LDSCTL_OFF))[u] = 0u;
    __syncthreads();
    XcdBarrier bar = xcd_barrier_post((unsigned*)(ws_fresh(ka) + WS_CTL) + CW_BAR, (volatile LAS unsigned*)(F.lds + LDSCTL_OFF + 32));
#define GRID_BAR() xcd_barrier(bar)
    const int bx = blockIdx.x;

    if (PH(0)) modv_phase(F, ka);
    for (int rep_ = 0; rep_ < REPS(2); ++rep_) if (PH(2)) convert_weights(F, ka, 0, 0);
    GRID_BAR();
    if (PH(3)) row_phase(F, ka, 0);
    GRID_BAR();

    for (int l = 0; l < NL; ++l) {
        const bool last = (l == NL - 1);
        const int nMe = last ? MLAT / 256 : MT / 256;
        const int nMs = last ? NSLOT_LAT / 256 : NSLOT / 256;
        int cur = 0;
        if (PH(4)) { unsigned char* ws = ws_fresh(ka);
            for (int rep_ = 0; rep_ < REPS(4); ++rep_) { pg8::Gemm g{(const bf16_t*)(ws + WS_R4), (const bf16_t*)wsel(ws, l, W_IN), 1024, 1024, 1024, 0}; pg8::Order S; S.init(MT / 256, DINP / 256, F.G, bx);
              pg8::EpiStoreBf16 E{(bf16_t*)(ws + WS_HW), DINP}; pg8::gemm_phase(F.lds, g, S, E); }
            for (int rep_ = 0; rep_ < REPS(17); ++rep_) { pg8::Gemm g{(const bf16_t*)(ws + WS_R4 + 68 * MiB), (const bf16_t*)wsel(ws, l, W_GL), 1024, 1024, 1024, 0}; pg8::Order S; S.init(MT / 256, NGL / 256, F.G, (bx + F.G / 2) % F.G);
              pg8::EpiGate E{ws + WS_G}; pg8::gemm_phase<pg8::EpiGate, true>(F.lds, g, S, E); } }
        if (!last && F.G == 256) {
            int q = 0, off = 0;
            if (bx < 128) { q = Q_INA; off = bx * Q_INA; } else if (bx >= 224) { q = Q_INC; off = 128 * Q_INA + 24 * Q_INB + (bx - 224) * Q_INC; } else if (bx >= 200) { q = Q_INB; off = 128 * Q_INA + (bx - 200) * Q_INB; }
            if (q) convert_tail(F, ka, l + 1, cur + 8 * off, q);
            cur += 8 * (128 * Q_INA + 24 * Q_INB + 32 * Q_INC); }
        GRID_BAR();
        for (int rep_ = 0; rep_ < REPS(5); ++rep_) if (PH(5)) { unsigned char* ws = ws_fresh(ka); pg8::Gemm g{(const bf16_t*)(ws + WS_HW) + C_CQ, (const bf16_t*)wsel(ws, l, W_UP), 384, DINP, 384, 0}; pg8::Order S; S.init(MT / 256, UW / 256, F.G, bx);
            pg8::EpiStoreBf16 E{(bf16_t*)(ws + WS_R4), UW}; pg8::gemm_phase(F.lds, g, S, E); }
        for (int rep_ = 0; rep_ < REPS(6); ++rep_) if (PH(6)) prep_phase(F, ka, l);
        GRID_BAR();
        for (int rep_ = 0; rep_ < REPS(7); ++rep_) if (PH(7)) prep2_phase(F, ka, l, rep_);
        GRID_BAR();
        for (int rep_ = 0; rep_ < REPS(8); ++rep_) if (PH(8)) attn_phase(F, ka, l);
        GRID_BAR();
        for (int rep_ = 0; rep_ < REPS(9); ++rep_) if (PH(9)) { unsigned char* ws = ws_fresh(ka); pg8::Order S; S.init(nMe, 4, F.G, bx);
          const unsigned char* OC = ws + WS_OCAT; bf16_t* MG = (bf16_t*)(ws + WS_MERGED); const unsigned char* GL = ws + WS_G;
          { pg8::Gemm3 g{OC, OC + 512, OC + 1024, wsel(ws, l, W_NAO), wsel(ws, l, W_MLAO), wsel(ws, l, W_SWAO), OCW, 512}; pg8::EpiMerge3 E{MG, GL}; pg8::gemm_phase3(F.lds, g, S, E); } }
        TAIL1(nMe * 4, Q_MRG);
        GRID_BAR();
        if (PH(10)) { unsigned char* ws = ws_fresh(ka); pg8::Gemm g{(const bf16_t*)(ws + WS_MERGED), (const bf16_t*)wsel(ws, l, W_O), 1024, 1024, 1024, 0}; pg8::Order S; S.init(nMe, 4, F.G, bx);
            pg8::EpiResid E{(bf16_t*)(ws + WS_XS), (const float*)(ws + WS_MODV) + (size_t)l * 9 * 6144 + 2 * 1024}; pg8::gemm_phase<pg8::EpiResid, true>(F.lds, g, S, E); }
        TAIL1(nMe * 4, Q_WO);
        GRID_BAR();
        for (int rep_ = 0; rep_ < REPS(11); ++rep_) if (PH(11)) norm2_phase(F, ka, l, last ? MLAT : MT);
        GRID_BAR();
        for (int rep_ = 0; rep_ < REPS(12); ++rep_) if (PH(12)) select_phase(F, ka, l);
        GRID_BAR();
        for (int rep_ = 0; rep_ < REPS(13); ++rep_) if (PH(13)) { unsigned char* ws = ws_fresh(ka); pg8::Gemm g{(const bf16_t*)(ws + WS_XG), (const bf16_t*)wsel(ws, l, W_GU), 1024, 1024, 1024, (size_t)2048 * 1024}; pg8::Order S; S.init(nMs, 8, F.G, bx, 1);
            pg8::EpiSwiglu E{ws + WS_ACT}; pg8::gemm_phase<pg8::EpiSwiglu, true>(F.lds, g, S, E); }
        TAIL1(nMs * 8, Q_GU);
        GRID_BAR();
        for (int rep_ = 0; rep_ < REPS(14); ++rep_) if (PH(14)) { unsigned char* ws = ws_fresh(ka); pg8::Gemm g{(const bf16_t*)(ws + WS_ACT), (const bf16_t*)wsel(ws, l, W_DN), 1024, 1024, 1024, (size_t)1024 * 1024}; pg8::Order S; S.init(nMs, 4, F.G, bx, 1);
            pg8::EpiDown E{(bf16_t*)(ws + WS_Y), (const float*)(ws + WS_GATE)}; pg8::gemm_phase<pg8::EpiDown, true>(F.lds, g, S, E); }
        TAIL1(nMs * 4, Q_DN);
        GRID_BAR();
        for (int rep_ = 0; rep_ < REPS(15); ++rep_) if (PH(15)) row_phase(F, ka, l + 1, rep_);
        if (!last) { for (int rep_ = 0; rep_ < REPS(16); ++rep_) if (PH(16)) convert_weights(F, ka, l + 1, cur); GRID_BAR(); }
    }
}

extern "C" void kernel_launch(void* const* d_in, const int* in_sizes, int n_in, void* d_out, int out_size, void* d_ws, size_t ws_size, hipStream_t stream) {
    static int grid = 0;
    if (grid == 0) {
        if (n_in != 29 || in_sizes[0] != MLAT * D || out_size != MLAT * D || ws_size < WS_END) {
            fprintf(stderr, "kernel_launch: unexpected problem: n_in %d in0 %d out %d ws %zu (need %zu)\n", n_in, n_in > 0 ? in_sizes[0] : -1, out_size, ws_size, (size_t)WS_END); grid = -1; return; }
        int dev = 0, cus = 0, per_cu = 0;
        if (hipGetDevice(&dev) != hipSuccess || hipDeviceGetAttribute(&cus, hipDeviceAttributeMultiprocessorCount, dev) != hipSuccess) { fprintf(stderr, "kernel_launch: device query failed\n"); grid = -1; return; }
        if (hipFuncSetAttribute((const void*)mega_fwd, hipFuncAttributeMaxDynamicSharedMemorySize, LDS_BYTES) != hipSuccess) { fprintf(stderr, "kernel_launch: hipFuncSetAttribute failed\n"); grid = -1; return; }
        if (hipOccupancyMaxActiveBlocksPerMultiprocessor(&per_cu, (const void*)mega_fwd, 512, LDS_BYTES) != hipSuccess || per_cu < 1) {
            fprintf(stderr, "kernel_launch: occupancy query reports %d workgroups per CU\n", per_cu); }
        (void)hipGetLastError();
        grid = cus;
    }
    if (grid < 0) return;
    if (hipMemsetAsync((char*)d_ws + WS_CTL, 0, CTL_BYTES, stream) != hipSuccess) { fprintf(stderr, "kernel_launch: memset failed\n"); return; }
    Args a{};
    for (int i = 0; i < 29; ++i) a.in[i] = (const float*)d_in[i];
    a.out = (float*)d_out; a.ws = (unsigned char*)d_ws;
    hipLaunchKernelGGL(mega_fwd, dim3(grid), dim3(512), LDS_BYTES, stream, a);
    const hipError_t le = hipPeekAtLastError();
    if (le != hipSuccess) fprintf(stderr, "kernel_launch: launch failed: %s\n", hipGetErrorName(le));
}
```

```cpp
#include <hip/hip_runtime.h>
#include <cstdio>
#include <cstdint>

#define DI __device__ __forceinline__
#ifndef PH_MASK
#define PH_MASK 0xFFFFF
#endif
#define PH(b) ((PH_MASK >> (b)) & 1)
#ifndef REP_MASK
#define REP_MASK 0
#endif
#define REPS(b) (1 + ((REP_MASK >> (b)) & 1))
#define LAS __attribute__((address_space(3)))
#define GAS __attribute__((address_space(1)))
typedef unsigned short bf16_t;
typedef short bf16x8 __attribute__((ext_vector_type(8)));
typedef short s16x4 __attribute__((ext_vector_type(4)));
typedef float f32x4 __attribute__((ext_vector_type(4)));
typedef float f32x2 __attribute__((ext_vector_type(2)));
typedef float f32x16 __attribute__((ext_vector_type(16)));
typedef unsigned u32x4 __attribute__((ext_vector_type(4)));
typedef unsigned u32x2 __attribute__((ext_vector_type(2)));
typedef int i32x8 __attribute__((ext_vector_type(8)));

constexpr int D = 1024, NB = 8, SEQ = 4096, NL = 4, CTX = 256;
constexpr int MLAT = NB * SEQ, MCTX = NB * CTX, MT = MLAT + MCTX;
constexpr int DIN = 5312, DINP = 2304, NGL = 3072;
constexpr int C_NAQ = 0, C_NAK = 384, C_NAV = 768, C_CQ = 1152, C_CKV = 1408, C_KR = 1536, C_SWQ = 1600, C_SWK = 1984, C_SWV = 2112, C_GL = 2240;
constexpr int UW = 1792;
constexpr int P1W = 1280;
constexpr int P2W = 1536;
constexpr int OCW = 1536;
constexpr int NE = 16, CAP_LAT = 512, CAP_CTX = 32;
constexpr int NSLOT_LAT = NB * NE * CAP_LAT, NSLOT = NSLOT_LAT + NB * NE * CAP_CTX;
constexpr float EPS = 1e-6f;
constexpr float LOG2E = 1.4426950408889634f;

constexpr size_t MiB = 1u << 20;
constexpr size_t WS_CTL = 0, CTL_BYTES = 1 * MiB;
constexpr size_t WS_MODV = 1 * MiB;
constexpr size_t WS_W = 2 * MiB;
constexpr size_t W_IN = 0, W_GL = 4718592  , W_UP = 11010048, W_NAO = 7864320  , W_MLAO = 13172736, W_SWAO = 8912896  , W_O = 15007744, W_GU = 17104896, W_DN = 84213760, W_END = 117768192;
constexpr size_t WS_XS = 115 * MiB, WS_W2 = 183 * MiB  ;
constexpr size_t WS_HW = 251 * MiB;
constexpr size_t WS_G = WS_HW + 153 * MiB;
constexpr size_t WS_P1 = 608 * MiB;
constexpr size_t WS_P2 = 693 * MiB;
constexpr size_t WS_R4 = 795 * MiB;
constexpr size_t WS_AFL = 914 * MiB;
constexpr size_t WS_AFC = 916 * MiB;
constexpr size_t WS_SMAP = 917 * MiB;
constexpr size_t WS_GATE = 920 * MiB;
constexpr size_t WS_OCAT = 921 * MiB;
constexpr size_t WS_END = 1006 * MiB;
constexpr size_t WS_MERGED = WS_P1;
constexpr size_t WS_H2 = WS_HW;
constexpr size_t WS_XG = WS_HW + 68 * MiB;
constexpr size_t WS_ACT = WS_HW + 204 * MiB;
constexpr size_t WS_Y = WS_HW + 340 * MiB;
static_assert(W_END <= 113 * MiB && WS_W + 113 * MiB <= WS_XS, "weights");
static_assert(W_GU + 64 * MiB <= W_DN && W_DN + 32 * MiB <= 113 * MiB && WS_XS + (size_t)MT * D * 2 <= WS_W2 && WS_W2 + W_GU <= WS_HW, "second weight buffers");
static_assert(WS_XS + (size_t)MT * D * 4 <= WS_HW && WS_HW + (size_t)MT * DINP * 2 <= WS_G && WS_G + (size_t)MT * NGL * 2 <= WS_P1 && WS_P1 + (size_t)MT * P1W * 2 <= WS_P2 && WS_P2 + (size_t)MT * P2W * 2 <= WS_R4, "map");
static_assert(WS_R4 + (size_t)MT * UW * 2 <= WS_AFL && WS_Y + (size_t)NSLOT * D * 2 <= WS_R4 && WS_SMAP + (size_t)16 * MT * 4 <= WS_GATE && WS_GATE + (size_t)NSLOT * 4 <= WS_OCAT && WS_OCAT + (size_t)MT * OCW <= WS_END, "map2");
constexpr int CW_BAR = 4096;

constexpr int RING_BYTES = 131072, LDSCTL_OFF = RING_BYTES, LDS_BYTES = 147456;

DI unsigned pk2(float lo, float hi) { unsigned r; asm("v_cvt_pk_bf16_f32 %0, %1, %2" : "=v"(r) : "v"(lo), "v"(hi)); return r; }
DI unsigned pk4_fp8(float a, float b, float c, float d) { int w = 0; w = __builtin_amdgcn_cvt_pk_fp8_f32(a, b, w, false); w = __builtin_amdgcn_cvt_pk_fp8_f32(c, d, w, true); return (unsigned)w; }
DI float bflo(unsigned w) { return __uint_as_float(w << 16); }
DI float bfhi(unsigned w) { return __uint_as_float(w & 0xffff0000u); }
DI float bf2f(bf16_t b) { return __uint_as_float((unsigned)b << 16); }
DI float wave_sum(float v) {
#pragma unroll
    for (int o = 1; o < 64; o <<= 1) v += __shfl_xor(v, o);
    return v;
}
DI float sigmoidf_(float x) { return __builtin_amdgcn_rcpf(1.0f + __builtin_amdgcn_exp2f(-x * LOG2E)); }
DI int mod_index(int row) { return row < MLAT ? (row >> 12) : 8; }

#define XB_TMO      128
#define XB_XCNT(j)  (256  + 64 * (j))
#define XB_XSUB(j)  (1280 + 64 * (j))
#define XB_XGEN(j)  (2304 + 64 * (j))
#define XB_TOP      3328
#define XB_TOPGEN   3392
#define XCD_BAR_WORDS 3456
#define XB_SPIN_CAP (1u << 18)
DI unsigned xb_ld(unsigned* p)              { return __hip_atomic_load(p, __ATOMIC_RELAXED, __HIP_MEMORY_SCOPE_AGENT); }
DI unsigned xb_add(unsigned* p, unsigned v) { return __hip_atomic_fetch_add(p, v, __ATOMIC_RELAXED, __HIP_MEMORY_SCOPE_AGENT); }
DI unsigned xb_xcc_id() { return (unsigned)__builtin_amdgcn_s_getreg((3 << 11) | 20) & 0xFu; }
#define XB_SPIN(cond, bar) do { unsigned _sp = 0; while (cond) { __builtin_amdgcn_s_sleep(1); \
    if ((++_sp & 255u) == 0u) { if (xb_ld(&(bar)[XB_TMO])) break; if (_sp > XB_SPIN_CAP) { atomicAdd(&(bar)[XB_TMO], 1u); break; } } } } while (0)
struct XcdBarrier { unsigned* bar; unsigned x; volatile LAS unsigned* st; };
DI XcdBarrier xcd_barrier_post(unsigned* bar, volatile LAS unsigned* st) {
    XcdBarrier b; b.bar = bar; b.x = xb_xcc_id(); b.st = st;
    if (threadIdx.x == 0) (void)xb_add(&bar[XB_XCNT(b.x)], 1u);
    return b;
}
DI void xcd_barrier_complete(unsigned* bar, unsigned x, unsigned& nloc, unsigned& nx) {
    const unsigned G = gridDim.x * gridDim.y * gridDim.z;
    unsigned sum, cnt, mine, sp = 0u;
    for (;;) {
        sum = 0u; cnt = 0u; mine = 0u;
#pragma unroll
        for (unsigned j = 0; j < 16; ++j) { const unsigned c = xb_ld(&bar[XB_XCNT(j)]); sum += c; cnt += (c > 0u) ? 1u : 0u; mine = (j == x) ? c : mine; }
        if (sum == G) break;
        __builtin_amdgcn_s_sleep(1);
        if ((++sp & 255u) == 0u) { if (xb_ld(&bar[XB_TMO])) break; if (sp > XB_SPIN_CAP) { atomicAdd(&bar[XB_TMO], 1u); break; } }
    }
    nloc = mine > 0u ? mine : 1u; nx = cnt > 0u ? cnt : 1u;
}
DI void xcd_barrier(const XcdBarrier& b) {
    asm volatile("s_waitcnt vmcnt(0)" ::: "memory");
    __syncthreads();
    if (threadIdx.x == 0) {
        unsigned* bar = b.bar; unsigned bx_ = b.x; asm volatile("" : "+s"(bar), "+s"(bx_));
        __builtin_amdgcn_s_waitcnt(0);
        unsigned nloc = b.st[0], nx = b.st[1];
        if (nloc == 0u) { xcd_barrier_complete(bar, bx_, nloc, nx); b.st[0] = nloc; b.st[1] = nx; }
        const unsigned old = xb_add(&bar[XB_XSUB(bx_)], 1u);
        const unsigned gen = old / nloc;
        if (old + 1u == (gen + 1u) * nloc) {
            __builtin_amdgcn_fence(__ATOMIC_RELEASE, "agent");
            asm volatile("s_waitcnt vmcnt(0)" ::: "memory");
            const unsigned og = xb_add(&bar[XB_TOP], 1u);
            const unsigned tg = og / nx;
            if (og + 1u == (tg + 1u) * nx) xb_add(&bar[XB_TOPGEN], 1u);
            else XB_SPIN(xb_ld(&bar[XB_TOPGEN]) == tg, bar);
            __builtin_amdgcn_fence(__ATOMIC_ACQUIRE, "agent");
            xb_add(&bar[XB_XGEN(bx_)], 1u);
            asm volatile("s_waitcnt vmcnt(0)" ::: "memory");
        } else {
            XB_SPIN(xb_ld(&bar[XB_XGEN(bx_)]) == gen, bar);
            __builtin_amdgcn_fence(__ATOMIC_ACQUIRE, "agent");
            asm volatile("s_waitcnt vmcnt(0)" ::: "memory");
        }
    }
    __syncthreads();
}

namespace pg8 {
constexpr int BM = 256, BK = 64, HALF = 128, HTB = HALF * BK * 2, NXCD = 8, WGM = 8;
__host__ __device__ __forceinline__ int lds_byte(int r, int c) { const int st = (r >> 4) * 2 + (c >> 5), rr = r & 15, cc = c & 31, ob = rr * 64 + cc * 2; return st * 1024 + (ob ^ (((ob >> 9) & 1) << 5)); }
__host__ __device__ __forceinline__ void stage_rc(int b, int& R, int& C) { const int st = b / 1024, sb = b % 1024, swz = sb ^ (((sb >> 9) & 1) << 5); R = (st >> 1) * 16 + swz / 64; C = (st & 1) * 32 + (swz % 64) / 2; }
__host__ __device__ __forceinline__ int perm32(int rho) { const int n = rho >> 4, i = rho & 15; return 8 * (i >> 2) + 4 * n + (i & 3); }
struct Unit { int pm, pn; };
struct Gemm { const bf16_t* A; const bf16_t* Bt; int K, lda, ldb; size_t estride; };
struct Order {
    int nM, nN, nwg, G, c, moe;
    DI void init(int nM_, int nN_, int G_, int c_, int moe_ = 0) { nM = nM_; nN = nN_; nwg = nM * nN; G = G_; c = c_; moe = moe_; }
    DI bool next(int i, Unit& u) const {
        const long L = (long)i * G + c; if (L >= nwg) return false;
        int wgid = (int)L; { const int q = nwg / NXCD, r = nwg % NXCD, xcd = wgid % NXCD, off = wgid / NXCD; wgid = (xcd < r ? xcd * (q + 1) : r * (q + 1) + (xcd - r) * q) + off; }
        const int nig = WGM * nN, gid = wgid / nig, fm = gid * WGM, gsz = (nM - fm) < WGM ? (nM - fm) : WGM;
        u.pm = fm + ((wgid % nig) % gsz); u.pn = (wgid % nig) / gsz;
        if (moe && u.pm < 256) { const int e = u.pm >> 4, b = (u.pm >> 1) & 7, hf = u.pm & 1; u.pm = (((b << 4) | e) << 1) | hf; }
        return true;
    }
};
struct EpiStoreBf16 {
    static constexpr bool PERM = true;
    bf16_t* O; int ldc;
    DI void operator()(const f32x4 (&acc)[2][2][4][2], const Unit& u, int wr, int wc, int fr, int fq) const {
        const int row0 = u.pm * BM + wr * 64 + fr, col0 = u.pn * BM + wc * 32 + 8 * fq;
#pragma unroll
        for (int ai = 0; ai < 2; ++ai)
#pragma unroll
            for (int m = 0; m < 4; ++m) { bf16_t* rowp = O + (size_t)(row0 + ai * HALF + m * 16) * ldc + col0;
#pragma unroll
                for (int bj = 0; bj < 2; ++bj) { const f32x4 v0 = acc[ai][bj][m][0], v1 = acc[ai][bj][m][1];
                    u32x4 w; w.x = pk2(v0[0], v0[1]); w.y = pk2(v0[2], v0[3]); w.z = pk2(v1[0], v1[1]); w.w = pk2(v1[2], v1[3]);
                    *(u32x4*)(rowp + bj * HALF) = w; } }
    }
};
DI unsigned pk4_u8(float a, float b, float c, float d) {
    unsigned ua = (unsigned)(a * 255.0f + 0.5f), ub = (unsigned)(b * 255.0f + 0.5f), uc = (unsigned)(c * 255.0f + 0.5f), ud = (unsigned)(d * 255.0f + 0.5f);
    ua = ua < 1u ? 1u : ua; ub = ub < 1u ? 1u : ub; uc = uc < 1u ? 1u : uc; ud = ud < 1u ? 1u : ud;
    return ua | (ub << 8) | (uc << 16) | (ud << 24);
}
struct EpiGate {
    static constexpr bool PERM = true;
    unsigned char* O;
    DI void operator()(const f32x4 (&acc)[2][2][4][2], const Unit& u, int wr, int wc, int fr, int fq) const {
        const int row0 = u.pm * BM + wr * 64 + fr, col0 = u.pn * BM + wc * 32 + 8 * fq;
#pragma unroll
        for (int ai = 0; ai < 2; ++ai)
#pragma unroll
            for (int m = 0; m < 4; ++m) { unsigned char* rowp = O + (size_t)(row0 + ai * HALF + m * 16) * NGL + col0;
#pragma unroll
                for (int bj = 0; bj < 2; ++bj) { const f32x4 v0 = acc[ai][bj][m][0] * 0.03125f, v1 = acc[ai][bj][m][1] * 0.03125f;
                    u32x2 w; w.x = pk4_u8(sigmoidf_(v0[0]), sigmoidf_(v0[1]), sigmoidf_(v0[2]), sigmoidf_(v0[3])); w.y = pk4_u8(sigmoidf_(v1[0]), sigmoidf_(v1[1]), sigmoidf_(v1[2]), sigmoidf_(v1[3]));
                    *(u32x2*)(rowp + bj * HALF) = w; } }
    }
};
DI float u8f(unsigned w, int k) { return (float)((w >> (8 * k)) & 0xffu) * (1.0f / 255.0f); }
struct EpiMerge {
    static constexpr bool PERM = true;
    bf16_t* O; const unsigned char* gl; int first;
    DI void operator()(const f32x4 (&acc)[2][2][4][2], const Unit& u, int wr, int wc, int fr, int fq) const {
        const int row0 = u.pm * BM + wr * 64 + fr, col0 = u.pn * BM + wc * 32 + 8 * fq;
#pragma unroll
        for (int ai = 0; ai < 2; ++ai) {
            u32x2 g[4][2]; u32x4 p[4][2];
#pragma unroll
            for (int m = 0; m < 4; ++m)
#pragma unroll
                for (int bj = 0; bj < 2; ++bj) { const int row = row0 + ai * HALF + m * 16, col = col0 + bj * HALF;
                    g[m][bj] = *(const u32x2*)(gl + (size_t)row * NGL + col);
                    p[m][bj] = first ? (u32x4){0u, 0u, 0u, 0u} : *(const u32x4*)(O + (size_t)row * D + col); }
#pragma unroll
            for (int m = 0; m < 4; ++m)
#pragma unroll
                for (int bj = 0; bj < 2; ++bj) { const int row = row0 + ai * HALF + m * 16, col = col0 + bj * HALF;
                    const u32x2 gg = g[m][bj]; const u32x4 pp = p[m][bj]; const f32x4 v0 = acc[ai][bj][m][0], v1 = acc[ai][bj][m][1];
                    const float r0 = v0[0] * u8f(gg.x, 0) + bflo(pp.x), r1 = v0[1] * u8f(gg.x, 1) + bfhi(pp.x), r2 = v0[2] * u8f(gg.x, 2) + bflo(pp.y), r3 = v0[3] * u8f(gg.x, 3) + bfhi(pp.y);
                    const float r4 = v1[0] * u8f(gg.y, 0) + bflo(pp.z), r5 = v1[1] * u8f(gg.y, 1) + bfhi(pp.z), r6 = v1[2] * u8f(gg.y, 2) + bflo(pp.w), r7 = v1[3] * u8f(gg.y, 3) + bfhi(pp.w);
                    u32x4 w; w.x = pk2(r0, r1); w.y = pk2(r2, r3); w.z = pk2(r4, r5); w.w = pk2(r6, r7);
                    *(u32x4*)(O + (size_t)row * D + col) = w; }
        }
    }
};
struct EpiResid {
    static constexpr bool PERM = true;
    bf16_t* xs; const float* modg;
    DI void operator()(const f32x4 (&acc)[2][2][4][2], const Unit& u, int wr, int wc, int fr, int fq) const {
        const int row0 = u.pm * BM + wr * 64 + fr, col0 = u.pn * BM + wc * 32 + 8 * fq;
        const float* mp = modg + (size_t)mod_index(u.pm * BM) * 6144 + col0;
        f32x4 g0[2], g1[2];
#pragma unroll
        for (int bj = 0; bj < 2; ++bj) { g0[bj] = *(const f32x4*)(mp + bj * HALF) * (1.0f / 128.0f); g1[bj] = *(const f32x4*)(mp + bj * HALF + 4) * (1.0f / 128.0f); }
#pragma unroll
        for (int ai = 0; ai < 2; ++ai)
#pragma unroll
            for (int mh = 0; mh < 2; ++mh) {
                u32x4 xw[2][2];
#pragma unroll
                for (int m2 = 0; m2 < 2; ++m2)
#pragma unroll
                    for (int bj = 0; bj < 2; ++bj) xw[m2][bj] = *(const u32x4*)(xs + (size_t)(row0 + ai * HALF + (2 * mh + m2) * 16) * D + col0 + bj * HALF);
#pragma unroll
                for (int m2 = 0; m2 < 2; ++m2)
#pragma unroll
                    for (int bj = 0; bj < 2; ++bj) { const int m = 2 * mh + m2; const u32x4 x = xw[m2][bj];
                        const f32x4 x0 = (f32x4){bflo(x.x), bfhi(x.x), bflo(x.y), bfhi(x.y)} + g0[bj] * acc[ai][bj][m][0];
                        const f32x4 x1 = (f32x4){bflo(x.z), bfhi(x.z), bflo(x.w), bfhi(x.w)} + g1[bj] * acc[ai][bj][m][1];
                        u32x4 w; w.x = pk2(x0[0], x0[1]); w.y = pk2(x0[2], x0[3]); w.z = pk2(x1[0], x1[1]); w.w = pk2(x1[2], x1[3]);
                        *(u32x4*)(xs + (size_t)(row0 + ai * HALF + m * 16) * D + col0 + bj * HALF) = w; }
            }
    }
};
struct EpiSwiglu {
    static constexpr bool PERM = true;
    unsigned char* O;
    DI void operator()(const f32x4 (&acc)[2][2][4][2], const Unit& u, int wr, int wc, int fr, int fq) const {
        const int row0 = u.pm * BM + wr * 64 + fr, col0 = u.pn * HALF + wc * 32 + 8 * fq;
#pragma unroll
        for (int ai = 0; ai < 2; ++ai)
#pragma unroll
            for (int m = 0; m < 4; ++m) { const int row = row0 + ai * HALF + m * 16;
                const f32x4 a0 = acc[ai][0][m][0] * 0.03125f, a1 = acc[ai][0][m][1] * 0.03125f, u0 = acc[ai][1][m][0] * 0.25f, u1 = acc[ai][1][m][1] * 0.25f;
                float r[8];
#pragma unroll
                for (int j = 0; j < 4; ++j) { r[j] = a0[j] * sigmoidf_(a0[j]) * u0[j]; r[4 + j] = a1[j] * sigmoidf_(a1[j]) * u1[j]; }
                u32x2 w; w.x = pk4_fp8(r[0], r[1], r[2], r[3]); w.y = pk4_fp8(r[4], r[5], r[6], r[7]);
                *(u32x2*)(O + (size_t)row * D + col0) = w; }
    }
};
struct EpiDown {
    static constexpr bool PERM = true;
    bf16_t* O; const float* gate;
    DI void operator()(const f32x4 (&acc)[2][2][4][2], const Unit& u, int wr, int wc, int fr, int fq) const {
        const int row0 = u.pm * BM + wr * 64 + fr, col0 = u.pn * BM + wc * 32 + 8 * fq;
        float gv[2][4];
#pragma unroll
        for (int ai = 0; ai < 2; ++ai)
#pragma unroll
            for (int m = 0; m < 4; ++m) gv[ai][m] = gate[row0 + ai * HALF + m * 16] * (1.0f / 256.0f);
#pragma unroll
        for (int ai = 0; ai < 2; ++ai)
#pragma unroll
            for (int m = 0; m < 4; ++m) { const int row = row0 + ai * HALF + m * 16; const float g = gv[ai][m]; bf16_t* rowp = O + (size_t)row * D + col0;
#pragma unroll
                for (int bj = 0; bj < 2; ++bj) { const f32x4 v0 = acc[ai][bj][m][0] * g, v1 = acc[ai][bj][m][1] * g;
                    u32x4 w; w.x = pk2(v0[0], v0[1]); w.y = pk2(v0[2], v0[3]); w.z = pk2(v1[0], v1[1]); w.w = pk2(v1[2], v1[3]);
                    *(u32x4*)(rowp + bj * HALF) = w; } }
    }
};

struct EpiMerge3 {
    static constexpr bool PERM = true;
    bf16_t* O; const unsigned char* gl;
    DI void operator()(f32x4 (&acc)[2][2][4][2], const Unit& u, int seg, int wr, int wc, int fr, int fq) const {
        const int row0 = u.pm * BM + wr * 64 + fr, col0 = u.pn * BM + wc * 32 + 8 * fq;
#pragma unroll
        for (int ai = 0; ai < 2; ++ai) {
            u32x2 ga[4][2], gb[4][2];
#pragma unroll
            for (int m = 0; m < 4; ++m)
#pragma unroll
                for (int bj = 0; bj < 2; ++bj) { const unsigned char* gp = gl + (size_t)(row0 + ai * HALF + m * 16) * NGL + 1024 * seg + col0 + bj * HALF;
                    ga[m][bj] = *(const u32x2*)gp; gb[m][bj] = seg < 2 ? *(const u32x2*)(gp + 1024) : (u32x2){0u, 0u}; }
#pragma unroll
            for (int m = 0; m < 4; ++m)
#pragma unroll
                for (int bj = 0; bj < 2; ++bj) {
                    f32x4 s0, s1;
#pragma unroll
                    for (int k = 0; k < 4; ++k) { const float a0 = (float)((ga[m][bj].x >> (8 * k)) & 0xffu), a1 = (float)((ga[m][bj].y >> (8 * k)) & 0xffu);
                        if (seg < 2) { const float b0 = (float)((gb[m][bj].x >> (8 * k)) & 0xffu), b1 = (float)((gb[m][bj].y >> (8 * k)) & 0xffu); s0[k] = a0 * __builtin_amdgcn_rcpf(b0); s1[k] = a1 * __builtin_amdgcn_rcpf(b1); }
                        else { s0[k] = a0 * (1.0f / (255.0f * 128.0f)); s1[k] = a1 * (1.0f / (255.0f * 128.0f)); } }
                    acc[ai][bj][m][0] *= s0; acc[ai][bj][m][1] *= s1;
                    if (seg == 2) { const f32x4 v0 = acc[ai][bj][m][0] * 4.0f, v1 = acc[ai][bj][m][1] * 4.0f;
                        u32x2 w; w.x = pk4_fp8(v0[0], v0[1], v0[2], v0[3]); w.y = pk4_fp8(v1[0], v1[1], v1[2], v1[3]);
                        *(u32x2*)((unsigned char*)O + (size_t)(row0 + ai * HALF + m * 16) * D + col0 + bj * HALF) = w; }
                }
        }
    }
};
struct Gemm3 { const unsigned char* A0; const unsigned char* A1; const unsigned char* A2; const unsigned char* B0; const unsigned char* B1; const unsigned char* B2; int lda, ldb; };
template <class Epi>
DI void gemm_phase3(LAS unsigned char* lds, const Gemm3 g, const Order& S, const Epi& E) {
    int tid_ = threadIdx.x; asm volatile("" : "+v"(tid_));
    const int tid = tid_, wid = __builtin_amdgcn_readfirstlane(tid >> 6), lane = tid & 63, wr = wid >> 2, wc = wid & 3, fr = lane & 15, fq = lane >> 4;
    unsigned voffA[2], voffB[2];
#pragma unroll
    for (int i = 0; i < 2; ++i) { int R, C; stage_rc(tid * 16 + i * 8192, R, C); const int Rb = Epi::PERM ? ((R & ~31) + perm32(R & 31)) : R;
        voffA[i] = (unsigned)(R * g.lda + C * 2); voffB[i] = (unsigned)(Rb * g.ldb + C * 2); }
    const size_t kstep = (size_t)(BK * 2);
    const size_t hstepA = (size_t)HALF * g.lda, hstepB = (size_t)HALF * g.ldb;
    const size_t tstepA = 2 * hstepA, tstepB = 2 * hstepB;
    const unsigned ldsw = (unsigned)wid * 1024u;
    const int aoff = lds_byte(wr * 64 + fr, fq * 8), boff = lds_byte(wc * 32 + fr, fq * 8);
#define PG8_SA(b, h) (((b) * 2 + (h)) * HTB)
#define PG8_SB(b, h) ((4 + (b) * 2 + (h)) * HTB)
#define PG8_STAGE(bufoff, gbase, voff) do { _Pragma("unroll") for (int _i = 0; _i < 2; ++_i) \
        __builtin_amdgcn_global_load_lds((const unsigned*)((const char*)(gbase) + (voff)[_i]), (LAS unsigned*)(lds + (bufoff) + ldsw + _i * 8192), 16, 0, 0); } while (0)
#define PG8_LDA(dst, b, h) do { _Pragma("unroll") for (int m = 0; m < 4; ++m) _Pragma("unroll") for (int k = 0; k < 2; ++k) dst[m][k] = *(const LAS bf16x8*)(lds + PG8_SA(b, h) + aoff + m * 2048 + k * 1024); } while (0)
#define PG8_LDB(dst, b, h) do { _Pragma("unroll") for (int n = 0; n < 2; ++n) _Pragma("unroll") for (int k = 0; k < 2; ++k) dst[n][k] = *(const LAS bf16x8*)(lds + PG8_SB(b, h) + boff + n * 2048 + k * 1024); } while (0)
#define PG8_MMA(ai, bj, At, Bt) do { __builtin_amdgcn_s_setprio(1); _Pragma("unroll") for (int m = 0; m < 4; ++m) _Pragma("unroll") for (int n = 0; n < 2; ++n) { \
        const i32x8 bb_ = __builtin_bit_cast(i32x8, __builtin_shufflevector(Bt[n][0], Bt[n][1], 0, 1, 2, 3, 4, 5, 6, 7, 8, 9, 10, 11, 12, 13, 14, 15)); \
        const i32x8 aa_ = __builtin_bit_cast(i32x8, __builtin_shufflevector(At[m][0], At[m][1], 0, 1, 2, 3, 4, 5, 6, 7, 8, 9, 10, 11, 12, 13, 14, 15)); \
        asm volatile("v_mfma_scale_f32_16x16x128_f8f6f4 %0, %1, %2, %0, %3, %3 op_sel_hi:[0,0,0]" : "+v"(acc[ai][bj][m][n]) : "v"(bb_), "v"(aa_), "v"(0x7F7F7F7F)); } \
        __builtin_amdgcn_s_setprio(0); } while (0)
#define PG8_WAIT_V(n) asm volatile("s_waitcnt vmcnt(" #n ")" ::: "memory")
#define PG8_WAIT_L(n) asm volatile("s_waitcnt lgkmcnt(" #n ")" ::: "memory")
#define PG8_BAR __builtin_amdgcn_s_barrier()
#define PG8_SCHED __builtin_amdgcn_sched_barrier(0)
#define PG8_A3(sg, u) ((const char*)((sg) == 0 ? g.A0 : (sg) == 1 ? g.A1 : g.A2) + (size_t)(u).pm * tstepA)
#define PG8_B3(sg, u) ((const char*)((sg) == 0 ? g.B0 : (sg) == 1 ? g.B1 : g.B2) + (size_t)(u).pn * tstepB)
    Unit cur, nu; int ui = 0, seg = 0;
    if (!S.next(0, cur)) return;
    f32x4 acc[2][2][4][2];
#pragma unroll
    for (int a = 0; a < 2; ++a)
#pragma unroll
        for (int b = 0; b < 2; ++b)
#pragma unroll
            for (int m = 0; m < 4; ++m)
#pragma unroll
                for (int n = 0; n < 2; ++n) acc[a][b][m][n] = (f32x4){0.f, 0.f, 0.f, 0.f};
    bf16x8 At[4][2], B0[2][2], B1[2][2];
    const char* cA = PG8_A3(0, cur); const char* cB = PG8_B3(0, cur);
    PG8_STAGE(PG8_SB(0, 0), cB, voffB); PG8_STAGE(PG8_SB(0, 1), cB + hstepB, voffB); PG8_STAGE(PG8_SA(0, 0), cA, voffA); PG8_STAGE(PG8_SA(0, 1), cA + hstepA, voffA);
    if (wr == 1) PG8_BAR;
    PG8_WAIT_V(2); PG8_BAR;
    PG8_STAGE(PG8_SB(1, 0), cB + kstep, voffB); PG8_STAGE(PG8_SA(1, 0), cA + kstep, voffA); PG8_STAGE(PG8_SB(1, 1), cB + hstepB + kstep, voffB);
    PG8_WAIT_V(6); PG8_BAR;
    for (;;) {
        int nseg = seg + 1; bool has_next = true; nu = cur;
        if (nseg == 3) { nseg = 0; has_next = S.next(ui + 1, nu); }
        const char* nA = has_next ? PG8_A3(nseg, nu) : cA; const char* nB = has_next ? PG8_B3(nseg, nu) : cB;
        int nt_ = 4; asm volatile("" : "+s"(nt_));
        const int nt = nt_;
#pragma nounroll
        for (int t = 0; t < nt; t += 2) {
            const bool last = (t == nt - 2);
            const char* a1 = cA + (size_t)(t + 1) * kstep;
            const char* a2 = last ? nA : cA + (size_t)(t + 2) * kstep; const char* b2 = last ? nB : cB + (size_t)(t + 2) * kstep;
            const char* a3 = a2 + kstep; const char* b3 = b2 + kstep;
            PG8_LDB(B0, 0, 0); PG8_LDB(B1, 0, 1); PG8_SCHED; PG8_LDA(At, 0, 0); PG8_STAGE(PG8_SA(1, 1), a1 + hstepA, voffA);
            PG8_WAIT_V(8); PG8_WAIT_L(0); PG8_BAR; PG8_MMA(0, 0, At, B0); PG8_MMA(0, 1, At, B1); PG8_BAR; PG8_SCHED;
            PG8_LDA(At, 0, 1); PG8_STAGE(PG8_SB(0, 0), b2, voffB); PG8_STAGE(PG8_SB(0, 1), b2 + hstepB, voffB); PG8_STAGE(PG8_SA(0, 0), a2, voffA);
            PG8_WAIT_V(8); PG8_WAIT_L(0); PG8_BAR; PG8_MMA(1, 0, At, B0); PG8_MMA(1, 1, At, B1); PG8_BAR; PG8_SCHED;
            PG8_LDB(B0, 1, 0); PG8_LDB(B1, 1, 1); PG8_SCHED; PG8_LDA(At, 1, 0); PG8_STAGE(PG8_SA(0, 1), a2 + hstepA, voffA);
            PG8_WAIT_V(8); PG8_WAIT_L(0); PG8_BAR; PG8_MMA(0, 0, At, B0); PG8_MMA(0, 1, At, B1); PG8_BAR; PG8_SCHED;
            PG8_LDA(At, 1, 1); PG8_STAGE(PG8_SB(1, 0), b3, voffB); PG8_STAGE(PG8_SB(1, 1), b3 + hstepB, voffB); PG8_STAGE(PG8_SA(1, 0), a3, voffA);
            PG8_WAIT_V(8); PG8_WAIT_L(0); PG8_BAR; PG8_MMA(1, 0, At, B0); PG8_MMA(1, 1, At, B1); PG8_BAR; PG8_SCHED;
        }
        if (wr == 0) PG8_BAR;
        E(acc, cur, seg, wr, wc, fr, fq);
        if (!has_next) break;
        if (seg == 2) {
#pragma unroll
            for (int a = 0; a < 2; ++a)
#pragma unroll
                for (int b = 0; b < 2; ++b)
#pragma unroll
                    for (int m = 0; m < 4; ++m)
#pragma unroll
                        for (int n = 0; n < 2; ++n) acc[a][b][m][n] = (f32x4){0.f, 0.f, 0.f, 0.f};
            cur = nu; ++ui;
        }
        seg = nseg; cA = nA; cB = nB;
        if (wr == 1) PG8_BAR;
    }
    PG8_WAIT_V(0);
    PG8_BAR;
#undef PG8_SA
#undef PG8_SB
#undef PG8_STAGE
#undef PG8_LDA
#undef PG8_LDB
#undef PG8_MMA
#undef PG8_WAIT_V
#undef PG8_WAIT_L
#undef PG8_BAR
#undef PG8_SCHED
#undef PG8_A3
#undef PG8_B3
}

template <class Epi, bool FP8 = false>
DI void gemm_phase(LAS unsigned char* lds, const Gemm g, const Order& S, const Epi& E) {
    constexpr int ESZ = FP8 ? 1 : 2;
    int tid_ = threadIdx.x; asm volatile("" : "+v"(tid_));
    const int tid = tid_, wid = __builtin_amdgcn_readfirstlane(tid >> 6), lane = tid & 63, wr = wid >> 2, wc = wid & 3, fr = lane & 15, fq = lane >> 4;
    const int K = g.K, nt = K * ESZ / (BK * 2);
    unsigned voffA[2], voffB[2];
#pragma unroll
    for (int i = 0; i < 2; ++i) { int R, C; stage_rc(tid * 16 + i * 8192, R, C); const int Rb = Epi::PERM ? ((R & ~31) + perm32(R & 31)) : R;
        voffA[i] = (unsigned)(R * g.lda * ESZ + C * 2); voffB[i] = (unsigned)(Rb * g.ldb * ESZ + C * 2); }
    const size_t kstep = (size_t)(BK * 2);
    const size_t hstepA = (size_t)HALF * g.lda * ESZ, hstepB = (size_t)HALF * g.ldb * ESZ;
    const size_t tstepA = 2 * hstepA, tstepB = 2 * hstepB;
    const unsigned ldsw = (unsigned)wid * 1024u;
    const int aoff = lds_byte(wr * 64 + fr, fq * 8), boff = lds_byte(wc * 32 + fr, fq * 8);
#define PG8_SA(b, h) (((b) * 2 + (h)) * HTB)
#define PG8_SB(b, h) ((4 + (b) * 2 + (h)) * HTB)
#define PG8_STAGE(bufoff, gbase, voff) do { _Pragma("unroll") for (int _i = 0; _i < 2; ++_i) \
        __builtin_amdgcn_global_load_lds((const unsigned*)((const char*)(gbase) + (voff)[_i]), (LAS unsigned*)(lds + (bufoff) + ldsw + _i * 8192), 16, 0, 0); } while (0)
#define PG8_LDA(dst, b, h) do { _Pragma("unroll") for (int m = 0; m < 4; ++m) _Pragma("unroll") for (int k = 0; k < 2; ++k) dst[m][k] = *(const LAS bf16x8*)(lds + PG8_SA(b, h) + aoff + m * 2048 + k * 1024); } while (0)
#define PG8_LDB(dst, b, h) do { _Pragma("unroll") for (int n = 0; n < 2; ++n) _Pragma("unroll") for (int k = 0; k < 2; ++k) dst[n][k] = *(const LAS bf16x8*)(lds + PG8_SB(b, h) + boff + n * 2048 + k * 1024); } while (0)
#define PG8_MMA(ai, bj, At, Bt) do { __builtin_amdgcn_s_setprio(1); _Pragma("unroll") for (int m = 0; m < 4; ++m) _Pragma("unroll") for (int n = 0; n < 2; ++n) { \
        if constexpr (FP8) { const i32x8 bb_ = __builtin_bit_cast(i32x8, __builtin_shufflevector(Bt[n][0], Bt[n][1], 0, 1, 2, 3, 4, 5, 6, 7, 8, 9, 10, 11, 12, 13, 14, 15)); \
            const i32x8 aa_ = __builtin_bit_cast(i32x8, __builtin_shufflevector(At[m][0], At[m][1], 0, 1, 2, 3, 4, 5, 6, 7, 8, 9, 10, 11, 12, 13, 14, 15)); \
            asm volatile("v_mfma_scale_f32_16x16x128_f8f6f4 %0, %1, %2, %0, %3, %3 op_sel_hi:[0,0,0]" : "+v"(acc[ai][bj][m][n]) : "v"(bb_), "v"(aa_), "v"(0x7F7F7F7F)); } \
        else { _Pragma("unroll") for (int k = 0; k < 2; ++k) acc[ai][bj][m][n] = __builtin_amdgcn_mfma_f32_16x16x32_bf16(Bt[n][k], At[m][k], acc[ai][bj][m][n], 0, 0, 0); } } \
        __builtin_amdgcn_s_setprio(0); } while (0)
#define PG8_WAIT_V(n) asm volatile("s_waitcnt vmcnt(" #n ")" ::: "memory")
#define PG8_WAIT_L(n) asm volatile("s_waitcnt lgkmcnt(" #n ")" ::: "memory")
#define PG8_BAR __builtin_amdgcn_s_barrier()
#define PG8_SCHED __builtin_amdgcn_sched_barrier(0)
#define PG8_EXPERT(pm) ((pm) < 256 ? (((pm) >> 1) & 15) : ((pm) - 256))
#define PG8_ABASE(u) ((const char*)g.A + (size_t)(u).pm * tstepA)
#define PG8_BBASE(u) ((const char*)g.Bt + (size_t)PG8_EXPERT((u).pm) * g.estride * ESZ + (size_t)(u).pn * tstepB)
    Unit cur, nxt; int ui = 0;
    if (!S.next(0, cur)) return;
    f32x4 acc[2][2][4][2];
#pragma unroll
    for (int a = 0; a < 2; ++a)
#pragma unroll
        for (int b = 0; b < 2; ++b)
#pragma unroll
            for (int m = 0; m < 4; ++m)
#pragma unroll
                for (int n = 0; n < 2; ++n) acc[a][b][m][n] = (f32x4){0.f, 0.f, 0.f, 0.f};
    bf16x8 At[4][2], B0[2][2], B1[2][2];
    const char* cA = PG8_ABASE(cur); const char* cB = PG8_BBASE(cur);
    PG8_STAGE(PG8_SB(0, 0), cB, voffB); PG8_STAGE(PG8_SB(0, 1), cB + hstepB, voffB); PG8_STAGE(PG8_SA(0, 0), cA, voffA); PG8_STAGE(PG8_SA(0, 1), cA + hstepA, voffA);
    if (wr == 1) PG8_BAR;
    PG8_WAIT_V(2); PG8_BAR;
    PG8_STAGE(PG8_SB(1, 0), cB + kstep, voffB); PG8_STAGE(PG8_SA(1, 0), cA + kstep, voffA); PG8_STAGE(PG8_SB(1, 1), cB + hstepB + kstep, voffB);
    PG8_WAIT_V(6); PG8_BAR;
    for (;;) {
        const bool has_next = S.next(ui + 1, nxt);
        const char* nA = has_next ? PG8_ABASE(nxt) : cA; const char* nB = has_next ? PG8_BBASE(nxt) : cB;
#pragma nounroll
        for (int t = 0; t < nt; t += 2) {
            const bool last = (t == nt - 2);
            const char* a1 = cA + (size_t)(t + 1) * kstep;
            const char* a2 = last ? nA : cA + (size_t)(t + 2) * kstep; const char* b2 = last ? nB : cB + (size_t)(t + 2) * kstep;
            const char* a3 = a2 + kstep; const char* b3 = b2 + kstep;
            PG8_LDB(B0, 0, 0); PG8_LDB(B1, 0, 1); PG8_SCHED; PG8_LDA(At, 0, 0); PG8_STAGE(PG8_SA(1, 1), a1 + hstepA, voffA);
            PG8_WAIT_V(8); PG8_WAIT_L(0); PG8_BAR; PG8_MMA(0, 0, At, B0); PG8_MMA(0, 1, At, B1); PG8_BAR; PG8_SCHED;
            PG8_LDA(At, 0, 1); PG8_STAGE(PG8_SB(0, 0), b2, voffB); PG8_STAGE(PG8_SB(0, 1), b2 + hstepB, voffB); PG8_STAGE(PG8_SA(0, 0), a2, voffA);
            PG8_WAIT_V(8); PG8_WAIT_L(0); PG8_BAR; PG8_MMA(1, 0, At, B0); PG8_MMA(1, 1, At, B1); PG8_BAR; PG8_SCHED;
            PG8_LDB(B0, 1, 0); PG8_LDB(B1, 1, 1); PG8_SCHED; PG8_LDA(At, 1, 0); PG8_STAGE(PG8_SA(0, 1), a2 + hstepA, voffA);
            PG8_WAIT_V(8); PG8_WAIT_L(0); PG8_BAR; PG8_MMA(0, 0, At, B0); PG8_MMA(0, 1, At, B1); PG8_BAR; PG8_SCHED;
            PG8_LDA(At, 1, 1); PG8_STAGE(PG8_SB(1, 0), b3, voffB); PG8_STAGE(PG8_SB(1, 1), b3 + hstepB, voffB); PG8_STAGE(PG8_SA(1, 0), a3, voffA);
            PG8_WAIT_V(8); PG8_WAIT_L(0); PG8_BAR; PG8_MMA(1, 0, At, B0); PG8_MMA(1, 1, At, B1); PG8_BAR; PG8_SCHED;
        }
        if (wr == 0) PG8_BAR;
        E(acc, cur, wr, wc, fr, fq);
        if (!has_next) break;
#pragma unroll
        for (int a = 0; a < 2; ++a)
#pragma unroll
            for (int b = 0; b < 2; ++b)
#pragma unroll
                for (int m = 0; m < 4; ++m)
#pragma unroll
                    for (int n = 0; n < 2; ++n) acc[a][b][m][n] = (f32x4){0.f, 0.f, 0.f, 0.f};
        cur = nxt; cA = nA; cB = nB; ++ui;
        if (wr == 1) PG8_BAR;
    }
    PG8_WAIT_V(0);
    PG8_BAR;
#undef PG8_SA
#undef PG8_SB
#undef PG8_STAGE
#undef PG8_LDA
#undef PG8_LDB
#undef PG8_MMA
#undef PG8_WAIT_V
#undef PG8_WAIT_L
#undef PG8_BAR
#undef PG8_SCHED
}
}

struct Args { const float* in[29]; float* out; unsigned char* ws; };
typedef const __attribute__((address_space(4))) Args* KArgs;
#define KA_FRESH(ka) asm volatile("" : "+s"(ka))
enum { I_X = 0, I_C, I_CTX, I_CCTX, I_N1G, I_N2G, I_WADA, I_BADA, I_WIN, I_NAQG, I_NAKG, I_RPB, I_MQN, I_WUQ, I_MKVN, I_WUKV, I_MQG, I_MKG, I_SWQG, I_SWKG, I_SINK,
       I_WNAO, I_WMLAO, I_WSWAO, I_WO, I_ROUTER, I_WGATE, I_WUP, I_WDOWN };
struct Frame {
    LAS unsigned char* lds;
    int tid, lane, wave, G, vcu, gw, ngw;
};

DI void frame_fresh(Frame& F) { int t = F.tid, w = F.wave, v = F.vcu; asm volatile("" : "+v"(t), "+s"(w), "+s"(v)); F.tid = t; F.lane = t & 63; F.wave = w; F.vcu = v; F.gw = v * 8 + w; }
DI void modv_phase(Frame& F, KArgs ka) {
    KA_FRESH(ka); const __attribute__((address_space(4))) Args& a = *ka; frame_fresh(F);
    LAS float* cact = (LAS float*)F.lds;
    LAS float* red = (LAS float*)(F.lds + 9 * 1024 * 4);
    const float* c = a.in[I_C]; const float* cc = a.in[I_CCTX];
    for (int i = F.tid; i < 9 * 1024; i += 512) { const float v = i < 8192 ? c[i] : cc[i - 8192]; cact[i] = v * sigmoidf_(v); }
    __syncthreads();
    float* modv = (float*)(a.ws + WS_MODV);
    const int cl = F.lane & 31, kp = F.lane >> 5;
    for (int unit = F.vcu; unit < NL * 192; unit += F.G) {
        const int l = unit / 192, n = (unit % 192) * 32 + cl;
        const float* w = a.in[I_WADA] + (size_t)l * 1024 * 6144 + n;
        float acc[9];
#pragma unroll
        for (int i = 0; i < 9; ++i) acc[i] = 0.f;
        const int k0 = F.wave * 128 + kp;
#pragma unroll 16
        for (int k = 0; k < 128; k += 2) { const float wv = w[(size_t)(k0 + k) * 6144];
#pragma unroll
            for (int i = 0; i < 9; ++i) acc[i] += cact[i * 1024 + k0 + k] * wv; }
#pragma unroll
        for (int i = 0; i < 9; ++i) red[((F.wave * 2 + kp) * 9 + i) * 32 + cl] = acc[i];
        __syncthreads();
        for (int t = F.tid; t < 9 * 32; t += 512) { const int i = t >> 5, nn = t & 31; float s = 0.f;
#pragma unroll
            for (int w16 = 0; w16 < 16; ++w16) s += red[(w16 * 9 + i) * 32 + nn];
            const int col = (unit % 192) * 32 + nn;
            modv[((size_t)l * 9 + i) * 6144 + col] = s + a.in[I_BADA][l * 6144 + col]; }
        __syncthreads();
    }
}
DI void copy_phase(Frame& F, KArgs ka) {
    KA_FRESH(ka); const __attribute__((address_space(4))) Args& a = *ka; frame_fresh(F);
    u32x2* xs = (u32x2*)(a.ws + WS_XS);
    const f32x4* x = (const f32x4*)a.in[I_X]; const f32x4* cx = (const f32x4*)a.in[I_CTX];
    const size_t nl = (size_t)MLAT * D / 4, nc = (size_t)MCTX * D / 4;
    for (size_t i = (size_t)blockIdx.x * 512 + F.tid; i < nl + nc; i += (size_t)F.G * 512) { const f32x4 v = i < nl ? x[i] : cx[i - nl]; u32x2 w; w.x = pk2(v.x, v.y); w.y = pk2(v.z, v.w); xs[i] = w; }
}

DI unsigned char* wsel(unsigned char* ws, int l, size_t off) {
    const size_t p = (size_t)(l & 1);
    return ws + (off >= W_DN ? WS_W + off + p * (16 * MiB) : off >= W_GU ? WS_W + off + p * (32 * MiB) : (p ? WS_W2 : WS_W) + off);
}
constexpr int T_IN = 16 * 166, T_UQ = 4 * 24, T_UKV = 2 * 32, T_NAO = 6 * 32, T_MLAO = 8 * 32, T_SWAO = 6 * 32, T_O = 16 * 32, T_E = 16 * 32 * 16;
constexpr int NIT = T_IN + T_UQ + T_UKV + T_NAO + T_MLAO + T_SWAO + T_O + 3 * T_E;
DI void cvt_item(const __attribute__((address_space(4))) Args& a, int l, int r, LAS float* scr, int lane) {
    const float* W; const float* ks = nullptr; int ldw = 1024, kb, nb, ldt = 1024, drow0, dcol0 = 0, fp8 = 1; size_t woff;
    if (r < T_IN) { kb = r / 166; nb = r % 166; W = a.in[I_WIN] + (size_t)l * 1024 * DIN; ldw = DIN;
        if (nb < 70) { fp8 = 0; woff = W_IN; drow0 = 32 * nb; } else { woff = W_GL; drow0 = 32 * nb - 2240; } }
    else if ((r -= T_IN) < T_UQ) { kb = r / 24; nb = r % 24; W = a.in[I_WUQ] + (size_t)l * 256 * 768; ldw = 768; fp8 = 0; woff = W_UP; ldt = 384; drow0 = 32 * nb; ks = a.in[I_MQN] + l * 256; }
    else if ((r -= T_UQ) < T_UKV) { kb = r / 32; nb = r % 32; W = a.in[I_WUKV] + (size_t)l * 128 * 1024; fp8 = 0; woff = W_UP; ldt = 384; drow0 = 768 + 32 * nb; dcol0 = 256; ks = a.in[I_MKVN] + l * 128; }
    else if ((r -= T_UKV) < T_NAO) { kb = r / 32; nb = r % 32; W = a.in[I_WNAO] + (size_t)l * 384 * 1024; woff = W_NAO; ldt = 512; drow0 = 32 * nb; }
    else if ((r -= T_NAO) < T_MLAO) { kb = r / 32; nb = r % 32; W = a.in[I_WMLAO] + (size_t)l * 512 * 1024; woff = W_MLAO; ldt = 512; drow0 = 32 * nb; }
    else if ((r -= T_MLAO) < T_SWAO) { kb = r / 32; nb = r % 32; W = a.in[I_WSWAO] + (size_t)l * 384 * 1024; woff = W_SWAO; ldt = 512; drow0 = 32 * nb; }
    else if ((r -= T_SWAO) < T_O) { kb = r / 32; nb = r % 32; W = a.in[I_WO] + (size_t)l * 1024 * 1024; woff = W_O; drow0 = 32 * nb; }
    else if ((r -= T_O) < 2 * T_E) {
        const int which = r / T_E, rr = r % T_E, e = rr / 512, t = rr % 512; kb = t / 32; nb = t % 32; const int f0 = 32 * nb;
        W = a.in[which ? I_WUP : I_WGATE] + ((size_t)l * 16 + e) * 1024 * 1024; woff = W_GU + (size_t)e * 2048 * 1024; drow0 = 256 * (f0 >> 7) + 128 * which + (f0 & 127); }
    else { r -= 2 * T_E; const int e = r / 512, t = r % 512; kb = t / 32; nb = t % 32;
        W = a.in[I_WDOWN] + ((size_t)l * 16 + e) * 1024 * 1024; woff = W_DN + (size_t)e * 1024 * 1024; drow0 = 32 * nb; }
    const int k0 = 64 * kb, n0 = 32 * nb; dcol0 += k0;
    unsigned char* WT; { const size_t p = (size_t)(l & 1); WT = a.ws + (woff >= W_DN ? WS_W + woff + p * (16 * MiB) : woff >= W_GU ? WS_W + woff + p * (32 * MiB) : (p ? WS_W2 : WS_W) + woff); }
    const float sc = fp8 ? 32.0f : 1.0f;
    const float* Wl = W + (size_t)(k0 + (lane >> 5)) * ldw + n0 + (lane & 31); LAS float* sl = scr + (lane >> 5) * 33 + (lane & 31);
    if (ks) { ks += k0 + (lane >> 5);
#pragma unroll 8
        for (int i = 0; i < 32; ++i) sl[2 * i * 33] = Wl[(size_t)(2 * i) * ldw] * ks[2 * i]; }
    else {
        float wv[32];
#pragma unroll
        for (int i = 0; i < 32; ++i) wv[i] = Wl[(size_t)(2 * i) * ldw];
#pragma unroll
        for (int i = 0; i < 32; ++i) sl[2 * i * 33] = wv[i] * sc; }
    asm volatile("s_waitcnt lgkmcnt(0)" ::: "memory");
    const int c = lane & 7;
    if (fp8) {
#pragma unroll
        for (int j = 0; j < 4; ++j) { const int n = (lane >> 3) + 8 * j; const LAS float* s = scr + (8 * c) * 33 + n;
            u32x2 o; o.x = pk4_fp8(s[0 * 33], s[1 * 33], s[2 * 33], s[3 * 33]); o.y = pk4_fp8(s[4 * 33], s[5 * 33], s[6 * 33], s[7 * 33]);
            *(u32x2*)(WT + (size_t)(drow0 + n) * ldt + dcol0 + 8 * c) = o; }
    } else {
#pragma unroll
        for (int j = 0; j < 4; ++j) { const int n = (lane >> 3) + 8 * j; const LAS float* s = scr + (8 * c) * 33 + n;
            u32x4 o; o.x = pk2(s[0 * 33], s[1 * 33]); o.y = pk2(s[2 * 33], s[3 * 33]); o.z = pk2(s[4 * 33], s[5 * 33]); o.w = pk2(s[6 * 33], s[7 * 33]);
            *(u32x4*)((bf16_t*)WT + (size_t)(drow0 + n) * ldt + dcol0 + 8 * c) = o; }
    }
    asm volatile("s_waitcnt lgkmcnt(0)" ::: "memory");
}
DI void convert_weights(Frame& F, KArgs ka, int l, int begin) {
    KA_FRESH(ka); const __attribute__((address_space(4))) Args& a = *ka; frame_fresh(F);
    LAS float* scr = (LAS float*)(F.lds + F.wave * 16384);
#pragma nounroll
    for (int it = begin + F.gw; it < NIT; it += F.ngw) cvt_item(a, l, it, scr, F.lane);
    unsigned char* wb = a.ws + ((l & 1) ? WS_W2 : WS_W);
    constexpr int Z0 = 64 * 128, Z1 = 768 * 16, Z2 = 1024 * 32, Z3 = 2 * 1024 * 8;
    unsigned zz = 0u; asm volatile("" : "+v"(zz));
    const u32x4 z = {zz, zz, zz, zz};
    for (int i = blockIdx.x * 512 + F.tid; i < Z0 + Z1 + Z2 + Z3; i += F.G * 512) {
        if (i >= Z0 + Z1 + Z2) { const int j = i - Z0 - Z1 - Z2, which = j >> 13, jj = j & 8191; *(u32x4*)(wb + (which ? W_SWAO : W_NAO) + (size_t)(jj >> 3) * 512 + 384 + (jj & 7) * 16) = z; continue; }
        if (i < Z0) *(u32x4*)((bf16_t*)(wb + W_IN) + (size_t)(2240 + i / 128) * 1024 + (i % 128) * 8) = z;
        else if (i < Z0 + Z1) { const int j = i - Z0; *(u32x4*)((bf16_t*)(wb + W_UP) + (size_t)(j / 16) * 384 + 256 + (j % 16) * 8) = z; }
        else { const int j = i - Z0 - Z1; *(u32x4*)((bf16_t*)(wb + W_UP) + (size_t)(768 + j / 32) * 384 + (j % 32) * 8) = z; }
    }
}
DI void convert_tail(Frame& F, KArgs ka, int l, int first, int q) {
    KA_FRESH(ka); const __attribute__((address_space(4))) Args& a = *ka; frame_fresh(F);
    LAS float* scr = (LAS float*)(F.lds + F.wave * 16384);
#pragma nounroll
    for (int j = 0; j < q; ++j) { const int it = first + 8 * j + F.wave; if (it < NIT) cvt_item(a, l, it, scr, F.lane); }
}


DI void row_phase(Frame& F, KArgs ka, int l, int dry = 0) {
    KA_FRESH(ka); const __attribute__((address_space(4))) Args& a = *ka; frame_fresh(F);
    bf16_t* xs = (bf16_t*)(a.ws + WS_XS);
    const float* modv = (const float*)(a.ws + WS_MODV);
    const int* smap = (const int*)(a.ws + WS_SMAP);
    const bf16_t* Y = (const bf16_t*)(a.ws + WS_Y);
    bf16_t* H = (bf16_t*)(a.ws + WS_R4);
    unsigned char* H8 = a.ws + WS_R4 + 68 * MiB;
    bf16_t* xso = xs; float* outo = a.out;
    if (dry) { unsigned char* tr = a.ws + WS_END + (size_t)F.gw * 16384; xso = (bf16_t*)tr; outo = (float*)tr; H = (bf16_t*)(tr + 8192); H8 = tr + 12288; }
    const int nrows = (l == NL) ? MLAT : MT;
    const bool comb = (l > 0);
    constexpr int RR = 4;
    for (int mb = RR * F.gw; mb < nrows; mb += RR * F.ngw) {
        f32x4 v[RR][4]; int myslot[RR];
#pragma unroll
        for (int rr = 0; rr < RR; ++rr) { const int m = mb + rr;
            if (l == 0) {
                if (F.lane < 16 && !dry) *(u32x4*)(a.ws + WS_OCAT + (size_t)m * OCW + ((F.lane >> 3) ? 1408 : 384) + 16 * (F.lane & 7)) = (u32x4){0u, 0u, 0u, 0u};
                const f32x4* xr = (const f32x4*)(m < MLAT ? a.in[I_X] + (size_t)m * D : a.in[I_CTX] + (size_t)(m - MLAT) * D) + F.lane;
                u32x2* xo = (u32x2*)(xs + (size_t)m * D) + F.lane;
#pragma unroll
                for (int j = 0; j < 4; ++j) { const f32x4 t = xr[64 * j]; u32x2 w; w.x = pk2(t.x, t.y); w.y = pk2(t.z, t.w); if (!dry) xo[64 * j] = w; v[rr][j] = (f32x4){bflo(w.x), bfhi(w.x), bflo(w.y), bfhi(w.y)}; }
            } else {
                const u32x2* xr = (const u32x2*)(xs + (size_t)m * D) + F.lane;
#pragma unroll
                for (int j = 0; j < 4; ++j) { const u32x2 w = xr[64 * j]; v[rr][j] = (f32x4){bflo(w.x), bfhi(w.x), bflo(w.y), bfhi(w.y)}; }
            }
            myslot[rr] = (comb && F.lane < 16) ? smap[(size_t)F.lane * MT + mb + rr] : -1; }
        const int mi = mod_index(mb);
        if (comb) {
            f32x4 acc[RR][4];
            unsigned long long mk[RR];
#pragma unroll
            for (int rr = 0; rr < RR; ++rr) { mk[rr] = __ballot(myslot[rr] >= 0);
#pragma unroll
                for (int j = 0; j < 4; ++j) acc[rr][j] = (f32x4){0.f, 0.f, 0.f, 0.f}; }
            while ((mk[0] | mk[1]) | (mk[2] | mk[3])) {
                u32x2 w[RR][4];
#pragma unroll
                for (int rr = 0; rr < RR; ++rr) {
                    int s = -1;
                    if (mk[rr]) { const int e0 = __builtin_ctzll(mk[rr]); s = __shfl(myslot[rr], e0); mk[rr] &= mk[rr] - 1; }
#pragma unroll
                    for (int j = 0; j < 4; ++j) w[rr][j] = (u32x2){0u, 0u};
                    if (s >= 0) { const u32x2* yr = (const u32x2*)(Y + (size_t)s * D) + F.lane;
#pragma unroll
                        for (int j = 0; j < 4; ++j) w[rr][j] = yr[64 * j]; }
                }
#pragma unroll
                for (int rr = 0; rr < RR; ++rr)
#pragma unroll
                    for (int j = 0; j < 4; ++j) acc[rr][j] += (f32x4){bflo(w[rr][j].x), bfhi(w[rr][j].x), bflo(w[rr][j].y), bfhi(w[rr][j].y)};
            }
            const f32x4* g5 = (const f32x4*)(modv + ((size_t)(l - 1) * 9 + mi) * 6144 + 5 * 1024) + F.lane;
            f32x4 g5v[4];
#pragma unroll
            for (int j = 0; j < 4; ++j) g5v[j] = g5[64 * j];
#pragma unroll
            for (int rr = 0; rr < RR; ++rr) { const int m = mb + rr;
                const size_t ro = dry ? (size_t)rr * 1024 : (size_t)m * D;
#pragma unroll
                for (int j = 0; j < 4; ++j) { v[rr][j] += g5v[j] * acc[rr][j];
                    if (l == NL) ((f32x4*)(outo + ro) + F.lane)[64 * j] = v[rr][j];
                    else { u32x2 w; w.x = pk2(v[rr][j].x, v[rr][j].y); w.y = pk2(v[rr][j].z, v[rr][j].w); ((u32x2*)(xso + ro) + F.lane)[64 * j] = w;
                           v[rr][j] = (f32x4){bflo(w.x), bfhi(w.x), bflo(w.y), bfhi(w.y)}; } } }
        }
        if (l < NL) {
            const f32x4* g = (const f32x4*)(a.in[I_N1G] + l * D) + F.lane;
            const f32x4* sh = (const f32x4*)(modv + ((size_t)l * 9 + mi) * 6144) + F.lane;
            const f32x4* sc = (const f32x4*)(modv + ((size_t)l * 9 + mi) * 6144 + 1024) + F.lane;
            f32x4 gg[4], shv[4];
#pragma unroll
            for (int j = 0; j < 4; ++j) { gg[j] = g[64 * j] * (sc[64 * j] + 1.0f); shv[j] = sh[64 * j]; }
#pragma unroll
            for (int rr = 0; rr < RR; ++rr) { const int m = mb + rr;
                float ss = 0.f;
#pragma unroll
                for (int j = 0; j < 4; ++j) ss += (v[rr][j].x * v[rr][j].x + v[rr][j].y * v[rr][j].y) + (v[rr][j].z * v[rr][j].z + v[rr][j].w * v[rr][j].w);
                const float rstd = __builtin_amdgcn_rsqf(wave_sum(ss) * (1.f / D) + EPS);
                u32x2* o = (u32x2*)(H + (dry ? (size_t)rr * 1024 : (size_t)m * D)) + F.lane;
                unsigned* o8 = (unsigned*)(H8 + (dry ? (size_t)rr * 1024 : (size_t)m * D)) + F.lane;
#pragma unroll
                for (int j = 0; j < 4; ++j) { const f32x4 hh = v[rr][j] * rstd * gg[j] + shv[j]; u32x2 w; w.x = pk2(hh.x, hh.y); w.y = pk2(hh.z, hh.w); o[64 * j] = w;
                    o8[64 * j] = pk4_fp8(hh.x, hh.y, hh.z, hh.w); } }
        }
    }
}

DI void rope_cs(int d, int prow, int pcol, float& cs, float& sn) {
    const int i = d & 15; const float pos = (float)((d & 32) ? pcol : prow);
    const float inv = __builtin_amdgcn_exp2f(-(float)i * (13.287712379549449f / 16.0f));
    const float rev = pos * inv * 0.15915494309189535f;
    const float fr = rev - floorf(rev);
    cs = __builtin_amdgcn_cosf(fr); sn = __builtin_amdgcn_sinf(fr);
}
DI void prep_phase(Frame& F, KArgs ka, int l) {
    KA_FRESH(ka); const __attribute__((address_space(4))) Args& a = *ka; frame_fresh(F);
    const bf16_t* HW = (const bf16_t*)(a.ws + WS_HW);
    bf16_t* P1 = (bf16_t*)(a.ws + WS_P1);
    const float sc64 = 0.125f * LOG2E;
    const int d0 = 8 * (F.lane & 7);
    float gn[3][8]; int srcc[3]; bool ropei[3], acti[3];
    const float* gp0 = a.in[I_NAQG]; const float* gp1 = a.in[I_NAKG]; const float* gp2 = a.in[I_SWQG]; const float* gp3 = a.in[I_SWKG];
#pragma unroll
    for (int i = 0; i < 3; ++i) { const int c = F.lane + 64 * i, col = 8 * c; acti[i] = c < 160;
        const int ty = col < 384 ? 0 : col < 768 ? 1 : col < 1152 ? 2 : 3;
        srcc[i] = col < 768 ? col : col + (C_SWQ - 768);
        ropei[i] = ty >= 2;
        const float sc = (ty == 0 || ty == 2) ? sc64 : 1.0f;
#pragma unroll
        for (int j = 0; j < 8; ++j) { const float g0 = gp0[l * 64 + d0 + j], g1 = gp1[l * 64 + d0 + j], g2 = gp2[l * 64 + d0 + j], g3 = gp3[l * 64 + d0 + j];
            gn[i][j] = acti[i] ? (ty == 0 ? g0 : ty == 1 ? g1 : ty == 2 ? g2 : g3) * sc : 0.f; } }
    float invf[8];
#pragma unroll
    for (int j = 0; j < 8; ++j) invf[j] = __builtin_amdgcn_exp2f(-(float)((d0 & 8) + j) * (13.287712379549449f / 16.0f)) * 0.15915494309189535f;
    const bool second = (d0 & 16) != 0, usecol = (d0 & 32) != 0;
    for (int mb = 2 * F.gw; mb < MT; mb += 2 * F.ngw) {
        u32x4 w[2][3];
#pragma unroll
        for (int rr = 0; rr < 2; ++rr)
#pragma unroll
            for (int i = 0; i < 3; ++i) if (acti[i]) w[rr][i] = *(const u32x4*)(HW + (size_t)(mb + rr) * DINP + srcc[i]); else w[rr][i] = (u32x4){0u, 0u, 0u, 0u};
#pragma unroll
        for (int rr = 0; rr < 2; ++rr) {
            const int m = mb + rr; const bool lat = m < MLAT; const int s = m & 4095; const float prw = (float)(s >> 6), pcl = (float)(s & 63); float pos = usecol ? pcl : prw; asm volatile("" : "+v"(pos));
            float cs[8], sn[8];
#pragma unroll
            for (int j = 0; j < 8; ++j) { cs[j] = 1.f; sn[j] = 0.f; }
            if (lat) {
#pragma unroll
                for (int j = 0; j < 8; ++j) { const float rev = pos * invf[j], fr = rev - floorf(rev); cs[j] = __builtin_amdgcn_cosf(fr); sn[j] = __builtin_amdgcn_sinf(fr); } }
#pragma unroll
            for (int i = 0; i < 3; ++i) {
                float x[8] = {bflo(w[rr][i].x), bfhi(w[rr][i].x), bflo(w[rr][i].y), bfhi(w[rr][i].y), bflo(w[rr][i].z), bfhi(w[rr][i].z), bflo(w[rr][i].w), bfhi(w[rr][i].w)};
                float ss = 0.f;
#pragma unroll
                for (int j = 0; j < 8; ++j) ss += x[j] * x[j];
                ss += __shfl_xor(ss, 1); ss += __shfl_xor(ss, 2); ss += __shfl_xor(ss, 4);
                const float rs = __builtin_amdgcn_rsqf(ss * (1.f / 64.f) + EPS);
#pragma unroll
                for (int j = 0; j < 8; ++j) x[j] *= rs * gn[i][j];
                const bool rp = ropei[i] && lat;
#pragma unroll
                for (int j = 0; j < 8; ++j) { const float y = __int_as_float(__builtin_amdgcn_ds_bpermute((F.lane ^ 2) << 2, __float_as_int(x[j]))); const float rot = second ? x[j] * cs[j] + y * sn[j] : x[j] * cs[j] - y * sn[j]; x[j] = rp ? rot : x[j]; }
                if (acti[i]) { u32x4 o; o.x = pk2(x[0], x[1]); o.y = pk2(x[2], x[3]); o.z = pk2(x[4], x[5]); o.w = pk2(x[6], x[7]);
                    *(u32x4*)(P1 + (size_t)m * P1W + 8 * (F.lane + 64 * i)) = o; }
            }
        }
    }
}
DI void prep2_phase(Frame& F, KArgs ka, int l, int dry = 0) {
    KA_FRESH(ka); const __attribute__((address_space(4))) Args& a = *ka; frame_fresh(F);
    const bf16_t* HW = (const bf16_t*)(a.ws + WS_HW);
    bf16_t* U = (bf16_t*)(a.ws + WS_R4);
    bf16_t* P2 = (bf16_t*)(a.ws + WS_P2);
    const float scq = 0.07216878364870322f * LOG2E;
    const int ln = F.lane, q = ln & 15, h = ln >> 4;
    float qgn[8], qgr[4], kgn[8], kgr[4], invf[4];
    { const float* qg = a.in[I_MQG] + l * 192; const float* kg = a.in[I_MKG] + l * 192;
#pragma unroll
      for (int j = 0; j < 8; ++j) { qgn[j] = qg[8 * q + j] * scq; kgn[j] = kg[8 * q + j]; }
#pragma unroll
      for (int j = 0; j < 4; ++j) { qgr[j] = qg[128 + 4 * q + j] * scq; kgr[j] = kg[128 + 4 * q + j];
          invf[j] = __builtin_amdgcn_exp2f(-(float)(4 * (q & 3) + j) * (13.287712379549449f / 16.0f)) * 0.15915494309189535f; } }
    const bool second = (q & 4) != 0, usecol = (q & 8) != 0;
    const int pl = (ln ^ 4) << 2;
    for (int mb = 2 * F.gw; mb < MT; mb += 2 * F.ngw) {
        u32x2 wcq[2], wqr[2], wkr[2]; unsigned wckv[2]; u32x4 wqn[2], wkn[2], wv[2];
#pragma unroll
        for (int rr = 0; rr < 2; ++rr) { const bf16_t* hr = HW + (size_t)(mb + rr) * DINP; const bf16_t* ur = U + (size_t)(mb + rr) * UW;
            wcq[rr] = *(const u32x2*)(hr + C_CQ + 4 * ln); wckv[rr] = *(const unsigned*)(hr + C_CKV + 2 * ln); wkr[rr] = *(const u32x2*)(hr + C_KR + 4 * q);
            wqn[rr] = *(const u32x4*)(ur + h * 192 + 8 * q); wqr[rr] = *(const u32x2*)(ur + h * 192 + 128 + 4 * q);
            wkn[rr] = *(const u32x4*)(ur + 768 + h * 256 + 8 * q); wv[rr] = *(const u32x4*)(ur + 768 + h * 256 + 128 + 8 * q); }
#pragma unroll
        for (int rr = 0; rr < 2; ++rr) {
            const int m = mb + rr; const bool lat = m < MLAT; const int s = m & 4095;
            bf16_t* ur = U + (size_t)m * UW; bf16_t* pr = P2 + (size_t)m * P2W;
            if (dry) { ur = (bf16_t*)(a.ws + WS_END + (size_t)F.gw * 8192); pr = ur + 2048; }
            float rq, rkv;
            { const float a0 = bflo(wcq[rr].x), a1 = bfhi(wcq[rr].x), a2 = bflo(wcq[rr].y), a3 = bfhi(wcq[rr].y);
              rq = __builtin_amdgcn_rsqf(wave_sum(a0 * a0 + a1 * a1 + a2 * a2 + a3 * a3) * (1.f / 256.f) + EPS); }
            { const float a0 = bflo(wckv[rr]), a1 = bfhi(wckv[rr]);
              rkv = __builtin_amdgcn_rsqf(wave_sum(a0 * a0 + a1 * a1) * (1.f / 128.f) + EPS); }
            float cs[4], sn[4];
            { const float prw = (float)(s >> 6), pcl = (float)(s & 63); float pos = usecol ? pcl : prw; asm volatile("" : "+v"(pos));
#pragma unroll
              for (int j = 0; j < 4; ++j) { const float rev = pos * invf[j], fr = rev - floorf(rev); cs[j] = lat ? __builtin_amdgcn_cosf(fr) : 1.f; sn[j] = lat ? __builtin_amdgcn_sinf(fr) : 0.f; } }
#pragma unroll
            for (int isk = 0; isk < 2; ++isk) {
                const u32x4 wn = isk ? wkn[rr] : wqn[rr]; const u32x2 wr2 = isk ? wkr[rr] : wqr[rr];
                const float sn_ = isk ? rkv : rq, sr_ = isk ? 1.0f : rq;
                float x[8] = {bflo(wn.x) * sn_, bfhi(wn.x) * sn_, bflo(wn.y) * sn_, bfhi(wn.y) * sn_, bflo(wn.z) * sn_, bfhi(wn.z) * sn_, bflo(wn.w) * sn_, bfhi(wn.w) * sn_};
                float y[4] = {bflo(wr2.x) * sr_, bfhi(wr2.x) * sr_, bflo(wr2.y) * sr_, bfhi(wr2.y) * sr_};
                float ss = 0.f;
#pragma unroll
                for (int j = 0; j < 8; ++j) ss += x[j] * x[j];
#pragma unroll
                for (int j = 0; j < 4; ++j) ss += y[j] * y[j];
                ss += __shfl_xor(ss, 1); ss += __shfl_xor(ss, 2); ss += __shfl_xor(ss, 4); ss += __shfl_xor(ss, 8);
                const float rs = __builtin_amdgcn_rsqf(ss * (1.f / 192.f) + EPS);
#pragma unroll
                for (int j = 0; j < 8; ++j) x[j] *= rs * (isk ? kgn[j] : qgn[j]);
#pragma unroll
                for (int j = 0; j < 4; ++j) { y[j] *= rs * (isk ? kgr[j] : qgr[j]);
                    const float p = __int_as_float(__builtin_amdgcn_ds_bpermute(pl, __float_as_int(y[j])));
                    y[j] = second ? y[j] * cs[j] + p * sn[j] : y[j] * cs[j] - p * sn[j]; }
                u32x4 o; o.x = pk2(x[0], x[1]); o.y = pk2(x[2], x[3]); o.z = pk2(x[4], x[5]); o.w = pk2(x[6], x[7]);
                u32x2 o2; o2.x = pk2(y[0], y[1]); o2.y = pk2(y[2], y[3]);
                *(u32x4*)(pr + 768 * isk + h * 192 + 8 * q) = o; *(u32x2*)(pr + 768 * isk + h * 192 + 128 + 4 * q) = o2;
            }
            { const u32x4 vw = wv[rr]; u32x4 o; o.x = pk2(bflo(vw.x) * rkv, bfhi(vw.x) * rkv); o.y = pk2(bflo(vw.y) * rkv, bfhi(vw.y) * rkv); o.z = pk2(bflo(vw.z) * rkv, bfhi(vw.z) * rkv); o.w = pk2(bflo(vw.w) * rkv, bfhi(vw.w) * rkv);
              *(u32x4*)(ur + 768 + h * 256 + 128 + 8 * q) = o; }
        }
    }
}

struct AU {
    const bf16_t *q, *k, *v; unsigned char* o;
    int ldq, ldk, ldv, ldo;
    int qrow0;
    int lat_row0, n_lat, ctx_row0, n_ctx;
    int mode;
    int qpos0, kpos0;
    float m0, l0;
    const float* rpb;
};
template <int DQ, int DV, int LDK, int LDV>
DI void attn_unit(LAS unsigned char* lds, const AU& u, int tid, int wave, int lane) {
    constexpr int KP = DQ * 2 + 16, VP = DV * 2 + 64, KBY = 64 * KP, VBY = 64 * VP, STG = KBY + VBY;
    constexpr int NKS = DQ / 16, NDT = DV / 32, KCH = DQ / 8, VCH = DV / 8;
    constexpr int KC = KP / 16, VC = VP / 16;
    constexpr int KI = (KC + 7) / 8, VI = (VC + 7) / 8;
    constexpr int BIAS_OFF = 98304;
    constexpr float MTHR = 11.5f;
    static_assert(2 * STG <= BIAS_OFF && KBY % 1024 == 0 && VBY % 1024 == 0, "attention LDS");
    const int r = lane & 31, h = lane >> 5;
    const int nt = u.n_lat + u.n_ctx;
    LAS float* btab = (LAS float*)(lds + BIAS_OFF);
    if (u.mode == 2) { for (int i = tid; i < 15 * 31; i += 512) btab[i] = u.rpb[i] * LOG2E; }
    bf16x8 qf[NKS];
    { const bf16_t* qp = u.q + (size_t)(u.qrow0 + wave * 32 + r) * u.ldq + 8 * h;
#pragma unroll
      for (int ks = 0; ks < NKS; ++ks) qf[ks] = *(const bf16x8*)(qp + 16 * ks); }
    f32x16 o[NDT];
#pragma unroll
    for (int dt = 0; dt < NDT; ++dt)
#pragma unroll
        for (int i = 0; i < 16; ++i) o[dt][i] = 0.f;
    float mrun = u.m0, lrun = (h == 0) ? u.l0 : 0.f;
    unsigned koff[KI], voff[VI];
#pragma unroll
    for (int i = 0; i < KI; ++i) { const int c = 64 * (wave + 8 * i) + lane, row = c / KC, cc = c % KC; koff[i] = (unsigned)(row * LDK * 2 + (cc < KCH ? cc : KCH - 1) * 16); }
#pragma unroll
    for (int i = 0; i < VI; ++i) { const int c = 64 * (wave + 8 * i) + lane, row = c / VC, cc = c % VC; voff[i] = (unsigned)(row * LDV * 2 + (cc < VCH ? cc : VCH - 1) * 16); }
#define AT_ROWBASE(t) ((t) < u.n_lat ? u.lat_row0 + 64 * (t) : u.ctx_row0 + 64 * ((t) - u.n_lat))
#define AT_ISSUE(t, buf) do { const int rb_ = AT_ROWBASE(t); const char* kb_ = (const char*)(u.k + (size_t)rb_ * LDK); const char* vb_ = (const char*)(u.v + (size_t)rb_ * LDV); \
        _Pragma("unroll") for (int i_ = 0; i_ < KI; ++i_) { const int j_ = wave + 8 * i_; if (j_ < KC) __builtin_amdgcn_global_load_lds((const unsigned*)(kb_ + koff[i_]), (LAS unsigned*)(lds + (buf) * STG + j_ * 1024), 16, 0, 0); } \
        _Pragma("unroll") for (int i_ = 0; i_ < VI; ++i_) { const int j_ = wave + 8 * i_; if (j_ < VC) __builtin_amdgcn_global_load_lds((const unsigned*)(vb_ + voff[i_]), (LAS unsigned*)(lds + (buf) * STG + KBY + j_ * 1024), 16, 0, 0); } } while (0)
    AT_ISSUE(0, 0);
    asm volatile("s_waitcnt vmcnt(0)" ::: "memory");
    __syncthreads();
    const int tq = (lane & 15) >> 2, tp = lane & 3, tblk = (lane >> 4) & 1;
    const int vlane_off = (4 * h + tq) * VP + 32 * tblk + 8 * tp;
    for (int t = 0; t < nt; ++t) {
        const int buf = t & 1;
        if (t + 1 < nt) AT_ISSUE(t + 1, buf ^ 1);
        bool skip = false; int a0 = 0, a1 = 0;
        bool inband = false;
        if (u.mode == 1 && t < u.n_lat) { const int k0 = u.kpos0 + 64 * t, q0 = u.qpos0 + 32 * wave; skip = (k0 > q0 + 31 + 128) || (k0 + 63 < q0 - 128); a0 = k0; a1 = q0; inband = (k0 >= q0 + 31 - 128) && (k0 + 63 <= q0 + 128); }
        if (u.mode == 2 && t < u.n_lat) { const int kr = u.kpos0 + t, qr = u.qpos0 + (wave >> 1); int rs = qr - 4; rs = rs < 0 ? 0 : (rs > 56 ? 56 : rs); skip = (kr < rs) || (kr >= rs + 8); a0 = kr - qr + 7; }
        if (!skip) {
            const LAS unsigned char* Kt = lds + buf * STG; const LAS unsigned char* Vt = Kt + KBY;
            f32x16 s0, s1;
#pragma unroll
            for (int i = 0; i < 16; ++i) { s0[i] = 0.f; s1[i] = 0.f; }
#pragma unroll
            for (int ks = 0; ks < NKS; ++ks) {
                const bf16x8 k0 = *(const LAS bf16x8*)(Kt + r * KP + (16 * ks + 8 * h) * 2);
                const bf16x8 k1 = *(const LAS bf16x8*)(Kt + (32 + r) * KP + (16 * ks + 8 * h) * 2);
                s0 = __builtin_amdgcn_mfma_f32_32x32x16_bf16(k0, qf[ks], s0, 0, 0, 0);
                s1 = __builtin_amdgcn_mfma_f32_32x32x16_bf16(k1, qf[ks], s1, 0, 0, 0);
            }
            if (u.mode == 1 && t < u.n_lat && !inband) {
                const int qpos = a1 + r;
#pragma unroll
                for (int i = 0; i < 16; ++i) { const int kk = a0 + (i & 3) + 8 * (i >> 2) + 4 * h; int d0 = qpos - kk; d0 = d0 < 0 ? -d0 : d0; int d1 = qpos - (kk + 32); d1 = d1 < 0 ? -d1 : d1;
                    s0[i] = d0 <= 128 ? s0[i] : -INFINITY; s1[i] = d1 <= 128 ? s1[i] : -INFINITY; }
            }
            if (u.mode == 2 && t < u.n_lat) {
                const int qc = 32 * (wave & 1) + r; int cs = qc - 8; cs = cs < 0 ? 0 : (cs > 48 ? 48 : cs);
                const LAS float* bp = btab + (a0 * 31 + 15 - qc + 4 * h);
                float bb[16];
#pragma unroll
                for (int half = 0; half < 2; ++half) {
#pragma unroll
                    for (int i = 0; i < 16; ++i) bb[i] = bp[32 * half + (i & 3) + 8 * (i >> 2)];
                    asm volatile("" : "+v"(bb[0]), "+v"(bb[1]), "+v"(bb[2]), "+v"(bb[3]), "+v"(bb[4]), "+v"(bb[5]), "+v"(bb[6]), "+v"(bb[7]), "+v"(bb[8]), "+v"(bb[9]), "+v"(bb[10]), "+v"(bb[11]), "+v"(bb[12]), "+v"(bb[13]), "+v"(bb[14]), "+v"(bb[15]));
#pragma unroll
                    for (int i = 0; i < 16; ++i) { const int kc = 32 * half + (i & 3) + 8 * (i >> 2) + 4 * h; const bool ok = (kc >= cs) && (kc < cs + 16);
                        if (half == 0) s0[i] = ok ? s0[i] + bb[i] : -INFINITY; else s1[i] = ok ? s1[i] + bb[i] : -INFINITY; }
                }
            }
            float mx = fmaxf(s0[0], s1[0]);
#pragma unroll
            for (int i = 1; i < 16; ++i) mx = fmaxf(mx, fmaxf(s0[i], s1[i]));
            mx = fmaxf(mx, __shfl_xor(mx, 32));
            if (__builtin_amdgcn_ballot_w64(mx > mrun + MTHR) != 0ull) {
                const float mnew = fmaxf(mrun, mx), alpha = __builtin_amdgcn_exp2f(mrun - mnew);
                lrun *= alpha; mrun = mnew;
#pragma unroll
                for (int dt = 0; dt < NDT; ++dt)
#pragma unroll
                    for (int i = 0; i < 16; ++i) o[dt][i] *= alpha;
            }
            float ls = 0.f;
#pragma unroll
            for (int i = 0; i < 16; ++i) { s0[i] = __builtin_amdgcn_exp2f(s0[i] - mrun); s1[i] = __builtin_amdgcn_exp2f(s1[i] - mrun); ls += s0[i] + s1[i]; }
            lrun += ls;
            bf16x8 pf[4];
            { u32x4 w;
              w.x = pk2(s0[0], s0[1]); w.y = pk2(s0[2], s0[3]); w.z = pk2(s0[4], s0[5]); w.w = pk2(s0[6], s0[7]); pf[0] = __builtin_bit_cast(bf16x8, w);
              w.x = pk2(s0[8], s0[9]); w.y = pk2(s0[10], s0[11]); w.z = pk2(s0[12], s0[13]); w.w = pk2(s0[14], s0[15]); pf[1] = __builtin_bit_cast(bf16x8, w);
              w.x = pk2(s1[0], s1[1]); w.y = pk2(s1[2], s1[3]); w.z = pk2(s1[4], s1[5]); w.w = pk2(s1[6], s1[7]); pf[2] = __builtin_bit_cast(bf16x8, w);
              w.x = pk2(s1[8], s1[9]); w.y = pk2(s1[10], s1[11]); w.z = pk2(s1[12], s1[13]); w.w = pk2(s1[14], s1[15]); pf[3] = __builtin_bit_cast(bf16x8, w); }
#pragma unroll
            for (int kk = 0; kk < 4; ++kk) {
#pragma unroll
                for (int dt = 0; dt < NDT; ++dt) {
                    const LAS unsigned char* vp = Vt + (16 * kk) * VP + vlane_off + 64 * dt;
                    const s16x4 lo = __builtin_amdgcn_ds_read_tr16_b64_v4i16((LAS s16x4*)vp);
                    const s16x4 hi = __builtin_amdgcn_ds_read_tr16_b64_v4i16((LAS s16x4*)(vp + 8 * VP));
                    const bf16x8 vf = __builtin_shufflevector(lo, hi, 0, 1, 2, 3, 4, 5, 6, 7);
                    o[dt] = __builtin_amdgcn_mfma_f32_32x32x16_bf16(vf, pf[kk], o[dt], 0, 0, 0);
                }
            }
        }
        asm volatile("s_waitcnt vmcnt(0)" ::: "memory");
        __syncthreads();
    }
    const float ltot = lrun + __shfl_xor(lrun, 32), inv = 1.0f / ltot;
    unsigned char* op = u.o + (size_t)(u.qrow0 + wave * 32 + r) * u.ldo + 4 * h;
    const float inv4 = inv * 4.0f;
#pragma unroll
    for (int dt = 0; dt < NDT; ++dt)
#pragma unroll
        for (int g = 0; g < 4; ++g) *(unsigned*)(op + 32 * dt + 8 * g) = pk4_fp8(o[dt][4 * g] * inv4, o[dt][4 * g + 1] * inv4, o[dt][4 * g + 2] * inv4, o[dt][4 * g + 3] * inv4);
#undef AT_ROWBASE
#undef AT_ISSUE
}

DI void attn_phase(Frame& F, KArgs ka, int l) {
    KA_FRESH(ka); const __attribute__((address_space(4))) Args& a = *ka; frame_fresh(F);
    const bf16_t* HW = (const bf16_t*)(a.ws + WS_HW);
    const bf16_t* P1 = (const bf16_t*)(a.ws + WS_P1);
    const bf16_t* P2 = (const bf16_t*)(a.ws + WS_P2);
    const bf16_t* U = (const bf16_t*)(a.ws + WS_R4);
    unsigned char* OC = a.ws + WS_OCAT;
    const bool last = (l == NL - 1);
    constexpr int nA = 512, nB = 768, nC = 768;
    const int ntot = nA + nB + nC + (last ? 0 : 128);
#ifndef ATT_PROBE
#define ATT_PROBE 0
#endif
    for (int rep2_ = 0; rep2_ < 1 + (ATT_PROBE != 0); ++rep2_)
    for (int id = F.vcu; id < ntot; id += F.G) {
        if (rep2_ == 1 && !((ATT_PROBE == 1) ? (id < nA) : (id >= nA && id < nA + nB))) continue;
        AU u; bool big = false;
        u.mode = 0; u.qpos0 = 0; u.kpos0 = 0; u.m0 = -1e30f; u.l0 = 0.f; u.rpb = nullptr; u.n_ctx = 4;
        if (id < nA) {
            const int b = id >> 6, h = (id >> 4) & 3, qb = id & 15; big = true;
            u.q = P2 + h * 192; u.ldq = P2W; u.k = P2 + 768 + h * 192; u.ldk = P2W; u.v = U + 768 + h * 256 + 128; u.ldv = UW; u.o = OC + 512 + h * 128; u.ldo = OCW;
            u.qrow0 = b * SEQ + qb * 256; u.lat_row0 = b * SEQ; u.n_lat = 64; u.ctx_row0 = MLAT + b * CTX;
        } else if (id < nA + nB) {
            const int j = id - nA, b = j / 96, h = (j >> 4) % 6, qb = j & 15;
            u.q = P1 + h * 64; u.ldq = P1W; u.k = P1 + 384 + h * 64; u.ldk = P1W; u.v = HW + C_NAV + h * 64; u.ldv = DINP; u.o = OC + h * 64; u.ldo = OCW;
            int rlo = 4 * qb - 4; rlo = rlo < 0 ? 0 : (rlo > 56 ? 56 : rlo); int rhi = 4 * qb + 3 - 4; rhi = (rhi < 0 ? 0 : (rhi > 56 ? 56 : rhi)) + 7;
            u.qrow0 = b * SEQ + qb * 256; u.lat_row0 = b * SEQ + rlo * 64; u.n_lat = rhi - rlo + 1; u.ctx_row0 = MLAT + b * CTX;
            u.mode = 2; u.qpos0 = 4 * qb; u.kpos0 = rlo; u.rpb = a.in[I_RPB] + (size_t)(l * 6 + h) * 465;
        } else if (id < nA + nB + nC) {
            const int j = id - nA - nB, b = j / 96, hq = (j >> 4) % 6, qb = j & 15, kvh = hq / 3;
            u.q = P1 + 768 + hq * 64; u.ldq = P1W; u.k = P1 + 1152 + kvh * 64; u.ldk = P1W; u.v = HW + C_SWV + kvh * 64; u.ldv = DINP; u.o = OC + 1024 + hq * 64; u.ldo = OCW;
            int klo = qb * 256 - 128; klo = klo < 0 ? 0 : klo; int khi = qb * 256 + 384; khi = khi > SEQ ? SEQ : khi;
            u.qrow0 = b * SEQ + qb * 256; u.lat_row0 = b * SEQ + klo; u.n_lat = (khi - klo) >> 6; u.ctx_row0 = MLAT + b * CTX;
            u.mode = 1; u.qpos0 = qb * 256; u.kpos0 = klo; u.m0 = a.in[I_SINK][l * 6 + hq] * LOG2E; u.l0 = 1.f;
        } else {
            const int j = id - nA - nB - nC;
            u.n_lat = 0; u.lat_row0 = 0;
            if (j < 32) { const int b = j >> 2, h = j & 3; big = true;
                u.q = P2 + h * 192; u.ldq = P2W; u.k = P2 + 768 + h * 192; u.ldk = P2W; u.v = U + 768 + h * 256 + 128; u.ldv = UW; u.o = OC + 512 + h * 128; u.ldo = OCW;
                u.qrow0 = MLAT + b * CTX; u.ctx_row0 = MLAT + b * CTX;
            } else if (j < 80) { const int jj = j - 32, b = jj / 6, h = jj % 6;
                u.q = P1 + h * 64; u.ldq = P1W; u.k = P1 + 384 + h * 64; u.ldk = P1W; u.v = HW + C_NAV + h * 64; u.ldv = DINP; u.o = OC + h * 64; u.ldo = OCW;
                u.qrow0 = MLAT + b * CTX; u.ctx_row0 = MLAT + b * CTX;
            } else { const int jj = j - 80, b = jj / 6, hq = jj % 6, kvh = hq / 3;
                u.q = P1 + 768 + hq * 64; u.ldq = P1W; u.k = P1 + 1152 + kvh * 64; u.ldk = P1W; u.v = HW + C_SWV + kvh * 64; u.ldv = DINP; u.o = OC + 1024 + hq * 64; u.ldo = OCW;
                u.qrow0 = MLAT + b * CTX; u.ctx_row0 = MLAT + b * CTX; u.m0 = a.in[I_SINK][l * 6 + hq] * LOG2E; u.l0 = 1.f;
            }
        }
        if (big) attn_unit<192, 128, P2W, UW>(F.lds, u, F.tid, F.wave, F.lane);
        else attn_unit<64, 64, P1W, DINP>(F.lds, u, F.tid, F.wave, F.lane);
    }
}

DI void norm2_phase(Frame& F, KArgs ka, int l, int nrows) {
    KA_FRESH(ka); const __attribute__((address_space(4))) Args& a = *ka; frame_fresh(F);
    LAS float* rt = (LAS float*)F.lds;
    const float* rg = a.in[I_ROUTER] + (size_t)l * 1024 * 16;
    for (int i = F.tid; i < 16384; i += 512) rt[i] = rg[i];
    __syncthreads();
    LAS float* xr = (LAS float*)(F.lds + 65536 + F.wave * 8192);
    const bf16_t* xs = (const bf16_t*)(a.ws + WS_XS);
    const float* modv = (const float*)(a.ws + WS_MODV);
    unsigned char* H2 = a.ws + WS_H2;
    float* AFL = (float*)(a.ws + WS_AFL); float* AFC = (float*)(a.ws + WS_AFC);
    const int eq = F.lane & 3, kq = F.lane >> 2;
    u32x2 xw[2][4];
#define N2_LOAD(mb_) do { _Pragma("unroll") for (int rr_ = 0; rr_ < 2; ++rr_) { const u32x2* xp_ = (const u32x2*)(xs + (size_t)((mb_) + rr_) * D) + F.lane; \
        _Pragma("unroll") for (int j_ = 0; j_ < 4; ++j_) xw[rr_][j_] = xp_[64 * j_]; } } while (0)
    if (2 * F.gw < nrows) N2_LOAD(2 * F.gw);
    for (int mb = 2 * F.gw; mb < nrows; mb += 2 * F.ngw) {
        const int mi = mod_index(mb);
        f32x4 v[2][4];
#pragma unroll
        for (int rr = 0; rr < 2; ++rr)
#pragma unroll
            for (int j = 0; j < 4; ++j) { const u32x2 w = xw[rr][j]; v[rr][j] = (f32x4){bflo(w.x), bfhi(w.x), bflo(w.y), bfhi(w.y)}; }
        if (mb + 2 * F.ngw < nrows) N2_LOAD(mb + 2 * F.ngw);
        const f32x4* g = (const f32x4*)(a.in[I_N2G] + l * D) + F.lane;
        const f32x4* sh = (const f32x4*)(modv + ((size_t)l * 9 + mi) * 6144 + 3 * 1024) + F.lane;
        const f32x4* sc = (const f32x4*)(modv + ((size_t)l * 9 + mi) * 6144 + 4 * 1024) + F.lane;
        f32x4 gg[4], shv[4];
#pragma unroll
        for (int j = 0; j < 4; ++j) { gg[j] = g[64 * j] * (sc[64 * j] + 1.0f); shv[j] = sh[64 * j]; }
#pragma unroll
        for (int rr = 0; rr < 2; ++rr) {
            float ss = 0.f;
#pragma unroll
            for (int j = 0; j < 4; ++j) ss += (v[rr][j].x * v[rr][j].x + v[rr][j].y * v[rr][j].y) + (v[rr][j].z * v[rr][j].z + v[rr][j].w * v[rr][j].w);
            const float rstd = __builtin_amdgcn_rsqf(wave_sum(ss) * (1.f / D) + EPS);
            unsigned* o = (unsigned*)(H2 + (size_t)(mb + rr) * D) + F.lane;
#pragma unroll
            for (int j = 0; j < 4; ++j) { const f32x4 hh = v[rr][j] * rstd * gg[j] + shv[j]; o[64 * j] = pk4_fp8(hh.x, hh.y, hh.z, hh.w);
                *(LAS f32x4*)(xr + rr * 1024 + 4 * F.lane + 256 * j) = hh; }
        }
        asm volatile("s_waitcnt lgkmcnt(0)" ::: "memory");
        f32x4 acc[2] = {{0.f, 0.f, 0.f, 0.f}, {0.f, 0.f, 0.f, 0.f}};
#pragma unroll 8
        for (int i = 0; i < 64; ++i) { const int k = kq + 16 * i; const float x0 = xr[k], x1 = xr[1024 + k]; const f32x4 w = *(const LAS f32x4*)(rt + k * 16 + 4 * eq); acc[0] += w * x0; acc[1] += w * x1; }
        asm volatile("s_waitcnt lgkmcnt(0)" ::: "memory");
#pragma unroll
        for (int rr = 0; rr < 2; ++rr) { const int m = mb + rr; f32x4 ac = acc[rr];
#pragma unroll
            for (int ofs = 4; ofs < 64; ofs <<= 1) { ac.x += __shfl_xor(ac.x, ofs); ac.y += __shfl_xor(ac.y, ofs); ac.z += __shfl_xor(ac.z, ofs); ac.w += __shfl_xor(ac.w, ofs); }
            float mx = fmaxf(fmaxf(ac.x, ac.y), fmaxf(ac.z, ac.w)); mx = fmaxf(mx, __shfl_xor(mx, 1)); mx = fmaxf(mx, __shfl_xor(mx, 2));
            f32x4 ex; ex.x = __expf(ac.x - mx); ex.y = __expf(ac.y - mx); ex.z = __expf(ac.z - mx); ex.w = __expf(ac.w - mx);
            float sum = (ex.x + ex.y) + (ex.z + ex.w); sum += __shfl_xor(sum, 1); sum += __shfl_xor(sum, 2);
            const float inv = 1.0f / sum;
            if (F.lane < 4) {
                if (m < MLAT) { const int b = m >> 12, s = m & 4095; float* p = AFL + ((size_t)(b * 16 + 4 * F.lane)) * 4096 + s; p[0] = ex.x * inv; p[4096] = ex.y * inv; p[2 * 4096] = ex.z * inv; p[3 * 4096] = ex.w * inv; }
                else { const int b = (m - MLAT) >> 8, s = (m - MLAT) & 255; float* p = AFC + ((size_t)(b * 16 + 4 * F.lane)) * 256 + s; p[0] = ex.x * inv; p[256] = ex.y * inv; p[512] = ex.z * inv; p[768] = ex.w * inv; }
            }
        }
    }
}

DI unsigned block_excl_scan(unsigned v, unsigned& total, LAS unsigned* wsum, int tid, int lane, int wave) {
    unsigned x = v;
#pragma unroll
    for (int o = 1; o < 64; o <<= 1) { const unsigned y = __shfl_up(x, o); if (lane >= o) x += y; }
    if (lane == 63) wsum[wave] = x;
    __syncthreads();
    unsigned base = 0, tot = 0;
#pragma unroll
    for (int w = 0; w < 8; ++w) { const unsigned s = wsum[w]; if (w < wave) base += s; tot += s; }
    __syncthreads();
    total = tot;
    return base + x - v;
}
DI void select_phase(Frame& F, KArgs ka, int l) {
    KA_FRESH(ka); const __attribute__((address_space(4))) Args& a = *ka; frame_fresh(F);
    const bool last = (l == NL - 1);
    const int nunits = last ? 128 : 256;
    LAS unsigned* hist = (LAS unsigned*)F.lds;
    LAS unsigned* wsum = (LAS unsigned*)(F.lds + 8192);
    LAS unsigned* bc = (LAS unsigned*)(F.lds + 8192 + 64);
    LAS int* sel = (LAS int*)(F.lds + 16384);
    const float* AFL = (const float*)(a.ws + WS_AFL); const float* AFC = (const float*)(a.ws + WS_AFC);
    int* smap = (int*)(a.ws + WS_SMAP); float* gate = (float*)(a.ws + WS_GATE);
    const unsigned char* H2 = a.ws + WS_H2; unsigned char* XG = a.ws + WS_XG;
    for (int unit = blockIdx.x; unit < nunits; unit += F.G) {
        const bool lat = unit < 128; const int be = unit & 127, b = be >> 4, e = be & 15;
        const int N = lat ? 4096 : 256, cap = lat ? CAP_LAT : CAP_CTX;
        const float* aff = lat ? AFL + (size_t)be * 4096 : AFC + (size_t)be * 256;
        unsigned key[8]; const int per = lat ? 8 : 1; const bool act = lat || F.tid < 256;
#pragma unroll
        for (int j = 0; j < 8; ++j) key[j] = (act && j < per) ? __float_as_uint(aff[F.tid * per + j]) : 0u;
        unsigned prefix = 0u, pmask = 0u, need = (unsigned)cap;
#pragma unroll
        for (int pass = 0; pass < 3; ++pass) {
            const int shift = pass == 0 ? 21 : (pass == 1 ? 10 : 0), nb = pass == 2 ? 1024 : 2048;
            for (int i = F.tid; i < 2048; i += 512) hist[i] = 0u;
            __syncthreads();
#pragma unroll
            for (int j = 0; j < 8; ++j) if (act && j < per && (key[j] & pmask) == prefix) (void)__hip_atomic_fetch_add(&hist[(key[j] >> shift) & (nb - 1)], 1u, __ATOMIC_RELAXED, __HIP_MEMORY_SCOPE_WORKGROUP);
            __syncthreads();
            unsigned c4[4], mine = 0;
#pragma unroll
            for (int j = 0; j < 4; ++j) { const int bin = 2047 - 4 * F.tid - j; c4[j] = bin < nb ? hist[bin] : 0u; mine += c4[j]; }
            unsigned tot; unsigned run = block_excl_scan(mine, tot, wsum, F.tid, F.lane, F.wave);
#pragma unroll
            for (int j = 0; j < 4; ++j) { const int bin = 2047 - 4 * F.tid - j;
                if (bin < nb && run < need && run + c4[j] >= need) { bc[0] = (unsigned)bin; bc[1] = run; }
                run += c4[j]; }
            __syncthreads();
            const unsigned cb = bc[0], above = bc[1];
            prefix |= cb << shift; pmask |= (unsigned)(nb - 1) << shift; need -= above;
            __syncthreads();
        }
        unsigned neq = 0, ngt = 0;
#pragma unroll
        for (int j = 0; j < 8; ++j) if (act && j < per) { neq += key[j] == prefix; ngt += key[j] > prefix; }
        unsigned teq; const unsigned eqbase = block_excl_scan(neq, teq, wsum, F.tid, F.lane, F.wave);
        unsigned nsel = 0, flags = 0, erun = eqbase;
#pragma unroll
        for (int j = 0; j < 8; ++j) if (act && j < per) { bool s = key[j] > prefix; if (key[j] == prefix) { s = erun < need; ++erun; } if (s) { flags |= 1u << j; ++nsel; } }
        unsigned tsel; unsigned sbase = block_excl_scan(nsel, tsel, wsum, F.tid, F.lane, F.wave);
        const int rowbase = lat ? b * SEQ : MLAT + b * CTX;
        const int slotbase = lat ? be * CAP_LAT : NSLOT_LAT + (e * 8 + b) * CAP_CTX;
#pragma unroll
        for (int j = 0; j < 8; ++j) if (act && j < per) { const int tok = F.tid * per + j; int slot = -1;
            if ((flags >> j) & 1u) { slot = slotbase + (int)sbase; sel[sbase] = tok; gate[slot] = __uint_as_float(key[j]); ++sbase; }
            smap[(size_t)e * MT + rowbase + tok] = slot; }
        __syncthreads();
        if (lat) {
            for (int t0 = F.wave * 16; t0 < cap; t0 += 128) {
                u32x4 rowv[16];
#pragma unroll
                for (int q = 0; q < 16; ++q) rowv[q] = ((const u32x4*)(H2 + (size_t)(rowbase + sel[t0 + q]) * D))[F.lane];
#pragma unroll
                for (int q = 0; q < 16; ++q) ((u32x4*)(XG + (size_t)(slotbase + t0 + q) * D))[F.lane] = rowv[q];
            }
        } else {
            const int t0 = F.wave * 4;
            u32x4 rowv[4];
#pragma unroll
            for (int q = 0; q < 4; ++q) rowv[q] = ((const u32x4*)(H2 + (size_t)(rowbase + sel[t0 + q]) * D))[F.lane];
#pragma unroll
            for (int q = 0; q < 4; ++q) ((u32x4*)(XG + (size_t)(slotbase + t0 + q) * D))[F.lane] = rowv[q];
        }
        __syncthreads();
    }
}

#ifndef Q_INA
#define Q_INA 3
#endif
#ifndef Q_INB
#define Q_INB 6
#endif
#ifndef Q_INC
#define Q_INC 9
#endif
#ifndef Q_MRG
#define Q_MRG 9
#endif
#ifndef Q_WO
#define Q_WO 2
#endif
#ifndef Q_GU
#define Q_GU 3
#endif
#ifndef Q_DN
#define Q_DN 3
#endif
#define TAIL1(nwg_, Q_) do { const int r_ = (nwg_) % F.G; if (!last && r_ != 0) { if (bx >= r_) convert_tail(F, ka, l + 1, cur + 8 * (Q_) * (bx - r_), (Q_)); cur += 8 * (Q_) * (F.G - r_); } } while (0)
DI unsigned char* ws_fresh(KArgs ka) { KA_FRESH(ka); return ka->ws; }
__global__ void __launch_bounds__(512, 2) mega_fwd(Args a_unused) {
    extern __shared__ __attribute__((aligned(16))) unsigned char lds_raw[];
    KArgs ka = (KArgs)__builtin_amdgcn_kernarg_segment_ptr();
    Frame F;
    F.lds = (LAS unsigned char*)lds_raw;
    F.tid = threadIdx.x; F.lane = F.tid & 63; F.wave = __builtin_amdgcn_readfirstlane(F.tid >> 6);
    F.G = gridDim.x; { const int bx = blockIdx.x; F.vcu = (F.G % 8 == 0) ? (bx % 8) * (F.G / 8) + bx / 8 : bx; }
    F.gw = F.vcu * 8 + F.wave; F.ngw = F.G * 8;
    for (int u = F.tid; u < (LDS_BYTES - LDSCTL_OFF) / 4; u += 512) ((LAS unsigned*)(F.lds + LDSCTL_OFF))[u] = 0u;
    __syncthreads();
    XcdBarrier bar = xcd_barrier_post((unsigned*)(ws_fresh(ka) + WS_CTL) + CW_BAR, (volatile LAS unsigned*)(F.lds + LDSCTL_OFF + 32));
#define GRID_BAR() xcd_barrier(bar)
    const int bx = blockIdx.x;

    if (PH(0)) modv_phase(F, ka);
    for (int rep_ = 0; rep_ < REPS(2); ++rep_) if (PH(2)) convert_weights(F, ka, 0, 0);
    GRID_BAR();
    if (PH(3)) row_phase(F, ka, 0);
    GRID_BAR();

    for (int l = 0; l < NL; ++l) {
        const bool last = (l == NL - 1);
        const int nMe = last ? MLAT / 256 : MT / 256;
        const int nMs = last ? NSLOT_LAT / 256 : NSLOT / 256;
        int cur = 0;
        if (PH(4)) { unsigned char* ws = ws_fresh(ka);
            for (int rep_ = 0; rep_ < REPS(4); ++rep_) { pg8::Gemm g{(const bf16_t*)(ws + WS_R4), (const bf16_t*)wsel(ws, l, W_IN), 1024, 1024, 1024, 0}; pg8::Order S; S.init(MT / 256, DINP / 256, F.G, bx);
              pg8::EpiStoreBf16 E{(bf16_t*)(ws + WS_HW), DINP}; pg8::gemm_phase(F.lds, g, S, E); }
            for (int rep_ = 0; rep_ < REPS(17); ++rep_) { pg8::Gemm g{(const bf16_t*)(ws + WS_R4 + 68 * MiB), (const bf16_t*)wsel(ws, l, W_GL), 1024, 1024, 1024, 0}; pg8::Order S; S.init(MT / 256, NGL / 256, F.G, (bx + F.G / 2) % F.G);
              pg8::EpiGate E{ws + WS_G}; pg8::gemm_phase<pg8::EpiGate, true>(F.lds, g, S, E); } }
        if (!last && F.G == 256) {
            int q = 0, off = 0;
            if (bx < 128) { q = Q_INA; off = bx * Q_INA; } else if (bx >= 224) { q = Q_INC; off = 128 * Q_INA + 24 * Q_INB + (bx - 224) * Q_INC; } else if (bx >= 200) { q = Q_INB; off = 128 * Q_INA + (bx - 200) * Q_INB; }
            if (q) convert_tail(F, ka, l + 1, cur + 8 * off, q);
            cur += 8 * (128 * Q_INA + 24 * Q_INB + 32 * Q_INC); }
        GRID_BAR();
        for (int rep_ = 0; rep_ < REPS(5); ++rep_) if (PH(5)) { unsigned char* ws = ws_fresh(ka); pg8::Gemm g{(const bf16_t*)(ws + WS_HW) + C_CQ, (const bf16_t*)wsel(ws, l, W_UP), 384, DINP, 384, 0}; pg8::Order S; S.init(MT / 256, UW / 256, F.G, bx);
            pg8::EpiStoreBf16 E{(bf16_t*)(ws + WS_R4), UW}; pg8::gemm_phase(F.lds, g, S, E); }
        for (int rep_ = 0; rep_ < REPS(6); ++rep_) if (PH(6)) prep_phase(F, ka, l);
        GRID_BAR();
        for (int rep_ = 0; rep_ < REPS(7); ++rep_) if (PH(7)) prep2_phase(F, ka, l, rep_);
        GRID_BAR();
        for (int rep_ = 0; rep_ < REPS(8); ++rep_) if (PH(8)) attn_phase(F, ka, l);
        GRID_BAR();
        for (int rep_ = 0; rep_ < REPS(9); ++rep_) if (PH(9)) { unsigned char* ws = ws_fresh(ka); pg8::Order S; S.init(nMe, 4, F.G, bx);
          const unsigned char* OC = ws + WS_OCAT; bf16_t* MG = (bf16_t*)(ws + WS_MERGED); const unsigned char* GL = ws + WS_G;
          { pg8::Gemm3 g{OC, OC + 512, OC + 1024, wsel(ws, l, W_NAO), wsel(ws, l, W_MLAO), wsel(ws, l, W_SWAO), OCW, 512}; pg8::EpiMerge3 E{MG, GL}; pg8::gemm_phase3(F.lds, g, S, E); } }
        TAIL1(nMe * 4, Q_MRG);
        GRID_BAR();
        if (PH(10)) { unsigned char* ws = ws_fresh(ka); pg8::Gemm g{(const bf16_t*)(ws + WS_MERGED), (const bf16_t*)wsel(ws, l, W_O), 1024, 1024, 1024, 0}; pg8::Order S; S.init(nMe, 4, F.G, bx);
            pg8::EpiResid E{(bf16_t*)(ws + WS_XS), (const float*)(ws + WS_MODV) + (size_t)l * 9 * 6144 + 2 * 1024}; pg8::gemm_phase<pg8::EpiResid, true>(F.lds, g, S, E); }
        TAIL1(nMe * 4, Q_WO);
        GRID_BAR();
        for (int rep_ = 0; rep_ < REPS(11); ++rep_) if (PH(11)) norm2_phase(F, ka, l, last ? MLAT : MT);
        GRID_BAR();
        for (int rep_ = 0; rep_ < REPS(12); ++rep_) if (PH(12)) select_phase(F, ka, l);
        GRID_BAR();
        for (int rep_ = 0; rep_ < REPS(13); ++rep_) if (PH(13)) { unsigned char* ws = ws_fresh(ka); pg8::Gemm g{(const bf16_t*)(ws + WS_XG), (const bf16_t*)wsel(ws, l, W_GU), 1024, 1024, 1024, (size_t)2048 * 1024}; pg8::Order S; S.init(nMs, 8, F.G, bx, 1);
            pg8::EpiSwiglu E{ws + WS_ACT}; pg8::gemm_phase<pg8::EpiSwiglu, true>(F.lds, g, S, E); }
        TAIL1(nMs * 8, Q_GU);
        GRID_BAR();
        for (int rep_ = 0; rep_ < REPS(14); ++rep_) if (PH(14)) { unsigned char* ws = ws_fresh(ka); pg8::Gemm g{(const bf16_t*)(ws + WS_ACT), (const bf16_t*)wsel(ws, l, W_DN), 1024, 1024, 1024, (size_t)1024 * 1024}; pg8::Order S; S.init(nMs, 4, F.G, bx, 1);
            pg8::EpiDown E{(bf16_t*)(ws + WS_Y), (const float*)(ws + WS_GATE)}; pg8::gemm_phase<pg8::EpiDown, true>(F.lds, g, S, E); }
        TAIL1(nMs * 4, Q_DN);
        GRID_BAR();
        for (int rep_ = 0; rep_ < REPS(15); ++rep_) if (PH(15)) row_phase(F, ka, l + 1, rep_);
        if (!last) { for (int rep_ = 0; rep_ < REPS(16); ++rep_) if (PH(16)) convert_weights(F, ka, l + 1, cur); GRID_BAR(); }
    }
}

extern "C" void kernel_launch(void* const* d_in, const int* in_sizes, int n_in, void* d_out, int out_size, void* d_ws, size_t ws_size, hipStream_t stream) {
    static int grid = 0;
    if (grid == 0) {
        if (n_in != 29 || in_sizes[0] != MLAT * D || out_size != MLAT * D || ws_size < WS_END) {
            fprintf(stderr, "kernel_launch: unexpected problem: n_in %d in0 %d out %d ws %zu (need %zu)\n", n_in, n_in > 0 ? in_sizes[0] : -1, out_size, ws_size, (size_t)WS_END); grid = -1; return; }
        int dev = 0, cus = 0, per_cu = 0;
        if (hipGetDevice(&dev) != hipSuccess || hipDeviceGetAttribute(&cus, hipDeviceAttributeMultiprocessorCount, dev) != hipSuccess) { fprintf(stderr, "kernel_launch: device query failed\n"); grid = -1; return; }
        if (hipFuncSetAttribute((const void*)mega_fwd, hipFuncAttributeMaxDynamicSharedMemorySize, LDS_BYTES) != hipSuccess) { fprintf(stderr, "kernel_launch: hipFuncSetAttribute failed\n"); grid = -1; return; }
        if (hipOccupancyMaxActiveBlocksPerMultiprocessor(&per_cu, (const void*)mega_fwd, 512, LDS_BYTES) != hipSuccess || per_cu < 1) {
            fprintf(stderr, "kernel_launch: occupancy query reports %d workgroups per CU\n", per_cu); }
        (void)hipGetLastError();
        grid = cus;
    }
    if (grid < 0) return;
    if (hipMemsetAsync((char*)d_ws + WS_CTL, 0, CTL_BYTES, stream) != hipSuccess) { fprintf(stderr, "kernel_launch: memset failed\n"); return; }
    Args a{};
    for (int i = 0; i < 29; ++i) a.in[i] = (const float*)d_in[i];
    a.out = (float*)d_out; a.ws = (unsigned char*)d_ws;
    hipLaunchKernelGGL(mega_fwd, dim3(grid), dim3(512), LDS_BYTES, stream, a);
    const hipError_t le = hipPeekAtLastError();
    if (le != hipSuccess) fprintf(stderr, "kernel_launch: launch failed: %s\n", hipGetErrorName(le));
}
```

```cpp
#include <hip/hip_runtime.h>
#include <cstdio>
#include <cstdint>

#define DI __device__ __forceinline__
#ifndef PH_MASK
#define PH_MASK 0xFFFFF
#endif
#define PH(b) ((PH_MASK >> (b)) & 1)
#ifndef REP_MASK
#define REP_MASK 0
#endif
#define REPS(b) (1 + ((REP_MASK >> (b)) & 1))
#define LAS __attribute__((address_space(3)))
#define GAS __attribute__((address_space(1)))
typedef unsigned short bf16_t;
typedef short bf16x8 __attribute__((ext_vector_type(8)));
typedef short s16x4 __attribute__((ext_vector_type(4)));
typedef float f32x4 __attribute__((ext_vector_type(4)));
typedef float f32x2 __attribute__((ext_vector_type(2)));
typedef float f32x16 __attribute__((ext_vector_type(16)));
typedef unsigned u32x4 __attribute__((ext_vector_type(4)));
typedef unsigned u32x2 __attribute__((ext_vector_type(2)));
typedef int i32x8 __attribute__((ext_vector_type(8)));

constexpr int D = 1024, NB = 8, SEQ = 4096, NL = 4, CTX = 256;
constexpr int MLAT = NB * SEQ, MCTX = NB * CTX, MT = MLAT + MCTX;
constexpr int DIN = 5312, DINP = 2304, NGL = 3072;
constexpr int C_NAQ = 0, C_NAK = 384, C_NAV = 768, C_CQ = 1152, C_CKV = 1408, C_KR = 1536, C_SWQ = 1600, C_SWK = 1984, C_SWV = 2112, C_GL = 2240;
constexpr int UW = 1792;
constexpr int P1W = 1280;
constexpr int P2W = 1536;
constexpr int OCW = 1536;
constexpr int NE = 16, CAP_LAT = 512, CAP_CTX = 32;
constexpr int NSLOT_LAT = NB * NE * CAP_LAT, NSLOT = NSLOT_LAT + NB * NE * CAP_CTX;
constexpr float EPS = 1e-6f;
constexpr float LOG2E = 1.4426950408889634f;

constexpr size_t MiB = 1u << 20;
constexpr size_t WS_CTL = 0, CTL_BYTES = 1 * MiB;
constexpr size_t WS_MODV = 1 * MiB;
constexpr size_t WS_W = 2 * MiB;
constexpr size_t W_IN = 0, W_GL = 4718592  , W_UP = 11010048, W_NAO = 7864320  , W_MLAO = 13172736, W_SWAO = 8912896  , W_O = 15007744, W_GU = 17104896, W_DN = 84213760, W_END = 117768192;
constexpr size_t WS_XS = 115 * MiB, WS_W2 = 183 * MiB  ;
constexpr size_t WS_HW = 251 * MiB;
constexpr size_t WS_G = WS_HW + 153 * MiB;
constexpr size_t WS_P1 = 608 * MiB;
constexpr size_t WS_P2 = 693 * MiB;
constexpr size_t WS_R4 = 795 * MiB;
constexpr size_t WS_AFL = 914 * MiB;
constexpr size_t WS_AFC = 916 * MiB;
constexpr size_t WS_SMAP = 917 * MiB;
constexpr size_t WS_GATE = 920 * MiB;
constexpr size_t WS_OCAT = 921 * MiB;
constexpr size_t WS_END = 1006 * MiB;
constexpr size_t WS_MERGED = WS_P1;
constexpr size_t WS_H2 = WS_HW;
constexpr size_t WS_XG = WS_HW + 68 * MiB;
constexpr size_t WS_ACT = WS_HW + 204 * MiB;
constexpr size_t WS_Y = WS_HW + 340 * MiB;
static_assert(W_END <= 113 * MiB && WS_W + 113 * MiB <= WS_XS, "weights");
static_assert(W_GU + 64 * MiB <= W_DN && W_DN + 32 * MiB <= 113 * MiB && WS_XS + (size_t)MT * D * 2 <= WS_W2 && WS_W2 + W_GU <= WS_HW, "second weight buffers");
static_assert(WS_XS + (size_t)MT * D * 4 <= WS_HW && WS_HW + (size_t)MT * DINP * 2 <= WS_G && WS_G + (size_t)MT * NGL * 2 <= WS_P1 && WS_P1 + (size_t)MT * P1W * 2 <= WS_P2 && WS_P2 + (size_t)MT * P2W * 2 <= WS_R4, "map");
static_assert(WS_R4 + (size_t)MT * UW * 2 <= WS_AFL && WS_Y + (size_t)NSLOT * D * 2 <= WS_R4 && WS_SMAP + (size_t)16 * MT * 4 <= WS_GATE && WS_GATE + (size_t)NSLOT * 4 <= WS_OCAT && WS_OCAT + (size_t)MT * OCW <= WS_END, "map2");
constexpr int CW_BAR = 4096;

constexpr int RING_BYTES = 131072, LDSCTL_OFF = RING_BYTES, LDS_BYTES = 147456;

DI unsigned pk2(float lo, float hi) { unsigned r; asm("v_cvt_pk_bf16_f32 %0, %1, %2" : "=v"(r) : "v"(lo), "v"(hi)); return r; }
DI unsigned pk4_fp8(float a, float b, float c, float d) { int w = 0; w = __builtin_amdgcn_cvt_pk_fp8_f32(a, b, w, false); w = __builtin_amdgcn_cvt_pk_fp8_f32(c, d, w, true); return (unsigned)w; }
DI float bflo(unsigned w) { return __uint_as_float(w << 16); }
DI float bfhi(unsigned w) { return __uint_as_float(w & 0xffff0000u); }
DI float bf2f(bf16_t b) { return __uint_as_float((unsigned)b << 16); }
DI float wave_sum(float v) {
#pragma unroll
    for (int o = 1; o < 64; o <<= 1) v += __shfl_xor(v, o);
    return v;
}
DI float sigmoidf_(float x) { return __builtin_amdgcn_rcpf(1.0f + __builtin_amdgcn_exp2f(-x * LOG2E)); }
DI int mod_index(int row) { return row < MLAT ? (row >> 12) : 8; }

#define XB_TMO      128
#define XB_XCNT(j)  (256  + 64 * (j))
#define XB_XSUB(j)  (1280 + 64 * (j))
#define XB_XGEN(j)  (2304 + 64 * (j))
#define XB_TOP      3328
#define XB_TOPGEN   3392
#define XCD_BAR_WORDS 3456
#define XB_SPIN_CAP (1u << 18)
DI unsigned xb_ld(unsigned* p)              { return __hip_atomic_load(p, __ATOMIC_RELAXED, __HIP_MEMORY_SCOPE_AGENT); }
DI unsigned xb_add(unsigned* p, unsigned v) { return __hip_atomic_fetch_add(p, v, __ATOMIC_RELAXED, __HIP_MEMORY_SCOPE_AGENT); }
DI unsigned xb_xcc_id() { return (unsigned)__builtin_amdgcn_s_getreg((3 << 11) | 20) & 0xFu; }
#define XB_SPIN(cond, bar) do { unsigned _sp = 0; while (cond) { __builtin_amdgcn_s_sleep(1); \
    if ((++_sp & 255u) == 0u) { if (xb_ld(&(bar)[XB_TMO])) break; if (_sp > XB_SPIN_CAP) { atomicAdd(&(bar)[XB_TMO], 1u); break; } } } } while (0)
struct XcdBarrier { unsigned* bar; unsigned x; volatile LAS unsigned* st; };
DI XcdBarrier xcd_barrier_post(unsigned* bar, volatile LAS unsigned* st) {
    XcdBarrier b; b.bar = bar; b.x = xb_xcc_id(); b.st = st;
    if (threadIdx.x == 0) (void)xb_add(&bar[XB_XCNT(b.x)], 1u);
    return b;
}
DI void xcd_barrier_complete(unsigned* bar, unsigned x, unsigned& nloc, unsigned& nx) {
    const unsigned G = gridDim.x * gridDim.y * gridDim.z;
    unsigned sum, cnt, mine, sp = 0u;
    for (;;) {
        sum = 0u; cnt = 0u; mine = 0u;
#pragma unroll
        for (unsigned j = 0; j < 16; ++j) { const unsigned c = xb_ld(&bar[XB_XCNT(j)]); sum += c; cnt += (c > 0u) ? 1u : 0u; mine = (j == x) ? c : mine; }
        if (sum == G) break;
        __builtin_amdgcn_s_sleep(1);
        if ((++sp & 255u) == 0u) { if (xb_ld(&bar[XB_TMO])) break; if (sp > XB_SPIN_CAP) { atomicAdd(&bar[XB_TMO], 1u); break; } }
    }
    nloc = mine > 0u ? mine : 1u; nx = cnt > 0u ? cnt : 1u;
}
DI void xcd_barrier(const XcdBarrier& b) {
    asm volatile("s_waitcnt vmcnt(0)" ::: "memory");
    __syncthreads();
    if (threadIdx.x == 0) {
        unsigned* bar = b.bar; unsigned bx_ = b.x; asm volatile("" : "+s"(bar), "+s"(bx_));
        __builtin_amdgcn_s_waitcnt(0);
        unsigned nloc = b.st[0], nx = b.st[1];
        if (nloc == 0u) { xcd_barrier_complete(bar, bx_, nloc, nx); b.st[0] = nloc; b.st[1] = nx; }
        const unsigned old = xb_add(&bar[XB_XSUB(bx_)], 1u);
        const unsigned gen = old / nloc;
        if (old + 1u == (gen + 1u) * nloc) {
            __builtin_amdgcn_fence(__ATOMIC_RELEASE, "agent");
            asm volatile("s_waitcnt vmcnt(0)" ::: "memory");
            const unsigned og = xb_add(&bar[XB_TOP], 1u);
            const unsigned tg = og / nx;
            if (og + 1u == (tg + 1u) * nx) xb_add(&bar[XB_TOPGEN], 1u);
            else XB_SPIN(xb_ld(&bar[XB_TOPGEN]) == tg, bar);
            __builtin_amdgcn_fence(__ATOMIC_ACQUIRE, "agent");
            xb_add(&bar[XB_XGEN(bx_)], 1u);
            asm volatile("s_waitcnt vmcnt(0)" ::: "memory");
        } else {
            XB_SPIN(xb_ld(&bar[XB_XGEN(bx_)]) == gen, bar);
            __builtin_amdgcn_fence(__ATOMIC_ACQUIRE, "agent");
            asm volatile("s_waitcnt vmcnt(0)" ::: "memory");
        }
    }
    __syncthreads();
}

namespace pg8 {
constexpr int BM = 256, BK = 64, HALF = 128, HTB = HALF * BK * 2, NXCD = 8, WGM = 8;
__host__ __device__ __forceinline__ int lds_byte(int r, int c) { const int st = (r >> 4) * 2 + (c >> 5), rr = r & 15, cc = c & 31, ob = rr * 64 + cc * 2; return st * 1024 + (ob ^ (((ob >> 9) & 1) << 5)); }
__host__ __device__ __forceinline__ void stage_rc(int b, int& R, int& C) { const int st = b / 1024, sb = b % 1024, swz = sb ^ (((sb >> 9) & 1) << 5); R = (st >> 1) * 16 + swz / 64; C = (st & 1) * 32 + (swz % 64) / 2; }
__host__ __device__ __forceinline__ int perm32(int rho) { const int n = rho >> 4, i = rho & 15; return 8 * (i >> 2) + 4 * n + (i & 3); }
struct Unit { int pm, pn; };
struct Gemm { const bf16_t* A; const bf16_t* Bt; int K, lda, ldb; size_t estride; };
struct Order {
    int nM, nN, nwg, G, c, moe;
    DI void init(int nM_, int nN_, int G_, int c_, int moe_ = 0) { nM = nM_; nN = nN_; nwg = nM * nN; G = G_; c = c_; moe = moe_; }
    DI bool next(int i, Unit& u) const {
        const long L = (long)i * G + c; if (L >= nwg) return false;
        int wgid = (int)L; { const int q = nwg / NXCD, r = nwg % NXCD, xcd = wgid % NXCD, off = wgid / NXCD; wgid = (xcd < r ? xcd * (q + 1) : r * (q + 1) + (xcd - r) * q) + off; }
        const int nig = WGM * nN, gid = wgid / nig, fm = gid * WGM, gsz = (nM - fm) < WGM ? (nM - fm) : WGM;
        u.pm = fm + ((wgid % nig) % gsz); u.pn = (wgid % nig) / gsz;
        if (moe && u.pm < 256) { const int e = u.pm >> 4, b = (u.pm >> 1) & 7, hf = u.pm & 1; u.pm = (((b << 4) | e) << 1) | hf; }
        return true;
    }
};
struct EpiStoreBf16 {
    static constexpr bool PERM = true;
    bf16_t* O; int ldc;
    DI void operator()(const f32x4 (&acc)[2][2][4][2], const Unit& u, int wr, int wc, int fr, int fq) const {
        const int row0 = u.pm * BM + wr * 64 + fr, col0 = u.pn * BM + wc * 32 + 8 * fq;
#pragma unroll
        for (int ai = 0; ai < 2; ++ai)
#pragma unroll
            for (int m = 0; m < 4; ++m) { bf16_t* rowp = O + (size_t)(row0 + ai * HALF + m * 16) * ldc + col0;
#pragma unroll
                for (int bj = 0; bj < 2; ++bj) { const f32x4 v0 = acc[ai][bj][m][0], v1 = acc[ai][bj][m][1];
                    u32x4 w; w.x = pk2(v0[0], v0[1]); w.y = pk2(v0[2], v0[3]); w.z = pk2(v1[0], v1[1]); w.w = pk2(v1[2], v1[3]);
                    *(u32x4*)(rowp + bj * HALF) = w; } }
    }
};
DI unsigned pk4_u8(float a, float b, float c, float d) {
    unsigned ua = (unsigned)(a * 255.0f + 0.5f), ub = (unsigned)(b * 255.0f + 0.5f), uc = (unsigned)(c * 255.0f + 0.5f), ud = (unsigned)(d * 255.0f + 0.5f);
    ua = ua < 1u ? 1u : ua; ub = ub < 1u ? 1u : ub; uc = uc < 1u ? 1u : uc; ud = ud < 1u ? 1u : ud;
    return ua | (ub << 8) | (uc << 16) | (ud << 24);
}
struct EpiGate {
    static constexpr bool PERM = true;
    unsigned char* O;
    DI void operator()(const f32x4 (&acc)[2][2][4][2], const Unit& u, int wr, int wc, int fr, int fq) const {
        const int row0 = u.pm * BM + wr * 64 + fr, col0 = u.pn * BM + wc * 32 + 8 * fq;
#pragma unroll
        for (int ai = 0; ai < 2; ++ai)
#pragma unroll
            for (int m = 0; m < 4; ++m) { unsigned char* rowp = O + (size_t)(row0 + ai * HALF + m * 16) * NGL + col0;
#pragma unroll
                for (int bj = 0; bj < 2; ++bj) { const f32x4 v0 = acc[ai][bj][m][0] * 0.03125f, v1 = acc[ai][bj][m][1] * 0.03125f;
                    u32x2 w; w.x = pk4_u8(sigmoidf_(v0[0]), sigmoidf_(v0[1]), sigmoidf_(v0[2]), sigmoidf_(v0[3])); w.y = pk4_u8(sigmoidf_(v1[0]), sigmoidf_(v1[1]), sigmoidf_(v1[2]), sigmoidf_(v1[3]));
                    *(u32x2*)(rowp + bj * HALF) = w; } }
    }
};
DI float u8f(unsigned w, int k) { return (float)((w >> (8 * k)) & 0xffu) * (1.0f / 255.0f); }
struct EpiMerge {
    static constexpr bool PERM = true;
    bf16_t* O; const unsigned char* gl; int first;
    DI void operator()(const f32x4 (&acc)[2][2][4][2], const Unit& u, int wr, int wc, int fr, int fq) const {
        const int row0 = u.pm * BM + wr * 64 + fr, col0 = u.pn * BM + wc * 32 + 8 * fq;
#pragma unroll
        for (int ai = 0; ai < 2; ++ai) {
            u32x2 g[4][2]; u32x4 p[4][2];
#pragma unroll
            for (int m = 0; m < 4; ++m)
#pragma unroll
                for (int bj = 0; bj < 2; ++bj) { const int row = row0 + ai * HALF + m * 16, col = col0 + bj * HALF;
                    g[m][bj] = *(const u32x2*)(gl + (size_t)row * NGL + col);
                    p[m][bj] = first ? (u32x4){0u, 0u, 0u, 0u} : *(const u32x4*)(O + (size_t)row * D + col); }
#pragma unroll
            for (int m = 0; m < 4; ++m)
#pragma unroll
                for (int bj = 0; bj < 2; ++bj) { const int row = row0 + ai * HALF + m * 16, col = col0 + bj * HALF;
                    const u32x2 gg = g[m][bj]; const u32x4 pp = p[m][bj]; const f32x4 v0 = acc[ai][bj][m][0], v1 = acc[ai][bj][m][1];
                    const float r0 = v0[0] * u8f(gg.x, 0) + bflo(pp.x), r1 = v0[1] * u8f(gg.x, 1) + bfhi(pp.x), r2 = v0[2] * u8f(gg.x, 2) + bflo(pp.y), r3 = v0[3] * u8f(gg.x, 3) + bfhi(pp.y);
                    const float r4 = v1[0] * u8f(gg.y, 0) + bflo(pp.z), r5 = v1[1] * u8f(gg.y, 1) + bfhi(pp.z), r6 = v1[2] * u8f(gg.y, 2) + bflo(pp.w), r7 = v1[3] * u8f(gg.y, 3) + bfhi(pp.w);
                    u32x4 w; w.x = pk2(r0, r1); w.y = pk2(r2, r3); w.z = pk2(r4, r5); w.w = pk2(r6, r7);
                    *(u32x4*)(O + (size_t)row * D + col) = w; }
        }
    }
};
struct EpiResid {
    static constexpr bool PERM = true;
    bf16_t* xs; const float* modg;
    DI void operator()(const f32x4 (&acc)[2][2][4][2], const Unit& u, int wr, int wc, int fr, int fq) const {
        const int row0 = u.pm * BM + wr * 64 + fr, col0 = u.pn * BM + wc * 32 + 8 * fq;
        const float* mp = modg + (size_t)mod_index(u.pm * BM) * 6144 + col0;
        f32x4 g0[2], g1[2];
#pragma unroll
        for (int bj = 0; bj < 2; ++bj) { g0[bj] = *(const f32x4*)(mp + bj * HALF) * (1.0f / 128.0f); g1[bj] = *(const f32x4*)(mp + bj * HALF + 4) * (1.0f / 128.0f); }
#pragma unroll
        for (int ai = 0; ai < 2; ++ai)
#pragma unroll
            for (int mh = 0; mh < 2; ++mh) {
                u32x4 xw[2][2];
#pragma unroll
                for (int m2 = 0; m2 < 2; ++m2)
#pragma unroll
                    for (int bj = 0; bj < 2; ++bj) xw[m2][bj] = *(const u32x4*)(xs + (size_t)(row0 + ai * HALF + (2 * mh + m2) * 16) * D + col0 + bj * HALF);
#pragma unroll
                for (int m2 = 0; m2 < 2; ++m2)
#pragma unroll
                    for (int bj = 0; bj < 2; ++bj) { const int m = 2 * mh + m2; const u32x4 x = xw[m2][bj];
                        const f32x4 x0 = (f32x4){bflo(x.x), bfhi(x.x), bflo(x.y), bfhi(x.y)} + g0[bj] * acc[ai][bj][m][0];
                        const f32x4 x1 = (f32x4){bflo(x.z), bfhi(x.z), bflo(x.w), bfhi(x.w)} + g1[bj] * acc[ai][bj][m][1];
                        u32x4 w; w.x = pk2(x0[0], x0[1]); w.y = pk2(x0[2], x0[3]); w.z = pk2(x1[0], x1[1]); w.w = pk2(x1[2], x1[3]);
                        *(u32x4*)(xs + (size_t)(row0 + ai * HALF + m * 16) * D + col0 + bj * HALF) = w; }
            }
    }
};
struct EpiSwiglu {
    static constexpr bool PERM = true;
    unsigned char* O;
    DI void operator()(const f32x4 (&acc)[2][2][4][2], const Unit& u, int wr, int wc, int fr, int fq) const {
        const int row0 = u.pm * BM + wr * 64 + fr, col0 = u.pn * HALF + wc * 32 + 8 * fq;
#pragma unroll
        for (int ai = 0; ai < 2; ++ai)
#pragma unroll
            for (int m = 0; m < 4; ++m) { const int row = row0 + ai * HALF + m * 16;
                const f32x4 a0 = acc[ai][0][m][0] * 0.03125f, a1 = acc[ai][0][m][1] * 0.03125f, u0 = acc[ai][1][m][0] * 0.25f, u1 = acc[ai][1][m][1] * 0.25f;
                float r[8];
#pragma unroll
                for (int j = 0; j < 4; ++j) { r[j] = a0[j] * sigmoidf_(a0[j]) * u0[j]; r[4 + j] = a1[j] * sigmoidf_(a1[j]) * u1[j]; }
                u32x2 w; w.x = pk4_fp8(r[0], r[1], r[2], r[3]); w.y = pk4_fp8(r[4], r[5], r[6], r[7]);
                *(u32x2*)(O + (size_t)row * D + col0) = w; }
    }
};
struct EpiDown {
    static constexpr bool PERM = true;
    bf16_t* O; const float* gate;
    DI void operator()(const f32x4 (&acc)[2][2][4][2], const Unit& u, int wr, int wc, int fr, int fq) const {
        const int row0 = u.pm * BM + wr * 64 + fr, col0 = u.pn * BM + wc * 32 + 8 * fq;
        float gv[2][4];
#pragma unroll
        for (int ai = 0; ai < 2; ++ai)
#pragma unroll
            for (int m = 0; m < 4; ++m) gv[ai][m] = gate[row0 + ai * HALF + m * 16] * (1.0f / 256.0f);
#pragma unroll
        for (int ai = 0; ai < 2; ++ai)
#pragma unroll
            for (int m = 0; m < 4; ++m) { const int row = row0 + ai * HALF + m * 16; const float g = gv[ai][m]; bf16_t* rowp = O + (size_t)row * D + col0;
#pragma unroll
                for (int bj = 0; bj < 2; ++bj) { const f32x4 v0 = acc[ai][bj][m][0] * g, v1 = acc[ai][bj][m][1] * g;
                    u32x4 w; w.x = pk2(v0[0], v0[1]); w.y = pk2(v0[2], v0[3]); w.z = pk2(v1[0], v1[1]); w.w = pk2(v1[2], v1[3]);
                    *(u32x4*)(rowp + bj * HALF) = w; } }
    }
};

struct EpiMerge3 {
    static constexpr bool PERM = true;
    bf16_t* O; const unsigned char* gl;
    DI void operator()(f32x4 (&acc)[2][2][4][2], const Unit& u, int seg, int wr, int wc, int fr, int fq) const {
        const int row0 = u.pm * BM + wr * 64 + fr, col0 = u.pn * BM + wc * 32 + 8 * fq;
#pragma unroll
        for (int ai = 0; ai < 2; ++ai) {
            u32x2 ga[4][2], gb[4][2];
#pragma unroll
            for (int m = 0; m < 4; ++m)
#pragma unroll
                for (int bj = 0; bj < 2; ++bj) { const unsigned char* gp = gl + (size_t)(row0 + ai * HALF + m * 16) * NGL + 1024 * seg + col0 + bj * HALF;
                    ga[m][bj] = *(const u32x2*)gp; gb[m][bj] = seg < 2 ? *(const u32x2*)(gp + 1024) : (u32x2){0u, 0u}; }
#pragma unroll
            for (int m = 0; m < 4; ++m)
#pragma unroll
                for (int bj = 0; bj < 2; ++bj) {
                    f32x4 s0, s1;
#pragma unroll
                    for (int k = 0; k < 4; ++k) { const float a0 = (float)((ga[m][bj].x >> (8 * k)) & 0xffu), a1 = (float)((ga[m][bj].y >> (8 * k)) & 0xffu);
                        if (seg < 2) { const float b0 = (float)((gb[m][bj].x >> (8 * k)) & 0xffu), b1 = (float)((gb[m][bj].y >> (8 * k)) & 0xffu); s0[k] = a0 * __builtin_amdgcn_rcpf(b0); s1[k] = a1 * __builtin_amdgcn_rcpf(b1); }
                        else { s0[k] = a0 * (1.0f / (255.0f * 128.0f)); s1[k] = a1 * (1.0f / (255.0f * 128.0f)); } }
                    acc[ai][bj][m][0] *= s0; acc[ai][bj][m][1] *= s1;
                    if (seg == 2) { const f32x4 v0 = acc[ai][bj][m][0] * 4.0f, v1 = acc[ai][bj][m][1] * 4.0f;
                        u32x2 w; w.x = pk4_fp8(v0[0], v0[1], v0[2], v0[3]); w.y = pk4_fp8(v1[0], v1[1], v1[2], v1[3]);
                        *(u32x2*)((unsigned char*)O + (size_t)(row0 + ai * HALF + m * 16) * D + col0 + bj * HALF) = w; }
                }
        }
    }
};
struct Gemm3 { const unsigned char* A0; const unsigned char* A1; const unsigned char* A2; const unsigned char* B0; const unsigned char* B1; const unsigned char* B2; int lda, ldb; };
template <class Epi>
DI void gemm_phase3(LAS unsigned char* lds, const Gemm3 g, const Order& S, const Epi& E) {
    int tid_ = threadIdx.x; asm volatile("" : "+v"(tid_));
    const int tid = tid_, wid = __builtin_amdgcn_readfirstlane(tid >> 6), lane = tid & 63, wr = wid >> 2, wc = wid & 3, fr = lane & 15, fq = lane >> 4;
    unsigned voffA[2], voffB[2];
#pragma unroll
    for (int i = 0; i < 2; ++i) { int R, C; stage_rc(tid * 16 + i * 8192, R, C); const int Rb = Epi::PERM ? ((R & ~31) + perm32(R & 31)) : R;
        voffA[i] = (unsigned)(R * g.lda + C * 2); voffB[i] = (unsigned)(Rb * g.ldb + C * 2); }
    const size_t kstep = (size_t)(BK * 2);
    const size_t hstepA = (size_t)HALF * g.lda, hstepB = (size_t)HALF * g.ldb;
    const size_t tstepA = 2 * hstepA, tstepB = 2 * hstepB;
    const unsigned ldsw = (unsigned)wid * 1024u;
    const int aoff = lds_byte(wr * 64 + fr, fq * 8), boff = lds_byte(wc * 32 + fr, fq * 8);
#define PG8_SA(b, h) (((b) * 2 + (h)) * HTB)
#define PG8_SB(b, h) ((4 + (b) * 2 + (h)) * HTB)
#define PG8_STAGE(bufoff, gbase, voff) do { _Pragma("unroll") for (int _i = 0; _i < 2; ++_i) \
        __builtin_amdgcn_global_load_lds((const unsigned*)((const char*)(gbase) + (voff)[_i]), (LAS unsigned*)(lds + (bufoff) + ldsw + _i * 8192), 16, 0, 0); } while (0)
#define PG8_LDA(dst, b, h) do { _Pragma("unroll") for (int m = 0; m < 4; ++m) _Pragma("unroll") for (int k = 0; k < 2; ++k) dst[m][k] = *(const LAS bf16x8*)(lds + PG8_SA(b, h) + aoff + m * 2048 + k * 1024); } while (0)
#define PG8_LDB(dst, b, h) do { _Pragma("unroll") for (int n = 0; n < 2; ++n) _Pragma("unroll") for (int k = 0; k < 2; ++k) dst[n][k] = *(const LAS bf16x8*)(lds + PG8_SB(b, h) + boff + n * 2048 + k * 1024); } while (0)
#define PG8_MMA(ai, bj, At, Bt) do { __builtin_amdgcn_s_setprio(1); _Pragma("unroll") for (int m = 0; m < 4; ++m) _Pragma("unroll") for (int n = 0; n < 2; ++n) { \
        const i32x8 bb_ = __builtin_bit_cast(i32x8, __builtin_shufflevector(Bt[n][0], Bt[n][1], 0, 1, 2, 3, 4, 5, 6, 7, 8, 9, 10, 11, 12, 13, 14, 15)); \
        const i32x8 aa_ = __builtin_bit_cast(i32x8, __builtin_shufflevector(At[m][0], At[m][1], 0, 1, 2, 3, 4, 5, 6, 7, 8, 9, 10, 11, 12, 13, 14, 15)); \
        asm volatile("v_mfma_scale_f32_16x16x128_f8f6f4 %0, %1, %2, %0, %3, %3 op_sel_hi:[0,0,0]" : "+v"(acc[ai][bj][m][n]) : "v"(bb_), "v"(aa_), "v"(0x7F7F7F7F)); } \
        __builtin_amdgcn_s_setprio(0); } while (0)
#define PG8_WAIT_V(n) asm volatile("s_waitcnt vmcnt(" #n ")" ::: "memory")
#define PG8_WAIT_L(n) asm volatile("s_waitcnt lgkmcnt(" #n ")" ::: "memory")
#define PG8_BAR __builtin_amdgcn_s_barrier()
#define PG8_SCHED __builtin_amdgcn_sched_barrier(0)
#define PG8_A3(sg, u) ((const char*)((sg) == 0 ? g.A0 : (sg) == 1 ? g.A1 : g.A2) + (size_t)(u).pm * tstepA)
#define PG8_B3(sg, u) ((const char*)((sg) == 0 ? g.B0 : (sg) == 1 ? g.B1 : g.B2) + (size_t)(u).pn * tstepB)
    Unit cur, nu; int ui = 0, seg = 0;
    if (!S.next(0, cur)) return;
    f32x4 acc[2][2][4][2];
#pragma unroll
    for (int a = 0; a < 2; ++a)
#pragma unroll
        for (int b = 0; b < 2; ++b)
#pragma unroll
            for (int m = 0; m < 4; ++m)
#pragma unroll
                for (int n = 0; n < 2; ++n) acc[a][b][m][n] = (f32x4){0.f, 0.f, 0.f, 0.f};
    bf16x8 At[4][2], B0[2][2], B1[2][2];
    const char* cA = PG8_A3(0, cur); const char* cB = PG8_B3(0, cur);
    PG8_STAGE(PG8_SB(0, 0), cB, voffB); PG8_STAGE(PG8_SB(0, 1), cB + hstepB, voffB); PG8_STAGE(PG8_SA(0, 0), cA, voffA); PG8_STAGE(PG8_SA(0, 1), cA + hstepA, voffA);
    if (wr == 1) PG8_BAR;
    PG8_WAIT_V(2); PG8_BAR;
    PG8_STAGE(PG8_SB(1, 0), cB + kstep, voffB); PG8_STAGE(PG8_SA(1, 0), cA + kstep, voffA); PG8_STAGE(PG8_SB(1, 1), cB + hstepB + kstep, voffB);
    PG8_WAIT_V(6); PG8_BAR;
    for (;;) {
        int nseg = seg + 1; bool has_next = true; nu = cur;
        if (nseg == 3) { nseg = 0; has_next = S.next(ui + 1, nu); }
        const char* nA = has_next ? PG8_A3(nseg, nu) : cA; const char* nB = has_next ? PG8_B3(nseg, nu) : cB;
        int nt_ = 4; asm volatile("" : "+s"(nt_));
        const int nt = nt_;
#pragma nounroll
        for (int t = 0; t < nt; t += 2) {
            const bool last = (t == nt - 2);
            const char* a1 = cA + (size_t)(t + 1) * kstep;
            const char* a2 = last ? nA : cA + (size_t)(t + 2) * kstep; const char* b2 = last ? nB : cB + (size_t)(t + 2) * kstep;
            const char* a3 = a2 + kstep; const char* b3 = b2 + kstep;
            PG8_LDB(B0, 0, 0); PG8_LDB(B1, 0, 1); PG8_SCHED; PG8_LDA(At, 0, 0); PG8_STAGE(PG8_SA(1, 1), a1 + hstepA, voffA);
            PG8_WAIT_V(8); PG8_WAIT_L(0); PG8_BAR; PG8_MMA(0, 0, At, B0); PG8_MMA(0, 1, At, B1); PG8_BAR; PG8_SCHED;
            PG8_LDA(At, 0, 1); PG8_STAGE(PG8_SB(0, 0), b2, voffB); PG8_STAGE(PG8_SB(0, 1), b2 + hstepB, voffB); PG8_STAGE(PG8_SA(0, 0), a2, voffA);
            PG8_WAIT_V(8); PG8_WAIT_L(0); PG8_BAR; PG8_MMA(1, 0, At, B0); PG8_MMA(1, 1, At, B1); PG8_BAR; PG8_SCHED;
            PG8_LDB(B0, 1, 0); PG8_LDB(B1, 1, 1); PG8_SCHED; PG8_LDA(At, 1, 0); PG8_STAGE(PG8_SA(0, 1), a2 + hstepA, voffA);
            PG8_WAIT_V(8); PG8_WAIT_L(0); PG8_BAR; PG8_MMA(0, 0, At, B0); PG8_MMA(0, 1, At, B1); PG8_BAR; PG8_SCHED;
            PG8_LDA(At, 1, 1); PG8_STAGE(PG8_SB(1, 0), b3, voffB); PG8_STAGE(PG8_SB(1, 1), b3 + hstepB, voffB); PG8_STAGE(PG8_SA(1, 0), a3, voffA);
            PG8_WAIT_V(8); PG8_WAIT_L(0); PG8_BAR; PG8_MMA(1, 0, At, B0); PG8_MMA(1, 1, At, B1); PG8_BAR; PG8_SCHED;
        }
        if (wr == 0) PG8_BAR;
        E(acc, cur, seg, wr, wc, fr, fq);
        if (!has_next) break;
        if (seg == 2) {
#pragma unroll
            for (int a = 0; a < 2; ++a)
#pragma unroll
                for (int b = 0; b < 2; ++b)
#pragma unroll
                    for (int m = 0; m < 4; ++m)
#pragma unroll
                        for (int n = 0; n < 2; ++n) acc[a][b][m][n] = (f32x4){0.f, 0.f, 0.f, 0.f};
            cur = nu; ++ui;
        }
        seg = nseg; cA = nA; cB = nB;
        if (wr == 1) PG8_BAR;
    }
    PG8_WAIT_V(0);
    PG8_BAR;
#undef PG8_SA
#undef PG8_SB
#undef PG8_STAGE
#undef PG8_LDA
#undef PG8_LDB
#undef PG8_MMA
#undef PG8_WAIT_V
#undef PG8_WAIT_L
#undef PG8_BAR
#undef PG8_SCHED
#undef PG8_A3
#undef PG8_B3
}

template <class Epi, bool FP8 = false>
DI void gemm_phase(LAS unsigned char* lds, const Gemm g, const Order& S, const Epi& E) {
    constexpr int ESZ = FP8 ? 1 : 2;
    int tid_ = threadIdx.x; asm volatile("" : "+v"(tid_));
    const int tid = tid_, wid = __builtin_amdgcn_readfirstlane(tid >> 6), lane = tid & 63, wr = wid >> 2, wc = wid & 3, fr = lane & 15, fq = lane >> 4;
    const int K = g.K, nt = K * ESZ / (BK * 2);
    unsigned voffA[2], voffB[2];
#pragma unroll
    for (int i = 0; i < 2; ++i) { int R, C; stage_rc(tid * 16 + i * 8192, R, C); const int Rb = Epi::PERM ? ((R & ~31) + perm32(R & 31)) : R;
        voffA[i] = (unsigned)(R * g.lda * ESZ + C * 2); voffB[i] = (unsigned)(Rb * g.ldb * ESZ + C * 2); }
    const size_t kstep = (size_t)(BK * 2);
    const size_t hstepA = (size_t)HALF * g.lda * ESZ, hstepB = (size_t)HALF * g.ldb * ESZ;
    const size_t tstepA = 2 * hstepA, tstepB = 2 * hstepB;
    const unsigned ldsw = (unsigned)wid * 1024u;
    const int aoff = lds_byte(wr * 64 + fr, fq * 8), boff = lds_byte(wc * 32 + fr, fq * 8);
#define PG8_SA(b, h) (((b) * 2 + (h)) * HTB)
#define PG8_SB(b, h) ((4 + (b) * 2 + (h)) * HTB)
#define PG8_STAGE(bufoff, gbase, voff) do { _Pragma("unroll") for (int _i = 0; _i < 2; ++_i) \
        __builtin_amdgcn_global_load_lds((const unsigned*)((const char*)(gbase) + (voff)[_i]), (LAS unsigned*)(lds + (bufoff) + ldsw + _i * 8192), 16, 0, 0); } while (0)
#define PG8_LDA(dst, b, h) do { _Pragma("unroll") for (int m = 0; m < 4; ++m) _Pragma("unroll") for (int k = 0; k < 2; ++k) dst[m][k] = *(const LAS bf16x8*)(lds + PG8_SA(b, h) + aoff + m * 2048 + k * 1024); } while (0)
#define PG8_LDB(dst, b, h) do { _Pragma("unroll") for (int n = 0; n < 2; ++n) _Pragma("unroll") for (int k = 0; k < 2; ++k) dst[n][k] = *(const LAS bf16x8*)(lds + PG8_SB(b, h) + boff + n * 2048 + k * 1024); } while (0)
#define PG8_MMA(ai, bj, At, Bt) do { __builtin_amdgcn_s_setprio(1); _Pragma("unroll") for (int m = 0; m < 4; ++m) _Pragma("unroll") for (int n = 0; n < 2; ++n) { \
        if constexpr (FP8) { const i32x8 bb_ = __builtin_bit_cast(i32x8, __builtin_shufflevector(Bt[n][0], Bt[n][1], 0, 1, 2, 3, 4, 5, 6, 7, 8, 9, 10, 11, 12, 13, 14, 15)); \
            const i32x8 aa_ = __builtin_bit_cast(i32x8, __builtin_shufflevector(At[m][0], At[m][1], 0, 1, 2, 3, 4, 5, 6, 7, 8, 9, 10, 11, 12, 13, 14, 15)); \
            asm volatile("v_mfma_scale_f32_16x16x128_f8f6f4 %0, %1, %2, %0, %3, %3 op_sel_hi:[0,0,0]" : "+v"(acc[ai][bj][m][n]) : "v"(bb_), "v"(aa_), "v"(0x7F7F7F7F)); } \
        else { _Pragma("unroll") for (int k = 0; k < 2; ++k) acc[ai][bj][m][n] = __builtin_amdgcn_mfma_f32_16x16x32_bf16(Bt[n][k], At[m][k], acc[ai][bj][m][n], 0, 0, 0); } } \
        __builtin_amdgcn_s_setprio(0); } while (0)
#define PG8_WAIT_V(n) asm volatile("s_waitcnt vmcnt(" #n ")" ::: "memory")
#define PG8_WAIT_L(n) asm volatile("s_waitcnt lgkmcnt(" #n ")" ::: "memory")
#define PG8_BAR __builtin_amdgcn_s_barrier()
#define PG8_SCHED __builtin_amdgcn_sched_barrier(0)
#define PG8_EXPERT(pm) ((pm) < 256 ? (((pm) >> 1) & 15) : ((pm) - 256))
#define PG8_ABASE(u) ((const char*)g.A + (size_t)(u).pm * tstepA)
#define PG8_BBASE(u) ((const char*)g.Bt + (size_t)PG8_EXPERT((u).pm) * g.estride * ESZ + (size_t)(u).pn * tstepB)
    Unit cur, nxt; int ui = 0;
    if (!S.next(0, cur)) return;
    f32x4 acc[2][2][4][2];
#pragma unroll
    for (int a = 0; a < 2; ++a)
#pragma unroll
        for (int b = 0; b < 2; ++b)
#pragma unroll
            for (int m = 0; m < 4; ++m)
#pragma unroll
                for (int n = 0; n < 2; ++n) acc[a][b][m][n] = (f32x4){0.f, 0.f, 0.f, 0.f};
    bf16x8 At[4][2], B0[2][2], B1[2][2];
    const char* cA = PG8_ABASE(cur); const char* cB = PG8_BBASE(cur);
    PG8_STAGE(PG8_SB(0, 0), cB, voffB); PG8_STAGE(PG8_SB(0, 1), cB + hstepB, voffB); PG8_STAGE(PG8_SA(0, 0), cA, voffA); PG8_STAGE(PG8_SA(0, 1), cA + hstepA, voffA);
    if (wr == 1) PG8_BAR;
    PG8_WAIT_V(2); PG8_BAR;
    PG8_STAGE(PG8_SB(1, 0), cB + kstep, voffB); PG8_STAGE(PG8_SA(1, 0), cA + kstep, voffA); PG8_STAGE(PG8_SB(1, 1), cB + hstepB + kstep, voffB);
    PG8_WAIT_V(6); PG8_BAR;
    for (;;) {
        const bool has_next = S.next(ui + 1, nxt);
        const char* nA = has_next ? PG8_ABASE(nxt) : cA; const char* nB = has_next ? PG8_BBASE(nxt) : cB;
#pragma nounroll
        for (int t = 0; t < nt; t += 2) {
            const bool last = (t == nt - 2);
            const char* a1 = cA + (size_t)(t + 1) * kstep;
            const char* a2 = last ? nA : cA + (size_t)(t + 2) * kstep; const char* b2 = last ? nB : cB + (size_t)(t + 2) * kstep;
            const char* a3 = a2 + kstep; const char* b3 = b2 + kstep;
            PG8_LDB(B0, 0, 0); PG8_LDB(B1, 0, 1); PG8_SCHED; PG8_LDA(At, 0, 0); PG8_STAGE(PG8_SA(1, 1), a1 + hstepA, voffA);
            PG8_WAIT_V(8); PG8_WAIT_L(0); PG8_BAR; PG8_MMA(0, 0, At, B0); PG8_MMA(0, 1, At, B1); PG8_BAR; PG8_SCHED;
            PG8_LDA(At, 0, 1); PG8_STAGE(PG8_SB(0, 0), b2, voffB); PG8_STAGE(PG8_SB(0, 1), b2 + hstepB, voffB); PG8_STAGE(PG8_SA(0, 0), a2, voffA);
            PG8_WAIT_V(8); PG8_WAIT_L(0); PG8_BAR; PG8_MMA(1, 0, At, B0); PG8_MMA(1, 1, At, B1); PG8_BAR; PG8_SCHED;
            PG8_LDB(B0, 1, 0); PG8_LDB(B1, 1, 1); PG8_SCHED; PG8_LDA(At, 1, 0); PG8_STAGE(PG8_SA(0, 1), a2 + hstepA, voffA);
            PG8_WAIT_V(8); PG8_WAIT_L(0); PG8_BAR; PG8_MMA(0, 0, At, B0); PG8_MMA(0, 1, At, B1); PG8_BAR; PG8_SCHED;
            PG8_LDA(At, 1, 1); PG8_STAGE(PG8_SB(1, 0), b3, voffB); PG8_STAGE(PG8_SB(1, 1), b3 + hstepB, voffB); PG8_STAGE(PG8_SA(1, 0), a3, voffA);
            PG8_WAIT_V(8); PG8_WAIT_L(0); PG8_BAR; PG8_MMA(1, 0, At, B0); PG8_MMA(1, 1, At, B1); PG8_BAR; PG8_SCHED;
        }
        if (wr == 0) PG8_BAR;
        E(acc, cur, wr, wc, fr, fq);
        if (!has_next) break;
#pragma unroll
        for (int a = 0; a < 2; ++a)
#pragma unroll
            for (int b = 0; b < 2; ++b)
#pragma unroll
                for (int m = 0; m < 4; ++m)
#pragma unroll
                    for (int n = 0; n < 2; ++n) acc[a][b][m][n] = (f32x4){0.f, 0.f, 0.f, 0.f};
        cur = nxt; cA = nA; cB = nB; ++ui;
        if (wr == 1) PG8_BAR;
    }
    PG8_WAIT_V(0);
    PG8_BAR;
#undef PG8_SA
#undef PG8_SB
#undef PG8_STAGE
#undef PG8_LDA
#undef PG8_LDB
#undef PG8_MMA
#undef PG8_WAIT_V
#undef PG8_WAIT_L
#undef PG8_BAR
#undef PG8_SCHED
}
}

struct Args { const float* in[29]; float* out; unsigned char* ws; };
typedef const __attribute__((address_space(4))) Args* KArgs;
#define KA_FRESH(ka) asm volatile("" : "+s"(ka))
enum { I_X = 0, I_C, I_CTX, I_CCTX, I_N1G, I_N2G, I_WADA, I_BADA, I_WIN, I_NAQG, I_NAKG, I_RPB, I_MQN, I_WUQ, I_MKVN, I_WUKV, I_MQG, I_MKG, I_SWQG, I_SWKG, I_SINK,
       I_WNAO, I_WMLAO, I_WSWAO, I_WO, I_ROUTER, I_WGATE, I_WUP, I_WDOWN };
struct Frame {
    LAS unsigned char* lds;
    int tid, lane, wave, G, vcu, gw, ngw;
};

DI void frame_fresh(Frame& F) { int t = F.tid, w = F.wave, v = F.vcu; asm volatile("" : "+v"(t), "+s"(w), "+s"(v)); F.tid = t; F.lane = t & 63; F.wave = w; F.vcu = v; F.gw = v * 8 + w; }
DI void modv_phase(Frame& F, KArgs ka) {
    KA_FRESH(ka); const __attribute__((address_space(4))) Args& a = *ka; frame_fresh(F);
    LAS float* cact = (LAS float*)F.lds;
    LAS float* red = (LAS float*)(F.lds + 9 * 1024 * 4);
    const float* c = a.in[I_C]; const float* cc = a.in[I_CCTX];
    for (int i = F.tid; i < 9 * 1024; i += 512) { const float v = i < 8192 ? c[i] : cc[i - 8192]; cact[i] = v * sigmoidf_(v); }
    __syncthreads();
    float* modv = (float*)(a.ws + WS_MODV);
    const int cl = F.lane & 31, kp = F.lane >> 5;
    for (int unit = F.vcu; unit < NL * 192; unit += F.G) {
        const int l = unit / 192, n = (unit % 192) * 32 + cl;
        const float* w = a.in[I_WADA] + (size_t)l * 1024 * 6144 + n;
        float acc[9];
#pragma unroll
        for (int i = 0; i < 9; ++i) acc[i] = 0.f;
        const int k0 = F.wave * 128 + kp;
#pragma unroll 16
        for (int k = 0; k < 128; k += 2) { const float wv = w[(size_t)(k0 + k) * 6144];
#pragma unroll
            for (int i = 0; i < 9; ++i) acc[i] += cact[i * 1024 + k0 + k] * wv; }
#pragma unroll
        for (int i = 0; i < 9; ++i) red[((F.wave * 2 + kp) * 9 + i) * 32 + cl] = acc[i];
        __syncthreads();
        for (int t = F.tid; t < 9 * 32; t += 512) { const int i = t >> 5, nn = t & 31; float s = 0.f;
#pragma unroll
            for (int w16 = 0; w16 < 16; ++w16) s += red[(w16 * 9 + i) * 32 + nn];
            const int col = (unit % 192) * 32 + nn;
            modv[((size_t)l * 9 + i) * 6144 + col] = s + a.in[I_BADA][l * 6144 + col]; }
        __syncthreads();
    }
}
DI void copy_phase(Frame& F, KArgs ka) {
    KA_FRESH(ka); const __attribute__((address_space(4))) Args& a = *ka; frame_fresh(F);
    u32x2* xs = (u32x2*)(a.ws + WS_XS);
    const f32x4* x = (const f32x4*)a.in[I_X]; const f32x4* cx = (const f32x4*)a.in[I_CTX];
    const size_t nl = (size_t)MLAT * D / 4, nc = (size_t)MCTX * D / 4;
    for (size_t i = (size_t)blockIdx.x * 512 + F.tid; i < nl + nc; i += (size_t)F.G * 512) { const f32x4 v = i < nl ? x[i] : cx[i - nl]; u32x2 w; w.x = pk2(v.x, v.y); w.y = pk2(v.z, v.w); xs[i] = w; }
}

DI unsigned char* wsel(unsigned char* ws, int l, size_t off) {
    const size_t p = (size_t)(l & 1);
    return ws + (off >= W_DN ? WS_W + off + p * (16 * MiB) : off >= W_GU ? WS_W + off + p * (32 * MiB) : (p ? WS_W2 : WS_W) + off);
}
constexpr int T_IN = 16 * 166, T_UQ = 4 * 24, T_UKV = 2 * 32, T_NAO = 6 * 32, T_MLAO = 8 * 32, T_SWAO = 6 * 32, T_O = 16 * 32, T_E = 16 * 32 * 16;
constexpr int NIT = T_IN + T_UQ + T_UKV + T_NAO + T_MLAO + T_SWAO + T_O + 3 * T_E;
DI void cvt_item(const __attribute__((address_space(4))) Args& a, int l, int r, LAS float* scr, int lane) {
    const float* W; const float* ks = nullptr; int ldw = 1024, kb, nb, ldt = 1024, drow0, dcol0 = 0, fp8 = 1; size_t woff;
    if (r < T_IN) { kb = r / 166; nb = r % 166; W = a.in[I_WIN] + (size_t)l * 1024 * DIN; ldw = DIN;
        if (nb < 70) { fp8 = 0; woff = W_IN; drow0 = 32 * nb; } else { woff = W_GL; drow0 = 32 * nb - 2240; } }
    else if ((r -= T_IN) < T_UQ) { kb = r / 24; nb = r % 24; W = a.in[I_WUQ] + (size_t)l * 256 * 768; ldw = 768; fp8 = 0; woff = W_UP; ldt = 384; drow0 = 32 * nb; ks = a.in[I_MQN] + l * 256; }
    else if ((r -= T_UQ) < T_UKV) { kb = r / 32; nb = r % 32; W = a.in[I_WUKV] + (size_t)l * 128 * 1024; fp8 = 0; woff = W_UP; ldt = 384; drow0 = 768 + 32 * nb; dcol0 = 256; ks = a.in[I_MKVN] + l * 128; }
    else if ((r -= T_UKV) < T_NAO) { kb = r / 32; nb = r % 32; W = a.in[I_WNAO] + (size_t)l * 384 * 1024; woff = W_NAO; ldt = 512; drow0 = 32 * nb; }
    else if ((r -= T_NAO) < T_MLAO) { kb = r / 32; nb = r % 32; W = a.in[I_WMLAO] + (size_t)l * 512 * 1024; woff = W_MLAO; ldt = 512; drow0 = 32 * nb; }
    else if ((r -= T_MLAO) < T_SWAO) { kb = r / 32; nb = r % 32; W = a.in[I_WSWAO] + (size_t)l * 384 * 1024; woff = W_SWAO; ldt = 512; drow0 = 32 * nb; }
    else if ((r -= T_SWAO) < T_O) { kb = r / 32; nb = r % 32; W = a.in[I_WO] + (size_t)l * 1024 * 1024; woff = W_O; drow0 = 32 * nb; }
    else if ((r -= T_O) < 2 * T_E) {
        const int which = r / T_E, rr = r % T_E, e = rr / 512, t = rr % 512; kb = t / 32; nb = t % 32; const int f0 = 32 * nb;
        W = a.in[which ? I_WUP : I_WGATE] + ((size_t)l * 16 + e) * 1024 * 1024; woff = W_GU + (size_t)e * 2048 * 1024; drow0 = 256 * (f0 >> 7) + 128 * which + (f0 & 127); }
    else { r -= 2 * T_E; const int e = r / 512, t = r % 512; kb = t / 32; nb = t % 32;
        W = a.in[I_WDOWN] + ((size_t)l * 16 + e) * 1024 * 1024; woff = W_DN + (size_t)e * 1024 * 1024; drow0 = 32 * nb; }
    const int k0 = 64 * kb, n0 = 32 * nb; dcol0 += k0;
    unsigned char* WT; { const size_t p = (size_t)(l & 1); WT = a.ws + (woff >= W_DN ? WS_W + woff + p * (16 * MiB) : woff >= W_GU ? WS_W + woff + p * (32 * MiB) : (p ? WS_W2 : WS_W) + woff); }
    const float sc = fp8 ? 32.0f : 1.0f;
    const float* Wl = W + (size_t)(k0 + (lane >> 5)) * ldw + n0 + (lane & 31); LAS float* sl = scr + (lane >> 5) * 33 + (lane & 31);
    if (ks) { ks += k0 + (lane >> 5);
#pragma unroll 8
        for (int i = 0; i < 32; ++i) sl[2 * i * 33] = Wl[(size_t)(2 * i) * ldw] * ks[2 * i]; }
    else {
        float wv[32];
#pragma unroll
        for (int i = 0; i < 32; ++i) wv[i] = Wl[(size_t)(2 * i) * ldw];
#pragma unroll
        for (int i = 0; i < 32; ++i) sl[2 * i * 33] = wv[i] * sc; }
    asm volatile("s_waitcnt lgkmcnt(0)" ::: "memory");
    const int c = lane & 7;
    if (fp8) {
#pragma unroll
        for (int j = 0; j < 4; ++j) { const int n = (lane >> 3) + 8 * j; const LAS float* s = scr + (8 * c) * 33 + n;
            u32x2 o; o.x = pk4_fp8(s[0 * 33], s[1 * 33], s[2 * 33], s[3 * 33]); o.y = pk4_fp8(s[4 * 33], s[5 * 33], s[6 * 33], s[7 * 33]);
            *(u32x2*)(WT + (size_t)(drow0 + n) * ldt + dcol0 + 8 * c) = o; }
    } else {
#pragma unroll
        for (int j = 0; j < 4; ++j) { const int n = (lane >> 3) + 8 * j; const LAS float* s = scr + (8 * c) * 33 + n;
            u32x4 o; o.x = pk2(s[0 * 33], s[1 * 33]); o.y = pk2(s[2 * 33], s[3 * 33]); o.z = pk2(s[4 * 33], s[5 * 33]); o.w = pk2(s[6 * 33], s[7 * 33]);
            *(u32x4*)((bf16_t*)WT + (size_t)(drow0 + n) * ldt + dcol0 + 8 * c) = o; }
    }
    asm volatile("s_waitcnt lgkmcnt(0)" ::: "memory");
}
DI void convert_weights(Frame& F, KArgs ka, int l, int begin) {
    KA_FRESH(ka); const __attribute__((address_space(4))) Args& a = *ka; frame_fresh(F);
    LAS float* scr = (LAS float*)(F.lds + F.wave * 16384);
#pragma nounroll
    for (int it = begin + F.gw; it < NIT; it += F.ngw) cvt_item(a, l, it, scr, F.lane);
    unsigned char* wb = a.ws + ((l & 1) ? WS_W2 : WS_W);
    constexpr int Z0 = 64 * 128, Z1 = 768 * 16, Z2 = 1024 * 32, Z3 = 2 * 1024 * 8;
    unsigned zz = 0u; asm volatile("" : "+v"(zz));
    const u32x4 z = {zz, zz, zz, zz};
    for (int i = blockIdx.x * 512 + F.tid; i < Z0 + Z1 + Z2 + Z3; i += F.G * 512) {
        if (i >= Z0 + Z1 + Z2) { const int j = i - Z0 - Z1 - Z2, which = j >> 13, jj = j & 8191; *(u32x4*)(wb + (which ? W_SWAO : W_NAO) + (size_t)(jj >> 3) * 512 + 384 + (jj & 7) * 16) = z; continue; }
        if (i < Z0) *(u32x4*)((bf16_t*)(wb + W_IN) + (size_t)(2240 + i / 128) * 1024 + (i % 128) * 8) = z;
        else if (i < Z0 + Z1) { const int j = i - Z0; *(u32x4*)((bf16_t*)(wb + W_UP) + (size_t)(j / 16) * 384 + 256 + (j % 16) * 8) = z; }
        else { const int j = i - Z0 - Z1; *(u32x4*)((bf16_t*)(wb + W_UP) + (size_t)(768 + j / 32) * 384 + (j % 32) * 8) = z; }
    }
}
DI void convert_tail(Frame& F, KArgs ka, int l, int first, int q) {
    KA_FRESH(ka); const __attribute__((address_space(4))) Args& a = *ka; frame_fresh(F);
    LAS float* scr = (LAS float*)(F.lds + F.wave * 16384);
#pragma nounroll
    for (int j = 0; j < q; ++j) { const int it = first + 8 * j + F.wave; if (it < NIT) cvt_item(a, l, it, scr, F.lane); }
}


DI void row_phase(Frame& F, KArgs ka, int l, int dry = 0) {
    KA_FRESH(ka); const __attribute__((address_space(4))) Args& a = *ka; frame_fresh(F);
    bf16_t* xs = (bf16_t*)(a.ws + WS_XS);
    const float* modv = (const float*)(a.ws + WS_MODV);
    const int* smap = (const int*)(a.ws + WS_SMAP);
    const bf16_t* Y = (const bf16_t*)(a.ws + WS_Y);
    bf16_t* H = (bf16_t*)(a.ws + WS_R4);
    unsigned char* H8 = a.ws + WS_R4 + 68 * MiB;
    bf16_t* xso = xs; float* outo = a.out;
    if (dry) { unsigned char* tr = a.ws + WS_END + (size_t)F.gw * 16384; xso = (bf16_t*)tr; outo = (float*)tr; H = (bf16_t*)(tr + 8192); H8 = tr + 12288; }
    const int nrows = (l == NL) ? MLAT : MT;
    const bool comb = (l > 0);
    constexpr int RR = 4;
    for (int mb = RR * F.gw; mb < nrows; mb += RR * F.ngw) {
        f32x4 v[RR][4]; int myslot[RR];
#pragma unroll
        for (int rr = 0; rr < RR; ++rr) { const int m = mb + rr;
            if (l == 0) {
                if (F.lane < 16 && !dry) *(u32x4*)(a.ws + WS_OCAT + (size_t)m * OCW + ((F.lane >> 3) ? 1408 : 384) + 16 * (F.lane & 7)) = (u32x4){0u, 0u, 0u, 0u};
                const f32x4* xr = (const f32x4*)(m < MLAT ? a.in[I_X] + (size_t)m * D : a.in[I_CTX] + (size_t)(m - MLAT) * D) + F.lane;
                u32x2* xo = (u32x2*)(xs + (size_t)m * D) + F.lane;
#pragma unroll
                for (int j = 0; j < 4; ++j) { const f32x4 t = xr[64 * j]; u32x2 w; w.x = pk2(t.x, t.y); w.y = pk2(t.z, t.w); if (!dry) xo[64 * j] = w; v[rr][j] = (f32x4){bflo(w.x), bfhi(w.x), bflo(w.y), bfhi(w.y)}; }
            } else {
                const u32x2* xr = (const u32x2*)(xs + (size_t)m * D) + F.lane;
#pragma unroll
                for (int j = 0; j < 4; ++j) { const u32x2 w = xr[64 * j]; v[rr][j] = (f32x4){bflo(w.x), bfhi(w.x), bflo(w.y), bfhi(w.y)}; }
            }
            myslot[rr] = (comb && F.lane < 16) ? smap[(size_t)F.lane * MT + mb + rr] : -1; }
        const int mi = mod_index(mb);
        if (comb) {
            f32x4 acc[RR][4];
            unsigned long long mk[RR];
#pragma unroll
            for (int rr = 0; rr < RR; ++rr) { mk[rr] = __ballot(myslot[rr] >= 0);
#pragma unroll
                for (int j = 0; j < 4; ++j) acc[rr][j] = (f32x4){0.f, 0.f, 0.f, 0.f}; }
            while ((mk[0] | mk[1]) | (mk[2] | mk[3])) {
                u32x2 w[RR][4];
#pragma unroll
                for (int rr = 0; rr < RR; ++rr) {
                    int s = -1;
                    if (mk[rr]) { const int e0 = __builtin_ctzll(mk[rr]); s = __shfl(myslot[rr], e0); mk[rr] &= mk[rr] - 1; }
#pragma unroll
                    for (int j = 0; j < 4; ++j) w[rr][j] = (u32x2){0u, 0u};
                    if (s >= 0) { const u32x2* yr = (const u32x2*)(Y + (size_t)s * D) + F.lane;
#pragma unroll
                        for (int j = 0; j < 4; ++j) w[rr][j] = yr[64 * j]; }
                }
#pragma unroll
                for (int rr = 0; rr < RR; ++rr)
#pragma unroll
                    for (int j = 0; j < 4; ++j) acc[rr][j] += (f32x4){bflo(w[rr][j].x), bfhi(w[rr][j].x), bflo(w[rr][j].y), bfhi(w[rr][j].y)};
            }
            const f32x4* g5 = (const f32x4*)(modv + ((size_t)(l - 1) * 9 + mi) * 6144 + 5 * 1024) + F.lane;
            f32x4 g5v[4];
#pragma unroll
            for (int j = 0; j < 4; ++j) g5v[j] = g5[64 * j];
#pragma unroll
            for (int rr = 0; rr < RR; ++rr) { const int m = mb + rr;
                const size_t ro = dry ? (size_t)rr * 1024 : (size_t)m * D;
#pragma unroll
                for (int j = 0; j < 4; ++j) { v[rr][j] += g5v[j] * acc[rr][j];
                    if (l == NL) ((f32x4*)(outo + ro) + F.lane)[64 * j] = v[rr][j];
                    else { u32x2 w; w.x = pk2(v[rr][j].x, v[rr][j].y); w.y = pk2(v[rr][j].z, v[rr][j].w); ((u32x2*)(xso + ro) + F.lane)[64 * j] = w;
                           v[rr][j] = (f32x4){bflo(w.x), bfhi(w.x), bflo(w.y), bfhi(w.y)}; } } }
        }
        if (l < NL) {
            const f32x4* g = (const f32x4*)(a.in[I_N1G] + l * D) + F.lane;
            const f32x4* sh = (const f32x4*)(modv + ((size_t)l * 9 + mi) * 6144) + F.lane;
            const f32x4* sc = (const f32x4*)(modv + ((size_t)l * 9 + mi) * 6144 + 1024) + F.lane;
            f32x4 gg[4], shv[4];
#pragma unroll
            for (int j = 0; j < 4; ++j) { gg[j] = g[64 * j] * (sc[64 * j] + 1.0f); shv[j] = sh[64 * j]; }
#pragma unroll
            for (int rr = 0; rr < RR; ++rr) { const int m = mb + rr;
                float ss = 0.f;
#pragma unroll
                for (int j = 0; j < 4; ++j) ss += (v[rr][j].x * v[rr][j].x + v[rr][j].y * v[rr][j].y) + (v[rr][j].z * v[rr][j].z + v[rr][j].w * v[rr][j].w);
                const float rstd = __builtin_amdgcn_rsqf(wave_sum(ss) * (1.f / D) + EPS);
                u32x2* o = (u32x2*)(H + (dry ? (size_t)rr * 1024 : (size_t)m * D)) + F.lane;
                unsigned* o8 = (unsigned*)(H8 + (dry ? (size_t)rr * 1024 : (size_t)m * D)) + F.lane;
#pragma unroll
                for (int j = 0; j < 4; ++j) { const f32x4 hh = v[rr][j] * rstd * gg[j] + shv[j]; u32x2 w; w.x = pk2(hh.x, hh.y); w.y = pk2(hh.z, hh.w); o[64 * j] = w;
                    o8[64 * j] = pk4_fp8(hh.x, hh.y, hh.z, hh.w); } }
        }
    }
}

DI void rope_cs(int d, int prow, int pcol, float& cs, float& sn) {
    const int i = d & 15; const float pos = (float)((d & 32) ? pcol : prow);
    const float inv = __builtin_amdgcn_exp2f(-(float)i * (13.287712379549449f / 16.0f));
    const float rev = pos * inv * 0.15915494309189535f;
    const float fr = rev - floorf(rev);
    cs = __builtin_amdgcn_cosf(fr); sn = __builtin_amdgcn_sinf(fr);
}
DI void prep_phase(Frame& F, KArgs ka, int l) {
    KA_FRESH(ka); const __attribute__((address_space(4))) Args& a = *ka; frame_fresh(F);
    const bf16_t* HW = (const bf16_t*)(a.ws + WS_HW);
    bf16_t* P1 = (bf16_t*)(a.ws + WS_P1);
    const float sc64 = 0.125f * LOG2E;
    const int d0 = 8 * (F.lane & 7);
    float gn[3][8]; int srcc[3]; bool ropei[3], acti[3];
    const float* gp0 = a.in[I_NAQG]; const float* gp1 = a.in[I_NAKG]; const float* gp2 = a.in[I_SWQG]; const float* gp3 = a.in[I_SWKG];
#pragma unroll
    for (int i = 0; i < 3; ++i) { const int c = F.lane + 64 * i, col = 8 * c; acti[i] = c < 160;
        const int ty = col < 384 ? 0 : col < 768 ? 1 : col < 1152 ? 2 : 3;
        srcc[i] = col < 768 ? col : col + (C_SWQ - 768);
        ropei[i] = ty >= 2;
        const float sc = (ty == 0 || ty == 2) ? sc64 : 1.0f;
#pragma unroll
        for (int j = 0; j < 8; ++j) { const float g0 = gp0[l * 64 + d0 + j], g1 = gp1[l * 64 + d0 + j], g2 = gp2[l * 64 + d0 + j], g3 = gp3[l * 64 + d0 + j];
            gn[i][j] = acti[i] ? (ty == 0 ? g0 : ty == 1 ? g1 : ty == 2 ? g2 : g3) * sc : 0.f; } }
    float invf[8];
#pragma unroll
    for (int j = 0; j < 8; ++j) invf[j] = __builtin_amdgcn_exp2f(-(float)((d0 & 8) + j) * (13.287712379549449f / 16.0f)) * 0.15915494309189535f;
    const bool second = (d0 & 16) != 0, usecol = (d0 & 32) != 0;
    for (int mb = 2 * F.gw; mb < MT; mb += 2 * F.ngw) {
        u32x4 w[2][3];
#pragma unroll
        for (int rr = 0; rr < 2; ++rr)
#pragma unroll
            for (int i = 0; i < 3; ++i) if (acti[i]) w[rr][i] = *(const u32x4*)(HW + (size_t)(mb + rr) * DINP + srcc[i]); else w[rr][i] = (u32x4){0u, 0u, 0u, 0u};
#pragma unroll
        for (int rr = 0; rr < 2; ++rr) {
            const int m = mb + rr; const bool lat = m < MLAT; const int s = m & 4095; const float prw = (float)(s >> 6), pcl = (float)(s & 63); float pos = usecol ? pcl : prw; asm volatile("" : "+v"(pos));
            float cs[8], sn[8];
#pragma unroll
            for (int j = 0; j < 8; ++j) { cs[j] = 1.f; sn[j] = 0.f; }
            if (lat) {
#pragma unroll
                for (int j = 0; j < 8; ++j) { const float rev = pos * invf[j], fr = rev - floorf(rev); cs[j] = __builtin_amdgcn_cosf(fr); sn[j] = __builtin_amdgcn_sinf(fr); } }
#pragma unroll
            for (int i = 0; i < 3; ++i) {
                float x[8] = {bflo(w[rr][i].x), bfhi(w[rr][i].x), bflo(w[rr][i].y), bfhi(w[rr][i].y), bflo(w[rr][i].z), bfhi(w[rr][i].z), bflo(w[rr][i].w), bfhi(w[rr][i].w)};
                float ss = 0.f;
#pragma unroll
                for (int j = 0; j < 8; ++j) ss += x[j] * x[j];
                ss += __shfl_xor(ss, 1); ss += __shfl_xor(ss, 2); ss += __shfl_xor(ss, 4);
                const float rs = __builtin_amdgcn_rsqf(ss * (1.f / 64.f) + EPS);
#pragma unroll
                for (int j = 0; j < 8; ++j) x[j] *= rs * gn[i][j];
                const bool rp = ropei[i] && lat;
#pragma unroll
                for (int j = 0; j < 8; ++j) { const float y = __int_as_float(__builtin_amdgcn_ds_bpermute((F.lane ^ 2) << 2, __float_as_int(x[j]))); const float rot = second ? x[j] * cs[j] + y * sn[j] : x[j] * cs[j] - y * sn[j]; x[j] = rp ? rot : x[j]; }
                if (acti[i]) { u32x4 o; o.x = pk2(x[0], x[1]); o.y = pk2(x[2], x[3]); o.z = pk2(x[4], x[5]); o.w = pk2(x[6], x[7]);
                    *(u32x4*)(P1 + (size_t)m * P1W + 8 * (F.lane + 64 * i)) = o; }
            }
        }
    }
}
DI void prep2_phase(Frame& F, KArgs ka, int l, int dry = 0) {
    KA_FRESH(ka); const __attribute__((address_space(4))) Args& a = *ka; frame_fresh(F);
    const bf16_t* HW = (const bf16_t*)(a.ws + WS_HW);
    bf16_t* U = (bf16_t*)(a.ws + WS_R4);
    bf16_t* P2 = (bf16_t*)(a.ws + WS_P2);
    const float scq = 0.07216878364870322f * LOG2E;
    const int ln = F.lane, q = ln & 15, h = ln >> 4;
    float qgn[8], qgr[4], kgn[8], kgr[4], invf[4];
    { const float* qg = a.in[I_MQG] + l * 192; const float* kg = a.in[I_MKG] + l * 192;
#pragma unroll
      for (int j = 0; j < 8; ++j) { qgn[j] = qg[8 * q + j] * scq; kgn[j] = kg[8 * q + j]; }
#pragma unroll
      for (int j = 0; j < 4; ++j) { qgr[j] = qg[128 + 4 * q + j] * scq; kgr[j] = kg[128 + 4 * q + j];
          invf[j] = __builtin_amdgcn_exp2f(-(float)(4 * (q & 3) + j) * (13.287712379549449f / 16.0f)) * 0.15915494309189535f; } }
    const bool second = (q & 4) != 0, usecol = (q & 8) != 0;
    const int pl = (ln ^ 4) << 2;
    for (int mb = 2 * F.gw; mb < MT; mb += 2 * F.ngw) {
        u32x2 wcq[2], wqr[2], wkr[2]; unsigned wckv[2]; u32x4 wqn[2], wkn[2], wv[2];
#pragma unroll
        for (int rr = 0; rr < 2; ++rr) { const bf16_t* hr = HW + (size_t)(mb + rr) * DINP; const bf16_t* ur = U + (size_t)(mb + rr) * UW;
            wcq[rr] = *(const u32x2*)(hr + C_CQ + 4 * ln); wckv[rr] = *(const unsigned*)(hr + C_CKV + 2 * ln); wkr[rr] = *(const u32x2*)(hr + C_KR + 4 * q);
            wqn[rr] = *(const u32x4*)(ur + h * 192 + 8 * q); wqr[rr] = *(const u32x2*)(ur + h * 192 + 128 + 4 * q);
            wkn[rr] = *(const u32x4*)(ur + 768 + h * 256 + 8 * q); wv[rr] = *(const u32x4*)(ur + 768 + h * 256 + 128 + 8 * q); }
#pragma unroll
        for (int rr = 0; rr < 2; ++rr) {
            const int m = mb + rr; const bool lat = m < MLAT; const int s = m & 4095;
            bf16_t* ur = U + (size_t)m * UW; bf16_t* pr = P2 + (size_t)m * P2W;
            if (dry) { ur = (bf16_t*)(a.ws + WS_END + (size_t)F.gw * 8192); pr = ur + 2048; }
            float rq, rkv;
            { const float a0 = bflo(wcq[rr].x), a1 = bfhi(wcq[rr].x), a2 = bflo(wcq[rr].y), a3 = bfhi(wcq[rr].y);
              rq = __builtin_amdgcn_rsqf(wave_sum(a0 * a0 + a1 * a1 + a2 * a2 + a3 * a3) * (1.f / 256.f) + EPS); }
            { const float a0 = bflo(wckv[rr]), a1 = bfhi(wckv[rr]);
              rkv = __builtin_amdgcn_rsqf(wave_sum(a0 * a0 + a1 * a1) * (1.f / 128.f) + EPS); }
            float cs[4], sn[4];
            { const float prw = (float)(s >> 6), pcl = (float)(s & 63); float pos = usecol ? pcl : prw; asm volatile("" : "+v"(pos));
#pragma unroll
              for (int j = 0; j < 4; ++j) { const float rev = pos * invf[j], fr = rev - floorf(rev); cs[j] = lat ? __builtin_amdgcn_cosf(fr) : 1.f; sn[j] = lat ? __builtin_amdgcn_sinf(fr) : 0.f; } }
#pragma unroll
            for (int isk = 0; isk < 2; ++isk) {
                const u32x4 wn = isk ? wkn[rr] : wqn[rr]; const u32x2 wr2 = isk ? wkr[rr] : wqr[rr];
                const float sn_ = isk ? rkv : rq, sr_ = isk ? 1.0f : rq;
                float x[8] = {bflo(wn.x) * sn_, bfhi(wn.x) * sn_, bflo(wn.y) * sn_, bfhi(wn.y) * sn_, bflo(wn.z) * sn_, bfhi(wn.z) * sn_, bflo(wn.w) * sn_, bfhi(wn.w) * sn_};
                float y[4] = {bflo(wr2.x) * sr_, bfhi(wr2.x) * sr_, bflo(wr2.y) * sr_, bfhi(wr2.y) * sr_};
                float ss = 0.f;
#pragma unroll
                for (int j = 0; j < 8; ++j) ss += x[j] * x[j];
#pragma unroll
                for (int j = 0; j < 4; ++j) ss += y[j] * y[j];
                ss += __shfl_xor(ss, 1); ss += __shfl_xor(ss, 2); ss += __shfl_xor(ss, 4); ss += __shfl_xor(ss, 8);
                const float rs = __builtin_amdgcn_rsqf(ss * (1.f / 192.f) + EPS);
#pragma unroll
                for (int j = 0; j < 8; ++j) x[j] *= rs * (isk ? kgn[j] : qgn[j]);
#pragma unroll
                for (int j = 0; j < 4; ++j) { y[j] *= rs * (isk ? kgr[j] : qgr[j]);
                    const float p = __int_as_float(__builtin_amdgcn_ds_bpermute(pl, __float_as_int(y[j])));
                    y[j] = second ? y[j] * cs[j] + p * sn[j] : y[j] * cs[j] - p * sn[j]; }
                u32x4 o; o.x = pk2(x[0], x[1]); o.y = pk2(x[2], x[3]); o.z = pk2(x[4], x[5]); o.w = pk2(x[6], x[7]);
                u32x2 o2; o2.x = pk2(y[0], y[1]); o2.y = pk2(y[2], y[3]);
                *(u32x4*)(pr + 768 * isk + h * 192 + 8 * q) = o; *(u32x2*)(pr + 768 * isk + h * 192 + 128 + 4 * q) = o2;
            }
            { const u32x4 vw = wv[rr]; u32x4 o; o.x = pk2(bflo(vw.x) * rkv, bfhi(vw.x) * rkv); o.y = pk2(bflo(vw.y) * rkv, bfhi(vw.y) * rkv); o.z = pk2(bflo(vw.z) * rkv, bfhi(vw.z) * rkv); o.w = pk2(bflo(vw.w) * rkv, bfhi(vw.w) * rkv);
              *(u32x4*)(ur + 768 + h * 256 + 128 + 8 * q) = o; }
        }
    }
}

struct AU {
    const bf16_t *q, *k, *v; unsigned char* o;
    int ldq, ldk, ldv, ldo;
    int qrow0;
    int lat_row0, n_lat, ctx_row0, n_ctx;
    int mode;
    int qpos0, kpos0;
    float m0, l0;
    const float* rpb;
};
#define AT_PIN16(b) asm volatile("" : "+v"(b[0]), "+v"(b[1]), "+v"(b[2]), "+v"(b[3]), "+v"(b[4]), "+v"(b[5]), "+v"(b[6]), "+v"(b[7]), "+v"(b[8]), "+v"(b[9]), "+v"(b[10]), "+v"(b[11]), "+v"(b[12]), "+v"(b[13]), "+v"(b[14]), "+v"(b[15]))
#define AT_PIN4(b, j) asm volatile("" : "+v"(b[j]), "+v"(b[j + 1]), "+v"(b[j + 2]), "+v"(b[j + 3]))
template <int NDT, int VP, int P>
DI void att_tail(f32x16& s0, f32x16& s1, f32x16 (&o)[NDT], float& mrun, float& lrun, const LAS unsigned char* Vt, int vlane_off, const LAS float* bp, int cs, int h) {
    constexpr float MTHR = 11.5f;
#define AT_A0(i) (P != 1 || (i) >= 12)
#define AT_A1(i) (P != 0 || (i) < 4)
    if constexpr (P >= 0) {
        float bb[16];
        if constexpr (P == 0) {
#pragma unroll
            for (int i = 0; i < 16; ++i) bb[i] = bp[(i & 3) + 8 * (i >> 2)];
            AT_PIN16(bb);
#pragma unroll
            for (int i = 0; i < 16; ++i) { const int kc = (i & 3) + 8 * (i >> 2) + 4 * h; const bool ok = (kc >= cs) && (kc < cs + 16); s0[i] = ok ? s0[i] + bb[i] : -INFINITY; }
#pragma unroll
            for (int i = 0; i < 4; ++i) bb[i] = bp[32 + i];
            AT_PIN4(bb, 0);
#pragma unroll
            for (int i = 0; i < 4; ++i) { const int kc = 32 + i + 4 * h; const bool ok = (kc >= cs) && (kc < cs + 16); s1[i] = ok ? s1[i] + bb[i] : -INFINITY; }
        } else {
#pragma unroll
            for (int i = 12; i < 16; ++i) bb[i] = bp[24 + (i & 3)];
            AT_PIN4(bb, 12);
#pragma unroll
            for (int i = 12; i < 16; ++i) { const int kc = 24 + (i & 3) + 4 * h; const bool ok = (kc >= cs) && (kc < cs + 16); s0[i] = ok ? s0[i] + bb[i] : -INFINITY; }
#pragma unroll
            for (int i = 0; i < 16; ++i) bb[i] = bp[32 + (i & 3) + 8 * (i >> 2)];
            AT_PIN16(bb);
#pragma unroll
            for (int i = 0; i < 16; ++i) { const int kc = 32 + (i & 3) + 8 * (i >> 2) + 4 * h; const bool ok = (kc >= cs) && (kc < cs + 16); s1[i] = ok ? s1[i] + bb[i] : -INFINITY; }
        }
    }
    float mx = (P == 1) ? s1[0] : s0[0];
#pragma unroll
    for (int i = 0; i < 16; ++i) { if (AT_A0(i)) mx = fmaxf(mx, s0[i]); if (AT_A1(i)) mx = fmaxf(mx, s1[i]); }
    mx = fmaxf(mx, __shfl_xor(mx, 32));
    if (__builtin_amdgcn_ballot_w64(mx > mrun + MTHR) != 0ull) {
        const float mnew = fmaxf(mrun, mx), alpha = __builtin_amdgcn_exp2f(mrun - mnew);
        lrun *= alpha; mrun = mnew;
#pragma unroll
        for (int dt = 0; dt < NDT; ++dt)
#pragma unroll
            for (int i = 0; i < 16; ++i) o[dt][i] *= alpha;
    }
    float ls = 0.f;
#pragma unroll
    for (int i = 0; i < 16; ++i) {
        if (AT_A0(i)) { s0[i] = __builtin_amdgcn_exp2f(s0[i] - mrun); ls += s0[i]; } else s0[i] = 0.f;
        if (AT_A1(i)) { s1[i] = __builtin_amdgcn_exp2f(s1[i] - mrun); ls += s1[i]; } else s1[i] = 0.f;
    }
    lrun += ls;
    bf16x8 pf[4];
    { u32x4 w;
      w.x = pk2(s0[0], s0[1]); w.y = pk2(s0[2], s0[3]); w.z = pk2(s0[4], s0[5]); w.w = pk2(s0[6], s0[7]); pf[0] = __builtin_bit_cast(bf16x8, w);
      if (P == 1) { w.x = 0u; w.y = 0u; } else { w.x = pk2(s0[8], s0[9]); w.y = pk2(s0[10], s0[11]); } w.z = pk2(s0[12], s0[13]); w.w = pk2(s0[14], s0[15]); pf[1] = __builtin_bit_cast(bf16x8, w);
      w.x = pk2(s1[0], s1[1]); w.y = pk2(s1[2], s1[3]); if (P == 0) { w.z = 0u; w.w = 0u; } else { w.z = pk2(s1[4], s1[5]); w.w = pk2(s1[6], s1[7]); } pf[2] = __builtin_bit_cast(bf16x8, w);
      w.x = pk2(s1[8], s1[9]); w.y = pk2(s1[10], s1[11]); w.z = pk2(s1[12], s1[13]); w.w = pk2(s1[14], s1[15]); pf[3] = __builtin_bit_cast(bf16x8, w); }
#pragma unroll
    for (int kk = 0; kk < 4; ++kk) {
        if ((P == 0 && kk == 3) || (P == 1 && kk == 0)) continue;
#pragma unroll
        for (int dt = 0; dt < NDT; ++dt) {
            const LAS unsigned char* vp = Vt + (16 * kk) * VP + vlane_off + 64 * dt;
            const s16x4 lo = __builtin_amdgcn_ds_read_tr16_b64_v4i16((LAS s16x4*)vp);
            const s16x4 hi = __builtin_amdgcn_ds_read_tr16_b64_v4i16((LAS s16x4*)(vp + 8 * VP));
            const bf16x8 vf = __builtin_shufflevector(lo, hi, 0, 1, 2, 3, 4, 5, 6, 7);
            o[dt] = __builtin_amdgcn_mfma_f32_32x32x16_bf16(vf, pf[kk], o[dt], 0, 0, 0);
        }
    }
#undef AT_A0
#undef AT_A1
}
template <int DQ, int DV, int LDK, int LDV>
DI void attn_unit(LAS unsigned char* lds, const AU& u, int tid, int wave, int lane) {
    constexpr int KP = DQ * 2 + 16, VP = DV * 2 + 64, KBY = 64 * KP, VBY = 64 * VP, STG = KBY + VBY;
    constexpr int NKS = DQ / 16, NDT = DV / 32, KCH = DQ / 8, VCH = DV / 8;
    constexpr int KC = KP / 16, VC = VP / 16;
    constexpr int KI = (KC + 7) / 8, VI = (VC + 7) / 8;
    constexpr int BIAS_OFF = 98304;
    static_assert(2 * STG <= BIAS_OFF && KBY % 1024 == 0 && VBY % 1024 == 0, "attention LDS");
    const int r = lane & 31, h = lane >> 5;
    const int nt = u.n_lat + u.n_ctx;
    LAS float* btab = (LAS float*)(lds + BIAS_OFF);
    if (u.mode == 2) { for (int i = tid; i < 15 * 31; i += 512) btab[i] = u.rpb[i] * LOG2E; }
    bf16x8 qf[NKS];
    { const bf16_t* qp = u.q + (size_t)(u.qrow0 + wave * 32 + r) * u.ldq + 8 * h;
#pragma unroll
      for (int ks = 0; ks < NKS; ++ks) qf[ks] = *(const bf16x8*)(qp + 16 * ks); }
    f32x16 o[NDT];
#pragma unroll
    for (int dt = 0; dt < NDT; ++dt)
#pragma unroll
        for (int i = 0; i < 16; ++i) o[dt][i] = 0.f;
    float mrun = u.m0, lrun = (h == 0) ? u.l0 : 0.f;
    unsigned koff[KI], voff[VI];
#pragma unroll
    for (int i = 0; i < KI; ++i) { const int c = 64 * (wave + 8 * i) + lane, row = c / KC, cc = c % KC; koff[i] = (unsigned)(row * LDK * 2 + (cc < KCH ? cc : KCH - 1) * 16); }
#pragma unroll
    for (int i = 0; i < VI; ++i) { const int c = 64 * (wave + 8 * i) + lane, row = c / VC, cc = c % VC; voff[i] = (unsigned)(row * LDV * 2 + (cc < VCH ? cc : VCH - 1) * 16); }
#define AT_ROWBASE(t) ((t) < u.n_lat ? u.lat_row0 + 64 * (t) : u.ctx_row0 + 64 * ((t) - u.n_lat))
#define AT_ISSUE(t, buf) do { const int rb_ = AT_ROWBASE(t); const char* kb_ = (const char*)(u.k + (size_t)rb_ * LDK); const char* vb_ = (const char*)(u.v + (size_t)rb_ * LDV); \
        _Pragma("unroll") for (int i_ = 0; i_ < KI; ++i_) { const int j_ = wave + 8 * i_; if (j_ < KC) __builtin_amdgcn_global_load_lds((const unsigned*)(kb_ + koff[i_]), (LAS unsigned*)(lds + (buf) * STG + j_ * 1024), 16, 0, 0); } \
        _Pragma("unroll") for (int i_ = 0; i_ < VI; ++i_) { const int j_ = wave + 8 * i_; if (j_ < VC) __builtin_amdgcn_global_load_lds((const unsigned*)(vb_ + voff[i_]), (LAS unsigned*)(lds + (buf) * STG + KBY + j_ * 1024), 16, 0, 0); } } while (0)
    AT_ISSUE(0, 0);
    asm volatile("s_waitcnt vmcnt(0)" ::: "memory");
    __syncthreads();
    const int tq = (lane & 15) >> 2, tp = lane & 3, tblk = (lane >> 4) & 1;
    const int vlane_off = (4 * h + tq) * VP + 32 * tblk + 8 * tp;
    for (int t = 0; t < nt; ++t) {
        const int buf = t & 1;
        if (t + 1 < nt) AT_ISSUE(t + 1, buf ^ 1);
        bool skip = false; int a0 = 0, a1 = 0;
        bool inband = false;
        if (u.mode == 1 && t < u.n_lat) { const int k0 = u.kpos0 + 64 * t, q0 = u.qpos0 + 32 * wave; skip = (k0 > q0 + 31 + 128) || (k0 + 63 < q0 - 128); a0 = k0; a1 = q0; inband = (k0 >= q0 + 31 - 128) && (k0 + 63 <= q0 + 128); }
        if (u.mode == 2 && t < u.n_lat) { const int kr = u.kpos0 + t, qr = u.qpos0 + (wave >> 1); int rs = qr - 4; rs = rs < 0 ? 0 : (rs > 56 ? 56 : rs); skip = (kr < rs) || (kr >= rs + 8); a0 = kr - qr + 7; }
        if (!skip) {
            const LAS unsigned char* Kt = lds + buf * STG; const LAS unsigned char* Vt = Kt + KBY;
            f32x16 s0, s1;
#pragma unroll
            for (int i = 0; i < 16; ++i) { s0[i] = 0.f; s1[i] = 0.f; }
#pragma unroll
            for (int ks = 0; ks < NKS; ++ks) {
                const bf16x8 k0 = *(const LAS bf16x8*)(Kt + r * KP + (16 * ks + 8 * h) * 2);
                const bf16x8 k1 = *(const LAS bf16x8*)(Kt + (32 + r) * KP + (16 * ks + 8 * h) * 2);
                s0 = __builtin_amdgcn_mfma_f32_32x32x16_bf16(k0, qf[ks], s0, 0, 0, 0);
                s1 = __builtin_amdgcn_mfma_f32_32x32x16_bf16(k1, qf[ks], s1, 0, 0, 0);
            }
            if (u.mode == 1 && t < u.n_lat && !inband) {
                const int qpos = a1 + r;
#pragma unroll
                for (int i = 0; i < 16; ++i) { const int kk = a0 + (i & 3) + 8 * (i >> 2) + 4 * h; int d0 = qpos - kk; d0 = d0 < 0 ? -d0 : d0; int d1 = qpos - (kk + 32); d1 = d1 < 0 ? -d1 : d1;
                    s0[i] = d0 <= 128 ? s0[i] : -INFINITY; s1[i] = d1 <= 128 ? s1[i] : -INFINITY; }
            }
            if (DQ == 64 && u.mode == 2 && t < u.n_lat) {
                const int qc = 32 * (wave & 1) + r; int cs = qc - 8; cs = cs < 0 ? 0 : (cs > 48 ? 48 : cs);
                const LAS float* bp = btab + (a0 * 31 + 15 - qc + 4 * h);
                if ((wave & 1) == 0) att_tail<NDT, VP, (DQ == 64 ? 0 : -1)>(s0, s1, o, mrun, lrun, Vt, vlane_off, bp, cs, h);
                else att_tail<NDT, VP, (DQ == 64 ? 1 : -1)>(s0, s1, o, mrun, lrun, Vt, vlane_off, bp, cs, h);
            } else att_tail<NDT, VP, -1>(s0, s1, o, mrun, lrun, Vt, vlane_off, nullptr, 0, h);
        }
        asm volatile("s_waitcnt vmcnt(0)" ::: "memory");
        __syncthreads();
    }
    const float ltot = lrun + __shfl_xor(lrun, 32), inv = 1.0f / ltot;
    unsigned char* op = u.o + (size_t)(u.qrow0 + wave * 32 + r) * u.ldo + 4 * h;
    const float inv4 = inv * 4.0f;
#pragma unroll
    for (int dt = 0; dt < NDT; ++dt)
#pragma unroll
        for (int g = 0; g < 4; ++g) *(unsigned*)(op + 32 * dt + 8 * g) = pk4_fp8(o[dt][4 * g] * inv4, o[dt][4 * g + 1] * inv4, o[dt][4 * g + 2] * inv4, o[dt][4 * g + 3] * inv4);
#undef AT_ROWBASE
#undef AT_ISSUE
}

DI void attn_phase(Frame& F, KArgs ka, int l) {
    KA_FRESH(ka); const __attribute__((address_space(4))) Args& a = *ka; frame_fresh(F);
    const bf16_t* HW = (const bf16_t*)(a.ws + WS_HW);
    const bf16_t* P1 = (const bf16_t*)(a.ws + WS_P1);
    const bf16_t* P2 = (const bf16_t*)(a.ws + WS_P2);
    const bf16_t* U = (const bf16_t*)(a.ws + WS_R4);
    unsigned char* OC = a.ws + WS_OCAT;
    const bool last = (l == NL - 1);
    constexpr int nA = 512, nB = 768, nC = 768;
    const int ntot = nA + nB + nC + (last ? 0 : 128);
#ifndef ATT_PROBE
#define ATT_PROBE 0
#endif
    for (int rep2_ = 0; rep2_ < 1 + (ATT_PROBE != 0); ++rep2_)
    for (int id = F.vcu; id < ntot; id += F.G) {
        if (rep2_ == 1 && !((ATT_PROBE == 1) ? (id < nA) : (id >= nA && id < nA + nB))) continue;
        AU u; bool big = false;
        u.mode = 0; u.qpos0 = 0; u.kpos0 = 0; u.m0 = -1e30f; u.l0 = 0.f; u.rpb = nullptr; u.n_ctx = 4;
        if (id < nA) {
            const int b = id >> 6, h = (id >> 4) & 3, qb = id & 15; big = true;
            u.q = P2 + h * 192; u.ldq = P2W; u.k = P2 + 768 + h * 192; u.ldk = P2W; u.v = U + 768 + h * 256 + 128; u.ldv = UW; u.o = OC + 512 + h * 128; u.ldo = OCW;
            u.qrow0 = b * SEQ + qb * 256; u.lat_row0 = b * SEQ; u.n_lat = 64; u.ctx_row0 = MLAT + b * CTX;
        } else if (id < nA + nB) {
            const int j = id - nA, b = j / 96, h = (j >> 4) % 6, qb = j & 15;
            u.q = P1 + h * 64; u.ldq = P1W; u.k = P1 + 384 + h * 64; u.ldk = P1W; u.v = HW + C_NAV + h * 64; u.ldv = DINP; u.o = OC + h * 64; u.ldo = OCW;
            int rlo = 4 * qb - 4; rlo = rlo < 0 ? 0 : (rlo > 56 ? 56 : rlo); int rhi = 4 * qb + 3 - 4; rhi = (rhi < 0 ? 0 : (rhi > 56 ? 56 : rhi)) + 7;
            u.qrow0 = b * SEQ + qb * 256; u.lat_row0 = b * SEQ + rlo * 64; u.n_lat = rhi - rlo + 1; u.ctx_row0 = MLAT + b * CTX;
            u.mode = 2; u.qpos0 = 4 * qb; u.kpos0 = rlo; u.rpb = a.in[I_RPB] + (size_t)(l * 6 + h) * 465;
        } else if (id < nA + nB + nC) {
            const int j = id - nA - nB, b = j / 96, hq = (j >> 4) % 6, qb = j & 15, kvh = hq / 3;
            u.q = P1 + 768 + hq * 64; u.ldq = P1W; u.k = P1 + 1152 + kvh * 64; u.ldk = P1W; u.v = HW + C_SWV + kvh * 64; u.ldv = DINP; u.o = OC + 1024 + hq * 64; u.ldo = OCW;
            int klo = qb * 256 - 128; klo = klo < 0 ? 0 : klo; int khi = qb * 256 + 384; khi = khi > SEQ ? SEQ : khi;
            u.qrow0 = b * SEQ + qb * 256; u.lat_row0 = b * SEQ + klo; u.n_lat = (khi - klo) >> 6; u.ctx_row0 = MLAT + b * CTX;
            u.mode = 1; u.qpos0 = qb * 256; u.kpos0 = klo; u.m0 = a.in[I_SINK][l * 6 + hq] * LOG2E; u.l0 = 1.f;
        } else {
            const int j = id - nA - nB - nC;
            u.n_lat = 0; u.lat_row0 = 0;
            if (j < 32) { const int b = j >> 2, h = j & 3; big = true;
                u.q = P2 + h * 192; u.ldq = P2W; u.k = P2 + 768 + h * 192; u.ldk = P2W; u.v = U + 768 + h * 256 + 128; u.ldv = UW; u.o = OC + 512 + h * 128; u.ldo = OCW;
                u.qrow0 = MLAT + b * CTX; u.ctx_row0 = MLAT + b * CTX;
            } else if (j < 80) { const int jj = j - 32, b = jj / 6, h = jj % 6;
                u.q = P1 + h * 64; u.ldq = P1W; u.k = P1 + 384 + h * 64; u.ldk = P1W; u.v = HW + C_NAV + h * 64; u.ldv = DINP; u.o = OC + h * 64; u.ldo = OCW;
                u.qrow0 = MLAT + b * CTX; u.ctx_row0 = MLAT + b * CTX;
            } else { const int jj = j - 80, b = jj / 6, hq = jj % 6, kvh = hq / 3;
                u.q = P1 + 768 + hq * 64; u.ldq = P1W; u.k = P1 + 1152 + kvh * 64; u.ldk = P1W; u.v = HW + C_SWV + kvh * 64; u.ldv = DINP; u.o = OC + 1024 + hq * 64; u.ldo = OCW;
                u.qrow0 = MLAT + b * CTX; u.ctx_row0 = MLAT + b * CTX; u.m0 = a.in[I_SINK][l * 6 + hq] * LOG2E; u.l0 = 1.f;
            }
        }
        if (big) attn_unit<192, 128, P2W, UW>(F.lds, u, F.tid, F.wave, F.lane);
        else attn_unit<64, 64, P1W, DINP>(F.lds, u, F.tid, F.wave, F.lane);
    }
}

DI void norm2_phase(Frame& F, KArgs ka, int l, int nrows) {
    KA_FRESH(ka); const __attribute__((address_space(4))) Args& a = *ka; frame_fresh(F);
    LAS float* rt = (LAS float*)F.lds;
    const float* rg = a.in[I_ROUTER] + (size_t)l * 1024 * 16;
    for (int i = F.tid; i < 16384; i += 512) rt[i] = rg[i];
    __syncthreads();
    LAS float* xr = (LAS float*)(F.lds + 65536 + F.wave * 8192);
    const bf16_t* xs = (const bf16_t*)(a.ws + WS_XS);
    const float* modv = (const float*)(a.ws + WS_MODV);
    unsigned char* H2 = a.ws + WS_H2;
    float* AFL = (float*)(a.ws + WS_AFL); float* AFC = (float*)(a.ws + WS_AFC);
    const int eq = F.lane & 3, kq = F.lane >> 2;
    u32x2 xw[2][4];
#define N2_LOAD(mb_) do { _Pragma("unroll") for (int rr_ = 0; rr_ < 2; ++rr_) { const u32x2* xp_ = (const u32x2*)(xs + (size_t)((mb_) + rr_) * D) + F.lane; \
        _Pragma("unroll") for (int j_ = 0; j_ < 4; ++j_) xw[rr_][j_] = xp_[64 * j_]; } } while (0)
    if (2 * F.gw < nrows) N2_LOAD(2 * F.gw);
    for (int mb = 2 * F.gw; mb < nrows; mb += 2 * F.ngw) {
        const int mi = mod_index(mb);
        f32x4 v[2][4];
#pragma unroll
        for (int rr = 0; rr < 2; ++rr)
#pragma unroll
            for (int j = 0; j < 4; ++j) { const u32x2 w = xw[rr][j]; v[rr][j] = (f32x4){bflo(w.x), bfhi(w.x), bflo(w.y), bfhi(w.y)}; }
        if (mb + 2 * F.ngw < nrows) N2_LOAD(mb + 2 * F.ngw);
        const f32x4* g = (const f32x4*)(a.in[I_N2G] + l * D) + F.lane;
        const f32x4* sh = (const f32x4*)(modv + ((size_t)l * 9 + mi) * 6144 + 3 * 1024) + F.lane;
        const f32x4* sc = (const f32x4*)(modv + ((size_t)l * 9 + mi) * 6144 + 4 * 1024) + F.lane;
        f32x4 gg[4], shv[4];
#pragma unroll
        for (int j = 0; j < 4; ++j) { gg[j] = g[64 * j] * (sc[64 * j] + 1.0f); shv[j] = sh[64 * j]; }
#pragma unroll
        for (int rr = 0; rr < 2; ++rr) {
            float ss = 0.f;
#pragma unroll
            for (int j = 0; j < 4; ++j) ss += (v[rr][j].x * v[rr][j].x + v[rr][j].y * v[rr][j].y) + (v[rr][j].z * v[rr][j].z + v[rr][j].w * v[rr][j].w);
            const float rstd = __builtin_amdgcn_rsqf(wave_sum(ss) * (1.f / D) + EPS);
            unsigned* o = (unsigned*)(H2 + (size_t)(mb + rr) * D) + F.lane;
#pragma unroll
            for (int j = 0; j < 4; ++j) { const f32x4 hh = v[rr][j] * rstd * gg[j] + shv[j]; o[64 * j] = pk4_fp8(hh.x, hh.y, hh.z, hh.w);
                *(LAS f32x4*)(xr + rr * 1024 + 4 * F.lane + 256 * j) = hh; }
        }
        asm volatile("s_waitcnt lgkmcnt(0)" ::: "memory");
        f32x4 acc[2] = {{0.f, 0.f, 0.f, 0.f}, {0.f, 0.f, 0.f, 0.f}};
#pragma unroll 8
        for (int i = 0; i < 64; ++i) { const int k = kq + 16 * i; const float x0 = xr[k], x1 = xr[1024 + k]; const f32x4 w = *(const LAS f32x4*)(rt + k * 16 + 4 * eq); acc[0] += w * x0; acc[1] += w * x1; }
        asm volatile("s_waitcnt lgkmcnt(0)" ::: "memory");
#pragma unroll
        for (int rr = 0; rr < 2; ++rr) { const int m = mb + rr; f32x4 ac = acc[rr];
#pragma unroll
            for (int ofs = 4; ofs < 64; ofs <<= 1) { ac.x += __shfl_xor(ac.x, ofs); ac.y += __shfl_xor(ac.y, ofs); ac.z += __shfl_xor(ac.z, ofs); ac.w += __shfl_xor(ac.w, ofs); }
            float mx = fmaxf(fmaxf(ac.x, ac.y), fmaxf(ac.z, ac.w)); mx = fmaxf(mx, __shfl_xor(mx, 1)); mx = fmaxf(mx, __shfl_xor(mx, 2));
            f32x4 ex; ex.x = __expf(ac.x - mx); ex.y = __expf(ac.y - mx); ex.z = __expf(ac.z - mx); ex.w = __expf(ac.w - mx);
            float sum = (ex.x + ex.y) + (ex.z + ex.w); sum += __shfl_xor(sum, 1); sum += __shfl_xor(sum, 2);
            const float inv = 1.0f / sum;
            if (F.lane < 4) {
                if (m < MLAT) { const int b = m >> 12, s = m & 4095; float* p = AFL + ((size_t)(b * 16 + 4 * F.lane)) * 4096 + s; p[0] = ex.x * inv; p[4096] = ex.y * inv; p[2 * 4096] = ex.z * inv; p[3 * 4096] = ex.w * inv; }
                else { const int b = (m - MLAT) >> 8, s = (m - MLAT) & 255; float* p = AFC + ((size_t)(b * 16 + 4 * F.lane)) * 256 + s; p[0] = ex.x * inv; p[256] = ex.y * inv; p[512] = ex.z * inv; p[768] = ex.w * inv; }
            }
        }
    }
}

DI unsigned block_excl_scan(unsigned v, unsigned& total, LAS unsigned* wsum, int tid, int lane, int wave) {
    unsigned x = v;
#pragma unroll
    for (int o = 1; o < 64; o <<= 1) { const unsigned y = __shfl_up(x, o); if (lane >= o) x += y; }
    if (lane == 63) wsum[wave] = x;
    __syncthreads();
    unsigned base = 0, tot = 0;
#pragma unroll
    for (int w = 0; w < 8; ++w) { const unsigned s = wsum[w]; if (w < wave) base += s; tot += s; }
    __syncthreads();
    total = tot;
    return base + x - v;
}
DI void select_phase(Frame& F, KArgs ka, int l) {
    KA_FRESH(ka); const __attribute__((address_space(4))) Args& a = *ka; frame_fresh(F);
    const bool last = (l == NL - 1);
    const int nunits = last ? 128 : 256;
    LAS unsigned* hist = (LAS unsigned*)F.lds;
    LAS unsigned* wsum = (LAS unsigned*)(F.lds + 8192);
    LAS unsigned* bc = (LAS unsigned*)(F.lds + 8192 + 64);
    LAS int* sel = (LAS int*)(F.lds + 16384);
    const float* AFL = (const float*)(a.ws + WS_AFL); const float* AFC = (const float*)(a.ws + WS_AFC);
    int* smap = (int*)(a.ws + WS_SMAP); float* gate = (float*)(a.ws + WS_GATE);
    const unsigned char* H2 = a.ws + WS_H2; unsigned char* XG = a.ws + WS_XG;
    for (int unit = blockIdx.x; unit < nunits; unit += F.G) {
        const bool lat = unit < 128; const int be = unit & 127, b = be >> 4, e = be & 15;
        const int N = lat ? 4096 : 256, cap = lat ? CAP_LAT : CAP_CTX;
        const float* aff = lat ? AFL + (size_t)be * 4096 : AFC + (size_t)be * 256;
        unsigned key[8]; const int per = lat ? 8 : 1; const bool act = lat || F.tid < 256;
#pragma unroll
        for (int j = 0; j < 8; ++j) key[j] = (act && j < per) ? __float_as_uint(aff[F.tid * per + j]) : 0u;
        unsigned prefix = 0u, pmask = 0u, need = (unsigned)cap;
#pragma unroll
        for (int pass = 0; pass < 3; ++pass) {
            const int shift = pass == 0 ? 21 : (pass == 1 ? 10 : 0), nb = pass == 2 ? 1024 : 2048;
            for (int i = F.tid; i < 2048; i += 512) hist[i] = 0u;
            __syncthreads();
#pragma unroll
            for (int j = 0; j < 8; ++j) if (act && j < per && (key[j] & pmask) == prefix) (void)__hip_atomic_fetch_add(&hist[(key[j] >> shift) & (nb - 1)], 1u, __ATOMIC_RELAXED, __HIP_MEMORY_SCOPE_WORKGROUP);
            __syncthreads();
            unsigned c4[4], mine = 0;
#pragma unroll
            for (int j = 0; j < 4; ++j) { const int bin = 2047 - 4 * F.tid - j; c4[j] = bin < nb ? hist[bin] : 0u; mine += c4[j]; }
            unsigned tot; unsigned run = block_excl_scan(mine, tot, wsum, F.tid, F.lane, F.wave);
#pragma unroll
            for (int j = 0; j < 4; ++j) { const int bin = 2047 - 4 * F.tid - j;
                if (bin < nb && run < need && run + c4[j] >= need) { bc[0] = (unsigned)bin; bc[1] = run; }
                run += c4[j]; }
            __syncthreads();
            const unsigned cb = bc[0], above = bc[1];
            prefix |= cb << shift; pmask |= (unsigned)(nb - 1) << shift; need -= above;
            __syncthreads();
        }
        unsigned neq = 0, ngt = 0;
#pragma unroll
        for (int j = 0; j < 8; ++j) if (act && j < per) { neq += key[j] == prefix; ngt += key[j] > prefix; }
        unsigned teq; const unsigned eqbase = block_excl_scan(neq, teq, wsum, F.tid, F.lane, F.wave);
        unsigned nsel = 0, flags = 0, erun = eqbase;
#pragma unroll
        for (int j = 0; j < 8; ++j) if (act && j < per) { bool s = key[j] > prefix; if (key[j] == prefix) { s = erun < need; ++erun; } if (s) { flags |= 1u << j; ++nsel; } }
        unsigned tsel; unsigned sbase = block_excl_scan(nsel, tsel, wsum, F.tid, F.lane, F.wave);
        const int rowbase = lat ? b * SEQ : MLAT + b * CTX;
        const int slotbase = lat ? be * CAP_LAT : NSLOT_LAT + (e * 8 + b) * CAP_CTX;
#pragma unroll
        for (int j = 0; j < 8; ++j) if (act && j < per) { const int tok = F.tid * per + j; int slot = -1;
            if ((flags >> j) & 1u) { slot = slotbase + (int)sbase; sel[sbase] = tok; gate[slot] = __uint_as_float(key[j]); ++sbase; }
            smap[(size_t)e * MT + rowbase + tok] = slot; }
        __syncthreads();
        if (lat) {
            for (int t0 = F.wave * 16; t0 < cap; t0 += 128) {
                u32x4 rowv[16];
#pragma unroll
                for (int q = 0; q < 16; ++q) rowv[q] = ((const u32x4*)(H2 + (size_t)(rowbase + sel[t0 + q]) * D))[F.lane];
#pragma unroll
                for (int q = 0; q < 16; ++q) ((u32x4*)(XG + (size_t)(slotbase + t0 + q) * D))[F.lane] = rowv[q];
            }
        } else {
            const int t0 = F.wave * 4;
            u32x4 rowv[4];
#pragma unroll
            for (int q = 0; q < 4; ++q) rowv[q] = ((const u32x4*)(H2 + (size_t)(rowbase + sel[t0 + q]) * D))[F.lane];
#pragma unroll
            for (int q = 0; q < 4; ++q) ((u32x4*)(XG + (size_t)(slotbase + t0 + q) * D))[F.lane] = rowv[q];
        }
        __syncthreads();
    }
}

#ifndef Q_INA
#define Q_INA 3
#endif
#ifndef Q_INB
#define Q_INB 6
#endif
#ifndef Q_INC
#define Q_INC 9
#endif
#ifndef Q_MRG
#define Q_MRG 9
#endif
#ifndef Q_WO
#define Q_WO 2
#endif
#ifndef Q_GU
#define Q_GU 3
#endif
#ifndef Q_DN
#define Q_DN 3
#endif
#define TAIL1(nwg_, Q_) do { const int r_ = (nwg_) % F.G; if (!last && r_ != 0) { if (bx >= r_) convert_tail(F, ka, l + 1, cur + 8 * (Q_) * (bx - r_), (Q_)); cur += 8 * (Q_) * (F.G - r_); } } while (0)
DI unsigned char* ws_fresh(KArgs ka) { KA_FRESH(ka); return ka->ws; }
__global__ void __launch_bounds__(512, 2) mega_fwd(Args a_unused) {
    extern __shared__ __attribute__((aligned(16))) unsigned char lds_raw[];
    KArgs ka = (KArgs)__builtin_amdgcn_kernarg_segment_ptr();
    Frame F;
    F.lds = (LAS unsigned char*)lds_raw;
    F.tid = threadIdx.x; F.lane = F.tid & 63; F.wave = __builtin_amdgcn_readfirstlane(F.tid >> 6);
    F.G = gridDim.x; { const int bx = blockIdx.x; F.vcu = (F.G % 8 == 0) ? (bx % 8) * (F.G / 8) + bx / 8 : bx; }
    F.gw = F.vcu * 8 + F.wave; F.ngw = F.G * 8;
    for (int u = F.tid; u < (LDS_BYTES - LDSCTL_OFF) / 4; u += 512) ((LAS unsigned*)(F.lds + LDSCTL_OFF))[u] = 0u;
    __syncthreads();
    XcdBarrier bar = xcd_barrier_post((unsigned*)(ws_fresh(ka) + WS_CTL) + CW_BAR, (volatile LAS unsigned*)(F.lds + LDSCTL_OFF + 32));
#define GRID_BAR() xcd_barrier(bar)
    const int bx = blockIdx.x;

    if (PH(0)) modv_phase(F, ka);
    for (int rep_ = 0; rep_ < REPS(2); ++rep_) if (PH(2)) convert_weights(F, ka, 0, 0);
    GRID_BAR();
    if (PH(3)) row_phase(F, ka, 0);
    GRID_BAR();

    for (int l = 0; l < NL; ++l) {
        const bool last = (l == NL - 1);
        const int nMe = last ? MLAT / 256 : MT / 256;
        const int nMs = last ? NSLOT_LAT / 256 : NSLOT / 256;
        int cur = 0;
        if (PH(4)) { unsigned char* ws = ws_fresh(ka);
            for (int rep_ = 0; rep_ < REPS(4); ++rep_) { pg8::Gemm g{(const bf16_t*)(ws + WS_R4), (const bf16_t*)wsel(ws, l, W_IN), 1024, 1024, 1024, 0}; pg8::Order S; S.init(MT / 256, DINP / 256, F.G, bx);
              pg8::EpiStoreBf16 E{(bf16_t*)(ws + WS_HW), DINP}; pg8::gemm_phase(F.lds, g, S, E); }
            for (int rep_ = 0; rep_ < REPS(17); ++rep_) { pg8::Gemm g{(const bf16_t*)(ws + WS_R4 + 68 * MiB), (const bf16_t*)wsel(ws, l, W_GL), 1024, 1024, 1024, 0}; pg8::Order S; S.init(MT / 256, NGL / 256, F.G, (bx + F.G / 2) % F.G);
              pg8::EpiGate E{ws + WS_G}; pg8::gemm_phase<pg8::EpiGate, true>(F.lds, g, S, E); } }
        if (!last && F.G == 256) {
            int q = 0, off = 0;
            if (bx < 128) { q = Q_INA; off = bx * Q_INA; } else if (bx >= 224) { q = Q_INC; off = 128 * Q_INA + 24 * Q_INB + (bx - 224) * Q_INC; } else if (bx >= 200) { q = Q_INB; off = 128 * Q_INA + (bx - 200) * Q_INB; }
            if (q) convert_tail(F, ka, l + 1, cur + 8 * off, q);
            cur += 8 * (128 * Q_INA + 24 * Q_INB + 32 * Q_INC); }
        GRID_BAR();
        for (int rep_ = 0; rep_ < REPS(5); ++rep_) if (PH(5)) { unsigned char* ws = ws_fresh(ka); pg8::Gemm g{(const bf16_t*)(ws + WS_HW) + C_CQ, (const bf16_t*)wsel(ws, l, W_UP), 384, DINP, 384, 0}; pg8::Order S; S.init(MT / 256, UW / 256, F.G, bx);
            pg8::EpiStoreBf16 E{(bf16_t*)(ws + WS_R4), UW}; pg8::gemm_phase(F.lds, g, S, E); }
        for (int rep_ = 0; rep_ < REPS(6); ++rep_) if (PH(6)) prep_phase(F, ka, l);
        GRID_BAR();
        for (int rep_ = 0; rep_ < REPS(7); ++rep_) if (PH(7)) prep2_phase(F, ka, l, rep_);
        GRID_BAR();
        for (int rep_ = 0; rep_ < REPS(8); ++rep_) if (PH(8)) attn_phase(F, ka, l);
        GRID_BAR();
        for (int rep_ = 0; rep_ < REPS(9); ++rep_) if (PH(9)) { unsigned char* ws = ws_fresh(ka); pg8::Order S; S.init(nMe, 4, F.G, bx);
          const unsigned char* OC = ws + WS_OCAT; bf16_t* MG = (bf16_t*)(ws + WS_MERGED); const unsigned char* GL = ws + WS_G;
          { pg8::Gemm3 g{OC, OC + 512, OC + 1024, wsel(ws, l, W_NAO), wsel(ws, l, W_MLAO), wsel(ws, l, W_SWAO), OCW, 512}; pg8::EpiMerge3 E{MG, GL}; pg8::gemm_phase3(F.lds, g, S, E); } }
        TAIL1(nMe * 4, Q_MRG);
        GRID_BAR();
        if (PH(10)) { unsigned char* ws = ws_fresh(ka); pg8::Gemm g{(const bf16_t*)(ws + WS_MERGED), (const bf16_t*)wsel(ws, l, W_O), 1024, 1024, 1024, 0}; pg8::Order S; S.init(nMe, 4, F.G, bx);
            pg8::EpiResid E{(bf16_t*)(ws + WS_XS), (const float*)(ws + WS_MODV) + (size_t)l * 9 * 6144 + 2 * 1024}; pg8::gemm_phase<pg8::EpiResid, true>(F.lds, g, S, E); }
        TAIL1(nMe * 4, Q_WO);
        GRID_BAR();
        for (int rep_ = 0; rep_ < REPS(11); ++rep_) if (PH(11)) norm2_phase(F, ka, l, last ? MLAT : MT);
        GRID_BAR();
        for (int rep_ = 0; rep_ < REPS(12); ++rep_) if (PH(12)) select_phase(F, ka, l);
        GRID_BAR();
        for (int rep_ = 0; rep_ < REPS(13); ++rep_) if (PH(13)) { unsigned char* ws = ws_fresh(ka); pg8::Gemm g{(const bf16_t*)(ws + WS_XG), (const bf16_t*)wsel(ws, l, W_GU), 1024, 1024, 1024, (size_t)2048 * 1024}; pg8::Order S; S.init(nMs, 8, F.G, bx, 1);
            pg8::EpiSwiglu E{ws + WS_ACT}; pg8::gemm_phase<pg8::EpiSwiglu, true>(F.lds, g, S, E); }
        TAIL1(nMs * 8, Q_GU);
        GRID_BAR();
        for (int rep_ = 0; rep_ < REPS(14); ++rep_) if (PH(14)) { unsigned char* ws = ws_fresh(ka); pg8::Gemm g{(const bf16_t*)(ws + WS_ACT), (const bf16_t*)wsel(ws, l, W_DN), 1024, 1024, 1024, (size_t)1024 * 1024}; pg8::Order S; S.init(nMs, 4, F.G, bx, 1);
            pg8::EpiDown E{(bf16_t*)(ws + WS_Y), (const float*)(ws + WS_GATE)}; pg8::gemm_phase<pg8::EpiDown, true>(F.lds, g, S, E); }
        TAIL1(nMs * 4, Q_DN);
        GRID_BAR();
        for (int rep_ = 0; rep_ < REPS(15); ++rep_) if (PH(15)) row_phase(F, ka, l + 1, rep_);
        if (!last) { for (int rep_ = 0; rep_ < REPS(16); ++rep_) if (PH(16)) convert_weights(F, ka, l + 1, cur); GRID_BAR(); }
    }
}

extern "C" void kernel_launch(void* const* d_in, const int* in_sizes, int n_in, void* d_out, int out_size, void* d_ws, size_t ws_size, hipStream_t stream) {
    static int grid = 0;
    if (grid == 0) {
        if (n_in != 29 || in_sizes[0] != MLAT * D || out_size != MLAT * D || ws_size < WS_END) {
            fprintf(stderr, "kernel_launch: unexpected problem: n_in %d in0 %d out %d ws %zu (need %zu)\n", n_in, n_in > 0 ? in_sizes[0] : -1, out_size, ws_size, (size_t)WS_END); grid = -1; return; }
        int dev = 0, cus = 0, per_cu = 0;
        if (hipGetDevice(&dev) != hipSuccess || hipDeviceGetAttribute(&cus, hipDeviceAttributeMultiprocessorCount, dev) != hipSuccess) { fprintf(stderr, "kernel_launch: device query failed\n"); grid = -1; return; }
        if (hipFuncSetAttribute((const void*)mega_fwd, hipFuncAttributeMaxDynamicSharedMemorySize, LDS_BYTES) != hipSuccess) { fprintf(stderr, "kernel_launch: hipFuncSetAttribute failed\n"); grid = -1; return; }
        if (hipOccupancyMaxActiveBlocksPerMultiprocessor(&per_cu, (const void*)mega_fwd, 512, LDS_BYTES) != hipSuccess || per_cu < 1) {
            fprintf(stderr, "kernel_launch: occupancy query reports %d workgroups per CU\n", per_cu); }
        (void)hipGetLastError();
        grid = cus;
    }
    if (grid < 0) return;
    if (hipMemsetAsync((char*)d_ws + WS_CTL, 0, CTL_BYTES, stream) != hipSuccess) { fprintf(stderr, "kernel_launch: memset failed\n"); return; }
    Args a{};
    for (int i = 0; i < 29; ++i) a.in[i] = (const float*)d_in[i];
    a.out = (float*)d_out; a.ws = (unsigned char*)d_ws;
    hipLaunchKernelGGL(mega_fwd, dim3(grid), dim3(512), LDS_BYTES, stream, a);
    const hipError_t le = hipPeekAtLastError();
    if (le != hipSuccess) fprintf(stderr, "kernel_launch: launch failed: %s\n", hipGetErrorName(le));
}
```

```cpp
#include <hip/hip_runtime.h>
#include <cstdio>
#include <cstdint>

#define DI __device__ __forceinline__
#ifndef PH_MASK
#define PH_MASK 0xFFFFF
#endif
#define PH(b) ((PH_MASK >> (b)) & 1)
#ifndef REP_MASK
#define REP_MASK 0
#endif
#define REPS(b) (1 + ((REP_MASK >> (b)) & 1))
#define LAS __attribute__((address_space(3)))
#define GAS __attribute__((address_space(1)))
typedef unsigned short bf16_t;
typedef short bf16x8 __attribute__((ext_vector_type(8)));
typedef short s16x4 __attribute__((ext_vector_type(4)));
typedef float f32x4 __attribute__((ext_vector_type(4)));
typedef float f32x2 __attribute__((ext_vector_type(2)));
typedef float f32x16 __attribute__((ext_vector_type(16)));
typedef unsigned u32x4 __attribute__((ext_vector_type(4)));
typedef unsigned u32x2 __attribute__((ext_vector_type(2)));
typedef int i32x8 __attribute__((ext_vector_type(8)));

constexpr int D = 1024, NB = 8, SEQ = 4096, NL = 4, CTX = 256;
constexpr int MLAT = NB * SEQ, MCTX = NB * CTX, MT = MLAT + MCTX;
constexpr int DIN = 5312, DINP = 2304, NGL = 3072;
constexpr int C_NAQ = 0, C_NAK = 384, C_NAV = 768, C_CQ = 1152, C_CKV = 1408, C_KR = 1536, C_SWQ = 1600, C_SWK = 1984, C_SWV = 2112, C_GL = 2240;
constexpr int UW = 1792;
constexpr int P1W = 1280;
constexpr int P2W = 1536;
constexpr int OCW = 1536;
constexpr int NE = 16, CAP_LAT = 512, CAP_CTX = 32;
constexpr int NSLOT_LAT = NB * NE * CAP_LAT, NSLOT = NSLOT_LAT + NB * NE * CAP_CTX;
constexpr float EPS = 1e-6f;
constexpr float LOG2E = 1.4426950408889634f;

constexpr size_t MiB = 1u << 20;
constexpr size_t WS_CTL = 0, CTL_BYTES = 1 * MiB;
constexpr size_t WS_MODV = 1 * MiB;
constexpr size_t WS_W = 2 * MiB;
constexpr size_t W_IN = 0, W_GL = 4718592  , W_UP = 11010048, W_NAO = 7864320  , W_MLAO = 13172736, W_SWAO = 8912896  , W_O = 15007744, W_GU = 17104896, W_DN = 84213760, W_END = 117768192;
constexpr size_t WS_XS = 115 * MiB, WS_W2 = 183 * MiB  ;
constexpr size_t WS_HW = 251 * MiB;
constexpr size_t WS_G = WS_HW + 153 * MiB;
constexpr size_t WS_P1 = 608 * MiB;
constexpr size_t WS_P2 = 693 * MiB;
constexpr size_t WS_R4 = 795 * MiB;
constexpr size_t WS_AFL = 914 * MiB;
constexpr size_t WS_AFC = 916 * MiB;
constexpr size_t WS_SMAP = 917 * MiB;
constexpr size_t WS_GATE = 920 * MiB;
constexpr size_t WS_OCAT = 921 * MiB;
constexpr size_t WS_END = 1006 * MiB;
constexpr size_t WS_MERGED = WS_P1;
constexpr size_t WS_H2 = WS_HW;
constexpr size_t WS_XG = WS_HW + 68 * MiB;
constexpr size_t WS_ACT = WS_HW + 204 * MiB;
constexpr size_t WS_Y = WS_HW + 340 * MiB;
static_assert(W_END <= 113 * MiB && WS_W + 113 * MiB <= WS_XS, "weights");
static_assert(W_GU + 64 * MiB <= W_DN && W_DN + 32 * MiB <= 113 * MiB && WS_XS + (size_t)MT * D * 2 <= WS_W2 && WS_W2 + W_GU <= WS_HW, "second weight buffers");
static_assert(WS_XS + (size_t)MT * D * 4 <= WS_HW && WS_HW + (size_t)MT * DINP * 2 <= WS_G && WS_G + (size_t)MT * NGL * 2 <= WS_P1 && WS_P1 + (size_t)MT * P1W * 2 <= WS_P2 && WS_P2 + (size_t)MT * P2W * 2 <= WS_R4, "map");
static_assert(WS_R4 + (size_t)MT * UW * 2 <= WS_AFL && WS_Y + (size_t)NSLOT * D * 2 <= WS_R4 && WS_SMAP + (size_t)16 * MT * 4 <= WS_GATE && WS_GATE + (size_t)NSLOT * 4 <= WS_OCAT && WS_OCAT + (size_t)MT * OCW <= WS_END, "map2");
constexpr int CW_BAR = 4096;

constexpr int RING_BYTES = 131072, LDSCTL_OFF = RING_BYTES, LDS_BYTES = 147456;

DI unsigned pk2(float lo, float hi) { unsigned r; asm("v_cvt_pk_bf16_f32 %0, %1, %2" : "=v"(r) : "v"(lo), "v"(hi)); return r; }
DI unsigned pk4_fp8(float a, float b, float c, float d) { int w = 0; w = __builtin_amdgcn_cvt_pk_fp8_f32(a, b, w, false); w = __builtin_amdgcn_cvt_pk_fp8_f32(c, d, w, true); return (unsigned)w; }
DI float bflo(unsigned w) { return __uint_as_float(w << 16); }
DI float bfhi(unsigned w) { return __uint_as_float(w & 0xffff0000u); }
DI float bf2f(bf16_t b) { return __uint_as_float((unsigned)b << 16); }
DI float wave_sum(float v) {
#pragma unroll
    for (int o = 1; o < 64; o <<= 1) v += __shfl_xor(v, o);
    return v;
}
DI float sigmoidf_(float x) { return __builtin_amdgcn_rcpf(1.0f + __builtin_amdgcn_exp2f(-x * LOG2E)); }
DI int mod_index(int row) { return row < MLAT ? (row >> 12) : 8; }

#define XB_TMO      128
#define XB_XCNT(j)  (256  + 64 * (j))
#define XB_XSUB(j)  (1280 + 64 * (j))
#define XB_XGEN(j)  (2304 + 64 * (j))
#define XB_TOP      3328
#define XB_TOPGEN   3392
#define XCD_BAR_WORDS 3456
#define XB_SPIN_CAP (1u << 18)
DI unsigned xb_ld(unsigned* p)              { return __hip_atomic_load(p, __ATOMIC_RELAXED, __HIP_MEMORY_SCOPE_AGENT); }
DI unsigned xb_add(unsigned* p, unsigned v) { return __hip_atomic_fetch_add(p, v, __ATOMIC_RELAXED, __HIP_MEMORY_SCOPE_AGENT); }
DI unsigned xb_xcc_id() { return (unsigned)__builtin_amdgcn_s_getreg((3 << 11) | 20) & 0xFu; }
#define XB_SPIN(cond, bar) do { unsigned _sp = 0; while (cond) { __builtin_amdgcn_s_sleep(1); \
    if ((++_sp & 255u) == 0u) { if (xb_ld(&(bar)[XB_TMO])) break; if (_sp > XB_SPIN_CAP) { atomicAdd(&(bar)[XB_TMO], 1u); break; } } } } while (0)
struct XcdBarrier { unsigned* bar; unsigned x; volatile LAS unsigned* st; };
DI XcdBarrier xcd_barrier_post(unsigned* bar, volatile LAS unsigned* st) {
    XcdBarrier b; b.bar = bar; b.x = xb_xcc_id(); b.st = st;
    if (threadIdx.x == 0) (void)xb_add(&bar[XB_XCNT(b.x)], 1u);
    return b;
}
DI void xcd_barrier_complete(unsigned* bar, unsigned x, unsigned& nloc, unsigned& nx) {
    const unsigned G = gridDim.x * gridDim.y * gridDim.z;
    unsigned sum, cnt, mine, sp = 0u;
    for (;;) {
        sum = 0u; cnt = 0u; mine = 0u;
#pragma unroll
        for (unsigned j = 0; j < 16; ++j) { const unsigned c = xb_ld(&bar[XB_XCNT(j)]); sum += c; cnt += (c > 0u) ? 1u : 0u; mine = (j == x) ? c : mine; }
        if (sum == G) break;
        __builtin_amdgcn_s_sleep(1);
        if ((++sp & 255u) == 0u) { if (xb_ld(&bar[XB_TMO])) break; if (sp > XB_SPIN_CAP) { atomicAdd(&bar[XB_TMO], 1u); break; } }
    }
    nloc = mine > 0u ? mine : 1u; nx = cnt > 0u ? cnt : 1u;
}
DI void xcd_barrier(const XcdBarrier& b) {
    asm volatile("s_waitcnt vmcnt(0)" ::: "memory");
    __syncthreads();
    if (threadIdx.x == 0) {
        unsigned* bar = b.bar; unsigned bx_ = b.x; asm volatile("" : "+s"(bar), "+s"(bx_));
        __builtin_amdgcn_s_waitcnt(0);
        unsigned nloc = b.st[0], nx = b.st[1];
        if (nloc == 0u) { xcd_barrier_complete(bar, bx_, nloc, nx); b.st[0] = nloc; b.st[1] = nx; }
        const unsigned old = xb_add(&bar[XB_XSUB(bx_)], 1u);
        const unsigned gen = old / nloc;
        if (old + 1u == (gen + 1u) * nloc) {
            __builtin_amdgcn_fence(__ATOMIC_RELEASE, "agent");
            asm volatile("s_waitcnt vmcnt(0)" ::: "memory");
            const unsigned og = xb_add(&bar[XB_TOP], 1u);
            const unsigned tg = og / nx;
            if (og + 1u == (tg + 1u) * nx) xb_add(&bar[XB_TOPGEN], 1u);
            else XB_SPIN(xb_ld(&bar[XB_TOPGEN]) == tg, bar);
            __builtin_amdgcn_fence(__ATOMIC_ACQUIRE, "agent");
            xb_add(&bar[XB_XGEN(bx_)], 1u);
            asm volatile("s_waitcnt vmcnt(0)" ::: "memory");
        } else {
            XB_SPIN(xb_ld(&bar[XB_XGEN(bx_)]) == gen, bar);
            __builtin_amdgcn_fence(__ATOMIC_ACQUIRE, "agent");
            asm volatile("s_waitcnt vmcnt(0)" ::: "memory");
        }
    }
    __syncthreads();
}

namespace pg8 {
constexpr int BM = 256, BK = 64, HALF = 128, HTB = HALF * BK * 2, NXCD = 8, WGM = 8;
__host__ __device__ __forceinline__ int lds_byte(int r, int c) { const int st = (r >> 4) * 2 + (c >> 5), rr = r & 15, cc = c & 31, ob = rr * 64 + cc * 2; return st * 1024 + (ob ^ (((ob >> 9) & 1) << 5)); }
__host__ __device__ __forceinline__ void stage_rc(int b, int& R, int& C) { const int st = b / 1024, sb = b % 1024, swz = sb ^ (((sb >> 9) & 1) << 5); R = (st >> 1) * 16 + swz / 64; C = (st & 1) * 32 + (swz % 64) / 2; }
__host__ __device__ __forceinline__ int perm32(int rho) { const int n = rho >> 4, i = rho & 15; return 8 * (i >> 2) + 4 * n + (i & 3); }
struct Unit { int pm, pn; };
struct Gemm { const bf16_t* A; const bf16_t* Bt; int K, lda, ldb; size_t estride; };
struct Order {
    int nM, nN, nwg, G, c, moe;
    DI void init(int nM_, int nN_, int G_, int c_, int moe_ = 0) { nM = nM_; nN = nN_; nwg = nM * nN; G = G_; c = c_; moe = moe_; }
    DI bool next(int i, Unit& u) const {
        const long L = (long)i * G + c; if (L >= nwg) return false;
        int wgid = (int)L; { const int q = nwg / NXCD, r = nwg % NXCD, xcd = wgid % NXCD, off = wgid / NXCD; wgid = (xcd < r ? xcd * (q + 1) : r * (q + 1) + (xcd - r) * q) + off; }
        const int nig = WGM * nN, gid = wgid / nig, fm = gid * WGM, gsz = (nM - fm) < WGM ? (nM - fm) : WGM;
        u.pm = fm + ((wgid % nig) % gsz); u.pn = (wgid % nig) / gsz;
        if (moe && u.pm < 256) { const int e = u.pm >> 4, b = (u.pm >> 1) & 7, hf = u.pm & 1; u.pm = (((b << 4) | e) << 1) | hf; }
        return true;
    }
};
struct EpiStoreBf16 {
    static constexpr bool PERM = true;
    bf16_t* O; int ldc;
    DI void operator()(const f32x4 (&acc)[2][2][4][2], const Unit& u, int wr, int wc, int fr, int fq) const {
        const int row0 = u.pm * BM + wr * 64 + fr, col0 = u.pn * BM + wc * 32 + 8 * fq;
#pragma unroll
        for (int ai = 0; ai < 2; ++ai)
#pragma unroll
            for (int m = 0; m < 4; ++m) { bf16_t* rowp = O + (size_t)(row0 + ai * HALF + m * 16) * ldc + col0;
#pragma unroll
                for (int bj = 0; bj < 2; ++bj) { const f32x4 v0 = acc[ai][bj][m][0], v1 = acc[ai][bj][m][1];
                    u32x4 w; w.x = pk2(v0[0], v0[1]); w.y = pk2(v0[2], v0[3]); w.z = pk2(v1[0], v1[1]); w.w = pk2(v1[2], v1[3]);
                    *(u32x4*)(rowp + bj * HALF) = w; } }
    }
};
DI unsigned pk4_u8(float a, float b, float c, float d) {
    unsigned ua = (unsigned)(a * 255.0f + 0.5f), ub = (unsigned)(b * 255.0f + 0.5f), uc = (unsigned)(c * 255.0f + 0.5f), ud = (unsigned)(d * 255.0f + 0.5f);
    ua = ua < 1u ? 1u : ua; ub = ub < 1u ? 1u : ub; uc = uc < 1u ? 1u : uc; ud = ud < 1u ? 1u : ud;
    return ua | (ub << 8) | (uc << 16) | (ud << 24);
}
struct EpiGate {
    static constexpr bool PERM = true;
    unsigned char* O;
    DI void operator()(const f32x4 (&acc)[2][2][4][2], const Unit& u, int wr, int wc, int fr, int fq) const {
        const int row0 = u.pm * BM + wr * 64 + fr, col0 = u.pn * BM + wc * 32 + 8 * fq;
#pragma unroll
        for (int ai = 0; ai < 2; ++ai)
#pragma unroll
            for (int m = 0; m < 4; ++m) { unsigned char* rowp = O + (size_t)(row0 + ai * HALF + m * 16) * NGL + col0;
#pragma unroll
                for (int bj = 0; bj < 2; ++bj) { const f32x4 v0 = acc[ai][bj][m][0] * 0.03125f, v1 = acc[ai][bj][m][1] * 0.03125f;
                    u32x2 w; w.x = pk4_u8(sigmoidf_(v0[0]), sigmoidf_(v0[1]), sigmoidf_(v0[2]), sigmoidf_(v0[3])); w.y = pk4_u8(sigmoidf_(v1[0]), sigmoidf_(v1[1]), sigmoidf_(v1[2]), sigmoidf_(v1[3]));
                    *(u32x2*)(rowp + bj * HALF) = w; } }
    }
};
DI float u8f(unsigned w, int k) { return (float)((w >> (8 * k)) & 0xffu) * (1.0f / 255.0f); }
struct EpiMerge {
    static constexpr bool PERM = true;
    bf16_t* O; const unsigned char* gl; int first;
    DI void operator()(const f32x4 (&acc)[2][2][4][2], const Unit& u, int wr, int wc, int fr, int fq) const {
        const int row0 = u.pm * BM + wr * 64 + fr, col0 = u.pn * BM + wc * 32 + 8 * fq;
#pragma unroll
        for (int ai = 0; ai < 2; ++ai) {
            u32x2 g[4][2]; u32x4 p[4][2];
#pragma unroll
            for (int m = 0; m < 4; ++m)
#pragma unroll
                for (int bj = 0; bj < 2; ++bj) { const int row = row0 + ai * HALF + m * 16, col = col0 + bj * HALF;
                    g[m][bj] = *(const u32x2*)(gl + (size_t)row * NGL + col);
                    p[m][bj] = first ? (u32x4){0u, 0u, 0u, 0u} : *(const u32x4*)(O + (size_t)row * D + col); }
#pragma unroll
            for (int m = 0; m < 4; ++m)
#pragma unroll
                for (int bj = 0; bj < 2; ++bj) { const int row = row0 + ai * HALF + m * 16, col = col0 + bj * HALF;
                    const u32x2 gg = g[m][bj]; const u32x4 pp = p[m][bj]; const f32x4 v0 = acc[ai][bj][m][0], v1 = acc[ai][bj][m][1];
                    const float r0 = v0[0] * u8f(gg.x, 0) + bflo(pp.x), r1 = v0[1] * u8f(gg.x, 1) + bfhi(pp.x), r2 = v0[2] * u8f(gg.x, 2) + bflo(pp.y), r3 = v0[3] * u8f(gg.x, 3) + bfhi(pp.y);
                    const float r4 = v1[0] * u8f(gg.y, 0) + bflo(pp.z), r5 = v1[1] * u8f(gg.y, 1) + bfhi(pp.z), r6 = v1[2] * u8f(gg.y, 2) + bflo(pp.w), r7 = v1[3] * u8f(gg.y, 3) + bfhi(pp.w);
                    u32x4 w; w.x = pk2(r0, r1); w.y = pk2(r2, r3); w.z = pk2(r4, r5); w.w = pk2(r6, r7);
                    *(u32x4*)(O + (size_t)row * D + col) = w; }
        }
    }
};
struct EpiResid {
    static constexpr bool PERM = true;
    bf16_t* xs; const float* modg;
    DI void operator()(const f32x4 (&acc)[2][2][4][2], const Unit& u, int wr, int wc, int fr, int fq) const {
        const int row0 = u.pm * BM + wr * 64 + fr, col0 = u.pn * BM + wc * 32 + 8 * fq;
        const float* mp = modg + (size_t)mod_index(u.pm * BM) * 6144 + col0;
        f32x4 g0[2], g1[2];
#pragma unroll
        for (int bj = 0; bj < 2; ++bj) { g0[bj] = *(const f32x4*)(mp + bj * HALF) * (1.0f / 128.0f); g1[bj] = *(const f32x4*)(mp + bj * HALF + 4) * (1.0f / 128.0f); }
#pragma unroll
        for (int ai = 0; ai < 2; ++ai)
#pragma unroll
            for (int mh = 0; mh < 2; ++mh) {
                u32x4 xw[2][2];
#pragma unroll
                for (int m2 = 0; m2 < 2; ++m2)
#pragma unroll
                    for (int bj = 0; bj < 2; ++bj) xw[m2][bj] = *(const u32x4*)(xs + (size_t)(row0 + ai * HALF + (2 * mh + m2) * 16) * D + col0 + bj * HALF);
#pragma unroll
                for (int m2 = 0; m2 < 2; ++m2)
#pragma unroll
                    for (int bj = 0; bj < 2; ++bj) { const int m = 2 * mh + m2; const u32x4 x = xw[m2][bj];
                        const f32x4 x0 = (f32x4){bflo(x.x), bfhi(x.x), bflo(x.y), bfhi(x.y)} + g0[bj] * acc[ai][bj][m][0];
                        const f32x4 x1 = (f32x4){bflo(x.z), bfhi(x.z), bflo(x.w), bfhi(x.w)} + g1[bj] * acc[ai][bj][m][1];
                        u32x4 w; w.x = pk2(x0[0], x0[1]); w.y = pk2(x0[2], x0[3]); w.z = pk2(x1[0], x1[1]); w.w = pk2(x1[2], x1[3]);
                        *(u32x4*)(xs + (size_t)(row0 + ai * HALF + m * 16) * D + col0 + bj * HALF) = w; }
            }
    }
};
struct EpiSwiglu {
    static constexpr bool PERM = true;
    unsigned char* O;
    DI void operator()(const f32x4 (&acc)[2][2][4][2], const Unit& u, int wr, int wc, int fr, int fq) const {
        const int row0 = u.pm * BM + wr * 64 + fr, col0 = u.pn * HALF + wc * 32 + 8 * fq;
#pragma unroll
        for (int ai = 0; ai < 2; ++ai)
#pragma unroll
            for (int m = 0; m < 4; ++m) { const int row = row0 + ai * HALF + m * 16;
                const f32x4 a0 = acc[ai][0][m][0] * 0.03125f, a1 = acc[ai][0][m][1] * 0.03125f, u0 = acc[ai][1][m][0] * 0.25f, u1 = acc[ai][1][m][1] * 0.25f;
                float r[8];
#pragma unroll
                for (int j = 0; j < 4; ++j) { r[j] = a0[j] * sigmoidf_(a0[j]) * u0[j]; r[4 + j] = a1[j] * sigmoidf_(a1[j]) * u1[j]; }
                u32x2 w; w.x = pk4_fp8(r[0], r[1], r[2], r[3]); w.y = pk4_fp8(r[4], r[5], r[6], r[7]);
                *(u32x2*)(O + (size_t)row * D + col0) = w; }
    }
};
struct EpiDown {
    static constexpr bool PERM = true;
    bf16_t* O; const float* gate;
    DI void operator()(const f32x4 (&acc)[2][2][4][2], const Unit& u, int wr, int wc, int fr, int fq) const {
        const int row0 = u.pm * BM + wr * 64 + fr, col0 = u.pn * BM + wc * 32 + 8 * fq;
        float gv[2][4];
#pragma unroll
        for (int ai = 0; ai < 2; ++ai)
#pragma unroll
            for (int m = 0; m < 4; ++m) gv[ai][m] = gate[row0 + ai * HALF + m * 16] * (1.0f / 256.0f);
#pragma unroll
        for (int ai = 0; ai < 2; ++ai)
#pragma unroll
            for (int m = 0; m < 4; ++m) { const int row = row0 + ai * HALF + m * 16; const float g = gv[ai][m]; bf16_t* rowp = O + (size_t)row * D + col0;
#pragma unroll
                for (int bj = 0; bj < 2; ++bj) { const f32x4 v0 = acc[ai][bj][m][0] * g, v1 = acc[ai][bj][m][1] * g;
                    u32x4 w; w.x = pk2(v0[0], v0[1]); w.y = pk2(v0[2], v0[3]); w.z = pk2(v1[0], v1[1]); w.w = pk2(v1[2], v1[3]);
                    *(u32x4*)(rowp + bj * HALF) = w; } }
    }
};

struct EpiMerge3 {
    static constexpr bool PERM = true;
    bf16_t* O; const unsigned char* gl;
    DI void operator()(f32x4 (&acc)[2][2][4][2], const Unit& u, int seg, int wr, int wc, int fr, int fq) const {
        const int row0 = u.pm * BM + wr * 64 + fr, col0 = u.pn * BM + wc * 32 + 8 * fq;
#pragma unroll
        for (int ai = 0; ai < 2; ++ai) {
            u32x2 ga[4][2], gb[4][2];
#pragma unroll
            for (int m = 0; m < 4; ++m)
#pragma unroll
                for (int bj = 0; bj < 2; ++bj) { const unsigned char* gp = gl + (size_t)(row0 + ai * HALF + m * 16) * NGL + 1024 * seg + col0 + bj * HALF;
                    ga[m][bj] = *(const u32x2*)gp; gb[m][bj] = seg < 2 ? *(const u32x2*)(gp + 1024) : (u32x2){0u, 0u}; }
#pragma unroll
            for (int m = 0; m < 4; ++m)
#pragma unroll
                for (int bj = 0; bj < 2; ++bj) {
                    f32x4 s0, s1;
#pragma unroll
                    for (int k = 0; k < 4; ++k) { const float a0 = (float)((ga[m][bj].x >> (8 * k)) & 0xffu), a1 = (float)((ga[m][bj].y >> (8 * k)) & 0xffu);
                        if (seg < 2) { const float b0 = (float)((gb[m][bj].x >> (8 * k)) & 0xffu), b1 = (float)((gb[m][bj].y >> (8 * k)) & 0xffu); s0[k] = a0 * __builtin_amdgcn_rcpf(b0); s1[k] = a1 * __builtin_amdgcn_rcpf(b1); }
                        else { s0[k] = a0 * (1.0f / (255.0f * 128.0f)); s1[k] = a1 * (1.0f / (255.0f * 128.0f)); } }
                    acc[ai][bj][m][0] *= s0; acc[ai][bj][m][1] *= s1;
                    if (seg == 2) { const f32x4 v0 = acc[ai][bj][m][0] * 4.0f, v1 = acc[ai][bj][m][1] * 4.0f;
                        u32x2 w; w.x = pk4_fp8(v0[0], v0[1], v0[2], v0[3]); w.y = pk4_fp8(v1[0], v1[1], v1[2], v1[3]);
                        *(u32x2*)((unsigned char*)O + (size_t)(row0 + ai * HALF + m * 16) * D + col0 + bj * HALF) = w; }
                }
        }
    }
};
struct Gemm3 { const unsigned char* A0; const unsigned char* A1; const unsigned char* A2; const unsigned char* B0; const unsigned char* B1; const unsigned char* B2; int lda, ldb; };
template <class Epi>
DI void gemm_phase3(LAS unsigned char* lds, const Gemm3 g, const Order& S, const Epi& E) {
    int tid_ = threadIdx.x; asm volatile("" : "+v"(tid_));
    const int tid = tid_, wid = __builtin_amdgcn_readfirstlane(tid >> 6), lane = tid & 63, wr = wid >> 2, wc = wid & 3, fr = lane & 15, fq = lane >> 4;
    unsigned voffA[2], voffB[2];
#pragma unroll
    for (int i = 0; i < 2; ++i) { int R, C; stage_rc(tid * 16 + i * 8192, R, C); const int Rb = Epi::PERM ? ((R & ~31) + perm32(R & 31)) : R;
        voffA[i] = (unsigned)(R * g.lda + C * 2); voffB[i] = (unsigned)(Rb * g.ldb + C * 2); }
    const size_t kstep = (size_t)(BK * 2);
    const size_t hstepA = (size_t)HALF * g.lda, hstepB = (size_t)HALF * g.ldb;
    const size_t tstepA = 2 * hstepA, tstepB = 2 * hstepB;
    const unsigned ldsw = (unsigned)wid * 1024u;
    const int aoff = lds_byte(wr * 64 + fr, fq * 8), boff = lds_byte(wc * 32 + fr, fq * 8);
#define PG8_SA(b, h) (((b) * 2 + (h)) * HTB)
#define PG8_SB(b, h) ((4 + (b) * 2 + (h)) * HTB)
#define PG8_STAGE(bufoff, gbase, voff) do { _Pragma("unroll") for (int _i = 0; _i < 2; ++_i) \
        __builtin_amdgcn_global_load_lds((const unsigned*)((const char*)(gbase) + (voff)[_i]), (LAS unsigned*)(lds + (bufoff) + ldsw + _i * 8192), 16, 0, 0); } while (0)
#define PG8_LDA(dst, b, h) do { _Pragma("unroll") for (int m = 0; m < 4; ++m) _Pragma("unroll") for (int k = 0; k < 2; ++k) dst[m][k] = *(const LAS bf16x8*)(lds + PG8_SA(b, h) + aoff + m * 2048 + k * 1024); } while (0)
#define PG8_LDB(dst, b, h) do { _Pragma("unroll") for (int n = 0; n < 2; ++n) _Pragma("unroll") for (int k = 0; k < 2; ++k) dst[n][k] = *(const LAS bf16x8*)(lds + PG8_SB(b, h) + boff + n * 2048 + k * 1024); } while (0)
#define PG8_MMA(ai, bj, At, Bt) do { __builtin_amdgcn_s_setprio(1); _Pragma("unroll") for (int m = 0; m < 4; ++m) _Pragma("unroll") for (int n = 0; n < 2; ++n) { \
        const i32x8 bb_ = __builtin_bit_cast(i32x8, __builtin_shufflevector(Bt[n][0], Bt[n][1], 0, 1, 2, 3, 4, 5, 6, 7, 8, 9, 10, 11, 12, 13, 14, 15)); \
        const i32x8 aa_ = __builtin_bit_cast(i32x8, __builtin_shufflevector(At[m][0], At[m][1], 0, 1, 2, 3, 4, 5, 6, 7, 8, 9, 10, 11, 12, 13, 14, 15)); \
        asm volatile("v_mfma_scale_f32_16x16x128_f8f6f4 %0, %1, %2, %0, %3, %3 op_sel_hi:[0,0,0]" : "+v"(acc[ai][bj][m][n]) : "v"(bb_), "v"(aa_), "v"(0x7F7F7F7F)); } \
        __builtin_amdgcn_s_setprio(0); } while (0)
#define PG8_WAIT_V(n) asm volatile("s_waitcnt vmcnt(" #n ")" ::: "memory")
#define PG8_WAIT_L(n) asm volatile("s_waitcnt lgkmcnt(" #n ")" ::: "memory")
#define PG8_BAR __builtin_amdgcn_s_barrier()
#define PG8_SCHED __builtin_amdgcn_sched_barrier(0)
#define PG8_A3(sg, u) ((const char*)((sg) == 0 ? g.A0 : (sg) == 1 ? g.A1 : g.A2) + (size_t)(u).pm * tstepA)
#define PG8_B3(sg, u) ((const char*)((sg) == 0 ? g.B0 : (sg) == 1 ? g.B1 : g.B2) + (size_t)(u).pn * tstepB)
    Unit cur, nu; int ui = 0, seg = 0;
    if (!S.next(0, cur)) return;
    f32x4 acc[2][2][4][2];
#pragma unroll
    for (int a = 0; a < 2; ++a)
#pragma unroll
        for (int b = 0; b < 2; ++b)
#pragma unroll
            for (int m = 0; m < 4; ++m)
#pragma unroll
                for (int n = 0; n < 2; ++n) acc[a][b][m][n] = (f32x4){0.f, 0.f, 0.f, 0.f};
    bf16x8 At[4][2], B0[2][2], B1[2][2];
    const char* cA = PG8_A3(0, cur); const char* cB = PG8_B3(0, cur);
    PG8_STAGE(PG8_SB(0, 0), cB, voffB); PG8_STAGE(PG8_SB(0, 1), cB + hstepB, voffB); PG8_STAGE(PG8_SA(0, 0), cA, voffA); PG8_STAGE(PG8_SA(0, 1), cA + hstepA, voffA);
    if (wr == 1) PG8_BAR;
    PG8_WAIT_V(2); PG8_BAR;
    PG8_STAGE(PG8_SB(1, 0), cB + kstep, voffB); PG8_STAGE(PG8_SA(1, 0), cA + kstep, voffA); PG8_STAGE(PG8_SB(1, 1), cB + hstepB + kstep, voffB);
    PG8_WAIT_V(6); PG8_BAR;
    for (;;) {
        int nseg = seg + 1; bool has_next = true; nu = cur;
        if (nseg == 3) { nseg = 0; has_next = S.next(ui + 1, nu); }
        const char* nA = has_next ? PG8_A3(nseg, nu) : cA; const char* nB = has_next ? PG8_B3(nseg, nu) : cB;
        int nt_ = 4; asm volatile("" : "+s"(nt_));
        const int nt = nt_;
#pragma nounroll
        for (int t = 0; t < nt; t += 2) {
            const bool last = (t == nt - 2);
            const char* a1 = cA + (size_t)(t + 1) * kstep;
            const char* a2 = last ? nA : cA + (size_t)(t + 2) * kstep; const char* b2 = last ? nB : cB + (size_t)(t + 2) * kstep;
            const char* a3 = a2 + kstep; const char* b3 = b2 + kstep;
            PG8_LDB(B0, 0, 0); PG8_LDB(B1, 0, 1); PG8_SCHED; PG8_LDA(At, 0, 0); PG8_STAGE(PG8_SA(1, 1), a1 + hstepA, voffA);
            PG8_WAIT_V(8); PG8_WAIT_L(0); PG8_BAR; PG8_MMA(0, 0, At, B0); PG8_MMA(0, 1, At, B1); PG8_BAR; PG8_SCHED;
            PG8_LDA(At, 0, 1); PG8_STAGE(PG8_SB(0, 0), b2, voffB); PG8_STAGE(PG8_SB(0, 1), b2 + hstepB, voffB); PG8_STAGE(PG8_SA(0, 0), a2, voffA);
            PG8_WAIT_V(8); PG8_WAIT_L(0); PG8_BAR; PG8_MMA(1, 0, At, B0); PG8_MMA(1, 1, At, B1); PG8_BAR; PG8_SCHED;
            PG8_LDB(B0, 1, 0); PG8_LDB(B1, 1, 1); PG8_SCHED; PG8_LDA(At, 1, 0); PG8_STAGE(PG8_SA(0, 1), a2 + hstepA, voffA);
            PG8_WAIT_V(8); PG8_WAIT_L(0); PG8_BAR; PG8_MMA(0, 0, At, B0); PG8_MMA(0, 1, At, B1); PG8_BAR; PG8_SCHED;
            PG8_LDA(At, 1, 1); PG8_STAGE(PG8_SB(1, 0), b3, voffB); PG8_STAGE(PG8_SB(1, 1), b3 + hstepB, voffB); PG8_STAGE(PG8_SA(1, 0), a3, voffA);
            PG8_WAIT_V(8); PG8_WAIT_L(0); PG8_BAR; PG8_MMA(1, 0, At, B0); PG8_MMA(1, 1, At, B1); PG8_BAR; PG8_SCHED;
        }
        if (wr == 0) PG8_BAR;
        E(acc, cur, seg, wr, wc, fr, fq);
        if (!has_next) break;
        if (seg == 2) {
#pragma unroll
            for (int a = 0; a < 2; ++a)
#pragma unroll
                for (int b = 0; b < 2; ++b)
#pragma unroll
                    for (int m = 0; m < 4; ++m)
#pragma unroll
                        for (int n = 0; n < 2; ++n) acc[a][b][m][n] = (f32x4){0.f, 0.f, 0.f, 0.f};
            cur = nu; ++ui;
        }
        seg = nseg; cA = nA; cB = nB;
        if (wr == 1) PG8_BAR;
    }
    PG8_WAIT_V(0);
    PG8_BAR;
#undef PG8_SA
#undef PG8_SB
#undef PG8_STAGE
#undef PG8_LDA
#undef PG8_LDB
#undef PG8_MMA
#undef PG8_WAIT_V
#undef PG8_WAIT_L
#undef PG8_BAR
#undef PG8_SCHED
#undef PG8_A3
#undef PG8_B3
}

template <class Epi, bool FP8 = false>
DI void gemm_phase(LAS unsigned char* lds, const Gemm g, const Order& S, const Epi& E) {
    constexpr int ESZ = FP8 ? 1 : 2;
    int tid_ = threadIdx.x; asm volatile("" : "+v"(tid_));
    const int tid = tid_, wid = __builtin_amdgcn_readfirstlane(tid >> 6), lane = tid & 63, wr = wid >> 2, wc = wid & 3, fr = lane & 15, fq = lane >> 4;
    const int K = g.K, nt = K * ESZ / (BK * 2);
    unsigned voffA[2], voffB[2];
#pragma unroll
    for (int i = 0; i < 2; ++i) { int R, C; stage_rc(tid * 16 + i * 8192, R, C); const int Rb = Epi::PERM ? ((R & ~31) + perm32(R & 31)) : R;
        voffA[i] = (unsigned)(R * g.lda * ESZ + C * 2); voffB[i] = (unsigned)(Rb * g.ldb * ESZ + C * 2); }
    const size_t kstep = (size_t)(BK * 2);
    const size_t hstepA = (size_t)HALF * g.lda * ESZ, hstepB = (size_t)HALF * g.ldb * ESZ;
    const size_t tstepA = 2 * hstepA, tstepB = 2 * hstepB;
    const unsigned ldsw = (unsigned)wid * 1024u;
    const int aoff = lds_byte(wr * 64 + fr, fq * 8), boff = lds_byte(wc * 32 + fr, fq * 8);
#define PG8_SA(b, h) (((b) * 2 + (h)) * HTB)
#define PG8_SB(b, h) ((4 + (b) * 2 + (h)) * HTB)
#define PG8_STAGE(bufoff, gbase, voff) do { _Pragma("unroll") for (int _i = 0; _i < 2; ++_i) \
        __builtin_amdgcn_global_load_lds((const unsigned*)((const char*)(gbase) + (voff)[_i]), (LAS unsigned*)(lds + (bufoff) + ldsw + _i * 8192), 16, 0, 0); } while (0)
#define PG8_LDA(dst, b, h) do { _Pragma("unroll") for (int m = 0; m < 4; ++m) _Pragma("unroll") for (int k = 0; k < 2; ++k) dst[m][k] = *(const LAS bf16x8*)(lds + PG8_SA(b, h) + aoff + m * 2048 + k * 1024); } while (0)
#define PG8_LDB(dst, b, h) do { _Pragma("unroll") for (int n = 0; n < 2; ++n) _Pragma("unroll") for (int k = 0; k < 2; ++k) dst[n][k] = *(const LAS bf16x8*)(lds + PG8_SB(b, h) + boff + n * 2048 + k * 1024); } while (0)
#define PG8_MMA(ai, bj, At, Bt) do { __builtin_amdgcn_s_setprio(1); _Pragma("unroll") for (int m = 0; m < 4; ++m) _Pragma("unroll") for (int n = 0; n < 2; ++n) { \
        if constexpr (FP8) { const i32x8 bb_ = __builtin_bit_cast(i32x8, __builtin_shufflevector(Bt[n][0], Bt[n][1], 0, 1, 2, 3, 4, 5, 6, 7, 8, 9, 10, 11, 12, 13, 14, 15)); \
            const i32x8 aa_ = __builtin_bit_cast(i32x8, __builtin_shufflevector(At[m][0], At[m][1], 0, 1, 2, 3, 4, 5, 6, 7, 8, 9, 10, 11, 12, 13, 14, 15)); \
            asm volatile("v_mfma_scale_f32_16x16x128_f8f6f4 %0, %1, %2, %0, %3, %3 op_sel_hi:[0,0,0]" : "+v"(acc[ai][bj][m][n]) : "v"(bb_), "v"(aa_), "v"(0x7F7F7F7F)); } \
        else { _Pragma("unroll") for (int k = 0; k < 2; ++k) acc[ai][bj][m][n] = __builtin_amdgcn_mfma_f32_16x16x32_bf16(Bt[n][k], At[m][k], acc[ai][bj][m][n], 0, 0, 0); } } \
        __builtin_amdgcn_s_setprio(0); } while (0)
#define PG8_WAIT_V(n) asm volatile("s_waitcnt vmcnt(" #n ")" ::: "memory")
#define PG8_WAIT_L(n) asm volatile("s_waitcnt lgkmcnt(" #n ")" ::: "memory")
#define PG8_BAR __builtin_amdgcn_s_barrier()
#define PG8_SCHED __builtin_amdgcn_sched_barrier(0)
#define PG8_EXPERT(pm) ((pm) < 256 ? (((pm) >> 1) & 15) : ((pm) - 256))
#define PG8_ABASE(u) ((const char*)g.A + (size_t)(u).pm * tstepA)
#define PG8_BBASE(u) ((const char*)g.Bt + (size_t)PG8_EXPERT((u).pm) * g.estride * ESZ + (size_t)(u).pn * tstepB)
    Unit cur, nxt; int ui = 0;
    if (!S.next(0, cur)) return;
    f32x4 acc[2][2][4][2];
#pragma unroll
    for (int a = 0; a < 2; ++a)
#pragma unroll
        for (int b = 0; b < 2; ++b)
#pragma unroll
            for (int m = 0; m < 4; ++m)
#pragma unroll
                for (int n = 0; n < 2; ++n) acc[a][b][m][n] = (f32x4){0.f, 0.f, 0.f, 0.f};
    bf16x8 At[4][2], B0[2][2], B1[2][2];
    const char* cA = PG8_ABASE(cur); const char* cB = PG8_BBASE(cur);
    PG8_STAGE(PG8_SB(0, 0), cB, voffB); PG8_STAGE(PG8_SB(0, 1), cB + hstepB, voffB); PG8_STAGE(PG8_SA(0, 0), cA, voffA); PG8_STAGE(PG8_SA(0, 1), cA + hstepA, voffA);
    if (wr == 1) PG8_BAR;
    PG8_WAIT_V(2); PG8_BAR;
    PG8_STAGE(PG8_SB(1, 0), cB + kstep, voffB); PG8_STAGE(PG8_SA(1, 0), cA + kstep, voffA); PG8_STAGE(PG8_SB(1, 1), cB + hstepB + kstep, voffB);
    PG8_WAIT_V(6); PG8_BAR;
    for (;;) {
        const bool has_next = S.next(ui + 1, nxt);
        const char* nA = has_next ? PG8_ABASE(nxt) : cA; const char* nB = has_next ? PG8_BBASE(nxt) : cB;
#pragma nounroll
        for (int t = 0; t < nt; t += 2) {
            const bool last = (t == nt - 2);
            const char* a1 = cA + (size_t)(t + 1) * kstep;
            const char* a2 = last ? nA : cA + (size_t)(t + 2) * kstep; const char* b2 = last ? nB : cB + (size_t)(t + 2) * kstep;
            const char* a3 = a2 + kstep; const char* b3 = b2 + kstep;
            PG8_LDB(B0, 0, 0); PG8_LDB(B1, 0, 1); PG8_SCHED; PG8_LDA(At, 0, 0); PG8_STAGE(PG8_SA(1, 1), a1 + hstepA, voffA);
            PG8_WAIT_V(8); PG8_WAIT_L(0); PG8_BAR; PG8_MMA(0, 0, At, B0); PG8_MMA(0, 1, At, B1); PG8_BAR; PG8_SCHED;
            PG8_LDA(At, 0, 1); PG8_STAGE(PG8_SB(0, 0), b2, voffB); PG8_STAGE(PG8_SB(0, 1), b2 + hstepB, voffB); PG8_STAGE(PG8_SA(0, 0), a2, voffA);
            PG8_WAIT_V(8); PG8_WAIT_L(0); PG8_BAR; PG8_MMA(1, 0, At, B0); PG8_MMA(1, 1, At, B1); PG8_BAR; PG8_SCHED;
            PG8_LDB(B0, 1, 0); PG8_LDB(B1, 1, 1); PG8_SCHED; PG8_LDA(At, 1, 0); PG8_STAGE(PG8_SA(0, 1), a2 + hstepA, voffA);
            PG8_WAIT_V(8); PG8_WAIT_L(0); PG8_BAR; PG8_MMA(0, 0, At, B0); PG8_MMA(0, 1, At, B1); PG8_BAR; PG8_SCHED;
            PG8_LDA(At, 1, 1); PG8_STAGE(PG8_SB(1, 0), b3, voffB); PG8_STAGE(PG8_SB(1, 1), b3 + hstepB, voffB); PG8_STAGE(PG8_SA(1, 0), a3, voffA);
            PG8_WAIT_V(8); PG8_WAIT_L(0); PG8_BAR; PG8_MMA(1, 0, At, B0); PG8_MMA(1, 1, At, B1); PG8_BAR; PG8_SCHED;
        }
        if (wr == 0) PG8_BAR;
        E(acc, cur, wr, wc, fr, fq);
        if (!has_next) break;
#pragma unroll
        for (int a = 0; a < 2; ++a)
#pragma unroll
            for (int b = 0; b < 2; ++b)
#pragma unroll
                for (int m = 0; m < 4; ++m)
#pragma unroll
                    for (int n = 0; n < 2; ++n) acc[a][b][m][n] = (f32x4){0.f, 0.f, 0.f, 0.f};
        cur = nxt; cA = nA; cB = nB; ++ui;
        if (wr == 1) PG8_BAR;
    }
    PG8_WAIT_V(0);
    PG8_BAR;
#undef PG8_SA
#undef PG8_SB
#undef PG8_STAGE
#undef PG8_LDA
#undef PG8_LDB
#undef PG8_MMA
#undef PG8_WAIT_V
#undef PG8_WAIT_L
#undef PG8_BAR
#undef PG8_SCHED
}
}

struct Args { const float* in[29]; float* out; unsigned char* ws; };
typedef const __attribute__((address_space(4))) Args* KArgs;
#define KA_FRESH(ka) asm volatile("" : "+s"(ka))
enum { I_X = 0, I_C, I_CTX, I_CCTX, I_N1G, I_N2G, I_WADA, I_BADA, I_WIN, I_NAQG, I_NAKG, I_RPB, I_MQN, I_WUQ, I_MKVN, I_WUKV, I_MQG, I_MKG, I_SWQG, I_SWKG, I_SINK,
       I_WNAO, I_WMLAO, I_WSWAO, I_WO, I_ROUTER, I_WGATE, I_WUP, I_WDOWN };
struct Frame {
    LAS unsigned char* lds;
    int tid, lane, wave, G, vcu, gw, ngw;
};

DI void frame_fresh(Frame& F) { int t = F.tid, w = F.wave, v = F.vcu; asm volatile("" : "+v"(t), "+s"(w), "+s"(v)); F.tid = t; F.lane = t & 63; F.wave = w; F.vcu = v; F.gw = v * 8 + w; }
DI void modv_phase(Frame& F, KArgs ka) {
    KA_FRESH(ka); const __attribute__((address_space(4))) Args& a = *ka; frame_fresh(F);
    LAS float* cact = (LAS float*)F.lds;
    LAS float* red = (LAS float*)(F.lds + 9 * 1024 * 4);
    const float* c = a.in[I_C]; const float* cc = a.in[I_CCTX];
    for (int i = F.tid; i < 9 * 1024; i += 512) { const float v = i < 8192 ? c[i] : cc[i - 8192]; cact[i] = v * sigmoidf_(v); }
    __syncthreads();
    float* modv = (float*)(a.ws + WS_MODV);
    const int cl = F.lane & 31, kp = F.lane >> 5;
    for (int unit = F.vcu; unit < NL * 192; unit += F.G) {
        const int l = unit / 192, n = (unit % 192) * 32 + cl;
        const float* w = a.in[I_WADA] + (size_t)l * 1024 * 6144 + n;
        float acc[9];
#pragma unroll
        for (int i = 0; i < 9; ++i) acc[i] = 0.f;
        const int k0 = F.wave * 128 + kp;
#pragma unroll 16
        for (int k = 0; k < 128; k += 2) { const float wv = w[(size_t)(k0 + k) * 6144];
#pragma unroll
            for (int i = 0; i < 9; ++i) acc[i] += cact[i * 1024 + k0 + k] * wv; }
#pragma unroll
        for (int i = 0; i < 9; ++i) red[((F.wave * 2 + kp) * 9 + i) * 32 + cl] = acc[i];
        __syncthreads();
        for (int t = F.tid; t < 9 * 32; t += 512) { const int i = t >> 5, nn = t & 31; float s = 0.f;
#pragma unroll
            for (int w16 = 0; w16 < 16; ++w16) s += red[(w16 * 9 + i) * 32 + nn];
            const int col = (unit % 192) * 32 + nn;
            modv[((size_t)l * 9 + i) * 6144 + col] = s + a.in[I_BADA][l * 6144 + col]; }
        __syncthreads();
    }
}
DI void copy_phase(Frame& F, KArgs ka) {
    KA_FRESH(ka); const __attribute__((address_space(4))) Args& a = *ka; frame_fresh(F);
    u32x2* xs = (u32x2*)(a.ws + WS_XS);
    const f32x4* x = (const f32x4*)a.in[I_X]; const f32x4* cx = (const f32x4*)a.in[I_CTX];
    const size_t nl = (size_t)MLAT * D / 4, nc = (size_t)MCTX * D / 4;
    for (size_t i = (size_t)blockIdx.x * 512 + F.tid; i < nl + nc; i += (size_t)F.G * 512) { const f32x4 v = i < nl ? x[i] : cx[i - nl]; u32x2 w; w.x = pk2(v.x, v.y); w.y = pk2(v.z, v.w); xs[i] = w; }
}

DI unsigned char* wsel(unsigned char* ws, int l, size_t off) {
    const size_t p = (size_t)(l & 1);
    return ws + (off >= W_DN ? WS_W + off + p * (16 * MiB) : off >= W_GU ? WS_W + off + p * (32 * MiB) : (p ? WS_W2 : WS_W) + off);
}
constexpr int T_IN = 16 * 166, T_UQ = 4 * 24, T_UKV = 2 * 32, T_NAO = 6 * 32, T_MLAO = 8 * 32, T_SWAO = 6 * 32, T_O = 16 * 32, T_E = 16 * 32 * 16;
constexpr int NIT = T_IN + T_UQ + T_UKV + T_NAO + T_MLAO + T_SWAO + T_O + 3 * T_E;
DI void cvt_item(const __attribute__((address_space(4))) Args& a, int l, int r, LAS float* scr, int lane) {
    const float* W; const float* ks = nullptr; int ldw = 1024, kb, nb, ldt = 1024, drow0, dcol0 = 0, fp8 = 1; size_t woff;
    if (r < T_IN) { kb = r / 166; nb = r % 166; W = a.in[I_WIN] + (size_t)l * 1024 * DIN; ldw = DIN;
        if (nb < 70) { fp8 = 0; woff = W_IN; drow0 = 32 * nb; } else { woff = W_GL; drow0 = 32 * nb - 2240; } }
    else if ((r -= T_IN) < T_UQ) { kb = r / 24; nb = r % 24; W = a.in[I_WUQ] + (size_t)l * 256 * 768; ldw = 768; fp8 = 0; woff = W_UP; ldt = 384; drow0 = 32 * nb; ks = a.in[I_MQN] + l * 256; }
    else if ((r -= T_UQ) < T_UKV) { kb = r / 32; nb = r % 32; W = a.in[I_WUKV] + (size_t)l * 128 * 1024; fp8 = 0; woff = W_UP; ldt = 384; drow0 = 768 + 32 * nb; dcol0 = 256; ks = a.in[I_MKVN] + l * 128; }
    else if ((r -= T_UKV) < T_NAO) { kb = r / 32; nb = r % 32; W = a.in[I_WNAO] + (size_t)l * 384 * 1024; woff = W_NAO; ldt = 512; drow0 = 32 * nb; }
    else if ((r -= T_NAO) < T_MLAO) { kb = r / 32; nb = r % 32; W = a.in[I_WMLAO] + (size_t)l * 512 * 1024; woff = W_MLAO; ldt = 512; drow0 = 32 * nb; }
    else if ((r -= T_MLAO) < T_SWAO) { kb = r / 32; nb = r % 32; W = a.in[I_WSWAO] + (size_t)l * 384 * 1024; woff = W_SWAO; ldt = 512; drow0 = 32 * nb; }
    else if ((r -= T_SWAO) < T_O) { kb = r / 32; nb = r % 32; W = a.in[I_WO] + (size_t)l * 1024 * 1024; woff = W_O; drow0 = 32 * nb; }
    else if ((r -= T_O) < 2 * T_E) {
        const int which = r / T_E, rr = r % T_E, e = rr / 512, t = rr % 512; kb = t / 32; nb = t % 32; const int f0 = 32 * nb;
        W = a.in[which ? I_WUP : I_WGATE] + ((size_t)l * 16 + e) * 1024 * 1024; woff = W_GU + (size_t)e * 2048 * 1024; drow0 = 256 * (f0 >> 7) + 128 * which + (f0 & 127); }
    else { r -= 2 * T_E; const int e = r / 512, t = r % 512; kb = t / 32; nb = t % 32;
        W = a.in[I_WDOWN] + ((size_t)l * 16 + e) * 1024 * 1024; woff = W_DN + (size_t)e * 1024 * 1024; drow0 = 32 * nb; }
    const int k0 = 64 * kb, n0 = 32 * nb; dcol0 += k0;
    unsigned char* WT; { const size_t p = (size_t)(l & 1); WT = a.ws + (woff >= W_DN ? WS_W + woff + p * (16 * MiB) : woff >= W_GU ? WS_W + woff + p * (32 * MiB) : (p ? WS_W2 : WS_W) + woff); }
    const float sc = fp8 ? 32.0f : 1.0f;
    const float* Wl = W + (size_t)(k0 + (lane >> 5)) * ldw + n0 + (lane & 31); LAS float* sl = scr + (lane >> 5) * 33 + (lane & 31);
    if (ks) { ks += k0 + (lane >> 5);
#pragma unroll 8
        for (int i = 0; i < 32; ++i) sl[2 * i * 33] = Wl[(size_t)(2 * i) * ldw] * ks[2 * i]; }
    else {
        float wv[32];
#pragma unroll
        for (int i = 0; i < 32; ++i) wv[i] = Wl[(size_t)(2 * i) * ldw];
#pragma unroll
        for (int i = 0; i < 32; ++i) sl[2 * i * 33] = wv[i] * sc; }
    asm volatile("s_waitcnt lgkmcnt(0)" ::: "memory");
    const int c = lane & 7;
    if (fp8) {
#pragma unroll
        for (int j = 0; j < 4; ++j) { const int n = (lane >> 3) + 8 * j; const LAS float* s = scr + (8 * c) * 33 + n;
            u32x2 o; o.x = pk4_fp8(s[0 * 33], s[1 * 33], s[2 * 33], s[3 * 33]); o.y = pk4_fp8(s[4 * 33], s[5 * 33], s[6 * 33], s[7 * 33]);
            *(u32x2*)(WT + (size_t)(drow0 + n) * ldt + dcol0 + 8 * c) = o; }
    } else {
#pragma unroll
        for (int j = 0; j < 4; ++j) { const int n = (lane >> 3) + 8 * j; const LAS float* s = scr + (8 * c) * 33 + n;
            u32x4 o; o.x = pk2(s[0 * 33], s[1 * 33]); o.y = pk2(s[2 * 33], s[3 * 33]); o.z = pk2(s[4 * 33], s[5 * 33]); o.w = pk2(s[6 * 33], s[7 * 33]);
            *(u32x4*)((bf16_t*)WT + (size_t)(drow0 + n) * ldt + dcol0 + 8 * c) = o; }
    }
    asm volatile("s_waitcnt lgkmcnt(0)" ::: "memory");
}
DI void convert_weights(Frame& F, KArgs ka, int l, int begin) {
    KA_FRESH(ka); const __attribute__((address_space(4))) Args& a = *ka; frame_fresh(F);
    LAS float* scr = (LAS float*)(F.lds + F.wave * 16384);
#pragma nounroll
    for (int it = begin + F.gw; it < NIT; it += F.ngw) cvt_item(a, l, it, scr, F.lane);
    unsigned char* wb = a.ws + ((l & 1) ? WS_W2 : WS_W);
    constexpr int Z0 = 64 * 128, Z1 = 768 * 16, Z2 = 1024 * 32, Z3 = 2 * 1024 * 8;
    unsigned zz = 0u; asm volatile("" : "+v"(zz));
    const u32x4 z = {zz, zz, zz, zz};
    for (int i = blockIdx.x * 512 + F.tid; i < Z0 + Z1 + Z2 + Z3; i += F.G * 512) {
        if (i >= Z0 + Z1 + Z2) { const int j = i - Z0 - Z1 - Z2, which = j >> 13, jj = j & 8191; *(u32x4*)(wb + (which ? W_SWAO : W_NAO) + (size_t)(jj >> 3) * 512 + 384 + (jj & 7) * 16) = z; continue; }
        if (i < Z0) *(u32x4*)((bf16_t*)(wb + W_IN) + (size_t)(2240 + i / 128) * 1024 + (i % 128) * 8) = z;
        else if (i < Z0 + Z1) { const int j = i - Z0; *(u32x4*)((bf16_t*)(wb + W_UP) + (size_t)(j / 16) * 384 + 256 + (j % 16) * 8) = z; }
        else { const int j = i - Z0 - Z1; *(u32x4*)((bf16_t*)(wb + W_UP) + (size_t)(768 + j / 32) * 384 + (j % 32) * 8) = z; }
    }
}
DI void convert_tail(Frame& F, KArgs ka, int l, int first, int q) {
    KA_FRESH(ka); const __attribute__((address_space(4))) Args& a = *ka; frame_fresh(F);
    LAS float* scr = (LAS float*)(F.lds + F.wave * 16384);
#pragma nounroll
    for (int j = 0; j < q; ++j) { const int it = first + 8 * j + F.wave; if (it < NIT) cvt_item(a, l, it, scr, F.lane); }
}


DI void row_phase(Frame& F, KArgs ka, int l, int dry = 0) {
    KA_FRESH(ka); const __attribute__((address_space(4))) Args& a = *ka; frame_fresh(F);
    bf16_t* xs = (bf16_t*)(a.ws + WS_XS);
    const float* modv = (const float*)(a.ws + WS_MODV);
    const int* smap = (const int*)(a.ws + WS_SMAP);
    const bf16_t* Y = (const bf16_t*)(a.ws + WS_Y);
    bf16_t* H = (bf16_t*)(a.ws + WS_R4);
    unsigned char* H8 = a.ws + WS_R4 + 68 * MiB;
    bf16_t* xso = xs; float* outo = a.out;
    if (dry) { unsigned char* tr = a.ws + WS_END + (size_t)F.gw * 16384; xso = (bf16_t*)tr; outo = (float*)tr; H = (bf16_t*)(tr + 8192); H8 = tr + 12288; }
    const int nrows = (l == NL) ? MLAT : MT;
    const bool comb = (l > 0);
    constexpr int RR = 4;
    for (int mb = RR * F.gw; mb < nrows; mb += RR * F.ngw) {
        f32x4 v[RR][4]; int myslot[RR];
#pragma unroll
        for (int rr = 0; rr < RR; ++rr) { const int m = mb + rr;
            if (l == 0) {
                if (F.lane < 16 && !dry) *(u32x4*)(a.ws + WS_OCAT + (size_t)m * OCW + ((F.lane >> 3) ? 1408 : 384) + 16 * (F.lane & 7)) = (u32x4){0u, 0u, 0u, 0u};
                const f32x4* xr = (const f32x4*)(m < MLAT ? a.in[I_X] + (size_t)m * D : a.in[I_CTX] + (size_t)(m - MLAT) * D) + F.lane;
                u32x2* xo = (u32x2*)(xs + (size_t)m * D) + F.lane;
#pragma unroll
                for (int j = 0; j < 4; ++j) { const f32x4 t = xr[64 * j]; u32x2 w; w.x = pk2(t.x, t.y); w.y = pk2(t.z, t.w); if (!dry) xo[64 * j] = w; v[rr][j] = (f32x4){bflo(w.x), bfhi(w.x), bflo(w.y), bfhi(w.y)}; }
            } else {
                const u32x2* xr = (const u32x2*)(xs + (size_t)m * D) + F.lane;
#pragma unroll
                for (int j = 0; j < 4; ++j) { const u32x2 w = xr[64 * j]; v[rr][j] = (f32x4){bflo(w.x), bfhi(w.x), bflo(w.y), bfhi(w.y)}; }
            }
            myslot[rr] = (comb && F.lane < 16) ? smap[(size_t)F.lane * MT + mb + rr] : -1; }
        const int mi = mod_index(mb);
        if (comb) {
            f32x4 acc[RR][4];
            unsigned long long mk[RR];
#pragma unroll
            for (int rr = 0; rr < RR; ++rr) { mk[rr] = __ballot(myslot[rr] >= 0);
#pragma unroll
                for (int j = 0; j < 4; ++j) acc[rr][j] = (f32x4){0.f, 0.f, 0.f, 0.f}; }
            while ((mk[0] | mk[1]) | (mk[2] | mk[3])) {
                u32x2 w[RR][4];
#pragma unroll
                for (int rr = 0; rr < RR; ++rr) {
                    int s = -1;
                    if (mk[rr]) { const int e0 = __builtin_ctzll(mk[rr]); s = __shfl(myslot[rr], e0); mk[rr] &= mk[rr] - 1; }
#pragma unroll
                    for (int j = 0; j < 4; ++j) w[rr][j] = (u32x2){0u, 0u};
                    if (s >= 0) { const u32x2* yr = (const u32x2*)(Y + (size_t)s * D) + F.lane;
#pragma unroll
                        for (int j = 0; j < 4; ++j) w[rr][j] = yr[64 * j]; }
                }
#pragma unroll
                for (int rr = 0; rr < RR; ++rr)
#pragma unroll
                    for (int j = 0; j < 4; ++j) acc[rr][j] += (f32x4){bflo(w[rr][j].x), bfhi(w[rr][j].x), bflo(w[rr][j].y), bfhi(w[rr][j].y)};
            }
            const f32x4* g5 = (const f32x4*)(modv + ((size_t)(l - 1) * 9 + mi) * 6144 + 5 * 1024) + F.lane;
            f32x4 g5v[4];
#pragma unroll
            for (int j = 0; j < 4; ++j) g5v[j] = g5[64 * j];
#pragma unroll
            for (int rr = 0; rr < RR; ++rr) { const int m = mb + rr;
                const size_t ro = dry ? (size_t)rr * 1024 : (size_t)m * D;
#pragma unroll
                for (int j = 0; j < 4; ++j) { v[rr][j] += g5v[j] * acc[rr][j];
                    if (l == NL) ((f32x4*)(outo + ro) + F.lane)[64 * j] = v[rr][j];
                    else { u32x2 w; w.x = pk2(v[rr][j].x, v[rr][j].y); w.y = pk2(v[rr][j].z, v[rr][j].w); ((u32x2*)(xso + ro) + F.lane)[64 * j] = w;
                           v[rr][j] = (f32x4){bflo(w.x), bfhi(w.x), bflo(w.y), bfhi(w.y)}; } } }
        }
        if (l < NL) {
            const f32x4* g = (const f32x4*)(a.in[I_N1G] + l * D) + F.lane;
            const f32x4* sh = (const f32x4*)(modv + ((size_t)l * 9 + mi) * 6144) + F.lane;
            const f32x4* sc = (const f32x4*)(modv + ((size_t)l * 9 + mi) * 6144 + 1024) + F.lane;
            f32x4 gg[4], shv[4];
#pragma unroll
            for (int j = 0; j < 4; ++j) { gg[j] = g[64 * j] * (sc[64 * j] + 1.0f); shv[j] = sh[64 * j]; }
#pragma unroll
            for (int rr = 0; rr < RR; ++rr) { const int m = mb + rr;
                float ss = 0.f;
#pragma unroll
                for (int j = 0; j < 4; ++j) ss += (v[rr][j].x * v[rr][j].x + v[rr][j].y * v[rr][j].y) + (v[rr][j].z * v[rr][j].z + v[rr][j].w * v[rr][j].w);
                const float rstd = __builtin_amdgcn_rsqf(wave_sum(ss) * (1.f / D) + EPS);
                u32x2* o = (u32x2*)(H + (dry ? (size_t)rr * 1024 : (size_t)m * D)) + F.lane;
                unsigned* o8 = (unsigned*)(H8 + (dry ? (size_t)rr * 1024 : (size_t)m * D)) + F.lane;
#pragma unroll
                for (int j = 0; j < 4; ++j) { const f32x4 hh = v[rr][j] * rstd * gg[j] + shv[j]; u32x2 w; w.x = pk2(hh.x, hh.y); w.y = pk2(hh.z, hh.w); o[64 * j] = w;
                    o8[64 * j] = pk4_fp8(hh.x, hh.y, hh.z, hh.w); } }
        }
    }
}

DI void rope_cs(int d, int prow, int pcol, float& cs, float& sn) {
    const int i = d & 15; const float pos = (float)((d & 32) ? pcol : prow);
    const float inv = __builtin_amdgcn_exp2f(-(float)i * (13.287712379549449f / 16.0f));
    const float rev = pos * inv * 0.15915494309189535f;
    const float fr = rev - floorf(rev);
    cs = __builtin_amdgcn_cosf(fr); sn = __builtin_amdgcn_sinf(fr);
}
DI void prep_phase(Frame& F, KArgs ka, int l) {
    KA_FRESH(ka); const __attribute__((address_space(4))) Args& a = *ka; frame_fresh(F);
    const bf16_t* HW = (const bf16_t*)(a.ws + WS_HW);
    bf16_t* P1 = (bf16_t*)(a.ws + WS_P1);
    const float sc64 = 0.125f * LOG2E;
    const int d0 = 8 * (F.lane & 7);
    float gn[3][8]; int srcc[3]; bool ropei[3], acti[3];
    const float* gp0 = a.in[I_NAQG]; const float* gp1 = a.in[I_NAKG]; const float* gp2 = a.in[I_SWQG]; const float* gp3 = a.in[I_SWKG];
#pragma unroll
    for (int i = 0; i < 3; ++i) { const int c = F.lane + 64 * i, col = 8 * c; acti[i] = c < 160;
        const int ty = col < 384 ? 0 : col < 768 ? 1 : col < 1152 ? 2 : 3;
        srcc[i] = col < 768 ? col : col + (C_SWQ - 768);
        ropei[i] = ty >= 2;
        const float sc = (ty == 0 || ty == 2) ? sc64 : 1.0f;
#pragma unroll
        for (int j = 0; j < 8; ++j) { const float g0 = gp0[l * 64 + d0 + j], g1 = gp1[l * 64 + d0 + j], g2 = gp2[l * 64 + d0 + j], g3 = gp3[l * 64 + d0 + j];
            gn[i][j] = acti[i] ? (ty == 0 ? g0 : ty == 1 ? g1 : ty == 2 ? g2 : g3) * sc : 0.f; } }
    float invf[8];
#pragma unroll
    for (int j = 0; j < 8; ++j) invf[j] = __builtin_amdgcn_exp2f(-(float)((d0 & 8) + j) * (13.287712379549449f / 16.0f)) * 0.15915494309189535f;
    const bool second = (d0 & 16) != 0, usecol = (d0 & 32) != 0;
    for (int mb = 2 * F.gw; mb < MT; mb += 2 * F.ngw) {
        u32x4 w[2][3];
#pragma unroll
        for (int rr = 0; rr < 2; ++rr)
#pragma unroll
            for (int i = 0; i < 3; ++i) if (acti[i]) w[rr][i] = *(const u32x4*)(HW + (size_t)(mb + rr) * DINP + srcc[i]); else w[rr][i] = (u32x4){0u, 0u, 0u, 0u};
#pragma unroll
        for (int rr = 0; rr < 2; ++rr) {
            const int m = mb + rr; const bool lat = m < MLAT; const int s = m & 4095; const float prw = (float)(s >> 6), pcl = (float)(s & 63); float pos = usecol ? pcl : prw; asm volatile("" : "+v"(pos));
            float cs[8], sn[8];
#pragma unroll
            for (int j = 0; j < 8; ++j) { cs[j] = 1.f; sn[j] = 0.f; }
            if (lat) {
#pragma unroll
                for (int j = 0; j < 8; ++j) { const float rev = pos * invf[j], fr = rev - floorf(rev); cs[j] = __builtin_amdgcn_cosf(fr); sn[j] = __builtin_amdgcn_sinf(fr); } }
#pragma unroll
            for (int i = 0; i < 3; ++i) {
                float x[8] = {bflo(w[rr][i].x), bfhi(w[rr][i].x), bflo(w[rr][i].y), bfhi(w[rr][i].y), bflo(w[rr][i].z), bfhi(w[rr][i].z), bflo(w[rr][i].w), bfhi(w[rr][i].w)};
                float ss = 0.f;
#pragma unroll
                for (int j = 0; j < 8; ++j) ss += x[j] * x[j];
                ss += __shfl_xor(ss, 1); ss += __shfl_xor(ss, 2); ss += __shfl_xor(ss, 4);
                const float rs = __builtin_amdgcn_rsqf(ss * (1.f / 64.f) + EPS);
#pragma unroll
                for (int j = 0; j < 8; ++j) x[j] *= rs * gn[i][j];
                const bool rp = ropei[i] && lat;
#pragma unroll
                for (int j = 0; j < 8; ++j) { const float y = __int_as_float(__builtin_amdgcn_ds_bpermute((F.lane ^ 2) << 2, __float_as_int(x[j]))); const float rot = second ? x[j] * cs[j] + y * sn[j] : x[j] * cs[j] - y * sn[j]; x[j] = rp ? rot : x[j]; }
                if (acti[i]) { u32x4 o; o.x = pk2(x[0], x[1]); o.y = pk2(x[2], x[3]); o.z = pk2(x[4], x[5]); o.w = pk2(x[6], x[7]);
                    *(u32x4*)(P1 + (size_t)m * P1W + 8 * (F.lane + 64 * i)) = o; }
            }
        }
    }
}
DI void prep2_phase(Frame& F, KArgs ka, int l, int dry = 0) {
    KA_FRESH(ka); const __attribute__((address_space(4))) Args& a = *ka; frame_fresh(F);
    const bf16_t* HW = (const bf16_t*)(a.ws + WS_HW);
    bf16_t* U = (bf16_t*)(a.ws + WS_R4);
    bf16_t* P2 = (bf16_t*)(a.ws + WS_P2);
    const float scq = 0.07216878364870322f * LOG2E;
    const int ln = F.lane, q = ln & 15, h = ln >> 4;
    float qgn[8], qgr[4], kgn[8], kgr[4], invf[4];
    { const float* qg = a.in[I_MQG] + l * 192; const float* kg = a.in[I_MKG] + l * 192;
#pragma unroll
      for (int j = 0; j < 8; ++j) { qgn[j] = qg[8 * q + j] * scq; kgn[j] = kg[8 * q + j]; }
#pragma unroll
      for (int j = 0; j < 4; ++j) { qgr[j] = qg[128 + 4 * q + j] * scq; kgr[j] = kg[128 + 4 * q + j];
          invf[j] = __builtin_amdgcn_exp2f(-(float)(4 * (q & 3) + j) * (13.287712379549449f / 16.0f)) * 0.15915494309189535f; } }
    const bool second = (q & 4) != 0, usecol = (q & 8) != 0;
    const int pl = (ln ^ 4) << 2;
    for (int mb = 2 * F.gw; mb < MT; mb += 2 * F.ngw) {
        u32x2 wcq[2], wqr[2], wkr[2]; unsigned wckv[2]; u32x4 wqn[2], wkn[2], wv[2];
#pragma unroll
        for (int rr = 0; rr < 2; ++rr) { const bf16_t* hr = HW + (size_t)(mb + rr) * DINP; const bf16_t* ur = U + (size_t)(mb + rr) * UW;
            wcq[rr] = *(const u32x2*)(hr + C_CQ + 4 * ln); wckv[rr] = *(const unsigned*)(hr + C_CKV + 2 * ln); wkr[rr] = *(const u32x2*)(hr + C_KR + 4 * q);
            wqn[rr] = *(const u32x4*)(ur + h * 192 + 8 * q); wqr[rr] = *(const u32x2*)(ur + h * 192 + 128 + 4 * q);
            wkn[rr] = *(const u32x4*)(ur + 768 + h * 256 + 8 * q); wv[rr] = *(const u32x4*)(ur + 768 + h * 256 + 128 + 8 * q); }
#pragma unroll
        for (int rr = 0; rr < 2; ++rr) {
            const int m = mb + rr; const bool lat = m < MLAT; const int s = m & 4095;
            bf16_t* ur = U + (size_t)m * UW; bf16_t* pr = P2 + (size_t)m * P2W;
            if (dry) { ur = (bf16_t*)(a.ws + WS_END + (size_t)F.gw * 8192); pr = ur + 2048; }
            float rq, rkv;
            { const float a0 = bflo(wcq[rr].x), a1 = bfhi(wcq[rr].x), a2 = bflo(wcq[rr].y), a3 = bfhi(wcq[rr].y);
              rq = __builtin_amdgcn_rsqf(wave_sum(a0 * a0 + a1 * a1 + a2 * a2 + a3 * a3) * (1.f / 256.f) + EPS); }
            { const float a0 = bflo(wckv[rr]), a1 = bfhi(wckv[rr]);
              rkv = __builtin_amdgcn_rsqf(wave_sum(a0 * a0 + a1 * a1) * (1.f / 128.f) + EPS); }
            float cs[4], sn[4];
            { const float prw = (float)(s >> 6), pcl = (float)(s & 63); float pos = usecol ? pcl : prw; asm volatile("" : "+v"(pos));
#pragma unroll
              for (int j = 0; j < 4; ++j) { const float rev = pos * invf[j], fr = rev - floorf(rev); cs[j] = lat ? __builtin_amdgcn_cosf(fr) : 1.f; sn[j] = lat ? __builtin_amdgcn_sinf(fr) : 0.f; } }
#pragma unroll
            for (int isk = 0; isk < 2; ++isk) {
                const u32x4 wn = isk ? wkn[rr] : wqn[rr]; const u32x2 wr2 = isk ? wkr[rr] : wqr[rr];
                const float sn_ = isk ? rkv : rq, sr_ = isk ? 1.0f : rq;
                float x[8] = {bflo(wn.x) * sn_, bfhi(wn.x) * sn_, bflo(wn.y) * sn_, bfhi(wn.y) * sn_, bflo(wn.z) * sn_, bfhi(wn.z) * sn_, bflo(wn.w) * sn_, bfhi(wn.w) * sn_};
                float y[4] = {bflo(wr2.x) * sr_, bfhi(wr2.x) * sr_, bflo(wr2.y) * sr_, bfhi(wr2.y) * sr_};
                float ss = 0.f;
#pragma unroll
                for (int j = 0; j < 8; ++j) ss += x[j] * x[j];
#pragma unroll
                for (int j = 0; j < 4; ++j) ss += y[j] * y[j];
                ss += __shfl_xor(ss, 1); ss += __shfl_xor(ss, 2); ss += __shfl_xor(ss, 4); ss += __shfl_xor(ss, 8);
                const float rs = __builtin_amdgcn_rsqf(ss * (1.f / 192.f) + EPS);
#pragma unroll
                for (int j = 0; j < 8; ++j) x[j] *= rs * (isk ? kgn[j] : qgn[j]);
#pragma unroll
                for (int j = 0; j < 4; ++j) { y[j] *= rs * (isk ? kgr[j] : qgr[j]);
                    const float p = __int_as_float(__builtin_amdgcn_ds_bpermute(pl, __float_as_int(y[j])));
                    y[j] = second ? y[j] * cs[j] + p * sn[j] : y[j] * cs[j] - p * sn[j]; }
                u32x4 o; o.x = pk2(x[0], x[1]); o.y = pk2(x[2], x[3]); o.z = pk2(x[4], x[5]); o.w = pk2(x[6], x[7]);
                u32x2 o2; o2.x = pk2(y[0], y[1]); o2.y = pk2(y[2], y[3]);
                *(u32x4*)(pr + 768 * isk + h * 192 + 8 * q) = o; *(u32x2*)(pr + 768 * isk + h * 192 + 128 + 4 * q) = o2;
            }
            { const u32x4 vw = wv[rr]; u32x4 o; o.x = pk2(bflo(vw.x) * rkv, bfhi(vw.x) * rkv); o.y = pk2(bflo(vw.y) * rkv, bfhi(vw.y) * rkv); o.z = pk2(bflo(vw.z) * rkv, bfhi(vw.z) * rkv); o.w = pk2(bflo(vw.w) * rkv, bfhi(vw.w) * rkv);
              *(u32x4*)(ur + 768 + h * 256 + 128 + 8 * q) = o; }
        }
    }
}

struct AU {
    const bf16_t *q, *k, *v; unsigned char* o;
    int ldq, ldk, ldv, ldo;
    int qrow0;
    int lat_row0, n_lat, ctx_row0, n_ctx;
    int mode;
    int qpos0, kpos0;
    float m0, l0;
    const float* rpb;
};
#define AT_PIN16(b) asm volatile("" : "+v"(b[0]), "+v"(b[1]), "+v"(b[2]), "+v"(b[3]), "+v"(b[4]), "+v"(b[5]), "+v"(b[6]), "+v"(b[7]), "+v"(b[8]), "+v"(b[9]), "+v"(b[10]), "+v"(b[11]), "+v"(b[12]), "+v"(b[13]), "+v"(b[14]), "+v"(b[15]))
#define AT_PIN4(b, j) asm volatile("" : "+v"(b[j]), "+v"(b[j + 1]), "+v"(b[j + 2]), "+v"(b[j + 3]))
template <int NDT, int VP, int P>
DI void att_tail(f32x16& s0, f32x16& s1, f32x16 (&o)[NDT], float& mrun, float& lrun, f32x16& negm, bool& fresh, const LAS unsigned char* Vt, int vlane_off, const LAS float* bp, int cs, int h) {
    constexpr float MTHR = 11.5f;
#define AT_A0(i) (P != 1 || (i) >= 12)
#define AT_A1(i) (P != 0 || (i) < 4)
    if constexpr (P >= 0) {
        float bb[16];
        if constexpr (P == 0) {
#pragma unroll
            for (int i = 0; i < 16; ++i) bb[i] = bp[(i & 3) + 8 * (i >> 2)];
            AT_PIN16(bb);
#pragma unroll
            for (int i = 0; i < 16; ++i) { const int kc = (i & 3) + 8 * (i >> 2) + 4 * h; const bool ok = (kc >= cs) && (kc < cs + 16); s0[i] = ok ? s0[i] + bb[i] : -INFINITY; }
#pragma unroll
            for (int i = 0; i < 4; ++i) bb[i] = bp[32 + i];
            AT_PIN4(bb, 0);
#pragma unroll
            for (int i = 0; i < 4; ++i) { const int kc = 32 + i + 4 * h; const bool ok = (kc >= cs) && (kc < cs + 16); s1[i] = ok ? s1[i] + bb[i] : -INFINITY; }
        } else {
#pragma unroll
            for (int i = 12; i < 16; ++i) bb[i] = bp[24 + (i & 3)];
            AT_PIN4(bb, 12);
#pragma unroll
            for (int i = 12; i < 16; ++i) { const int kc = 24 + (i & 3) + 4 * h; const bool ok = (kc >= cs) && (kc < cs + 16); s0[i] = ok ? s0[i] + bb[i] : -INFINITY; }
#pragma unroll
            for (int i = 0; i < 16; ++i) bb[i] = bp[32 + (i & 3) + 8 * (i >> 2)];
            AT_PIN16(bb);
#pragma unroll
            for (int i = 0; i < 16; ++i) { const int kc = 32 + (i & 3) + 8 * (i >> 2) + 4 * h; const bool ok = (kc >= cs) && (kc < cs + 16); s1[i] = ok ? s1[i] + bb[i] : -INFINITY; }
        }
    }
    float mx = (P == 1) ? s1[0] : s0[0];
#pragma unroll
    for (int i = 0; i < 16; ++i) { if (AT_A0(i)) mx = fmaxf(mx, s0[i]); if (AT_A1(i)) mx = fmaxf(mx, s1[i]); }
    mx = fmaxf(mx, __shfl_xor(mx, 32));
    if (fresh || __builtin_amdgcn_ballot_w64(mx > MTHR) != 0ull) {
        const float d = fresh ? (mx > -1e30f ? mx : 0.f) : fmaxf(mx, 0.f), alpha = fresh ? 1.0f : __builtin_amdgcn_exp2f(-d);
        lrun *= alpha; mrun += d; fresh = false;
#pragma unroll
        for (int i = 0; i < 16; ++i) negm[i] = -mrun;
#pragma unroll
        for (int dt = 0; dt < NDT; ++dt)
#pragma unroll
            for (int i = 0; i < 16; ++i) o[dt][i] *= alpha;
#pragma unroll
        for (int i = 0; i < 16; ++i) { if (AT_A0(i)) s0[i] -= d; if (AT_A1(i)) s1[i] -= d; }
    }
    float ls = 0.f;
#pragma unroll
    for (int i = 0; i < 16; ++i) {
        if (AT_A0(i)) { s0[i] = __builtin_amdgcn_exp2f(s0[i]); ls += s0[i]; } else s0[i] = 0.f;
        if (AT_A1(i)) { s1[i] = __builtin_amdgcn_exp2f(s1[i]); ls += s1[i]; } else s1[i] = 0.f;
    }
    lrun += ls;
    bf16x8 pf[4];
    { u32x4 w;
      w.x = pk2(s0[0], s0[1]); w.y = pk2(s0[2], s0[3]); w.z = pk2(s0[4], s0[5]); w.w = pk2(s0[6], s0[7]); pf[0] = __builtin_bit_cast(bf16x8, w);
      if (P == 1) { w.x = 0u; w.y = 0u; } else { w.x = pk2(s0[8], s0[9]); w.y = pk2(s0[10], s0[11]); } w.z = pk2(s0[12], s0[13]); w.w = pk2(s0[14], s0[15]); pf[1] = __builtin_bit_cast(bf16x8, w);
      w.x = pk2(s1[0], s1[1]); w.y = pk2(s1[2], s1[3]); if (P == 0) { w.z = 0u; w.w = 0u; } else { w.z = pk2(s1[4], s1[5]); w.w = pk2(s1[6], s1[7]); } pf[2] = __builtin_bit_cast(bf16x8, w);
      w.x = pk2(s1[8], s1[9]); w.y = pk2(s1[10], s1[11]); w.z = pk2(s1[12], s1[13]); w.w = pk2(s1[14], s1[15]); pf[3] = __builtin_bit_cast(bf16x8, w); }
#pragma unroll
    for (int kk = 0; kk < 4; ++kk) {
        if ((P == 0 && kk == 3) || (P == 1 && kk == 0)) continue;
#pragma unroll
        for (int dt = 0; dt < NDT; ++dt) {
            const LAS unsigned char* vp = Vt + (16 * kk) * VP + vlane_off + 64 * dt;
            const s16x4 lo = __builtin_amdgcn_ds_read_tr16_b64_v4i16((LAS s16x4*)vp);
            const s16x4 hi = __builtin_amdgcn_ds_read_tr16_b64_v4i16((LAS s16x4*)(vp + 8 * VP));
            const bf16x8 vf = __builtin_shufflevector(lo, hi, 0, 1, 2, 3, 4, 5, 6, 7);
            o[dt] = __builtin_amdgcn_mfma_f32_32x32x16_bf16(vf, pf[kk], o[dt], 0, 0, 0);
        }
    }
#undef AT_A0
#undef AT_A1
}
template <int DQ, int DV, int LDK, int LDV>
DI void attn_unit(LAS unsigned char* lds, const AU& u, int tid, int wave, int lane) {
    constexpr int KP = DQ * 2 + 16, VP = DV * 2 + 64, KBY = 64 * KP, VBY = 64 * VP, STG = KBY + VBY;
    constexpr int NKS = DQ / 16, NDT = DV / 32, KCH = DQ / 8, VCH = DV / 8;
    constexpr int KC = KP / 16, VC = VP / 16;
    constexpr int KI = (KC + 7) / 8, VI = (VC + 7) / 8;
    constexpr int BIAS_OFF = 98304;
    static_assert(2 * STG <= BIAS_OFF && KBY % 1024 == 0 && VBY % 1024 == 0, "attention LDS");
    const int r = lane & 31, h = lane >> 5;
    const int nt = u.n_lat + u.n_ctx;
    LAS float* btab = (LAS float*)(lds + BIAS_OFF);
    if (u.mode == 2) { for (int i = tid; i < 15 * 31; i += 512) btab[i] = u.rpb[i] * LOG2E; }
    bf16x8 qf[NKS];
    { const bf16_t* qp = u.q + (size_t)(u.qrow0 + wave * 32 + r) * u.ldq + 8 * h;
#pragma unroll
      for (int ks = 0; ks < NKS; ++ks) qf[ks] = *(const bf16x8*)(qp + 16 * ks); }
    f32x16 o[NDT];
#pragma unroll
    for (int dt = 0; dt < NDT; ++dt)
#pragma unroll
        for (int i = 0; i < 16; ++i) o[dt][i] = 0.f;
    bool fresh = u.m0 < -1e29f;
    float mrun = fresh ? 0.f : u.m0, lrun = (h == 0) ? u.l0 : 0.f;
    f32x16 negm;
#pragma unroll
    for (int i = 0; i < 16; ++i) negm[i] = -mrun;
    unsigned koff[KI], voff[VI];
#pragma unroll
    for (int i = 0; i < KI; ++i) { const int c = 64 * (wave + 8 * i) + lane, row = c / KC, cc = c % KC; koff[i] = (unsigned)(row * LDK * 2 + (cc < KCH ? cc : KCH - 1) * 16); }
#pragma unroll
    for (int i = 0; i < VI; ++i) { const int c = 64 * (wave + 8 * i) + lane, row = c / VC, cc = c % VC; voff[i] = (unsigned)(row * LDV * 2 + (cc < VCH ? cc : VCH - 1) * 16); }
#define AT_ROWBASE(t) ((t) < u.n_lat ? u.lat_row0 + 64 * (t) : u.ctx_row0 + 64 * ((t) - u.n_lat))
#define AT_ISSUE(t, buf) do { const int rb_ = AT_ROWBASE(t); const char* kb_ = (const char*)(u.k + (size_t)rb_ * LDK); const char* vb_ = (const char*)(u.v + (size_t)rb_ * LDV); \
        _Pragma("unroll") for (int i_ = 0; i_ < KI; ++i_) { const int j_ = wave + 8 * i_; if (j_ < KC) __builtin_amdgcn_global_load_lds((const unsigned*)(kb_ + koff[i_]), (LAS unsigned*)(lds + (buf) * STG + j_ * 1024), 16, 0, 0); } \
        _Pragma("unroll") for (int i_ = 0; i_ < VI; ++i_) { const int j_ = wave + 8 * i_; if (j_ < VC) __builtin_amdgcn_global_load_lds((const unsigned*)(vb_ + voff[i_]), (LAS unsigned*)(lds + (buf) * STG + KBY + j_ * 1024), 16, 0, 0); } } while (0)
    AT_ISSUE(0, 0);
    asm volatile("s_waitcnt vmcnt(0)" ::: "memory");
    __syncthreads();
    const int tq = (lane & 15) >> 2, tp = lane & 3, tblk = (lane >> 4) & 1;
    const int vlane_off = (4 * h + tq) * VP + 32 * tblk + 8 * tp;
    for (int t = 0; t < nt; ++t) {
        const int buf = t & 1;
        if (t + 1 < nt) AT_ISSUE(t + 1, buf ^ 1);
        bool skip = false; int a0 = 0, a1 = 0;
        bool inband = false;
        if (u.mode == 1 && t < u.n_lat) { const int k0 = u.kpos0 + 64 * t, q0 = u.qpos0 + 32 * wave; skip = (k0 > q0 + 31 + 128) || (k0 + 63 < q0 - 128); a0 = k0; a1 = q0; inband = (k0 >= q0 + 31 - 128) && (k0 + 63 <= q0 + 128); }
        if (u.mode == 2 && t < u.n_lat) { const int kr = u.kpos0 + t, qr = u.qpos0 + (wave >> 1); int rs = qr - 4; rs = rs < 0 ? 0 : (rs > 56 ? 56 : rs); skip = (kr < rs) || (kr >= rs + 8); a0 = kr - qr + 7; }
        if (!skip) {
            const LAS unsigned char* Kt = lds + buf * STG; const LAS unsigned char* Vt = Kt + KBY;
            f32x16 s0, s1;
#pragma unroll
            for (int ks = 0; ks < NKS; ++ks) {
                const bf16x8 k0 = *(const LAS bf16x8*)(Kt + r * KP + (16 * ks + 8 * h) * 2);
                const bf16x8 k1 = *(const LAS bf16x8*)(Kt + (32 + r) * KP + (16 * ks + 8 * h) * 2);
                s0 = __builtin_amdgcn_mfma_f32_32x32x16_bf16(k0, qf[ks], ks == 0 ? negm : s0, 0, 0, 0);
                s1 = __builtin_amdgcn_mfma_f32_32x32x16_bf16(k1, qf[ks], ks == 0 ? negm : s1, 0, 0, 0);
            }
            if (u.mode == 1 && t < u.n_lat && !inband) {
                const int qpos = a1 + r;
#pragma unroll
                for (int i = 0; i < 16; ++i) { const int kk = a0 + (i & 3) + 8 * (i >> 2) + 4 * h; int d0 = qpos - kk; d0 = d0 < 0 ? -d0 : d0; int d1 = qpos - (kk + 32); d1 = d1 < 0 ? -d1 : d1;
                    s0[i] = d0 <= 128 ? s0[i] : -INFINITY; s1[i] = d1 <= 128 ? s1[i] : -INFINITY; }
            }
            if (DQ == 64 && u.mode == 2 && t < u.n_lat) {
                const int qc = 32 * (wave & 1) + r; int cs = qc - 8; cs = cs < 0 ? 0 : (cs > 48 ? 48 : cs);
                const LAS float* bp = btab + (a0 * 31 + 15 - qc + 4 * h);
                if ((wave & 1) == 0) att_tail<NDT, VP, (DQ == 64 ? 0 : -1)>(s0, s1, o, mrun, lrun, negm, fresh, Vt, vlane_off, bp, cs, h);
                else att_tail<NDT, VP, (DQ == 64 ? 1 : -1)>(s0, s1, o, mrun, lrun, negm, fresh, Vt, vlane_off, bp, cs, h);
            } else att_tail<NDT, VP, -1>(s0, s1, o, mrun, lrun, negm, fresh, Vt, vlane_off, nullptr, 0, h);
        }
        asm volatile("s_waitcnt vmcnt(0)" ::: "memory");
        __syncthreads();
    }
    const float ltot = lrun + __shfl_xor(lrun, 32), inv = 1.0f / ltot;
    unsigned char* op = u.o + (size_t)(u.qrow0 + wave * 32 + r) * u.ldo + 4 * h;
    const float inv4 = inv * 4.0f;
#pragma unroll
    for (int dt = 0; dt < NDT; ++dt)
#pragma unroll
        for (int g = 0; g < 4; ++g) *(unsigned*)(op + 32 * dt + 8 * g) = pk4_fp8(o[dt][4 * g] * inv4, o[dt][4 * g + 1] * inv4, o[dt][4 * g + 2] * inv4, o[dt][4 * g + 3] * inv4);
#undef AT_ROWBASE
#undef AT_ISSUE
}

DI void attn_phase(Frame& F, KArgs ka, int l) {
    KA_FRESH(ka); const __attribute__((address_space(4))) Args& a = *ka; frame_fresh(F);
    const bf16_t* HW = (const bf16_t*)(a.ws + WS_HW);
    const bf16_t* P1 = (const bf16_t*)(a.ws + WS_P1);
    const bf16_t* P2 = (const bf16_t*)(a.ws + WS_P2);
    const bf16_t* U = (const bf16_t*)(a.ws + WS_R4);
    unsigned char* OC = a.ws + WS_OCAT;
    const bool last = (l == NL - 1);
    constexpr int nA = 512, nB = 768, nC = 768;
    const int ntot = nA + nB + nC + (last ? 0 : 128);
#ifndef ATT_PROBE
#define ATT_PROBE 0
#endif
    for (int rep2_ = 0; rep2_ < 1 + (ATT_PROBE != 0); ++rep2_)
    for (int id = F.vcu; id < ntot; id += F.G) {
        if (rep2_ == 1 && !((ATT_PROBE == 1) ? (id < nA) : (id >= nA && id < nA + nB))) continue;
        AU u; bool big = false;
        u.mode = 0; u.qpos0 = 0; u.kpos0 = 0; u.m0 = -1e30f; u.l0 = 0.f; u.rpb = nullptr; u.n_ctx = 4;
        if (id < nA) {
            const int b = id >> 6, h = (id >> 4) & 3, qb = id & 15; big = true;
            u.q = P2 + h * 192; u.ldq = P2W; u.k = P2 + 768 + h * 192; u.ldk = P2W; u.v = U + 768 + h * 256 + 128; u.ldv = UW; u.o = OC + 512 + h * 128; u.ldo = OCW;
            u.qrow0 = b * SEQ + qb * 256; u.lat_row0 = b * SEQ; u.n_lat = 64; u.ctx_row0 = MLAT + b * CTX;
        } else if (id < nA + nB) {
            const int j = id - nA, b = j / 96, h = (j >> 4) % 6, qb = j & 15;
            u.q = P1 + h * 64; u.ldq = P1W; u.k = P1 + 384 + h * 64; u.ldk = P1W; u.v = HW + C_NAV + h * 64; u.ldv = DINP; u.o = OC + h * 64; u.ldo = OCW;
            int rlo = 4 * qb - 4; rlo = rlo < 0 ? 0 : (rlo > 56 ? 56 : rlo); int rhi = 4 * qb + 3 - 4; rhi = (rhi < 0 ? 0 : (rhi > 56 ? 56 : rhi)) + 7;
            u.qrow0 = b * SEQ + qb * 256; u.lat_row0 = b * SEQ + rlo * 64; u.n_lat = rhi - rlo + 1; u.ctx_row0 = MLAT + b * CTX;
            u.mode = 2; u.qpos0 = 4 * qb; u.kpos0 = rlo; u.rpb = a.in[I_RPB] + (size_t)(l * 6 + h) * 465;
        } else if (id < nA + nB + nC) {
            const int j = id - nA - nB, b = j / 96, hq = (j >> 4) % 6, qb = j & 15, kvh = hq / 3;
            u.q = P1 + 768 + hq * 64; u.ldq = P1W; u.k = P1 + 1152 + kvh * 64; u.ldk = P1W; u.v = HW + C_SWV + kvh * 64; u.ldv = DINP; u.o = OC + 1024 + hq * 64; u.ldo = OCW;
            int klo = qb * 256 - 128; klo = klo < 0 ? 0 : klo; int khi = qb * 256 + 384; khi = khi > SEQ ? SEQ : khi;
            u.qrow0 = b * SEQ + qb * 256; u.lat_row0 = b * SEQ + klo; u.n_lat = (khi - klo) >> 6; u.ctx_row0 = MLAT + b * CTX;
            u.mode = 1; u.qpos0 = qb * 256; u.kpos0 = klo; u.m0 = a.in[I_SINK][l * 6 + hq] * LOG2E; u.l0 = 1.f;
        } else {
            const int j = id - nA - nB - nC;
            u.n_lat = 0; u.lat_row0 = 0;
            if (j < 32) { const int b = j >> 2, h = j & 3; big = true;
                u.q = P2 + h * 192; u.ldq = P2W; u.k = P2 + 768 + h * 192; u.ldk = P2W; u.v = U + 768 + h * 256 + 128; u.ldv = UW; u.o = OC + 512 + h * 128; u.ldo = OCW;
                u.qrow0 = MLAT + b * CTX; u.ctx_row0 = MLAT + b * CTX;
            } else if (j < 80) { const int jj = j - 32, b = jj / 6, h = jj % 6;
                u.q = P1 + h * 64; u.ldq = P1W; u.k = P1 + 384 + h * 64; u.ldk = P1W; u.v = HW + C_NAV + h * 64; u.ldv = DINP; u.o = OC + h * 64; u.ldo = OCW;
                u.qrow0 = MLAT + b * CTX; u.ctx_row0 = MLAT + b * CTX;
            } else { const int jj = j - 80, b = jj / 6, hq = jj % 6, kvh = hq / 3;
                u.q = P1 + 768 + hq * 64; u.ldq = P1W; u.k = P1 + 1152 + kvh * 64; u.ldk = P1W; u.v = HW + C_SWV + kvh * 64; u.ldv = DINP; u.o = OC + 1024 + hq * 64; u.ldo = OCW;
                u.qrow0 = MLAT + b * CTX; u.ctx_row0 = MLAT + b * CTX; u.m0 = a.in[I_SINK][l * 6 + hq] * LOG2E; u.l0 = 1.f;
            }
        }
        if (big) attn_unit<192, 128, P2W, UW>(F.lds, u, F.tid, F.wave, F.lane);
        else attn_unit<64, 64, P1W, DINP>(F.lds, u, F.tid, F.wave, F.lane);
    }
}

DI void norm2_phase(Frame& F, KArgs ka, int l, int nrows) {
    KA_FRESH(ka); const __attribute__((address_space(4))) Args& a = *ka; frame_fresh(F);
    LAS float* rt = (LAS float*)F.lds;
    const float* rg = a.in[I_ROUTER] + (size_t)l * 1024 * 16;
    for (int i = F.tid; i < 16384; i += 512) rt[i] = rg[i];
    __syncthreads();
    LAS float* xr = (LAS float*)(F.lds + 65536 + F.wave * 8192);
    const bf16_t* xs = (const bf16_t*)(a.ws + WS_XS);
    const float* modv = (const float*)(a.ws + WS_MODV);
    unsigned char* H2 = a.ws + WS_H2;
    float* AFL = (float*)(a.ws + WS_AFL); float* AFC = (float*)(a.ws + WS_AFC);
    const int eq = F.lane & 3, kq = F.lane >> 2;
    u32x2 xw[2][4];
#define N2_LOAD(mb_) do { _Pragma("unroll") for (int rr_ = 0; rr_ < 2; ++rr_) { const u32x2* xp_ = (const u32x2*)(xs + (size_t)((mb_) + rr_) * D) + F.lane; \
        _Pragma("unroll") for (int j_ = 0; j_ < 4; ++j_) xw[rr_][j_] = xp_[64 * j_]; } } while (0)
    if (2 * F.gw < nrows) N2_LOAD(2 * F.gw);
    for (int mb = 2 * F.gw; mb < nrows; mb += 2 * F.ngw) {
        const int mi = mod_index(mb);
        f32x4 v[2][4];
#pragma unroll
        for (int rr = 0; rr < 2; ++rr)
#pragma unroll
            for (int j = 0; j < 4; ++j) { const u32x2 w = xw[rr][j]; v[rr][j] = (f32x4){bflo(w.x), bfhi(w.x), bflo(w.y), bfhi(w.y)}; }
        if (mb + 2 * F.ngw < nrows) N2_LOAD(mb + 2 * F.ngw);
        const f32x4* g = (const f32x4*)(a.in[I_N2G] + l * D) + F.lane;
        const f32x4* sh = (const f32x4*)(modv + ((size_t)l * 9 + mi) * 6144 + 3 * 1024) + F.lane;
        const f32x4* sc = (const f32x4*)(modv + ((size_t)l * 9 + mi) * 6144 + 4 * 1024) + F.lane;
        f32x4 gg[4], shv[4];
#pragma unroll
        for (int j = 0; j < 4; ++j) { gg[j] = g[64 * j] * (sc[64 * j] + 1.0f); shv[j] = sh[64 * j]; }
#pragma unroll
        for (int rr = 0; rr < 2; ++rr) {
            float ss = 0.f;
#pragma unroll
            for (int j = 0; j < 4; ++j) ss += (v[rr][j].x * v[rr][j].x + v[rr][j].y * v[rr][j].y) + (v[rr][j].z * v[rr][j].z + v[rr][j].w * v[rr][j].w);
            const float rstd = __builtin_amdgcn_rsqf(wave_sum(ss) * (1.f / D) + EPS);
            unsigned* o = (unsigned*)(H2 + (size_t)(mb + rr) * D) + F.lane;
#pragma unroll
            for (int j = 0; j < 4; ++j) { const f32x4 hh = v[rr][j] * rstd * gg[j] + shv[j]; o[64 * j] = pk4_fp8(hh.x, hh.y, hh.z, hh.w);
                *(LAS f32x4*)(xr + rr * 1024 + 4 * F.lane + 256 * j) = hh; }
        }
        asm volatile("s_waitcnt lgkmcnt(0)" ::: "memory");
        f32x4 acc[2] = {{0.f, 0.f, 0.f, 0.f}, {0.f, 0.f, 0.f, 0.f}};
#pragma unroll 8
        for (int i = 0; i < 64; ++i) { const int k = kq + 16 * i; const float x0 = xr[k], x1 = xr[1024 + k]; const f32x4 w = *(const LAS f32x4*)(rt + k * 16 + 4 * eq); acc[0] += w * x0; acc[1] += w * x1; }
        asm volatile("s_waitcnt lgkmcnt(0)" ::: "memory");
#pragma unroll
        for (int rr = 0; rr < 2; ++rr) { const int m = mb + rr; f32x4 ac = acc[rr];
#pragma unroll
            for (int ofs = 4; ofs < 64; ofs <<= 1) { ac.x += __shfl_xor(ac.x, ofs); ac.y += __shfl_xor(ac.y, ofs); ac.z += __shfl_xor(ac.z, ofs); ac.w += __shfl_xor(ac.w, ofs); }
            float mx = fmaxf(fmaxf(ac.x, ac.y), fmaxf(ac.z, ac.w)); mx = fmaxf(mx, __shfl_xor(mx, 1)); mx = fmaxf(mx, __shfl_xor(mx, 2));
            f32x4 ex; ex.x = __expf(ac.x - mx); ex.y = __expf(ac.y - mx); ex.z = __expf(ac.z - mx); ex.w = __expf(ac.w - mx);
            float sum = (ex.x + ex.y) + (ex.z + ex.w); sum += __shfl_xor(sum, 1); sum += __shfl_xor(sum, 2);
            const float inv = 1.0f / sum;
            if (F.lane < 4) {
                if (m < MLAT) { const int b = m >> 12, s = m & 4095; float* p = AFL + ((size_t)(b * 16 + 4 * F.lane)) * 4096 + s; p[0] = ex.x * inv; p[4096] = ex.y * inv; p[2 * 4096] = ex.z * inv; p[3 * 4096] = ex.w * inv; }
                else { const int b = (m - MLAT) >> 8, s = (m - MLAT) & 255; float* p = AFC + ((size_t)(b * 16 + 4 * F.lane)) * 256 + s; p[0] = ex.x * inv; p[256] = ex.y * inv; p[512] = ex.z * inv; p[768] = ex.w * inv; }
            }
        }
    }
}

DI unsigned block_excl_scan(unsigned v, unsigned& total, LAS unsigned* wsum, int tid, int lane, int wave) {
    unsigned x = v;
#pragma unroll
    for (int o = 1; o < 64; o <<= 1) { const unsigned y = __shfl_up(x, o); if (lane >= o) x += y; }
    if (lane == 63) wsum[wave] = x;
    __syncthreads();
    unsigned base = 0, tot = 0;
#pragma unroll
    for (int w = 0; w < 8; ++w) { const unsigned s = wsum[w]; if (w < wave) base += s; tot += s; }
    __syncthreads();
    total = tot;
    return base + x - v;
}
DI void select_phase(Frame& F, KArgs ka, int l) {
    KA_FRESH(ka); const __attribute__((address_space(4))) Args& a = *ka; frame_fresh(F);
    const bool last = (l == NL - 1);
    const int nunits = last ? 128 : 256;
    LAS unsigned* hist = (LAS unsigned*)F.lds;
    LAS unsigned* wsum = (LAS unsigned*)(F.lds + 8192);
    LAS unsigned* bc = (LAS unsigned*)(F.lds + 8192 + 64);
    LAS int* sel = (LAS int*)(F.lds + 16384);
    const float* AFL = (const float*)(a.ws + WS_AFL); const float* AFC = (const float*)(a.ws + WS_AFC);
    int* smap = (int*)(a.ws + WS_SMAP); float* gate = (float*)(a.ws + WS_GATE);
    const unsigned char* H2 = a.ws + WS_H2; unsigned char* XG = a.ws + WS_XG;
    for (int unit = blockIdx.x; unit < nunits; unit += F.G) {
        const bool lat = unit < 128; const int be = unit & 127, b = be >> 4, e = be & 15;
        const int N = lat ? 4096 : 256, cap = lat ? CAP_LAT : CAP_CTX;
        const float* aff = lat ? AFL + (size_t)be * 4096 : AFC + (size_t)be * 256;
        unsigned key[8]; const int per = lat ? 8 : 1; const bool act = lat || F.tid < 256;
#pragma unroll
        for (int j = 0; j < 8; ++j) key[j] = (act && j < per) ? __float_as_uint(aff[F.tid * per + j]) : 0u;
        unsigned prefix = 0u, pmask = 0u, need = (unsigned)cap;
#pragma unroll
        for (int pass = 0; pass < 3; ++pass) {
            const int shift = pass == 0 ? 21 : (pass == 1 ? 10 : 0), nb = pass == 2 ? 1024 : 2048;
            for (int i = F.tid; i < 2048; i += 512) hist[i] = 0u;
            __syncthreads();
#pragma unroll
            for (int j = 0; j < 8; ++j) if (act && j < per && (key[j] & pmask) == prefix) (void)__hip_atomic_fetch_add(&hist[(key[j] >> shift) & (nb - 1)], 1u, __ATOMIC_RELAXED, __HIP_MEMORY_SCOPE_WORKGROUP);
            __syncthreads();
            unsigned c4[4], mine = 0;
#pragma unroll
            for (int j = 0; j < 4; ++j) { const int bin = 2047 - 4 * F.tid - j; c4[j] = bin < nb ? hist[bin] : 0u; mine += c4[j]; }
            unsigned tot; unsigned run = block_excl_scan(mine, tot, wsum, F.tid, F.lane, F.wave);
#pragma unroll
            for (int j = 0; j < 4; ++j) { const int bin = 2047 - 4 * F.tid - j;
                if (bin < nb && run < need && run + c4[j] >= need) { bc[0] = (unsigned)bin; bc[1] = run; }
                run += c4[j]; }
            __syncthreads();
            const unsigned cb = bc[0], above = bc[1];
            prefix |= cb << shift; pmask |= (unsigned)(nb - 1) << shift; need -= above;
            __syncthreads();
        }
        unsigned neq = 0, ngt = 0;
#pragma unroll
        for (int j = 0; j < 8; ++j) if (act && j < per) { neq += key[j] == prefix; ngt += key[j] > prefix; }
        unsigned teq; const unsigned eqbase = block_excl_scan(neq, teq, wsum, F.tid, F.lane, F.wave);
        unsigned nsel = 0, flags = 0, erun = eqbase;
#pragma unroll
        for (int j = 0; j < 8; ++j) if (act && j < per) { bool s = key[j] > prefix; if (key[j] == prefix) { s = erun < need; ++erun; } if (s) { flags |= 1u << j; ++nsel; } }
        unsigned tsel; unsigned sbase = block_excl_scan(nsel, tsel, wsum, F.tid, F.lane, F.wave);
        const int rowbase = lat ? b * SEQ : MLAT + b * CTX;
        const int slotbase = lat ? be * CAP_LAT : NSLOT_LAT + (e * 8 + b) * CAP_CTX;
#pragma unroll
        for (int j = 0; j < 8; ++j) if (act && j < per) { const int tok = F.tid * per + j; int slot = -1;
            if ((flags >> j) & 1u) { slot = slotbase + (int)sbase; sel[sbase] = tok; gate[slot] = __uint_as_float(key[j]); ++sbase; }
            smap[(size_t)e * MT + rowbase + tok] = slot; }
        __syncthreads();
        if (lat) {
            for (int t0 = F.wave * 16; t0 < cap; t0 += 128) {
                u32x4 rowv[16];
#pragma unroll
                for (int q = 0; q < 16; ++q) rowv[q] = ((const u32x4*)(H2 + (size_t)(rowbase + sel[t0 + q]) * D))[F.lane];
#pragma unroll
                for (int q = 0; q < 16; ++q) ((u32x4*)(XG + (size_t)(slotbase + t0 + q) * D))[F.lane] = rowv[q];
            }
        } else {
            const int t0 = F.wave * 4;
            u32x4 rowv[4];
#pragma unroll
            for (int q = 0; q < 4; ++q) rowv[q] = ((const u32x4*)(H2 + (size_t)(rowbase + sel[t0 + q]) * D))[F.lane];
#pragma unroll
            for (int q = 0; q < 4; ++q) ((u32x4*)(XG + (size_t)(slotbase + t0 + q) * D))[F.lane] = rowv[q];
        }
        __syncthreads();
    }
}

#ifndef Q_INA
#define Q_INA 3
#endif
#ifndef Q_INB
#define Q_INB 6
#endif
#ifndef Q_INC
#define Q_INC 9
#endif
#ifndef Q_MRG
#define Q_MRG 9
#endif
#ifndef Q_WO
#define Q_WO 2
#endif
#ifndef Q_GU
#define Q_GU 3
#endif
#ifndef Q_DN
#define Q_DN 3
#endif
#define TAIL1(nwg_, Q_) do { const int r_ = (nwg_) % F.G; if (!last && r_ != 0) { if (bx >= r_) convert_tail(F, ka, l + 1, cur + 8 * (Q_) * (bx - r_), (Q_)); cur += 8 * (Q_) * (F.G - r_); } } while (0)
DI unsigned char* ws_fresh(KArgs ka) { KA_FRESH(ka); return ka->ws; }
__global__ void __launch_bounds__(512, 2) mega_fwd(Args a_unused) {
    extern __shared__ __attribute__((aligned(16))) unsigned char lds_raw[];
    KArgs ka = (KArgs)__builtin_amdgcn_kernarg_segment_ptr();
    Frame F;
    F.lds = (LAS unsigned char*)lds_raw;
    F.tid = threadIdx.x; F.lane = F.tid & 63; F.wave = __builtin_amdgcn_readfirstlane(F.tid >> 6);
    F.G = gridDim.x; { const int bx = blockIdx.x; F.vcu = (F.G % 8 == 0) ? (bx % 8) * (F.G / 8) + bx / 8 : bx; }
    F.gw = F.vcu * 8 + F.wave; F.ngw = F.G * 8;
    for (int u = F.tid; u < (LDS_BYTES - LDSCTL_OFF) / 4; u += 512) ((LAS unsigned*)(F.lds + LDSCTL_OFF))[u] = 0u;
    __syncthreads();
    XcdBarrier bar = xcd_barrier_post((unsigned*)(ws_fresh(ka) + WS_CTL) + CW_BAR, (volatile LAS unsigned*)(F.lds + LDSCTL_OFF + 32));
#define GRID_BAR() xcd_barrier(bar)
    const int bx = blockIdx.x;

    if (PH(0)) modv_phase(F, ka);
    for (int rep_ = 0; rep_ < REPS(2); ++rep_) if (PH(2)) convert_weights(F, ka, 0, 0);
    GRID_BAR();
    if (PH(3)) row_phase(F, ka, 0);
    GRID_BAR();

    for (int l = 0; l < NL; ++l) {
        const bool last = (l == NL - 1);
        const int nMe = last ? MLAT / 256 : MT / 256;
        const int nMs = last ? NSLOT_LAT / 256 : NSLOT / 256;
        int cur = 0;
        if (PH(4)) { unsigned char* ws = ws_fresh(ka);
            for (int rep_ = 0; rep_ < REPS(4); ++rep_) { pg8::Gemm g{(const bf16_t*)(ws + WS_R4), (const bf16_t*)wsel(ws, l, W_IN), 1024, 1024, 1024, 0}; pg8::Order S; S.init(MT / 256, DINP / 256, F.G, bx);
              pg8::EpiStoreBf16 E{(bf16_t*)(ws + WS_HW), DINP}; pg8::gemm_phase(F.lds, g, S, E); }
            for (int rep_ = 0; rep_ < REPS(17); ++rep_) { pg8::Gemm g{(const bf16_t*)(ws + WS_R4 + 68 * MiB), (const bf16_t*)wsel(ws, l, W_GL), 1024, 1024, 1024, 0}; pg8::Order S; S.init(MT / 256, NGL / 256, F.G, (bx + F.G / 2) % F.G);
              pg8::EpiGate E{ws + WS_G}; pg8::gemm_phase<pg8::EpiGate, true>(F.lds, g, S, E); } }
        if (!last && F.G == 256) {
            int q = 0, off = 0;
            if (bx < 128) { q = Q_INA; off = bx * Q_INA; } else if (bx >= 224) { q = Q_INC; off = 128 * Q_INA + 24 * Q_INB + (bx - 224) * Q_INC; } else if (bx >= 200) { q = Q_INB; off = 128 * Q_INA + (bx - 200) * Q_INB; }
            if (q) convert_tail(F, ka, l + 1, cur + 8 * off, q);
            cur += 8 * (128 * Q_INA + 24 * Q_INB + 32 * Q_INC); }
        GRID_BAR();
        for (int rep_ = 0; rep_ < REPS(5); ++rep_) if (PH(5)) { unsigned char* ws = ws_fresh(ka); pg8::Gemm g{(const bf16_t*)(ws + WS_HW) + C_CQ, (const bf16_t*)wsel(ws, l, W_UP), 384, DINP, 384, 0}; pg8::Order S; S.init(MT / 256, UW / 256, F.G, bx);
            pg8::EpiStoreBf16 E{(bf16_t*)(ws + WS_R4), UW}; pg8::gemm_phase(F.lds, g, S, E); }
        for (int rep_ = 0; rep_ < REPS(6); ++rep_) if (PH(6)) prep_phase(F, ka, l);
        GRID_BAR();
        for (int rep_ = 0; rep_ < REPS(7); ++rep_) if (PH(7)) prep2_phase(F, ka, l, rep_);
        GRID_BAR();
        for (int rep_ = 0; rep_ < REPS(8); ++rep_) if (PH(8)) attn_phase(F, ka, l);
        GRID_BAR();
        for (int rep_ = 0; rep_ < REPS(9); ++rep_) if (PH(9)) { unsigned char* ws = ws_fresh(ka); pg8::Order S; S.init(nMe, 4, F.G, bx);
          const unsigned char* OC = ws + WS_OCAT; bf16_t* MG = (bf16_t*)(ws + WS_MERGED); const unsigned char* GL = ws + WS_G;
          { pg8::Gemm3 g{OC, OC + 512, OC + 1024, wsel(ws, l, W_NAO), wsel(ws, l, W_MLAO), wsel(ws, l, W_SWAO), OCW, 512}; pg8::EpiMerge3 E{MG, GL}; pg8::gemm_phase3(F.lds, g, S, E); } }
        TAIL1(nMe * 4, Q_MRG);
        GRID_BAR();
        if (PH(10)) { unsigned char* ws = ws_fresh(ka); pg8::Gemm g{(const bf16_t*)(ws + WS_MERGED), (const bf16_t*)wsel(ws, l, W_O), 1024, 1024, 1024, 0}; pg8::Order S; S.init(nMe, 4, F.G, bx);
            pg8::EpiResid E{(bf16_t*)(ws + WS_XS), (const float*)(ws + WS_MODV) + (size_t)l * 9 * 6144 + 2 * 1024}; pg8::gemm_phase<pg8::EpiResid, true>(F.lds, g, S, E); }
        TAIL1(nMe * 4, Q_WO);
        GRID_BAR();
        for (int rep_ = 0; rep_ < REPS(11); ++rep_) if (PH(11)) norm2_phase(F, ka, l, last ? MLAT : MT);
        GRID_BAR();
        for (int rep_ = 0; rep_ < REPS(12); ++rep_) if (PH(12)) select_phase(F, ka, l);
        GRID_BAR();
        for (int rep_ = 0; rep_ < REPS(13); ++rep_) if (PH(13)) { unsigned char* ws = ws_fresh(ka); pg8::Gemm g{(const bf16_t*)(ws + WS_XG), (const bf16_t*)wsel(ws, l, W_GU), 1024, 1024, 1024, (size_t)2048 * 1024}; pg8::Order S; S.init(nMs, 8, F.G, bx, 1);
            pg8::EpiSwiglu E{ws + WS_ACT}; pg8::gemm_phase<pg8::EpiSwiglu, true>(F.lds, g, S, E); }
        TAIL1(nMs * 8, Q_GU);
        GRID_BAR();
        for (int rep_ = 0; rep_ < REPS(14); ++rep_) if (PH(14)) { unsigned char* ws = ws_fresh(ka); pg8::Gemm g{(const bf16_t*)(ws + WS_ACT), (const bf16_t*)wsel(ws, l, W_DN), 1024, 1024, 1024, (size_t)1024 * 1024}; pg8::Order S; S.init(nMs, 4, F.G, bx, 1);
            pg8::EpiDown E{(bf16_t*)(ws + WS_Y), (const float*)(ws + WS_GATE)}; pg8::gemm_phase<pg8::EpiDown, true>(F.lds, g, S, E); }
        TAIL1(nMs * 4, Q_DN);
        GRID_BAR();
        for (int rep_ = 0; rep_ < REPS(15); ++rep_) if (PH(15)) row_phase(F, ka, l + 1, rep_);
        if (!last) { for (int rep_ = 0; rep_ < REPS(16); ++rep_) if (PH(16)) convert_weights(F, ka, l + 1, cur); GRID_BAR(); }
    }
}

extern "C" void kernel_launch(void* const* d_in, const int* in_sizes, int n_in, void* d_out, int out_size, void* d_ws, size_t ws_size, hipStream_t stream) {
    static int grid = 0;
    if (grid == 0) {
        if (n_in != 29 || in_sizes[0] != MLAT * D || out_size != MLAT * D || ws_size < WS_END) {
            fprintf(stderr, "kernel_launch: unexpected problem: n_in %d in0 %d out %d ws %zu (need %zu)\n", n_in, n_in > 0 ? in_sizes[0] : -1, out_size, ws_size, (size_t)WS_END); grid = -1; return; }
        int dev = 0, cus = 0, per_cu = 0;
        if (hipGetDevice(&dev) != hipSuccess || hipDeviceGetAttribute(&cus, hipDeviceAttributeMultiprocessorCount, dev) != hipSuccess) { fprintf(stderr, "kernel_launch: device query failed\n"); grid = -1; return; }
        if (hipFuncSetAttribute((const void*)mega_fwd, hipFuncAttributeMaxDynamicSharedMemorySize, LDS_BYTES) != hipSuccess) { fprintf(stderr, "kernel_launch: hipFuncSetAttribute failed\n"); grid = -1; return; }
        if (hipOccupancyMaxActiveBlocksPerMultiprocessor(&per_cu, (const void*)mega_fwd, 512, LDS_BYTES) != hipSuccess || per_cu < 1) {
            fprintf(stderr, "kernel_launch: occupancy query reports %d workgroups per CU\n", per_cu); }
        (void)hipGetLastError();
        grid = cus;
    }
    if (grid < 0) return;
    if (hipMemsetAsync((char*)d_ws + WS_CTL, 0, CTL_BYTES, stream) != hipSuccess) { fprintf(stderr, "kernel_launch: memset failed\n"); return; }
    Args a{};
    for (int i = 0; i < 29; ++i) a.in[i] = (const float*)d_in[i];
    a.out = (float*)d_out; a.ws = (unsigned char*)d_ws;
    hipLaunchKernelGGL(mega_fwd, dim3(grid), dim3(512), LDS_BYTES, stream, a);
    const hipError_t le = hipPeekAtLastError();
    if (le != hipSuccess) fprintf(stderr, "kernel_launch: launch failed: %s\n", hipGetErrorName(le));
}
```

```cpp
#include <hip/hip_runtime.h>
#include <cstdio>
#include <cstdint>

#define DI __device__ __forceinline__
#ifndef PH_MASK
#define PH_MASK 0xFFFFF
#endif
#define PH(b) ((PH_MASK >> (b)) & 1)
#ifndef REP_MASK
#define REP_MASK 0
#endif
#define REPS(b) (1 + ((REP_MASK >> (b)) & 1))
#define LAS __attribute__((address_space(3)))
#define GAS __attribute__((address_space(1)))
typedef unsigned short bf16_t;
typedef short bf16x8 __attribute__((ext_vector_type(8)));
typedef short s16x4 __attribute__((ext_vector_type(4)));
typedef float f32x4 __attribute__((ext_vector_type(4)));
typedef float f32x2 __attribute__((ext_vector_type(2)));
typedef float f32x16 __attribute__((ext_vector_type(16)));
typedef unsigned u32x4 __attribute__((ext_vector_type(4)));
typedef unsigned u32x2 __attribute__((ext_vector_type(2)));
typedef int i32x8 __attribute__((ext_vector_type(8)));

constexpr int D = 1024, NB = 8, SEQ = 4096, NL = 4, CTX = 256;
constexpr int MLAT = NB * SEQ, MCTX = NB * CTX, MT = MLAT + MCTX;
constexpr int DIN = 5312, DINP = 2304, NGL = 3072;
constexpr int C_NAQ = 0, C_NAK = 384, C_NAV = 768, C_CQ = 1152, C_CKV = 1408, C_KR = 1536, C_SWQ = 1600, C_SWK = 1984, C_SWV = 2112, C_GL = 2240;
constexpr int UW = 1792;
constexpr int P1W = 1280;
constexpr int P2W = 1536;
constexpr int OCW = 1536;
constexpr int NE = 16, CAP_LAT = 512, CAP_CTX = 32;
constexpr int NSLOT_LAT = NB * NE * CAP_LAT, NSLOT = NSLOT_LAT + NB * NE * CAP_CTX;
constexpr float EPS = 1e-6f;
constexpr float LOG2E = 1.4426950408889634f;

constexpr size_t MiB = 1u << 20;
constexpr size_t WS_CTL = 0, CTL_BYTES = 1 * MiB;
constexpr size_t WS_MODV = 1 * MiB;
constexpr size_t WS_W = 2 * MiB;
constexpr size_t W_IN = 0, W_GL = 4718592  , W_UP = 11010048, W_NAO = 7864320  , W_MLAO = 13172736, W_SWAO = 8912896  , W_O = 15007744, W_GU = 17104896, W_DN = 84213760, W_END = 117768192;
constexpr size_t WS_XS = 115 * MiB, WS_W2 = 183 * MiB  ;
constexpr size_t WS_HW = 251 * MiB;
constexpr size_t WS_G = WS_HW + 153 * MiB;
constexpr size_t WS_P1 = 608 * MiB;
constexpr size_t WS_P2 = 693 * MiB;
constexpr size_t WS_R4 = 795 * MiB;
constexpr size_t WS_AFL = 914 * MiB;
constexpr size_t WS_AFC = 916 * MiB;
constexpr size_t WS_SMAP = 917 * MiB;
constexpr size_t WS_GATE = 920 * MiB;
constexpr size_t WS_OCAT = 921 * MiB;
constexpr size_t WS_END = 1006 * MiB;
constexpr size_t WS_MERGED = WS_P1;
constexpr size_t WS_H2 = WS_HW;
constexpr size_t WS_XG = WS_HW + 68 * MiB;
constexpr size_t WS_ACT = WS_HW + 204 * MiB;
constexpr size_t WS_Y = WS_HW + 340 * MiB;
static_assert(W_END <= 113 * MiB && WS_W + 113 * MiB <= WS_XS, "weights");
static_assert(W_GU + 64 * MiB <= W_DN && W_DN + 32 * MiB <= 113 * MiB && WS_XS + (size_t)MT * D * 2 <= WS_W2 && WS_W2 + W_GU <= WS_HW, "second weight buffers");
static_assert(WS_XS + (size_t)MT * D * 4 <= WS_HW && WS_HW + (size_t)MT * DINP * 2 <= WS_G && WS_G + (size_t)MT * NGL * 2 <= WS_P1 && WS_P1 + (size_t)MT * P1W * 2 <= WS_P2 && WS_P2 + (size_t)MT * P2W * 2 <= WS_R4, "map");
static_assert(WS_R4 + (size_t)MT * UW * 2 <= WS_AFL && WS_Y + (size_t)NSLOT * D * 2 <= WS_R4 && WS_SMAP + (size_t)16 * MT * 4 <= WS_GATE && WS_GATE + (size_t)NSLOT * 4 <= WS_OCAT && WS_OCAT + (size_t)MT * OCW <= WS_END, "map2");
constexpr int CW_BAR = 4096;

constexpr int RING_BYTES = 131072, LDSCTL_OFF = RING_BYTES, LDS_BYTES = 147456;

DI unsigned pk2(float lo, float hi) { unsigned r; asm("v_cvt_pk_bf16_f32 %0, %1, %2" : "=v"(r) : "v"(lo), "v"(hi)); return r; }
DI unsigned pk4_fp8(float a, float b, float c, float d) { int w = 0; w = __builtin_amdgcn_cvt_pk_fp8_f32(a, b, w, false); w = __builtin_amdgcn_cvt_pk_fp8_f32(c, d, w, true); return (unsigned)w; }
DI float bflo(unsigned w) { return __uint_as_float(w << 16); }
DI float bfhi(unsigned w) { return __uint_as_float(w & 0xffff0000u); }
DI float bf2f(bf16_t b) { return __uint_as_float((unsigned)b << 16); }
DI float wave_sum(float v) {
#pragma unroll
    for (int o = 1; o < 64; o <<= 1) v += __shfl_xor(v, o);
    return v;
}
DI float sigmoidf_(float x) { return __builtin_amdgcn_rcpf(1.0f + __builtin_amdgcn_exp2f(-x * LOG2E)); }
DI int mod_index(int row) { return row < MLAT ? (row >> 12) : 8; }

#define XB_TMO      128
#define XB_XCNT(j)  (256  + 64 * (j))
#define XB_XSUB(j)  (1280 + 64 * (j))
#define XB_XGEN(j)  (2304 + 64 * (j))
#define XB_TOP      3328
#define XB_TOPGEN   3392
#define XCD_BAR_WORDS 3456
#define XB_SPIN_CAP (1u << 18)
DI unsigned xb_ld(unsigned* p)              { return __hip_atomic_load(p, __ATOMIC_RELAXED, __HIP_MEMORY_SCOPE_AGENT); }
DI unsigned xb_add(unsigned* p, unsigned v) { return __hip_atomic_fetch_add(p, v, __ATOMIC_RELAXED, __HIP_MEMORY_SCOPE_AGENT); }
DI unsigned xb_xcc_id() { return (unsigned)__builtin_amdgcn_s_getreg((3 << 11) | 20) & 0xFu; }
#define XB_SPIN(cond, bar) do { unsigned _sp = 0; while (cond) { __builtin_amdgcn_s_sleep(1); \
    if ((++_sp & 255u) == 0u) { if (xb_ld(&(bar)[XB_TMO])) break; if (_sp > XB_SPIN_CAP) { atomicAdd(&(bar)[XB_TMO], 1u); break; } } } } while (0)
struct XcdBarrier { unsigned* bar; unsigned x; volatile LAS unsigned* st; };
DI XcdBarrier xcd_barrier_post(unsigned* bar, volatile LAS unsigned* st) {
    XcdBarrier b; b.bar = bar; b.x = xb_xcc_id(); b.st = st;
    if (threadIdx.x == 0) (void)xb_add(&bar[XB_XCNT(b.x)], 1u);
    return b;
}
DI void xcd_barrier_complete(unsigned* bar, unsigned x, unsigned& nloc, unsigned& nx) {
    const unsigned G = gridDim.x * gridDim.y * gridDim.z;
    unsigned sum, cnt, mine, sp = 0u;
    for (;;) {
        sum = 0u; cnt = 0u; mine = 0u;
#pragma unroll
        for (unsigned j = 0; j < 16; ++j) { const unsigned c = xb_ld(&bar[XB_XCNT(j)]); sum += c; cnt += (c > 0u) ? 1u : 0u; mine = (j == x) ? c : mine; }
        if (sum == G) break;
        __builtin_amdgcn_s_sleep(1);
        if ((++sp & 255u) == 0u) { if (xb_ld(&bar[XB_TMO])) break; if (sp > XB_SPIN_CAP) { atomicAdd(&bar[XB_TMO], 1u); break; } }
    }
    nloc = mine > 0u ? mine : 1u; nx = cnt > 0u ? cnt : 1u;
}
DI void xcd_barrier(const XcdBarrier& b) {
    asm volatile("s_waitcnt vmcnt(0)" ::: "memory");
    __syncthreads();
    if (threadIdx.x == 0) {
        unsigned* bar = b.bar; unsigned bx_ = b.x; asm volatile("" : "+s"(bar), "+s"(bx_));
        __builtin_amdgcn_s_waitcnt(0);
        unsigned nloc = b.st[0], nx = b.st[1];
        if (nloc == 0u) { xcd_barrier_complete(bar, bx_, nloc, nx); b.st[0] = nloc; b.st[1] = nx; }
        const unsigned old = xb_add(&bar[XB_XSUB(bx_)], 1u);
        const unsigned gen = old / nloc;
        if (old + 1u == (gen + 1u) * nloc) {
            __builtin_amdgcn_fence(__ATOMIC_RELEASE, "agent");
            asm volatile("s_waitcnt vmcnt(0)" ::: "memory");
            const unsigned og = xb_add(&bar[XB_TOP], 1u);
            const unsigned tg = og / nx;
            if (og + 1u == (tg + 1u) * nx) xb_add(&bar[XB_TOPGEN], 1u);
            else XB_SPIN(xb_ld(&bar[XB_TOPGEN]) == tg, bar);
            __builtin_amdgcn_fence(__ATOMIC_ACQUIRE, "agent");
            xb_add(&bar[XB_XGEN(bx_)], 1u);
            asm volatile("s_waitcnt vmcnt(0)" ::: "memory");
        } else {
            XB_SPIN(xb_ld(&bar[XB_XGEN(bx_)]) == gen, bar);
            __builtin_amdgcn_fence(__ATOMIC_ACQUIRE, "agent");
            asm volatile("s_waitcnt vmcnt(0)" ::: "memory");
        }
    }
    __syncthreads();
}

namespace pg8 {
constexpr int BM = 256, BK = 64, HALF = 128, HTB = HALF * BK * 2, NXCD = 8, WGM = 8;
__host__ __device__ __forceinline__ int lds_byte(int r, int c) { const int st = (r >> 4) * 2 + (c >> 5), rr = r & 15, cc = c & 31, ob = rr * 64 + cc * 2; return st * 1024 + (ob ^ (((ob >> 9) & 1) << 5)); }
__host__ __device__ __forceinline__ void stage_rc(int b, int& R, int& C) { const int st = b / 1024, sb = b % 1024, swz = sb ^ (((sb >> 9) & 1) << 5); R = (st >> 1) * 16 + swz / 64; C = (st & 1) * 32 + (swz % 64) / 2; }
__host__ __device__ __forceinline__ int perm32(int rho) { const int n = rho >> 4, i = rho & 15; return 8 * (i >> 2) + 4 * n + (i & 3); }
struct Unit { int pm, pn; };
struct Gemm { const bf16_t* A; const bf16_t* Bt; int K, lda, ldb; size_t estride; };
struct Order {
    int nM, nN, nwg, G, c, moe;
    DI void init(int nM_, int nN_, int G_, int c_, int moe_ = 0) { nM = nM_; nN = nN_; nwg = nM * nN; G = G_; c = c_; moe = moe_; }
    DI bool next(int i, Unit& u) const {
        const long L = (long)i * G + c; if (L >= nwg) return false;
        int wgid = (int)L; { const int q = nwg / NXCD, r = nwg % NXCD, xcd = wgid % NXCD, off = wgid / NXCD; wgid = (xcd < r ? xcd * (q + 1) : r * (q + 1) + (xcd - r) * q) + off; }
        const int nig = WGM * nN, gid = wgid / nig, fm = gid * WGM, gsz = (nM - fm) < WGM ? (nM - fm) : WGM;
        u.pm = fm + ((wgid % nig) % gsz); u.pn = (wgid % nig) / gsz;
        if (moe && u.pm < 256) { const int e = u.pm >> 4, b = (u.pm >> 1) & 7, hf = u.pm & 1; u.pm = (((b << 4) | e) << 1) | hf; }
        return true;
    }
};
struct EpiStoreBf16 {
    static constexpr bool PERM = true;
    bf16_t* O; int ldc;
    DI void operator()(const f32x4 (&acc)[2][2][4][2], const Unit& u, int wr, int wc, int fr, int fq) const {
        const int row0 = u.pm * BM + wr * 64 + fr, col0 = u.pn * BM + wc * 32 + 8 * fq;
#pragma unroll
        for (int ai = 0; ai < 2; ++ai)
#pragma unroll
            for (int m = 0; m < 4; ++m) { bf16_t* rowp = O + (size_t)(row0 + ai * HALF + m * 16) * ldc + col0;
#pragma unroll
                for (int bj = 0; bj < 2; ++bj) { const f32x4 v0 = acc[ai][bj][m][0], v1 = acc[ai][bj][m][1];
                    u32x4 w; w.x = pk2(v0[0], v0[1]); w.y = pk2(v0[2], v0[3]); w.z = pk2(v1[0], v1[1]); w.w = pk2(v1[2], v1[3]);
                    *(u32x4*)(rowp + bj * HALF) = w; } }
    }
};
DI unsigned pk4_u8(float a, float b, float c, float d) {
    unsigned ua = (unsigned)(a * 255.0f + 0.5f), ub = (unsigned)(b * 255.0f + 0.5f), uc = (unsigned)(c * 255.0f + 0.5f), ud = (unsigned)(d * 255.0f + 0.5f);
    ua = ua < 1u ? 1u : ua; ub = ub < 1u ? 1u : ub; uc = uc < 1u ? 1u : uc; ud = ud < 1u ? 1u : ud;
    return ua | (ub << 8) | (uc << 16) | (ud << 24);
}
struct EpiGate {
    static constexpr bool PERM = true;
    unsigned char* O;
    DI void operator()(const f32x4 (&acc)[2][2][4][2], const Unit& u, int wr, int wc, int fr, int fq) const {
        const int row0 = u.pm * BM + wr * 64 + fr, col0 = u.pn * BM + wc * 32 + 8 * fq;
#pragma unroll
        for (int ai = 0; ai < 2; ++ai)
#pragma unroll
            for (int m = 0; m < 4; ++m) { unsigned char* rowp = O + (size_t)(row0 + ai * HALF + m * 16) * NGL + col0;
#pragma unroll
                for (int bj = 0; bj < 2; ++bj) { const f32x4 v0 = acc[ai][bj][m][0] * 0.03125f, v1 = acc[ai][bj][m][1] * 0.03125f;
                    u32x2 w; w.x = pk4_u8(sigmoidf_(v0[0]), sigmoidf_(v0[1]), sigmoidf_(v0[2]), sigmoidf_(v0[3])); w.y = pk4_u8(sigmoidf_(v1[0]), sigmoidf_(v1[1]), sigmoidf_(v1[2]), sigmoidf_(v1[3]));
                    *(u32x2*)(rowp + bj * HALF) = w; } }
    }
};
DI float u8f(unsigned w, int k) { return (float)((w >> (8 * k)) & 0xffu) * (1.0f / 255.0f); }
struct EpiMerge {
    static constexpr bool PERM = true;
    bf16_t* O; const unsigned char* gl; int first;
    DI void operator()(const f32x4 (&acc)[2][2][4][2], const Unit& u, int wr, int wc, int fr, int fq) const {
        const int row0 = u.pm * BM + wr * 64 + fr, col0 = u.pn * BM + wc * 32 + 8 * fq;
#pragma unroll
        for (int ai = 0; ai < 2; ++ai) {
            u32x2 g[4][2]; u32x4 p[4][2];
#pragma unroll
            for (int m = 0; m < 4; ++m)
#pragma unroll
                for (int bj = 0; bj < 2; ++bj) { const int row = row0 + ai * HALF + m * 16, col = col0 + bj * HALF;
                    g[m][bj] = *(const u32x2*)(gl + (size_t)row * NGL + col);
                    p[m][bj] = first ? (u32x4){0u, 0u, 0u, 0u} : *(const u32x4*)(O + (size_t)row * D + col); }
#pragma unroll
            for (int m = 0; m < 4; ++m)
#pragma unroll
                for (int bj = 0; bj < 2; ++bj) { const int row = row0 + ai * HALF + m * 16, col = col0 + bj * HALF;
                    const u32x2 gg = g[m][bj]; const u32x4 pp = p[m][bj]; const f32x4 v0 = acc[ai][bj][m][0], v1 = acc[ai][bj][m][1];
                    const float r0 = v0[0] * u8f(gg.x, 0) + bflo(pp.x), r1 = v0[1] * u8f(gg.x, 1) + bfhi(pp.x), r2 = v0[2] * u8f(gg.x, 2) + bflo(pp.y), r3 = v0[3] * u8f(gg.x, 3) + bfhi(pp.y);
                    const float r4 = v1[0] * u8f(gg.y, 0) + bflo(pp.z), r5 = v1[1] * u8f(gg.y, 1) + bfhi(pp.z), r6 = v1[2] * u8f(gg.y, 2) + bflo(pp.w), r7 = v1[3] * u8f(gg.y, 3) + bfhi(pp.w);
                    u32x4 w; w.x = pk2(r0, r1); w.y = pk2(r2, r3); w.z = pk2(r4, r5); w.w = pk2(r6, r7);
                    *(u32x4*)(O + (size_t)row * D + col) = w; }
        }
    }
};
struct EpiResid {
    static constexpr bool PERM = true;
    bf16_t* xs; const float* modg;
    DI void operator()(const f32x4 (&acc)[2][2][4][2], const Unit& u, int wr, int wc, int fr, int fq) const {
        const int row0 = u.pm * BM + wr * 64 + fr, col0 = u.pn * BM + wc * 32 + 8 * fq;
        const float* mp = modg + (size_t)mod_index(u.pm * BM) * 6144 + col0;
        f32x4 g0[2], g1[2];
#pragma unroll
        for (int bj = 0; bj < 2; ++bj) { g0[bj] = *(const f32x4*)(mp + bj * HALF) * (1.0f / 128.0f); g1[bj] = *(const f32x4*)(mp + bj * HALF + 4) * (1.0f / 128.0f); }
#pragma unroll
        for (int ai = 0; ai < 2; ++ai)
#pragma unroll
            for (int mh = 0; mh < 2; ++mh) {
                u32x4 xw[2][2];
#pragma unroll
                for (int m2 = 0; m2 < 2; ++m2)
#pragma unroll
                    for (int bj = 0; bj < 2; ++bj) xw[m2][bj] = *(const u32x4*)(xs + (size_t)(row0 + ai * HALF + (2 * mh + m2) * 16) * D + col0 + bj * HALF);
#pragma unroll
                for (int m2 = 0; m2 < 2; ++m2)
#pragma unroll
                    for (int bj = 0; bj < 2; ++bj) { const int m = 2 * mh + m2; const u32x4 x = xw[m2][bj];
                        const f32x4 x0 = (f32x4){bflo(x.x), bfhi(x.x), bflo(x.y), bfhi(x.y)} + g0[bj] * acc[ai][bj][m][0];
                        const f32x4 x1 = (f32x4){bflo(x.z), bfhi(x.z), bflo(x.w), bfhi(x.w)} + g1[bj] * acc[ai][bj][m][1];
                        u32x4 w; w.x = pk2(x0[0], x0[1]); w.y = pk2(x0[2], x0[3]); w.z = pk2(x1[0], x1[1]); w.w = pk2(x1[2], x1[3]);
                        *(u32x4*)(xs + (size_t)(row0 + ai * HALF + m * 16) * D + col0 + bj * HALF) = w; }
            }
    }
};
struct EpiSwiglu {
    static constexpr bool PERM = true;
    unsigned char* O;
    DI void operator()(const f32x4 (&acc)[2][2][4][2], const Unit& u, int wr, int wc, int fr, int fq) const {
        const int row0 = u.pm * BM + wr * 64 + fr, col0 = u.pn * HALF + wc * 32 + 8 * fq;
#pragma unroll
        for (int ai = 0; ai < 2; ++ai)
#pragma unroll
            for (int m = 0; m < 4; ++m) { const int row = row0 + ai * HALF + m * 16;
                const f32x4 a0 = acc[ai][0][m][0] * 0.03125f, a1 = acc[ai][0][m][1] * 0.03125f, u0 = acc[ai][1][m][0] * 0.25f, u1 = acc[ai][1][m][1] * 0.25f;
                float r[8];
#pragma unroll
                for (int j = 0; j < 4; ++j) { r[j] = a0[j] * sigmoidf_(a0[j]) * u0[j]; r[4 + j] = a1[j] * sigmoidf_(a1[j]) * u1[j]; }
                u32x2 w; w.x = pk4_fp8(r[0], r[1], r[2], r[3]); w.y = pk4_fp8(r[4], r[5], r[6], r[7]);
                *(u32x2*)(O + (size_t)row * D + col0) = w; }
    }
};
struct EpiDown {
    static constexpr bool PERM = true;
    bf16_t* O; const float* gate;
    DI void operator()(const f32x4 (&acc)[2][2][4][2], const Unit& u, int wr, int wc, int fr, int fq) const {
        const int row0 = u.pm * BM + wr * 64 + fr, col0 = u.pn * BM + wc * 32 + 8 * fq;
        float gv[2][4];
#pragma unroll
        for (int ai = 0; ai < 2; ++ai)
#pragma unroll
            for (int m = 0; m < 4; ++m) gv[ai][m] = gate[row0 + ai * HALF + m * 16] * (1.0f / 256.0f);
#pragma unroll
        for (int ai = 0; ai < 2; ++ai)
#pragma unroll
            for (int m = 0; m < 4; ++m) { const int row = row0 + ai * HALF + m * 16; const float g = gv[ai][m]; bf16_t* rowp = O + (size_t)row * D + col0;
#pragma unroll
                for (int bj = 0; bj < 2; ++bj) { const f32x4 v0 = acc[ai][bj][m][0] * g, v1 = acc[ai][bj][m][1] * g;
                    u32x4 w; w.x = pk2(v0[0], v0[1]); w.y = pk2(v0[2], v0[3]); w.z = pk2(v1[0], v1[1]); w.w = pk2(v1[2], v1[3]);
                    *(u32x4*)(rowp + bj * HALF) = w; } }
    }
};

struct EpiMerge3 {
    static constexpr bool PERM = true;
    bf16_t* O; const unsigned char* gl;
    DI void operator()(f32x4 (&acc)[2][2][4][2], const Unit& u, int seg, int wr, int wc, int fr, int fq) const {
        const int row0 = u.pm * BM + wr * 64 + fr, col0 = u.pn * BM + wc * 32 + 8 * fq;
#pragma unroll
        for (int ai = 0; ai < 2; ++ai) {
            u32x2 ga[4][2], gb[4][2];
#pragma unroll
            for (int m = 0; m < 4; ++m)
#pragma unroll
                for (int bj = 0; bj < 2; ++bj) { const unsigned char* gp = gl + (size_t)(row0 + ai * HALF + m * 16) * NGL + 1024 * seg + col0 + bj * HALF;
                    ga[m][bj] = *(const u32x2*)gp; gb[m][bj] = seg < 2 ? *(const u32x2*)(gp + 1024) : (u32x2){0u, 0u}; }
#pragma unroll
            for (int m = 0; m < 4; ++m)
#pragma unroll
                for (int bj = 0; bj < 2; ++bj) {
                    f32x4 s0, s1;
#pragma unroll
                    for (int k = 0; k < 4; ++k) { const float a0 = (float)((ga[m][bj].x >> (8 * k)) & 0xffu), a1 = (float)((ga[m][bj].y >> (8 * k)) & 0xffu);
                        if (seg < 2) { const float b0 = (float)((gb[m][bj].x >> (8 * k)) & 0xffu), b1 = (float)((gb[m][bj].y >> (8 * k)) & 0xffu); s0[k] = a0 * __builtin_amdgcn_rcpf(b0); s1[k] = a1 * __builtin_amdgcn_rcpf(b1); }
                        else { s0[k] = a0 * (1.0f / (255.0f * 128.0f)); s1[k] = a1 * (1.0f / (255.0f * 128.0f)); } }
                    acc[ai][bj][m][0] *= s0; acc[ai][bj][m][1] *= s1;
                    if (seg == 2) { const f32x4 v0 = acc[ai][bj][m][0] * 4.0f, v1 = acc[ai][bj][m][1] * 4.0f;
                        u32x2 w; w.x = pk4_fp8(v0[0], v0[1], v0[2], v0[3]); w.y = pk4_fp8(v1[0], v1[1], v1[2], v1[3]);
                        *(u32x2*)((unsigned char*)O + (size_t)(row0 + ai * HALF + m * 16) * D + col0 + bj * HALF) = w; }
                }
        }
    }
};
struct Gemm3 { const unsigned char* A0; const unsigned char* A1; const unsigned char* A2; const unsigned char* B0; const unsigned char* B1; const unsigned char* B2; int lda, ldb; };
template <class Epi>
DI void gemm_phase3(LAS unsigned char* lds, const Gemm3 g, const Order& S, const Epi& E) {
    int tid_ = threadIdx.x; asm volatile("" : "+v"(tid_));
    const int tid = tid_, wid = __builtin_amdgcn_readfirstlane(tid >> 6), lane = tid & 63, wr = wid >> 2, wc = wid & 3, fr = lane & 15, fq = lane >> 4;
    unsigned voffA[2], voffB[2];
#pragma unroll
    for (int i = 0; i < 2; ++i) { int R, C; stage_rc(tid * 16 + i * 8192, R, C); const int Rb = Epi::PERM ? ((R & ~31) + perm32(R & 31)) : R;
        voffA[i] = (unsigned)(R * g.lda + C * 2); voffB[i] = (unsigned)(Rb * g.ldb + C * 2); }
    const size_t kstep = (size_t)(BK * 2);
    const size_t hstepA = (size_t)HALF * g.lda, hstepB = (size_t)HALF * g.ldb;
    const size_t tstepA = 2 * hstepA, tstepB = 2 * hstepB;
    const unsigned ldsw = (unsigned)wid * 1024u;
    const int aoff = lds_byte(wr * 64 + fr, fq * 8), boff = lds_byte(wc * 32 + fr, fq * 8);
#define PG8_SA(b, h) (((b) * 2 + (h)) * HTB)
#define PG8_SB(b, h) ((4 + (b) * 2 + (h)) * HTB)
#define PG8_STAGE(bufoff, gbase, voff) do { _Pragma("unroll") for (int _i = 0; _i < 2; ++_i) \
        __builtin_amdgcn_global_load_lds((const unsigned*)((const char*)(gbase) + (voff)[_i]), (LAS unsigned*)(lds + (bufoff) + ldsw + _i * 8192), 16, 0, 0); } while (0)
#define PG8_LDA(dst, b, h) do { _Pragma("unroll") for (int m = 0; m < 4; ++m) _Pragma("unroll") for (int k = 0; k < 2; ++k) dst[m][k] = *(const LAS bf16x8*)(lds + PG8_SA(b, h) + aoff + m * 2048 + k * 1024); } while (0)
#define PG8_LDB(dst, b, h) do { _Pragma("unroll") for (int n = 0; n < 2; ++n) _Pragma("unroll") for (int k = 0; k < 2; ++k) dst[n][k] = *(const LAS bf16x8*)(lds + PG8_SB(b, h) + boff + n * 2048 + k * 1024); } while (0)
#define PG8_MMA(ai, bj, At, Bt) do { __builtin_amdgcn_s_setprio(1); _Pragma("unroll") for (int m = 0; m < 4; ++m) _Pragma("unroll") for (int n = 0; n < 2; ++n) { \
        const i32x8 bb_ = __builtin_bit_cast(i32x8, __builtin_shufflevector(Bt[n][0], Bt[n][1], 0, 1, 2, 3, 4, 5, 6, 7, 8, 9, 10, 11, 12, 13, 14, 15)); \
        const i32x8 aa_ = __builtin_bit_cast(i32x8, __builtin_shufflevector(At[m][0], At[m][1], 0, 1, 2, 3, 4, 5, 6, 7, 8, 9, 10, 11, 12, 13, 14, 15)); \
        asm volatile("v_mfma_scale_f32_16x16x128_f8f6f4 %0, %1, %2, %0, %3, %3 op_sel_hi:[0,0,0]" : "+v"(acc[ai][bj][m][n]) : "v"(bb_), "v"(aa_), "v"(0x7F7F7F7F)); } \
        __builtin_amdgcn_s_setprio(0); } while (0)
#define PG8_WAIT_V(n) asm volatile("s_waitcnt vmcnt(" #n ")" ::: "memory")
#define PG8_WAIT_L(n) asm volatile("s_waitcnt lgkmcnt(" #n ")" ::: "memory")
#define PG8_BAR __builtin_amdgcn_s_barrier()
#define PG8_SCHED __builtin_amdgcn_sched_barrier(0)
#define PG8_A3(sg, u) ((const char*)((sg) == 0 ? g.A0 : (sg) == 1 ? g.A1 : g.A2) + (size_t)(u).pm * tstepA)
#define PG8_B3(sg, u) ((const char*)((sg) == 0 ? g.B0 : (sg) == 1 ? g.B1 : g.B2) + (size_t)(u).pn * tstepB)
    Unit cur, nu; int ui = 0, seg = 0;
    if (!S.next(0, cur)) return;
    f32x4 acc[2][2][4][2];
#pragma unroll
    for (int a = 0; a < 2; ++a)
#pragma unroll
        for (int b = 0; b < 2; ++b)
#pragma unroll
            for (int m = 0; m < 4; ++m)
#pragma unroll
                for (int n = 0; n < 2; ++n) acc[a][b][m][n] = (f32x4){0.f, 0.f, 0.f, 0.f};
    bf16x8 At[4][2], B0[2][2], B1[2][2];
    const char* cA = PG8_A3(0, cur); const char* cB = PG8_B3(0, cur);
    PG8_STAGE(PG8_SB(0, 0), cB, voffB); PG8_STAGE(PG8_SB(0, 1), cB + hstepB, voffB); PG8_STAGE(PG8_SA(0, 0), cA, voffA); PG8_STAGE(PG8_SA(0, 1), cA + hstepA, voffA);
    if (wr == 1) PG8_BAR;
    PG8_WAIT_V(2); PG8_BAR;
    PG8_STAGE(PG8_SB(1, 0), cB + kstep, voffB); PG8_STAGE(PG8_SA(1, 0), cA + kstep, voffA); PG8_STAGE(PG8_SB(1, 1), cB + hstepB + kstep, voffB);
    PG8_WAIT_V(6); PG8_BAR;
    for (;;) {
        int nseg = seg + 1; bool has_next = true; nu = cur;
        if (nseg == 3) { nseg = 0; has_next = S.next(ui + 1, nu); }
        const char* nA = has_next ? PG8_A3(nseg, nu) : cA; const char* nB = has_next ? PG8_B3(nseg, nu) : cB;
        int nt_ = 4; asm volatile("" : "+s"(nt_));
        const int nt = nt_;
#pragma nounroll
        for (int t = 0; t < nt; t += 2) {
            const bool last = (t == nt - 2);
            const char* a1 = cA + (size_t)(t + 1) * kstep;
            const char* a2 = last ? nA : cA + (size_t)(t + 2) * kstep; const char* b2 = last ? nB : cB + (size_t)(t + 2) * kstep;
            const char* a3 = a2 + kstep; const char* b3 = b2 + kstep;
            PG8_LDB(B0, 0, 0); PG8_LDB(B1, 0, 1); PG8_SCHED; PG8_LDA(At, 0, 0); PG8_STAGE(PG8_SA(1, 1), a1 + hstepA, voffA);
            PG8_WAIT_V(8); PG8_WAIT_L(0); PG8_BAR; PG8_MMA(0, 0, At, B0); PG8_MMA(0, 1, At, B1); PG8_BAR; PG8_SCHED;
            PG8_LDA(At, 0, 1); PG8_STAGE(PG8_SB(0, 0), b2, voffB); PG8_STAGE(PG8_SB(0, 1), b2 + hstepB, voffB); PG8_STAGE(PG8_SA(0, 0), a2, voffA);
            PG8_WAIT_V(8); PG8_WAIT_L(0); PG8_BAR; PG8_MMA(1, 0, At, B0); PG8_MMA(1, 1, At, B1); PG8_BAR; PG8_SCHED;
            PG8_LDB(B0, 1, 0); PG8_LDB(B1, 1, 1); PG8_SCHED; PG8_LDA(At, 1, 0); PG8_STAGE(PG8_SA(0, 1), a2 + hstepA, voffA);
            PG8_WAIT_V(8); PG8_WAIT_L(0); PG8_BAR; PG8_MMA(0, 0, At, B0); PG8_MMA(0, 1, At, B1); PG8_BAR; PG8_SCHED;
            PG8_LDA(At, 1, 1); PG8_STAGE(PG8_SB(1, 0), b3, voffB); PG8_STAGE(PG8_SB(1, 1), b3 + hstepB, voffB); PG8_STAGE(PG8_SA(1, 0), a3, voffA);
            PG8_WAIT_V(8); PG8_WAIT_L(0); PG8_BAR; PG8_MMA(1, 0, At, B0); PG8_MMA(1, 1, At, B1); PG8_BAR; PG8_SCHED;
        }
        if (wr == 0) PG8_BAR;
        E(acc, cur, seg, wr, wc, fr, fq);
        if (!has_next) break;
        if (seg == 2) {
#pragma unroll
            for (int a = 0; a < 2; ++a)
#pragma unroll
                for (int b = 0; b < 2; ++b)
#pragma unroll
                    for (int m = 0; m < 4; ++m)
#pragma unroll
                        for (int n = 0; n < 2; ++n) acc[a][b][m][n] = (f32x4){0.f, 0.f, 0.f, 0.f};
            cur = nu; ++ui;
        }
        seg = nseg; cA = nA; cB = nB;
        if (wr == 1) PG8_BAR;
    }
    PG8_WAIT_V(0);
    PG8_BAR;
#undef PG8_SA
#undef PG8_SB
#undef PG8_STAGE
#undef PG8_LDA
#undef PG8_LDB
#undef PG8_MMA
#undef PG8_WAIT_V
#undef PG8_WAIT_L
#undef PG8_BAR
#undef PG8_SCHED
#undef PG8_A3
#undef PG8_B3
}

template <class Epi, bool FP8 = false>
DI void gemm_phase(LAS unsigned char* lds, const Gemm g, const Order& S, const Epi& E) {
    constexpr int ESZ = FP8 ? 1 : 2;
    int tid_ = threadIdx.x; asm volatile("" : "+v"(tid_));
    const int tid = tid_, wid = __builtin_amdgcn_readfirstlane(tid >> 6), lane = tid & 63, wr = wid >> 2, wc = wid & 3, fr = lane & 15, fq = lane >> 4;
    const int K = g.K, nt = K * ESZ / (BK * 2);
    unsigned voffA[2], voffB[2];
#pragma unroll
    for (int i = 0; i < 2; ++i) { int R, C; stage_rc(tid * 16 + i * 8192, R, C); const int Rb = Epi::PERM ? ((R & ~31) + perm32(R & 31)) : R;
        voffA[i] = (unsigned)(R * g.lda * ESZ + C * 2); voffB[i] = (unsigned)(Rb * g.ldb * ESZ + C * 2); }
    const size_t kstep = (size_t)(BK * 2);
    const size_t hstepA = (size_t)HALF * g.lda * ESZ, hstepB = (size_t)HALF * g.ldb * ESZ;
    const size_t tstepA = 2 * hstepA, tstepB = 2 * hstepB;
    const unsigned ldsw = (unsigned)wid * 1024u;
    const int aoff = lds_byte(wr * 64 + fr, fq * 8), boff = lds_byte(wc * 32 + fr, fq * 8);
#define PG8_SA(b, h) (((b) * 2 + (h)) * HTB)
#define PG8_SB(b, h) ((4 + (b) * 2 + (h)) * HTB)
#define PG8_STAGE(bufoff, gbase, voff) do { _Pragma("unroll") for (int _i = 0; _i < 2; ++_i) \
        __builtin_amdgcn_global_load_lds((const unsigned*)((const char*)(gbase) + (voff)[_i]), (LAS unsigned*)(lds + (bufoff) + ldsw + _i * 8192), 16, 0, 0); } while (0)
#define PG8_LDA(dst, b, h) do { _Pragma("unroll") for (int m = 0; m < 4; ++m) _Pragma("unroll") for (int k = 0; k < 2; ++k) dst[m][k] = *(const LAS bf16x8*)(lds + PG8_SA(b, h) + aoff + m * 2048 + k * 1024); } while (0)
#define PG8_LDB(dst, b, h) do { _Pragma("unroll") for (int n = 0; n < 2; ++n) _Pragma("unroll") for (int k = 0; k < 2; ++k) dst[n][k] = *(const LAS bf16x8*)(lds + PG8_SB(b, h) + boff + n * 2048 + k * 1024); } while (0)
#define PG8_MMA(ai, bj, At, Bt) do { __builtin_amdgcn_s_setprio(1); _Pragma("unroll") for (int m = 0; m < 4; ++m) _Pragma("unroll") for (int n = 0; n < 2; ++n) { \
        if constexpr (FP8) { const i32x8 bb_ = __builtin_bit_cast(i32x8, __builtin_shufflevector(Bt[n][0], Bt[n][1], 0, 1, 2, 3, 4, 5, 6, 7, 8, 9, 10, 11, 12, 13, 14, 15)); \
            const i32x8 aa_ = __builtin_bit_cast(i32x8, __builtin_shufflevector(At[m][0], At[m][1], 0, 1, 2, 3, 4, 5, 6, 7, 8, 9, 10, 11, 12, 13, 14, 15)); \
            asm volatile("v_mfma_scale_f32_16x16x128_f8f6f4 %0, %1, %2, %0, %3, %3 op_sel_hi:[0,0,0]" : "+v"(acc[ai][bj][m][n]) : "v"(bb_), "v"(aa_), "v"(0x7F7F7F7F)); } \
        else { _Pragma("unroll") for (int k = 0; k < 2; ++k) acc[ai][bj][m][n] = __builtin_amdgcn_mfma_f32_16x16x32_bf16(Bt[n][k], At[m][k], acc[ai][bj][m][n], 0, 0, 0); } } \
        __builtin_amdgcn_s_setprio(0); } while (0)
#define PG8_WAIT_V(n) asm volatile("s_waitcnt vmcnt(" #n ")" ::: "memory")
#define PG8_WAIT_L(n) asm volatile("s_waitcnt lgkmcnt(" #n ")" ::: "memory")
#define PG8_BAR __builtin_amdgcn_s_barrier()
#define PG8_SCHED __builtin_amdgcn_sched_barrier(0)
#define PG8_EXPERT(pm) ((pm) < 256 ? (((pm) >> 1) & 15) : ((pm) - 256))
#define PG8_ABASE(u) ((const char*)g.A + (size_t)(u).pm * tstepA)
#define PG8_BBASE(u) ((const char*)g.Bt + (size_t)PG8_EXPERT((u).pm) * g.estride * ESZ + (size_t)(u).pn * tstepB)
    Unit cur, nxt; int ui = 0;
    if (!S.next(0, cur)) return;
    f32x4 acc[2][2][4][2];
#pragma unroll
    for (int a = 0; a < 2; ++a)
#pragma unroll
        for (int b = 0; b < 2; ++b)
#pragma unroll
            for (int m = 0; m < 4; ++m)
#pragma unroll
                for (int n = 0; n < 2; ++n) acc[a][b][m][n] = (f32x4){0.f, 0.f, 0.f, 0.f};
    bf16x8 At[4][2], B0[2][2], B1[2][2];
    const char* cA = PG8_ABASE(cur); const char* cB = PG8_BBASE(cur);
    PG8_STAGE(PG8_SB(0, 0), cB, voffB); PG8_STAGE(PG8_SB(0, 1), cB + hstepB, voffB); PG8_STAGE(PG8_SA(0, 0), cA, voffA); PG8_STAGE(PG8_SA(0, 1), cA + hstepA, voffA);
    if (wr == 1) PG8_BAR;
    PG8_WAIT_V(2); PG8_BAR;
    PG8_STAGE(PG8_SB(1, 0), cB + kstep, voffB); PG8_STAGE(PG8_SA(1, 0), cA + kstep, voffA); PG8_STAGE(PG8_SB(1, 1), cB + hstepB + kstep, voffB);
    PG8_WAIT_V(6); PG8_BAR;
    for (;;) {
        const bool has_next = S.next(ui + 1, nxt);
        const char* nA = has_next ? PG8_ABASE(nxt) : cA; const char* nB = has_next ? PG8_BBASE(nxt) : cB;
#pragma nounroll
        for (int t = 0; t < nt; t += 2) {
            const bool last = (t == nt - 2);
            const char* a1 = cA + (size_t)(t + 1) * kstep;
            const char* a2 = last ? nA : cA + (size_t)(t + 2) * kstep; const char* b2 = last ? nB : cB + (size_t)(t + 2) * kstep;
            const char* a3 = a2 + kstep; const char* b3 = b2 + kstep;
            PG8_LDB(B0, 0, 0); PG8_LDB(B1, 0, 1); PG8_SCHED; PG8_LDA(At, 0, 0); PG8_STAGE(PG8_SA(1, 1), a1 + hstepA, voffA);
            PG8_WAIT_V(8); PG8_WAIT_L(0); PG8_BAR; PG8_MMA(0, 0, At, B0); PG8_MMA(0, 1, At, B1); PG8_BAR; PG8_SCHED;
            PG8_LDA(At, 0, 1); PG8_STAGE(PG8_SB(0, 0), b2, voffB); PG8_STAGE(PG8_SB(0, 1), b2 + hstepB, voffB); PG8_STAGE(PG8_SA(0, 0), a2, voffA);
            PG8_WAIT_V(8); PG8_WAIT_L(0); PG8_BAR; PG8_MMA(1, 0, At, B0); PG8_MMA(1, 1, At, B1); PG8_BAR; PG8_SCHED;
            PG8_LDB(B0, 1, 0); PG8_LDB(B1, 1, 1); PG8_SCHED; PG8_LDA(At, 1, 0); PG8_STAGE(PG8_SA(0, 1), a2 + hstepA, voffA);
            PG8_WAIT_V(8); PG8_WAIT_L(0); PG8_BAR; PG8_MMA(0, 0, At, B0); PG8_MMA(0, 1, At, B1); PG8_BAR; PG8_SCHED;
            PG8_LDA(At, 1, 1); PG8_STAGE(PG8_SB(1, 0), b3, voffB); PG8_STAGE(PG8_SB(1, 1), b3 + hstepB, voffB); PG8_STAGE(PG8_SA(1, 0), a3, voffA);
            PG8_WAIT_V(8); PG8_WAIT_L(0); PG8_BAR; PG8_MMA(1, 0, At, B0); PG8_MMA(1, 1, At, B1); PG8_BAR; PG8_SCHED;
        }
        if (wr == 0) PG8_BAR;
        E(acc, cur, wr, wc, fr, fq);
        if (!has_next) break;
#pragma unroll
        for (int a = 0; a < 2; ++a)
#pragma unroll
            for (int b = 0; b < 2; ++b)
#pragma unroll
                for (int m = 0; m < 4; ++m)
#pragma unroll
                    for (int n = 0; n < 2; ++n) acc[a][b][m][n] = (f32x4){0.f, 0.f, 0.f, 0.f};
        cur = nxt; cA = nA; cB = nB; ++ui;
        if (wr == 1) PG8_BAR;
    }
    PG8_WAIT_V(0);
    PG8_BAR;
#undef PG8_SA
#undef PG8_SB
#undef PG8_STAGE
#undef PG8_LDA
#undef PG8_LDB
#undef PG8_MMA
#undef PG8_WAIT_V
#undef PG8_WAIT_L
#undef PG8_BAR
#undef PG8_SCHED
}
}

struct Args { const float* in[29]; float* out; unsigned char* ws; };
typedef const __attribute__((address_space(4))) Args* KArgs;
#define KA_FRESH(ka) asm volatile("" : "+s"(ka))
enum { I_X = 0, I_C, I_CTX, I_CCTX, I_N1G, I_N2G, I_WADA, I_BADA, I_WIN, I_NAQG, I_NAKG, I_RPB, I_MQN, I_WUQ, I_MKVN, I_WUKV, I_MQG, I_MKG, I_SWQG, I_SWKG, I_SINK,
       I_WNAO, I_WMLAO, I_WSWAO, I_WO, I_ROUTER, I_WGATE, I_WUP, I_WDOWN };
struct Frame {
    LAS unsigned char* lds;
    int tid, lane, wave, G, vcu, gw, ngw;
};

DI void frame_fresh(Frame& F) { int t = F.tid, w = F.wave, v = F.vcu; asm volatile("" : "+v"(t), "+s"(w), "+s"(v)); F.tid = t; F.lane = t & 63; F.wave = w; F.vcu = v; F.gw = v * 8 + w; }
DI void modv_phase(Frame& F, KArgs ka) {
    KA_FRESH(ka); const __attribute__((address_space(4))) Args& a = *ka; frame_fresh(F);
    LAS float* cact = (LAS float*)F.lds;
    LAS float* red = (LAS float*)(F.lds + 9 * 1024 * 4);
    const float* c = a.in[I_C]; const float* cc = a.in[I_CCTX];
    for (int i = F.tid; i < 9 * 1024; i += 512) { const float v = i < 8192 ? c[i] : cc[i - 8192]; cact[i] = v * sigmoidf_(v); }
    __syncthreads();
    float* modv = (float*)(a.ws + WS_MODV);
    const int cl = F.lane & 31, kp = F.lane >> 5;
    for (int unit = F.vcu; unit < NL * 192; unit += F.G) {
        const int l = unit / 192, n = (unit % 192) * 32 + cl;
        const float* w = a.in[I_WADA] + (size_t)l * 1024 * 6144 + n;
        float acc[9];
#pragma unroll
        for (int i = 0; i < 9; ++i) acc[i] = 0.f;
        const int k0 = F.wave * 128 + kp;
#pragma unroll 16
        for (int k = 0; k < 128; k += 2) { const float wv = w[(size_t)(k0 + k) * 6144];
#pragma unroll
            for (int i = 0; i < 9; ++i) acc[i] += cact[i * 1024 + k0 + k] * wv; }
#pragma unroll
        for (int i = 0; i < 9; ++i) red[((F.wave * 2 + kp) * 9 + i) * 32 + cl] = acc[i];
        __syncthreads();
        for (int t = F.tid; t < 9 * 32; t += 512) { const int i = t >> 5, nn = t & 31; float s = 0.f;
#pragma unroll
            for (int w16 = 0; w16 < 16; ++w16) s += red[(w16 * 9 + i) * 32 + nn];
            const int col = (unit % 192) * 32 + nn;
            modv[((size_t)l * 9 + i) * 6144 + col] = s + a.in[I_BADA][l * 6144 + col]; }
        __syncthreads();
    }
}
DI void copy_phase(Frame& F, KArgs ka) {
    KA_FRESH(ka); const __attribute__((address_space(4))) Args& a = *ka; frame_fresh(F);
    u32x2* xs = (u32x2*)(a.ws + WS_XS);
    const f32x4* x = (const f32x4*)a.in[I_X]; const f32x4* cx = (const f32x4*)a.in[I_CTX];
    const size_t nl = (size_t)MLAT * D / 4, nc = (size_t)MCTX * D / 4;
    for (size_t i = (size_t)blockIdx.x * 512 + F.tid; i < nl + nc; i += (size_t)F.G * 512) { const f32x4 v = i < nl ? x[i] : cx[i - nl]; u32x2 w; w.x = pk2(v.x, v.y); w.y = pk2(v.z, v.w); xs[i] = w; }
}

DI unsigned char* wsel(unsigned char* ws, int l, size_t off) {
    const size_t p = (size_t)(l & 1);
    return ws + (off >= W_DN ? WS_W + off + p * (16 * MiB) : off >= W_GU ? WS_W + off + p * (32 * MiB) : (p ? WS_W2 : WS_W) + off);
}
constexpr int T_IN = 16 * 166, T_UQ = 4 * 24, T_UKV = 2 * 32, T_NAO = 6 * 32, T_MLAO = 8 * 32, T_SWAO = 6 * 32, T_O = 16 * 32, T_E = 16 * 32 * 16;
constexpr int NIT = T_IN + T_UQ + T_UKV + T_NAO + T_MLAO + T_SWAO + T_O + 3 * T_E;
DI void cvt_item(const __attribute__((address_space(4))) Args& a, int l, int r, LAS float* scr, int lane) {
    const float* W; const float* ks = nullptr; int ldw = 1024, kb, nb, ldt = 1024, drow0, dcol0 = 0, fp8 = 1; size_t woff;
    if (r < T_IN) { kb = r / 166; nb = r % 166; W = a.in[I_WIN] + (size_t)l * 1024 * DIN; ldw = DIN;
        if (nb < 70) { fp8 = 0; woff = W_IN; drow0 = 32 * nb; } else { woff = W_GL; drow0 = 32 * nb - 2240; } }
    else if ((r -= T_IN) < T_UQ) { kb = r / 24; nb = r % 24; W = a.in[I_WUQ] + (size_t)l * 256 * 768; ldw = 768; fp8 = 0; woff = W_UP; ldt = 384; drow0 = 32 * nb; ks = a.in[I_MQN] + l * 256; }
    else if ((r -= T_UQ) < T_UKV) { kb = r / 32; nb = r % 32; W = a.in[I_WUKV] + (size_t)l * 128 * 1024; fp8 = 0; woff = W_UP; ldt = 384; drow0 = 768 + 32 * nb; dcol0 = 256; ks = a.in[I_MKVN] + l * 128; }
    else if ((r -= T_UKV) < T_NAO) { kb = r / 32; nb = r % 32; W = a.in[I_WNAO] + (size_t)l * 384 * 1024; woff = W_NAO; ldt = 512; drow0 = 32 * nb; }
    else if ((r -= T_NAO) < T_MLAO) { kb = r / 32; nb = r % 32; W = a.in[I_WMLAO] + (size_t)l * 512 * 1024; woff = W_MLAO; ldt = 512; drow0 = 32 * nb; }
    else if ((r -= T_MLAO) < T_SWAO) { kb = r / 32; nb = r % 32; W = a.in[I_WSWAO] + (size_t)l * 384 * 1024; woff = W_SWAO; ldt = 512; drow0 = 32 * nb; }
    else if ((r -= T_SWAO) < T_O) { kb = r / 32; nb = r % 32; W = a.in[I_WO] + (size_t)l * 1024 * 1024; woff = W_O; drow0 = 32 * nb; }
    else if ((r -= T_O) < 2 * T_E) {
        const int which = r / T_E, rr = r % T_E, e = rr / 512, t = rr % 512; kb = t / 32; nb = t % 32; const int f0 = 32 * nb;
        W = a.in[which ? I_WUP : I_WGATE] + ((size_t)l * 16 + e) * 1024 * 1024; woff = W_GU + (size_t)e * 2048 * 1024; drow0 = 256 * (f0 >> 7) + 128 * which + (f0 & 127); }
    else { r -= 2 * T_E; const int e = r / 512, t = r % 512; kb = t / 32; nb = t % 32;
        W = a.in[I_WDOWN] + ((size_t)l * 16 + e) * 1024 * 1024; woff = W_DN + (size_t)e * 1024 * 1024; drow0 = 32 * nb; }
    const int k0 = 64 * kb, n0 = 32 * nb; dcol0 += k0;
    unsigned char* WT; { const size_t p = (size_t)(l & 1); WT = a.ws + (woff >= W_DN ? WS_W + woff + p * (16 * MiB) : woff >= W_GU ? WS_W + woff + p * (32 * MiB) : (p ? WS_W2 : WS_W) + woff); }
    const float sc = fp8 ? 32.0f : 1.0f;
    const float* Wl = W + (size_t)(k0 + (lane >> 5)) * ldw + n0 + (lane & 31); LAS float* sl = scr + (lane >> 5) * 33 + (lane & 31);
    if (ks) { ks += k0 + (lane >> 5);
#pragma unroll 8
        for (int i = 0; i < 32; ++i) sl[2 * i * 33] = Wl[(size_t)(2 * i) * ldw] * ks[2 * i]; }
    else {
        float wv[32];
#pragma unroll
        for (int i = 0; i < 32; ++i) wv[i] = Wl[(size_t)(2 * i) * ldw];
#pragma unroll
        for (int i = 0; i < 32; ++i) sl[2 * i * 33] = wv[i] * sc; }
    asm volatile("s_waitcnt lgkmcnt(0)" ::: "memory");
    const int c = lane & 7;
    if (fp8) {
#pragma unroll
        for (int j = 0; j < 4; ++j) { const int n = (lane >> 3) + 8 * j; const LAS float* s = scr + (8 * c) * 33 + n;
            u32x2 o; o.x = pk4_fp8(s[0 * 33], s[1 * 33], s[2 * 33], s[3 * 33]); o.y = pk4_fp8(s[4 * 33], s[5 * 33], s[6 * 33], s[7 * 33]);
            *(u32x2*)(WT + (size_t)(drow0 + n) * ldt + dcol0 + 8 * c) = o; }
    } else {
#pragma unroll
        for (int j = 0; j < 4; ++j) { const int n = (lane >> 3) + 8 * j; const LAS float* s = scr + (8 * c) * 33 + n;
            u32x4 o; o.x = pk2(s[0 * 33], s[1 * 33]); o.y = pk2(s[2 * 33], s[3 * 33]); o.z = pk2(s[4 * 33], s[5 * 33]); o.w = pk2(s[6 * 33], s[7 * 33]);
            *(u32x4*)((bf16_t*)WT + (size_t)(drow0 + n) * ldt + dcol0 + 8 * c) = o; }
    }
    asm volatile("s_waitcnt lgkmcnt(0)" ::: "memory");
}
DI void convert_weights(Frame& F, KArgs ka, int l, int begin) {
    KA_FRESH(ka); const __attribute__((address_space(4))) Args& a = *ka; frame_fresh(F);
    LAS float* scr = (LAS float*)(F.lds + F.wave * 16384);
#pragma nounroll
    for (int it = begin + F.gw; it < NIT; it += F.ngw) cvt_item(a, l, it, scr, F.lane);
    unsigned char* wb = a.ws + ((l & 1) ? WS_W2 : WS_W);
    constexpr int Z0 = 64 * 128, Z1 = 768 * 16, Z2 = 1024 * 32, Z3 = 2 * 1024 * 8;
    unsigned zz = 0u; asm volatile("" : "+v"(zz));
    const u32x4 z = {zz, zz, zz, zz};
    for (int i = blockIdx.x * 512 + F.tid; i < Z0 + Z1 + Z2 + Z3; i += F.G * 512) {
        if (i >= Z0 + Z1 + Z2) { const int j = i - Z0 - Z1 - Z2, which = j >> 13, jj = j & 8191; *(u32x4*)(wb + (which ? W_SWAO : W_NAO) + (size_t)(jj >> 3) * 512 + 384 + (jj & 7) * 16) = z; continue; }
        if (i < Z0) *(u32x4*)((bf16_t*)(wb + W_IN) + (size_t)(2240 + i / 128) * 1024 + (i % 128) * 8) = z;
        else if (i < Z0 + Z1) { const int j = i - Z0; *(u32x4*)((bf16_t*)(wb + W_UP) + (size_t)(j / 16) * 384 + 256 + (j % 16) * 8) = z; }
        else { const int j = i - Z0 - Z1; *(u32x4*)((bf16_t*)(wb + W_UP) + (size_t)(768 + j / 32) * 384 + (j % 32) * 8) = z; }
    }
}
DI void convert_tail(Frame& F, KArgs ka, int l, int first, int q) {
    KA_FRESH(ka); const __attribute__((address_space(4))) Args& a = *ka; frame_fresh(F);
    LAS float* scr = (LAS float*)(F.lds + F.wave * 16384);
#pragma nounroll
    for (int j = 0; j < q; ++j) { const int it = first + 8 * j + F.wave; if (it < NIT) cvt_item(a, l, it, scr, F.lane); }
}


DI void row_phase(Frame& F, KArgs ka, int l, int dry = 0) {
    KA_FRESH(ka); const __attribute__((address_space(4))) Args& a = *ka; frame_fresh(F);
    bf16_t* xs = (bf16_t*)(a.ws + WS_XS);
    const float* modv = (const float*)(a.ws + WS_MODV);
    const int* smap = (const int*)(a.ws + WS_SMAP);
    const bf16_t* Y = (const bf16_t*)(a.ws + WS_Y);
    bf16_t* H = (bf16_t*)(a.ws + WS_R4);
    unsigned char* H8 = a.ws + WS_R4 + 68 * MiB;
    bf16_t* xso = xs; float* outo = a.out;
    if (dry) { unsigned char* tr = a.ws + WS_END + (size_t)F.gw * 16384; xso = (bf16_t*)tr; outo = (float*)tr; H = (bf16_t*)(tr + 8192); H8 = tr + 12288; }
    const int nrows = (l == NL) ? MLAT : MT;
    const bool comb = (l > 0);
    constexpr int RR = 4;
    for (int mb = RR * F.gw; mb < nrows; mb += RR * F.ngw) {
        f32x4 v[RR][4]; int myslot[RR];
#pragma unroll
        for (int rr = 0; rr < RR; ++rr) { const int m = mb + rr;
            if (l == 0) {
                if (F.lane < 16 && !dry) *(u32x4*)(a.ws + WS_OCAT + (size_t)m * OCW + ((F.lane >> 3) ? 1408 : 384) + 16 * (F.lane & 7)) = (u32x4){0u, 0u, 0u, 0u};
                const f32x4* xr = (const f32x4*)(m < MLAT ? a.in[I_X] + (size_t)m * D : a.in[I_CTX] + (size_t)(m - MLAT) * D) + F.lane;
                u32x2* xo = (u32x2*)(xs + (size_t)m * D) + F.lane;
#pragma unroll
                for (int j = 0; j < 4; ++j) { const f32x4 t = xr[64 * j]; u32x2 w; w.x = pk2(t.x, t.y); w.y = pk2(t.z, t.w); if (!dry) xo[64 * j] = w; v[rr][j] = (f32x4){bflo(w.x), bfhi(w.x), bflo(w.y), bfhi(w.y)}; }
            } else {
                const u32x2* xr = (const u32x2*)(xs + (size_t)m * D) + F.lane;
#pragma unroll
                for (int j = 0; j < 4; ++j) { const u32x2 w = xr[64 * j]; v[rr][j] = (f32x4){bflo(w.x), bfhi(w.x), bflo(w.y), bfhi(w.y)}; }
            }
            myslot[rr] = (comb && F.lane < 16) ? smap[(size_t)F.lane * MT + mb + rr] : -1; }
        const int mi = mod_index(mb);
        if (comb) {
            f32x4 acc[RR][4];
            unsigned long long mk[RR];
#pragma unroll
            for (int rr = 0; rr < RR; ++rr) { mk[rr] = __ballot(myslot[rr] >= 0);
#pragma unroll
                for (int j = 0; j < 4; ++j) acc[rr][j] = (f32x4){0.f, 0.f, 0.f, 0.f}; }
            while ((mk[0] | mk[1]) | (mk[2] | mk[3])) {
                u32x2 w[RR][4];
#pragma unroll
                for (int rr = 0; rr < RR; ++rr) {
                    int s = -1;
                    if (mk[rr]) { const int e0 = __builtin_ctzll(mk[rr]); s = __shfl(myslot[rr], e0); mk[rr] &= mk[rr] - 1; }
#pragma unroll
                    for (int j = 0; j < 4; ++j) w[rr][j] = (u32x2){0u, 0u};
                    if (s >= 0) { const u32x2* yr = (const u32x2*)(Y + (size_t)s * D) + F.lane;
#pragma unroll
                        for (int j = 0; j < 4; ++j) w[rr][j] = yr[64 * j]; }
                }
#pragma unroll
                for (int rr = 0; rr < RR; ++rr)
#pragma unroll
                    for (int j = 0; j < 4; ++j) acc[rr][j] += (f32x4){bflo(w[rr][j].x), bfhi(w[rr][j].x), bflo(w[rr][j].y), bfhi(w[rr][j].y)};
            }
            const f32x4* g5 = (const f32x4*)(modv + ((size_t)(l - 1) * 9 + mi) * 6144 + 5 * 1024) + F.lane;
            f32x4 g5v[4];
#pragma unroll
            for (int j = 0; j < 4; ++j) g5v[j] = g5[64 * j];
#pragma unroll
            for (int rr = 0; rr < RR; ++rr) { const int m = mb + rr;
                const size_t ro = dry ? (size_t)rr * 1024 : (size_t)m * D;
#pragma unroll
                for (int j = 0; j < 4; ++j) { v[rr][j] += g5v[j] * acc[rr][j];
                    if (l == NL) ((f32x4*)(outo + ro) + F.lane)[64 * j] = v[rr][j];
                    else { u32x2 w; w.x = pk2(v[rr][j].x, v[rr][j].y); w.y = pk2(v[rr][j].z, v[rr][j].w); ((u32x2*)(xso + ro) + F.lane)[64 * j] = w;
                           v[rr][j] = (f32x4){bflo(w.x), bfhi(w.x), bflo(w.y), bfhi(w.y)}; } } }
        }
        if (l < NL) {
            const f32x4* g = (const f32x4*)(a.in[I_N1G] + l * D) + F.lane;
            const f32x4* sh = (const f32x4*)(modv + ((size_t)l * 9 + mi) * 6144) + F.lane;
            const f32x4* sc = (const f32x4*)(modv + ((size_t)l * 9 + mi) * 6144 + 1024) + F.lane;
            f32x4 gg[4], shv[4];
#pragma unroll
            for (int j = 0; j < 4; ++j) { gg[j] = g[64 * j] * (sc[64 * j] + 1.0f); shv[j] = sh[64 * j]; }
#pragma unroll
            for (int rr = 0; rr < RR; ++rr) { const int m = mb + rr;
                float ss = 0.f;
#pragma unroll
                for (int j = 0; j < 4; ++j) ss += (v[rr][j].x * v[rr][j].x + v[rr][j].y * v[rr][j].y) + (v[rr][j].z * v[rr][j].z + v[rr][j].w * v[rr][j].w);
                const float rstd = __builtin_amdgcn_rsqf(wave_sum(ss) * (1.f / D) + EPS);
                u32x2* o = (u32x2*)(H + (dry ? (size_t)rr * 1024 : (size_t)m * D)) + F.lane;
                unsigned* o8 = (unsigned*)(H8 + (dry ? (size_t)rr * 1024 : (size_t)m * D)) + F.lane;
#pragma unroll
                for (int j = 0; j < 4; ++j) { const f32x4 hh = v[rr][j] * rstd * gg[j] + shv[j]; u32x2 w; w.x = pk2(hh.x, hh.y); w.y = pk2(hh.z, hh.w); o[64 * j] = w;
                    o8[64 * j] = pk4_fp8(hh.x, hh.y, hh.z, hh.w); } }
        }
    }
}

DI void rope_cs(int d, int prow, int pcol, float& cs, float& sn) {
    const int i = d & 15; const float pos = (float)((d & 32) ? pcol : prow);
    const float inv = __builtin_amdgcn_exp2f(-(float)i * (13.287712379549449f / 16.0f));
    const float rev = pos * inv * 0.15915494309189535f;
    const float fr = rev - floorf(rev);
    cs = __builtin_amdgcn_cosf(fr); sn = __builtin_amdgcn_sinf(fr);
}
DI void prep_phase(Frame& F, KArgs ka, int l) {
    KA_FRESH(ka); const __attribute__((address_space(4))) Args& a = *ka; frame_fresh(F);
    const bf16_t* HW = (const bf16_t*)(a.ws + WS_HW);
    bf16_t* P1 = (bf16_t*)(a.ws + WS_P1);
    const float sc64 = 0.125f * LOG2E;
    const int d0 = 8 * (F.lane & 7);
    float gn[3][8]; int srcc[3]; bool ropei[3], acti[3];
    const float* gp0 = a.in[I_NAQG]; const float* gp1 = a.in[I_NAKG]; const float* gp2 = a.in[I_SWQG]; const float* gp3 = a.in[I_SWKG];
#pragma unroll
    for (int i = 0; i < 3; ++i) { const int c = F.lane + 64 * i, col = 8 * c; acti[i] = c < 160;
        const int ty = col < 384 ? 0 : col < 768 ? 1 : col < 1152 ? 2 : 3;
        srcc[i] = col < 768 ? col : col + (C_SWQ - 768);
        ropei[i] = ty >= 2;
        const float sc = (ty == 0 || ty == 2) ? sc64 : 1.0f;
#pragma unroll
        for (int j = 0; j < 8; ++j) { const float g0 = gp0[l * 64 + d0 + j], g1 = gp1[l * 64 + d0 + j], g2 = gp2[l * 64 + d0 + j], g3 = gp3[l * 64 + d0 + j];
            gn[i][j] = acti[i] ? (ty == 0 ? g0 : ty == 1 ? g1 : ty == 2 ? g2 : g3) * sc : 0.f; } }
    float invf[8];
#pragma unroll
    for (int j = 0; j < 8; ++j) invf[j] = __builtin_amdgcn_exp2f(-(float)((d0 & 8) + j) * (13.287712379549449f / 16.0f)) * 0.15915494309189535f;
    const bool second = (d0 & 16) != 0, usecol = (d0 & 32) != 0;
    for (int mb = 2 * F.gw; mb < MT; mb += 2 * F.ngw) {
        u32x4 w[2][3];
#pragma unroll
        for (int rr = 0; rr < 2; ++rr)
#pragma unroll
            for (int i = 0; i < 3; ++i) if (acti[i]) w[rr][i] = *(const u32x4*)(HW + (size_t)(mb + rr) * DINP + srcc[i]); else w[rr][i] = (u32x4){0u, 0u, 0u, 0u};
#pragma unroll
        for (int rr = 0; rr < 2; ++rr) {
            const int m = mb + rr; const bool lat = m < MLAT; const int s = m & 4095; const float prw = (float)(s >> 6), pcl = (float)(s & 63); float pos = usecol ? pcl : prw; asm volatile("" : "+v"(pos));
            float cs[8], sn[8];
#pragma unroll
            for (int j = 0; j < 8; ++j) { cs[j] = 1.f; sn[j] = 0.f; }
            if (lat) {
#pragma unroll
                for (int j = 0; j < 8; ++j) { const float rev = pos * invf[j], fr = rev - floorf(rev); cs[j] = __builtin_amdgcn_cosf(fr); sn[j] = __builtin_amdgcn_sinf(fr); } }
#pragma unroll
            for (int i = 0; i < 3; ++i) {
                float x[8] = {bflo(w[rr][i].x), bfhi(w[rr][i].x), bflo(w[rr][i].y), bfhi(w[rr][i].y), bflo(w[rr][i].z), bfhi(w[rr][i].z), bflo(w[rr][i].w), bfhi(w[rr][i].w)};
                float ss = 0.f;
#pragma unroll
                for (int j = 0; j < 8; ++j) ss += x[j] * x[j];
                ss += __shfl_xor(ss, 1); ss += __shfl_xor(ss, 2); ss += __shfl_xor(ss, 4);
                const float rs = __builtin_amdgcn_rsqf(ss * (1.f / 64.f) + EPS);
#pragma unroll
                for (int j = 0; j < 8; ++j) x[j] *= rs * gn[i][j];
                const bool rp = ropei[i] && lat;
#pragma unroll
                for (int j = 0; j < 8; ++j) { const float y = __int_as_float(__builtin_amdgcn_ds_bpermute((F.lane ^ 2) << 2, __float_as_int(x[j]))); const float rot = second ? x[j] * cs[j] + y * sn[j] : x[j] * cs[j] - y * sn[j]; x[j] = rp ? rot : x[j]; }
                if (acti[i]) { u32x4 o; o.x = pk2(x[0], x[1]); o.y = pk2(x[2], x[3]); o.z = pk2(x[4], x[5]); o.w = pk2(x[6], x[7]);
                    *(u32x4*)(P1 + (size_t)m * P1W + 8 * (F.lane + 64 * i)) = o; }
            }
        }
    }
}
DI void prep2_phase(Frame& F, KArgs ka, int l, int dry = 0) {
    KA_FRESH(ka); const __attribute__((address_space(4))) Args& a = *ka; frame_fresh(F);
    const bf16_t* HW = (const bf16_t*)(a.ws + WS_HW);
    bf16_t* U = (bf16_t*)(a.ws + WS_R4);
    bf16_t* P2 = (bf16_t*)(a.ws + WS_P2);
    const float scq = 0.07216878364870322f * LOG2E;
    const int ln = F.lane, q = ln & 15, h = ln >> 4;
    float qgn[8], qgr[4], kgn[8], kgr[4], invf[4];
    { const float* qg = a.in[I_MQG] + l * 192; const float* kg = a.in[I_MKG] + l * 192;
#pragma unroll
      for (int j = 0; j < 8; ++j) { qgn[j] = qg[8 * q + j] * scq; kgn[j] = kg[8 * q + j]; }
#pragma unroll
      for (int j = 0; j < 4; ++j) { qgr[j] = qg[128 + 4 * q + j] * scq; kgr[j] = kg[128 + 4 * q + j];
          invf[j] = __builtin_amdgcn_exp2f(-(float)(4 * (q & 3) + j) * (13.287712379549449f / 16.0f)) * 0.15915494309189535f; } }
    const bool second = (q & 4) != 0, usecol = (q & 8) != 0;
    const int pl = (ln ^ 4) << 2;
    for (int mb = 2 * F.gw; mb < MT; mb += 2 * F.ngw) {
        u32x2 wcq[2], wqr[2], wkr[2]; unsigned wckv[2]; u32x4 wqn[2], wkn[2], wv[2];
#pragma unroll
        for (int rr = 0; rr < 2; ++rr) { const bf16_t* hr = HW + (size_t)(mb + rr) * DINP; const bf16_t* ur = U + (size_t)(mb + rr) * UW;
            wcq[rr] = *(const u32x2*)(hr + C_CQ + 4 * ln); wckv[rr] = *(const unsigned*)(hr + C_CKV + 2 * ln); wkr[rr] = *(const u32x2*)(hr + C_KR + 4 * q);
            wqn[rr] = *(const u32x4*)(ur + h * 192 + 8 * q); wqr[rr] = *(const u32x2*)(ur + h * 192 + 128 + 4 * q);
            wkn[rr] = *(const u32x4*)(ur + 768 + h * 256 + 8 * q); wv[rr] = *(const u32x4*)(ur + 768 + h * 256 + 128 + 8 * q); }
#pragma unroll
        for (int rr = 0; rr < 2; ++rr) {
            const int m = mb + rr; const bool lat = m < MLAT; const int s = m & 4095;
            bf16_t* ur = U + (size_t)m * UW; bf16_t* pr = P2 + (size_t)m * P2W;
            if (dry) { ur = (bf16_t*)(a.ws + WS_END + (size_t)F.gw * 8192); pr = ur + 2048; }
            float rq, rkv;
            { const float a0 = bflo(wcq[rr].x), a1 = bfhi(wcq[rr].x), a2 = bflo(wcq[rr].y), a3 = bfhi(wcq[rr].y);
              rq = __builtin_amdgcn_rsqf(wave_sum(a0 * a0 + a1 * a1 + a2 * a2 + a3 * a3) * (1.f / 256.f) + EPS); }
            { const float a0 = bflo(wckv[rr]), a1 = bfhi(wckv[rr]);
              rkv = __builtin_amdgcn_rsqf(wave_sum(a0 * a0 + a1 * a1) * (1.f / 128.f) + EPS); }
            float cs[4], sn[4];
            { const float prw = (float)(s >> 6), pcl = (float)(s & 63); float pos = usecol ? pcl : prw; asm volatile("" : "+v"(pos));
#pragma unroll
              for (int j = 0; j < 4; ++j) { const float rev = pos * invf[j], fr = rev - floorf(rev); cs[j] = lat ? __builtin_amdgcn_cosf(fr) : 1.f; sn[j] = lat ? __builtin_amdgcn_sinf(fr) : 0.f; } }
#pragma unroll
            for (int isk = 0; isk < 2; ++isk) {
                const u32x4 wn = isk ? wkn[rr] : wqn[rr]; const u32x2 wr2 = isk ? wkr[rr] : wqr[rr];
                const float sn_ = isk ? rkv : rq, sr_ = isk ? 1.0f : rq;
                float x[8] = {bflo(wn.x) * sn_, bfhi(wn.x) * sn_, bflo(wn.y) * sn_, bfhi(wn.y) * sn_, bflo(wn.z) * sn_, bfhi(wn.z) * sn_, bflo(wn.w) * sn_, bfhi(wn.w) * sn_};
                float y[4] = {bflo(wr2.x) * sr_, bfhi(wr2.x) * sr_, bflo(wr2.y) * sr_, bfhi(wr2.y) * sr_};
                float ss = 0.f;
#pragma unroll
                for (int j = 0; j < 8; ++j) ss += x[j] * x[j];
#pragma unroll
                for (int j = 0; j < 4; ++j) ss += y[j] * y[j];
                ss += __shfl_xor(ss, 1); ss += __shfl_xor(ss, 2); ss += __shfl_xor(ss, 4); ss += __shfl_xor(ss, 8);
                const float rs = __builtin_amdgcn_rsqf(ss * (1.f / 192.f) + EPS);
#pragma unroll
                for (int j = 0; j < 8; ++j) x[j] *= rs * (isk ? kgn[j] : qgn[j]);
#pragma unroll
                for (int j = 0; j < 4; ++j) { y[j] *= rs * (isk ? kgr[j] : qgr[j]);
                    const float p = __int_as_float(__builtin_amdgcn_ds_bpermute(pl, __float_as_int(y[j])));
                    y[j] = second ? y[j] * cs[j] + p * sn[j] : y[j] * cs[j] - p * sn[j]; }
                u32x4 o; o.x = pk2(x[0], x[1]); o.y = pk2(x[2], x[3]); o.z = pk2(x[4], x[5]); o.w = pk2(x[6], x[7]);
                u32x2 o2; o2.x = pk2(y[0], y[1]); o2.y = pk2(y[2], y[3]);
                *(u32x4*)(pr + 768 * isk + h * 192 + 8 * q) = o; *(u32x2*)(pr + 768 * isk + h * 192 + 128 + 4 * q) = o2;
            }
            { const u32x4 vw = wv[rr]; u32x4 o; o.x = pk2(bflo(vw.x) * rkv, bfhi(vw.x) * rkv); o.y = pk2(bflo(vw.y) * rkv, bfhi(vw.y) * rkv); o.z = pk2(bflo(vw.z) * rkv, bfhi(vw.z) * rkv); o.w = pk2(bflo(vw.w) * rkv, bfhi(vw.w) * rkv);
              *(u32x4*)(ur + 768 + h * 256 + 128 + 8 * q) = o; }
        }
    }
}

struct AU {
    const bf16_t *q, *k, *v; unsigned char* o;
    int ldq, ldk, ldv, ldo;
    int qrow0;
    int lat_row0, n_lat, ctx_row0, n_ctx;
    int mode;
    int qpos0, kpos0;
    float m0, l0;
    const float* rpb;
};
#define AT_PIN16(b) asm volatile("" : "+v"(b[0]), "+v"(b[1]), "+v"(b[2]), "+v"(b[3]), "+v"(b[4]), "+v"(b[5]), "+v"(b[6]), "+v"(b[7]), "+v"(b[8]), "+v"(b[9]), "+v"(b[10]), "+v"(b[11]), "+v"(b[12]), "+v"(b[13]), "+v"(b[14]), "+v"(b[15]))
#define AT_PIN4(b, j) asm volatile("" : "+v"(b[j]), "+v"(b[j + 1]), "+v"(b[j + 2]), "+v"(b[j + 3]))
template <int NDT, int VP, int P>
DI void att_tail(f32x16& s0, f32x16& s1, f32x16 (&o)[NDT], float& mrun, float& lrun, const LAS unsigned char* Vt, int vlane_off, const LAS float* bp, int cs, int h) {
    constexpr float MTHR = 11.5f;
#define AT_A0(i) (P != 1 || (i) >= 12)
#define AT_A1(i) (P != 0 || (i) < 4)
    if constexpr (P >= 0) {
        float bb[16];
        if constexpr (P == 0) {
#pragma unroll
            for (int i = 0; i < 16; ++i) bb[i] = bp[(i & 3) + 8 * (i >> 2)];
            AT_PIN16(bb);
#pragma unroll
            for (int i = 0; i < 16; ++i) { const int kc = (i & 3) + 8 * (i >> 2) + 4 * h; const bool ok = (kc >= cs) && (kc < cs + 16); s0[i] = ok ? s0[i] + bb[i] : -INFINITY; }
#pragma unroll
            for (int i = 0; i < 4; ++i) bb[i] = bp[32 + i];
            AT_PIN4(bb, 0);
#pragma unroll
            for (int i = 0; i < 4; ++i) { const int kc = 32 + i + 4 * h; const bool ok = (kc >= cs) && (kc < cs + 16); s1[i] = ok ? s1[i] + bb[i] : -INFINITY; }
        } else {
#pragma unroll
            for (int i = 12; i < 16; ++i) bb[i] = bp[24 + (i & 3)];
            AT_PIN4(bb, 12);
#pragma unroll
            for (int i = 12; i < 16; ++i) { const int kc = 24 + (i & 3) + 4 * h; const bool ok = (kc >= cs) && (kc < cs + 16); s0[i] = ok ? s0[i] + bb[i] : -INFINITY; }
#pragma unroll
            for (int i = 0; i < 16; ++i) bb[i] = bp[32 + (i & 3) + 8 * (i >> 2)];
            AT_PIN16(bb);
#pragma unroll
            for (int i = 0; i < 16; ++i) { const int kc = 32 + (i & 3) + 8 * (i >> 2) + 4 * h; const bool ok = (kc >= cs) && (kc < cs + 16); s1[i] = ok ? s1[i] + bb[i] : -INFINITY; }
        }
    }
    float mx = (P == 1) ? s1[0] : s0[0];
#pragma unroll
    for (int i = 0; i < 16; ++i) { if (AT_A0(i)) mx = fmaxf(mx, s0[i]); if (AT_A1(i)) mx = fmaxf(mx, s1[i]); }
    mx = fmaxf(mx, __shfl_xor(mx, 32));
    if (__builtin_amdgcn_ballot_w64(mx > mrun + MTHR) != 0ull) {
        const float mnew = fmaxf(mrun, mx), alpha = __builtin_amdgcn_exp2f(mrun - mnew);
        lrun *= alpha; mrun = mnew;
#pragma unroll
        for (int dt = 0; dt < NDT; ++dt)
#pragma unroll
            for (int i = 0; i < 16; ++i) o[dt][i] *= alpha;
    }
    float ls = 0.f;
#pragma unroll
    for (int i = 0; i < 16; ++i) {
        if (AT_A0(i)) { s0[i] = __builtin_amdgcn_exp2f(s0[i] - mrun); ls += s0[i]; } else s0[i] = 0.f;
        if (AT_A1(i)) { s1[i] = __builtin_amdgcn_exp2f(s1[i] - mrun); ls += s1[i]; } else s1[i] = 0.f;
    }
    lrun += ls;
    bf16x8 pf[4];
    { u32x4 w;
      w.x = pk2(s0[0], s0[1]); w.y = pk2(s0[2], s0[3]); w.z = pk2(s0[4], s0[5]); w.w = pk2(s0[6], s0[7]); pf[0] = __builtin_bit_cast(bf16x8, w);
      if (P == 1) { w.x = 0u; w.y = 0u; } else { w.x = pk2(s0[8], s0[9]); w.y = pk2(s0[10], s0[11]); } w.z = pk2(s0[12], s0[13]); w.w = pk2(s0[14], s0[15]); pf[1] = __builtin_bit_cast(bf16x8, w);
      w.x = pk2(s1[0], s1[1]); w.y = pk2(s1[2], s1[3]); if (P == 0) { w.z = 0u; w.w = 0u; } else { w.z = pk2(s1[4], s1[5]); w.w = pk2(s1[6], s1[7]); } pf[2] = __builtin_bit_cast(bf16x8, w);
      w.x = pk2(s1[8], s1[9]); w.y = pk2(s1[10], s1[11]); w.z = pk2(s1[12], s1[13]); w.w = pk2(s1[14], s1[15]); pf[3] = __builtin_bit_cast(bf16x8, w); }
#pragma unroll
    for (int kk = 0; kk < 4; ++kk) {
        if ((P == 0 && kk == 3) || (P == 1 && kk == 0)) continue;
#pragma unroll
        for (int dt = 0; dt < NDT; ++dt) {
            const LAS unsigned char* vp = Vt + (16 * kk) * VP + vlane_off + 64 * dt;
            const s16x4 lo = __builtin_amdgcn_ds_read_tr16_b64_v4i16((LAS s16x4*)vp);
            const s16x4 hi = __builtin_amdgcn_ds_read_tr16_b64_v4i16((LAS s16x4*)(vp + 8 * VP));
            const bf16x8 vf = __builtin_shufflevector(lo, hi, 0, 1, 2, 3, 4, 5, 6, 7);
            o[dt] = __builtin_amdgcn_mfma_f32_32x32x16_bf16(vf, pf[kk], o[dt], 0, 0, 0);
        }
    }
#undef AT_A0
#undef AT_A1
}
template <int DQ, int DV, int LDK, int LDV>
DI void attn_unit(LAS unsigned char* lds, const AU& u, int tid, int wave, int lane) {
    constexpr int KP = DQ * 2 + 16, VP = DV * 2 + 64, KBY = 64 * KP, VBY = 64 * VP, STG = KBY + VBY;
    constexpr int NKS = DQ / 16, NDT = DV / 32, KCH = DQ / 8, VCH = DV / 8;
    constexpr int KC = KP / 16, VC = VP / 16;
    constexpr int KI = (KC + 7) / 8, VI = (VC + 7) / 8;
    constexpr int BIAS_OFF = 98304;
    static_assert(2 * STG <= BIAS_OFF && KBY % 1024 == 0 && VBY % 1024 == 0, "attention LDS");
    const int r = lane & 31, h = lane >> 5;
    const int nt = u.n_lat + u.n_ctx;
    LAS float* btab = (LAS float*)(lds + BIAS_OFF);
    if (u.mode == 2) { for (int i = tid; i < 15 * 31; i += 512) btab[i] = u.rpb[i] * LOG2E; }
    bf16x8 qf[NKS];
    { const bf16_t* qp = u.q + (size_t)(u.qrow0 + wave * 32 + r) * u.ldq + 8 * h;
#pragma unroll
      for (int ks = 0; ks < NKS; ++ks) qf[ks] = *(const bf16x8*)(qp + 16 * ks); }
    f32x16 o[NDT];
#pragma unroll
    for (int dt = 0; dt < NDT; ++dt)
#pragma unroll
        for (int i = 0; i < 16; ++i) o[dt][i] = 0.f;
    float mrun = u.m0, lrun = (h == 0) ? u.l0 : 0.f;
    unsigned koff[KI], voff[VI];
#pragma unroll
    for (int i = 0; i < KI; ++i) { const int c = 64 * (wave + 8 * i) + lane, row = c / KC, cc = c % KC; koff[i] = (unsigned)(row * LDK * 2 + (cc < KCH ? cc : KCH - 1) * 16); }
#pragma unroll
    for (int i = 0; i < VI; ++i) { const int c = 64 * (wave + 8 * i) + lane, row = c / VC, cc = c % VC; voff[i] = (unsigned)(row * LDV * 2 + (cc < VCH ? cc : VCH - 1) * 16); }
#define AT_ROWBASE(t) ((t) < u.n_lat ? u.lat_row0 + 64 * (t) : u.ctx_row0 + 64 * ((t) - u.n_lat))
#define AT_ISSUE(t, buf) do { const int rb_ = AT_ROWBASE(t); const char* kb_ = (const char*)(u.k + (size_t)rb_ * LDK); const char* vb_ = (const char*)(u.v + (size_t)rb_ * LDV); \
        _Pragma("unroll") for (int i_ = 0; i_ < KI; ++i_) { const int j_ = wave + 8 * i_; if (j_ < KC) __builtin_amdgcn_global_load_lds((const unsigned*)(kb_ + koff[i_]), (LAS unsigned*)(lds + (buf) * STG + j_ * 1024), 16, 0, 0); } \
        _Pragma("unroll") for (int i_ = 0; i_ < VI; ++i_) { const int j_ = wave + 8 * i_; if (j_ < VC) __builtin_amdgcn_global_load_lds((const unsigned*)(vb_ + voff[i_]), (LAS unsigned*)(lds + (buf) * STG + KBY + j_ * 1024), 16, 0, 0); } } while (0)
    AT_ISSUE(0, 0);
    asm volatile("s_waitcnt vmcnt(0)" ::: "memory");
    __syncthreads();
    const int tq = (lane & 15) >> 2, tp = lane & 3, tblk = (lane >> 4) & 1;
    const int vlane_off = (4 * h + tq) * VP + 32 * tblk + 8 * tp;
    for (int t = 0; t < nt; ++t) {
        const int buf = t & 1;
        if (t + 1 < nt) AT_ISSUE(t + 1, buf ^ 1);
        bool skip = false; int a0 = 0, a1 = 0;
        bool inband = false;
        if (u.mode == 1 && t < u.n_lat) { const int k0 = u.kpos0 + 64 * t, q0 = u.qpos0 + 32 * wave; skip = (k0 > q0 + 31 + 128) || (k0 + 63 < q0 - 128); a0 = k0; a1 = q0; inband = (k0 >= q0 + 31 - 128) && (k0 + 63 <= q0 + 128); }
        if (u.mode == 2 && t < u.n_lat) { const int kr = u.kpos0 + t, qr = u.qpos0 + (wave >> 1); int rs = qr - 4; rs = rs < 0 ? 0 : (rs > 56 ? 56 : rs); skip = (kr < rs) || (kr >= rs + 8); a0 = kr - qr + 7; }
        if (!skip) {
            const LAS unsigned char* Kt = lds + buf * STG; const LAS unsigned char* Vt = Kt + KBY;
            f32x16 s0, s1;
#pragma unroll
            for (int i = 0; i < 16; ++i) { s0[i] = 0.f; s1[i] = 0.f; }
#pragma unroll
            for (int ks = 0; ks < NKS; ++ks) {
                const bf16x8 k0 = *(const LAS bf16x8*)(Kt + r * KP + (16 * ks + 8 * h) * 2);
                const bf16x8 k1 = *(const LAS bf16x8*)(Kt + (32 + r) * KP + (16 * ks + 8 * h) * 2);
                s0 = __builtin_amdgcn_mfma_f32_32x32x16_bf16(k0, qf[ks], s0, 0, 0, 0);
                s1 = __builtin_amdgcn_mfma_f32_32x32x16_bf16(k1, qf[ks], s1, 0, 0, 0);
            }
            if (u.mode == 1 && t < u.n_lat && !inband) {
                const int qpos = a1 + r;
#pragma unroll
                for (int i = 0; i < 16; ++i) { const int kk = a0 + (i & 3) + 8 * (i >> 2) + 4 * h; int d0 = qpos - kk; d0 = d0 < 0 ? -d0 : d0; int d1 = qpos - (kk + 32); d1 = d1 < 0 ? -d1 : d1;
                    s0[i] = d0 <= 128 ? s0[i] : -INFINITY; s1[i] = d1 <= 128 ? s1[i] : -INFINITY; }
            }
            if (DQ == 64 && u.mode == 2 && t < u.n_lat) {
                const int qc = 32 * (wave & 1) + r; int cs = qc - 8; cs = cs < 0 ? 0 : (cs > 48 ? 48 : cs);
                const LAS float* bp = btab + (a0 * 31 + 15 - qc + 4 * h);
                if ((wave & 1) == 0) att_tail<NDT, VP, (DQ == 64 ? 0 : -1)>(s0, s1, o, mrun, lrun, Vt, vlane_off, bp, cs, h);
                else att_tail<NDT, VP, (DQ == 64 ? 1 : -1)>(s0, s1, o, mrun, lrun, Vt, vlane_off, bp, cs, h);
            } else att_tail<NDT, VP, -1>(s0, s1, o, mrun, lrun, Vt, vlane_off, nullptr, 0, h);
        }
        asm volatile("s_waitcnt vmcnt(0)" ::: "memory");
        __syncthreads();
    }
    const float ltot = lrun + __shfl_xor(lrun, 32), inv = 1.0f / ltot;
    unsigned char* op = u.o + (size_t)(u.qrow0 + wave * 32 + r) * u.ldo + 4 * h;
    const float inv4 = inv * 4.0f;
#pragma unroll
    for (int dt = 0; dt < NDT; ++dt)
#pragma unroll
        for (int g = 0; g < 4; ++g) *(unsigned*)(op + 32 * dt + 8 * g) = pk4_fp8(o[dt][4 * g] * inv4, o[dt][4 * g + 1] * inv4, o[dt][4 * g + 2] * inv4, o[dt][4 * g + 3] * inv4);
#undef AT_ROWBASE
#undef AT_ISSUE
}

DI void attn_phase(Frame& F, KArgs ka, int l) {
    KA_FRESH(ka); const __attribute__((address_space(4))) Args& a = *ka; frame_fresh(F);
    const bf16_t* HW = (const bf16_t*)(a.ws + WS_HW);
    const bf16_t* P1 = (const bf16_t*)(a.ws + WS_P1);
    const bf16_t* P2 = (const bf16_t*)(a.ws + WS_P2);
    const bf16_t* U = (const bf16_t*)(a.ws + WS_R4);
    unsigned char* OC = a.ws + WS_OCAT;
    const bool last = (l == NL - 1);
    constexpr int nA = 512, nB = 768, nC = 768;
    const int ntot = nA + nB + nC + (last ? 0 : 128);
#ifndef ATT_PROBE
#define ATT_PROBE 0
#endif
    for (int rep2_ = 0; rep2_ < 1 + (ATT_PROBE != 0); ++rep2_)
    for (int id = F.vcu; id < ntot; id += F.G) {
        if (rep2_ == 1 && !((ATT_PROBE == 1) ? (id < nA) : (id >= nA && id < nA + nB))) continue;
        AU u; bool big = false;
        u.mode = 0; u.qpos0 = 0; u.kpos0 = 0; u.m0 = -1e30f; u.l0 = 0.f; u.rpb = nullptr; u.n_ctx = 4;
        if (id < nA) {
            const int b = id >> 6, h = (id >> 4) & 3, qb = id & 15; big = true;
            u.q = P2 + h * 192; u.ldq = P2W; u.k = P2 + 768 + h * 192; u.ldk = P2W; u.v = U + 768 + h * 256 + 128; u.ldv = UW; u.o = OC + 512 + h * 128; u.ldo = OCW;
            u.qrow0 = b * SEQ + qb * 256; u.lat_row0 = b * SEQ; u.n_lat = 64; u.ctx_row0 = MLAT + b * CTX;
        } else if (id < nA + nB) {
            const int j = id - nA, b = j / 96, h = (j >> 4) % 6, qb = j & 15;
            u.q = P1 + h * 64; u.ldq = P1W; u.k = P1 + 384 + h * 64; u.ldk = P1W; u.v = HW + C_NAV + h * 64; u.ldv = DINP; u.o = OC + h * 64; u.ldo = OCW;
            int rlo = 4 * qb - 4; rlo = rlo < 0 ? 0 : (rlo > 56 ? 56 : rlo); int rhi = 4 * qb + 3 - 4; rhi = (rhi < 0 ? 0 : (rhi > 56 ? 56 : rhi)) + 7;
            u.qrow0 = b * SEQ + qb * 256; u.lat_row0 = b * SEQ + rlo * 64; u.n_lat = rhi - rlo + 1; u.ctx_row0 = MLAT + b * CTX;
            u.mode = 2; u.qpos0 = 4 * qb; u.kpos0 = rlo; u.rpb = a.in[I_RPB] + (size_t)(l * 6 + h) * 465;
        } else if (id < nA + nB + nC) {
            const int j = id - nA - nB, b = j / 96, hq = (j >> 4) % 6, qb = j & 15, kvh = hq / 3;
            u.q = P1 + 768 + hq * 64; u.ldq = P1W; u.k = P1 + 1152 + kvh * 64; u.ldk = P1W; u.v = HW + C_SWV + kvh * 64; u.ldv = DINP; u.o = OC + 1024 + hq * 64; u.ldo = OCW;
            int klo = qb * 256 - 128; klo = klo < 0 ? 0 : klo; int khi = qb * 256 + 384; khi = khi > SEQ ? SEQ : khi;
            u.qrow0 = b * SEQ + qb * 256; u.lat_row0 = b * SEQ + klo; u.n_lat = (khi - klo) >> 6; u.ctx_row0 = MLAT + b * CTX;
            u.mode = 1; u.qpos0 = qb * 256; u.kpos0 = klo; u.m0 = a.in[I_SINK][l * 6 + hq] * LOG2E; u.l0 = 1.f;
        } else {
            const int j = id - nA - nB - nC;
            u.n_lat = 0; u.lat_row0 = 0;
            if (j < 32) { const int b = j >> 2, h = j & 3; big = true;
                u.q = P2 + h * 192; u.ldq = P2W; u.k = P2 + 768 + h * 192; u.ldk = P2W; u.v = U + 768 + h * 256 + 128; u.ldv = UW; u.o = OC + 512 + h * 128; u.ldo = OCW;
                u.qrow0 = MLAT + b * CTX; u.ctx_row0 = MLAT + b * CTX;
            } else if (j < 80) { const int jj = j - 32, b = jj / 6, h = jj % 6;
                u.q = P1 + h * 64; u.ldq = P1W; u.k = P1 + 384 + h * 64; u.ldk = P1W; u.v = HW + C_NAV + h * 64; u.ldv = DINP; u.o = OC + h * 64; u.ldo = OCW;
                u.qrow0 = MLAT + b * CTX; u.ctx_row0 = MLAT + b * CTX;
            } else { const int jj = j - 80, b = jj / 6, hq = jj % 6, kvh = hq / 3;
                u.q = P1 + 768 + hq * 64; u.ldq = P1W; u.k = P1 + 1152 + kvh * 64; u.ldk = P1W; u.v = HW + C_SWV + kvh * 64; u.ldv = DINP; u.o = OC + 1024 + hq * 64; u.ldo = OCW;
                u.qrow0 = MLAT + b * CTX; u.ctx_row0 = MLAT + b * CTX; u.m0 = a.in[I_SINK][l * 6 + hq] * LOG2E; u.l0 = 1.f;
            }
        }
        if (big) attn_unit<192, 128, P2W, UW>(F.lds, u, F.tid, F.wave, F.lane);
        else attn_unit<64, 64, P1W, DINP>(F.lds, u, F.tid, F.wave, F.lane);
    }
}

DI void norm2_phase(Frame& F, KArgs ka, int l, int nrows) {
    KA_FRESH(ka); const __attribute__((address_space(4))) Args& a = *ka; frame_fresh(F);
    LAS float* rt = (LAS float*)F.lds;
    const float* rg = a.in[I_ROUTER] + (size_t)l * 1024 * 16;
    for (int i = F.tid; i < 16384; i += 512) rt[i] = rg[i];
    __syncthreads();
    LAS float* xr = (LAS float*)(F.lds + 65536 + F.wave * 8192);
    const bf16_t* xs = (const bf16_t*)(a.ws + WS_XS);
    const float* modv = (const float*)(a.ws + WS_MODV);
    unsigned char* H2 = a.ws + WS_H2;
    float* AFL = (float*)(a.ws + WS_AFL); float* AFC = (float*)(a.ws + WS_AFC);
    const int eq = F.lane & 3, kq = F.lane >> 2;
    u32x2 xw[2][4];
#define N2_LOAD(mb_) do { _Pragma("unroll") for (int rr_ = 0; rr_ < 2; ++rr_) { const u32x2* xp_ = (const u32x2*)(xs + (size_t)((mb_) + rr_) * D) + F.lane; \
        _Pragma("unroll") for (int j_ = 0; j_ < 4; ++j_) xw[rr_][j_] = xp_[64 * j_]; } } while (0)
    if (2 * F.gw < nrows) N2_LOAD(2 * F.gw);
    for (int mb = 2 * F.gw; mb < nrows; mb += 2 * F.ngw) {
        const int mi = mod_index(mb);
        f32x4 v[2][4];
#pragma unroll
        for (int rr = 0; rr < 2; ++rr)
#pragma unroll
            for (int j = 0; j < 4; ++j) { const u32x2 w = xw[rr][j]; v[rr][j] = (f32x4){bflo(w.x), bfhi(w.x), bflo(w.y), bfhi(w.y)}; }
        if (mb + 2 * F.ngw < nrows) N2_LOAD(mb + 2 * F.ngw);
        const f32x4* g = (const f32x4*)(a.in[I_N2G] + l * D) + F.lane;
        const f32x4* sh = (const f32x4*)(modv + ((size_t)l * 9 + mi) * 6144 + 3 * 1024) + F.lane;
        const f32x4* sc = (const f32x4*)(modv + ((size_t)l * 9 + mi) * 6144 + 4 * 1024) + F.lane;
        f32x4 gg[4], shv[4];
#pragma unroll
        for (int j = 0; j < 4; ++j) { gg[j] = g[64 * j] * (sc[64 * j] + 1.0f); shv[j] = sh[64 * j]; }
#pragma unroll
        for (int rr = 0; rr < 2; ++rr) {
            float ss = 0.f;
#pragma unroll
            for (int j = 0; j < 4; ++j) ss += (v[rr][j].x * v[rr][j].x + v[rr][j].y * v[rr][j].y) + (v[rr][j].z * v[rr][j].z + v[rr][j].w * v[rr][j].w);
            const float rstd = __builtin_amdgcn_rsqf(wave_sum(ss) * (1.f / D) + EPS);
            unsigned* o = (unsigned*)(H2 + (size_t)(mb + rr) * D) + F.lane;
#pragma unroll
            for (int j = 0; j < 4; ++j) { const f32x4 hh = v[rr][j] * rstd * gg[j] + shv[j]; o[64 * j] = pk4_fp8(hh.x, hh.y, hh.z, hh.w);
                *(LAS f32x4*)(xr + rr * 1024 + 4 * F.lane + 256 * j) = hh; }
        }
        asm volatile("s_waitcnt lgkmcnt(0)" ::: "memory");
        f32x4 acc[2] = {{0.f, 0.f, 0.f, 0.f}, {0.f, 0.f, 0.f, 0.f}};
#pragma unroll 8
        for (int i = 0; i < 64; ++i) { const int k = kq + 16 * i; const float x0 = xr[k], x1 = xr[1024 + k]; const f32x4 w = *(const LAS f32x4*)(rt + k * 16 + 4 * eq); acc[0] += w * x0; acc[1] += w * x1; }
        asm volatile("s_waitcnt lgkmcnt(0)" ::: "memory");
#pragma unroll
        for (int rr = 0; rr < 2; ++rr) { const int m = mb + rr; f32x4 ac = acc[rr];
#pragma unroll
            for (int ofs = 4; ofs < 64; ofs <<= 1) { ac.x += __shfl_xor(ac.x, ofs); ac.y += __shfl_xor(ac.y, ofs); ac.z += __shfl_xor(ac.z, ofs); ac.w += __shfl_xor(ac.w, ofs); }
            float mx = fmaxf(fmaxf(ac.x, ac.y), fmaxf(ac.z, ac.w)); mx = fmaxf(mx, __shfl_xor(mx, 1)); mx = fmaxf(mx, __shfl_xor(mx, 2));
            f32x4 ex; ex.x = __expf(ac.x - mx); ex.y = __expf(ac.y - mx); ex.z = __expf(ac.z - mx); ex.w = __expf(ac.w - mx);
            float sum = (ex.x + ex.y) + (ex.z + ex.w); sum += __shfl_xor(sum, 1); sum += __shfl_xor(sum, 2);
            const float inv = 1.0f / sum;
            if (F.lane < 4) {
                if (m < MLAT) { const int b = m >> 12, s = m & 4095; float* p = AFL + ((size_t)(b * 16 + 4 * F.lane)) * 4096 + s; p[0] = ex.x * inv; p[4096] = ex.y * inv; p[2 * 4096] = ex.z * inv; p[3 * 4096] = ex.w * inv; }
                else { const int b = (m - MLAT) >> 8, s = (m - MLAT) & 255; float* p = AFC + ((size_t)(b * 16 + 4 * F.lane)) * 256 + s; p[0] = ex.x * inv; p[256] = ex.y * inv; p[512] = ex.z * inv; p[768] = ex.w * inv; }
            }
        }
    }
}

DI unsigned block_excl_scan(unsigned v, unsigned& total, LAS unsigned* wsum, int tid, int lane, int wave) {
    unsigned x = v;
#pragma unroll
    for (int o = 1; o < 64; o <<= 1) { const unsigned y = __shfl_up(x, o); if (lane >= o) x += y; }
    if (lane == 63) wsum[wave] = x;
    __syncthreads();
    unsigned base = 0, tot = 0;
#pragma unroll
    for (int w = 0; w < 8; ++w) { const unsigned s = wsum[w]; if (w < wave) base += s; tot += s; }
    __syncthreads();
    total = tot;
    return base + x - v;
}
DI void select_phase(Frame& F, KArgs ka, int l) {
    KA_FRESH(ka); const __attribute__((address_space(4))) Args& a = *ka; frame_fresh(F);
    const bool last = (l == NL - 1);
    const int nunits = last ? 128 : 256;
    LAS unsigned* hist = (LAS unsigned*)F.lds;
    LAS unsigned* wsum = (LAS unsigned*)(F.lds + 8192);
    LAS unsigned* bc = (LAS unsigned*)(F.lds + 8192 + 64);
    LAS int* sel = (LAS int*)(F.lds + 16384);
    const float* AFL = (const float*)(a.ws + WS_AFL); const float* AFC = (const float*)(a.ws + WS_AFC);
    int* smap = (int*)(a.ws + WS_SMAP); float* gate = (float*)(a.ws + WS_GATE);
    const unsigned char* H2 = a.ws + WS_H2; unsigned char* XG = a.ws + WS_XG;
    for (int unit = blockIdx.x; unit < nunits; unit += F.G) {
        const bool lat = unit < 128; const int be = unit & 127, b = be >> 4, e = be & 15;
        const int N = lat ? 4096 : 256, cap = lat ? CAP_LAT : CAP_CTX;
        const float* aff = lat ? AFL + (size_t)be * 4096 : AFC + (size_t)be * 256;
        unsigned key[8]; const int per = lat ? 8 : 1; const bool act = lat || F.tid < 256;
#pragma unroll
        for (int j = 0; j < 8; ++j) key[j] = (act && j < per) ? __float_as_uint(aff[F.tid * per + j]) : 0u;
        unsigned prefix = 0u, pmask = 0u, need = (unsigned)cap;
#pragma unroll
        for (int pass = 0; pass < 3; ++pass) {
            const int shift = pass == 0 ? 21 : (pass == 1 ? 10 : 0), nb = pass == 2 ? 1024 : 2048;
            for (int i = F.tid; i < 2048; i += 512) hist[i] = 0u;
            __syncthreads();
#pragma unroll
            for (int j = 0; j < 8; ++j) if (act && j < per && (key[j] & pmask) == prefix) (void)__hip_atomic_fetch_add(&hist[(key[j] >> shift) & (nb - 1)], 1u, __ATOMIC_RELAXED, __HIP_MEMORY_SCOPE_WORKGROUP);
            __syncthreads();
            unsigned c4[4], mine = 0;
#pragma unroll
            for (int j = 0; j < 4; ++j) { const int bin = 2047 - 4 * F.tid - j; c4[j] = bin < nb ? hist[bin] : 0u; mine += c4[j]; }
            unsigned tot; unsigned run = block_excl_scan(mine, tot, wsum, F.tid, F.lane, F.wave);
#pragma unroll
            for (int j = 0; j < 4; ++j) { const int bin = 2047 - 4 * F.tid - j;
                if (bin < nb && run < need && run + c4[j] >= need) { bc[0] = (unsigned)bin; bc[1] = run; }
                run += c4[j]; }
            __syncthreads();
            const unsigned cb = bc[0], above = bc[1];
            prefix |= cb << shift; pmask |= (unsigned)(nb - 1) << shift; need -= above;
            __syncthreads();
        }
        unsigned neq = 0, ngt = 0;
#pragma unroll
        for (int j = 0; j < 8; ++j) if (act && j < per) { neq += key[j] == prefix; ngt += key[j] > prefix; }
        unsigned teq; const unsigned eqbase = block_excl_scan(neq, teq, wsum, F.tid, F.lane, F.wave);
        unsigned nsel = 0, flags = 0, erun = eqbase;
#pragma unroll
        for (int j = 0; j < 8; ++j) if (act && j < per) { bool s = key[j] > prefix; if (key[j] == prefix) { s = erun < need; ++erun; } if (s) { flags |= 1u << j; ++nsel; } }
        unsigned tsel; unsigned sbase = block_excl_scan(nsel, tsel, wsum, F.tid, F.lane, F.wave);
        const int rowbase = lat ? b * SEQ : MLAT + b * CTX;
        const int slotbase = lat ? be * CAP_LAT : NSLOT_LAT + (e * 8 + b) * CAP_CTX;
#pragma unroll
        for (int j = 0; j < 8; ++j) if (act && j < per) { const int tok = F.tid * per + j; int slot = -1;
            if ((flags >> j) & 1u) { slot = slotbase + (int)sbase; sel[sbase] = tok; gate[slot] = __uint_as_float(key[j]); ++sbase; }
            smap[(size_t)e * MT + rowbase + tok] = slot; }
        __syncthreads();
        if (lat) {
            for (int t0 = F.wave * 16; t0 < cap; t0 += 128) {
                u32x4 rowv[16];
#pragma unroll
                for (int q = 0; q < 16; ++q) rowv[q] = ((const u32x4*)(H2 + (size_t)(rowbase + sel[t0 + q]) * D))[F.lane];
#pragma unroll
                for (int q = 0; q < 16; ++q) ((u32x4*)(XG + (size_t)(slotbase + t0 + q) * D))[F.lane] = rowv[q];
            }
        } else {
            const int t0 = F.wave * 4;
            u32x4 rowv[4];
#pragma unroll
            for (int q = 0; q < 4; ++q) rowv[q] = ((const u32x4*)(H2 + (size_t)(rowbase + sel[t0 + q]) * D))[F.lane];
#pragma unroll
            for (int q = 0; q < 4; ++q) ((u32x4*)(XG + (size_t)(slotbase + t0 + q) * D))[F.lane] = rowv[q];
        }
        __syncthreads();
    }
}

#ifndef Q_INA
#define Q_INA 3
#endif
#ifndef Q_INB
#define Q_INB 6
#endif
#ifndef Q_INC
#define Q_INC 9
#endif
#ifndef Q_MRG
#define Q_MRG 9
#endif
#ifndef Q_WO
#define Q_WO 2
#endif
#ifndef Q_GU
#define Q_GU 3
#endif
#ifndef Q_DN
#define Q_DN 3
#endif
#define TAIL1(nwg_, Q_) do { const int r_ = (nwg_) % F.G; if (!last && r_ != 0) { if (bx >= r_) convert_tail(F, ka, l + 1, cur + 8 * (Q_) * (bx - r_), (Q_)); cur += 8 * (Q_) * (F.G - r_); } } while (0)
DI unsigned char* ws_fresh(KArgs ka) { KA_FRESH(ka); return ka->ws; }
__global__ void __launch_bounds__(512, 2) mega_fwd(Args a_unused) {
    extern __shared__ __attribute__((aligned(16))) unsigned char lds_raw[];
    KArgs ka = (KArgs)__builtin_amdgcn_kernarg_segment_ptr();
    Frame F;
    F.lds = (LAS unsigned char*)lds_raw;
    F.tid = threadIdx.x; F.lane = F.tid & 63; F.wave = __builtin_amdgcn_readfirstlane(F.tid >> 6);
    F.G = gridDim.x; { const int bx = blockIdx.x; F.vcu = (F.G % 8 == 0) ? (bx % 8) * (F.G / 8) + bx / 8 : bx; }
    F.gw = F.vcu * 8 + F.wave; F.ngw = F.G * 8;
    for (int u = F.tid; u < (LDS_BYTES - LDSCTL_OFF) / 4; u += 512) ((LAS unsigned*)(F.lds + LDSCTL_OFF))[u] = 0u;
    __syncthreads();
    XcdBarrier bar = xcd_barrier_post((unsigned*)(ws_fresh(ka) + WS_CTL) + CW_BAR, (volatile LAS unsigned*)(F.lds + LDSCTL_OFF + 32));
#define GRID_BAR() xcd_barrier(bar)
    const int bx = blockIdx.x;

    if (PH(0)) modv_phase(F, ka);
    for (int rep_ = 0; rep_ < REPS(2); ++rep_) if (PH(2)) convert_weights(F, ka, 0, 0);
    GRID_BAR();
    if (PH(3)) row_phase(F, ka, 0);
    GRID_BAR();

    for (int l = 0; l < NL; ++l) {
        const bool last = (l == NL - 1);
        const int nMe = last ? MLAT / 256 : MT / 256;
        const int nMs = last ? NSLOT_LAT / 256 : NSLOT / 256;
        int cur = 0;
        if (PH(4)) { unsigned char* ws = ws_fresh(ka);
            for (int rep_ = 0; rep_ < REPS(4); ++rep_) { pg8::Gemm g{(const bf16_t*)(ws + WS_R4), (const bf16_t*)wsel(ws, l, W_IN), 1024, 1024, 1024, 0}; pg8::Order S; S.init(MT / 256, DINP / 256, F.G, bx);
              pg8::EpiStoreBf16 E{(bf16_t*)(ws + WS_HW), DINP}; pg8::gemm_phase(F.lds, g, S, E); }
            for (int rep_ = 0; rep_ < REPS(17); ++rep_) { pg8::Gemm g{(const bf16_t*)(ws + WS_R4 + 68 * MiB), (const bf16_t*)wsel(ws, l, W_GL), 1024, 1024, 1024, 0}; pg8::Order S; S.init(MT / 256, NGL / 256, F.G, (bx + F.G / 2) % F.G);
              pg8::EpiGate E{ws + WS_G}; pg8::gemm_phase<pg8::EpiGate, true>(F.lds, g, S, E); } }
        if (!last && F.G == 256) {
            int q = 0, off = 0;
            if (bx < 128) { q = Q_INA; off = bx * Q_INA; } else if (bx >= 224) { q = Q_INC; off = 128 * Q_INA + 24 * Q_INB + (bx - 224) * Q_INC; } else if (bx >= 200) { q = Q_INB; off = 128 * Q_INA + (bx - 200) * Q_INB; }
            if (q) convert_tail(F, ka, l + 1, cur + 8 * off, q);
            cur += 8 * (128 * Q_INA + 24 * Q_INB + 32 * Q_INC); }
        GRID_BAR();
        for (int rep_ = 0; rep_ < REPS(5); ++rep_) if (PH(5)) { unsigned char* ws = ws_fresh(ka); pg8::Gemm g{(const bf16_t*)(ws + WS_HW) + C_CQ, (const bf16_t*)wsel(ws, l, W_UP), 384, DINP, 384, 0}; pg8::Order S; S.init(MT / 256, UW / 256, F.G, bx);
            pg8::EpiStoreBf16 E{(bf16_t*)(ws + WS_R4), UW}; pg8::gemm_phase(F.lds, g, S, E); }
        for (int rep_ = 0; rep_ < REPS(6); ++rep_) if (PH(6)) prep_phase(F, ka, l);
        GRID_BAR();
        for (int rep_ = 0; rep_ < REPS(7); ++rep_) if (PH(7)) prep2_phase(F, ka, l, rep_);
        GRID_BAR();
        for (int rep_ = 0; rep_ < REPS(8); ++rep_) if (PH(8)) attn_phase(F, ka, l);
        GRID_BAR();
        for (int rep_ = 0; rep_ < REPS(9); ++rep_) if (PH(9)) { unsigned char* ws = ws_fresh(ka); pg8::Order S; S.init(nMe, 4, F.G, bx);
          const unsigned char* OC = ws + WS_OCAT; bf16_t* MG = (bf16_t*)(ws + WS_MERGED); const unsigned char* GL = ws + WS_G;
          { pg8::Gemm3 g{OC, OC + 512, OC + 1024, wsel(ws, l, W_NAO), wsel(ws, l, W_MLAO), wsel(ws, l, W_SWAO), OCW, 512}; pg8::EpiMerge3 E{MG, GL}; pg8::gemm_phase3(F.lds, g, S, E); } }
        TAIL1(nMe * 4, Q_MRG);
        GRID_BAR();
        if (PH(10)) { unsigned char* ws = ws_fresh(ka); pg8::Gemm g{(const bf16_t*)(ws + WS_MERGED), (const bf16_t*)wsel(ws, l, W_O), 1024, 1024, 1024, 0}; pg8::Order S; S.init(nMe, 4, F.G, bx);
            pg8::EpiResid E{(bf16_t*)(ws + WS_XS), (const float*)(ws + WS_MODV) + (size_t)l * 9 * 6144 + 2 * 1024}; pg8::gemm_phase<pg8::EpiResid, true>(F.lds, g, S, E); }
        TAIL1(nMe * 4, Q_WO);
        GRID_BAR();
        for (int rep_ = 0; rep_ < REPS(11); ++rep_) if (PH(11)) norm2_phase(F, ka, l, last ? MLAT : MT);
        GRID_BAR();
        for (int rep_ = 0; rep_ < REPS(12); ++rep_) if (PH(12)) select_phase(F, ka, l);
        GRID_BAR();
        for (int rep_ = 0; rep_ < REPS(13); ++rep_) if (PH(13)) { unsigned char* ws = ws_fresh(ka); pg8::Gemm g{(const bf16_t*)(ws + WS_XG), (const bf16_t*)wsel(ws, l, W_GU), 1024, 1024, 1024, (size_t)2048 * 1024}; pg8::Order S; S.init(nMs, 8, F.G, bx, 1);
            pg8::EpiSwiglu E{ws + WS_ACT}; pg8::gemm_phase<pg8::EpiSwiglu, true>(F.lds, g, S, E); }
        TAIL1(nMs * 8, Q_GU);
        GRID_BAR();
        for (int rep_ = 0; rep_ < REPS(14); ++rep_) if (PH(14)) { unsigned char* ws = ws_fresh(ka); pg8::Gemm g{(const bf16_t*)(ws + WS_ACT), (const bf16_t*)wsel(ws, l, W_DN), 1024, 1024, 1024, (size_t)1024 * 1024}; pg8::Order S; S.init(nMs, 4, F.G, bx, 1);
            pg8::EpiDown E{(bf16_t*)(ws + WS_Y), (const float*)(ws + WS_GATE)}; pg8::gemm_phase<pg8::EpiDown, true>(F.lds, g, S, E); }
        TAIL1(nMs * 4, Q_DN);
        GRID_BAR();
        for (int rep_ = 0; rep_ < REPS(15); ++rep_) if (PH(15)) row_phase(F, ka, l + 1, rep_);
        if (!last) { for (int rep_ = 0; rep_ < REPS(16); ++rep_) if (PH(16)) convert_weights(F, ka, l + 1, cur); GRID_BAR(); }
    }
}

extern "C" void kernel_launch(void* const* d_in, const int* in_sizes, int n_in, void* d_out, int out_size, void* d_ws, size_t ws_size, hipStream_t stream) {
    static int grid = 0;
    if (grid == 0) {
        if (n_in != 29 || in_sizes[0] != MLAT * D || out_size != MLAT * D || ws_size < WS_END) {
            fprintf(stderr, "kernel_launch: unexpected problem: n_in %d in0 %d out %d ws %zu (need %zu)\n", n_in, n_in > 0 ? in_sizes[0] : -1, out_size, ws_size, (size_t)WS_END); grid = -1; return; }
        int dev = 0, cus = 0, per_cu = 0;
        if (hipGetDevice(&dev) != hipSuccess || hipDeviceGetAttribute(&cus, hipDeviceAttributeMultiprocessorCount, dev) != hipSuccess) { fprintf(stderr, "kernel_launch: device query failed\n"); grid = -1; return; }
        if (hipFuncSetAttribute((const void*)mega_fwd, hipFuncAttributeMaxDynamicSharedMemorySize, LDS_BYTES) != hipSuccess) { fprintf(stderr, "kernel_launch: hipFuncSetAttribute failed\n"); grid = -1; return; }
        if (hipOccupancyMaxActiveBlocksPerMultiprocessor(&per_cu, (const void*)mega_fwd, 512, LDS_BYTES) != hipSuccess || per_cu < 1) {
            fprintf(stderr, "kernel_launch: occupancy query reports %d workgroups per CU\n", per_cu); }
        (void)hipGetLastError();
        grid = cus;
    }
    if (grid < 0) return;
    if (hipMemsetAsync((char*)d_ws + WS_CTL, 0, CTL_BYTES, stream) != hipSuccess) { fprintf(stderr, "kernel_launch: memset failed\n"); return; }
    Args a{};
    for (int i = 0; i < 29; ++i) a.in[i] = (const float*)d_in[i];
    a.out = (float*)d_out; a.ws = (unsigned char*)d_ws;
    hipLaunchKernelGGL(mega_fwd, dim3(grid), dim3(512), LDS_BYTES, stream, a);
    const hipError_t le = hipPeekAtLastError();
    if (le != hipSuccess) fprintf(stderr, "kernel_launch: launch failed: %s\n", hipGetErrorName(le));
}
```

```cpp
#include <hip/hip_runtime.h>
#include <cstdio>
#include <cstdint>

#define DI __device__ __forceinline__
#ifndef PH_MASK
#define PH_MASK 0xFFFFF
#endif
#define PH(b) ((PH_MASK >> (b)) & 1)
#ifndef REP_MASK
#define REP_MASK 0
#endif
#define REPS(b) (1 + ((REP_MASK >> (b)) & 1))
#define LAS __attribute__((address_space(3)))
#define GAS __attribute__((address_space(1)))
typedef unsigned short bf16_t;
typedef short bf16x8 __attribute__((ext_vector_type(8)));
typedef short s16x4 __attribute__((ext_vector_type(4)));
typedef float f32x4 __attribute__((ext_vector_type(4)));
typedef float f32x2 __attribute__((ext_vector_type(2)));
typedef float f32x16 __attribute__((ext_vector_type(16)));
typedef unsigned u32x4 __attribute__((ext_vector_type(4)));
typedef unsigned u32x2 __attribute__((ext_vector_type(2)));
typedef int i32x8 __attribute__((ext_vector_type(8)));

constexpr int D = 1024, NB = 8, SEQ = 4096, NL = 4, CTX = 256;
constexpr int MLAT = NB * SEQ, MCTX = NB * CTX, MT = MLAT + MCTX;
constexpr int DIN = 5312, DINP = 2304, NGL = 3072;
constexpr int C_NAQ = 0, C_NAK = 384, C_NAV = 768, C_CQ = 1152, C_CKV = 1408, C_KR = 1536, C_SWQ = 1600, C_SWK = 1984, C_SWV = 2112, C_GL = 2240;
constexpr int UW = 1792;
constexpr int P1W = 1280;
constexpr int P2W = 1536;
constexpr int OCW = 1536;
constexpr int NE = 16, CAP_LAT = 512, CAP_CTX = 32;
constexpr int NSLOT_LAT = NB * NE * CAP_LAT, NSLOT = NSLOT_LAT + NB * NE * CAP_CTX;
constexpr float EPS = 1e-6f;
constexpr float LOG2E = 1.4426950408889634f;

constexpr size_t MiB = 1u << 20;
constexpr size_t WS_CTL = 0, CTL_BYTES = 1 * MiB;
constexpr size_t WS_MODV = 1 * MiB;
constexpr size_t WS_W = 2 * MiB;
constexpr size_t W_IN = 0, W_GL = 4718592  , W_UP = 11010048, W_NAO = 7864320  , W_MLAO = 13172736, W_SWAO = 8912896  , W_O = 15007744, W_GU = 17104896, W_DN = 84213760, W_END = 117768192;
constexpr size_t WS_XS = 115 * MiB, WS_W2 = 183 * MiB  ;
constexpr size_t WS_HW = 251 * MiB;
constexpr size_t WS_G = WS_HW + 153 * MiB;
constexpr size_t WS_P1 = 608 * MiB;
constexpr size_t WS_P2 = 693 * MiB;
constexpr size_t WS_R4 = 795 * MiB;
constexpr size_t WS_AFL = 914 * MiB;
constexpr size_t WS_AFC = 916 * MiB;
constexpr size_t WS_SMAP = 917 * MiB;
constexpr size_t WS_GATE = 920 * MiB;
constexpr size_t WS_OCAT = 921 * MiB;
constexpr size_t WS_END = 1006 * MiB;
constexpr size_t WS_MERGED = WS_P1;
constexpr size_t WS_H2 = WS_HW;
constexpr size_t WS_XG = WS_HW + 68 * MiB;
constexpr size_t WS_ACT = WS_HW + 204 * MiB;
constexpr size_t WS_Y = WS_HW + 340 * MiB;
static_assert(W_END <= 113 * MiB && WS_W + 113 * MiB <= WS_XS, "weights");
static_assert(W_GU + 64 * MiB <= W_DN && W_DN + 32 * MiB <= 113 * MiB && WS_XS + (size_t)MT * D * 2 <= WS_W2 && WS_W2 + W_GU <= WS_HW, "second weight buffers");
static_assert(WS_XS + (size_t)MT * D * 4 <= WS_HW && WS_HW + (size_t)MT * DINP * 2 <= WS_G && WS_G + (size_t)MT * NGL * 2 <= WS_P1 && WS_P1 + (size_t)MT * P1W * 2 <= WS_P2 && WS_P2 + (size_t)MT * P2W * 2 <= WS_R4, "map");
static_assert(WS_R4 + (size_t)MT * UW * 2 <= WS_AFL && WS_Y + (size_t)NSLOT * D * 2 <= WS_R4 && WS_SMAP + (size_t)16 * MT * 4 <= WS_GATE && WS_GATE + (size_t)NSLOT * 4 <= WS_OCAT && WS_OCAT + (size_t)MT * OCW <= WS_END, "map2");
constexpr int CW_BAR = 4096;

constexpr int RING_BYTES = 131072, LDSCTL_OFF = RING_BYTES, LDS_BYTES = 147456;

DI unsigned pk2(float lo, float hi) { unsigned r; asm("v_cvt_pk_bf16_f32 %0, %1, %2" : "=v"(r) : "v"(lo), "v"(hi)); return r; }
DI unsigned pk4_fp8(float a, float b, float c, float d) { int w = 0; w = __builtin_amdgcn_cvt_pk_fp8_f32(a, b, w, false); w = __builtin_amdgcn_cvt_pk_fp8_f32(c, d, w, true); return (unsigned)w; }
DI float bflo(unsigned w) { return __uint_as_float(w << 16); }
DI float bfhi(unsigned w) { return __uint_as_float(w & 0xffff0000u); }
DI float bf2f(bf16_t b) { return __uint_as_float((unsigned)b << 16); }
DI float wave_sum(float v) {
#pragma unroll
    for (int o = 1; o < 64; o <<= 1) v += __shfl_xor(v, o);
    return v;
}
DI float sigmoidf_(float x) { return __builtin_amdgcn_rcpf(1.0f + __builtin_amdgcn_exp2f(-x * LOG2E)); }
DI int mod_index(int row) { return row < MLAT ? (row >> 12) : 8; }

#define XB_TMO      128
#define XB_XCNT(j)  (256  + 64 * (j))
#define XB_XSUB(j)  (1280 + 64 * (j))
#define XB_XGEN(j)  (2304 + 64 * (j))
#define XB_TOP      3328
#define XB_TOPGEN   3392
#define XCD_BAR_WORDS 3456
#define XB_SPIN_CAP (1u << 18)
DI unsigned xb_ld(unsigned* p)              { return __hip_atomic_load(p, __ATOMIC_RELAXED, __HIP_MEMORY_SCOPE_AGENT); }
DI unsigned xb_add(unsigned* p, unsigned v) { return __hip_atomic_fetch_add(p, v, __ATOMIC_RELAXED, __HIP_MEMORY_SCOPE_AGENT); }
DI unsigned xb_xcc_id() { return (unsigned)__builtin_amdgcn_s_getreg((3 << 11) | 20) & 0xFu; }
#define XB_SPIN(cond, bar) do { unsigned _sp = 0; while (cond) { __builtin_amdgcn_s_sleep(1); \
    if ((++_sp & 255u) == 0u) { if (xb_ld(&(bar)[XB_TMO])) break; if (_sp > XB_SPIN_CAP) { atomicAdd(&(bar)[XB_TMO], 1u); break; } } } } while (0)
struct XcdBarrier { unsigned* bar; unsigned x; volatile LAS unsigned* st; };
DI XcdBarrier xcd_barrier_post(unsigned* bar, volatile LAS unsigned* st) {
    XcdBarrier b; b.bar = bar; b.x = xb_xcc_id(); b.st = st;
    if (threadIdx.x == 0) (void)xb_add(&bar[XB_XCNT(b.x)], 1u);
    return b;
}
DI void xcd_barrier_complete(unsigned* bar, unsigned x, unsigned& nloc, unsigned& nx) {
    const unsigned G = gridDim.x * gridDim.y * gridDim.z;
    unsigned sum, cnt, mine, sp = 0u;
    for (;;) {
        sum = 0u; cnt = 0u; mine = 0u;
#pragma unroll
        for (unsigned j = 0; j < 16; ++j) { const unsigned c = xb_ld(&bar[XB_XCNT(j)]); sum += c; cnt += (c > 0u) ? 1u : 0u; mine = (j == x) ? c : mine; }
        if (sum == G) break;
        __builtin_amdgcn_s_sleep(1);
        if ((++sp & 255u) == 0u) { if (xb_ld(&bar[XB_TMO])) break; if (sp > XB_SPIN_CAP) { atomicAdd(&bar[XB_TMO], 1u); break; } }
    }
    nloc = mine > 0u ? mine : 1u; nx = cnt > 0u ? cnt : 1u;
}
DI void xcd_barrier(const XcdBarrier& b) {
    asm volatile("s_waitcnt vmcnt(0)" ::: "memory");
    __syncthreads();
    if (threadIdx.x == 0) {
        unsigned* bar = b.bar; unsigned bx_ = b.x; asm volatile("" : "+s"(bar), "+s"(bx_));
        __builtin_amdgcn_s_waitcnt(0);
        unsigned nloc = b.st[0], nx = b.st[1];
        if (nloc == 0u) { xcd_barrier_complete(bar, bx_, nloc, nx); b.st[0] = nloc; b.st[1] = nx; }
        const unsigned old = xb_add(&bar[XB_XSUB(bx_)], 1u);
        const unsigned gen = old / nloc;
        if (old + 1u == (gen + 1u) * nloc) {
            __builtin_amdgcn_fence(__ATOMIC_RELEASE, "agent");
            asm volatile("s_waitcnt vmcnt(0)" ::: "memory");
            const unsigned og = xb_add(&bar[XB_TOP], 1u);
            const unsigned tg = og / nx;
            if (og + 1u == (tg + 1u) * nx) xb_add(&bar[XB_TOPGEN], 1u);
            else XB_SPIN(xb_ld(&bar[XB_TOPGEN]) == tg, bar);
            __builtin_amdgcn_fence(__ATOMIC_ACQUIRE, "agent");
            xb_add(&bar[XB_XGEN(bx_)], 1u);
            asm volatile("s_waitcnt vmcnt(0)" ::: "memory");
        } else {
            XB_SPIN(xb_ld(&bar[XB_XGEN(bx_)]) == gen, bar);
            __builtin_amdgcn_fence(__ATOMIC_ACQUIRE, "agent");
            asm volatile("s_waitcnt vmcnt(0)" ::: "memory");
        }
    }
    __syncthreads();
}

namespace pg8 {
constexpr int BM = 256, BK = 64, HALF = 128, HTB = HALF * BK * 2, NXCD = 8, WGM = 8;
__host__ __device__ __forceinline__ int lds_byte(int r, int c) { const int st = (r >> 4) * 2 + (c >> 5), rr = r & 15, cc = c & 31, ob = rr * 64 + cc * 2; return st * 1024 + (ob ^ (((ob >> 9) & 1) << 5)); }
__host__ __device__ __forceinline__ void stage_rc(int b, int& R, int& C) { const int st = b / 1024, sb = b % 1024, swz = sb ^ (((sb >> 9) & 1) << 5); R = (st >> 1) * 16 + swz / 64; C = (st & 1) * 32 + (swz % 64) / 2; }
__host__ __device__ __forceinline__ int perm32(int rho) { const int n = rho >> 4, i = rho & 15; return 8 * (i >> 2) + 4 * n + (i & 3); }
struct Unit { int pm, pn; };
struct Gemm { const bf16_t* A; const bf16_t* Bt; int K, lda, ldb; size_t estride; };
struct Order {
    int nM, nN, nwg, G, c, moe;
    DI void init(int nM_, int nN_, int G_, int c_, int moe_ = 0) { nM = nM_; nN = nN_; nwg = nM * nN; G = G_; c = c_; moe = moe_; }
    DI bool next(int i, Unit& u) const {
        const long L = (long)i * G + c; if (L >= nwg) return false;
        int wgid = (int)L; { const int q = nwg / NXCD, r = nwg % NXCD, xcd = wgid % NXCD, off = wgid / NXCD; wgid = (xcd < r ? xcd * (q + 1) : r * (q + 1) + (xcd - r) * q) + off; }
        const int nig = WGM * nN, gid = wgid / nig, fm = gid * WGM, gsz = (nM - fm) < WGM ? (nM - fm) : WGM;
        u.pm = fm + ((wgid % nig) % gsz); u.pn = (wgid % nig) / gsz;
        if (moe && u.pm < 256) { const int e = u.pm >> 4, b = (u.pm >> 1) & 7, hf = u.pm & 1; u.pm = (((b << 4) | e) << 1) | hf; }
        return true;
    }
};
struct EpiStoreBf16 {
    static constexpr bool PERM = true;
    bf16_t* O; int ldc;
    DI void operator()(const f32x4 (&acc)[2][2][4][2], const Unit& u, int wr, int wc, int fr, int fq) const {
        const int row0 = u.pm * BM + wr * 64 + fr, col0 = u.pn * BM + wc * 32 + 8 * fq;
#pragma unroll
        for (int ai = 0; ai < 2; ++ai)
#pragma unroll
            for (int m = 0; m < 4; ++m) { bf16_t* rowp = O + (size_t)(row0 + ai * HALF + m * 16) * ldc + col0;
#pragma unroll
                for (int bj = 0; bj < 2; ++bj) { const f32x4 v0 = acc[ai][bj][m][0], v1 = acc[ai][bj][m][1];
                    u32x4 w; w.x = pk2(v0[0], v0[1]); w.y = pk2(v0[2], v0[3]); w.z = pk2(v1[0], v1[1]); w.w = pk2(v1[2], v1[3]);
                    *(u32x4*)(rowp + bj * HALF) = w; } }
    }
};
DI unsigned pk4_u8(float a, float b, float c, float d) {
    unsigned ua = (unsigned)(a * 255.0f + 0.5f), ub = (unsigned)(b * 255.0f + 0.5f), uc = (unsigned)(c * 255.0f + 0.5f), ud = (unsigned)(d * 255.0f + 0.5f);
    ua = ua < 1u ? 1u : ua; ub = ub < 1u ? 1u : ub; uc = uc < 1u ? 1u : uc; ud = ud < 1u ? 1u : ud;
    return ua | (ub << 8) | (uc << 16) | (ud << 24);
}
struct EpiGate {
    static constexpr bool PERM = true;
    unsigned char* O;
    DI void operator()(const f32x4 (&acc)[2][2][4][2], const Unit& u, int wr, int wc, int fr, int fq) const {
        const int row0 = u.pm * BM + wr * 64 + fr, col0 = u.pn * BM + wc * 32 + 8 * fq;
#pragma unroll
        for (int ai = 0; ai < 2; ++ai)
#pragma unroll
            for (int m = 0; m < 4; ++m) { unsigned char* rowp = O + (size_t)(row0 + ai * HALF + m * 16) * NGL + col0;
#pragma unroll
                for (int bj = 0; bj < 2; ++bj) { const f32x4 v0 = acc[ai][bj][m][0] * 0.03125f, v1 = acc[ai][bj][m][1] * 0.03125f;
                    u32x2 w; w.x = pk4_u8(sigmoidf_(v0[0]), sigmoidf_(v0[1]), sigmoidf_(v0[2]), sigmoidf_(v0[3])); w.y = pk4_u8(sigmoidf_(v1[0]), sigmoidf_(v1[1]), sigmoidf_(v1[2]), sigmoidf_(v1[3]));
                    *(u32x2*)(rowp + bj * HALF) = w; } }
    }
};
DI float u8f(unsigned w, int k) { return (float)((w >> (8 * k)) & 0xffu) * (1.0f / 255.0f); }
struct EpiMerge {
    static constexpr bool PERM = true;
    bf16_t* O; const unsigned char* gl; int first;
    DI void operator()(const f32x4 (&acc)[2][2][4][2], const Unit& u, int wr, int wc, int fr, int fq) const {
        const int row0 = u.pm * BM + wr * 64 + fr, col0 = u.pn * BM + wc * 32 + 8 * fq;
#pragma unroll
        for (int ai = 0; ai < 2; ++ai) {
            u32x2 g[4][2]; u32x4 p[4][2];
#pragma unroll
            for (int m = 0; m < 4; ++m)
#pragma unroll
                for (int bj = 0; bj < 2; ++bj) { const int row = row0 + ai * HALF + m * 16, col = col0 + bj * HALF;
                    g[m][bj] = *(const u32x2*)(gl + (size_t)row * NGL + col);
                    p[m][bj] = first ? (u32x4){0u, 0u, 0u, 0u} : *(const u32x4*)(O + (size_t)row * D + col); }
#pragma unroll
            for (int m = 0; m < 4; ++m)
#pragma unroll
                for (int bj = 0; bj < 2; ++bj) { const int row = row0 + ai * HALF + m * 16, col = col0 + bj * HALF;
                    const u32x2 gg = g[m][bj]; const u32x4 pp = p[m][bj]; const f32x4 v0 = acc[ai][bj][m][0], v1 = acc[ai][bj][m][1];
                    const float r0 = v0[0] * u8f(gg.x, 0) + bflo(pp.x), r1 = v0[1] * u8f(gg.x, 1) + bfhi(pp.x), r2 = v0[2] * u8f(gg.x, 2) + bflo(pp.y), r3 = v0[3] * u8f(gg.x, 3) + bfhi(pp.y);
                    const float r4 = v1[0] * u8f(gg.y, 0) + bflo(pp.z), r5 = v1[1] * u8f(gg.y, 1) + bfhi(pp.z), r6 = v1[2] * u8f(gg.y, 2) + bflo(pp.w), r7 = v1[3] * u8f(gg.y, 3) + bfhi(pp.w);
                    u32x4 w; w.x = pk2(r0, r1); w.y = pk2(r2, r3); w.z = pk2(r4, r5); w.w = pk2(r6, r7);
                    *(u32x4*)(O + (size_t)row * D + col) = w; }
        }
    }
};
struct EpiResid {
    static constexpr bool PERM = true;
    bf16_t* xs; const float* modg;
    DI void operator()(const f32x4 (&acc)[2][2][4][2], const Unit& u, int wr, int wc, int fr, int fq) const {
        const int row0 = u.pm * BM + wr * 64 + fr, col0 = u.pn * BM + wc * 32 + 8 * fq;
        const float* mp = modg + (size_t)mod_index(u.pm * BM) * 6144 + col0;
        f32x4 g0[2], g1[2];
#pragma unroll
        for (int bj = 0; bj < 2; ++bj) { g0[bj] = *(const f32x4*)(mp + bj * HALF) * (1.0f / 128.0f); g1[bj] = *(const f32x4*)(mp + bj * HALF + 4) * (1.0f / 128.0f); }
#pragma unroll
        for (int ai = 0; ai < 2; ++ai)
#pragma unroll
            for (int mh = 0; mh < 2; ++mh) {
                u32x4 xw[2][2];
#pragma unroll
                for (int m2 = 0; m2 < 2; ++m2)
#pragma unroll
                    for (int bj = 0; bj < 2; ++bj) xw[m2][bj] = *(const u32x4*)(xs + (size_t)(row0 + ai * HALF + (2 * mh + m2) * 16) * D + col0 + bj * HALF);
#pragma unroll
                for (int m2 = 0; m2 < 2; ++m2)
#pragma unroll
                    for (int bj = 0; bj < 2; ++bj) { const int m = 2 * mh + m2; const u32x4 x = xw[m2][bj];
                        const f32x4 x0 = (f32x4){bflo(x.x), bfhi(x.x), bflo(x.y), bfhi(x.y)} + g0[bj] * acc[ai][bj][m][0];
                        const f32x4 x1 = (f32x4){bflo(x.z), bfhi(x.z), bflo(x.w), bfhi(x.w)} + g1[bj] * acc[ai][bj][m][1];
                        u32x4 w; w.x = pk2(x0[0], x0[1]); w.y = pk2(x0[2], x0[3]); w.z = pk2(x1[0], x1[1]); w.w = pk2(x1[2], x1[3]);
                        *(u32x4*)(xs + (size_t)(row0 + ai * HALF + m * 16) * D + col0 + bj * HALF) = w; }
            }
    }
};
struct EpiSwiglu {
    static constexpr bool PERM = true;
    unsigned char* O;
    DI void operator()(const f32x4 (&acc)[2][2][4][2], const Unit& u, int wr, int wc, int fr, int fq) const {
        const int row0 = u.pm * BM + wr * 64 + fr, col0 = u.pn * HALF + wc * 32 + 8 * fq;
#pragma unroll
        for (int ai = 0; ai < 2; ++ai)
#pragma unroll
            for (int m = 0; m < 4; ++m) { const int row = row0 + ai * HALF + m * 16;
                const f32x4 a0 = acc[ai][0][m][0] * 0.03125f, a1 = acc[ai][0][m][1] * 0.03125f, u0 = acc[ai][1][m][0] * 0.25f, u1 = acc[ai][1][m][1] * 0.25f;
                float r[8];
#pragma unroll
                for (int j = 0; j < 4; ++j) { r[j] = a0[j] * sigmoidf_(a0[j]) * u0[j]; r[4 + j] = a1[j] * sigmoidf_(a1[j]) * u1[j]; }
                u32x2 w; w.x = pk4_fp8(r[0], r[1], r[2], r[3]); w.y = pk4_fp8(r[4], r[5], r[6], r[7]);
                *(u32x2*)(O + (size_t)row * D + col0) = w; }
    }
};
struct EpiDown {
    static constexpr bool PERM = true;
    bf16_t* O; const float* gate;
    DI void operator()(const f32x4 (&acc)[2][2][4][2], const Unit& u, int wr, int wc, int fr, int fq) const {
        const int row0 = u.pm * BM + wr * 64 + fr, col0 = u.pn * BM + wc * 32 + 8 * fq;
        float gv[2][4];
#pragma unroll
        for (int ai = 0; ai < 2; ++ai)
#pragma unroll
            for (int m = 0; m < 4; ++m) gv[ai][m] = gate[row0 + ai * HALF + m * 16] * (1.0f / 256.0f);
#pragma unroll
        for (int ai = 0; ai < 2; ++ai)
#pragma unroll
            for (int m = 0; m < 4; ++m) { const int row = row0 + ai * HALF + m * 16; const float g = gv[ai][m]; bf16_t* rowp = O + (size_t)row * D + col0;
#pragma unroll
                for (int bj = 0; bj < 2; ++bj) { const f32x4 v0 = acc[ai][bj][m][0] * g, v1 = acc[ai][bj][m][1] * g;
                    u32x4 w; w.x = pk2(v0[0], v0[1]); w.y = pk2(v0[2], v0[3]); w.z = pk2(v1[0], v1[1]); w.w = pk2(v1[2], v1[3]);
                    *(u32x4*)(rowp + bj * HALF) = w; } }
    }
};

struct EpiMerge3 {
    static constexpr bool PERM = true;
    bf16_t* O; const unsigned char* gl;
    DI void operator()(f32x4 (&acc)[2][2][4][2], const Unit& u, int seg, int wr, int wc, int fr, int fq) const {
        const int row0 = u.pm * BM + wr * 64 + fr, col0 = u.pn * BM + wc * 32 + 8 * fq;
#pragma unroll
        for (int ai = 0; ai < 2; ++ai) {
            u32x2 ga[4][2], gb[4][2];
#pragma unroll
            for (int m = 0; m < 4; ++m)
#pragma unroll
                for (int bj = 0; bj < 2; ++bj) { const unsigned char* gp = gl + (size_t)(row0 + ai * HALF + m * 16) * NGL + 1024 * seg + col0 + bj * HALF;
                    ga[m][bj] = *(const u32x2*)gp; gb[m][bj] = seg < 2 ? *(const u32x2*)(gp + 1024) : (u32x2){0u, 0u}; }
#pragma unroll
            for (int m = 0; m < 4; ++m)
#pragma unroll
                for (int bj = 0; bj < 2; ++bj) {
                    f32x4 s0, s1;
#pragma unroll
                    for (int k = 0; k < 4; ++k) { const float a0 = (float)((ga[m][bj].x >> (8 * k)) & 0xffu), a1 = (float)((ga[m][bj].y >> (8 * k)) & 0xffu);
                        if (seg < 2) { const float b0 = (float)((gb[m][bj].x >> (8 * k)) & 0xffu), b1 = (float)((gb[m][bj].y >> (8 * k)) & 0xffu); s0[k] = a0 * __builtin_amdgcn_rcpf(b0); s1[k] = a1 * __builtin_amdgcn_rcpf(b1); }
                        else { s0[k] = a0 * (1.0f / (255.0f * 128.0f)); s1[k] = a1 * (1.0f / (255.0f * 128.0f)); } }
                    acc[ai][bj][m][0] *= s0; acc[ai][bj][m][1] *= s1;
                    if (seg == 2) { const f32x4 v0 = acc[ai][bj][m][0] * 4.0f, v1 = acc[ai][bj][m][1] * 4.0f;
                        u32x2 w; w.x = pk4_fp8(v0[0], v0[1], v0[2], v0[3]); w.y = pk4_fp8(v1[0], v1[1], v1[2], v1[3]);
                        *(u32x2*)((unsigned char*)O + (size_t)(row0 + ai * HALF + m * 16) * D + col0 + bj * HALF) = w; }
                }
        }
    }
};
struct Gemm3 { const unsigned char* A0; const unsigned char* A1; const unsigned char* A2; const unsigned char* B0; const unsigned char* B1; const unsigned char* B2; int lda, ldb; };
template <class Epi>
DI void gemm_phase3(LAS unsigned char* lds, const Gemm3 g, const Order& S, const Epi& E) {
    int tid_ = threadIdx.x; asm volatile("" : "+v"(tid_));
    const int tid = tid_, wid = __builtin_amdgcn_readfirstlane(tid >> 6), lane = tid & 63, wr = wid >> 2, wc = wid & 3, fr = lane & 15, fq = lane >> 4;
    unsigned voffA[2], voffB[2];
#pragma unroll
    for (int i = 0; i < 2; ++i) { int R, C; stage_rc(tid * 16 + i * 8192, R, C); const int Rb = Epi::PERM ? ((R & ~31) + perm32(R & 31)) : R;
        voffA[i] = (unsigned)(R * g.lda + C * 2); voffB[i] = (unsigned)(Rb * g.ldb + C * 2); }
    const size_t kstep = (size_t)(BK * 2);
    const size_t hstepA = (size_t)HALF * g.lda, hstepB = (size_t)HALF * g.ldb;
    const size_t tstepA = 2 * hstepA, tstepB = 2 * hstepB;
    const unsigned ldsw = (unsigned)wid * 1024u;
    const int aoff = lds_byte(wr * 64 + fr, fq * 8), boff = lds_byte(wc * 32 + fr, fq * 8);
#define PG8_SA(b, h) (((b) * 2 + (h)) * HTB)
#define PG8_SB(b, h) ((4 + (b) * 2 + (h)) * HTB)
#define PG8_STAGE(bufoff, gbase, voff) do { _Pragma("unroll") for (int _i = 0; _i < 2; ++_i) \
        __builtin_amdgcn_global_load_lds((const unsigned*)((const char*)(gbase) + (voff)[_i]), (LAS unsigned*)(lds + (bufoff) + ldsw + _i * 8192), 16, 0, 0); } while (0)
#define PG8_LDA(dst, b, h) do { _Pragma("unroll") for (int m = 0; m < 4; ++m) _Pragma("unroll") for (int k = 0; k < 2; ++k) dst[m][k] = *(const LAS bf16x8*)(lds + PG8_SA(b, h) + aoff + m * 2048 + k * 1024); } while (0)
#define PG8_LDB(dst, b, h) do { _Pragma("unroll") for (int n = 0; n < 2; ++n) _Pragma("unroll") for (int k = 0; k < 2; ++k) dst[n][k] = *(const LAS bf16x8*)(lds + PG8_SB(b, h) + boff + n * 2048 + k * 1024); } while (0)
#define PG8_MMA(ai, bj, At, Bt) do { __builtin_amdgcn_s_setprio(1); _Pragma("unroll") for (int m = 0; m < 4; ++m) _Pragma("unroll") for (int n = 0; n < 2; ++n) { \
        const i32x8 bb_ = __builtin_bit_cast(i32x8, __builtin_shufflevector(Bt[n][0], Bt[n][1], 0, 1, 2, 3, 4, 5, 6, 7, 8, 9, 10, 11, 12, 13, 14, 15)); \
        const i32x8 aa_ = __builtin_bit_cast(i32x8, __builtin_shufflevector(At[m][0], At[m][1], 0, 1, 2, 3, 4, 5, 6, 7, 8, 9, 10, 11, 12, 13, 14, 15)); \
        asm volatile("v_mfma_scale_f32_16x16x128_f8f6f4 %0, %1, %2, %0, %3, %3 op_sel_hi:[0,0,0]" : "+v"(acc[ai][bj][m][n]) : "v"(bb_), "v"(aa_), "v"(0x7F7F7F7F)); } \
        __builtin_amdgcn_s_setprio(0); } while (0)
#define PG8_WAIT_V(n) asm volatile("s_waitcnt vmcnt(" #n ")" ::: "memory")
#define PG8_WAIT_L(n) asm volatile("s_waitcnt lgkmcnt(" #n ")" ::: "memory")
#define PG8_BAR __builtin_amdgcn_s_barrier()
#define PG8_SCHED __builtin_amdgcn_sched_barrier(0)
#define PG8_A3(sg, u) ((const char*)((sg) == 0 ? g.A0 : (sg) == 1 ? g.A1 : g.A2) + (size_t)(u).pm * tstepA)
#define PG8_B3(sg, u) ((const char*)((sg) == 0 ? g.B0 : (sg) == 1 ? g.B1 : g.B2) + (size_t)(u).pn * tstepB)
    Unit cur, nu; int ui = 0, seg = 0;
    if (!S.next(0, cur)) return;
    f32x4 acc[2][2][4][2];
#pragma unroll
    for (int a = 0; a < 2; ++a)
#pragma unroll
        for (int b = 0; b < 2; ++b)
#pragma unroll
            for (int m = 0; m < 4; ++m)
#pragma unroll
                for (int n = 0; n < 2; ++n) acc[a][b][m][n] = (f32x4){0.f, 0.f, 0.f, 0.f};
    bf16x8 At[4][2], B0[2][2], B1[2][2];
    const char* cA = PG8_A3(0, cur); const char* cB = PG8_B3(0, cur);
    PG8_STAGE(PG8_SB(0, 0), cB, voffB); PG8_STAGE(PG8_SB(0, 1), cB + hstepB, voffB); PG8_STAGE(PG8_SA(0, 0), cA, voffA); PG8_STAGE(PG8_SA(0, 1), cA + hstepA, voffA);
    if (wr == 1) PG8_BAR;
    PG8_WAIT_V(2); PG8_BAR;
    PG8_STAGE(PG8_SB(1, 0), cB + kstep, voffB); PG8_STAGE(PG8_SA(1, 0), cA + kstep, voffA); PG8_STAGE(PG8_SB(1, 1), cB + hstepB + kstep, voffB);
    PG8_WAIT_V(6); PG8_BAR;
    for (;;) {
        int nseg = seg + 1; bool has_next = true; nu = cur;
        if (nseg == 3) { nseg = 0; has_next = S.next(ui + 1, nu); }
        const char* nA = has_next ? PG8_A3(nseg, nu) : cA; const char* nB = has_next ? PG8_B3(nseg, nu) : cB;
        int nt_ = 4; asm volatile("" : "+s"(nt_));
        const int nt = nt_;
#pragma nounroll
        for (int t = 0; t < nt; t += 2) {
            const bool last = (t == nt - 2);
            const char* a1 = cA + (size_t)(t + 1) * kstep;
            const char* a2 = last ? nA : cA + (size_t)(t + 2) * kstep; const char* b2 = last ? nB : cB + (size_t)(t + 2) * kstep;
            const char* a3 = a2 + kstep; const char* b3 = b2 + kstep;
            PG8_LDB(B0, 0, 0); PG8_LDB(B1, 0, 1); PG8_SCHED; PG8_LDA(At, 0, 0); PG8_STAGE(PG8_SA(1, 1), a1 + hstepA, voffA);
            PG8_WAIT_V(8); PG8_WAIT_L(0); PG8_BAR; PG8_MMA(0, 0, At, B0); PG8_MMA(0, 1, At, B1); PG8_BAR; PG8_SCHED;
            PG8_LDA(At, 0, 1); PG8_STAGE(PG8_SB(0, 0), b2, voffB); PG8_STAGE(PG8_SB(0, 1), b2 + hstepB, voffB); PG8_STAGE(PG8_SA(0, 0), a2, voffA);
            PG8_WAIT_V(8); PG8_WAIT_L(0); PG8_BAR; PG8_MMA(1, 0, At, B0); PG8_MMA(1, 1, At, B1); PG8_BAR; PG8_SCHED;
            PG8_LDB(B0, 1, 0); PG8_LDB(B1, 1, 1); PG8_SCHED; PG8_LDA(At, 1, 0); PG8_STAGE(PG8_SA(0, 1), a2 + hstepA, voffA);
            PG8_WAIT_V(8); PG8_WAIT_L(0); PG8_BAR; PG8_MMA(0, 0, At, B0); PG8_MMA(0, 1, At, B1); PG8_BAR; PG8_SCHED;
            PG8_LDA(At, 1, 1); PG8_STAGE(PG8_SB(1, 0), b3, voffB); PG8_STAGE(PG8_SB(1, 1), b3 + hstepB, voffB); PG8_STAGE(PG8_SA(1, 0), a3, voffA);
            PG8_WAIT_V(8); PG8_WAIT_L(0); PG8_BAR; PG8_MMA(1, 0, At, B0); PG8_MMA(1, 1, At, B1); PG8_BAR; PG8_SCHED;
        }
        if (wr == 0) PG8_BAR;
        E(acc, cur, seg, wr, wc, fr, fq);
        if (!has_next) break;
        if (seg == 2) {
#pragma unroll
            for (int a = 0; a < 2; ++a)
#pragma unroll
                for (int b = 0; b < 2; ++b)
#pragma unroll
                    for (int m = 0; m < 4; ++m)
#pragma unroll
                        for (int n = 0; n < 2; ++n) acc[a][b][m][n] = (f32x4){0.f, 0.f, 0.f, 0.f};
            cur = nu; ++ui;
        }
        seg = nseg; cA = nA; cB = nB;
        if (wr == 1) PG8_BAR;
    }
    PG8_WAIT_V(0);
    PG8_BAR;
#undef PG8_SA
#undef PG8_SB
#undef PG8_STAGE
#undef PG8_LDA
#undef PG8_LDB
#undef PG8_MMA
#undef PG8_WAIT_V
#undef PG8_WAIT_L
#undef PG8_BAR
#undef PG8_SCHED
#undef PG8_A3
#undef PG8_B3
}

template <class Epi, bool FP8 = false>
DI void gemm_phase(LAS unsigned char* lds, const Gemm g, const Order& S, const Epi& E) {
    constexpr int ESZ = FP8 ? 1 : 2;
    int tid_ = threadIdx.x; asm volatile("" : "+v"(tid_));
    const int tid = tid_, wid = __builtin_amdgcn_readfirstlane(tid >> 6), lane = tid & 63, wr = wid >> 2, wc = wid & 3, fr = lane & 15, fq = lane >> 4;
    const int K = g.K, nt = K * ESZ / (BK * 2);
    unsigned voffA[2], voffB[2];
#pragma unroll
    for (int i = 0; i < 2; ++i) { int R, C; stage_rc(tid * 16 + i * 8192, R, C); const int Rb = Epi::PERM ? ((R & ~31) + perm32(R & 31)) : R;
        voffA[i] = (unsigned)(R * g.lda * ESZ + C * 2); voffB[i] = (unsigned)(Rb * g.ldb * ESZ + C * 2); }
    const size_t kstep = (size_t)(BK * 2);
    const size_t hstepA = (size_t)HALF * g.lda * ESZ, hstepB = (size_t)HALF * g.ldb * ESZ;
    const size_t tstepA = 2 * hstepA, tstepB = 2 * hstepB;
    const unsigned ldsw = (unsigned)wid * 1024u;
    const int aoff = lds_byte(wr * 64 + fr, fq * 8), boff = lds_byte(wc * 32 + fr, fq * 8);
#define PG8_SA(b, h) (((b) * 2 + (h)) * HTB)
#define PG8_SB(b, h) ((4 + (b) * 2 + (h)) * HTB)
#define PG8_STAGE(bufoff, gbase, voff) do { _Pragma("unroll") for (int _i = 0; _i < 2; ++_i) \
        __builtin_amdgcn_global_load_lds((const unsigned*)((const char*)(gbase) + (voff)[_i]), (LAS unsigned*)(lds + (bufoff) + ldsw + _i * 8192), 16, 0, 0); } while (0)
#define PG8_LDA(dst, b, h) do { _Pragma("unroll") for (int m = 0; m < 4; ++m) _Pragma("unroll") for (int k = 0; k < 2; ++k) dst[m][k] = *(const LAS bf16x8*)(lds + PG8_SA(b, h) + aoff + m * 2048 + k * 1024); } while (0)
#define PG8_LDB(dst, b, h) do { _Pragma("unroll") for (int n = 0; n < 2; ++n) _Pragma("unroll") for (int k = 0; k < 2; ++k) dst[n][k] = *(const LAS bf16x8*)(lds + PG8_SB(b, h) + boff + n * 2048 + k * 1024); } while (0)
#define PG8_MMA(ai, bj, At, Bt) do { __builtin_amdgcn_s_setprio(1); _Pragma("unroll") for (int m = 0; m < 4; ++m) _Pragma("unroll") for (int n = 0; n < 2; ++n) { \
        if constexpr (FP8) { const i32x8 bb_ = __builtin_bit_cast(i32x8, __builtin_shufflevector(Bt[n][0], Bt[n][1], 0, 1, 2, 3, 4, 5, 6, 7, 8, 9, 10, 11, 12, 13, 14, 15)); \
            const i32x8 aa_ = __builtin_bit_cast(i32x8, __builtin_shufflevector(At[m][0], At[m][1], 0, 1, 2, 3, 4, 5, 6, 7, 8, 9, 10, 11, 12, 13, 14, 15)); \
            asm volatile("v_mfma_scale_f32_16x16x128_f8f6f4 %0, %1, %2, %0, %3, %3 op_sel_hi:[0,0,0]" : "+v"(acc[ai][bj][m][n]) : "v"(bb_), "v"(aa_), "v"(0x7F7F7F7F)); } \
        else { _Pragma("unroll") for (int k = 0; k < 2; ++k) acc[ai][bj][m][n] = __builtin_amdgcn_mfma_f32_16x16x32_bf16(Bt[n][k], At[m][k], acc[ai][bj][m][n], 0, 0, 0); } } \
        __builtin_amdgcn_s_setprio(0); } while (0)
#define PG8_WAIT_V(n) asm volatile("s_waitcnt vmcnt(" #n ")" ::: "memory")
#define PG8_WAIT_L(n) asm volatile("s_waitcnt lgkmcnt(" #n ")" ::: "memory")
#define PG8_BAR __builtin_amdgcn_s_barrier()
#define PG8_SCHED __builtin_amdgcn_sched_barrier(0)
#define PG8_EXPERT(pm) ((pm) < 256 ? (((pm) >> 1) & 15) : ((pm) - 256))
#define PG8_ABASE(u) ((const char*)g.A + (size_t)(u).pm * tstepA)
#define PG8_BBASE(u) ((const char*)g.Bt + (size_t)PG8_EXPERT((u).pm) * g.estride * ESZ + (size_t)(u).pn * tstepB)
    Unit cur, nxt; int ui = 0;
    if (!S.next(0, cur)) return;
    f32x4 acc[2][2][4][2];
#pragma unroll
    for (int a = 0; a < 2; ++a)
#pragma unroll
        for (int b = 0; b < 2; ++b)
#pragma unroll
            for (int m = 0; m < 4; ++m)
#pragma unroll
                for (int n = 0; n < 2; ++n) acc[a][b][m][n] = (f32x4){0.f, 0.f, 0.f, 0.f};
    bf16x8 At[4][2], B0[2][2], B1[2][2];
    const char* cA = PG8_ABASE(cur); const char* cB = PG8_BBASE(cur);
    PG8_STAGE(PG8_SB(0, 0), cB, voffB); PG8_STAGE(PG8_SB(0, 1), cB + hstepB, voffB); PG8_STAGE(PG8_SA(0, 0), cA, voffA); PG8_STAGE(PG8_SA(0, 1), cA + hstepA, voffA);
    if (wr == 1) PG8_BAR;
    PG8_WAIT_V(2); PG8_BAR;
    PG8_STAGE(PG8_SB(1, 0), cB + kstep, voffB); PG8_STAGE(PG8_SA(1, 0), cA + kstep, voffA); PG8_STAGE(PG8_SB(1, 1), cB + hstepB + kstep, voffB);
    PG8_WAIT_V(6); PG8_BAR;
    for (;;) {
        const bool has_next = S.next(ui + 1, nxt);
        const char* nA = has_next ? PG8_ABASE(nxt) : cA; const char* nB = has_next ? PG8_BBASE(nxt) : cB;
#pragma nounroll
        for (int t = 0; t < nt; t += 2) {
            const bool last = (t == nt - 2);
            const char* a1 = cA + (size_t)(t + 1) * kstep;
            const char* a2 = last ? nA : cA + (size_t)(t + 2) * kstep; const char* b2 = last ? nB : cB + (size_t)(t + 2) * kstep;
            const char* a3 = a2 + kstep; const char* b3 = b2 + kstep;
            PG8_LDB(B0, 0, 0); PG8_LDB(B1, 0, 1); PG8_SCHED; PG8_LDA(At, 0, 0); PG8_STAGE(PG8_SA(1, 1), a1 + hstepA, voffA);
            PG8_WAIT_V(8); PG8_WAIT_L(0); PG8_BAR; PG8_MMA(0, 0, At, B0); PG8_MMA(0, 1, At, B1); PG8_BAR; PG8_SCHED;
            PG8_LDA(At, 0, 1); PG8_STAGE(PG8_SB(0, 0), b2, voffB); PG8_STAGE(PG8_SB(0, 1), b2 + hstepB, voffB); PG8_STAGE(PG8_SA(0, 0), a2, voffA);
            PG8_WAIT_V(8); PG8_WAIT_L(0); PG8_BAR; PG8_MMA(1, 0, At, B0); PG8_MMA(1, 1, At, B1); PG8_BAR; PG8_SCHED;
            PG8_LDB(B0, 1, 0); PG8_LDB(B1, 1, 1); PG8_SCHED; PG8_LDA(At, 1, 0); PG8_STAGE(PG8_SA(0, 1), a2 + hstepA, voffA);
            PG8_WAIT_V(8); PG8_WAIT_L(0); PG8_BAR; PG8_MMA(0, 0, At, B0); PG8_MMA(0, 1, At, B1); PG8_BAR; PG8_SCHED;
            PG8_LDA(At, 1, 1); PG8_STAGE(PG8_SB(1, 0), b3, voffB); PG8_STAGE(PG8_SB(1, 1), b3 + hstepB, voffB); PG8_STAGE(PG8_SA(1, 0), a3, voffA);
            PG8_WAIT_V(8); PG8_WAIT_L(0); PG8_BAR; PG8_MMA(1, 0, At, B0); PG8_MMA(1, 1, At, B1); PG8_BAR; PG8_SCHED;
        }
        if (wr == 0) PG8_BAR;
        E(acc, cur, wr, wc, fr, fq);
        if (!has_next) break;
#pragma unroll
        for (int a = 0; a < 2; ++a)
#pragma unroll
            for (int b = 0; b < 2; ++b)
#pragma unroll
                for (int m = 0; m < 4; ++m)
#pragma unroll
                    for (int n = 0; n < 2; ++n) acc[a][b][m][n] = (f32x4){0.f, 0.f, 0.f, 0.f};
        cur = nxt; cA = nA; cB = nB; ++ui;
        if (wr == 1) PG8_BAR;
    }
    PG8_WAIT_V(0);
    PG8_BAR;
#undef PG8_SA
#undef PG8_SB
#undef PG8_STAGE
#undef PG8_LDA
#undef PG8_LDB
#undef PG8_MMA
#undef PG8_WAIT_V
#undef PG8_WAIT_L
#undef PG8_BAR
#undef PG8_SCHED
}
}

struct Args { const float* in[29]; float* out; unsigned char* ws; };
typedef const __attribute__((address_space(4))) Args* KArgs;
#define KA_FRESH(ka) asm volatile("" : "+s"(ka))
enum { I_X = 0, I_C, I_CTX, I_CCTX, I_N1G, I_N2G, I_WADA, I_BADA, I_WIN, I_NAQG, I_NAKG, I_RPB, I_MQN, I_WUQ, I_MKVN, I_WUKV, I_MQG, I_MKG, I_SWQG, I_SWKG, I_SINK,
       I_WNAO, I_WMLAO, I_WSWAO, I_WO, I_ROUTER, I_WGATE, I_WUP, I_WDOWN };
struct Frame {
    LAS unsigned char* lds;
    int tid, lane, wave, G, vcu, gw, ngw;
};

DI void frame_fresh(Frame& F) { int t = F.tid, w = F.wave, v = F.vcu; asm volatile("" : "+v"(t), "+s"(w), "+s"(v)); F.tid = t; F.lane = t & 63; F.wave = w; F.vcu = v; F.gw = v * 8 + w; }
DI void modv_phase(Frame& F, KArgs ka) {
    KA_FRESH(ka); const __attribute__((address_space(4))) Args& a = *ka; frame_fresh(F);
    LAS float* cact = (LAS float*)F.lds;
    LAS float* red = (LAS float*)(F.lds + 9 * 1024 * 4);
    const float* c = a.in[I_C]; const float* cc = a.in[I_CCTX];
    for (int i = F.tid; i < 9 * 1024; i += 512) { const float v = i < 8192 ? c[i] : cc[i - 8192]; cact[i] = v * sigmoidf_(v); }
    __syncthreads();
    float* modv = (float*)(a.ws + WS_MODV);
    const int cl = F.lane & 31, kp = F.lane >> 5;
    for (int unit = F.vcu; unit < NL * 192; unit += F.G) {
        const int l = unit / 192, n = (unit % 192) * 32 + cl;
        const float* w = a.in[I_WADA] + (size_t)l * 1024 * 6144 + n;
        float acc[9];
#pragma unroll
        for (int i = 0; i < 9; ++i) acc[i] = 0.f;
        const int k0 = F.wave * 128 + kp;
#pragma unroll 16
        for (int k = 0; k < 128; k += 2) { const float wv = __builtin_nontemporal_load(&w[(size_t)(k0 + k) * 6144]);
#pragma unroll
            for (int i = 0; i < 9; ++i) acc[i] += cact[i * 1024 + k0 + k] * wv; }
#pragma unroll
        for (int i = 0; i < 9; ++i) red[((F.wave * 2 + kp) * 9 + i) * 32 + cl] = acc[i];
        __syncthreads();
        for (int t = F.tid; t < 9 * 32; t += 512) { const int i = t >> 5, nn = t & 31; float s = 0.f;
#pragma unroll
            for (int w16 = 0; w16 < 16; ++w16) s += red[(w16 * 9 + i) * 32 + nn];
            const int col = (unit % 192) * 32 + nn;
            modv[((size_t)l * 9 + i) * 6144 + col] = s + a.in[I_BADA][l * 6144 + col]; }
        __syncthreads();
    }
}
DI void copy_phase(Frame& F, KArgs ka) {
    KA_FRESH(ka); const __attribute__((address_space(4))) Args& a = *ka; frame_fresh(F);
    u32x2* xs = (u32x2*)(a.ws + WS_XS);
    const f32x4* x = (const f32x4*)a.in[I_X]; const f32x4* cx = (const f32x4*)a.in[I_CTX];
    const size_t nl = (size_t)MLAT * D / 4, nc = (size_t)MCTX * D / 4;
    for (size_t i = (size_t)blockIdx.x * 512 + F.tid; i < nl + nc; i += (size_t)F.G * 512) { const f32x4 v = i < nl ? x[i] : cx[i - nl]; u32x2 w; w.x = pk2(v.x, v.y); w.y = pk2(v.z, v.w); xs[i] = w; }
}

DI unsigned char* wsel(unsigned char* ws, int l, size_t off) {
    const size_t p = (size_t)(l & 1);
    return ws + (off >= W_DN ? WS_W + off + p * (16 * MiB) : off >= W_GU ? WS_W + off + p * (32 * MiB) : (p ? WS_W2 : WS_W) + off);
}
constexpr int T_IN = 16 * 166, T_UQ = 4 * 24, T_UKV = 2 * 32, T_NAO = 6 * 32, T_MLAO = 8 * 32, T_SWAO = 6 * 32, T_O = 16 * 32, T_E = 16 * 32 * 16;
constexpr int NIT = T_IN + T_UQ + T_UKV + T_NAO + T_MLAO + T_SWAO + T_O + 3 * T_E;
DI void cvt_item(const __attribute__((address_space(4))) Args& a, int l, int r, LAS float* scr, int lane) {
    const float* W; const float* ks = nullptr; int ldw = 1024, kb, nb, ldt = 1024, drow0, dcol0 = 0, fp8 = 1; size_t woff;
    if (r < T_IN) { kb = r / 166; nb = r % 166; W = a.in[I_WIN] + (size_t)l * 1024 * DIN; ldw = DIN;
        if (nb < 70) { fp8 = 0; woff = W_IN; drow0 = 32 * nb; } else { woff = W_GL; drow0 = 32 * nb - 2240; } }
    else if ((r -= T_IN) < T_UQ) { kb = r / 24; nb = r % 24; W = a.in[I_WUQ] + (size_t)l * 256 * 768; ldw = 768; fp8 = 0; woff = W_UP; ldt = 384; drow0 = 32 * nb; ks = a.in[I_MQN] + l * 256; }
    else if ((r -= T_UQ) < T_UKV) { kb = r / 32; nb = r % 32; W = a.in[I_WUKV] + (size_t)l * 128 * 1024; fp8 = 0; woff = W_UP; ldt = 384; drow0 = 768 + 32 * nb; dcol0 = 256; ks = a.in[I_MKVN] + l * 128; }
    else if ((r -= T_UKV) < T_NAO) { kb = r / 32; nb = r % 32; W = a.in[I_WNAO] + (size_t)l * 384 * 1024; woff = W_NAO; ldt = 512; drow0 = 32 * nb; }
    else if ((r -= T_NAO) < T_MLAO) { kb = r / 32; nb = r % 32; W = a.in[I_WMLAO] + (size_t)l * 512 * 1024; woff = W_MLAO; ldt = 512; drow0 = 32 * nb; }
    else if ((r -= T_MLAO) < T_SWAO) { kb = r / 32; nb = r % 32; W = a.in[I_WSWAO] + (size_t)l * 384 * 1024; woff = W_SWAO; ldt = 512; drow0 = 32 * nb; }
    else if ((r -= T_SWAO) < T_O) { kb = r / 32; nb = r % 32; W = a.in[I_WO] + (size_t)l * 1024 * 1024; woff = W_O; drow0 = 32 * nb; }
    else if ((r -= T_O) < 2 * T_E) {
        const int which = r / T_E, rr = r % T_E, e = rr / 512, t = rr % 512; kb = t / 32; nb = t % 32; const int f0 = 32 * nb;
        W = a.in[which ? I_WUP : I_WGATE] + ((size_t)l * 16 + e) * 1024 * 1024; woff = W_GU + (size_t)e * 2048 * 1024; drow0 = 256 * (f0 >> 7) + 128 * which + (f0 & 127); }
    else { r -= 2 * T_E; const int e = r / 512, t = r % 512; kb = t / 32; nb = t % 32;
        W = a.in[I_WDOWN] + ((size_t)l * 16 + e) * 1024 * 1024; woff = W_DN + (size_t)e * 1024 * 1024; drow0 = 32 * nb; }
    const int k0 = 64 * kb, n0 = 32 * nb; dcol0 += k0;
    unsigned char* WT; { const size_t p = (size_t)(l & 1); WT = a.ws + (woff >= W_DN ? WS_W + woff + p * (16 * MiB) : woff >= W_GU ? WS_W + woff + p * (32 * MiB) : (p ? WS_W2 : WS_W) + woff); }
    const float sc = fp8 ? 32.0f : 1.0f;
    const float* Wl = W + (size_t)(k0 + (lane >> 5)) * ldw + n0 + (lane & 31); LAS float* sl = scr + (lane >> 5) * 33 + (lane & 31);
    if (ks) { ks += k0 + (lane >> 5);
#pragma unroll 8
        for (int i = 0; i < 32; ++i) sl[2 * i * 33] = Wl[(size_t)(2 * i) * ldw] * ks[2 * i]; }
    else {
        float wv[32];
#pragma unroll
        for (int i = 0; i < 32; ++i) wv[i] = __builtin_nontemporal_load(&Wl[(size_t)(2 * i) * ldw]);
#pragma unroll
        for (int i = 0; i < 32; ++i) sl[2 * i * 33] = wv[i] * sc; }
    asm volatile("s_waitcnt lgkmcnt(0)" ::: "memory");
    const int c = lane & 7;
    if (fp8) {
#pragma unroll
        for (int j = 0; j < 4; ++j) { const int n = (lane >> 3) + 8 * j; const LAS float* s = scr + (8 * c) * 33 + n;
            u32x2 o; o.x = pk4_fp8(s[0 * 33], s[1 * 33], s[2 * 33], s[3 * 33]); o.y = pk4_fp8(s[4 * 33], s[5 * 33], s[6 * 33], s[7 * 33]);
            *(u32x2*)(WT + (size_t)(drow0 + n) * ldt + dcol0 + 8 * c) = o; }
    } else {
#pragma unroll
        for (int j = 0; j < 4; ++j) { const int n = (lane >> 3) + 8 * j; const LAS float* s = scr + (8 * c) * 33 + n;
            u32x4 o; o.x = pk2(s[0 * 33], s[1 * 33]); o.y = pk2(s[2 * 33], s[3 * 33]); o.z = pk2(s[4 * 33], s[5 * 33]); o.w = pk2(s[6 * 33], s[7 * 33]);
            *(u32x4*)((bf16_t*)WT + (size_t)(drow0 + n) * ldt + dcol0 + 8 * c) = o; }
    }
    asm volatile("s_waitcnt lgkmcnt(0)" ::: "memory");
}
DI void convert_weights(Frame& F, KArgs ka, int l, int begin) {
    KA_FRESH(ka); const __attribute__((address_space(4))) Args& a = *ka; frame_fresh(F);
    LAS float* scr = (LAS float*)(F.lds + F.wave * 16384);
#pragma nounroll
    for (int it = begin + F.gw; it < NIT; it += F.ngw) cvt_item(a, l, it, scr, F.lane);
    unsigned char* wb = a.ws + ((l & 1) ? WS_W2 : WS_W);
    constexpr int Z0 = 64 * 128, Z1 = 768 * 16, Z2 = 1024 * 32, Z3 = 2 * 1024 * 8;
    unsigned zz = 0u; asm volatile("" : "+v"(zz));
    const u32x4 z = {zz, zz, zz, zz};
    for (int i = blockIdx.x * 512 + F.tid; i < Z0 + Z1 + Z2 + Z3; i += F.G * 512) {
        if (i >= Z0 + Z1 + Z2) { const int j = i - Z0 - Z1 - Z2, which = j >> 13, jj = j & 8191; *(u32x4*)(wb + (which ? W_SWAO : W_NAO) + (size_t)(jj >> 3) * 512 + 384 + (jj & 7) * 16) = z; continue; }
        if (i < Z0) *(u32x4*)((bf16_t*)(wb + W_IN) + (size_t)(2240 + i / 128) * 1024 + (i % 128) * 8) = z;
        else if (i < Z0 + Z1) { const int j = i - Z0; *(u32x4*)((bf16_t*)(wb + W_UP) + (size_t)(j / 16) * 384 + 256 + (j % 16) * 8) = z; }
        else { const int j = i - Z0 - Z1; *(u32x4*)((bf16_t*)(wb + W_UP) + (size_t)(768 + j / 32) * 384 + (j % 32) * 8) = z; }
    }
}
DI void convert_tail(Frame& F, KArgs ka, int l, int first, int q) {
    KA_FRESH(ka); const __attribute__((address_space(4))) Args& a = *ka; frame_fresh(F);
    LAS float* scr = (LAS float*)(F.lds + F.wave * 16384);
#pragma nounroll
    for (int j = 0; j < q; ++j) { const int it = first + 8 * j + F.wave; if (it < NIT) cvt_item(a, l, it, scr, F.lane); }
}


DI void row_phase(Frame& F, KArgs ka, int l, int dry = 0) {
    KA_FRESH(ka); const __attribute__((address_space(4))) Args& a = *ka; frame_fresh(F);
    bf16_t* xs = (bf16_t*)(a.ws + WS_XS);
    const float* modv = (const float*)(a.ws + WS_MODV);
    const int* smap = (const int*)(a.ws + WS_SMAP);
    const bf16_t* Y = (const bf16_t*)(a.ws + WS_Y);
    bf16_t* H = (bf16_t*)(a.ws + WS_R4);
    unsigned char* H8 = a.ws + WS_R4 + 68 * MiB;
    bf16_t* xso = xs; float* outo = a.out;
    if (dry) { unsigned char* tr = a.ws + WS_END + (size_t)F.gw * 16384; xso = (bf16_t*)tr; outo = (float*)tr; H = (bf16_t*)(tr + 8192); H8 = tr + 12288; }
    const int nrows = (l == NL) ? MLAT : MT;
    const bool comb = (l > 0);
    constexpr int RR = 4;
    for (int mb = RR * F.gw; mb < nrows; mb += RR * F.ngw) {
        f32x4 v[RR][4]; int myslot[RR];
#pragma unroll
        for (int rr = 0; rr < RR; ++rr) { const int m = mb + rr;
            if (l == 0) {
                if (F.lane < 16 && !dry) *(u32x4*)(a.ws + WS_OCAT + (size_t)m * OCW + ((F.lane >> 3) ? 1408 : 384) + 16 * (F.lane & 7)) = (u32x4){0u, 0u, 0u, 0u};
                const f32x4* xr = (const f32x4*)(m < MLAT ? a.in[I_X] + (size_t)m * D : a.in[I_CTX] + (size_t)(m - MLAT) * D) + F.lane;
                u32x2* xo = (u32x2*)(xs + (size_t)m * D) + F.lane;
#pragma unroll
                for (int j = 0; j < 4; ++j) { const f32x4 t = __builtin_nontemporal_load(&xr[64 * j]); u32x2 w; w.x = pk2(t.x, t.y); w.y = pk2(t.z, t.w); if (!dry) xo[64 * j] = w; v[rr][j] = (f32x4){bflo(w.x), bfhi(w.x), bflo(w.y), bfhi(w.y)}; }
            } else {
                const u32x2* xr = (const u32x2*)(xs + (size_t)m * D) + F.lane;
#pragma unroll
                for (int j = 0; j < 4; ++j) { const u32x2 w = xr[64 * j]; v[rr][j] = (f32x4){bflo(w.x), bfhi(w.x), bflo(w.y), bfhi(w.y)}; }
            }
            myslot[rr] = (comb && F.lane < 16) ? smap[(size_t)F.lane * MT + mb + rr] : -1; }
        const int mi = mod_index(mb);
        if (comb) {
            f32x4 acc[RR][4];
            unsigned long long mk[RR];
#pragma unroll
            for (int rr = 0; rr < RR; ++rr) { mk[rr] = __ballot(myslot[rr] >= 0);
#pragma unroll
                for (int j = 0; j < 4; ++j) acc[rr][j] = (f32x4){0.f, 0.f, 0.f, 0.f}; }
            while ((mk[0] | mk[1]) | (mk[2] | mk[3])) {
                u32x2 w[RR][4];
#pragma unroll
                for (int rr = 0; rr < RR; ++rr) {
                    int s = -1;
                    if (mk[rr]) { const int e0 = __builtin_ctzll(mk[rr]); s = __shfl(myslot[rr], e0); mk[rr] &= mk[rr] - 1; }
#pragma unroll
                    for (int j = 0; j < 4; ++j) w[rr][j] = (u32x2){0u, 0u};
                    if (s >= 0) { const u32x2* yr = (const u32x2*)(Y + (size_t)s * D) + F.lane;
#pragma unroll
                        for (int j = 0; j < 4; ++j) w[rr][j] = __builtin_nontemporal_load(&yr[64 * j]); }
                }
#pragma unroll
                for (int rr = 0; rr < RR; ++rr)
#pragma unroll
                    for (int j = 0; j < 4; ++j) acc[rr][j] += (f32x4){bflo(w[rr][j].x), bfhi(w[rr][j].x), bflo(w[rr][j].y), bfhi(w[rr][j].y)};
            }
            const f32x4* g5 = (const f32x4*)(modv + ((size_t)(l - 1) * 9 + mi) * 6144 + 5 * 1024) + F.lane;
            f32x4 g5v[4];
#pragma unroll
            for (int j = 0; j < 4; ++j) g5v[j] = g5[64 * j];
#pragma unroll
            for (int rr = 0; rr < RR; ++rr) { const int m = mb + rr;
                const size_t ro = dry ? (size_t)rr * 1024 : (size_t)m * D;
#pragma unroll
                for (int j = 0; j < 4; ++j) { v[rr][j] += g5v[j] * acc[rr][j];
                    if (l == NL) ((f32x4*)(outo + ro) + F.lane)[64 * j] = v[rr][j];
                    else { u32x2 w; w.x = pk2(v[rr][j].x, v[rr][j].y); w.y = pk2(v[rr][j].z, v[rr][j].w); ((u32x2*)(xso + ro) + F.lane)[64 * j] = w;
                           v[rr][j] = (f32x4){bflo(w.x), bfhi(w.x), bflo(w.y), bfhi(w.y)}; } } }
        }
        if (l < NL) {
            const f32x4* g = (const f32x4*)(a.in[I_N1G] + l * D) + F.lane;
            const f32x4* sh = (const f32x4*)(modv + ((size_t)l * 9 + mi) * 6144) + F.lane;
            const f32x4* sc = (const f32x4*)(modv + ((size_t)l * 9 + mi) * 6144 + 1024) + F.lane;
            f32x4 gg[4], shv[4];
#pragma unroll
            for (int j = 0; j < 4; ++j) { gg[j] = g[64 * j] * (sc[64 * j] + 1.0f); shv[j] = sh[64 * j]; }
#pragma unroll
            for (int rr = 0; rr < RR; ++rr) { const int m = mb + rr;
                float ss = 0.f;
#pragma unroll
                for (int j = 0; j < 4; ++j) ss += (v[rr][j].x * v[rr][j].x + v[rr][j].y * v[rr][j].y) + (v[rr][j].z * v[rr][j].z + v[rr][j].w * v[rr][j].w);
                const float rstd = __builtin_amdgcn_rsqf(wave_sum(ss) * (1.f / D) + EPS);
                u32x2* o = (u32x2*)(H + (dry ? (size_t)rr * 1024 : (size_t)m * D)) + F.lane;
                unsigned* o8 = (unsigned*)(H8 + (dry ? (size_t)rr * 1024 : (size_t)m * D)) + F.lane;
#pragma unroll
                for (int j = 0; j < 4; ++j) { const f32x4 hh = v[rr][j] * rstd * gg[j] + shv[j]; u32x2 w; w.x = pk2(hh.x, hh.y); w.y = pk2(hh.z, hh.w); o[64 * j] = w;
                    o8[64 * j] = pk4_fp8(hh.x, hh.y, hh.z, hh.w); } }
        }
    }
}

DI void rope_cs(int d, int prow, int pcol, float& cs, float& sn) {
    const int i = d & 15; const float pos = (float)((d & 32) ? pcol : prow);
    const float inv = __builtin_amdgcn_exp2f(-(float)i * (13.287712379549449f / 16.0f));
    const float rev = pos * inv * 0.15915494309189535f;
    const float fr = rev - floorf(rev);
    cs = __builtin_amdgcn_cosf(fr); sn = __builtin_amdgcn_sinf(fr);
}
DI void prep_phase(Frame& F, KArgs ka, int l) {
    KA_FRESH(ka); const __attribute__((address_space(4))) Args& a = *ka; frame_fresh(F);
    const bf16_t* HW = (const bf16_t*)(a.ws + WS_HW);
    bf16_t* P1 = (bf16_t*)(a.ws + WS_P1);
    const float sc64 = 0.125f * LOG2E;
    const int d0 = 8 * (F.lane & 7);
    float gn[3][8]; int srcc[3]; bool ropei[3], acti[3];
    const float* gp0 = a.in[I_NAQG]; const float* gp1 = a.in[I_NAKG]; const float* gp2 = a.in[I_SWQG]; const float* gp3 = a.in[I_SWKG];
#pragma unroll
    for (int i = 0; i < 3; ++i) { const int c = F.lane + 64 * i, col = 8 * c; acti[i] = c < 160;
        const int ty = col < 384 ? 0 : col < 768 ? 1 : col < 1152 ? 2 : 3;
        srcc[i] = col < 768 ? col : col + (C_SWQ - 768);
        ropei[i] = ty >= 2;
        const float sc = (ty == 0 || ty == 2) ? sc64 : 1.0f;
#pragma unroll
        for (int j = 0; j < 8; ++j) { const float g0 = gp0[l * 64 + d0 + j], g1 = gp1[l * 64 + d0 + j], g2 = gp2[l * 64 + d0 + j], g3 = gp3[l * 64 + d0 + j];
            gn[i][j] = acti[i] ? (ty == 0 ? g0 : ty == 1 ? g1 : ty == 2 ? g2 : g3) * sc : 0.f; } }
    float invf[8];
#pragma unroll
    for (int j = 0; j < 8; ++j) invf[j] = __builtin_amdgcn_exp2f(-(float)((d0 & 8) + j) * (13.287712379549449f / 16.0f)) * 0.15915494309189535f;
    const bool second = (d0 & 16) != 0, usecol = (d0 & 32) != 0;
    for (int mb = 2 * F.gw; mb < MT; mb += 2 * F.ngw) {
        u32x4 w[2][3];
#pragma unroll
        for (int rr = 0; rr < 2; ++rr)
#pragma unroll
            for (int i = 0; i < 3; ++i) if (acti[i]) w[rr][i] = *(const u32x4*)(HW + (size_t)(mb + rr) * DINP + srcc[i]); else w[rr][i] = (u32x4){0u, 0u, 0u, 0u};
#pragma unroll
        for (int rr = 0; rr < 2; ++rr) {
            const int m = mb + rr; const bool lat = m < MLAT; const int s = m & 4095; const float prw = (float)(s >> 6), pcl = (float)(s & 63); float pos = usecol ? pcl : prw; asm volatile("" : "+v"(pos));
            float cs[8], sn[8];
#pragma unroll
            for (int j = 0; j < 8; ++j) { cs[j] = 1.f; sn[j] = 0.f; }
            if (lat) {
#pragma unroll
                for (int j = 0; j < 8; ++j) { const float rev = pos * invf[j], fr = rev - floorf(rev); cs[j] = __builtin_amdgcn_cosf(fr); sn[j] = __builtin_amdgcn_sinf(fr); } }
#pragma unroll
            for (int i = 0; i < 3; ++i) {
                float x[8] = {bflo(w[rr][i].x), bfhi(w[rr][i].x), bflo(w[rr][i].y), bfhi(w[rr][i].y), bflo(w[rr][i].z), bfhi(w[rr][i].z), bflo(w[rr][i].w), bfhi(w[rr][i].w)};
                float ss = 0.f;
#pragma unroll
                for (int j = 0; j < 8; ++j) ss += x[j] * x[j];
                ss += __shfl_xor(ss, 1); ss += __shfl_xor(ss, 2); ss += __shfl_xor(ss, 4);
                const float rs = __builtin_amdgcn_rsqf(ss * (1.f / 64.f) + EPS);
#pragma unroll
                for (int j = 0; j < 8; ++j) x[j] *= rs * gn[i][j];
                const bool rp = ropei[i] && lat;
#pragma unroll
                for (int j = 0; j < 8; ++j) { const float y = __int_as_float(__builtin_amdgcn_ds_bpermute((F.lane ^ 2) << 2, __float_as_int(x[j]))); const float rot = second ? x[j] * cs[j] + y * sn[j] : x[j] * cs[j] - y * sn[j]; x[j] = rp ? rot : x[j]; }
                if (acti[i]) { u32x4 o; o.x = pk2(x[0], x[1]); o.y = pk2(x[2], x[3]); o.z = pk2(x[4], x[5]); o.w = pk2(x[6], x[7]);
                    *(u32x4*)(P1 + (size_t)m * P1W + 8 * (F.lane + 64 * i)) = o; }
            }
        }
    }
}
DI void prep2_phase(Frame& F, KArgs ka, int l, int dry = 0) {
    KA_FRESH(ka); const __attribute__((address_space(4))) Args& a = *ka; frame_fresh(F);
    const bf16_t* HW = (const bf16_t*)(a.ws + WS_HW);
    bf16_t* U = (bf16_t*)(a.ws + WS_R4);
    bf16_t* P2 = (bf16_t*)(a.ws + WS_P2);
    const float scq = 0.07216878364870322f * LOG2E;
    const int ln = F.lane, q = ln & 15, h = ln >> 4;
    float qgn[8], qgr[4], kgn[8], kgr[4], invf[4];
    { const float* qg = a.in[I_MQG] + l * 192; const float* kg = a.in[I_MKG] + l * 192;
#pragma unroll
      for (int j = 0; j < 8; ++j) { qgn[j] = qg[8 * q + j] * scq; kgn[j] = kg[8 * q + j]; }
#pragma unroll
      for (int j = 0; j < 4; ++j) { qgr[j] = qg[128 + 4 * q + j] * scq; kgr[j] = kg[128 + 4 * q + j];
          invf[j] = __builtin_amdgcn_exp2f(-(float)(4 * (q & 3) + j) * (13.287712379549449f / 16.0f)) * 0.15915494309189535f; } }
    const bool second = (q & 4) != 0, usecol = (q & 8) != 0;
    const int pl = (ln ^ 4) << 2;
    for (int mb = 2 * F.gw; mb < MT; mb += 2 * F.ngw) {
        u32x2 wcq[2], wqr[2], wkr[2]; unsigned wckv[2]; u32x4 wqn[2], wkn[2], wv[2];
#pragma unroll
        for (int rr = 0; rr < 2; ++rr) { const bf16_t* hr = HW + (size_t)(mb + rr) * DINP; const bf16_t* ur = U + (size_t)(mb + rr) * UW;
            wcq[rr] = *(const u32x2*)(hr + C_CQ + 4 * ln); wckv[rr] = *(const unsigned*)(hr + C_CKV + 2 * ln); wkr[rr] = *(const u32x2*)(hr + C_KR + 4 * q);
            wqn[rr] = *(const u32x4*)(ur + h * 192 + 8 * q); wqr[rr] = *(const u32x2*)(ur + h * 192 + 128 + 4 * q);
            wkn[rr] = *(const u32x4*)(ur + 768 + h * 256 + 8 * q); wv[rr] = *(const u32x4*)(ur + 768 + h * 256 + 128 + 8 * q); }
#pragma unroll
        for (int rr = 0; rr < 2; ++rr) {
            const int m = mb + rr; const bool lat = m < MLAT; const int s = m & 4095;
            bf16_t* ur = U + (size_t)m * UW; bf16_t* pr = P2 + (size_t)m * P2W;
            if (dry) { ur = (bf16_t*)(a.ws + WS_END + (size_t)F.gw * 8192); pr = ur + 2048; }
            float rq, rkv;
            { const float a0 = bflo(wcq[rr].x), a1 = bfhi(wcq[rr].x), a2 = bflo(wcq[rr].y), a3 = bfhi(wcq[rr].y);
              rq = __builtin_amdgcn_rsqf(wave_sum(a0 * a0 + a1 * a1 + a2 * a2 + a3 * a3) * (1.f / 256.f) + EPS); }
            { const float a0 = bflo(wckv[rr]), a1 = bfhi(wckv[rr]);
              rkv = __builtin_amdgcn_rsqf(wave_sum(a0 * a0 + a1 * a1) * (1.f / 128.f) + EPS); }
            float cs[4], sn[4];
            { const float prw = (float)(s >> 6), pcl = (float)(s & 63); float pos = usecol ? pcl : prw; asm volatile("" : "+v"(pos));
#pragma unroll
              for (int j = 0; j < 4; ++j) { const float rev = pos * invf[j], fr = rev - floorf(rev); cs[j] = lat ? __builtin_amdgcn_cosf(fr) : 1.f; sn[j] = lat ? __builtin_amdgcn_sinf(fr) : 0.f; } }
#pragma unroll
            for (int isk = 0; isk < 2; ++isk) {
                const u32x4 wn = isk ? wkn[rr] : wqn[rr]; const u32x2 wr2 = isk ? wkr[rr] : wqr[rr];
                const float sn_ = isk ? rkv : rq, sr_ = isk ? 1.0f : rq;
                float x[8] = {bflo(wn.x) * sn_, bfhi(wn.x) * sn_, bflo(wn.y) * sn_, bfhi(wn.y) * sn_, bflo(wn.z) * sn_, bfhi(wn.z) * sn_, bflo(wn.w) * sn_, bfhi(wn.w) * sn_};
                float y[4] = {bflo(wr2.x) * sr_, bfhi(wr2.x) * sr_, bflo(wr2.y) * sr_, bfhi(wr2.y) * sr_};
                float ss = 0.f;
#pragma unroll
                for (int j = 0; j < 8; ++j) ss += x[j] * x[j];
#pragma unroll
                for (int j = 0; j < 4; ++j) ss += y[j] * y[j];
                ss += __shfl_xor(ss, 1); ss += __shfl_xor(ss, 2); ss += __shfl_xor(ss, 4); ss += __shfl_xor(ss, 8);
                const float rs = __builtin_amdgcn_rsqf(ss * (1.f / 192.f) + EPS);
#pragma unroll
                for (int j = 0; j < 8; ++j) x[j] *= rs * (isk ? kgn[j] : qgn[j]);
#pragma unroll
                for (int j = 0; j < 4; ++j) { y[j] *= rs * (isk ? kgr[j] : qgr[j]);
                    const float p = __int_as_float(__builtin_amdgcn_ds_bpermute(pl, __float_as_int(y[j])));
                    y[j] = second ? y[j] * cs[j] + p * sn[j] : y[j] * cs[j] - p * sn[j]; }
                u32x4 o; o.x = pk2(x[0], x[1]); o.y = pk2(x[2], x[3]); o.z = pk2(x[4], x[5]); o.w = pk2(x[6], x[7]);
                u32x2 o2; o2.x = pk2(y[0], y[1]); o2.y = pk2(y[2], y[3]);
                *(u32x4*)(pr + 768 * isk + h * 192 + 8 * q) = o; *(u32x2*)(pr + 768 * isk + h * 192 + 128 + 4 * q) = o2;
            }
            { const u32x4 vw = wv[rr]; u32x4 o; o.x = pk2(bflo(vw.x) * rkv, bfhi(vw.x) * rkv); o.y = pk2(bflo(vw.y) * rkv, bfhi(vw.y) * rkv); o.z = pk2(bflo(vw.z) * rkv, bfhi(vw.z) * rkv); o.w = pk2(bflo(vw.w) * rkv, bfhi(vw.w) * rkv);
              *(u32x4*)(ur + 768 + h * 256 + 128 + 8 * q) = o; }
        }
    }
}

struct AU {
    const bf16_t *q, *k, *v; unsigned char* o;
    int ldq, ldk, ldv, ldo;
    int qrow0;
    int lat_row0, n_lat, ctx_row0, n_ctx;
    int mode;
    int qpos0, kpos0;
    float m0, l0;
    const float* rpb;
};
#define AT_PIN16(b) asm volatile("" : "+v"(b[0]), "+v"(b[1]), "+v"(b[2]), "+v"(b[3]), "+v"(b[4]), "+v"(b[5]), "+v"(b[6]), "+v"(b[7]), "+v"(b[8]), "+v"(b[9]), "+v"(b[10]), "+v"(b[11]), "+v"(b[12]), "+v"(b[13]), "+v"(b[14]), "+v"(b[15]))
#define AT_PIN4(b, j) asm volatile("" : "+v"(b[j]), "+v"(b[j + 1]), "+v"(b[j + 2]), "+v"(b[j + 3]))
template <int NDT, int VP, int P>
DI void att_tail(f32x16& s0, f32x16& s1, f32x16 (&o)[NDT], float& mrun, float& lrun, const LAS unsigned char* Vt, int vlane_off, const LAS float* bp, int cs, int h) {
    constexpr float MTHR = 11.5f;
#define AT_A0(i) (P != 1 || (i) >= 12)
#define AT_A1(i) (P != 0 || (i) < 4)
    if constexpr (P >= 0) {
        float bb[16];
        if constexpr (P == 0) {
#pragma unroll
            for (int i = 0; i < 16; ++i) bb[i] = bp[(i & 3) + 8 * (i >> 2)];
            AT_PIN16(bb);
#pragma unroll
            for (int i = 0; i < 16; ++i) { const int kc = (i & 3) + 8 * (i >> 2) + 4 * h; const bool ok = (kc >= cs) && (kc < cs + 16); s0[i] = ok ? s0[i] + bb[i] : -INFINITY; }
#pragma unroll
            for (int i = 0; i < 4; ++i) bb[i] = bp[32 + i];
            AT_PIN4(bb, 0);
#pragma unroll
            for (int i = 0; i < 4; ++i) { const int kc = 32 + i + 4 * h; const bool ok = (kc >= cs) && (kc < cs + 16); s1[i] = ok ? s1[i] + bb[i] : -INFINITY; }
        } else {
#pragma unroll
            for (int i = 12; i < 16; ++i) bb[i] = bp[24 + (i & 3)];
            AT_PIN4(bb, 12);
#pragma unroll
            for (int i = 12; i < 16; ++i) { const int kc = 24 + (i & 3) + 4 * h; const bool ok = (kc >= cs) && (kc < cs + 16); s0[i] = ok ? s0[i] + bb[i] : -INFINITY; }
#pragma unroll
            for (int i = 0; i < 16; ++i) bb[i] = bp[32 + (i & 3) + 8 * (i >> 2)];
            AT_PIN16(bb);
#pragma unroll
            for (int i = 0; i < 16; ++i) { const int kc = 32 + (i & 3) + 8 * (i >> 2) + 4 * h; const bool ok = (kc >= cs) && (kc < cs + 16); s1[i] = ok ? s1[i] + bb[i] : -INFINITY; }
        }
    }
    float mx = (P == 1) ? s1[0] : s0[0];
#pragma unroll
    for (int i = 0; i < 16; ++i) { if (AT_A0(i)) mx = fmaxf(mx, s0[i]); if (AT_A1(i)) mx = fmaxf(mx, s1[i]); }
    mx = fmaxf(mx, __shfl_xor(mx, 32));
    if (__builtin_amdgcn_ballot_w64(mx > mrun + MTHR) != 0ull) {
        const float mnew = fmaxf(mrun, mx), alpha = __builtin_amdgcn_exp2f(mrun - mnew);
        lrun *= alpha; mrun = mnew;
#pragma unroll
        for (int dt = 0; dt < NDT; ++dt)
#pragma unroll
            for (int i = 0; i < 16; ++i) o[dt][i] *= alpha;
    }
    float ls = 0.f;
#pragma unroll
    for (int i = 0; i < 16; ++i) {
        if (AT_A0(i)) { s0[i] = __builtin_amdgcn_exp2f(s0[i] - mrun); ls += s0[i]; } else s0[i] = 0.f;
        if (AT_A1(i)) { s1[i] = __builtin_amdgcn_exp2f(s1[i] - mrun); ls += s1[i]; } else s1[i] = 0.f;
    }
    lrun += ls;
    bf16x8 pf[4];
    { u32x4 w;
      w.x = pk2(s0[0], s0[1]); w.y = pk2(s0[2], s0[3]); w.z = pk2(s0[4], s0[5]); w.w = pk2(s0[6], s0[7]); pf[0] = __builtin_bit_cast(bf16x8, w);
      if (P == 1) { w.x = 0u; w.y = 0u; } else { w.x = pk2(s0[8], s0[9]); w.y = pk2(s0[10], s0[11]); } w.z = pk2(s0[12], s0[13]); w.w = pk2(s0[14], s0[15]); pf[1] = __builtin_bit_cast(bf16x8, w);
      w.x = pk2(s1[0], s1[1]); w.y = pk2(s1[2], s1[3]); if (P == 0) { w.z = 0u; w.w = 0u; } else { w.z = pk2(s1[4], s1[5]); w.w = pk2(s1[6], s1[7]); } pf[2] = __builtin_bit_cast(bf16x8, w);
      w.x = pk2(s1[8], s1[9]); w.y = pk2(s1[10], s1[11]); w.z = pk2(s1[12], s1[13]); w.w = pk2(s1[14], s1[15]); pf[3] = __builtin_bit_cast(bf16x8, w); }
    constexpr int KK0 = (P == 1) ? 1 : 0, NKK = (P >= 0) ? 3 : 4, NST = NKK * NDT;
    s16x4 vlo[3], vhi[3];
#define AT_VREAD(i_, b_) do { const LAS unsigned char* vp_ = Vt + (16 * (KK0 + (i_) / NDT)) * VP + vlane_off + 64 * ((i_) % NDT); \
        vlo[b_] = __builtin_amdgcn_ds_read_tr16_b64_v4i16((LAS s16x4*)vp_); vhi[b_] = __builtin_amdgcn_ds_read_tr16_b64_v4i16((LAS s16x4*)(vp_ + 8 * VP)); } while (0)
    AT_VREAD(0, 0); AT_VREAD(1, 1);
#pragma unroll
    for (int i = 0; i < NST; ++i) {
        if (i + 2 < NST) AT_VREAD(i + 2, (i + 2) % 3);
        __builtin_amdgcn_sched_barrier(0);
        const bf16x8 vf = __builtin_shufflevector(vlo[i % 3], vhi[i % 3], 0, 1, 2, 3, 4, 5, 6, 7);
        o[i % NDT] = __builtin_amdgcn_mfma_f32_32x32x16_bf16(vf, pf[KK0 + i / NDT], o[i % NDT], 0, 0, 0);
        __builtin_amdgcn_sched_barrier(0);
    }
#undef AT_VREAD
#undef AT_A0
#undef AT_A1
}
template <int DQ, int DV, int LDK, int LDV>
DI void attn_unit(LAS unsigned char* lds, const AU& u, int tid, int wave, int lane) {
    constexpr int KP = DQ * 2 + 16, VP = DV * 2 + 64, KBY = 64 * KP, VBY = 64 * VP, STG = KBY + VBY;
    constexpr int NKS = DQ / 16, NDT = DV / 32, KCH = DQ / 8, VCH = DV / 8;
    constexpr int KC = KP / 16, VC = VP / 16;
    constexpr int KI = (KC + 7) / 8, VI = (VC + 7) / 8;
    constexpr int BIAS_OFF = 98304;
    static_assert(2 * STG <= BIAS_OFF && KBY % 1024 == 0 && VBY % 1024 == 0, "attention LDS");
    const int r = lane & 31, h = lane >> 5;
    const int nt = u.n_lat + u.n_ctx;
    LAS float* btab = (LAS float*)(lds + BIAS_OFF);
    if (u.mode == 2) { for (int i = tid; i < 15 * 31; i += 512) btab[i] = u.rpb[i] * LOG2E; }
    bf16x8 qf[NKS];
    { const bf16_t* qp = u.q + (size_t)(u.qrow0 + wave * 32 + r) * u.ldq + 8 * h;
#pragma unroll
      for (int ks = 0; ks < NKS; ++ks) qf[ks] = *(const bf16x8*)(qp + 16 * ks); }
    f32x16 o[NDT];
#pragma unroll
    for (int dt = 0; dt < NDT; ++dt)
#pragma unroll
        for (int i = 0; i < 16; ++i) o[dt][i] = 0.f;
    float mrun = u.m0, lrun = (h == 0) ? u.l0 : 0.f;
    unsigned koff[KI], voff[VI];
#pragma unroll
    for (int i = 0; i < KI; ++i) { const int c = 64 * (wave + 8 * i) + lane, row = c / KC, cc = c % KC; koff[i] = (unsigned)(row * LDK * 2 + (cc < KCH ? cc : KCH - 1) * 16); }
#pragma unroll
    for (int i = 0; i < VI; ++i) { const int c = 64 * (wave + 8 * i) + lane, row = c / VC, cc = c % VC; voff[i] = (unsigned)(row * LDV * 2 + (cc < VCH ? cc : VCH - 1) * 16); }
#define AT_ROWBASE(t) ((t) < u.n_lat ? u.lat_row0 + 64 * (t) : u.ctx_row0 + 64 * ((t) - u.n_lat))
#define AT_ISSUE(t, buf) do { const int rb_ = AT_ROWBASE(t); const char* kb_ = (const char*)(u.k + (size_t)rb_ * LDK); const char* vb_ = (const char*)(u.v + (size_t)rb_ * LDV); \
        _Pragma("unroll") for (int i_ = 0; i_ < KI; ++i_) { const int j_ = wave + 8 * i_; if (j_ < KC) __builtin_amdgcn_global_load_lds((const unsigned*)(kb_ + koff[i_]), (LAS unsigned*)(lds + (buf) * STG + j_ * 1024), 16, 0, 0); } \
        _Pragma("unroll") for (int i_ = 0; i_ < VI; ++i_) { const int j_ = wave + 8 * i_; if (j_ < VC) __builtin_amdgcn_global_load_lds((const unsigned*)(vb_ + voff[i_]), (LAS unsigned*)(lds + (buf) * STG + KBY + j_ * 1024), 16, 0, 0); } } while (0)
    AT_ISSUE(0, 0);
    asm volatile("s_waitcnt vmcnt(0)" ::: "memory");
    __syncthreads();
    const int tq = (lane & 15) >> 2, tp = lane & 3, tblk = (lane >> 4) & 1;
    const int vlane_off = (4 * h + tq) * VP + 32 * tblk + 8 * tp;
    for (int t = 0; t < nt; ++t) {
        const int buf = t & 1;
        if (t + 1 < nt) AT_ISSUE(t + 1, buf ^ 1);
        bool skip = false; int a0 = 0, a1 = 0;
        bool inband = false;
        if (u.mode == 1 && t < u.n_lat) { const int k0 = u.kpos0 + 64 * t, q0 = u.qpos0 + 32 * wave; skip = (k0 > q0 + 31 + 128) || (k0 + 63 < q0 - 128); a0 = k0; a1 = q0; inband = (k0 >= q0 + 31 - 128) && (k0 + 63 <= q0 + 128); }
        if (u.mode == 2 && t < u.n_lat) { const int kr = u.kpos0 + t, qr = u.qpos0 + (wave >> 1); int rs = qr - 4; rs = rs < 0 ? 0 : (rs > 56 ? 56 : rs); skip = (kr < rs) || (kr >= rs + 8); a0 = kr - qr + 7; }
        if (!skip) {
            const LAS unsigned char* Kt = lds + buf * STG; const LAS unsigned char* Vt = Kt + KBY;
            f32x16 s0, s1;
#pragma unroll
            for (int i = 0; i < 16; ++i) { s0[i] = 0.f; s1[i] = 0.f; }
            bf16x8 kfa[3], kfb[3];
#define AT_KREAD(ks_, b_) do { kfa[b_] = *(const LAS bf16x8*)(Kt + r * KP + (16 * (ks_) + 8 * h) * 2); kfb[b_] = *(const LAS bf16x8*)(Kt + (32 + r) * KP + (16 * (ks_) + 8 * h) * 2); } while (0)
            AT_KREAD(0, 0); AT_KREAD(1, 1);
#pragma unroll
            for (int ks = 0; ks < NKS; ++ks) {
                if (ks + 2 < NKS) AT_KREAD(ks + 2, (ks + 2) % 3);
                __builtin_amdgcn_sched_barrier(0);
                s0 = __builtin_amdgcn_mfma_f32_32x32x16_bf16(kfa[ks % 3], qf[ks], s0, 0, 0, 0);
                s1 = __builtin_amdgcn_mfma_f32_32x32x16_bf16(kfb[ks % 3], qf[ks], s1, 0, 0, 0);
                __builtin_amdgcn_sched_barrier(0);
            }
#undef AT_KREAD
            if (u.mode == 1 && t < u.n_lat && !inband) {
                const int qpos = a1 + r;
#pragma unroll
                for (int i = 0; i < 16; ++i) { const int kk = a0 + (i & 3) + 8 * (i >> 2) + 4 * h; int d0 = qpos - kk; d0 = d0 < 0 ? -d0 : d0; int d1 = qpos - (kk + 32); d1 = d1 < 0 ? -d1 : d1;
                    s0[i] = d0 <= 128 ? s0[i] : -INFINITY; s1[i] = d1 <= 128 ? s1[i] : -INFINITY; }
            }
            if (DQ == 64 && u.mode == 2 && t < u.n_lat) {
                const int qc = 32 * (wave & 1) + r; int cs = qc - 8; cs = cs < 0 ? 0 : (cs > 48 ? 48 : cs);
                const LAS float* bp = btab + (a0 * 31 + 15 - qc + 4 * h);
                if ((wave & 1) == 0) att_tail<NDT, VP, (DQ == 64 ? 0 : -1)>(s0, s1, o, mrun, lrun, Vt, vlane_off, bp, cs, h);
                else att_tail<NDT, VP, (DQ == 64 ? 1 : -1)>(s0, s1, o, mrun, lrun, Vt, vlane_off, bp, cs, h);
            } else att_tail<NDT, VP, -1>(s0, s1, o, mrun, lrun, Vt, vlane_off, nullptr, 0, h);
        }
        asm volatile("s_waitcnt vmcnt(0)" ::: "memory");
        __syncthreads();
    }
    const float ltot = lrun + __shfl_xor(lrun, 32), inv = 1.0f / ltot;
    unsigned char* op = u.o + (size_t)(u.qrow0 + wave * 32 + r) * u.ldo + 4 * h;
    const float inv4 = inv * 4.0f;
#pragma unroll
    for (int dt = 0; dt < NDT; ++dt)
#pragma unroll
        for (int g = 0; g < 4; ++g) *(unsigned*)(op + 32 * dt + 8 * g) = pk4_fp8(o[dt][4 * g] * inv4, o[dt][4 * g + 1] * inv4, o[dt][4 * g + 2] * inv4, o[dt][4 * g + 3] * inv4);
#undef AT_ROWBASE
#undef AT_ISSUE
}

DI void attn_phase(Frame& F, KArgs ka, int l) {
    KA_FRESH(ka); const __attribute__((address_space(4))) Args& a = *ka; frame_fresh(F);
    const bf16_t* HW = (const bf16_t*)(a.ws + WS_HW);
    const bf16_t* P1 = (const bf16_t*)(a.ws + WS_P1);
    const bf16_t* P2 = (const bf16_t*)(a.ws + WS_P2);
    const bf16_t* U = (const bf16_t*)(a.ws + WS_R4);
    unsigned char* OC = a.ws + WS_OCAT;
    const bool last = (l == NL - 1);
    constexpr int nA = 512, nB = 768, nC = 768;
    const int ntot = nA + nB + nC + (last ? 0 : 128);
#ifndef ATT_PROBE
#define ATT_PROBE 0
#endif
    for (int rep2_ = 0; rep2_ < 1 + (ATT_PROBE != 0); ++rep2_)
    for (int id = F.vcu; id < ntot; id += F.G) {
        if (rep2_ == 1 && !((ATT_PROBE == 1) ? (id < nA) : (id >= nA && id < nA + nB))) continue;
        AU u; bool big = false;
        u.mode = 0; u.qpos0 = 0; u.kpos0 = 0; u.m0 = -1e30f; u.l0 = 0.f; u.rpb = nullptr; u.n_ctx = 4;
        if (id < nA) {
            const int b = id >> 6, h = (id >> 4) & 3, qb = id & 15; big = true;
            u.q = P2 + h * 192; u.ldq = P2W; u.k = P2 + 768 + h * 192; u.ldk = P2W; u.v = U + 768 + h * 256 + 128; u.ldv = UW; u.o = OC + 512 + h * 128; u.ldo = OCW;
            u.qrow0 = b * SEQ + qb * 256; u.lat_row0 = b * SEQ; u.n_lat = 64; u.ctx_row0 = MLAT + b * CTX;
        } else if (id < nA + nB) {
            const int j = id - nA, b = j / 96, h = (j >> 4) % 6, qb = j & 15;
            u.q = P1 + h * 64; u.ldq = P1W; u.k = P1 + 384 + h * 64; u.ldk = P1W; u.v = HW + C_NAV + h * 64; u.ldv = DINP; u.o = OC + h * 64; u.ldo = OCW;
            int rlo = 4 * qb - 4; rlo = rlo < 0 ? 0 : (rlo > 56 ? 56 : rlo); int rhi = 4 * qb + 3 - 4; rhi = (rhi < 0 ? 0 : (rhi > 56 ? 56 : rhi)) + 7;
            u.qrow0 = b * SEQ + qb * 256; u.lat_row0 = b * SEQ + rlo * 64; u.n_lat = rhi - rlo + 1; u.ctx_row0 = MLAT + b * CTX;
            u.mode = 2; u.qpos0 = 4 * qb; u.kpos0 = rlo; u.rpb = a.in[I_RPB] + (size_t)(l * 6 + h) * 465;
        } else if (id < nA + nB + nC) {
            const int j = id - nA - nB, b = j / 96, hq = (j >> 4) % 6, qb = j & 15, kvh = hq / 3;
            u.q = P1 + 768 + hq * 64; u.ldq = P1W; u.k = P1 + 1152 + kvh * 64; u.ldk = P1W; u.v = HW + C_SWV + kvh * 64; u.ldv = DINP; u.o = OC + 1024 + hq * 64; u.ldo = OCW;
            int klo = qb * 256 - 128; klo = klo < 0 ? 0 : klo; int khi = qb * 256 + 384; khi = khi > SEQ ? SEQ : khi;
            u.qrow0 = b * SEQ + qb * 256; u.lat_row0 = b * SEQ + klo; u.n_lat = (khi - klo) >> 6; u.ctx_row0 = MLAT + b * CTX;
            u.mode = 1; u.qpos0 = qb * 256; u.kpos0 = klo; u.m0 = a.in[I_SINK][l * 6 + hq] * LOG2E; u.l0 = 1.f;
        } else {
            const int j = id - nA - nB - nC;
            u.n_lat = 0; u.lat_row0 = 0;
            if (j < 32) { const int b = j >> 2, h = j & 3; big = true;
                u.q = P2 + h * 192; u.ldq = P2W; u.k = P2 + 768 + h * 192; u.ldk = P2W; u.v = U + 768 + h * 256 + 128; u.ldv = UW; u.o = OC + 512 + h * 128; u.ldo = OCW;
                u.qrow0 = MLAT + b * CTX; u.ctx_row0 = MLAT + b * CTX;
            } else if (j < 80) { const int jj = j - 32, b = jj / 6, h = jj % 6;
                u.q = P1 + h * 64; u.ldq = P1W; u.k = P1 + 384 + h * 64; u.ldk = P1W; u.v = HW + C_NAV + h * 64; u.ldv = DINP; u.o = OC + h * 64; u.ldo = OCW;
                u.qrow0 = MLAT + b * CTX; u.ctx_row0 = MLAT + b * CTX;
            } else { const int jj = j - 80, b = jj / 6, hq = jj % 6, kvh = hq / 3;
                u.q = P1 + 768 + hq * 64; u.ldq = P1W; u.k = P1 + 1152 + kvh * 64; u.ldk = P1W; u.v = HW + C_SWV + kvh * 64; u.ldv = DINP; u.o = OC + 1024 + hq * 64; u.ldo = OCW;
                u.qrow0 = MLAT + b * CTX; u.ctx_row0 = MLAT + b * CTX; u.m0 = a.in[I_SINK][l * 6 + hq] * LOG2E; u.l0 = 1.f;
            }
        }
        if (big) attn_unit<192, 128, P2W, UW>(F.lds, u, F.tid, F.wave, F.lane);
        else attn_unit<64, 64, P1W, DINP>(F.lds, u, F.tid, F.wave, F.lane);
    }
}

DI void norm2_phase(Frame& F, KArgs ka, int l, int nrows) {
    KA_FRESH(ka); const __attribute__((address_space(4))) Args& a = *ka; frame_fresh(F);
    LAS float* rt = (LAS float*)F.lds;
    const float* rg = a.in[I_ROUTER] + (size_t)l * 1024 * 16;
    for (int i = F.tid; i < 16384; i += 512) { const int k = i >> 4, e = i & 15; rt[(k >> 2) * 64 + e * 4 + (k & 3)] = rg[i]; }
    LAS float* xr = (LAS float*)(F.lds + 65536);
    LAS float* part = (LAS float*)(F.lds + LDSCTL_OFF + 4096);
    __syncthreads();
    const bf16_t* xs = (const bf16_t*)(a.ws + WS_XS);
    const float* modv = (const float*)(a.ws + WS_MODV);
    unsigned char* H2 = a.ws + WS_H2;
    float* AFL = (float*)(a.ws + WS_AFL); float* AFC = (float*)(a.ws + WS_AFC);
    const int nblk = nrows >> 4, fm = F.lane & 15, fk = F.lane >> 4;
    u32x2 xw[2][4];
#define N2_LOAD(mb_) do { _Pragma("unroll") for (int rr_ = 0; rr_ < 2; ++rr_) { const u32x2* xp_ = (const u32x2*)(xs + (size_t)((mb_) + rr_) * D) + F.lane; \
        _Pragma("unroll") for (int j_ = 0; j_ < 4; ++j_) xw[rr_][j_] = xp_[64 * j_]; } } while (0)
    const int b0 = (int)(((long)nblk * F.vcu) / F.G), b1 = (int)(((long)nblk * (F.vcu + 1)) / F.G);
    int mi_cur = -1; f32x4 gg[4], shv[4];
#pragma unroll
    for (int j = 0; j < 4; ++j) { gg[j] = (f32x4){0.f, 0.f, 0.f, 0.f}; shv[j] = (f32x4){0.f, 0.f, 0.f, 0.f}; }
    if (b0 < b1) N2_LOAD(16 * b0 + 2 * F.wave);
    for (int blk = b0; blk < b1; ++blk) {
        const int mb = 16 * blk + 2 * F.wave;
        const int mi = mod_index(mb);
        f32x4 v[2][4];
#pragma unroll
        for (int rr = 0; rr < 2; ++rr)
#pragma unroll
            for (int j = 0; j < 4; ++j) { const u32x2 w = xw[rr][j]; v[rr][j] = (f32x4){bflo(w.x), bfhi(w.x), bflo(w.y), bfhi(w.y)}; }
        if (blk + 1 < b1) N2_LOAD(16 * (blk + 1) + 2 * F.wave);
        if (mi != mi_cur) { mi_cur = mi;
            const f32x4* g = (const f32x4*)(a.in[I_N2G] + l * D) + F.lane;
            const f32x4* sh = (const f32x4*)(modv + ((size_t)l * 9 + mi) * 6144 + 3 * 1024) + F.lane;
            const f32x4* sc = (const f32x4*)(modv + ((size_t)l * 9 + mi) * 6144 + 4 * 1024) + F.lane;
#pragma unroll
            for (int j = 0; j < 4; ++j) { gg[j] = g[64 * j] * (sc[64 * j] + 1.0f); shv[j] = sh[64 * j]; } }
#pragma unroll
        for (int rr = 0; rr < 2; ++rr) {
            float ss = 0.f;
#pragma unroll
            for (int j = 0; j < 4; ++j) ss += (v[rr][j].x * v[rr][j].x + v[rr][j].y * v[rr][j].y) + (v[rr][j].z * v[rr][j].z + v[rr][j].w * v[rr][j].w);
            const float rstd = __builtin_amdgcn_rsqf(wave_sum(ss) * (1.f / D) + EPS);
            unsigned* o = (unsigned*)(H2 + (size_t)(mb + rr) * D) + F.lane;
            const int m = 2 * F.wave + rr;
#pragma unroll
            for (int j = 0; j < 4; ++j) { const f32x4 hh = v[rr][j] * rstd * gg[j] + shv[j]; o[64 * j] = pk4_fp8(hh.x, hh.y, hh.z, hh.w);
                *(LAS f32x4*)(xr + m * 1024 + (((F.lane + 64 * j) ^ m) << 2)) = hh; }
        }
        __syncthreads();
        f32x4 acc = {0.f, 0.f, 0.f, 0.f};
        f32x4 av[8], bv[8];
#pragma unroll
        for (int j = 0; j < 8; ++j) { const int c = 32 * F.wave + 4 * j + fk;
            av[j] = *(const LAS f32x4*)(xr + fm * 1024 + ((c ^ fm) << 2));
            bv[j] = *(const LAS f32x4*)(rt + c * 64 + fm * 4); }
        __builtin_amdgcn_sched_barrier(0);
#pragma unroll
        for (int j = 0; j < 8; ++j)
#pragma unroll
            for (int i = 0; i < 4; ++i) acc = __builtin_amdgcn_mfma_f32_16x16x4f32(av[j][i], bv[j][i], acc, 0, 0, 0);
        *(LAS f32x4*)(part + (F.wave * 64 + F.lane) * 4) = acc;
        __syncthreads();
        if (F.lane < 32) {
            const int rr = F.lane >> 4, e = F.lane & 15, row = 2 * F.wave + rr, m = mb + rr;
            float lg = 0.f;
#pragma unroll
            for (int w8 = 0; w8 < 8; ++w8) lg += part[(w8 * 64 + 16 * (row >> 2) + e) * 4 + (row & 3)];
            float mx = lg; mx = fmaxf(mx, __shfl_xor(mx, 1)); mx = fmaxf(mx, __shfl_xor(mx, 2)); mx = fmaxf(mx, __shfl_xor(mx, 4)); mx = fmaxf(mx, __shfl_xor(mx, 8));
            const float ex = __expf(lg - mx);
            float sum = ex; sum += __shfl_xor(sum, 1); sum += __shfl_xor(sum, 2); sum += __shfl_xor(sum, 4); sum += __shfl_xor(sum, 8);
            const float p = ex * (1.0f / sum);
            if (m < MLAT) { const int b = m >> 12, s = m & 4095; AFL[((size_t)(b * 16 + e)) * 4096 + s] = p; }
            else { const int b = (m - MLAT) >> 8, s = (m - MLAT) & 255; AFC[((size_t)(b * 16 + e)) * 256 + s] = p; }
        }
    }
#undef N2_LOAD
}

DI unsigned block_excl_scan(unsigned v, unsigned& total, LAS unsigned* wsum, int tid, int lane, int wave) {
    unsigned x = v;
#pragma unroll
    for (int o = 1; o < 64; o <<= 1) { const unsigned y = __shfl_up(x, o); if (lane >= o) x += y; }
    if (lane == 63) wsum[wave] = x;
    __syncthreads();
    unsigned base = 0, tot = 0;
#pragma unroll
    for (int w = 0; w < 8; ++w) { const unsigned s = wsum[w]; if (w < wave) base += s; tot += s; }
    __syncthreads();
    total = tot;
    return base + x - v;
}
DI void select_phase(Frame& F, KArgs ka, int l) {
    KA_FRESH(ka); const __attribute__((address_space(4))) Args& a = *ka; frame_fresh(F);
    const bool last = (l == NL - 1);
    const int nunits = last ? 128 : 256;
    LAS unsigned* hist = (LAS unsigned*)F.lds;
    LAS unsigned* wsum = (LAS unsigned*)(F.lds + 8192);
    LAS unsigned* bc = (LAS unsigned*)(F.lds + 8192 + 64);
    LAS int* sel = (LAS int*)(F.lds + 16384);
    const float* AFL = (const float*)(a.ws + WS_AFL); const float* AFC = (const float*)(a.ws + WS_AFC);
    int* smap = (int*)(a.ws + WS_SMAP); float* gate = (float*)(a.ws + WS_GATE);
    const unsigned char* H2 = a.ws + WS_H2; unsigned char* XG = a.ws + WS_XG;
    for (int unit = blockIdx.x; unit < nunits; unit += F.G) {
        const bool lat = unit < 128; const int be = unit & 127, b = be >> 4, e = be & 15;
        const int N = lat ? 4096 : 256, cap = lat ? CAP_LAT : CAP_CTX;
        const float* aff = lat ? AFL + (size_t)be * 4096 : AFC + (size_t)be * 256;
        unsigned key[8]; const int per = lat ? 8 : 1; const bool act = lat || F.tid < 256;
#pragma unroll
        for (int j = 0; j < 8; ++j) key[j] = (act && j < per) ? __float_as_uint(aff[F.tid * per + j]) : 0u;
        unsigned prefix = 0u, pmask = 0u, need = (unsigned)cap;
#pragma unroll
        for (int pass = 0; pass < 3; ++pass) {
            const int shift = pass == 0 ? 21 : (pass == 1 ? 10 : 0), nb = pass == 2 ? 1024 : 2048;
            for (int i = F.tid; i < 2048; i += 512) hist[i] = 0u;
            __syncthreads();
#pragma unroll
            for (int j = 0; j < 8; ++j) if (act && j < per && (key[j] & pmask) == prefix) (void)__hip_atomic_fetch_add(&hist[(key[j] >> shift) & (nb - 1)], 1u, __ATOMIC_RELAXED, __HIP_MEMORY_SCOPE_WORKGROUP);
            __syncthreads();
            unsigned c4[4], mine = 0;
#pragma unroll
            for (int j = 0; j < 4; ++j) { const int bin = 2047 - 4 * F.tid - j; c4[j] = bin < nb ? hist[bin] : 0u; mine += c4[j]; }
            unsigned tot; unsigned run = block_excl_scan(mine, tot, wsum, F.tid, F.lane, F.wave);
#pragma unroll
            for (int j = 0; j < 4; ++j) { const int bin = 2047 - 4 * F.tid - j;
                if (bin < nb && run < need && run + c4[j] >= need) { bc[0] = (unsigned)bin; bc[1] = run; }
                run += c4[j]; }
            __syncthreads();
            const unsigned cb = bc[0], above = bc[1];
            prefix |= cb << shift; pmask |= (unsigned)(nb - 1) << shift; need -= above;
            __syncthreads();
        }
        unsigned neq = 0, ngt = 0;
#pragma unroll
        for (int j = 0; j < 8; ++j) if (act && j < per) { neq += key[j] == prefix; ngt += key[j] > prefix; }
        unsigned teq; const unsigned eqbase = block_excl_scan(neq, teq, wsum, F.tid, F.lane, F.wave);
        unsigned nsel = 0, flags = 0, erun = eqbase;
#pragma unroll
        for (int j = 0; j < 8; ++j) if (act && j < per) { bool s = key[j] > prefix; if (key[j] == prefix) { s = erun < need; ++erun; } if (s) { flags |= 1u << j; ++nsel; } }
        unsigned tsel; unsigned sbase = block_excl_scan(nsel, tsel, wsum, F.tid, F.lane, F.wave);
        const int rowbase = lat ? b * SEQ : MLAT + b * CTX;
        const int slotbase = lat ? be * CAP_LAT : NSLOT_LAT + (e * 8 + b) * CAP_CTX;
#pragma unroll
        for (int j = 0; j < 8; ++j) if (act && j < per) { const int tok = F.tid * per + j; int slot = -1;
            if ((flags >> j) & 1u) { slot = slotbase + (int)sbase; sel[sbase] = tok; gate[slot] = __uint_as_float(key[j]); ++sbase; }
            smap[(size_t)e * MT + rowbase + tok] = slot; }
        __syncthreads();
        if (lat) {
            for (int t0 = F.wave * 16; t0 < cap; t0 += 128) {
                u32x4 rowv[16];
#pragma unroll
                for (int q = 0; q < 16; ++q) rowv[q] = ((const u32x4*)(H2 + (size_t)(rowbase + sel[t0 + q]) * D))[F.lane];
#pragma unroll
                for (int q = 0; q < 16; ++q) ((u32x4*)(XG + (size_t)(slotbase + t0 + q) * D))[F.lane] = rowv[q];
            }
        } else {
            const int t0 = F.wave * 4;
            u32x4 rowv[4];
#pragma unroll
            for (int q = 0; q < 4; ++q) rowv[q] = ((const u32x4*)(H2 + (size_t)(rowbase + sel[t0 + q]) * D))[F.lane];
#pragma unroll
            for (int q = 0; q < 4; ++q) ((u32x4*)(XG + (size_t)(slotbase + t0 + q) * D))[F.lane] = rowv[q];
        }
        __syncthreads();
    }
}

#ifndef Q_INA
#define Q_INA 3
#endif
#ifndef Q_INB
#define Q_INB 6
#endif
#ifndef Q_INC
#define Q_INC 9
#endif
#ifndef Q_MRG
#define Q_MRG 9
#endif
#ifndef Q_WO
#define Q_WO 2
#endif
#ifndef Q_GU
#define Q_GU 3
#endif
#ifndef Q_DN
#define Q_DN 3
#endif
#define TAIL1(nwg_, Q_) do { const int r_ = (nwg_) % F.G; if (!last && r_ != 0) { if (bx >= r_) convert_tail(F, ka, l + 1, cur + 8 * (Q_) * (bx - r_), (Q_)); cur += 8 * (Q_) * (F.G - r_); } } while (0)
DI unsigned char* ws_fresh(KArgs ka) { KA_FRESH(ka); return ka->ws; }
__global__ void __launch_bounds__(512, 2) mega_fwd(Args a_unused) {
    extern __shared__ __attribute__((aligned(16))) unsigned char lds_raw[];
    KArgs ka = (KArgs)__builtin_amdgcn_kernarg_segment_ptr();
    Frame F;
    F.lds = (LAS unsigned char*)lds_raw;
    F.tid = threadIdx.x; F.lane = F.tid & 63; F.wave = __builtin_amdgcn_readfirstlane(F.tid >> 6);
    F.G = gridDim.x; { const int bx = blockIdx.x; F.vcu = (F.G % 8 == 0) ? (bx % 8) * (F.G / 8) + bx / 8 : bx; }
    F.gw = F.vcu * 8 + F.wave; F.ngw = F.G * 8;
    for (int u = F.tid; u < (LDS_BYTES - LDSCTL_OFF) / 4; u += 512) ((LAS unsigned*)(F.lds + LDSCTL_OFF))[u] = 0u;
    __syncthreads();
    XcdBarrier bar = xcd_barrier_post((unsigned*)(ws_fresh(ka) + WS_CTL) + CW_BAR, (volatile LAS unsigned*)(F.lds + LDSCTL_OFF + 32));
#define GRID_BAR() xcd_barrier(bar)
    const int bx = blockIdx.x;

    if (PH(0)) modv_phase(F, ka);
    for (int rep_ = 0; rep_ < REPS(2); ++rep_) if (PH(2)) convert_weights(F, ka, 0, 0);
    GRID_BAR();
    if (PH(3)) row_phase(F, ka, 0);
    GRID_BAR();

    for (int l = 0; l < NL; ++l) {
        const bool last = (l == NL - 1);
        const int nMe = last ? MLAT / 256 : MT / 256;
        const int nMs = last ? NSLOT_LAT / 256 : NSLOT / 256;
        int cur = 0;
        if (PH(4)) { unsigned char* ws = ws_fresh(ka);
            for (int rep_ = 0; rep_ < REPS(4); ++rep_) { pg8::Gemm g{(const bf16_t*)(ws + WS_R4), (const bf16_t*)wsel(ws, l, W_IN), 1024, 1024, 1024, 0}; pg8::Order S; S.init(MT / 256, DINP / 256, F.G, bx);
              pg8::EpiStoreBf16 E{(bf16_t*)(ws + WS_HW), DINP}; pg8::gemm_phase(F.lds, g, S, E); }
            for (int rep_ = 0; rep_ < REPS(17); ++rep_) { pg8::Gemm g{(const bf16_t*)(ws + WS_R4 + 68 * MiB), (const bf16_t*)wsel(ws, l, W_GL), 1024, 1024, 1024, 0}; pg8::Order S; S.init(MT / 256, NGL / 256, F.G, (bx + F.G / 2) % F.G);
              pg8::EpiGate E{ws + WS_G}; pg8::gemm_phase<pg8::EpiGate, true>(F.lds, g, S, E); } }
        if (!last && F.G == 256) {
            int q = 0, off = 0;
            if (bx < 128) { q = Q_INA; off = bx * Q_INA; } else if (bx >= 224) { q = Q_INC; off = 128 * Q_INA + 24 * Q_INB + (bx - 224) * Q_INC; } else if (bx >= 200) { q = Q_INB; off = 128 * Q_INA + (bx - 200) * Q_INB; }
            if (q) convert_tail(F, ka, l + 1, cur + 8 * off, q);
            cur += 8 * (128 * Q_INA + 24 * Q_INB + 32 * Q_INC); }
        GRID_BAR();
        for (int rep_ = 0; rep_ < REPS(5); ++rep_) if (PH(5)) { unsigned char* ws = ws_fresh(ka); pg8::Gemm g{(const bf16_t*)(ws + WS_HW) + C_CQ, (const bf16_t*)wsel(ws, l, W_UP), 384, DINP, 384, 0}; pg8::Order S; S.init(MT / 256, UW / 256, F.G, bx);
            pg8::EpiStoreBf16 E{(bf16_t*)(ws + WS_R4), UW}; pg8::gemm_phase(F.lds, g, S, E); }
        for (int rep_ = 0; rep_ < REPS(6); ++rep_) if (PH(6)) prep_phase(F, ka, l);
        GRID_BAR();
        for (int rep_ = 0; rep_ < REPS(7); ++rep_) if (PH(7)) prep2_phase(F, ka, l, rep_);
        GRID_BAR();
        for (int rep_ = 0; rep_ < REPS(8); ++rep_) if (PH(8)) attn_phase(F, ka, l);
        GRID_BAR();
        for (int rep_ = 0; rep_ < REPS(9); ++rep_) if (PH(9)) { unsigned char* ws = ws_fresh(ka); pg8::Order S; S.init(nMe, 4, F.G, bx);
          const unsigned char* OC = ws + WS_OCAT; bf16_t* MG = (bf16_t*)(ws + WS_MERGED); const unsigned char* GL = ws + WS_G;
          { pg8::Gemm3 g{OC, OC + 512, OC + 1024, wsel(ws, l, W_NAO), wsel(ws, l, W_MLAO), wsel(ws, l, W_SWAO), OCW, 512}; pg8::EpiMerge3 E{MG, GL}; pg8::gemm_phase3(F.lds, g, S, E); } }
        TAIL1(nMe * 4, Q_MRG);
        GRID_BAR();
        if (PH(10)) { unsigned char* ws = ws_fresh(ka); pg8::Gemm g{(const bf16_t*)(ws + WS_MERGED), (const bf16_t*)wsel(ws, l, W_O), 1024, 1024, 1024, 0}; pg8::Order S; S.init(nMe, 4, F.G, bx);
            pg8::EpiResid E{(bf16_t*)(ws + WS_XS), (const float*)(ws + WS_MODV) + (size_t)l * 9 * 6144 + 2 * 1024}; pg8::gemm_phase<pg8::EpiResid, true>(F.lds, g, S, E); }
        TAIL1(nMe * 4, Q_WO);
        GRID_BAR();
        for (int rep_ = 0; rep_ < REPS(11); ++rep_) if (PH(11)) norm2_phase(F, ka, l, last ? MLAT : MT);
        GRID_BAR();
        for (int rep_ = 0; rep_ < REPS(12); ++rep_) if (PH(12)) select_phase(F, ka, l);
        GRID_BAR();
        for (int rep_ = 0; rep_ < REPS(13); ++rep_) if (PH(13)) { unsigned char* ws = ws_fresh(ka); pg8::Gemm g{(const bf16_t*)(ws + WS_XG), (const bf16_t*)wsel(ws, l, W_GU), 1024, 1024, 1024, (size_t)2048 * 1024}; pg8::Order S; S.init(nMs, 8, F.G, bx, 1);
            pg8::EpiSwiglu E{ws + WS_ACT}; pg8::gemm_phase<pg8::EpiSwiglu, true>(F.lds, g, S, E); }
        TAIL1(nMs * 8, Q_GU);
        GRID_BAR();
        for (int rep_ = 0; rep_ < REPS(14); ++rep_) if (PH(14)) { unsigned char* ws = ws_fresh(ka); pg8::Gemm g{(const bf16_t*)(ws + WS_ACT), (const bf16_t*)wsel(ws, l, W_DN), 1024, 1024, 1024, (size_t)1024 * 1024}; pg8::Order S; S.init(nMs, 4, F.G, bx, 1);
            pg8::EpiDown E{(bf16_t*)(ws + WS_Y), (const float*)(ws + WS_GATE)}; pg8::gemm_phase<pg8::EpiDown, true>(F.lds, g, S, E); }
        TAIL1(nMs * 4, Q_DN);
        GRID_BAR();
        for (int rep_ = 0; rep_ < REPS(15); ++rep_) if (PH(15)) row_phase(F, ka, l + 1, rep_);
        if (!last) { for (int rep_ = 0; rep_ < REPS(16); ++rep_) if (PH(16)) convert_weights(F, ka, l + 1, cur); GRID_BAR(); }
    }
}

extern "C" void kernel_launch(void* const* d_in, const int* in_sizes, int n_in, void* d_out, int out_size, void* d_ws, size_t ws_size, hipStream_t stream) {
    static int grid = 0;
    if (grid == 0) {
        if (n_in != 29 || in_sizes[0] != MLAT * D || out_size != MLAT * D || ws_size < WS_END) {
            fprintf(stderr, "kernel_launch: unexpected problem: n_in %d in0 %d out %d ws %zu (need %zu)\n", n_in, n_in > 0 ? in_sizes[0] : -1, out_size, ws_size, (size_t)WS_END); grid = -1; return; }
        int dev = 0, cus = 0, per_cu = 0;
        if (hipGetDevice(&dev) != hipSuccess || hipDeviceGetAttribute(&cus, hipDeviceAttributeMultiprocessorCount, dev) != hipSuccess) { fprintf(stderr, "kernel_launch: device query failed\n"); grid = -1; return; }
        if (hipFuncSetAttribute((const void*)mega_fwd, hipFuncAttributeMaxDynamicSharedMemorySize, LDS_BYTES) != hipSuccess) { fprintf(stderr, "kernel_launch: hipFuncSetAttribute failed\n"); grid = -1; return; }
        if (hipOccupancyMaxActiveBlocksPerMultiprocessor(&per_cu, (const void*)mega_fwd, 512, LDS_BYTES) != hipSuccess || per_cu < 1) {
            fprintf(stderr, "kernel_launch: occupancy query reports %d workgroups per CU\n", per_cu); }
        (void)hipGetLastError();
        grid = cus;
    }
    if (grid < 0) return;
    if (hipMemsetAsync((char*)d_ws + WS_CTL, 0, CTL_BYTES, stream) != hipSuccess) { fprintf(stderr, "kernel_launch: memset failed\n"); return; }
    Args a{};
    for (int i = 0; i < 29; ++i) a.in[i] = (const float*)d_in[i];
    a.out = (float*)d_out; a.ws = (unsigned char*)d_ws;
    hipLaunchKernelGGL(mega_fwd, dim3(grid), dim3(512), LDS_BYTES, stream, a);
    const hipError_t le = hipPeekAtLastError();
    if (le != hipSuccess) fprintf(stderr, "kernel_launch: launch failed: %s\n", hipGetErrorName(le));
}
```
